# Optimizing an MI355X kernel written in HIP

```python
import math
import jax, jax.numpy as jnp
from jax import lax
import numpy as np

D_MODEL = 1024
BATCH = 8
SEQ = 4096
DEPTH = 1

GRID_W = 64
CTX_LEN = 256
HEAD_DIM = 64
D_MIX = D_MODEL
NA_HEADS = (D_MIX // 2) // HEAD_DIM
NA_WIDTH = NA_HEADS * HEAD_DIM
NA_WIN_R = 8
NA_WIN_C = 16
DIFF_QK = HEAD_DIM
DIFF_V = 2 * DIFF_QK
DIFF_HEADS = (D_MIX - NA_WIDTH) // DIFF_V
DIFF_WIDTH = DIFF_HEADS * DIFF_V
DIFF_QK_WIDTH = 2 * DIFF_HEADS * DIFF_QK
QKV_WIDTH = 3 * NA_WIDTH + 2 * DIFF_QK_WIDTH + DIFF_WIDTH
Q_BLOCK = 128
ROPE_THETA = 10000.0
PEER_HEADS = 8
PEER_NKEYS = 128
PEER_EXPERTS = PEER_NKEYS * PEER_NKEYS
PEER_QDIM = 256
PEER_TOPK = 16
TOKEN_BLOCK = 128
N_MOD = 6
EPS = 1e-6

kernel_name = "hybrid_natten_diffattn_peer_block"


def rmsnorm(x, g):
    xf = x.astype(jnp.float32)
    y = xf * lax.rsqrt(jnp.mean(xf * xf, axis=-1, keepdims=True) + EPS)
    return (y * g.astype(jnp.float32)).astype(x.dtype)


def modulate(h, shift, scale):
    return h * (1.0 + scale) + shift


def axial_rope_tables(n_tokens, dim):
    t = jnp.arange(n_tokens)
    row = (t // GRID_W).astype(jnp.float32)
    col = (t % GRID_W).astype(jnp.float32)
    n_freq = dim // 4
    inv = ROPE_THETA ** (-jnp.arange(n_freq, dtype=jnp.float32) / n_freq)
    ang = jnp.concatenate([row[:, None] * inv, col[:, None] * inv], axis=-1)
    return jnp.cos(ang), jnp.sin(ang)


def apply_rope(x, cos, sin):
    xp = x.reshape(x.shape[:-1] + (x.shape[-1] // 2, 2))
    x0, x1 = xp[..., 0], xp[..., 1]
    cos = cos.astype(x.dtype)
    sin = sin.astype(x.dtype)
    return jnp.stack([x0 * cos - x1 * sin, x0 * sin + x1 * cos], axis=-1).reshape(x.shape)


def split_projection(p):
    B, L, _ = p.shape
    cuts = [int(i) for i in np.cumsum([NA_WIDTH, NA_WIDTH, NA_WIDTH, DIFF_QK_WIDTH, DIFF_QK_WIDTH])]
    qa, ka, va, qd, kd, vd = jnp.split(p, cuts, axis=-1)
    heads_a = lambda t: t.reshape(B, L, NA_HEADS, HEAD_DIM).transpose(0, 2, 1, 3)
    heads_qk = lambda t: t.reshape(B, L, 2, DIFF_HEADS, DIFF_QK).transpose(0, 2, 3, 1, 4)
    heads_v = lambda t: t.reshape(B, L, DIFF_HEADS, DIFF_V).transpose(0, 2, 1, 3)
    return heads_a(qa), heads_a(ka), heads_a(va), heads_qk(qd), heads_qk(kd), heads_v(vd)


def merge_heads(out_a, out_d, w_out):
    B, _, L, _ = out_a.shape
    ya = out_a.transpose(0, 2, 1, 3).reshape(B, L, NA_WIDTH)
    yd = out_d.transpose(0, 2, 1, 3).reshape(B, L, DIFF_WIDTH)
    return jnp.concatenate([ya, yd], axis=-1) @ w_out


def neighbourhood_attention(q, k, v, k_ctx, v_ctx, rel_bias):
    B, H, T, d = q.shape
    C = k_ctx.shape[2]
    rows = T // GRID_W
    kr = min(NA_WIN_R, rows)
    kc = NA_WIN_C
    qg = q.reshape(B, H, rows, GRID_W, d)
    kg = k.reshape(B, H, rows, GRID_W, d)
    vg = v.reshape(B, H, rows, GRID_W, d)
    cols = jnp.arange(GRID_W)
    c_start = jnp.clip(cols - kc // 2, 0, GRID_W - kc)
    c_idx = c_start[:, None] + jnp.arange(kc)[None, :]
    c_off = c_idx - cols[:, None] + (NA_WIN_C - 1)
    scale = d ** -0.5

    def row_block(r):
        r_start = jnp.clip(r - kr // 2, 0, rows - kr)
        q_r = lax.dynamic_index_in_dim(qg, r, axis=2, keepdims=False)
        k_r = lax.dynamic_slice_in_dim(kg, r_start, kr, axis=2)
        v_r = lax.dynamic_slice_in_dim(vg, r_start, kr, axis=2)
        k_nb = k_r[:, :, :, c_idx]
        v_nb = v_r[:, :, :, c_idx]
        r_off = r_start + jnp.arange(kr) - r + (NA_WIN_R - 1)
        bias = rel_bias[:, r_off][:, :, c_off].transpose(0, 2, 1, 3)
        s_loc = jnp.einsum('bhwd,bhawkd->bhwak', q_r, k_nb) * scale + bias[None]
        s_ctx = jnp.einsum('bhwd,bhcd->bhwc', q_r, k_ctx) * scale
        s = jnp.concatenate([s_ctx, s_loc.reshape(B, H, GRID_W, kr * kc)], axis=-1)
        p = jax.nn.softmax(s.astype(jnp.float32), axis=-1).astype(v.dtype)
        p_ctx = p[..., :C]
        p_loc = p[..., C:].reshape(B, H, GRID_W, kr, kc)
        return (jnp.einsum('bhwc,bhcd->bhwd', p_ctx, v_ctx)
                + jnp.einsum('bhwak,bhawkd->bhwd', p_loc, v_nb))

    out = lax.map(row_block, jnp.arange(rows))
    return out.transpose(1, 2, 0, 3, 4).reshape(B, H, T, d)


def dense_attention(q, k, v):
    s = jnp.einsum('bhqd,bhkd->bhqk', q, k) * (q.shape[-1] ** -0.5)
    p = jax.nn.softmax(s.astype(jnp.float32), axis=-1).astype(v.dtype)
    return jnp.einsum('bhqk,bhkd->bhqd', p, v)


def diff_lambda_value(lam_params, lambda_init):
    lp = lam_params.astype(jnp.float32)
    return jnp.exp(jnp.sum(lp[0] * lp[1])) - jnp.exp(jnp.sum(lp[2] * lp[3])) + lambda_init


def diff_attention_block(q, k, v, lam):
    s = jnp.einsum('bmhqd,bmhkd->bmhqk', q, k).astype(jnp.float32) * (q.shape[-1] ** -0.5)
    p = jax.nn.softmax(s, axis=-1)
    a = p[:, 0] - lam * p[:, 1]
    return jnp.einsum('bhqk,bhkd->bhqd', a.astype(v.dtype), v)


def diff_attention_latent(q, k, v, k_ctx, v_ctx, lam):
    B, M, H, T, d = q.shape
    k_all = jnp.concatenate([k_ctx, k], axis=3)
    v_all = jnp.concatenate([v_ctx, v], axis=2)
    nb = T // Q_BLOCK
    qb = q.reshape(B, M, H, nb, Q_BLOCK, d).transpose(3, 0, 1, 2, 4, 5)
    out = lax.map(lambda qq: diff_attention_block(qq, k_all, v_all, lam), qb)
    return out.transpose(1, 2, 0, 3, 4).reshape(B, H, T, v.shape[-1])


def peer_ffn(h, w_q, keys, u, v):
    shp = h.shape
    hb = h.reshape(-1, TOKEN_BLOCK, shp[-1])

    def block(xb):
        tb = xb.shape[0]
        q = (xb @ w_q).reshape(tb, PEER_HEADS, 2, PEER_QDIM // 2)
        s = jnp.einsum('thpd,hpnd->thpn', q, keys).astype(jnp.float32)
        s_top, i_top = lax.top_k(s, PEER_TOPK)
        cand = s_top[:, :, 0, :, None] + s_top[:, :, 1, None, :]
        cand_idx = i_top[:, :, 0, :, None] * PEER_NKEYS + i_top[:, :, 1, None, :]
        best, pos = lax.top_k(cand.reshape(tb, PEER_HEADS, PEER_TOPK * PEER_TOPK), PEER_TOPK)
        experts = jnp.take_along_axis(cand_idx.reshape(tb, PEER_HEADS, -1), pos, axis=-1)
        gates = jax.nn.softmax(best, axis=-1).astype(xb.dtype)
        u_sel = u[experts]
        v_sel = v[experts]
        act = jax.nn.gelu(jnp.einsum('td,thkd->thk', xb, u_sel), approximate=False)
        return jnp.einsum('thk,thkd->td', gates * act, v_sel)

    return lax.map(block, hb).reshape(shp)


def setup_inputs(seed: int = 0) -> dict:
    key = jax.random.key(seed)
    ks = jax.random.split(key, 16)
    nrm = lambda k, shape, s: s * jax.random.normal(k, shape, jnp.float32)
    return {
        "x": nrm(ks[0], (BATCH, SEQ, D_MODEL), 1.0),
        "c": nrm(ks[1], (BATCH, D_MODEL), 1.0),
        "ctx": nrm(ks[2], (BATCH, CTX_LEN, D_MODEL), 1.0),
        "c_ctx": nrm(ks[3], (D_MODEL,), 1.0),
        "w_ada": nrm(ks[4], (DEPTH, D_MODEL, N_MOD * D_MODEL), 0.5 * D_MODEL ** -0.5),
        "b_ada": nrm(ks[5], (DEPTH, N_MOD * D_MODEL), 0.02),
        "g_norm": 1.0 + nrm(ks[6], (DEPTH, 4, D_MODEL), 0.02),
        "w_in": nrm(ks[7], (DEPTH, D_MODEL, QKV_WIDTH), D_MODEL ** -0.5),
        "na_rel_bias": nrm(ks[8], (DEPTH, NA_HEADS, 2 * NA_WIN_R - 1, 2 * NA_WIN_C - 1), 0.1),
        "diff_lambda": nrm(ks[9], (DEPTH, 4, DIFF_QK), 0.1),
        "diff_subln": 1.0 + nrm(ks[10], (DEPTH, DIFF_V), 0.02),
        "w_out": nrm(ks[11], (DEPTH, D_MIX, D_MODEL), D_MIX ** -0.5),
        "peer_wq": nrm(ks[12], (DEPTH, D_MODEL, PEER_HEADS * PEER_QDIM), D_MODEL ** -0.5),
        "peer_keys": nrm(ks[13], (DEPTH, PEER_HEADS, 2, PEER_NKEYS, PEER_QDIM // 2), (PEER_QDIM // 2) ** -0.5),
        "peer_u": nrm(ks[14], (DEPTH, PEER_EXPERTS, D_MODEL), D_MODEL ** -0.5),
        "peer_v": nrm(ks[15], (DEPTH, PEER_EXPERTS, D_MODEL), D_MODEL ** -0.5),
    }


def reference(x, c, ctx, c_ctx, w_ada, b_ada, g_norm, w_in, na_rel_bias, diff_lambda,
              diff_subln, w_out, peer_wq, peer_keys, peer_u, peer_v):
    T = x.shape[1]
    cos, sin = axial_rope_tables(T, DIFF_QK)
    x_lat, x_ctx = x, ctx
    for l in range(DEPTH):
        lambda_init = 0.8 - 0.6 * math.exp(-0.3 * l)
        mod_lat = (jax.nn.silu(c) @ w_ada[l] + b_ada[l])[:, None, :]
        mod_ctx = (jax.nn.silu(c_ctx) @ w_ada[l] + b_ada[l])[None, None, :]
        sh1, sc1, gt1, sh2, sc2, gt2 = jnp.split(mod_lat, N_MOD, axis=-1)
        csh1, csc1, cgt1, csh2, csc2, cgt2 = jnp.split(mod_ctx, N_MOD, axis=-1)
        lam = diff_lambda_value(diff_lambda[l], lambda_init)

        h_lat = modulate(rmsnorm(x_lat, g_norm[l, 0]), sh1, sc1)
        h_ctx = modulate(rmsnorm(x_ctx, g_norm[l, 0]), csh1, csc1)
        qa, ka, va, qd, kd, vd = split_projection(h_lat @ w_in[l])
        qa_c, ka_c, va_c, qd_c, kd_c, vd_c = split_projection(h_ctx @ w_in[l])
        qd = apply_rope(qd, cos, sin)
        kd = apply_rope(kd, cos, sin)

        out_a = neighbourhood_attention(qa, ka, va, ka_c, va_c, na_rel_bias[l])
        out_d = diff_attention_latent(qd, kd, vd, kd_c, vd_c, lam)
        out_d = rmsnorm(out_d, diff_subln[l]) * (1.0 - lambda_init)
        y = merge_heads(out_a, out_d, w_out[l])
        x_lat_new = x_lat + gt1 * rmsnorm(y, g_norm[l, 1])

        h2 = modulate(rmsnorm(x_lat_new, g_norm[l, 2]), sh2, sc2)
        x_lat_new = x_lat_new + gt2 * rmsnorm(peer_ffn(h2, peer_wq[l], peer_keys[l], peer_u[l], peer_v[l]), g_norm[l, 3])

        if l < DEPTH - 1:
            out_a_c = dense_attention(qa_c, ka_c, va_c)
            out_d_c = rmsnorm(diff_attention_block(qd_c, kd_c, vd_c, lam), diff_subln[l]) * (1.0 - lambda_init)
            y_c = merge_heads(out_a_c, out_d_c, w_out[l])
            x_ctx = x_ctx + cgt1 * rmsnorm(y_c, g_norm[l, 1])
            h2c = modulate(rmsnorm(x_ctx, g_norm[l, 2]), csh2, csc2)
            x_ctx = x_ctx + cgt2 * rmsnorm(peer_ffn(h2c, peer_wq[l], peer_keys[l], peer_u[l], peer_v[l]), g_norm[l, 3])
        x_lat = x_lat_new
    return x_lat
```

```cpp
#include <hip/hip_runtime.h>
#include <stdint.h>
#include <math.h>

typedef unsigned short bf16_t;
typedef float f32x4 __attribute__((ext_vector_type(4)));
typedef unsigned u32x4 __attribute__((ext_vector_type(4)));
typedef unsigned u32x2 __attribute__((ext_vector_type(2)));

constexpr int D = 1024, BATCH = 8, SEQ = 4096, CTX = 256, GW = 64;
constexpr int MLAT = BATCH * SEQ;
constexpr int MCTX = BATCH * CTX;
constexpr int MALL = MLAT + MCTX;
constexpr int NQKV = 3072;
constexpr int NKT = 68;
constexpr int NMOD = 6 * D;
constexpr int PE_H = 8, PE_NK = 128, PE_QD = 256, PE_TOPK = 16, PE_NEXP = 16384;
constexpr float EPS = 1e-6f;
constexpr float LOG2E = 1.4426950408889634f;
constexpr float C2 = 0.125f * LOG2E;
constexpr float LAMBDA_INIT = 0.2f;
constexpr float NEG_BIG = -30000.0f;

constexpr size_t MiB = 1u << 20;
constexpr size_t WS_CTL = 0;
constexpr size_t WS_MOD = 1 * MiB;
constexpr size_t WS_LAM = 1 * MiB + 256 * 1024;
constexpr size_t WS_ROPE = 1 * MiB + 512 * 1024;
constexpr size_t WS_MODP = 2 * MiB;
constexpr size_t WS_BIAST = 4 * MiB;
constexpr size_t WS_KEYS = 5 * MiB;
constexpr size_t WS_WIN = 6 * MiB;
constexpr size_t WS_WOUT = 12 * MiB;
constexpr size_t WS_WPQ = 14 * MiB;
constexpr size_t WS_UB = 18 * MiB;
constexpr size_t WS_VB = 50 * MiB;
constexpr size_t WS_EXP = 82 * MiB;
constexpr size_t WS_GATE = 98 * MiB;
constexpr size_t WS_H2 = 114 * MiB;
constexpr size_t WS_H = 178 * MiB;
constexpr size_t WS_Y = 178 * MiB;
constexpr size_t WS_QA = 246 * MiB;
constexpr size_t WS_KA = 278 * MiB;
constexpr size_t WS_VA = 312 * MiB;
constexpr size_t WS_QD = 346 * MiB;
constexpr size_t WS_KD = 378 * MiB;
constexpr size_t WS_VD = 412 * MiB;
constexpr size_t WS_YO = 246 * MiB;
constexpr size_t WS_Q2 = 246 * MiB;
constexpr size_t WS_END = 446 * MiB;

struct Params {
    const float *x, *c, *ctx, *c_ctx, *w_ada, *b_ada, *g_norm, *w_in, *rel_bias, *diff_lambda, *diff_subln, *w_out, *peer_wq, *peer_keys, *peer_u, *peer_v;
    float* out;
    unsigned char* ws;
};

__device__ __forceinline__ unsigned f2bf(float f) { unsigned u = __builtin_bit_cast(unsigned, f); return (u + 0x7fffu + ((u >> 16) & 1u)) >> 16; }
__device__ __forceinline__ unsigned pk2(float lo, float hi) { return f2bf(lo) | (f2bf(hi) << 16); }
__device__ __forceinline__ float bf2f(bf16_t h) { return __builtin_bit_cast(float, (unsigned)h << 16); }
__device__ __forceinline__ float bflo(unsigned w) { return __builtin_bit_cast(float, w << 16); }
__device__ __forceinline__ float bfhi(unsigned w) { return __builtin_bit_cast(float, w & 0xffff0000u); }
__device__ __forceinline__ float wave_sum(float v) {
#pragma unroll
    for (int o = 1; o < 64; o <<= 1) v += __shfl_xor(v, o);
    return v;
}
__device__ __forceinline__ float wave_max(float v) {
#pragma unroll
    for (int o = 1; o < 64; o <<= 1) v = fmaxf(v, __shfl_xor(v, o));
    return v;
}

__device__ __forceinline__ int ktile_off(int k, int d) { return (d >> 3) * 512 + k * 8 + (d & 7); }
__device__ __forceinline__ int vtile_off(int k, int d) { return (d >> 5) * 2048 + (k >> 4) * 512 + (k & 15) * 32 + (d & 31); }
__device__ __forceinline__ size_t qa_idx(int b, int h, int t, int d) { return ((size_t)(b * 8 + h) * SEQ + t) * 64 + d; }
__device__ __forceinline__ size_t ka_idx(int b, int h, int j, int d) { return ((size_t)(b * 8 + h) * NKT + (j >> 6)) * 4096 + ktile_off(j & 63, d); }
__device__ __forceinline__ size_t va_idx(int b, int h, int j, int d) { return ((size_t)(b * 8 + h) * NKT + (j >> 6)) * 4096 + vtile_off(j & 63, d); }
__device__ __forceinline__ size_t qd_idx(int b, int m, int h, int t, int d) { return ((size_t)((b * 2 + m) * 4 + h) * SEQ + t) * 64 + d; }
__device__ __forceinline__ size_t kd_idx(int b, int m, int h, int j, int d) { return ((size_t)((b * 2 + m) * 4 + h) * NKT + (j >> 6)) * 4096 + ktile_off(j & 63, d); }
__device__ __forceinline__ size_t vd_idx(int b, int h, int j, int d) { return ((size_t)(b * 4 + h) * NKT + (j >> 6)) * 8192 + vtile_off(j & 63, d); }

__global__ void __launch_bounds__(256) k_transpose_bf16(const float* __restrict__ W, bf16_t* __restrict__ WT, int K, int N) {
    __shared__ float tile[32][33];
    const int nb = N / 32, kb = blockIdx.x / nb, nbk = blockIdx.x % nb;
    const int tx = threadIdx.x & 31, ty = threadIdx.x >> 5;
    for (int i = ty; i < 32; i += 8) tile[i][tx] = W[(size_t)(kb * 32 + i) * N + nbk * 32 + tx];
    __syncthreads();
    for (int i = ty; i < 32; i += 8) WT[(size_t)(nbk * 32 + i) * K + kb * 32 + tx] = (bf16_t)f2bf(tile[tx][i]);
}
__global__ void __launch_bounds__(256) k_cvt_bf16(const float* __restrict__ src, bf16_t* __restrict__ dst, size_t n4) {
    for (size_t i = (size_t)blockIdx.x * 256 + threadIdx.x; i < n4; i += (size_t)gridDim.x * 256) {
        const f32x4 v = ((const f32x4*)src)[i];
        u32x2 o; o.x = pk2(v.x, v.y); o.y = pk2(v.z, v.w);
        ((u32x2*)dst)[i] = o;
    }
}
__global__ void __launch_bounds__(256) k_mod_naive(Params p) {
    __shared__ float sc[9][1024];
    for (int i = threadIdx.x; i < 9 * 1024; i += 256) { const int r = i >> 10, k = i & 1023; const float v = r < 8 ? p.c[r * 1024 + k] : p.c_ctx[k]; sc[r][k] = v / (1.f + __expf(-v)); }
    __syncthreads();
    const int j = blockIdx.x * 256 + threadIdx.x;
    float acc[9];
#pragma unroll
    for (int r = 0; r < 9; ++r) acc[r] = 0.f;
    for (int k = 0; k < 1024; ++k) { const float w = p.w_ada[(size_t)k * NMOD + j];
#pragma unroll
        for (int r = 0; r < 9; ++r) acc[r] += sc[r][k] * w; }
    float* mod = (float*)(p.ws + WS_MOD);
#pragma unroll
    for (int r = 0; r < 9; ++r) mod[r * NMOD + j] = acc[r] + p.b_ada[j];
}
__global__ void __launch_bounds__(256) k_misc(Params p) {
    const int gid = blockIdx.x * 256 + threadIdx.x, gsz = gridDim.x * 256;
    if (gid == 0) {
        float s01 = 0.f, s23 = 0.f;
        for (int i = 0; i < 64; ++i) { s01 += p.diff_lambda[i] * p.diff_lambda[64 + i]; s23 += p.diff_lambda[128 + i] * p.diff_lambda[192 + i]; }
        *(float*)(p.ws + WS_LAM) = expf(s01) - expf(s23) + LAMBDA_INIT;
    }
    float* rope = (float*)(p.ws + WS_ROPE);
    for (int i = gid; i < 64 * 16; i += gsz) { const int pos = i >> 4, f = i & 15; const float inv = exp2f(-(float)f * (13.287712379549449f / 16.f)); const float a = (float)pos * inv; rope[2 * i] = cosf(a); rope[2 * i + 1] = sinf(a); }
    bf16_t* bt = (bf16_t*)(p.ws + WS_BIAST);
    for (int i = gid; i < 8 * 15 * 4096; i += gsz) {
        const int j = i & 7, kc = (i >> 3) & 63, cq = (i >> 9) & 7, hd = i >> 12, dr = hd % 15, h = hd / 15;
        const int cp = cq * 8 + j; int cs = cp - 8; cs = cs < 0 ? 0 : (cs > 48 ? 48 : cs);
        float v = NEG_BIG;
        if (kc >= cs && kc < cs + 16) v = p.rel_bias[(h * 15 + dr) * 31 + (kc - cp + 15)] * LOG2E;
        bt[i] = (bf16_t)f2bf(v);
    }
}

__global__ void __launch_bounds__(256) k_hrows(Params p) {
    const int lane = threadIdx.x & 63, gw = (blockIdx.x * 256 + threadIdx.x) >> 6, ngw = gridDim.x * 4;
    const float* mod = (const float*)(p.ws + WS_MOD);
    bf16_t* H = (bf16_t*)(p.ws + WS_H);
    for (int row = gw; row < MALL; row += ngw) {
        const float* xr = row < MLAT ? p.x + (size_t)row * D : p.ctx + (size_t)(row - MLAT) * D;
        const int mr = row < MLAT ? (row >> 12) : 8;
        f32x4 v[4]; float s = 0.f;
#pragma unroll
        for (int j = 0; j < 4; ++j) { v[j] = ((const f32x4*)xr)[lane + 64 * j]; s += v[j].x * v[j].x + v[j].y * v[j].y + v[j].z * v[j].z + v[j].w * v[j].w; }
        const float rstd = rsqrtf(wave_sum(s) * (1.f / D) + EPS);
#pragma unroll
        for (int j = 0; j < 4; ++j) {
            const int col = (lane + 64 * j) * 4;
            const f32x4 g = *(const f32x4*)(p.g_norm + col), sh = *(const f32x4*)(mod + mr * NMOD + col), sc = *(const f32x4*)(mod + mr * NMOD + D + col);
            const f32x4 y = (v[j] * rstd * g) * (sc + 1.f) + sh;
            u32x2 o; o.x = pk2(y.x, y.y); o.y = pk2(y.z, y.w);
            *(u32x2*)(H + (size_t)row * D + col) = o;
        }
    }
}

struct EpiPlain {
    bf16_t* C; int ldc; int pad;
    __device__ __forceinline__ void operator()(const Params&, int row, int col, float v0, float v1, float v2, float v3) const {
        u32x2 o; o.x = pk2(v0, v1); o.y = pk2(v2, v3); *(u32x2*)(C + (size_t)row * ldc + col) = o;
    }
};
__device__ __forceinline__ void qkv_store_pair(const Params& p, int row, int col, float v0, float v1) {
    const bool lat = row < MLAT;
    const int b = lat ? (row >> 12) : ((row - MLAT) >> 8);
    const int t = lat ? (row & 4095) : 0;
    const int j = lat ? (256 + t) : ((row - MLAT) & 255);
    const int kind = col >> 9, cc = col & 511;
    unsigned char* ws = p.ws;
    if (kind == 0) { if (!lat) return; const int h = cc >> 6, d = cc & 63; *(unsigned*)((bf16_t*)(ws + WS_QA) + qa_idx(b, h, t, d)) = pk2(v0 * C2, v1 * C2); }
    else if (kind == 1) { const int h = cc >> 6, d = cc & 63; *(unsigned*)((bf16_t*)(ws + WS_KA) + ka_idx(b, h, j, d)) = pk2(v0, v1); }
    else if (kind == 2) { const int h = cc >> 6, d = cc & 63; *(unsigned*)((bf16_t*)(ws + WS_VA) + va_idx(b, h, j, d)) = pk2(v0, v1); }
    else if (kind == 3 || kind == 4) {
        if (kind == 3 && !lat) return;
        const int m = cc >> 8, h = (cc >> 6) & 3, d = cc & 63;
        if (lat) { const int i = d >> 1; const int pos = i < 16 ? (t >> 6) : (t & 63); const float* rp = (const float*)(ws + WS_ROPE) + (pos * 16 + (i & 15)) * 2; const float cs = rp[0], sn = rp[1];
            const float a0 = v0 * cs - v1 * sn, a1 = v0 * sn + v1 * cs; v0 = a0; v1 = a1; }
        if (kind == 3) *(unsigned*)((bf16_t*)(ws + WS_QD) + qd_idx(b, m, h, t, d)) = pk2(v0 * C2, v1 * C2);
        else *(unsigned*)((bf16_t*)(ws + WS_KD) + kd_idx(b, m, h, j, d)) = pk2(v0, v1);
    } else { const int h = cc >> 7, d = cc & 127; *(unsigned*)((bf16_t*)(ws + WS_VD) + vd_idx(b, h, j, d)) = pk2(v0, v1); }
}
struct EpiQKV {
    int pad0, pad1;
    __device__ __forceinline__ void operator()(const Params& p, int row, int col, float v0, float v1, float v2, float v3) const { qkv_store_pair(p, row, col, v0, v1); qkv_store_pair(p, row, col + 2, v2, v3); }
};
template <class Epi>
__global__ void __launch_bounds__(256) k_gemm_naive(Params p, const bf16_t* __restrict__ A, const bf16_t* __restrict__ Bt, int M, int N, int K, int padarg, Epi epi) {
    __shared__ float As[32][68], Bs[32][68];
    const int nbn = N / 64, bm = blockIdx.x / nbn, bn = blockIdx.x % nbn;
    const int tid = threadIdx.x, tx = tid & 15, ty = tid >> 4;
    const int lr = tid >> 2, lc = (tid & 3) * 8;
    float acc[4][4];
#pragma unroll
    for (int i = 0; i < 4; ++i)
#pragma unroll
        for (int j = 0; j < 4; ++j) acc[i][j] = 0.f;
    for (int k0 = 0; k0 < K; k0 += 32) {
        const u32x4 a = *(const u32x4*)(A + (size_t)(bm * 64 + lr) * K + k0 + lc);
        const u32x4 b = *(const u32x4*)(Bt + (size_t)(bn * 64 + lr) * K + k0 + lc);
        __syncthreads();
        As[lc + 0][lr] = bflo(a.x); As[lc + 1][lr] = bfhi(a.x); As[lc + 2][lr] = bflo(a.y); As[lc + 3][lr] = bfhi(a.y);
        As[lc + 4][lr] = bflo(a.z); As[lc + 5][lr] = bfhi(a.z); As[lc + 6][lr] = bflo(a.w); As[lc + 7][lr] = bfhi(a.w);
        Bs[lc + 0][lr] = bflo(b.x); Bs[lc + 1][lr] = bfhi(b.x); Bs[lc + 2][lr] = bflo(b.y); Bs[lc + 3][lr] = bfhi(b.y);
        Bs[lc + 4][lr] = bflo(b.z); Bs[lc + 5][lr] = bfhi(b.z); Bs[lc + 6][lr] = bflo(b.w); Bs[lc + 7][lr] = bfhi(b.w);
        __syncthreads();
#pragma unroll 8
        for (int k = 0; k < 32; ++k) {
            const f32x4 av = *(const f32x4*)&As[k][ty * 4], bv = *(const f32x4*)&Bs[k][tx * 4];
#pragma unroll
            for (int i = 0; i < 4; ++i) { acc[i][0] += av[i] * bv[0]; acc[i][1] += av[i] * bv[1]; acc[i][2] += av[i] * bv[2]; acc[i][3] += av[i] * bv[3]; }
        }
    }
#pragma unroll
    for (int i = 0; i < 4; ++i) epi(p, bm * 64 + ty * 4 + i, bn * 64 + tx * 4, acc[i][0], acc[i][1], acc[i][2], acc[i][3]);
}

__global__ void __launch_bounds__(256) k_na_naive(Params p) {
    __shared__ float sq[4][64], sp[4][384];
    const int w = threadIdx.x >> 6, lane = threadIdx.x & 63;
    const int q = blockIdx.x * 4 + w;
    const int t = q & 4095, h = (q >> 12) & 7, b = q >> 15;
    const bf16_t* Qa = (const bf16_t*)(p.ws + WS_QA); const bf16_t* Ka = (const bf16_t*)(p.ws + WS_KA); const bf16_t* Va = (const bf16_t*)(p.ws + WS_VA);
    sq[w][lane] = bf2f(Qa[qa_idx(b, h, t, lane)]);
    __syncthreads();
    const int r = t >> 6, c = t & 63;
    int rs = r - 4; rs = rs < 0 ? 0 : (rs > 56 ? 56 : rs);
    int cs = c - 8; cs = cs < 0 ? 0 : (cs > 48 ? 48 : cs);
    float sv[6]; float mx = -INFINITY;
#pragma unroll
    for (int i = 0; i < 6; ++i) {
        const int e = i * 64 + lane; int j; float bias = 0.f;
        if (e < 256) j = e; else { const int a = (e - 256) >> 4, kk = (e - 256) & 15; const int kr = rs + a, kc = cs + kk; j = 256 + kr * 64 + kc; bias = p.rel_bias[(h * 15 + (kr - r + 7)) * 31 + (kc - c + 15)] * LOG2E; }
        float s = 0.f;
        for (int d = 0; d < 64; ++d) s += sq[w][d] * bf2f(Ka[ka_idx(b, h, j, d)]);
        s += bias; sv[i] = s; mx = fmaxf(mx, s);
    }
    mx = wave_max(mx);
    float l = 0.f;
#pragma unroll
    for (int i = 0; i < 6; ++i) { const float e = exp2f(sv[i] - mx); l += e; sp[w][i * 64 + lane] = e; }
    l = wave_sum(l);
    __syncthreads();
    float o = 0.f;
    for (int e = 0; e < 384; ++e) { int j; if (e < 256) j = e; else { const int a = (e - 256) >> 4, kk = (e - 256) & 15; j = 256 + (rs + a) * 64 + cs + kk; }
        o += sp[w][e] * bf2f(Va[va_idx(b, h, j, lane)]); }
    bf16_t* Y = (bf16_t*)(p.ws + WS_Y);
    Y[(size_t)(b * SEQ + t) * D + h * 64 + lane] = (bf16_t)f2bf(o / l);
}

__global__ void __launch_bounds__(256) k_diff_naive(Params p) {
    extern __shared__ float dynss[];
    float (*ss)[2][4352] = (float (*)[2][4352])dynss;
    __shared__ float sq[2][2][64];
    __shared__ float red[8];
    __shared__ float stat[2][2][2];
    const int tid = threadIdx.x, lane = tid & 63, w = tid >> 6;
    const int blk = blockIdx.x;
    const int t0 = (blk & 2047) * 2, h = (blk >> 11) & 3, b = blk >> 13;
    const bf16_t* Qd = (const bf16_t*)(p.ws + WS_QD); const bf16_t* Kd = (const bf16_t*)(p.ws + WS_KD); const bf16_t* Vd = (const bf16_t*)(p.ws + WS_VD);
    { const int qi = tid >> 7, m = (tid >> 6) & 1, d = tid & 63; sq[qi][m][d] = bf2f(Qd[qd_idx(b, m, h, t0 + qi, d)]); }
    __syncthreads();
    for (int m = 0; m < 2; ++m)
        for (int j = tid; j < 4352; j += 256) {
            float s0 = 0.f, s1 = 0.f;
            for (int d = 0; d < 64; ++d) { const float kv = bf2f(Kd[kd_idx(b, m, h, j, d)]); s0 += sq[0][m][d] * kv; s1 += sq[1][m][d] * kv; }
            ss[0][m][j] = s0; ss[1][m][j] = s1;
        }
    __syncthreads();
    for (int qm = 0; qm < 4; ++qm) {
        const int qi = qm >> 1, m = qm & 1;
        float mx = -INFINITY;
        for (int j = tid; j < 4352; j += 256) mx = fmaxf(mx, ss[qi][m][j]);
        mx = wave_max(mx); if (lane == 0) red[w] = mx; __syncthreads();
        mx = fmaxf(fmaxf(red[0], red[1]), fmaxf(red[2], red[3])); __syncthreads();
        float l = 0.f;
        for (int j = tid; j < 4352; j += 256) l += exp2f(ss[qi][m][j] - mx);
        l = wave_sum(l); if (lane == 0) red[w] = l; __syncthreads();
        l = red[0] + red[1] + red[2] + red[3]; __syncthreads();
        if (tid == 0) { stat[qi][m][0] = mx; stat[qi][m][1] = l; }
    }
    __syncthreads();
    const float lam = *(const float*)(p.ws + WS_LAM);
    for (int qi = 0; qi < 2; ++qi) { const float m0 = stat[qi][0][0], l0 = stat[qi][0][1], m1 = stat[qi][1][0], l1 = stat[qi][1][1];
        for (int j = tid; j < 4352; j += 256) ss[qi][0][j] = exp2f(ss[qi][0][j] - m0) / l0 - lam * exp2f(ss[qi][1][j] - m1) / l1; }
    __syncthreads();
    const int qi = tid >> 7, dv = tid & 127;
    float o = 0.f;
    for (int j = 0; j < 4352; ++j) o += ss[qi][0][j] * bf2f(Vd[vd_idx(b, h, j, dv)]);
    float s2 = wave_sum(o * o); if (lane == 0) red[w] = s2; __syncthreads();
    const float tot = red[qi * 2] + red[qi * 2 + 1];
    const float y = o * rsqrtf(tot * (1.f / 128.f) + EPS) * p.diff_subln[dv] * (1.f - LAMBDA_INIT);
    bf16_t* Y = (bf16_t*)(p.ws + WS_Y);
    Y[(size_t)(b * SEQ + t0 + qi) * D + 512 + h * 128 + dv] = (bf16_t)f2bf(y);
}

__global__ void __launch_bounds__(256) k_rows2(Params p) {
    const int lane = threadIdx.x & 63, gw = (blockIdx.x * 256 + threadIdx.x) >> 6, ngw = gridDim.x * 4;
    const float* mod = (const float*)(p.ws + WS_MOD);
    const bf16_t* YO = (const bf16_t*)(p.ws + WS_YO);
    bf16_t* H2 = (bf16_t*)(p.ws + WS_H2);
    for (int row = gw; row < MLAT; row += ngw) {
        const int b = row >> 12; const float* mb = mod + b * NMOD;
        f32x4 xv[4], yv[4]; float s = 0.f;
#pragma unroll
        for (int j = 0; j < 4; ++j) { xv[j] = ((const f32x4*)(p.x + (size_t)row * D))[lane + 64 * j];
            const u32x2 yw = ((const u32x2*)(YO + (size_t)row * D))[lane + 64 * j]; yv[j] = (f32x4){bflo(yw.x), bfhi(yw.x), bflo(yw.y), bfhi(yw.y)};
            s += yv[j].x * yv[j].x + yv[j].y * yv[j].y + yv[j].z * yv[j].z + yv[j].w * yv[j].w; }
        const float rstd = rsqrtf(wave_sum(s) * (1.f / D) + EPS);
        float s2 = 0.f;
#pragma unroll
        for (int j = 0; j < 4; ++j) { const int col = (lane + 64 * j) * 4;
            const f32x4 g1 = *(const f32x4*)(p.g_norm + D + col), gt1 = *(const f32x4*)(mb + 2 * D + col);
            xv[j] = xv[j] + gt1 * (yv[j] * rstd * g1);
            *(f32x4*)(p.out + (size_t)row * D + col) = xv[j];
            s2 += xv[j].x * xv[j].x + xv[j].y * xv[j].y + xv[j].z * xv[j].z + xv[j].w * xv[j].w; }
        const float rstd2 = rsqrtf(wave_sum(s2) * (1.f / D) + EPS);
#pragma unroll
        for (int j = 0; j < 4; ++j) { const int col = (lane + 64 * j) * 4;
            const f32x4 g2 = *(const f32x4*)(p.g_norm + 2 * D + col), sh2 = *(const f32x4*)(mb + 3 * D + col), sc2 = *(const f32x4*)(mb + 4 * D + col);
            const f32x4 y = (xv[j] * rstd2 * g2) * (sc2 + 1.f) + sh2;
            u32x2 o; o.x = pk2(y.x, y.y); o.y = pk2(y.z, y.w);
            *(u32x2*)(H2 + (size_t)row * D + col) = o; }
    }
}

__global__ void __launch_bounds__(256) k_topk_naive(Params p) {
    __shared__ float q[2048];
    __shared__ float s[2048];
    __shared__ float stv[16][16]; __shared__ int sti[16][16];
    __shared__ float cand[8][256];
    const int tid = threadIdx.x, t = blockIdx.x;
    const bf16_t* Q2 = (const bf16_t*)(p.ws + WS_Q2); const bf16_t* KB = (const bf16_t*)(p.ws + WS_KEYS);
    for (int i = tid; i < 2048; i += 256) q[i] = bf2f(Q2[(size_t)t * 2048 + i]);
    __syncthreads();
    for (int i = tid; i < 2048; i += 256) { const int hp = i >> 7; float a = 0.f; const bf16_t* kr = KB + (size_t)i * 128; const float* qq = q + hp * 128;
        for (int d = 0; d < 128; ++d) a += qq[d] * bf2f(kr[d]); s[i] = a; }
    __syncthreads();
    if (tid < 16) { float* sv = s + tid * 128;
        for (int k = 0; k < 16; ++k) { float best = -INFINITY; int bi = 0; for (int n = 0; n < 128; ++n) { const float v = sv[n]; if (v > best) { best = v; bi = n; } } stv[tid][k] = best; sti[tid][k] = bi; sv[bi] = -INFINITY; } }
    __syncthreads();
    for (int i = tid; i < 2048; i += 256) { const int h = i >> 8, pos = i & 255; cand[h][pos] = stv[h * 2][pos >> 4] + stv[h * 2 + 1][pos & 15]; }
    __syncthreads();
    if (tid < 8) { const int h = tid; float bv[16]; int be[16]; float mx = -INFINITY;
#pragma unroll
        for (int k = 0; k < 16; ++k) { float best = -INFINITY; int bi = 0; for (int n = 0; n < 256; ++n) { const float v = cand[h][n]; if (v > best) { best = v; bi = n; } } cand[h][bi] = -INFINITY; bv[k] = best; be[k] = sti[h * 2][bi >> 4] * 128 + sti[h * 2 + 1][bi & 15]; mx = fmaxf(mx, best); }
        float l = 0.f;
#pragma unroll
        for (int k = 0; k < 16; ++k) { bv[k] = __expf(bv[k] - mx); l += bv[k]; }
        int* EX = (int*)(p.ws + WS_EXP); float* GT = (float*)(p.ws + WS_GATE);
#pragma unroll
        for (int k = 0; k < 16; ++k) { EX[(size_t)t * 128 + h * 16 + k] = be[k]; GT[(size_t)t * 128 + h * 16 + k] = bv[k] / l; } }
}

__global__ void __launch_bounds__(256) k_gather(Params p) {
    const int lane = threadIdx.x & 63, gw = (blockIdx.x * 256 + threadIdx.x) >> 6, ngw = gridDim.x * 4;
    const bf16_t* H2 = (const bf16_t*)(p.ws + WS_H2); const bf16_t* UB = (const bf16_t*)(p.ws + WS_UB); const bf16_t* VB = (const bf16_t*)(p.ws + WS_VB);
    const int* EX = (const int*)(p.ws + WS_EXP); const float* GT = (const float*)(p.ws + WS_GATE); const float* mod = (const float*)(p.ws + WS_MOD);
    for (int t = gw; t < MLAT; t += ngw) {
        float hv[16], acc[16];
        { const u32x4 a = *(const u32x4*)(H2 + (size_t)t * D + lane * 8), b = *(const u32x4*)(H2 + (size_t)t * D + 512 + lane * 8);
          hv[0] = bflo(a.x); hv[1] = bfhi(a.x); hv[2] = bflo(a.y); hv[3] = bfhi(a.y); hv[4] = bflo(a.z); hv[5] = bfhi(a.z); hv[6] = bflo(a.w); hv[7] = bfhi(a.w);
          hv[8] = bflo(b.x); hv[9] = bfhi(b.x); hv[10] = bflo(b.y); hv[11] = bfhi(b.y); hv[12] = bflo(b.z); hv[13] = bfhi(b.z); hv[14] = bflo(b.w); hv[15] = bfhi(b.w); }
#pragma unroll
        for (int i = 0; i < 16; ++i) acc[i] = 0.f;
        for (int k = 0; k < 128; ++k) {
            const int e = EX[(size_t)t * 128 + k]; const float g = GT[(size_t)t * 128 + k];
            const u32x4 a = *(const u32x4*)(UB + (size_t)e * D + lane * 8), b = *(const u32x4*)(UB + (size_t)e * D + 512 + lane * 8);
            float d = hv[0] * bflo(a.x) + hv[1] * bfhi(a.x) + hv[2] * bflo(a.y) + hv[3] * bfhi(a.y) + hv[4] * bflo(a.z) + hv[5] * bfhi(a.z) + hv[6] * bflo(a.w) + hv[7] * bfhi(a.w)
                    + hv[8] * bflo(b.x) + hv[9] * bfhi(b.x) + hv[10] * bflo(b.y) + hv[11] * bfhi(b.y) + hv[12] * bflo(b.z) + hv[13] * bfhi(b.z) + hv[14] * bflo(b.w) + hv[15] * bfhi(b.w);
            d = wave_sum(d);
            const float act = 0.5f * d * (1.f + erff(d * 0.70710678118654752f));
            const float cf = g * act;
            const u32x4 va = *(const u32x4*)(VB + (size_t)e * D + lane * 8), vb = *(const u32x4*)(VB + (size_t)e * D + 512 + lane * 8);
            acc[0] += cf * bflo(va.x); acc[1] += cf * bfhi(va.x); acc[2] += cf * bflo(va.y); acc[3] += cf * bfhi(va.y); acc[4] += cf * bflo(va.z); acc[5] += cf * bfhi(va.z); acc[6] += cf * bflo(va.w); acc[7] += cf * bfhi(va.w);
            acc[8] += cf * bflo(vb.x); acc[9] += cf * bfhi(vb.x); acc[10] += cf * bflo(vb.y); acc[11] += cf * bfhi(vb.y); acc[12] += cf * bflo(vb.z); acc[13] += cf * bfhi(vb.z); acc[14] += cf * bflo(vb.w); acc[15] += cf * bfhi(vb.w);
        }
        float s = 0.f;
#pragma unroll
        for (int i = 0; i < 16; ++i) s += acc[i] * acc[i];
        const float rstd = rsqrtf(wave_sum(s) * (1.f / D) + EPS);
        const float* mb = mod + (t >> 12) * NMOD + 5 * D; const float* g3 = p.g_norm + 3 * D;
#pragma unroll
        for (int hh = 0; hh < 2; ++hh) {
            const int col = hh * 512 + lane * 8;
            float* op = p.out + (size_t)t * D + col;
            const f32x4 x0 = *(const f32x4*)op, x1 = *(const f32x4*)(op + 4);
            const f32x4 ga = *(const f32x4*)(g3 + col), gb = *(const f32x4*)(g3 + col + 4), ta = *(const f32x4*)(mb + col), tb = *(const f32x4*)(mb + col + 4);
            const f32x4 pa = (f32x4){acc[hh * 8 + 0], acc[hh * 8 + 1], acc[hh * 8 + 2], acc[hh * 8 + 3]}, pb = (f32x4){acc[hh * 8 + 4], acc[hh * 8 + 5], acc[hh * 8 + 6], acc[hh * 8 + 7]};
            *(f32x4*)op = x0 + ta * (pa * rstd * ga);
            *(f32x4*)(op + 4) = x1 + tb * (pb * rstd * gb);
        }
    }
}

extern "C" void kernel_launch(void* const* d_in, const int* in_sizes, int n_in, void* d_out, int out_size, void* d_ws, size_t ws_size, hipStream_t stream) {
    if (n_in != 16 || ws_size < WS_END) return;
    Params p{};
    p.x = (const float*)d_in[0]; p.c = (const float*)d_in[1]; p.ctx = (const float*)d_in[2]; p.c_ctx = (const float*)d_in[3];
    p.w_ada = (const float*)d_in[4]; p.b_ada = (const float*)d_in[5]; p.g_norm = (const float*)d_in[6]; p.w_in = (const float*)d_in[7];
    p.rel_bias = (const float*)d_in[8]; p.diff_lambda = (const float*)d_in[9]; p.diff_subln = (const float*)d_in[10]; p.w_out = (const float*)d_in[11];
    p.peer_wq = (const float*)d_in[12]; p.peer_keys = (const float*)d_in[13]; p.peer_u = (const float*)d_in[14]; p.peer_v = (const float*)d_in[15];
    p.out = (float*)d_out; p.ws = (unsigned char*)d_ws;
    unsigned char* ws = p.ws;
    k_transpose_bf16<<<(1024 / 32) * (3072 / 32), 256, 0, stream>>>(p.w_in, (bf16_t*)(ws + WS_WIN), 1024, 3072);
    k_transpose_bf16<<<(1024 / 32) * (1024 / 32), 256, 0, stream>>>(p.w_out, (bf16_t*)(ws + WS_WOUT), 1024, 1024);
    k_transpose_bf16<<<(1024 / 32) * (2048 / 32), 256, 0, stream>>>(p.peer_wq, (bf16_t*)(ws + WS_WPQ), 1024, 2048);
    k_cvt_bf16<<<2048, 256, 0, stream>>>(p.peer_keys, (bf16_t*)(ws + WS_KEYS), (size_t)8 * 2 * 128 * 128 / 4);
    k_cvt_bf16<<<4096, 256, 0, stream>>>(p.peer_u, (bf16_t*)(ws + WS_UB), (size_t)PE_NEXP * D / 4);
    k_cvt_bf16<<<4096, 256, 0, stream>>>(p.peer_v, (bf16_t*)(ws + WS_VB), (size_t)PE_NEXP * D / 4);
    k_mod_naive<<<NMOD / 256, 256, 0, stream>>>(p);
    k_misc<<<512, 256, 0, stream>>>(p);
    k_hrows<<<2048, 256, 0, stream>>>(p);
    k_gemm_naive<EpiQKV><<<(MALL / 64) * (NQKV / 64), 256, 0, stream>>>(p, (const bf16_t*)(ws + WS_H), (const bf16_t*)(ws + WS_WIN), MALL, NQKV, D, 0, EpiQKV{0, 0});
    k_na_naive<<<BATCH * 8 * SEQ / 4, 256, 0, stream>>>(p);
    (void)hipFuncSetAttribute((const void*)k_diff_naive, hipFuncAttributeMaxDynamicSharedMemorySize, 2 * 2 * 4352 * 4);
    k_diff_naive<<<BATCH * 4 * SEQ / 2, 256, 2 * 2 * 4352 * 4, stream>>>(p);
    k_gemm_naive<EpiPlain><<<(MLAT / 64) * (D / 64), 256, 0, stream>>>(p, (const bf16_t*)(ws + WS_Y), (const bf16_t*)(ws + WS_WOUT), MLAT, D, D, 0, EpiPlain{(bf16_t*)(ws + WS_YO), D, 0});
    k_rows2<<<2048, 256, 0, stream>>>(p);
    k_gemm_naive<EpiPlain><<<(MLAT / 64) * (2048 / 64), 256, 0, stream>>>(p, (const bf16_t*)(ws + WS_H2), (const bf16_t*)(ws + WS_WPQ), MLAT, 2048, D, 0, EpiPlain{(bf16_t*)(ws + WS_Q2), 2048, 0});
    k_topk_naive<<<MLAT, 256, 0, stream>>>(p);
    k_gather<<<2048, 256, 0, stream>>>(p);
}
```

```cpp
#include <hip/hip_runtime.h>
#include <stdint.h>
#include <math.h>

typedef unsigned short bf16_t;
typedef float f32x4 __attribute__((ext_vector_type(4)));
typedef unsigned u32x4 __attribute__((ext_vector_type(4)));
typedef unsigned u32x2 __attribute__((ext_vector_type(2)));
typedef float f32x2 __attribute__((ext_vector_type(2)));

constexpr int D = 1024, BATCH = 8, SEQ = 4096, CTX = 256, GW = 64;
constexpr int MLAT = BATCH * SEQ;
constexpr int MCTX = BATCH * CTX;
constexpr int MALL = MLAT + MCTX;
constexpr int NQKV = 3072;
constexpr int NKT = 68;
constexpr int NMOD = 6 * D;
constexpr int PE_H = 8, PE_NK = 128, PE_QD = 256, PE_TOPK = 16, PE_NEXP = 16384;
constexpr float EPS = 1e-6f;
constexpr float LOG2E = 1.4426950408889634f;
constexpr float C2 = 0.125f * LOG2E;
constexpr float LAMBDA_INIT = 0.2f;
constexpr float NEG_BIG = -30000.0f;

constexpr size_t MiB = 1u << 20;
constexpr size_t WS_CTL = 0;
constexpr size_t WS_MOD = 1 * MiB;
constexpr size_t WS_LAM = 1 * MiB + 256 * 1024;
constexpr size_t WS_ROPE = 1 * MiB + 512 * 1024;
constexpr size_t WS_USC = 1 * MiB + 640 * 1024;
constexpr size_t WS_VSC = 1 * MiB + 704 * 1024;
constexpr size_t WS_MODP = 2 * MiB;
constexpr size_t WS_BIAST = 4 * MiB;
constexpr size_t WS_KEYS = 5 * MiB;
constexpr size_t WS_KEYSI = 5 * MiB + 512 * 1024;
constexpr size_t WS_WIN = 6 * MiB;
constexpr size_t WS_WOUT = 12 * MiB;
constexpr size_t WS_WPQ = 14 * MiB;
constexpr size_t WS_UB = 18 * MiB;
constexpr size_t WS_VB = 50 * MiB;
constexpr size_t WS_EXP = 82 * MiB;
constexpr size_t WS_GATE = 98 * MiB;
constexpr size_t WS_H2 = 114 * MiB;
constexpr size_t WS_H = 178 * MiB;
constexpr size_t WS_Y = 178 * MiB;
constexpr size_t WS_QA = 246 * MiB;
constexpr size_t WS_KA = 278 * MiB;
constexpr size_t WS_VA = 312 * MiB;
constexpr size_t WS_QD = 346 * MiB;
constexpr size_t WS_KD = 378 * MiB;
constexpr size_t WS_VD = 412 * MiB;
constexpr size_t WS_YO = 246 * MiB;
constexpr size_t WS_Q2 = 246 * MiB;
constexpr size_t WS_SU = 446 * MiB;
constexpr size_t WS_END = 462 * MiB;

struct Params {
    const float *x, *c, *ctx, *c_ctx, *w_ada, *b_ada, *g_norm, *w_in, *rel_bias, *diff_lambda, *diff_subln, *w_out, *peer_wq, *peer_keys, *peer_u, *peer_v;
    float* out;
    unsigned char* ws;
};

__device__ __forceinline__ unsigned f2bf(float f) { unsigned u = __builtin_bit_cast(unsigned, f); return (u + 0x7fffu + ((u >> 16) & 1u)) >> 16; }
__device__ __forceinline__ unsigned pk2(float lo, float hi) { return f2bf(lo) | (f2bf(hi) << 16); }
__device__ __forceinline__ float bf2f(bf16_t h) { return __builtin_bit_cast(float, (unsigned)h << 16); }
__device__ __forceinline__ float bflo(unsigned w) { return __builtin_bit_cast(float, w << 16); }
__device__ __forceinline__ float bfhi(unsigned w) { return __builtin_bit_cast(float, w & 0xffff0000u); }
__device__ __forceinline__ float wave_sum(float v) {
#pragma unroll
    for (int o = 1; o < 64; o <<= 1) v += __shfl_xor(v, o);
    return v;
}
__device__ __forceinline__ float wave_max(float v) {
#pragma unroll
    for (int o = 1; o < 64; o <<= 1) v = fmaxf(v, __shfl_xor(v, o));
    return v;
}

__device__ __forceinline__ int ktile_off(int k, int d) { return (d >> 3) * 512 + k * 8 + (d & 7); }
__device__ __forceinline__ int vtile_off(int k, int d) { return (d >> 5) * 2048 + (k >> 4) * 512 + (k & 15) * 32 + (d & 31); }
__device__ __forceinline__ size_t qa_idx(int b, int h, int t, int d) { return ((size_t)(b * 8 + h) * SEQ + t) * 64 + d; }
__device__ __forceinline__ size_t ka_idx(int b, int h, int j, int d) { return ((size_t)(b * 8 + h) * NKT + (j >> 6)) * 4096 + ktile_off(j & 63, d); }
__device__ __forceinline__ size_t va_idx(int b, int h, int j, int d) { return ((size_t)(b * 8 + h) * NKT + (j >> 6)) * 4096 + vtile_off(j & 63, d); }
__device__ __forceinline__ size_t qd_idx(int b, int m, int h, int t, int d) { return ((size_t)((b * 2 + m) * 4 + h) * SEQ + t) * 64 + d; }
__device__ __forceinline__ size_t kd_idx(int b, int m, int h, int j, int d) { return ((size_t)((b * 2 + m) * 4 + h) * NKT + (j >> 6)) * 4096 + ktile_off(j & 63, d); }
__device__ __forceinline__ size_t vd_idx(int b, int h, int j, int d) { return ((size_t)(b * 4 + h) * NKT + (j >> 6)) * 8192 + vtile_off(j & 63, d); }


namespace pg8 {
#define PG8_LAS __attribute__((address_space(3)))
typedef unsigned short bf16_t;
typedef short bf16x8 __attribute__((ext_vector_type(8)));
typedef float f32x4 __attribute__((ext_vector_type(4)));
typedef unsigned u32x4 __attribute__((ext_vector_type(4)));
constexpr int BM = 256, BK = 64, HALF = 128, HTB = HALF * BK * 2  , STAGE_BYTES = 8 * HTB, NXCD = 8, WGM = 8;

__host__ __device__ __forceinline__ int lds_byte(int r, int c) { const int st = (r >> 4) * 2 + (c >> 5), rr = r & 15, cc = c & 31, ob = rr * 64 + cc * 2; return st * 1024 + (ob ^ (((ob >> 9) & 1) << 5)); }
__host__ __device__ __forceinline__ void stage_rc(int b, int& R, int& C) { const int st = b / 1024, sb = b % 1024, swz = sb ^ (((sb >> 9) & 1) << 5); R = (st >> 1) * 16 + swz / 64; C = (st & 1) * 32 + (swz % 64) / 2; }
__host__ __device__ __forceinline__ int perm32(int rho) { const int n = rho >> 4, i = rho & 15; return 8 * (i >> 2) + 4 * n + (i & 3); }

struct Unit { int pm, pn; };
struct Gemm { const bf16_t* A; const bf16_t* Bt; int M, N, K; };

struct StaticOrder {
    int nM, nN, nwg, G, c;
    __host__ __device__ void init(int M, int N, int G_, int c_) { nM = M / BM; nN = N / BM; nwg = nM * nN; G = G_; c = c_; }
    __host__ __device__ bool next(int i, Unit& u) const {
        const long L = (long)i * G + c; if (L >= nwg) return false;
        int wgid = (int)L; { const int q = nwg / NXCD, r = nwg % NXCD, xcd = wgid % NXCD, off = wgid / NXCD; wgid = (xcd < r ? xcd * (q + 1) : r * (q + 1) + (xcd - r) * q) + off; }
        const int nig = WGM * nN, gid = wgid / nig, fm = gid * WGM, gsz = (nM - fm) < WGM ? (nM - fm) : WGM;
        u.pm = fm + ((wgid % nig) % gsz); u.pn = (wgid % nig) / gsz; return true;
    }
    __device__ __forceinline__ void a_ready(const Unit&) const {}
    __device__ __forceinline__ void done(const Unit&) const {}
};

__device__ __forceinline__ unsigned cvt_pk_bf16(float lo, float hi) { unsigned r; asm volatile("v_cvt_pk_bf16_f32 %0, %1, %2" : "=v"(r) : "v"(lo), "v"(hi)); return r; }
typedef float f32x2 __attribute__((ext_vector_type(2)));
__device__ __forceinline__ f32x2 gelu_pk(f32x2 v) {
    const f32x2 av = __builtin_elementwise_abs(v), d = av * 0.2316418882f + 1.0f;
    f32x2 t; t.x = __builtin_amdgcn_rcpf(d.x); t.y = __builtin_amdgcn_rcpf(d.y);
    f32x2 q = t * 0.5307027145f + (-0.7265760135f); q = q * t + 0.7107068705f; q = q * t + (-0.142248368f); q = q * t + 0.127414796f; q = q * t;
    const f32x2 s = (v * v) * (-0.72134752044f);
    f32x2 e; e.x = __builtin_amdgcn_exp2f(s.x); e.y = __builtin_amdgcn_exp2f(s.y);
    const f32x2 m = v * (q * e), r = v - m;
    f32x2 o; o.x = v.x < 0.f ? m.x : r.x; o.y = v.y < 0.f ? m.y : r.y; return o;
}

template <int ACT  > struct EpiBf16 {
    static constexpr bool PERM = true, AFTER_DRAIN = false; static_assert(ACT == 0 || ACT == 1, "EpiBf16: ACT is 0 (none) or 1 (gelu_pk)");
    bf16_t* O; int ldc; const float* bias; int split_cols; size_t split_stride; float scale0;
    __device__ __forceinline__ void operator()(const f32x4 (&acc)[2][2][4][2], const Unit& u, int wr, int wc, int fr, int fq) const {
        const int row0 = u.pm * BM + wr * 64 + fr; int colt = u.pn * BM; bf16_t* base = O;
        float sc = 1.f; if (split_cols) { const int t = colt / split_cols; base += (size_t)t * split_stride; colt -= t * split_cols; if (t == 0) sc = scale0; }
        const int col0 = colt + wc * 32 + 8 * fq, bcol0 = u.pn * BM + wc * 32 + 8 * fq;
        f32x4 bv[2][2];
#pragma unroll
        for (int bj = 0; bj < 2; ++bj)
#pragma unroll
            for (int n = 0; n < 2; ++n) bv[bj][n] = bias ? *(const f32x4*)(bias + bcol0 + bj * HALF + 4 * n) : (f32x4){0.f, 0.f, 0.f, 0.f};
#pragma unroll
        for (int ai = 0; ai < 2; ++ai)
#pragma unroll
            for (int m = 0; m < 4; ++m) { bf16_t* rowp = base + (size_t)(row0 + ai * HALF + m * 16) * ldc + col0;
#pragma unroll
                for (int bj = 0; bj < 2; ++bj) { f32x4 v0 = acc[ai][bj][m][0] + bv[bj][0], v1 = acc[ai][bj][m][1] + bv[bj][1];
                    if (ACT == 1) { f32x2 a = gelu_pk((f32x2){v0[0], v0[1]}), b = gelu_pk((f32x2){v0[2], v0[3]}), c = gelu_pk((f32x2){v1[0], v1[1]}), d = gelu_pk((f32x2){v1[2], v1[3]});
                        v0 = (f32x4){a.x, a.y, b.x, b.y}; v1 = (f32x4){c.x, c.y, d.x, d.y}; }
                    v0 = v0 * sc; v1 = v1 * sc; u32x4 w; w.x = cvt_pk_bf16(v0[0], v0[1]); w.y = cvt_pk_bf16(v0[2], v0[3]); w.z = cvt_pk_bf16(v1[0], v1[1]); w.w = cvt_pk_bf16(v1[2], v1[3]);
                    *(u32x4*)(rowp + bj * HALF) = w; } }
    }
};

template <class Epi, class Sched, bool ALIGN_EPI = false, bool SP2 = false>
__device__ __forceinline__ void gemm_phase(PG8_LAS unsigned char* lds, const Gemm g, const Sched& S, const Epi& E) {
    const int tid = threadIdx.x, wid = __builtin_amdgcn_readfirstlane(tid >> 6), lane = tid & 63, wr = wid >> 2, wc = wid & 3, fr = lane & 15, fq = lane >> 4;
    const int K = g.K, nt = K / BK;
    unsigned voffA[2], voffB[2];
#pragma unroll
    for (int i = 0; i < 2; ++i) { int R, C; stage_rc(tid * 16 + i * 8192, R, C); const int Rb = Epi::PERM ? ((R & ~31) + perm32(R & 31)) : R;
        voffA[i] = (unsigned)(R * K + C) * 2u; voffB[i] = (unsigned)(Rb * K + C) * 2u; }
    const size_t kstep = (size_t)(BK * 2);
    const size_t hstep = (size_t)HALF * K * 2;
    const size_t tstep = 2 * hstep;
    const unsigned ldsw = (unsigned)wid * 1024u;
    const int aoff = lds_byte(wr * 64 + fr, fq * 8), boff = lds_byte(wc * 32 + fr, fq * 8);
#define PG8_SA(b, h) (((b) * 2 + (h)) * HTB)
#define PG8_SB(b, h) ((4 + (b) * 2 + (h)) * HTB)
#define PG8_STAGE(bufoff, gbase, voff) do { _Pragma("unroll") for (int _i = 0; _i < 2; ++_i) \
        __builtin_amdgcn_global_load_lds((const unsigned*)((const char*)(gbase) + (voff)[_i]), (PG8_LAS unsigned*)(lds + (bufoff) + ldsw + _i * 8192), 16, 0, 0); } while (0)
#define PG8_LDA(dst, b, h) do { _Pragma("unroll") for (int m = 0; m < 4; ++m) _Pragma("unroll") for (int k = 0; k < 2; ++k) dst[m][k] = *(const PG8_LAS bf16x8*)(lds + PG8_SA(b, h) + aoff + m * 2048 + k * 1024); } while (0)
#define PG8_LDB(dst, b, h) do { _Pragma("unroll") for (int n = 0; n < 2; ++n) _Pragma("unroll") for (int k = 0; k < 2; ++k) dst[n][k] = *(const PG8_LAS bf16x8*)(lds + PG8_SB(b, h) + boff + n * 2048 + k * 1024); } while (0)
#define PG8_MMA(ai, bj, At, Bt) do { __builtin_amdgcn_s_setprio(1); _Pragma("unroll") for (int m = 0; m < 4; ++m) _Pragma("unroll") for (int n = 0; n < 2; ++n) _Pragma("unroll") for (int k = 0; k < 2; ++k) \
        acc[ai][bj][m][n] = __builtin_amdgcn_mfma_f32_16x16x32_bf16(Bt[n][k], At[m][k], acc[ai][bj][m][n], 0, 0, 0); __builtin_amdgcn_s_setprio(0); } while (0)
#define PG8_WAIT_V(n) asm volatile("s_waitcnt vmcnt(" #n ")" ::: "memory")
#define PG8_WAIT_L(n) asm volatile("s_waitcnt lgkmcnt(" #n ")" ::: "memory")
#define PG8_BAR __builtin_amdgcn_s_barrier()
#define PG8_SCHED __builtin_amdgcn_sched_barrier(0)
    Unit cur, nxt; int ui = 0;
    if (!S.next(0, cur)) return;
    f32x4 acc[2][2][4][2];
#pragma unroll
    for (int a = 0; a < 2; ++a)
#pragma unroll
        for (int b = 0; b < 2; ++b)
#pragma unroll
            for (int m = 0; m < 4; ++m)
#pragma unroll
                for (int n = 0; n < 2; ++n) acc[a][b][m][n] = (f32x4){0.f, 0.f, 0.f, 0.f};
    bf16x8 At[4][2], B0[2][2], B1[2][2];
    const char* cA = (const char*)g.A + (size_t)cur.pm * tstep; const char* cB = (const char*)g.Bt + (size_t)cur.pn * tstep;
    S.a_ready(cur);
    if constexpr (SP2) {
        PG8_STAGE(PG8_SB(0, 0), cB, voffB); PG8_STAGE(PG8_SB(0, 1), cB + hstep, voffB); PG8_STAGE(PG8_SA(0, 0), cA, voffA); PG8_STAGE(PG8_SA(0, 1), cA + hstep, voffA);
        if (wr == 1) PG8_BAR;
        PG8_WAIT_V(2); PG8_BAR;
        PG8_STAGE(PG8_SB(1, 0), cB + kstep, voffB); PG8_STAGE(PG8_SA(1, 0), cA + kstep, voffA); PG8_STAGE(PG8_SB(1, 1), cB + hstep + kstep, voffB);
        PG8_WAIT_V(6); PG8_BAR;
    } else {
        PG8_STAGE(PG8_SB(0, 0), cB, voffB); PG8_STAGE(PG8_SA(0, 0), cA, voffA); PG8_STAGE(PG8_SB(0, 1), cB + hstep, voffB); PG8_STAGE(PG8_SA(0, 1), cA + hstep, voffA);
        if (wr == 1) PG8_BAR;
        PG8_WAIT_V(4); PG8_BAR;
        PG8_STAGE(PG8_SB(1, 0), cB + kstep, voffB); PG8_STAGE(PG8_SA(1, 0), cA + kstep, voffA); PG8_STAGE(PG8_SB(1, 1), cB + hstep + kstep, voffB);
        PG8_WAIT_V(6); PG8_BAR;
    }
    for (;;) {
        const bool has_next = S.next(ui + 1, nxt);
        const char* nA = has_next ? (const char*)g.A + (size_t)nxt.pm * tstep : cA; const char* nB = has_next ? (const char*)g.Bt + (size_t)nxt.pn * tstep : cB;
        for (int t = 0; t < nt; t += 2) {
            const bool last = (t == nt - 2);
            const char* a1 = cA + (size_t)(t + 1) * kstep;
            const char* a2 = last ? nA : cA + (size_t)(t + 2) * kstep; const char* b2 = last ? nB : cB + (size_t)(t + 2) * kstep;
            const char* a3 = a2 + kstep; const char* b3 = b2 + kstep;
            if (last && has_next) S.a_ready(nxt);
            if constexpr (SP2) {
            PG8_LDB(B0, 0, 0); PG8_LDB(B1, 0, 1); PG8_SCHED; PG8_LDA(At, 0, 0); PG8_STAGE(PG8_SA(1, 1), a1 + hstep, voffA);
            PG8_WAIT_V(8); PG8_WAIT_L(0); PG8_BAR; PG8_MMA(0, 0, At, B0); PG8_MMA(0, 1, At, B1); PG8_BAR; PG8_SCHED;
            PG8_LDA(At, 0, 1); PG8_STAGE(PG8_SB(0, 0), b2, voffB); PG8_STAGE(PG8_SB(0, 1), b2 + hstep, voffB); PG8_STAGE(PG8_SA(0, 0), a2, voffA);
            PG8_WAIT_V(8); PG8_WAIT_L(0); PG8_BAR; PG8_MMA(1, 0, At, B0); PG8_MMA(1, 1, At, B1); PG8_BAR; PG8_SCHED;
            PG8_LDB(B0, 1, 0); PG8_LDB(B1, 1, 1); PG8_SCHED; PG8_LDA(At, 1, 0); PG8_STAGE(PG8_SA(0, 1), a2 + hstep, voffA);
            PG8_WAIT_V(8); PG8_WAIT_L(0); PG8_BAR; PG8_MMA(0, 0, At, B0); PG8_MMA(0, 1, At, B1); PG8_BAR; PG8_SCHED;
            PG8_LDA(At, 1, 1); PG8_STAGE(PG8_SB(1, 0), b3, voffB); PG8_STAGE(PG8_SB(1, 1), b3 + hstep, voffB); PG8_STAGE(PG8_SA(1, 0), a3, voffA);
            PG8_WAIT_V(8); PG8_WAIT_L(0); PG8_BAR; PG8_MMA(1, 0, At, B0); PG8_MMA(1, 1, At, B1); PG8_BAR; PG8_SCHED;
            } else {
            PG8_LDB(B0, 0, 0); PG8_SCHED; PG8_LDA(At, 0, 0); PG8_STAGE(PG8_SA(1, 1), a1 + hstep, voffA);
            PG8_WAIT_L(8); PG8_BAR; PG8_WAIT_L(0); PG8_MMA(0, 0, At, B0); PG8_BAR; PG8_SCHED;
            PG8_LDB(B1, 0, 1); PG8_STAGE(PG8_SB(0, 0), b2, voffB);
            PG8_BAR; PG8_WAIT_L(0); PG8_MMA(0, 1, At, B1); PG8_BAR;
            PG8_LDA(At, 0, 1); PG8_STAGE(PG8_SA(0, 0), a2, voffA);
            PG8_BAR; PG8_WAIT_L(0); PG8_MMA(1, 0, At, B0); PG8_BAR; PG8_SCHED;
            PG8_STAGE(PG8_SB(0, 1), b2 + hstep, voffB);
            PG8_WAIT_V(6); PG8_BAR; PG8_MMA(1, 1, At, B1); PG8_BAR;
            PG8_LDB(B0, 1, 0); PG8_SCHED; PG8_LDA(At, 1, 0); PG8_STAGE(PG8_SA(0, 1), a2 + hstep, voffA);
            PG8_WAIT_L(8); PG8_BAR; PG8_WAIT_L(0); PG8_MMA(0, 0, At, B0); PG8_BAR; PG8_SCHED;
            PG8_LDB(B1, 1, 1); PG8_STAGE(PG8_SB(1, 0), b3, voffB);
            PG8_BAR; PG8_WAIT_L(0); PG8_MMA(0, 1, At, B1); PG8_BAR;
            PG8_LDA(At, 1, 1); PG8_STAGE(PG8_SA(1, 0), a3, voffA);
            PG8_BAR; PG8_WAIT_L(0); PG8_MMA(1, 0, At, B0); PG8_BAR; PG8_SCHED;
            PG8_STAGE(PG8_SB(1, 1), b3 + hstep, voffB);
            PG8_WAIT_V(6); PG8_BAR; PG8_MMA(1, 1, At, B1); PG8_BAR;
            }
        }
        if constexpr (ALIGN_EPI) { if (wr == 0) PG8_BAR; }
        if constexpr (!Epi::AFTER_DRAIN) { E(acc, cur, wr, wc, fr, fq); S.done(cur); }
        if (!has_next) break;
#pragma unroll
        for (int a = 0; a < 2; ++a)
#pragma unroll
            for (int b = 0; b < 2; ++b)
#pragma unroll
                for (int m = 0; m < 4; ++m)
#pragma unroll
                    for (int n = 0; n < 2; ++n) acc[a][b][m][n] = (f32x4){0.f, 0.f, 0.f, 0.f};
        cur = nxt; cA = nA; cB = nB; ++ui;
        if constexpr (ALIGN_EPI) { if (wr == 1) PG8_BAR; }
    }
    PG8_WAIT_V(0);
    if constexpr (!ALIGN_EPI) { if (wr == 0) PG8_BAR; }
    PG8_BAR;
    if constexpr (Epi::AFTER_DRAIN) { E.fused(acc, cur, wr, wc, fr, fq, lds, wid, lane); S.done(cur); }
#undef PG8_SA
#undef PG8_SB
#undef PG8_STAGE
#undef PG8_LDA
#undef PG8_LDB
#undef PG8_MMA
#undef PG8_WAIT_V
#undef PG8_WAIT_L
#undef PG8_BAR
#undef PG8_SCHED
}
}

#define GAS __attribute__((address_space(1)))
#define LAS __attribute__((address_space(3)))
typedef unsigned v4u __attribute__((ext_vector_type(4)));
typedef float f32x4 __attribute__((ext_vector_type(4)));
typedef short bf16x8 __attribute__((ext_vector_type(8)));
typedef GAS unsigned gu32;
typedef GAS unsigned long long gu64;
#define RLX_AGENT __ATOMIC_RELAXED, __HIP_MEMORY_SCOPE_AGENT
#define LDS_WAIT() asm volatile("s_waitcnt lgkmcnt(0)" ::: "memory")
#define VM_WAIT() asm volatile("s_waitcnt vmcnt(0)" ::: "memory")
__device__ __forceinline__ unsigned long long rt() { return __builtin_amdgcn_s_memrealtime(); }

#define XB_TMO      128
#define XB_XCNT(j)  (256  + 64 * (j))
#define XB_XSUB(j)  (1280 + 64 * (j))
#define XB_XGEN(j)  (2304 + 64 * (j))
#define XB_TOP      3328
#define XB_TOPGEN   3392
#define XCD_BAR_WORDS 3456
#define XB_SPIN_CAP (1u << 18)

__device__ __forceinline__ unsigned xb_ld(unsigned* p)              { return __hip_atomic_load(p, __ATOMIC_RELAXED, __HIP_MEMORY_SCOPE_AGENT); }
__device__ __forceinline__ unsigned xb_add(unsigned* p, unsigned v) { return __hip_atomic_fetch_add(p, v, __ATOMIC_RELAXED, __HIP_MEMORY_SCOPE_AGENT); }
__device__ __forceinline__ unsigned xb_xcc_id() { return (unsigned)__builtin_amdgcn_s_getreg((3 << 11) | 20) & 0xFu; }
#define XB_SPIN(cond, bar) do { unsigned _sp = 0; while (cond) { __builtin_amdgcn_s_sleep(1); \
    if ((++_sp & 255u) == 0u) { if (xb_ld(&(bar)[XB_TMO])) break; if (_sp > XB_SPIN_CAP) { atomicAdd(&(bar)[XB_TMO], 1u); break; } } } } while (0)

struct XcdBarrier {
    unsigned* bar; unsigned x;
    volatile LAS unsigned* st;
};

__device__ __forceinline__ XcdBarrier xcd_barrier_post(unsigned* bar, volatile LAS unsigned* st) {
    XcdBarrier b; b.bar = bar; b.x = xb_xcc_id(); b.st = st;
    if (threadIdx.x == 0) (void)xb_add(&bar[XB_XCNT(b.x)], 1u);
    return b;
}
__device__ __forceinline__ void xcd_barrier_complete(unsigned* bar, unsigned x, unsigned& nloc, unsigned& nx) {
    const unsigned G = gridDim.x * gridDim.y * gridDim.z;
    unsigned sum, cnt, mine, sp = 0u;
    for (;;) {
        sum = 0u; cnt = 0u; mine = 0u;
#pragma unroll
        for (unsigned j = 0; j < 16; ++j) { const unsigned c = xb_ld(&bar[XB_XCNT(j)]); sum += c; cnt += (c > 0u) ? 1u : 0u; mine = (j == x) ? c : mine; }
        if (sum == G) break;
        __builtin_amdgcn_s_sleep(1);
        if ((++sp & 255u) == 0u) { if (xb_ld(&bar[XB_TMO])) break; if (sp > XB_SPIN_CAP) { atomicAdd(&bar[XB_TMO], 1u); break; } }
    }
    nloc = mine > 0u ? mine : 1u; nx = cnt > 0u ? cnt : 1u;
}

__device__ __forceinline__ void xcd_barrier(const XcdBarrier& b) {
    asm volatile("s_waitcnt vmcnt(0)" ::: "memory");
    __syncthreads();
    if (threadIdx.x == 0) {
        unsigned* bar = b.bar;
        __builtin_amdgcn_s_waitcnt(0);
        unsigned nloc = b.st[0], nx = b.st[1];
        if (nloc == 0u) { xcd_barrier_complete(bar, b.x, nloc, nx); b.st[0] = nloc; b.st[1] = nx; }
        const unsigned old = xb_add(&bar[XB_XSUB(b.x)], 1u);
        const unsigned gen = old / nloc;
        if (old + 1u == (gen + 1u) * nloc) {
            __builtin_amdgcn_fence(__ATOMIC_RELEASE, "agent");
            asm volatile("s_waitcnt vmcnt(0)" ::: "memory");
            const unsigned og = xb_add(&bar[XB_TOP], 1u);
            const unsigned tg = og / nx;
            if (og + 1u == (tg + 1u) * nx) xb_add(&bar[XB_TOPGEN], 1u);
            else XB_SPIN(xb_ld(&bar[XB_TOPGEN]) == tg, bar);
            __builtin_amdgcn_fence(__ATOMIC_ACQUIRE, "agent");
            xb_add(&bar[XB_XGEN(b.x)], 1u);
            asm volatile("s_waitcnt vmcnt(0)" ::: "memory");
        } else {
            XB_SPIN(xb_ld(&bar[XB_XGEN(b.x)]) == gen, bar);
            __builtin_amdgcn_fence(__ATOMIC_ACQUIRE, "agent");
            asm volatile("s_waitcnt vmcnt(0)" ::: "memory");
        }
    }
    __syncthreads();
}

constexpr int NWAVES = 8, NTHR = 512;
constexpr int RING_OFF = 0, RING_BYTES = 131072;
constexpr int LDS_BYTES = 159744;
constexpr int MISC_OFF = LDS_BYTES - 512;
constexpr size_t CTL_ZERO_BYTES = 65536;
constexpr int CW_BAR = 4096;

struct Frame {
    LAS unsigned char* lds;
    volatile LAS unsigned* MISC;
    int tid, lane, wave, G, bid;
};

__device__ __forceinline__ void p0_transpose_item(const float* W, int K, int N, bf16_t* WT, LAS float* scr, int item, int lane) {
    const int nblk = N / 32, kb = item / nblk, nb = item % nblk, k0 = 64 * kb, n0 = 32 * nb;
#pragma unroll 8
    for (int i = 0; i < 32; ++i) { const int kk = 2 * i + (lane >> 5); scr[kk * 33 + (lane & 31)] = W[(size_t)(k0 + kk) * N + n0 + (lane & 31)]; }
    LDS_WAIT(); asm volatile("" ::: "memory");
    const int c = lane & 7;
#pragma unroll
    for (int j = 0; j < 4; ++j) { const int n = (lane >> 3) + 8 * j; const LAS float* s = scr + (8 * c) * 33 + n;
        v4u o; o.x = pk2(s[0 * 33], s[1 * 33]); o.y = pk2(s[2 * 33], s[3 * 33]); o.z = pk2(s[4 * 33], s[5 * 33]); o.w = pk2(s[6 * 33], s[7 * 33]);
        *(GAS v4u*)(WT + (size_t)(n0 + n) * K + k0 + 8 * c) = o; }
    LDS_WAIT(); asm volatile("" ::: "memory");
}
__device__ __forceinline__ void cvt_stream(const float* src, bf16_t* dst, size_t n4, size_t gtid, size_t gsz) {
    for (size_t i = gtid; i < n4; i += gsz) { const f32x4 v = ((const f32x4*)src)[i]; u32x2 o; o.x = pk2(v.x, v.y); o.y = pk2(v.z, v.w); ((u32x2*)dst)[i] = o; }
}
__device__ __forceinline__ void p0_prologue(Frame& F, const Params& p) {
    unsigned char* ws = p.ws;
    for (int item = F.bid; item < 192; item += F.G) {
        LAS float* sil = (LAS float*)(F.lds);
        LAS float* red = (LAS float*)(F.lds + 8192);
        const int ks = item / 24, cc = item % 24;
        for (int i = F.tid; i < 9 * 128; i += NTHR) { const int r = i >> 7, k = ks * 128 + (i & 127); const float v = r < 8 ? p.c[r * 1024 + k] : p.c_ctx[k]; sil[i] = v / (1.f + __expf(-v)); }
        __syncthreads();
        f32x4 acc[9];
#pragma unroll
        for (int r = 0; r < 9; ++r) acc[r] = (f32x4){0.f, 0.f, 0.f, 0.f};
        const float* wp = p.w_ada + (size_t)(ks * 128 + F.wave * 16) * NMOD + cc * 256 + F.lane * 4;
#pragma unroll 4
        for (int kk = 0; kk < 16; ++kk) { const f32x4 w = *(const f32x4*)(wp + (size_t)kk * NMOD);
#pragma unroll
            for (int r = 0; r < 9; ++r) acc[r] += w * sil[r * 128 + F.wave * 16 + kk]; }
#pragma unroll
        for (int r = 0; r < 9; ++r) *(LAS f32x4*)(red + ((F.wave * 9 + r) * 256 + F.lane * 4)) = acc[r];
        __syncthreads();
        float* modp = (float*)(ws + WS_MODP);
        for (int i = F.tid; i < 9 * 256; i += NTHR) { const int r = i >> 8, c = i & 255; float s = 0.f;
#pragma unroll
            for (int w = 0; w < 8; ++w) s += red[(w * 9 + r) * 256 + c];
            modp[(size_t)(ks * 9 + r) * NMOD + cc * 256 + c] = s; }
        __syncthreads();
    }
    {
        LAS float* scr = (LAS float*)(F.lds + F.wave * 16384);
        const int gw = F.bid * NWAVES + F.wave, NGW = F.G * NWAVES;
        constexpr int I_IN = 16 * 96, I_OUT = 16 * 32, I_PQ = 16 * 64;
        for (int it = gw; it < I_IN + I_OUT + I_PQ; it += NGW) {
            int r = it;
            if (r < I_IN) { p0_transpose_item(p.w_in, D, NQKV, (bf16_t*)(ws + WS_WIN), scr, r, F.lane); continue; } r -= I_IN;
            if (r < I_OUT) { p0_transpose_item(p.w_out, D, D, (bf16_t*)(ws + WS_WOUT), scr, r, F.lane); continue; } r -= I_OUT;
            p0_transpose_item(p.peer_wq, D, 2048, (bf16_t*)(ws + WS_WPQ), scr, r, F.lane);
        }
    }
    const size_t gtid = (size_t)F.bid * NTHR + F.tid, gsz = (size_t)F.G * NTHR;
    cvt_stream(p.peer_keys, (bf16_t*)(ws + WS_KEYS), (size_t)8 * 2 * 128 * 128 / 4, gtid, gsz);
    { bf16_t* ki = (bf16_t*)(ws + WS_KEYSI);
      for (int i = (int)gtid; i < 8 * 2 * 16 * 128; i += (int)gsz) { const int key = i & 127, c = (i >> 7) & 15, hp = i >> 11;
          const float* sp = p.peer_keys + ((size_t)hp * 128 + key) * 128 + c * 8; const f32x4 a = *(const f32x4*)sp, b = *(const f32x4*)(sp + 4);
          u32x4 o; o.x = pk2(a.x, a.y); o.y = pk2(a.z, a.w); o.z = pk2(b.x, b.y); o.w = pk2(b.z, b.w); *(u32x4*)(ki + (size_t)i * 8) = o; } }
    {
        const int gw = F.bid * NWAVES + F.wave, NGW = F.G * NWAVES;
        for (int rr0 = gw * 2; rr0 < 2 * PE_NEXP; rr0 += NGW * 2) {
            f32x4 v[2][4]; float am[2];
#pragma unroll
            for (int q = 0; q < 2; ++q) { const int rr = rr0 + q, tbl = rr >= PE_NEXP, row = rr - tbl * PE_NEXP; const float* src = (tbl ? p.peer_v : p.peer_u) + (size_t)row * D;
#pragma unroll
                for (int j = 0; j < 4; ++j) v[q][j] = ((const f32x4*)src)[F.lane + 64 * j]; }
#pragma unroll
            for (int q = 0; q < 2; ++q) { float a = 0.f;
#pragma unroll
                for (int j = 0; j < 4; ++j) a = fmaxf(a, fmaxf(fmaxf(fabsf(v[q][j].x), fabsf(v[q][j].y)), fmaxf(fabsf(v[q][j].z), fabsf(v[q][j].w))));
                am[q] = wave_max(a); }
#pragma unroll
            for (int q = 0; q < 2; ++q) { const int rr = rr0 + q, tbl = rr >= PE_NEXP, row = rr - tbl * PE_NEXP;
                int e = am[q] > 0.f ? (int)floorf(log2f(240.f / am[q])) : 0; e = e < -100 ? -100 : (e > 100 ? 100 : e);
                const float sc = ldexpf(1.f, e);
                u32x4 o;
#pragma unroll
                for (int j = 0; j < 4; ++j) { int w = __builtin_amdgcn_cvt_pk_fp8_f32(v[q][j].x * sc, v[q][j].y * sc, 0, false); w = __builtin_amdgcn_cvt_pk_fp8_f32(v[q][j].z * sc, v[q][j].w * sc, w, true); o[j] = (unsigned)w; }
                *(u32x4*)(ws + (tbl ? WS_VB : WS_UB) + (size_t)row * 1024 + F.lane * 16) = o;
                if (F.lane == 0) ((float*)(ws + (tbl ? WS_VSC : WS_USC)))[row] = ldexpf(1.f, -e); }
        }
    }
    if (gtid == 0) {
        float s01 = 0.f, s23 = 0.f;
        for (int i = 0; i < 64; ++i) { s01 += p.diff_lambda[i] * p.diff_lambda[64 + i]; s23 += p.diff_lambda[128 + i] * p.diff_lambda[192 + i]; }
        *(float*)(ws + WS_LAM) = expf(s01) - expf(s23) + LAMBDA_INIT;
    }
    float* rope = (float*)(ws + WS_ROPE);
    for (int i = (int)gtid; i < 64 * 16; i += (int)gsz) { const int pos = i >> 4, f = i & 15; const float inv = exp2f(-(float)f * (13.287712379549449f / 16.f)); const float a = (float)pos * inv; rope[2 * i] = cosf(a); rope[2 * i + 1] = sinf(a); }
    bf16_t* bt = (bf16_t*)(ws + WS_BIAST);
    for (int i = (int)gtid; i < 8 * 15 * 4096; i += (int)gsz) {
        const int j = i & 7, kc = (i >> 3) & 63, cq = (i >> 9) & 7, hd = i >> 12, dr = hd % 15, h = hd / 15;
        const int cp = cq * 8 + j; int cs = cp - 8; cs = cs < 0 ? 0 : (cs > 48 ? 48 : cs);
        float v = NEG_BIG;
        if (kc >= cs && kc < cs + 16) v = p.rel_bias[(h * 15 + dr) * 31 + (kc - cp + 15)] * LOG2E;
        bt[i] = (bf16_t)f2bf(v);
    }
}

__device__ __forceinline__ void p1_hrows(Frame& F, const Params& p) {
    unsigned char* ws = p.ws;
    const float* modp = (const float*)(ws + WS_MODP);
    float* mod = (float*)(ws + WS_MOD);
    for (int i = F.bid * NTHR + F.tid; i < 9 * NMOD; i += F.G * NTHR) { float s = p.b_ada[i % NMOD];
#pragma unroll
        for (int ks = 0; ks < 8; ++ks) s += modp[(size_t)ks * 9 * NMOD + i];
        mod[i] = s; }
    const int rows_per = (MALL + F.G - 1) / F.G, r0 = F.bid * rows_per, r1 = min(MALL, r0 + rows_per);
    if (r0 >= r1) return;
    const int mr_lo = r0 < MLAT ? (r0 >> 12) : 8;
    LAS float* tab = (LAS float*)F.lds;
    for (int i = F.tid; i < 2 * 2048; i += NTHR) {
        const int which = i >> 11, ss = (i >> 10) & 1, col = i & 1023; const int mr = min(8, mr_lo + which);
        const int mi = mr * NMOD + (ss == 0 ? D : 0) + col;
        float s = p.b_ada[(ss == 0 ? D : 0) + col];
#pragma unroll
        for (int ks = 0; ks < 8; ++ks) s += modp[(size_t)ks * 9 * NMOD + mi];
        tab[i] = ss == 0 ? p.g_norm[col] * (1.f + s) : s;
    }
    __syncthreads();
    bf16_t* H = (bf16_t*)(ws + WS_H);
    f32x4 nx[2][4];
#define P1_LOAD(dst, rowa_) do { _Pragma("unroll") for (int q = 0; q < 2; ++q) { const int row = min((rowa_) + q * NWAVES, MALL - 1); \
            const float* xr = row < MLAT ? p.x + (size_t)row * D : p.ctx + (size_t)(row - MLAT) * D; \
            _Pragma("unroll") for (int j = 0; j < 4; ++j) dst[q][j] = ((const f32x4*)xr)[F.lane + 64 * j]; } } while (0)
    P1_LOAD(nx, r0 + F.wave);
    for (int rowa = r0 + F.wave; rowa < r1; rowa += 2 * NWAVES) {
        f32x4 v[2][4]; float ssq[2];
#pragma unroll
        for (int q = 0; q < 2; ++q)
#pragma unroll
            for (int j = 0; j < 4; ++j) v[q][j] = nx[q][j];
        if (rowa + 2 * NWAVES < r1) P1_LOAD(nx, rowa + 2 * NWAVES);
#pragma unroll
        for (int q = 0; q < 2; ++q) { float s = 0.f;
#pragma unroll
            for (int j = 0; j < 4; ++j) s += v[q][j].x * v[q][j].x + v[q][j].y * v[q][j].y + v[q][j].z * v[q][j].z + v[q][j].w * v[q][j].w;
            ssq[q] = wave_sum(s); }
#pragma unroll
        for (int q = 0; q < 2; ++q) { const int row = rowa + q * NWAVES; if (row < r1) {
            const int mr = row < MLAT ? (row >> 12) : 8; const LAS float* tb = tab + (mr - mr_lo) * 2048;
            const float rstd = rsqrtf(ssq[q] * (1.f / D) + EPS);
#pragma unroll
            for (int j = 0; j < 4; ++j) { const int col = (F.lane + 64 * j) * 4;
                const f32x4 sc = *(const LAS f32x4*)(tb + col), sh = *(const LAS f32x4*)(tb + 1024 + col);
                const f32x4 y = (v[q][j] * rstd) * sc + sh;
                u32x2 o; o.x = pk2(y.x, y.y); o.y = pk2(y.z, y.w);
                *(u32x2*)(H + (size_t)row * D + col) = o; } } }
    }
#undef P1_LOAD
}

struct EpiQKVFast {
    static constexpr bool PERM = true, AFTER_DRAIN = false;
    unsigned char* ws;
    __device__ __forceinline__ void operator()(const pg8::f32x4 (&acc)[2][2][4][2], const pg8::Unit& u, int wr, int wc, int fr, int fq) const {
        const bool lat = u.pm < 128;
        const int kind = u.pn >> 1;
        if (!lat && (kind == 0 || kind == 3)) return;
        const int b = lat ? (u.pm >> 4) : (u.pm - 128);
        const int tb = lat ? (u.pm & 15) * 256 : 0;
        const float* rope = (const float*)(ws + WS_ROPE);
#pragma unroll
        for (int bj = 0; bj < 2; ++bj) {
            const int cc = (u.pn & 1) * 256 + bj * 128 + wc * 32 + 8 * fq;
#pragma unroll
            for (int ai = 0; ai < 2; ++ai)
#pragma unroll
                for (int m = 0; m < 4; ++m) {
                    const int rowin = ai * 128 + wr * 64 + m * 16 + fr;
                    const int t = tb + rowin;
                    const int j = lat ? 256 + t : rowin;
                    f32x4 v0 = acc[ai][bj][m][0], v1 = acc[ai][bj][m][1];
                    bf16_t* dst;
                    if (kind == 0) { dst = (bf16_t*)(ws + WS_QA) + qa_idx(b, cc >> 6, t, cc & 63); v0 = v0 * C2; v1 = v1 * C2; }
                    else if (kind == 1) dst = (bf16_t*)(ws + WS_KA) + ka_idx(b, cc >> 6, j, cc & 63);
                    else if (kind == 2) dst = (bf16_t*)(ws + WS_VA) + va_idx(b, cc >> 6, j, cc & 63);
                    else if (kind == 5) dst = (bf16_t*)(ws + WS_VD) + vd_idx(b, cc >> 7, j, cc & 127);
                    else {
                        const int mm = cc >> 8, h = (cc >> 6) & 3, d = cc & 63;
                        if (lat) { const int i0 = d >> 1; const int pos = i0 < 16 ? (t >> 6) : (t & 63); const float* rp = rope + (pos * 16 + (i0 & 15)) * 2;
                            const f32x4 r0 = *(const f32x4*)rp, r1 = *(const f32x4*)(rp + 4);
                            f32x4 a0, a1;
                            a0.x = v0.x * r0.x - v0.y * r0.y; a0.y = v0.x * r0.y + v0.y * r0.x; a0.z = v0.z * r0.z - v0.w * r0.w; a0.w = v0.z * r0.w + v0.w * r0.z;
                            a1.x = v1.x * r1.x - v1.y * r1.y; a1.y = v1.x * r1.y + v1.y * r1.x; a1.z = v1.z * r1.z - v1.w * r1.w; a1.w = v1.z * r1.w + v1.w * r1.z;
                            v0 = a0; v1 = a1; }
                        if (kind == 3) { dst = (bf16_t*)(ws + WS_QD) + qd_idx(b, mm, h, t, d); v0 = v0 * C2; v1 = v1 * C2; }
                        else dst = (bf16_t*)(ws + WS_KD) + kd_idx(b, mm, h, j, d);
                    }
                    pg8::u32x4 w; w.x = pg8::cvt_pk_bf16(v0[0], v0[1]); w.y = pg8::cvt_pk_bf16(v0[2], v0[3]); w.z = pg8::cvt_pk_bf16(v1[0], v1[1]); w.w = pg8::cvt_pk_bf16(v1[2], v1[3]);
                    *(pg8::u32x4*)dst = w;
                }
        }
    }
};


struct EpiQ2Frag {
    static constexpr bool PERM = true, AFTER_DRAIN = false;
    bf16_t* O;
    __device__ __forceinline__ void operator()(const pg8::f32x4 (&acc)[2][2][4][2], const pg8::Unit& u, int wr, int wc, int fr, int fq) const {
        const int h = u.pn;
#pragma unroll
        for (int bj = 0; bj < 2; ++bj) {
            const int c8 = wc * 4 + fq;
#pragma unroll
            for (int ai = 0; ai < 2; ++ai)
#pragma unroll
                for (int m = 0; m < 4; ++m) {
                    const int row = u.pm * 256 + ai * 128 + wr * 64 + m * 16 + fr;
                    const size_t idx = ((((((size_t)(row >> 5) * 8 + h) * 2 + bj) * 8 + (c8 >> 1)) * 2 + (c8 & 1)) * 32 + (row & 31)) * 8;
                    const f32x4 v0 = acc[ai][bj][m][0], v1 = acc[ai][bj][m][1];
                    pg8::u32x4 w; w.x = pg8::cvt_pk_bf16(v0[0], v0[1]); w.y = pg8::cvt_pk_bf16(v0[2], v0[3]); w.z = pg8::cvt_pk_bf16(v1[0], v1[1]); w.w = pg8::cvt_pk_bf16(v1[2], v1[3]);
                    *(pg8::u32x4*)(O + idx) = w;
                }
        }
    }
};

__device__ __forceinline__ void p5_rows2(Frame& F, const Params& p) {
    unsigned char* ws = p.ws;
    const float* mod = (const float*)(ws + WS_MOD);
    const bf16_t* YO = (const bf16_t*)(ws + WS_YO);
    bf16_t* H2 = (bf16_t*)(ws + WS_H2);
    const int gw = F.bid * NWAVES + F.wave, NGW = F.G * NWAVES;
    const int rows_per = (MLAT + NGW - 1) / NGW;
    const int rend = min(MLAT, (gw + 1) * rows_per);
    f32x4 nxx[2][4]; u32x2 nxy[2][4];
#define P5_LOAD(rowa_) do { _Pragma("unroll") for (int q = 0; q < 2; ++q) { const int row = min((rowa_) + q, MLAT - 1); \
            _Pragma("unroll") for (int j = 0; j < 4; ++j) { nxx[q][j] = ((const f32x4*)(p.x + (size_t)row * D))[F.lane + 64 * j]; nxy[q][j] = ((const u32x2*)(YO + (size_t)row * D))[F.lane + 64 * j]; } } } while (0)
    P5_LOAD(gw * rows_per);
    for (int rowa = gw * rows_per; rowa < rend; rowa += 2) {
        f32x4 xv[2][4], yv[2][4]; float ssq[2];
#pragma unroll
        for (int q = 0; q < 2; ++q)
#pragma unroll
            for (int j = 0; j < 4; ++j) { xv[q][j] = nxx[q][j]; const u32x2 yw = nxy[q][j]; yv[q][j] = (f32x4){bflo(yw.x), bfhi(yw.x), bflo(yw.y), bfhi(yw.y)}; }
        if (rowa + 2 < rend) P5_LOAD(rowa + 2);
#pragma unroll
        for (int q = 0; q < 2; ++q) { float s = 0.f;
#pragma unroll
            for (int j = 0; j < 4; ++j) s += yv[q][j].x * yv[q][j].x + yv[q][j].y * yv[q][j].y + yv[q][j].z * yv[q][j].z + yv[q][j].w * yv[q][j].w;
            ssq[q] = wave_sum(s); }
#pragma unroll
        for (int q = 0; q < 2; ++q) { const int row = rowa + q; if (row < MLAT) {
            const int b = row >> 12; const float* mb = mod + b * NMOD;
            const float rstd = rsqrtf(ssq[q] * (1.f / D) + EPS);
            float s2 = 0.f;
#pragma unroll
            for (int j = 0; j < 4; ++j) { const int col = (F.lane + 64 * j) * 4;
                const f32x4 g1 = *(const f32x4*)(p.g_norm + D + col), gt1 = *(const f32x4*)(mb + 2 * D + col);
                xv[q][j] = xv[q][j] + gt1 * (yv[q][j] * rstd * g1);
                *(f32x4*)(p.out + (size_t)row * D + col) = xv[q][j];
                s2 += xv[q][j].x * xv[q][j].x + xv[q][j].y * xv[q][j].y + xv[q][j].z * xv[q][j].z + xv[q][j].w * xv[q][j].w; }
            const float rstd2 = rsqrtf(wave_sum(s2) * (1.f / D) + EPS);
#pragma unroll
            for (int j = 0; j < 4; ++j) { const int col = (F.lane + 64 * j) * 4;
                const f32x4 g2 = *(const f32x4*)(p.g_norm + 2 * D + col), sh2 = *(const f32x4*)(mb + 3 * D + col), sc2 = *(const f32x4*)(mb + 4 * D + col);
                const f32x4 y = (xv[q][j] * rstd2 * g2) * (sc2 + 1.f) + sh2;
                u32x2 o; o.x = pk2(y.x, y.y); o.y = pk2(y.z, y.w);
                *(u32x2*)(H2 + (size_t)row * D + col) = o; } } }
    }
#undef P5_LOAD
}

template <int J> __device__ __forceinline__ unsigned lane_xor(unsigned x, int lane) {
    if (J == 1) return (unsigned)__builtin_amdgcn_update_dpp(0, (int)x, 0xB1, 0xf, 0xf, false);
    if (J == 2) return (unsigned)__builtin_amdgcn_update_dpp(0, (int)x, 0x4E, 0xf, 0xf, false);
    if (J == 4) { const unsigned a = (unsigned)__builtin_amdgcn_update_dpp(0, (int)x, 0x104, 0xf, 0xf, false),
                                 b = (unsigned)__builtin_amdgcn_update_dpp(0, (int)x, 0x114, 0xf, 0xf, false);
                  return (lane & 4) ? b : a; }
    if (J == 8) return (unsigned)__builtin_amdgcn_update_dpp(0, (int)x, 0x128, 0xf, 0xf, false);
    if (J == 16) { auto r = __builtin_amdgcn_permlane16_swap(x, x, false, false); return (lane & 16) ? r[0] : r[1]; }
    auto r = __builtin_amdgcn_permlane32_swap(x, x, false, false); return (lane & 32) ? r[0] : r[1];
}
template <int K2, int J> __device__ __forceinline__ void bitonic_step128(unsigned& key0, unsigned& key1, int lane) {
    if (J == 64) { const unsigned lo = key0 < key1 ? key0 : key1, hi_ = key0 < key1 ? key1 : key0; key0 = lo; key1 = hi_; }
    else {
        const unsigned p0_ = lane_xor<J>(key0, lane), p1_ = lane_xor<J>(key1, lane);
        const bool lower = (lane & J) == 0;
        const bool asc0 = K2 == 128 ? true : ((lane & K2) == 0), asc1 = K2 == 128 ? true : (((64 + lane) & K2) == 0);
        const bool kmin0 = lower == asc0, kmin1 = lower == asc1;
        key0 = kmin0 ? (key0 < p0_ ? key0 : p0_) : (key0 < p0_ ? p0_ : key0);
        key1 = kmin1 ? (key1 < p1_ ? key1 : p1_) : (key1 < p1_ ? p1_ : key1);
    }
}
__device__ __forceinline__ void sort128_asc(unsigned& k0, unsigned& k1, int lane) {
    bitonic_step128<2, 1>(k0, k1, lane);
    bitonic_step128<4, 2>(k0, k1, lane); bitonic_step128<4, 1>(k0, k1, lane);
    bitonic_step128<8, 4>(k0, k1, lane); bitonic_step128<8, 2>(k0, k1, lane); bitonic_step128<8, 1>(k0, k1, lane);
    bitonic_step128<16, 8>(k0, k1, lane); bitonic_step128<16, 4>(k0, k1, lane); bitonic_step128<16, 2>(k0, k1, lane); bitonic_step128<16, 1>(k0, k1, lane);
    bitonic_step128<32, 16>(k0, k1, lane); bitonic_step128<32, 8>(k0, k1, lane); bitonic_step128<32, 4>(k0, k1, lane); bitonic_step128<32, 2>(k0, k1, lane); bitonic_step128<32, 1>(k0, k1, lane);
    bitonic_step128<64, 32>(k0, k1, lane); bitonic_step128<64, 16>(k0, k1, lane); bitonic_step128<64, 8>(k0, k1, lane); bitonic_step128<64, 4>(k0, k1, lane); bitonic_step128<64, 2>(k0, k1, lane); bitonic_step128<64, 1>(k0, k1, lane);
    bitonic_step128<128, 64>(k0, k1, lane); bitonic_step128<128, 32>(k0, k1, lane); bitonic_step128<128, 16>(k0, k1, lane); bitonic_step128<128, 8>(k0, k1, lane); bitonic_step128<128, 4>(k0, k1, lane); bitonic_step128<128, 2>(k0, k1, lane); bitonic_step128<128, 1>(k0, k1, lane);
}
__device__ __forceinline__ unsigned lane_xor_c(unsigned x, int j, int lane) {
    if (j == 1) return lane_xor<1>(x, lane); if (j == 2) return lane_xor<2>(x, lane); if (j == 4) return lane_xor<4>(x, lane);
    if (j == 8) return lane_xor<8>(x, lane); if (j == 16) return lane_xor<16>(x, lane); return lane_xor<32>(x, lane);
}
template <int R> __device__ __forceinline__ void sort_regs_asc(unsigned (&key)[R], int lane) {
#pragma unroll
    for (int k2 = 2; k2 <= 64 * R; k2 <<= 1)
#pragma unroll
        for (int j = k2 >> 1; j > 0; j >>= 1) {
            if (j >= 64) {
                const int jr = j >> 6;
#pragma unroll
                for (int r = 0; r < R; ++r) { const int rp = r ^ jr; if (rp > r) { const bool asc = ((r * 64) & k2) == 0;
                    const unsigned lo = key[r] < key[rp] ? key[r] : key[rp], hi_ = key[r] < key[rp] ? key[rp] : key[r];
                    key[r] = asc ? lo : hi_; key[rp] = asc ? hi_ : lo; } }
            } else {
                const bool lower = (lane & j) == 0;
#pragma unroll
                for (int r = 0; r < R; ++r) { const unsigned pv = lane_xor_c(key[r], j, lane);
                    const bool asc = k2 < 64 ? ((lane & k2) == 0) : (((r * 64) & k2) == 0);
                    const bool kmin = lower == asc;
                    key[r] = kmin ? (key[r] < pv ? key[r] : pv) : (key[r] < pv ? pv : key[r]); }
            }
        }
}
template <int MODE> __device__ __forceinline__ void p8_gather(Frame& F, const Params& p, const XcdBarrier& bar) {
    unsigned char* ws = p.ws;
    const bf16_t* H2 = (const bf16_t*)(ws + WS_H2); const unsigned char* U8 = ws + WS_UB; const unsigned char* V8 = ws + WS_VB;
    const int* EX = (const int*)(ws + WS_EXP); const float* GT = (const float*)(ws + WS_GATE); const float* SU = (const float*)(ws + WS_SU); const float* mod = (const float*)(ws + WS_MOD);
    const int gw = F.bid * NWAVES + F.wave, NGW = F.G * NWAVES, lane = F.lane;
    const int b5 = (lane >> 5) & 1, b4 = (lane >> 4) & 1, b3 = (lane >> 3) & 1;
    const int idx = b5 * 4 + b4 * 2 + b3;
    const int tpw = MLAT / NGW;
    for (int g = 0; g < tpw / 2; ++g) {
#if P8_SYNC
        if (g > 0) xcd_barrier(bar);
#endif
        const int t0 = gw * tpw + g * 2;
        float hv0[16], hv1[16], acc0[16], acc1[16];
#pragma unroll
        for (int j = 0; j < 4; ++j) { const u32x2 w0 = *(const u32x2*)(H2 + (size_t)t0 * D + (lane + 64 * j) * 4), w1 = *(const u32x2*)(H2 + (size_t)(t0 + 1) * D + (lane + 64 * j) * 4);
            hv0[4 * j] = bflo(w0.x); hv0[4 * j + 1] = bfhi(w0.x); hv0[4 * j + 2] = bflo(w0.y); hv0[4 * j + 3] = bfhi(w0.y);
            hv1[4 * j] = bflo(w1.x); hv1[4 * j + 1] = bfhi(w1.x); hv1[4 * j + 2] = bflo(w1.y); hv1[4 * j + 3] = bfhi(w1.y); }
#pragma unroll
        for (int i = 0; i < 16; ++i) { acc0[i] = 0.f; acc1[i] = 0.f; }
        unsigned key[4];
#pragma unroll
        for (int r = 0; r < 4; ++r) { const int n = r * 64 + lane; key[r] = ((unsigned)EX[(size_t)t0 * 128 + n] << 8) | (unsigned)n; }
        sort_regs_asc<4>(key, lane);
        const size_t tb_ = (size_t)t0 * 128;
        for (int bb = 0; bb < 32; ++bb) {
            const int rsel = bb >> 3; const unsigned kreg = rsel == 0 ? key[0] : (rsel == 1 ? key[1] : (rsel == 2 ? key[2] : key[3])); const int lb = (bb & 7) * 8;
            const unsigned kmine = (unsigned)__shfl((int)kreg, lb + idx);
            const float gl = GT[tb_ + (kmine & 255u)], sl = SU[tb_ + (kmine & 255u)];
            u32x4 ur[8], vr[8]; int slot[8];
#pragma unroll
            for (int i = 0; i < 8; ++i) { const unsigned ke = (unsigned)__builtin_amdgcn_readlane((int)kreg, lb + i); const int e = (int)(ke >> 8) & (MODE == 1 ? 1023 : 0xFFFF); slot[i] = (int)((ke >> 7) & 1u);
                ur[i] = *(const u32x4*)(U8 + (size_t)e * 1024 + lane * 16); vr[i] = *(const u32x4*)(V8 + (size_t)e * 1024 + lane * 16); }
            float d[8];
#pragma unroll
            for (int i = 0; i < 8; ++i) { float s = 0.f;
                if (slot[i] == 0) {
#pragma unroll
                    for (int j = 0; j < 4; ++j) { const f32x2 f0 = __builtin_amdgcn_cvt_pk_f32_fp8((int)ur[i][j], false), f1 = __builtin_amdgcn_cvt_pk_f32_fp8((int)ur[i][j], true);
                        s += hv0[4 * j] * f0.x + hv0[4 * j + 1] * f0.y + hv0[4 * j + 2] * f1.x + hv0[4 * j + 3] * f1.y; }
                } else {
#pragma unroll
                    for (int j = 0; j < 4; ++j) { const f32x2 f0 = __builtin_amdgcn_cvt_pk_f32_fp8((int)ur[i][j], false), f1 = __builtin_amdgcn_cvt_pk_f32_fp8((int)ur[i][j], true);
                        s += hv1[4 * j] * f0.x + hv1[4 * j + 1] * f0.y + hv1[4 * j + 2] * f1.x + hv1[4 * j + 3] * f1.y; }
                }
                d[i] = s; }
            float r4[4], r2[2], r1;
#pragma unroll
            for (int i = 0; i < 4; ++i) { auto rr = __builtin_amdgcn_permlane32_swap(__float_as_uint(d[i]), __float_as_uint(d[i + 4]), false, false); r4[i] = __uint_as_float(rr[0]) + __uint_as_float(rr[1]); }
#pragma unroll
            for (int i = 0; i < 2; ++i) { auto rr = __builtin_amdgcn_permlane16_swap(__float_as_uint(r4[i]), __float_as_uint(r4[i + 2]), false, false); r2[i] = __uint_as_float(rr[0]) + __uint_as_float(rr[1]); }
            { const float keep = b3 ? r2[1] : r2[0], send = b3 ? r2[0] : r2[1]; r1 = keep + __uint_as_float((unsigned)__builtin_amdgcn_update_dpp(0, (int)__float_as_uint(send), 0x128, 0xf, 0xf, false)); }
            r1 += __uint_as_float((unsigned)__builtin_amdgcn_update_dpp(0, (int)__float_as_uint(r1), 0xB1, 0xf, 0xf, false));
            r1 += __uint_as_float((unsigned)__builtin_amdgcn_update_dpp(0, (int)__float_as_uint(r1), 0x4E, 0xf, 0xf, false));
            r1 += __uint_as_float((unsigned)__builtin_amdgcn_update_dpp(0, (int)__float_as_uint(r1), 0x141, 0xf, 0xf, false));
            const float pre = r1 * sl;
            float act;
            { const float av = fabsf(pre), dd = av * 0.2316418882f + 1.0f; const float tt = __builtin_amdgcn_rcpf(dd);
              float q = tt * 0.5307027145f + (-0.7265760135f); q = q * tt + 0.7107068705f; q = q * tt + (-0.142248368f); q = q * tt + 0.127414796f; q = q * tt;
              const float ee = __builtin_amdgcn_exp2f((pre * pre) * (-0.72134752044f));
              const float mm = pre * (q * ee); act = pre < 0.f ? mm : pre - mm; }
            const float cfl = gl * act;
#pragma unroll
            for (int i = 0; i < 8; ++i) {
                const float cf = __uint_as_float((unsigned)__builtin_amdgcn_readlane((int)__float_as_uint(cfl), ((i >> 2) & 1) * 32 + ((i >> 1) & 1) * 16 + (i & 1) * 8));
                if (slot[i] == 0) {
#pragma unroll
                    for (int j = 0; j < 4; ++j) { const f32x2 f0 = __builtin_amdgcn_cvt_pk_f32_fp8((int)vr[i][j], false), f1 = __builtin_amdgcn_cvt_pk_f32_fp8((int)vr[i][j], true);
                        acc0[4 * j] += cf * f0.x; acc0[4 * j + 1] += cf * f0.y; acc0[4 * j + 2] += cf * f1.x; acc0[4 * j + 3] += cf * f1.y; }
                } else {
#pragma unroll
                    for (int j = 0; j < 4; ++j) { const f32x2 f0 = __builtin_amdgcn_cvt_pk_f32_fp8((int)vr[i][j], false), f1 = __builtin_amdgcn_cvt_pk_f32_fp8((int)vr[i][j], true);
                        acc1[4 * j] += cf * f0.x; acc1[4 * j + 1] += cf * f0.y; acc1[4 * j + 2] += cf * f1.x; acc1[4 * j + 3] += cf * f1.y; }
                }
            }
        }
#pragma unroll
        for (int sidx = 0; sidx < 2; ++sidx) {
            const int t = t0 + sidx;
            float s = 0.f;
#pragma unroll
            for (int i = 0; i < 16; ++i) { const float a = sidx ? acc1[i] : acc0[i]; s += a * a; }
            const float rstd = rsqrtf(wave_sum(s) * (1.f / D) + EPS);
            const float* mb = mod + (t >> 12) * NMOD + 5 * D; const float* g3 = p.g_norm + 3 * D;
#pragma unroll
            for (int j = 0; j < 4; ++j) { const int col = (lane + 64 * j) * 4;
                float* op = p.out + (size_t)t * D + col;
                const f32x4 x0 = *(const f32x4*)op, ga = *(const f32x4*)(g3 + col), ta = *(const f32x4*)(mb + col);
                const f32x4 pa = sidx ? (f32x4){acc1[4 * j], acc1[4 * j + 1], acc1[4 * j + 2], acc1[4 * j + 3]} : (f32x4){acc0[4 * j], acc0[4 * j + 1], acc0[4 * j + 2], acc0[4 * j + 3]};
                if (MODE == 0 || rstd == 123456.f) *(f32x4*)op = x0 + ta * (pa * rstd * ga); }
        }
    }
}

namespace att {
typedef short bf16x8 __attribute__((ext_vector_type(8)));
typedef short s16x4 __attribute__((ext_vector_type(4)));
typedef float f32x16 __attribute__((ext_vector_type(16)));
typedef __attribute__((address_space(3))) const unsigned char* lcp;
typedef __attribute__((address_space(3))) unsigned char* lp;
constexpr int NA_SLOT = 16384, NA_BIAS_OFF = 32768, WSF_OFF = 155648;
constexpr int DF_SLOT = 32768;
constexpr float THRL = 8.f;

__device__ __forceinline__ int crow(int r, int hi) { return (r & 3) + 8 * (r >> 2) + 4 * hi; }
__device__ __forceinline__ s16x4 vtr(lcp p) { return __builtin_bit_cast(s16x4, __builtin_amdgcn_ds_read_tr16_b64_v4i16((__attribute__((address_space(3))) s16x4*)p)); }
typedef float f32x2_t __attribute__((ext_vector_type(2))); typedef __bf16 bf16x2v_t __attribute__((ext_vector_type(2)));
__device__ __forceinline__ unsigned cvtpk(float lo, float hi) { f32x2_t v = {lo, hi}; bf16x2v_t b = __builtin_convertvector(v, bf16x2v_t); return __builtin_bit_cast(unsigned, b); }
__device__ __forceinline__ float swap_half(float v) { auto rr = __builtin_amdgcn_permlane32_swap(__float_as_uint(v), __float_as_uint(v), false, false); return __uint_as_float(rr[0]) == v ? __uint_as_float(rr[1]) : __uint_as_float(rr[0]); }
__device__ __forceinline__ void dma16(const void* gsrc, lp lds_dst) {
    unsigned keep; const unsigned dst = (unsigned)__builtin_amdgcn_readfirstlane((int)(unsigned)(size_t)lds_dst);
    asm volatile("s_mov_b32 %0, m0\n\ts_mov_b32 m0, %2\n\ts_nop 0\n\tglobal_load_lds_dwordx4 %1, off\n\ts_mov_b32 m0, %0" : "=&s"(keep) : "v"(gsrc), "s"(dst) : "memory");
}
__device__ __forceinline__ float max3f(float a, float b, float c) { float r; asm("v_max3_f32 %0, %1, %2, %3" : "=v"(r) : "v"(a), "v"(b), "v"(c)); return r; }
__device__ __forceinline__ float rowmax32(const f32x16& p0, const f32x16& p1) {
    float a = max3f(p0[0], p0[1], p1[0]), b = max3f(p0[2], p0[3], p1[1]); a = max3f(a, p1[2], p1[3]);
#pragma unroll
    for (int r = 4; r < 16; r += 4) { a = max3f(a, p0[r], p0[r + 1]); b = max3f(b, p0[r + 2], p0[r + 3]); a = max3f(a, p1[r], p1[r + 1]); b = max3f(b, p1[r + 2], p1[r + 3]); }
    float m = max3f(a, b, b);
    auto rr = __builtin_amdgcn_permlane32_swap(__float_as_uint(m), __float_as_uint(m), false, false);
    return max3f(__uint_as_float(rr[0]), __uint_as_float(rr[1]), __uint_as_float(rr[1]));
}

typedef __bf16 bf16x2_t __attribute__((ext_vector_type(2)));
__device__ __forceinline__ float psum_bf16(const u32x4 (&pw)[4], float acc) {
    const bf16x2_t ones = __builtin_bit_cast(bf16x2_t, 0x3F803F80u); float a0 = acc, a1 = 0.f;
#pragma unroll
    for (int k = 0; k < 4; ++k) { a0 = __builtin_amdgcn_fdot2_f32_bf16(__builtin_bit_cast(bf16x2_t, pw[k][0]), ones, a0, false); a1 = __builtin_amdgcn_fdot2_f32_bf16(__builtin_bit_cast(bf16x2_t, pw[k][1]), ones, a1, false);
        a0 = __builtin_amdgcn_fdot2_f32_bf16(__builtin_bit_cast(bf16x2_t, pw[k][2]), ones, a0, false); a1 = __builtin_amdgcn_fdot2_f32_bf16(__builtin_bit_cast(bf16x2_t, pw[k][3]), ones, a1, false); }
    return a0 + a1;
}
template <int NDV> struct FlashState { float mhat, l; f32x16 negm; f32x16 o[NDV]; };

template <int NDV, bool BIAS>
__device__ __forceinline__ void flash_tile(FlashState<NDV>& st, const bf16x8 (&qr)[4], lcp Kslot, lcp Vslot, lcp Bslot, const bf16x8 (&qoh)[2],
                                           __attribute__((address_space(3))) float* wsf, int r32, int hi, int lane, bool first) {
    f32x16 p0 = st.negm, p1 = st.negm;
    lcp kb = Kslot + hi * 1024 + r32 * 16;
    bf16x8 kf[8], bf_[4];
#pragma unroll
    for (int d0 = 0; d0 < 4; ++d0) { kf[2 * d0] = *(const __attribute__((address_space(3))) bf16x8*)(kb + d0 * 2048); kf[2 * d0 + 1] = *(const __attribute__((address_space(3))) bf16x8*)(kb + d0 * 2048 + 512); }
    if (BIAS) { lcp bb = Bslot + hi * 1024 + r32 * 16;
#pragma unroll
        for (int e = 0; e < 2; ++e) { bf_[2 * e] = *(const __attribute__((address_space(3))) bf16x8*)(bb + e * 2048); bf_[2 * e + 1] = *(const __attribute__((address_space(3))) bf16x8*)(bb + e * 2048 + 512); } }
    lcp vb = Vslot + ((lane >> 4) & 1) * 32 + (lane & 3) * 8 + (4 * hi + ((lane & 15) >> 2)) * 64;
    s16x4 va[8], vn[8];
#pragma unroll
    for (int ks = 0; ks < 4; ++ks) { va[2 * ks] = vtr(vb + ks * 1024); va[2 * ks + 1] = vtr(vb + ks * 1024 + 512); }
#pragma unroll
    for (int d0 = 0; d0 < 4; ++d0) { p0 = __builtin_amdgcn_mfma_f32_32x32x16_bf16(kf[2 * d0], qr[d0], p0, 0, 0, 0); p1 = __builtin_amdgcn_mfma_f32_32x32x16_bf16(kf[2 * d0 + 1], qr[d0], p1, 0, 0, 0); }
    if (BIAS) {
#pragma unroll
        for (int e = 0; e < 2; ++e) { p0 = __builtin_amdgcn_mfma_f32_32x32x16_bf16(bf_[2 * e], qoh[e], p0, 0, 0, 0); p1 = __builtin_amdgcn_mfma_f32_32x32x16_bf16(bf_[2 * e + 1], qoh[e], p1, 0, 0, 0); }
    }
    asm volatile("s_nop 15\n\ts_nop 7" : "+v"(p0), "+v"(p1));
    const float rm = rowmax32(p0, p1);
    if (first) {
        st.mhat += rm;
#pragma unroll
        for (int r = 0; r < 16; ++r) { p0[r] -= rm; p1[r] -= rm; st.negm[r] = -st.mhat; }
    } else if (__any(rm > THRL)) {
        const float dl = fmaxf(rm, 0.f); const float alpha = __builtin_amdgcn_exp2f(-dl); st.mhat += dl; st.l *= alpha;
        if (hi == 0) wsf[r32] = alpha;
        asm volatile("s_waitcnt lgkmcnt(0)" ::: "memory");
        float al[16];
#pragma unroll
        for (int r = 0; r < 16; ++r) al[r] = wsf[crow(r, hi)];
#pragma unroll
        for (int d = 0; d < NDV; ++d)
#pragma unroll
            for (int r = 0; r < 16; ++r) st.o[d][r] *= al[r];
#pragma unroll
        for (int r = 0; r < 16; ++r) { p0[r] -= dl; p1[r] -= dl; st.negm[r] = -st.mhat; }
    }
    float sacc = 0.f;
#pragma unroll
    for (int r = 0; r < 16; ++r) { p0[r] = __builtin_amdgcn_exp2f(p0[r]); p1[r] = __builtin_amdgcn_exp2f(p1[r]); sacc += p0[r] + p1[r]; }
    st.l += sacc;
    u32x4 pw[4];
#pragma unroll
    for (int i = 0; i < 4; ++i) { pw[0][i] = cvtpk(p0[2 * i], p0[2 * i + 1]); pw[1][i] = cvtpk(p0[8 + 2 * i], p0[8 + 2 * i + 1]); pw[2][i] = cvtpk(p1[2 * i], p1[2 * i + 1]); pw[3][i] = cvtpk(p1[8 + 2 * i], p1[8 + 2 * i + 1]); }
    __builtin_amdgcn_sched_barrier(0);
#pragma unroll
    for (int d0 = 0; d0 < NDV; ++d0) {
#pragma unroll
        for (int ks = 0; ks < 4; ++ks) {
            if (d0 < NDV - 1) { vn[2 * ks] = vtr(vb + (d0 + 1) * 4096 + ks * 1024); vn[2 * ks + 1] = vtr(vb + (d0 + 1) * 4096 + ks * 1024 + 512); }
            const bf16x8 vf = (bf16x8){va[2 * ks][0], va[2 * ks][1], va[2 * ks][2], va[2 * ks][3], va[2 * ks + 1][0], va[2 * ks + 1][1], va[2 * ks + 1][2], va[2 * ks + 1][3]};
            st.o[d0] = __builtin_amdgcn_mfma_f32_32x32x16_bf16(__builtin_bit_cast(bf16x8, pw[ks]), vf, st.o[d0], 0, 0, 0);
            __builtin_amdgcn_sched_barrier(0);
        }
#pragma unroll
        for (int i = 0; i < 8; ++i) va[i] = vn[i];
    }
}

constexpr int NA2_SLOT = 16384, NA2_BIAS_OFF = 65536;
__device__ __forceinline__ void na_units(Frame& F, const Params& p) {
    unsigned char* ws = p.ws;
    const bf16_t* QA = (const bf16_t*)(ws + WS_QA); const bf16_t* KA = (const bf16_t*)(ws + WS_KA); const bf16_t* VA = (const bf16_t*)(ws + WS_VA);
    const bf16_t* BT = (const bf16_t*)(ws + WS_BIAST); bf16_t* Y = (bf16_t*)(ws + WS_Y);
    const int lane = F.lane, r32 = lane & 31, hi = lane >> 5, wave = F.wave;
    lp lds = (lp)F.lds;
    __attribute__((address_space(3))) float* wsf = (__attribute__((address_space(3))) float*)(lds + WSF_OFF) + wave * 64;
    const int upw = 1024 / F.G;
    int cur_h = -1, cur_lo = -1, cur_hi = -1;
    bf16x8 qoh[2];
#pragma unroll
    for (int e = 0; e < 2; ++e)
#pragma unroll
        for (int j = 0; j < 8; ++j) qoh[e][j] = (16 * e + 8 * hi + j == r32) ? (short)0x3F80 : (short)0;
    for (int ui = 0; ui < upw; ++ui) {
        const int u = F.bid * upw + ui, bh = u >> 4, rg = u & 15, b = bh >> 3, h = bh & 7;
        const int r0 = rg * 4, r = r0 + (wave >> 1), ch = wave & 1;
        int rs = r - 4; rs = rs < 0 ? 0 : (rs > 56 ? 56 : rs);
        int kr_lo = r0 - 4; kr_lo = kr_lo < 0 ? 0 : (kr_lo > 56 ? 56 : kr_lo);
        int kr_hi = r0 + 3 - 4; kr_hi = kr_hi < 0 ? 0 : (kr_hi > 56 ? 56 : kr_hi); kr_hi += 7;
        const int T = 4 + (kr_hi - kr_lo + 1);
        int dr_lo = 99, dr_hi = -1;
#pragma unroll
        for (int q = 0; q < 4; ++q) { int s_ = r0 + q - 4; s_ = s_ < 0 ? 0 : (s_ > 56 ? 56 : s_); const int a = s_ - (r0 + q) + 7; dr_lo = a < dr_lo ? a : dr_lo; dr_hi = a + 7 > dr_hi ? a + 7 : dr_hi; }
        const bf16_t* Kb = KA + (size_t)bh * NKT * 4096; const bf16_t* Vb = VA + (size_t)bh * NKT * 4096;
        if (h != cur_h || dr_lo != cur_lo || dr_hi != cur_hi) {
            cur_h = h; cur_lo = dr_lo; cur_hi = dr_hi;
            const unsigned char* src = (const unsigned char*)(BT + ((size_t)h * 15 + dr_lo) * 4096);
            const int npc = (dr_hi - dr_lo + 1) * 8;
            for (int pi = wave; pi < npc; pi += 8) dma16(src + pi * 1024 + lane * 16, lds + NA2_BIAS_OFF + pi * 1024);
        }
        bf16x8 qr[4];
        { const bf16_t* qp = QA + ((size_t)bh * SEQ + r * 64 + ch * 32 + r32) * 64 + hi * 8;
#pragma unroll
          for (int d0 = 0; d0 < 4; ++d0) qr[d0] = *(const bf16x8*)(qp + d0 * 16); }
#define NA_DMA(i_) do { const int tg_ = (i_) < 4 ? (i_) : (4 + kr_lo + (i_) - 4); lp sl_ = lds + ((i_) & 3) * NA2_SLOT; \
            dma16((const unsigned char*)(Kb + (size_t)tg_ * 4096) + wave * 1024 + lane * 16, sl_ + wave * 1024); \
            dma16((const unsigned char*)(Vb + (size_t)tg_ * 4096) + wave * 1024 + lane * 16, sl_ + 8192 + wave * 1024); } while (0)
        NA_DMA(0); NA_DMA(1);
        FlashState<2> st; st.mhat = 0.f; st.l = 0.f;
#pragma unroll
        for (int rr = 0; rr < 16; ++rr) st.negm[rr] = 0.f;
#pragma unroll
        for (int d = 0; d < 2; ++d)
#pragma unroll
            for (int rr = 0; rr < 16; ++rr) st.o[d][rr] = 0.f;
        for (int i = 0; i < T; ++i) {
            if (i + 1 < T) asm volatile("s_waitcnt vmcnt(2)" ::: "memory"); else asm volatile("s_waitcnt vmcnt(0)" ::: "memory");
            __syncthreads();
            if (i + 2 < T) NA_DMA(i + 2);
            lcp sl = (lcp)(lds + (i & 3) * NA2_SLOT);
            if (i < 4) flash_tile<2, false>(st, qr, sl, sl + 8192, sl, qoh, wsf, r32, hi, lane, i == 0);
            else { const int kr = kr_lo + (i - 4);
                if (kr >= rs && kr < rs + 8) { const int dr = kr - r + 7;
                    flash_tile<2, true>(st, qr, sl, sl + 8192, (lcp)(lds + NA2_BIAS_OFF + (dr - dr_lo) * 8192 + ch * 4096), qoh, wsf, r32, hi, lane, false); } }
        }
#undef NA_DMA
        float lt = st.l; { auto rr = __builtin_amdgcn_permlane32_swap(__float_as_uint(lt), __float_as_uint(lt), false, false); lt = __uint_as_float(rr[0]) + __uint_as_float(rr[1]); }
        if (hi == 0) wsf[32 + r32] = lt;
        asm volatile("s_waitcnt lgkmcnt(0)" ::: "memory");
        bf16_t* yb = Y + ((size_t)b * SEQ + r * 64 + ch * 32) * D + h * 64 + r32;
#pragma unroll
        for (int rr = 0; rr < 16; ++rr) { const float rl = __builtin_amdgcn_rcpf(wsf[32 + crow(rr, hi)]);
#pragma unroll
            for (int d0 = 0; d0 < 2; ++d0) yb[(size_t)crow(rr, hi) * D + d0 * 32] = (bf16_t)f2bf(st.o[d0][rr] * rl); }
        __syncthreads();
    }
}

template <int MODE> __device__ __forceinline__ void diff_units_v2(Frame& F, const Params& p) {
    unsigned char* ws = p.ws;
    const bf16_t* QD = (const bf16_t*)(ws + WS_QD); const bf16_t* KD = (const bf16_t*)(ws + WS_KD); const bf16_t* VD = (const bf16_t*)(ws + WS_VD);
    bf16_t* Y = (bf16_t*)(ws + WS_Y);
    const float lam = *(const float*)(ws + WS_LAM);
    const int lane = F.lane, r32 = lane & 31, hi = lane >> 5, wave = F.wave, map = wave >> 2, qg = wave & 3;
    lp lds = (lp)F.lds;
    __attribute__((address_space(3))) float* wsf = (__attribute__((address_space(3))) float*)(lds + WSF_OFF) + wave * 64;
    __attribute__((address_space(3))) float* X = (__attribute__((address_space(3))) float*)lds;
    const int upw = 1024 / F.G;
    const int koff = map * 8192 + hi * 1024 + r32 * 16;
    const int voff = 16384 + ((lane >> 4) & 1) * 32 + (lane & 3) * 8 + (4 * hi + ((lane & 15) >> 2)) * 64;
    for (int ui = 0; ui < upw; ++ui) {
        int bh, qb;
        if (F.G == 256) { bh = (F.bid & 7) * 4 + ui; qb = F.bid >> 3; } else { const int u = F.bid * upw + ui; bh = u >> 5; qb = u & 31; }
        const int b = bh >> 2, h = bh & 3;
        const unsigned char* K1 = (const unsigned char*)(KD + (size_t)((b * 2 + 0) * 4 + h) * NKT * 4096);
        const unsigned char* K2 = (const unsigned char*)(KD + (size_t)((b * 2 + 1) * 4 + h) * NKT * 4096);
        const unsigned char* Vg = (const unsigned char*)(VD + (size_t)bh * NKT * 8192);
#define DF_DMA(t, slot) do { if (MODE != 1 && MODE != 3) { lp sl_ = lds + (slot) * DF_SLOT; \
            dma16(K1 + (size_t)(t) * 8192 + wave * 1024 + lane * 16, sl_ + wave * 1024); \
            dma16(K2 + (size_t)(t) * 8192 + wave * 1024 + lane * 16, sl_ + 8192 + wave * 1024); \
            dma16(Vg + (size_t)(t) * 16384 + wave * 1024 + lane * 16, sl_ + 16384 + wave * 1024); \
            dma16(Vg + (size_t)(t) * 16384 + 8192 + wave * 1024 + lane * 16, sl_ + 24576 + wave * 1024); } } while (0)
        DF_DMA(0, 0); DF_DMA(1, 1);
        const int q0 = qb * 128 + qg * 32;
        bf16x8 qr[4];
        { const bf16_t* qp = QD + ((size_t)((b * 2 + map) * 4 + h) * SEQ + q0 + r32) * 64 + hi * 8;
#pragma unroll
          for (int d0 = 0; d0 < 4; ++d0) qr[d0] = *(const bf16x8*)(qp + d0 * 16); }
        float mhat = 0.f, lsum = 0.f; f32x16 o[4], negm;
#pragma unroll
        for (int d = 0; d < 4; ++d)
#pragma unroll
            for (int rr = 0; rr < 16; ++rr) o[d][rr] = 0.f;
        asm volatile("s_waitcnt vmcnt(0)" ::: "memory");
        __syncthreads();
        f32x16 s0, s1;
#pragma unroll
        for (int rr = 0; rr < 16; ++rr) { s0[rr] = 0.f; s1[rr] = 0.f; }
        { lcp kb = (lcp)(lds + koff);
#pragma unroll
          for (int d0 = 0; d0 < 4; ++d0) {
              const bf16x8 b0 = *(const __attribute__((address_space(3))) bf16x8*)(kb + d0 * 2048), b1 = *(const __attribute__((address_space(3))) bf16x8*)(kb + d0 * 2048 + 512);
              s0 = __builtin_amdgcn_mfma_f32_32x32x16_bf16(b0, qr[d0], s0, 0, 0, 0); s1 = __builtin_amdgcn_mfma_f32_32x32x16_bf16(b1, qr[d0], s1, 0, 0, 0); } }
        { asm volatile("s_nop 15\n\ts_nop 7" : "+v"(s0), "+v"(s1)); const float rm0 = rowmax32(s0, s1); mhat = rm0;
#pragma unroll
          for (int rr = 0; rr < 16; ++rr) { s0[rr] -= rm0; s1[rr] -= rm0; negm[rr] = -rm0; } }
        u32x4 pw[4];
#define EXP4(X, B) do { X[B] = __builtin_amdgcn_exp2f(X[B]); X[B + 1] = __builtin_amdgcn_exp2f(X[B + 1]); X[B + 2] = __builtin_amdgcn_exp2f(X[B + 2]); X[B + 3] = __builtin_amdgcn_exp2f(X[B + 3]); sacc += (X[B] + X[B + 1]) + (X[B + 2] + X[B + 3]); } while (0)
#define STAGE_A(t_) do { \
            lcp nxt = (lcp)(lds + (((t_) + 1) & 3) * DF_SLOT); \
            bf16x8 kf[8]; \
            _Pragma("unroll") for (int d0 = 0; d0 < 4; ++d0) { kf[2 * d0] = *(const __attribute__((address_space(3))) bf16x8*)(nxt + koff + d0 * 2048); kf[2 * d0 + 1] = *(const __attribute__((address_space(3))) bf16x8*)(nxt + koff + d0 * 2048 + 512); } \
            asm volatile("s_nop 15\n\ts_nop 7" : "+v"(s0), "+v"(s1)); \
            const float rm = rowmax32(s0, s1); \
            if (__any(rm > THRL)) { \
                const float dl = fmaxf(rm, 0.f); const float alpha = __builtin_amdgcn_exp2f(-dl); mhat += dl; lsum *= alpha; \
                if (hi == 0) wsf[r32] = alpha; \
                asm volatile("s_waitcnt lgkmcnt(0)" ::: "memory"); \
                float al[16]; \
                _Pragma("unroll") for (int r = 0; r < 16; ++r) al[r] = wsf[crow(r, hi)]; \
                _Pragma("unroll") for (int d = 0; d < 4; ++d) _Pragma("unroll") for (int r = 0; r < 16; ++r) o[d][r] *= al[r]; \
                _Pragma("unroll") for (int r = 0; r < 16; ++r) { s0[r] -= dl; s1[r] -= dl; negm[r] = -mhat; } \
            } \
            f32x16 n0, n1; float sacc = 0.f; \
            __builtin_amdgcn_sched_barrier(0); \
            n0 = __builtin_amdgcn_mfma_f32_32x32x16_bf16(kf[0], qr[0], negm, 0, 0, 0); EXP4(s0, 0);  __builtin_amdgcn_sched_barrier(0); \
            n1 = __builtin_amdgcn_mfma_f32_32x32x16_bf16(kf[1], qr[0], negm, 0, 0, 0); EXP4(s0, 4);  __builtin_amdgcn_sched_barrier(0); \
            n0 = __builtin_amdgcn_mfma_f32_32x32x16_bf16(kf[2], qr[1], n0, 0, 0, 0); EXP4(s0, 8);  __builtin_amdgcn_sched_barrier(0); \
            n1 = __builtin_amdgcn_mfma_f32_32x32x16_bf16(kf[3], qr[1], n1, 0, 0, 0); EXP4(s0, 12); __builtin_amdgcn_sched_barrier(0); \
            n0 = __builtin_amdgcn_mfma_f32_32x32x16_bf16(kf[4], qr[2], n0, 0, 0, 0); EXP4(s1, 0);  __builtin_amdgcn_sched_barrier(0); \
            n1 = __builtin_amdgcn_mfma_f32_32x32x16_bf16(kf[5], qr[2], n1, 0, 0, 0); EXP4(s1, 4);  __builtin_amdgcn_sched_barrier(0); \
            n0 = __builtin_amdgcn_mfma_f32_32x32x16_bf16(kf[6], qr[3], n0, 0, 0, 0); EXP4(s1, 8);  __builtin_amdgcn_sched_barrier(0); \
            n1 = __builtin_amdgcn_mfma_f32_32x32x16_bf16(kf[7], qr[3], n1, 0, 0, 0); EXP4(s1, 12); __builtin_amdgcn_sched_barrier(0); \
            _Pragma("unroll") for (int i = 0; i < 4; ++i) { pw[0][i] = cvtpk(s0[2 * i], s0[2 * i + 1]); pw[1][i] = cvtpk(s0[8 + 2 * i], s0[8 + 2 * i + 1]); pw[2][i] = cvtpk(s1[2 * i], s1[2 * i + 1]); pw[3][i] = cvtpk(s1[8 + 2 * i], s1[8 + 2 * i + 1]); } \
            lsum += sacc; \
            s0 = n0; s1 = n1; \
        } while (0)
#define STAGE_B(tl_) do { \
            lcp vb = (lcp)(lds + ((tl_) & 3) * DF_SLOT) + voff; \
            s16x4 va[8], vn[8]; \
            _Pragma("unroll") for (int ks = 0; ks < 4; ++ks) { va[2 * ks] = vtr(vb + ks * 1024); va[2 * ks + 1] = vtr(vb + ks * 1024 + 512); } \
            __builtin_amdgcn_sched_barrier(0); \
            _Pragma("unroll") for (int d0 = 0; d0 < 4; ++d0) { \
                _Pragma("unroll") for (int ks = 0; ks < 4; ++ks) { \
                    if (d0 < 3) { vn[2 * ks] = vtr(vb + (d0 + 1) * 4096 + ks * 1024); vn[2 * ks + 1] = vtr(vb + (d0 + 1) * 4096 + ks * 1024 + 512); } \
                    const bf16x8 vf = (bf16x8){va[2 * ks][0], va[2 * ks][1], va[2 * ks][2], va[2 * ks][3], va[2 * ks + 1][0], va[2 * ks + 1][1], va[2 * ks + 1][2], va[2 * ks + 1][3]}; \
                    o[d0] = __builtin_amdgcn_mfma_f32_32x32x16_bf16(__builtin_bit_cast(bf16x8, pw[ks]), vf, o[d0], 0, 0, 0); \
                    __builtin_amdgcn_sched_barrier(0); \
                } \
                _Pragma("unroll") for (int i = 0; i < 8; ++i) va[i] = vn[i]; \
            } \
        } while (0)
        for (int t = 0; t < NKT; ++t) {
            if (t > 0) { asm volatile("s_waitcnt vmcnt(0)" ::: "memory"); if (MODE != 3) __syncthreads(); }
            if (t + 2 < NKT) DF_DMA(t + 2, (t + 2) & 3);
            if (MODE != 2) {
                if (map == 1 && t > 0) STAGE_B(t - 1);
                STAGE_A(t);
                if (map == 0) STAGE_B(t);
            }
        }
        if (MODE != 2 && map == 1) STAGE_B(NKT - 1);
#undef STAGE_A
#undef STAGE_B
#undef EXP4
#undef DF_DMA
        float lt = lsum; { auto rr = __builtin_amdgcn_permlane32_swap(__float_as_uint(lt), __float_as_uint(lt), false, false); lt = __uint_as_float(rr[0]) + __uint_as_float(rr[1]); }
        if (hi == 0) wsf[32 + r32] = lt;
        asm volatile("s_waitcnt lgkmcnt(0)" ::: "memory");
#pragma unroll
        for (int rr = 0; rr < 16; ++rr) { const float rl = __builtin_amdgcn_rcpf(wsf[32 + crow(rr, hi)]);
#pragma unroll
            for (int d = 0; d < 4; ++d) o[d][rr] *= rl; }
        __syncthreads();
        if (map == 1) {
#pragma unroll
            for (int d = 0; d < 4; ++d)
#pragma unroll
                for (int rr = 0; rr < 16; ++rr) X[((qg * 4 + d) * 16 + rr) * 64 + lane] = o[d][rr];
        }
        __syncthreads();
        if (map == 0 && (MODE == 0 || lam == 123456.f)) {
            float ss[16];
#pragma unroll
            for (int rr = 0; rr < 16; ++rr) { float s = 0.f;
#pragma unroll
                for (int d = 0; d < 4; ++d) { const float v = o[d][rr] - lam * X[((qg * 4 + d) * 16 + rr) * 64 + lane]; o[d][rr] = v; s += v * v; }
                ss[rr] = s; }
#pragma unroll
            for (int oo = 1; oo < 32; oo <<= 1)
#pragma unroll
                for (int rr = 0; rr < 16; ++rr) ss[rr] += __shfl_xor(ss[rr], oo);
            float g[4];
#pragma unroll
            for (int d = 0; d < 4; ++d) g[d] = p.diff_subln[d * 32 + r32] * (1.f - LAMBDA_INIT);
            bf16_t* yb = Y + ((size_t)b * SEQ + q0) * D + 512 + h * 128 + r32;
#pragma unroll
            for (int rr = 0; rr < 16; ++rr) { const float rn = rsqrtf(ss[rr] * (1.f / 128.f) + EPS);
#pragma unroll
                for (int d = 0; d < 4; ++d) yb[(size_t)crow(rr, hi) * D + d * 32] = (bf16_t)f2bf(o[d][rr] * rn * g[d]); }
        }
        __syncthreads();
    }
}
}

__device__ __forceinline__ void p3_attention(Frame& F, const Params& p) {
    att::na_units(F, p);
    att::diff_units_v2<0>(F, p);
}

namespace tk {
typedef short bf16x8 __attribute__((ext_vector_type(8)));
typedef float f32x16 __attribute__((ext_vector_type(16)));
constexpr int WLK_OFF = 65536;
__device__ __forceinline__ unsigned ord(float f) { const unsigned u = __float_as_uint(f); return u ^ ((unsigned)((int)u >> 31) | 0x80000000u); }
__device__ __forceinline__ float unord(unsigned o) { return __uint_as_float(o ^ ((o & 0x80000000u) ? 0x80000000u : 0xFFFFFFFFu)); }
__device__ __forceinline__ void cs_desc(unsigned& a, unsigned& b) { const unsigned mx = a > b ? a : b, mn = a > b ? b : a; a = mx; b = mn; }
__device__ __forceinline__ void sort16_desc(unsigned (&v)[16]) {
#pragma unroll
    for (int k = 2; k <= 16; k <<= 1)
#pragma unroll
        for (int j = k >> 1; j > 0; j >>= 1)
#pragma unroll
            for (int i = 0; i < 16; ++i) { const int l = i ^ j; if (l > i) { if ((i & k) == 0 || k == 16) cs_desc(v[i], v[l]); else cs_desc(v[l], v[i]); } }
}
__device__ __forceinline__ void bmerge16_desc(unsigned (&v)[16]) {
#pragma unroll
    for (int j = 8; j > 0; j >>= 1)
#pragma unroll
        for (int i = 0; i < 16; ++i) { const int l = i ^ j; if (l > i) cs_desc(v[i], v[l]); }
}
__device__ __forceinline__ void merge_top16(unsigned (&a)[16], const unsigned (&b)[16]) {
#pragma unroll
    for (int i = 0; i < 16; ++i) a[i] = a[i] > b[15 - i] ? a[i] : b[15 - i];
    bmerge16_desc(a);
}
__device__ __forceinline__ void top16_of_64x2(unsigned (&v0)[16], unsigned (&v1)[16], unsigned (&v2)[16], unsigned (&v3)[16]) {
    sort16_desc(v0); sort16_desc(v1); sort16_desc(v2); sort16_desc(v3);
    merge_top16(v0, v1); merge_top16(v2, v3); merge_top16(v0, v2);
    unsigned pb[16];
#pragma unroll
    for (int i = 0; i < 16; ++i) pb[i] = (unsigned)__shfl_xor((int)v0[i], 32);
    merge_top16(v0, pb);
}
}

__device__ __forceinline__ void p7_topk(Frame& F, const Params& p) {
    using namespace tk;
    unsigned char* ws = p.ws;
    const bf16_t* Q2 = (const bf16_t*)(ws + WS_Q2); const unsigned char* KI = (const unsigned char*)(ws + WS_KEYSI);
    int* EX = (int*)(ws + WS_EXP); float* GT = (float*)(ws + WS_GATE); float* SUo = (float*)(ws + WS_SU);
    const float* USC = (const float*)(ws + WS_USC); const float* VSC = (const float*)(ws + WS_VSC);
    const int lane = F.lane, r32 = lane & 31, hi = lane >> 5, wave = F.wave;
    att::lp lds = (att::lp)F.lds;
    LAS int* W = (LAS int*)(F.lds + WLK_OFF + wave * 8192);
    const int ntask = 1024 / F.G;
    const int h = F.bid & 7;
    { const unsigned char* src = KI + (size_t)h * 65536;
      for (int k = 0; k < 8; ++k) { const int pi = wave + 8 * k; att::dma16(src + pi * 1024 + lane * 16, lds + pi * 1024); } }
    asm volatile("s_waitcnt vmcnt(0)" ::: "memory");
    __syncthreads();
    bf16x8 qf[8], qn[8];
    { const int tb32 = ((F.bid >> 3) * ntask) * 8 + wave;
      const bf16_t* qp = Q2 + ((((size_t)tb32 * 8 + h) * 2 + 0) * 8 * 2 + hi) * 256 + r32 * 8;
#pragma unroll
      for (int s = 0; s < 8; ++s) qn[s] = *(const bf16x8*)(qp + s * 512); }
    for (int ti = 0; ti < ntask; ++ti) {
        const int tb = (F.bid >> 3) * ntask + ti;
        const int t = tb * 256 + wave * 32 + r32;
        unsigned A[16], B[16];
#pragma unroll
        for (int pp = 0; pp < 2; ++pp) {
#pragma unroll
            for (int s = 0; s < 8; ++s) qf[s] = qn[s];
            { const int nti = pp == 0 ? ti : ti + 1, npp = pp ^ 1;
              if (nti < ntask) { const int tb32 = ((F.bid >> 3) * ntask + nti) * 8 + wave;
                  const bf16_t* qp = Q2 + ((((size_t)tb32 * 8 + h) * 2 + npp) * 8 * 2 + hi) * 256 + r32 * 8;
#pragma unroll
                  for (int s = 0; s < 8; ++s) qn[s] = *(const bf16x8*)(qp + s * 512); } }
            f32x16 acc[4];
#pragma unroll
            for (int kb = 0; kb < 4; ++kb)
#pragma unroll
                for (int r = 0; r < 16; ++r) acc[kb][r] = 0.f;
            att::lcp ab = (att::lcp)(lds + pp * 32768 + hi * 2048 + r32 * 16);
#pragma unroll
            for (int s = 0; s < 8; ++s)
#pragma unroll
                for (int kb = 0; kb < 4; ++kb) {
                    const bf16x8 a = *(const __attribute__((address_space(3))) bf16x8*)(ab + s * 4096 + kb * 512);
                    acc[kb] = __builtin_amdgcn_mfma_f32_32x32x16_bf16(a, qf[s], acc[kb], 0, 0, 0);
                }
            unsigned v0[16], v1[16], v2[16], v3[16];
#pragma unroll
            for (int r = 0; r < 16; ++r) {
                const int c = 127 - ((r & 3) + 8 * (r >> 2));
                v0[r] = (ord(acc[0][r]) & 0xFFFFFF80u) | (unsigned)(c - 0 - 4 * hi);
                v1[r] = (ord(acc[1][r]) & 0xFFFFFF80u) | (unsigned)(c - 32 - 4 * hi);
                v2[r] = (ord(acc[2][r]) & 0xFFFFFF80u) | (unsigned)(c - 64 - 4 * hi);
                v3[r] = (ord(acc[3][r]) & 0xFFFFFF80u) | (unsigned)(c - 96 - 4 * hi);
            }
            top16_of_64x2(v0, v1, v2, v3);
            if (pp == 0) {
#pragma unroll
                for (int i = 0; i < 16; ++i) A[i] = v0[i];
            } else {
#pragma unroll
                for (int i = 0; i < 16; ++i) B[i] = v0[i];
            }
        }
        float fa[16], fb[16];
#pragma unroll
        for (int i = 0; i < 16; ++i) { fa[i] = unord(A[i] & 0xFFFFFF80u); fb[i] = unord(B[i] & 0xFFFFFF80u);
            W[i * 64 + lane] = 127 - (int)(A[i] & 127u); W[(16 + i) * 64 + lane] = 127 - (int)(B[i] & 127u); }
        unsigned c0[16], c1[16], c2[16], c3[16];
#pragma unroll
        for (int j = 0; j < 16; ++j) c0[j] = (ord(fa[0] + fb[j]) & 0xFFFFFF00u) | (unsigned)(255 - j);
        {
            int n = 0;
#pragma unroll
            for (int i = 1; i < 16; ++i)
#pragma unroll
                for (int j = 0; j < 16; ++j) if ((i + 1) * (j + 1) <= 16) {
                    const unsigned key = (ord(fa[i] + fb[j]) & 0xFFFFFF00u) | (unsigned)(255 - (i * 16 + j));
                    if (n < 16) c1[n] = key; else if (n < 32) c2[n - 16] = key; else c3[n - 32] = key;
                    ++n;
                }
#pragma unroll
            for (int k = 2; k < 16; ++k) c3[k] = 0u;
        }
        sort16_desc(c1); sort16_desc(c2); sort16_desc(c3);
        merge_top16(c0, c1); merge_top16(c2, c3); merge_top16(c0, c2);
        float ev[16]; float l = 0.f; const float mx = unord(c0[0] & 0xFFFFFF00u);
#pragma unroll
        for (int k = 0; k < 16; ++k) { ev[k] = __expf(unord(c0[k] & 0xFFFFFF00u) - mx); l += ev[k]; }
        const float rl = 1.f / l;
        int ex[8]; float gt[8], su[8];
#pragma unroll
        for (int kk = 0; kk < 8; ++kk) {
            const unsigned key = hi ? c0[8 + kk] : c0[kk]; const float e = hi ? ev[8 + kk] : ev[kk];
            const int pos = 255 - (int)(key & 255u);
            ex[kk] = W[(pos >> 4) * 64 + lane] * 128 + W[(16 + (pos & 15)) * 64 + lane];
            gt[kk] = e * rl * VSC[ex[kk]]; su[kk] = USC[ex[kk]];
        }
        int* ep = EX + (size_t)t * 128 + h * 16 + hi * 8; float* gp = GT + (size_t)t * 128 + h * 16 + hi * 8;
        *(u32x4*)ep = (u32x4){(unsigned)ex[0], (unsigned)ex[1], (unsigned)ex[2], (unsigned)ex[3]}; *(u32x4*)(ep + 4) = (u32x4){(unsigned)ex[4], (unsigned)ex[5], (unsigned)ex[6], (unsigned)ex[7]};
        *(f32x4*)gp = (f32x4){gt[0], gt[1], gt[2], gt[3]}; *(f32x4*)(gp + 4) = (f32x4){gt[4], gt[5], gt[6], gt[7]};
        float* sp = SUo + (size_t)t * 128 + h * 16 + hi * 8;
        *(f32x4*)sp = (f32x4){su[0], su[1], su[2], su[3]}; *(f32x4*)(sp + 4) = (f32x4){su[4], su[5], su[6], su[7]};
    }
    __syncthreads();
}

#define P8_SYNC 0
#define HAVE_P3 1
#define HAVE_P7 1
struct Args { Params p; int ph_lo, ph_hi, li, pad; };
__global__ void __launch_bounds__(NTHR, 2) mk_fwd(Args a) {
    extern __shared__ __attribute__((aligned(16))) unsigned char lds[];
    Frame F;
    F.lds = (LAS unsigned char*)lds;
    F.MISC = (volatile LAS unsigned*)(F.lds + MISC_OFF);
    F.tid = threadIdx.x; F.lane = F.tid & 63; F.wave = __builtin_amdgcn_readfirstlane(F.tid >> 6);
    F.G = gridDim.x; F.bid = blockIdx.x;
    const Params& p = a.p;
    gu32* ctl = (gu32*)(p.ws + WS_CTL);
    for (int u = F.tid; u < 128; u += NTHR) ((LAS unsigned*)(F.lds + MISC_OFF))[u] = 0u;
    __syncthreads();
    XcdBarrier bar = xcd_barrier_post((unsigned*)(ctl + CW_BAR) + a.li * XCD_BAR_WORDS, F.MISC + 8);
    const int lo = a.ph_lo, hi = a.ph_hi;
#define IN(k) (lo <= (k) && (k) < hi)
#define SEAM(k) do { if (IN(k) && IN((k) + 1)) xcd_barrier(bar); } while (0)

#ifndef PROBE_DUP
#define PROBE_DUP -1
#endif
#define REP(k) for (int rep_ = 0; rep_ < (PROBE_DUP == (k) ? 2 : 1); ++rep_)
    if (IN(0)) { REP(0) p0_prologue(F, p); SEAM(0); }
    if (IN(1)) { REP(1) { p1_hrows(F, p); __syncthreads(); } SEAM(1); }
    if (IN(2)) {
        pg8::Gemm g{(const bf16_t*)(p.ws + WS_H), (const bf16_t*)(p.ws + WS_WIN), MALL, NQKV, D}; pg8::StaticOrder S; S.init(MALL, NQKV, F.G, F.bid);
        EpiQKVFast E{p.ws};
        REP(2) pg8::gemm_phase<EpiQKVFast, pg8::StaticOrder, true, true>(F.lds + RING_OFF, g, S, E);
        SEAM(2);
    }
#if HAVE_P3
    if (IN(3)) { REP(31) att::na_units(F, p); att::diff_units_v2<0>(F, p);
#if PROBE_DUP == 321
        att::diff_units_v2<1>(F, p);
#elif PROBE_DUP == 323
        att::diff_units_v2<3>(F, p);
#elif PROBE_DUP == 322
        att::diff_units_v2<2>(F, p);
#elif PROBE_DUP == 32
        att::diff_units_v2<0>(F, p);
#endif
        SEAM(3); }
#endif
    if (IN(4)) {
        pg8::Gemm g{(const bf16_t*)(p.ws + WS_Y), (const bf16_t*)(p.ws + WS_WOUT), MLAT, D, D}; pg8::StaticOrder S; S.init(MLAT, D, F.G, F.bid);
        pg8::EpiBf16<0> E{(bf16_t*)(p.ws + WS_YO), D, nullptr, 0, 0, 1.f};
        REP(4) pg8::gemm_phase<pg8::EpiBf16<0>, pg8::StaticOrder, true, true>(F.lds + RING_OFF, g, S, E);
        SEAM(4);
    }
    if (IN(5)) { REP(5) p5_rows2(F, p); SEAM(5); }
    if (IN(6)) {
        pg8::Gemm g{(const bf16_t*)(p.ws + WS_H2), (const bf16_t*)(p.ws + WS_WPQ), MLAT, 2048, D}; pg8::StaticOrder S; S.init(MLAT, 2048, F.G, F.bid);
        EpiQ2Frag E{(bf16_t*)(p.ws + WS_Q2)};
        REP(6) pg8::gemm_phase<EpiQ2Frag, pg8::StaticOrder, true, true>(F.lds + RING_OFF, g, S, E);
        SEAM(6);
    }
#if HAVE_P7
    if (IN(7)) { REP(7) p7_topk(F, p); SEAM(7); }
#endif
#if PROBE_DUP == 81
    if (IN(8)) { p8_gather<1>(F, p, bar); }
#endif
    if (IN(8)) { p8_gather<0>(F, p, bar); }
#undef IN
#undef SEAM
}

static void launch_mk(const Params& p, int lo, int hi, int li, hipStream_t stream) {
    Args a{}; a.p = p; a.ph_lo = lo; a.ph_hi = hi; a.li = li; a.pad = 0;
    hipLaunchKernelGGL(mk_fwd, dim3(256), dim3(NTHR), LDS_BYTES, stream, a);
}
extern "C" void kernel_launch(void* const* d_in, const int* in_sizes, int n_in, void* d_out, int out_size, void* d_ws, size_t ws_size, hipStream_t stream) {
    if (n_in != 16 || ws_size < WS_END) return;
    static bool attr_done = false;
    if (!attr_done) {
        (void)hipFuncSetAttribute((const void*)mk_fwd, hipFuncAttributeMaxDynamicSharedMemorySize, LDS_BYTES);
        attr_done = true;
    }
    Params p{};
    p.x = (const float*)d_in[0]; p.c = (const float*)d_in[1]; p.ctx = (const float*)d_in[2]; p.c_ctx = (const float*)d_in[3];
    p.w_ada = (const float*)d_in[4]; p.b_ada = (const float*)d_in[5]; p.g_norm = (const float*)d_in[6]; p.w_in = (const float*)d_in[7];
    p.rel_bias = (const float*)d_in[8]; p.diff_lambda = (const float*)d_in[9]; p.diff_subln = (const float*)d_in[10]; p.w_out = (const float*)d_in[11];
    p.peer_wq = (const float*)d_in[12]; p.peer_keys = (const float*)d_in[13]; p.peer_u = (const float*)d_in[14]; p.peer_v = (const float*)d_in[15];
    p.out = (float*)d_out; p.ws = (unsigned char*)d_ws;
    (void)hipMemsetAsync((char*)d_ws + WS_CTL, 0, CTL_ZERO_BYTES, stream);

    launch_mk(p, 0, 9, 0, stream);

}
```

```cpp
#include <hip/hip_runtime.h>
#include <stdint.h>
#include <math.h>

typedef unsigned short bf16_t;
typedef float f32x4 __attribute__((ext_vector_type(4)));
typedef unsigned u32x4 __attribute__((ext_vector_type(4)));
typedef unsigned u32x2 __attribute__((ext_vector_type(2)));
typedef float f32x2 __attribute__((ext_vector_type(2)));

constexpr int D = 1024, BATCH = 8, SEQ = 4096, CTX = 256, GW = 64;
constexpr int MLAT = BATCH * SEQ;
constexpr int MCTX = BATCH * CTX;
constexpr int MALL = MLAT + MCTX;
constexpr int NQKV = 3072;
constexpr int NKT = 68;
constexpr int NMOD = 6 * D;
constexpr int PE_H = 8, PE_NK = 128, PE_QD = 256, PE_TOPK = 16, PE_NEXP = 16384;
constexpr float EPS = 1e-6f;
constexpr float LOG2E = 1.4426950408889634f;
constexpr float C2 = 0.125f * LOG2E;
constexpr float LAMBDA_INIT = 0.2f;
constexpr float NEG_BIG = -30000.0f;

constexpr size_t MiB = 1u << 20;
constexpr size_t WS_CTL = 0;
constexpr size_t WS_MOD = 1 * MiB;
constexpr size_t WS_LAM = 1 * MiB + 256 * 1024;
constexpr size_t WS_ROPE = 1 * MiB + 512 * 1024;
constexpr size_t WS_USC = 1 * MiB + 640 * 1024;
constexpr size_t WS_VSC = 1 * MiB + 704 * 1024;
constexpr size_t WS_MODP = 2 * MiB;
constexpr size_t WS_BIAST = 4 * MiB;
constexpr size_t WS_KEYS = 5 * MiB;
constexpr size_t WS_KEYSI = 5 * MiB + 512 * 1024;
constexpr size_t WS_WIN = 6 * MiB;
constexpr size_t WS_WOUT = 12 * MiB;
constexpr size_t WS_WPQ = 14 * MiB;
constexpr size_t WS_UB = 18 * MiB;
constexpr size_t WS_VB = 50 * MiB;
constexpr size_t WS_EXP = 82 * MiB;
constexpr size_t WS_GATE = 98 * MiB;
constexpr size_t WS_H2 = 114 * MiB;
constexpr size_t WS_H = 178 * MiB;
constexpr size_t WS_Y = 178 * MiB;
constexpr size_t WS_QA = 246 * MiB;
constexpr size_t WS_KA = 278 * MiB;
constexpr size_t WS_VA = 312 * MiB;
constexpr size_t WS_QD = 346 * MiB;
constexpr size_t WS_KD = 378 * MiB;
constexpr size_t WS_VD = 412 * MiB;
constexpr size_t WS_YO = 246 * MiB;
constexpr size_t WS_Q2 = 246 * MiB;
constexpr size_t WS_PART = 178 * MiB;
constexpr size_t WS_DSCR = 464 * MiB;
constexpr size_t WS_SU = 446 * MiB;
constexpr size_t WS_END = 496 * MiB;

struct Params {
    const float *x, *c, *ctx, *c_ctx, *w_ada, *b_ada, *g_norm, *w_in, *rel_bias, *diff_lambda, *diff_subln, *w_out, *peer_wq, *peer_keys, *peer_u, *peer_v;
    float* out;
    unsigned char* ws;
};

__device__ __forceinline__ unsigned f2bf(float f) { unsigned u = __builtin_bit_cast(unsigned, f); return (u + 0x7fffu + ((u >> 16) & 1u)) >> 16; }
__device__ __forceinline__ unsigned pk2(float lo, float hi) { return f2bf(lo) | (f2bf(hi) << 16); }
__device__ __forceinline__ float bf2f(bf16_t h) { return __builtin_bit_cast(float, (unsigned)h << 16); }
__device__ __forceinline__ float bflo(unsigned w) { return __builtin_bit_cast(float, w << 16); }
__device__ __forceinline__ float bfhi(unsigned w) { return __builtin_bit_cast(float, w & 0xffff0000u); }
__device__ __forceinline__ float wave_sum(float v) {
    v += __uint_as_float((unsigned)__builtin_amdgcn_update_dpp(0, (int)__float_as_uint(v), 0xB1, 0xf, 0xf, false));
    v += __uint_as_float((unsigned)__builtin_amdgcn_update_dpp(0, (int)__float_as_uint(v), 0x4E, 0xf, 0xf, false));
    v += __uint_as_float((unsigned)__builtin_amdgcn_update_dpp(0, (int)__float_as_uint(v), 0x141, 0xf, 0xf, false));
    v += __uint_as_float((unsigned)__builtin_amdgcn_update_dpp(0, (int)__float_as_uint(v), 0x128, 0xf, 0xf, false));
    { auto r = __builtin_amdgcn_permlane16_swap(__float_as_uint(v), __float_as_uint(v), false, false); v = __uint_as_float(r[0]) + __uint_as_float(r[1]); }
    { auto r = __builtin_amdgcn_permlane32_swap(__float_as_uint(v), __float_as_uint(v), false, false); v = __uint_as_float(r[0]) + __uint_as_float(r[1]); }
    return v;
}
__device__ __forceinline__ float wave_max(float v) {
    v = fmaxf(v, __uint_as_float((unsigned)__builtin_amdgcn_update_dpp(0, (int)__float_as_uint(v), 0xB1, 0xf, 0xf, false)));
    v = fmaxf(v, __uint_as_float((unsigned)__builtin_amdgcn_update_dpp(0, (int)__float_as_uint(v), 0x4E, 0xf, 0xf, false)));
    v = fmaxf(v, __uint_as_float((unsigned)__builtin_amdgcn_update_dpp(0, (int)__float_as_uint(v), 0x141, 0xf, 0xf, false)));
    v = fmaxf(v, __uint_as_float((unsigned)__builtin_amdgcn_update_dpp(0, (int)__float_as_uint(v), 0x128, 0xf, 0xf, false)));
    { auto r = __builtin_amdgcn_permlane16_swap(__float_as_uint(v), __float_as_uint(v), false, false); v = fmaxf(__uint_as_float(r[0]), __uint_as_float(r[1])); }
    { auto r = __builtin_amdgcn_permlane32_swap(__float_as_uint(v), __float_as_uint(v), false, false); v = fmaxf(__uint_as_float(r[0]), __uint_as_float(r[1])); }
    return v;
}

__device__ __forceinline__ int ktile_off(int k, int d) { return (d >> 3) * 512 + k * 8 + (d & 7); }
__device__ __forceinline__ int vtile_off(int k, int d) { return (d >> 5) * 2048 + (k >> 4) * 512 + (k & 15) * 32 + (d & 31); }
__device__ __forceinline__ size_t qa_idx(int b, int h, int t, int d) { return ((size_t)(b * 8 + h) * SEQ + t) * 64 + d; }
__device__ __forceinline__ size_t ka_idx(int b, int h, int j, int d) { return ((size_t)(b * 8 + h) * NKT + (j >> 6)) * 4096 + ktile_off(j & 63, d); }
__device__ __forceinline__ size_t va_idx(int b, int h, int j, int d) { return ((size_t)(b * 8 + h) * NKT + (j >> 6)) * 4096 + vtile_off(j & 63, d); }
__device__ __forceinline__ size_t qd_idx(int b, int m, int h, int t, int d) { return ((size_t)((b * 2 + m) * 4 + h) * SEQ + t) * 64 + d; }
__device__ __forceinline__ size_t kd_idx(int b, int m, int h, int j, int d) { return ((size_t)((b * 2 + m) * 4 + h) * NKT + (j >> 6)) * 4096 + ktile_off(j & 63, d); }
__device__ __forceinline__ size_t vd_idx(int b, int h, int j, int d) { return ((size_t)(b * 4 + h) * NKT + (j >> 6)) * 8192 + vtile_off(j & 63, d); }


namespace pg8 {
#define PG8_LAS __attribute__((address_space(3)))
typedef unsigned short bf16_t;
typedef short bf16x8 __attribute__((ext_vector_type(8)));
typedef float f32x4 __attribute__((ext_vector_type(4)));
typedef unsigned u32x4 __attribute__((ext_vector_type(4)));
constexpr int BM = 256, BK = 64, HALF = 128, HTB = HALF * BK * 2  , STAGE_BYTES = 8 * HTB, NXCD = 8, WGM = 8;

__host__ __device__ __forceinline__ int lds_byte(int r, int c) { const int st = (r >> 4) * 2 + (c >> 5), rr = r & 15, cc = c & 31, ob = rr * 64 + cc * 2; return st * 1024 + (ob ^ (((ob >> 9) & 1) << 5)); }
__host__ __device__ __forceinline__ void stage_rc(int b, int& R, int& C) { const int st = b / 1024, sb = b % 1024, swz = sb ^ (((sb >> 9) & 1) << 5); R = (st >> 1) * 16 + swz / 64; C = (st & 1) * 32 + (swz % 64) / 2; }
__host__ __device__ __forceinline__ int perm32(int rho) { const int n = rho >> 4, i = rho & 15; return 8 * (i >> 2) + 4 * n + (i & 3); }

struct Unit { int pm, pn; };
struct Gemm { const bf16_t* A; const bf16_t* Bt; int M, N, K; };

struct StaticOrder {
    int nM, nN, nwg, G, c;
    __host__ __device__ void init(int M, int N, int G_, int c_) { nM = M / BM; nN = N / BM; nwg = nM * nN; G = G_; c = c_; }
    __host__ __device__ bool next(int i, Unit& u) const {
        const long L = (long)i * G + c; if (L >= nwg) return false;
        int wgid = (int)L; { const int q = nwg / NXCD, r = nwg % NXCD, xcd = wgid % NXCD, off = wgid / NXCD; wgid = (xcd < r ? xcd * (q + 1) : r * (q + 1) + (xcd - r) * q) + off; }
        const int nig = WGM * nN, gid = wgid / nig, fm = gid * WGM, gsz = (nM - fm) < WGM ? (nM - fm) : WGM;
        u.pm = fm + ((wgid % nig) % gsz); u.pn = (wgid % nig) / gsz; return true;
    }
    __device__ __forceinline__ void a_ready(const Unit&) const {}
    __device__ __forceinline__ void done(const Unit&) const {}
};

__device__ __forceinline__ unsigned cvt_pk_bf16(float lo, float hi) { unsigned r; asm volatile("v_cvt_pk_bf16_f32 %0, %1, %2" : "=v"(r) : "v"(lo), "v"(hi)); return r; }
typedef float f32x2 __attribute__((ext_vector_type(2)));
__device__ __forceinline__ f32x2 gelu_pk(f32x2 v) {
    const f32x2 av = __builtin_elementwise_abs(v), d = av * 0.2316418882f + 1.0f;
    f32x2 t; t.x = __builtin_amdgcn_rcpf(d.x); t.y = __builtin_amdgcn_rcpf(d.y);
    f32x2 q = t * 0.5307027145f + (-0.7265760135f); q = q * t + 0.7107068705f; q = q * t + (-0.142248368f); q = q * t + 0.127414796f; q = q * t;
    const f32x2 s = (v * v) * (-0.72134752044f);
    f32x2 e; e.x = __builtin_amdgcn_exp2f(s.x); e.y = __builtin_amdgcn_exp2f(s.y);
    const f32x2 m = v * (q * e), r = v - m;
    f32x2 o; o.x = v.x < 0.f ? m.x : r.x; o.y = v.y < 0.f ? m.y : r.y; return o;
}

template <int ACT  > struct EpiBf16 {
    static constexpr bool PERM = true, AFTER_DRAIN = false; static_assert(ACT == 0 || ACT == 1, "EpiBf16: ACT is 0 (none) or 1 (gelu_pk)");
    bf16_t* O; int ldc; const float* bias; int split_cols; size_t split_stride; float scale0;
    __device__ __forceinline__ void operator()(const f32x4 (&acc)[2][2][4][2], const Unit& u, int wr, int wc, int fr, int fq) const {
        const int row0 = u.pm * BM + wr * 64 + fr; int colt = u.pn * BM; bf16_t* base = O;
        float sc = 1.f; if (split_cols) { const int t = colt / split_cols; base += (size_t)t * split_stride; colt -= t * split_cols; if (t == 0) sc = scale0; }
        const int col0 = colt + wc * 32 + 8 * fq, bcol0 = u.pn * BM + wc * 32 + 8 * fq;
        f32x4 bv[2][2];
#pragma unroll
        for (int bj = 0; bj < 2; ++bj)
#pragma unroll
            for (int n = 0; n < 2; ++n) bv[bj][n] = bias ? *(const f32x4*)(bias + bcol0 + bj * HALF + 4 * n) : (f32x4){0.f, 0.f, 0.f, 0.f};
#pragma unroll
        for (int ai = 0; ai < 2; ++ai)
#pragma unroll
            for (int m = 0; m < 4; ++m) { bf16_t* rowp = base + (size_t)(row0 + ai * HALF + m * 16) * ldc + col0;
#pragma unroll
                for (int bj = 0; bj < 2; ++bj) { f32x4 v0 = acc[ai][bj][m][0] + bv[bj][0], v1 = acc[ai][bj][m][1] + bv[bj][1];
                    if (ACT == 1) { f32x2 a = gelu_pk((f32x2){v0[0], v0[1]}), b = gelu_pk((f32x2){v0[2], v0[3]}), c = gelu_pk((f32x2){v1[0], v1[1]}), d = gelu_pk((f32x2){v1[2], v1[3]});
                        v0 = (f32x4){a.x, a.y, b.x, b.y}; v1 = (f32x4){c.x, c.y, d.x, d.y}; }
                    v0 = v0 * sc; v1 = v1 * sc; u32x4 w; w.x = cvt_pk_bf16(v0[0], v0[1]); w.y = cvt_pk_bf16(v0[2], v0[3]); w.z = cvt_pk_bf16(v1[0], v1[1]); w.w = cvt_pk_bf16(v1[2], v1[3]);
                    *(u32x4*)(rowp + bj * HALF) = w; } }
    }
};

template <class Epi, class Sched, bool ALIGN_EPI = false, bool SP2 = false>
__device__ __forceinline__ void gemm_phase(PG8_LAS unsigned char* lds, const Gemm g, const Sched& S, const Epi& E) {
    const int tid = threadIdx.x, wid = __builtin_amdgcn_readfirstlane(tid >> 6), lane = tid & 63, wr = wid >> 2, wc = wid & 3, fr = lane & 15, fq = lane >> 4;
    const int K = g.K, nt = K / BK;
    unsigned voffA[2], voffB[2];
#pragma unroll
    for (int i = 0; i < 2; ++i) { int R, C; stage_rc(tid * 16 + i * 8192, R, C); const int Rb = Epi::PERM ? ((R & ~31) + perm32(R & 31)) : R;
        voffA[i] = (unsigned)(R * K + C) * 2u; voffB[i] = (unsigned)(Rb * K + C) * 2u; }
    const size_t kstep = (size_t)(BK * 2);
    const size_t hstep = (size_t)HALF * K * 2;
    const size_t tstep = 2 * hstep;
    const unsigned ldsw = (unsigned)wid * 1024u;
    const int aoff = lds_byte(wr * 64 + fr, fq * 8), boff = lds_byte(wc * 32 + fr, fq * 8);
#define PG8_SA(b, h) (((b) * 2 + (h)) * HTB)
#define PG8_SB(b, h) ((4 + (b) * 2 + (h)) * HTB)
#define PG8_STAGE(bufoff, gbase, voff) do { _Pragma("unroll") for (int _i = 0; _i < 2; ++_i) \
        __builtin_amdgcn_global_load_lds((const unsigned*)((const char*)(gbase) + (voff)[_i]), (PG8_LAS unsigned*)(lds + (bufoff) + ldsw + _i * 8192), 16, 0, 0); } while (0)
#define PG8_LDA(dst, b, h) do { _Pragma("unroll") for (int m = 0; m < 4; ++m) _Pragma("unroll") for (int k = 0; k < 2; ++k) dst[m][k] = *(const PG8_LAS bf16x8*)(lds + PG8_SA(b, h) + aoff + m * 2048 + k * 1024); } while (0)
#define PG8_LDB(dst, b, h) do { _Pragma("unroll") for (int n = 0; n < 2; ++n) _Pragma("unroll") for (int k = 0; k < 2; ++k) dst[n][k] = *(const PG8_LAS bf16x8*)(lds + PG8_SB(b, h) + boff + n * 2048 + k * 1024); } while (0)
#define PG8_MMA(ai, bj, At, Bt) do { __builtin_amdgcn_s_setprio(1); _Pragma("unroll") for (int m = 0; m < 4; ++m) _Pragma("unroll") for (int n = 0; n < 2; ++n) _Pragma("unroll") for (int k = 0; k < 2; ++k) \
        acc[ai][bj][m][n] = __builtin_amdgcn_mfma_f32_16x16x32_bf16(Bt[n][k], At[m][k], acc[ai][bj][m][n], 0, 0, 0); __builtin_amdgcn_s_setprio(0); } while (0)
#define PG8_WAIT_V(n) asm volatile("s_waitcnt vmcnt(" #n ")" ::: "memory")
#define PG8_WAIT_L(n) asm volatile("s_waitcnt lgkmcnt(" #n ")" ::: "memory")
#define PG8_BAR __builtin_amdgcn_s_barrier()
#define PG8_SCHED __builtin_amdgcn_sched_barrier(0)
    Unit cur, nxt; int ui = 0;
    if (!S.next(0, cur)) return;
    f32x4 acc[2][2][4][2];
#pragma unroll
    for (int a = 0; a < 2; ++a)
#pragma unroll
        for (int b = 0; b < 2; ++b)
#pragma unroll
            for (int m = 0; m < 4; ++m)
#pragma unroll
                for (int n = 0; n < 2; ++n) acc[a][b][m][n] = (f32x4){0.f, 0.f, 0.f, 0.f};
    bf16x8 At[4][2], B0[2][2], B1[2][2];
    const char* cA = (const char*)g.A + (size_t)cur.pm * tstep; const char* cB = (const char*)g.Bt + (size_t)cur.pn * tstep;
    S.a_ready(cur);
    if constexpr (SP2) {
        PG8_STAGE(PG8_SB(0, 0), cB, voffB); PG8_STAGE(PG8_SB(0, 1), cB + hstep, voffB); PG8_STAGE(PG8_SA(0, 0), cA, voffA); PG8_STAGE(PG8_SA(0, 1), cA + hstep, voffA);
        if (wr == 1) PG8_BAR;
        PG8_WAIT_V(2); PG8_BAR;
        PG8_STAGE(PG8_SB(1, 0), cB + kstep, voffB); PG8_STAGE(PG8_SA(1, 0), cA + kstep, voffA); PG8_STAGE(PG8_SB(1, 1), cB + hstep + kstep, voffB);
        PG8_WAIT_V(6); PG8_BAR;
    } else {
        PG8_STAGE(PG8_SB(0, 0), cB, voffB); PG8_STAGE(PG8_SA(0, 0), cA, voffA); PG8_STAGE(PG8_SB(0, 1), cB + hstep, voffB); PG8_STAGE(PG8_SA(0, 1), cA + hstep, voffA);
        if (wr == 1) PG8_BAR;
        PG8_WAIT_V(4); PG8_BAR;
        PG8_STAGE(PG8_SB(1, 0), cB + kstep, voffB); PG8_STAGE(PG8_SA(1, 0), cA + kstep, voffA); PG8_STAGE(PG8_SB(1, 1), cB + hstep + kstep, voffB);
        PG8_WAIT_V(6); PG8_BAR;
    }
    for (;;) {
        const bool has_next = S.next(ui + 1, nxt);
        const char* nA = has_next ? (const char*)g.A + (size_t)nxt.pm * tstep : cA; const char* nB = has_next ? (const char*)g.Bt + (size_t)nxt.pn * tstep : cB;
        for (int t = 0; t < nt; t += 2) {
            const bool last = (t == nt - 2);
            const char* a1 = cA + (size_t)(t + 1) * kstep;
            const char* a2 = last ? nA : cA + (size_t)(t + 2) * kstep; const char* b2 = last ? nB : cB + (size_t)(t + 2) * kstep;
            const char* a3 = a2 + kstep; const char* b3 = b2 + kstep;
            if (last && has_next) S.a_ready(nxt);
            if constexpr (SP2) {
            PG8_LDB(B0, 0, 0); PG8_LDB(B1, 0, 1); PG8_SCHED; PG8_LDA(At, 0, 0); PG8_STAGE(PG8_SA(1, 1), a1 + hstep, voffA);
            PG8_WAIT_V(8); PG8_WAIT_L(0); PG8_BAR; PG8_MMA(0, 0, At, B0); PG8_MMA(0, 1, At, B1); PG8_BAR; PG8_SCHED;
            PG8_LDA(At, 0, 1); PG8_STAGE(PG8_SB(0, 0), b2, voffB); PG8_STAGE(PG8_SB(0, 1), b2 + hstep, voffB); PG8_STAGE(PG8_SA(0, 0), a2, voffA);
            PG8_WAIT_V(8); PG8_WAIT_L(0); PG8_BAR; PG8_MMA(1, 0, At, B0); PG8_MMA(1, 1, At, B1); PG8_BAR; PG8_SCHED;
            PG8_LDB(B0, 1, 0); PG8_LDB(B1, 1, 1); PG8_SCHED; PG8_LDA(At, 1, 0); PG8_STAGE(PG8_SA(0, 1), a2 + hstep, voffA);
            PG8_WAIT_V(8); PG8_WAIT_L(0); PG8_BAR; PG8_MMA(0, 0, At, B0); PG8_MMA(0, 1, At, B1); PG8_BAR; PG8_SCHED;
            PG8_LDA(At, 1, 1); PG8_STAGE(PG8_SB(1, 0), b3, voffB); PG8_STAGE(PG8_SB(1, 1), b3 + hstep, voffB); PG8_STAGE(PG8_SA(1, 0), a3, voffA);
            PG8_WAIT_V(8); PG8_WAIT_L(0); PG8_BAR; PG8_MMA(1, 0, At, B0); PG8_MMA(1, 1, At, B1); PG8_BAR; PG8_SCHED;
            } else {
            PG8_LDB(B0, 0, 0); PG8_SCHED; PG8_LDA(At, 0, 0); PG8_STAGE(PG8_SA(1, 1), a1 + hstep, voffA);
            PG8_WAIT_L(8); PG8_BAR; PG8_WAIT_L(0); PG8_MMA(0, 0, At, B0); PG8_BAR; PG8_SCHED;
            PG8_LDB(B1, 0, 1); PG8_STAGE(PG8_SB(0, 0), b2, voffB);
            PG8_BAR; PG8_WAIT_L(0); PG8_MMA(0, 1, At, B1); PG8_BAR;
            PG8_LDA(At, 0, 1); PG8_STAGE(PG8_SA(0, 0), a2, voffA);
            PG8_BAR; PG8_WAIT_L(0); PG8_MMA(1, 0, At, B0); PG8_BAR; PG8_SCHED;
            PG8_STAGE(PG8_SB(0, 1), b2 + hstep, voffB);
            PG8_WAIT_V(6); PG8_BAR; PG8_MMA(1, 1, At, B1); PG8_BAR;
            PG8_LDB(B0, 1, 0); PG8_SCHED; PG8_LDA(At, 1, 0); PG8_STAGE(PG8_SA(0, 1), a2 + hstep, voffA);
            PG8_WAIT_L(8); PG8_BAR; PG8_WAIT_L(0); PG8_MMA(0, 0, At, B0); PG8_BAR; PG8_SCHED;
            PG8_LDB(B1, 1, 1); PG8_STAGE(PG8_SB(1, 0), b3, voffB);
            PG8_BAR; PG8_WAIT_L(0); PG8_MMA(0, 1, At, B1); PG8_BAR;
            PG8_LDA(At, 1, 1); PG8_STAGE(PG8_SA(1, 0), a3, voffA);
            PG8_BAR; PG8_WAIT_L(0); PG8_MMA(1, 0, At, B0); PG8_BAR; PG8_SCHED;
            PG8_STAGE(PG8_SB(1, 1), b3 + hstep, voffB);
            PG8_WAIT_V(6); PG8_BAR; PG8_MMA(1, 1, At, B1); PG8_BAR;
            }
        }
        if constexpr (ALIGN_EPI) { if (wr == 0) PG8_BAR; }
        if constexpr (!Epi::AFTER_DRAIN) { E(acc, cur, wr, wc, fr, fq); S.done(cur); }
        if (!has_next) break;
#pragma unroll
        for (int a = 0; a < 2; ++a)
#pragma unroll
            for (int b = 0; b < 2; ++b)
#pragma unroll
                for (int m = 0; m < 4; ++m)
#pragma unroll
                    for (int n = 0; n < 2; ++n) acc[a][b][m][n] = (f32x4){0.f, 0.f, 0.f, 0.f};
        cur = nxt; cA = nA; cB = nB; ++ui;
        if constexpr (ALIGN_EPI) { if (wr == 1) PG8_BAR; }
    }
    PG8_WAIT_V(0);
    if constexpr (!ALIGN_EPI) { if (wr == 0) PG8_BAR; }
    PG8_BAR;
    if constexpr (Epi::AFTER_DRAIN) { E.fused(acc, cur, wr, wc, fr, fq, lds, wid, lane); S.done(cur); }
#undef PG8_SA
#undef PG8_SB
#undef PG8_STAGE
#undef PG8_LDA
#undef PG8_LDB
#undef PG8_MMA
#undef PG8_WAIT_V
#undef PG8_WAIT_L
#undef PG8_BAR
#undef PG8_SCHED
}
}

#define GAS __attribute__((address_space(1)))
#define LAS __attribute__((address_space(3)))
typedef unsigned v4u __attribute__((ext_vector_type(4)));
typedef float f32x4 __attribute__((ext_vector_type(4)));
typedef short bf16x8 __attribute__((ext_vector_type(8)));
typedef GAS unsigned gu32;
typedef GAS unsigned long long gu64;
#define RLX_AGENT __ATOMIC_RELAXED, __HIP_MEMORY_SCOPE_AGENT
#define LDS_WAIT() asm volatile("s_waitcnt lgkmcnt(0)" ::: "memory")
#define VM_WAIT() asm volatile("s_waitcnt vmcnt(0)" ::: "memory")
__device__ __forceinline__ unsigned long long rt() { return __builtin_amdgcn_s_memrealtime(); }

#define XB_TMO      128
#define XB_XCNT(j)  (256  + 64 * (j))
#define XB_XSUB(j)  (1280 + 64 * (j))
#define XB_XGEN(j)  (2304 + 64 * (j))
#define XB_TOP      3328
#define XB_TOPGEN   3392
#define XCD_BAR_WORDS 3456
#define XB_SPIN_CAP (1u << 18)

__device__ __forceinline__ unsigned xb_ld(unsigned* p)              { return __hip_atomic_load(p, __ATOMIC_RELAXED, __HIP_MEMORY_SCOPE_AGENT); }
__device__ __forceinline__ unsigned xb_add(unsigned* p, unsigned v) { return __hip_atomic_fetch_add(p, v, __ATOMIC_RELAXED, __HIP_MEMORY_SCOPE_AGENT); }
__device__ __forceinline__ unsigned xb_xcc_id() { return (unsigned)__builtin_amdgcn_s_getreg((3 << 11) | 20) & 0xFu; }
#define XB_SPIN(cond, bar) do { unsigned _sp = 0; while (cond) { __builtin_amdgcn_s_sleep(1); \
    if ((++_sp & 255u) == 0u) { if (xb_ld(&(bar)[XB_TMO])) break; if (_sp > XB_SPIN_CAP) { atomicAdd(&(bar)[XB_TMO], 1u); break; } } } } while (0)

struct XcdBarrier {
    unsigned* bar; unsigned x;
    volatile LAS unsigned* st;
};

__device__ __forceinline__ XcdBarrier xcd_barrier_post(unsigned* bar, volatile LAS unsigned* st) {
    XcdBarrier b; b.bar = bar; b.x = xb_xcc_id(); b.st = st;
    if (threadIdx.x == 0) (void)xb_add(&bar[XB_XCNT(b.x)], 1u);
    return b;
}
__device__ __forceinline__ void xcd_barrier_complete(unsigned* bar, unsigned x, unsigned& nloc, unsigned& nx) {
    const unsigned G = gridDim.x * gridDim.y * gridDim.z;
    unsigned sum, cnt, mine, sp = 0u;
    for (;;) {
        sum = 0u; cnt = 0u; mine = 0u;
#pragma unroll
        for (unsigned j = 0; j < 16; ++j) { const unsigned c = xb_ld(&bar[XB_XCNT(j)]); sum += c; cnt += (c > 0u) ? 1u : 0u; mine = (j == x) ? c : mine; }
        if (sum == G) break;
        __builtin_amdgcn_s_sleep(1);
        if ((++sp & 255u) == 0u) { if (xb_ld(&bar[XB_TMO])) break; if (sp > XB_SPIN_CAP) { atomicAdd(&bar[XB_TMO], 1u); break; } }
    }
    nloc = mine > 0u ? mine : 1u; nx = cnt > 0u ? cnt : 1u;
}

__device__ __forceinline__ void xcd_barrier(const XcdBarrier& b) {
    asm volatile("s_waitcnt vmcnt(0)" ::: "memory");
    __syncthreads();
    if (threadIdx.x == 0) {
        unsigned* bar = b.bar;
        __builtin_amdgcn_s_waitcnt(0);
        unsigned nloc = b.st[0], nx = b.st[1];
        if (nloc == 0u) { xcd_barrier_complete(bar, b.x, nloc, nx); b.st[0] = nloc; b.st[1] = nx; }
        const unsigned old = xb_add(&bar[XB_XSUB(b.x)], 1u);
        const unsigned gen = old / nloc;
        if (old + 1u == (gen + 1u) * nloc) {
            __builtin_amdgcn_fence(__ATOMIC_RELEASE, "agent");
            asm volatile("s_waitcnt vmcnt(0)" ::: "memory");
            const unsigned og = xb_add(&bar[XB_TOP], 1u);
            const unsigned tg = og / nx;
            if (og + 1u == (tg + 1u) * nx) xb_add(&bar[XB_TOPGEN], 1u);
            else XB_SPIN(xb_ld(&bar[XB_TOPGEN]) == tg, bar);
            __builtin_amdgcn_fence(__ATOMIC_ACQUIRE, "agent");
            xb_add(&bar[XB_XGEN(b.x)], 1u);
            asm volatile("s_waitcnt vmcnt(0)" ::: "memory");
        } else {
            XB_SPIN(xb_ld(&bar[XB_XGEN(b.x)]) == gen, bar);
            __builtin_amdgcn_fence(__ATOMIC_ACQUIRE, "agent");
            asm volatile("s_waitcnt vmcnt(0)" ::: "memory");
        }
    }
    __syncthreads();
}

constexpr int NWAVES = 8, NTHR = 512;
constexpr int RING_OFF = 0, RING_BYTES = 131072;
constexpr int LDS_BYTES = 159744;
constexpr int MISC_OFF = LDS_BYTES - 512;
constexpr size_t CTL_ZERO_BYTES = 65536;
constexpr int CW_P8CTR = 2048;
constexpr int CW_BAR = 4096;

struct Frame {
    LAS unsigned char* lds;
    volatile LAS unsigned* MISC;
    int tid, lane, wave, G, bid;
};

__device__ __forceinline__ void p0_transpose_item(const float* W, int K, int N, bf16_t* WT, LAS float* scr, int item, int lane) {
    const int nblk = N / 32, kb = item / nblk, nb = item % nblk, k0 = 64 * kb, n0 = 32 * nb;
    float tv[32];
#pragma unroll
    for (int i = 0; i < 32; ++i) tv[i] = W[(size_t)(k0 + 2 * i + (lane >> 5)) * N + n0 + (lane & 31)];
#pragma unroll
    for (int i = 0; i < 32; ++i) scr[(2 * i + (lane >> 5)) * 33 + (lane & 31)] = tv[i];
    LDS_WAIT(); asm volatile("" ::: "memory");
    const int c = lane & 7;
#pragma unroll
    for (int j = 0; j < 4; ++j) { const int n = (lane >> 3) + 8 * j; const LAS float* s = scr + (8 * c) * 33 + n;
        v4u o; o.x = pk2(s[0 * 33], s[1 * 33]); o.y = pk2(s[2 * 33], s[3 * 33]); o.z = pk2(s[4 * 33], s[5 * 33]); o.w = pk2(s[6 * 33], s[7 * 33]);
        *(GAS v4u*)(WT + (size_t)(n0 + n) * K + k0 + 8 * c) = o; }
    LDS_WAIT(); asm volatile("" ::: "memory");
}
__device__ __forceinline__ void cvt_stream(const float* src, bf16_t* dst, size_t n4, size_t gtid, size_t gsz) {
    for (size_t i = gtid; i < n4; i += gsz) { const f32x4 v = ((const f32x4*)src)[i]; u32x2 o; o.x = pk2(v.x, v.y); o.y = pk2(v.z, v.w); ((u32x2*)dst)[i] = o; }
}
__device__ __forceinline__ void p0_prologue(Frame& F, const Params& p) {
    unsigned char* ws = p.ws;
    for (int item = F.bid; item < 192; item += F.G) {
        LAS float* sil = (LAS float*)(F.lds);
        LAS float* red = (LAS float*)(F.lds + 8192);
        const int ks = item / 24, cc = item % 24;
        for (int i = F.tid; i < 9 * 128; i += NTHR) { const int r = i >> 7, k = ks * 128 + (i & 127); const float v = r < 8 ? p.c[r * 1024 + k] : p.c_ctx[k]; sil[i] = v / (1.f + __expf(-v)); }
        __syncthreads();
        f32x4 acc[9];
#pragma unroll
        for (int r = 0; r < 9; ++r) acc[r] = (f32x4){0.f, 0.f, 0.f, 0.f};
        const float* wp = p.w_ada + (size_t)(ks * 128 + F.wave * 16) * NMOD + cc * 256 + F.lane * 4;
#pragma unroll 4
        for (int kk = 0; kk < 16; ++kk) { const f32x4 w = *(const f32x4*)(wp + (size_t)kk * NMOD);
#pragma unroll
            for (int r = 0; r < 9; ++r) acc[r] += w * sil[r * 128 + F.wave * 16 + kk]; }
#pragma unroll
        for (int r = 0; r < 9; ++r) *(LAS f32x4*)(red + ((F.wave * 9 + r) * 256 + F.lane * 4)) = acc[r];
        __syncthreads();
        float* modp = (float*)(ws + WS_MODP);
        for (int i = F.tid; i < 9 * 256; i += NTHR) { const int r = i >> 8, c = i & 255; float s = 0.f;
#pragma unroll
            for (int w = 0; w < 8; ++w) s += red[(w * 9 + r) * 256 + c];
            modp[(size_t)(ks * 9 + r) * NMOD + cc * 256 + c] = s; }
        __syncthreads();
    }
    {
        LAS float* scr = (LAS float*)(F.lds + F.wave * 16384);
        const int gw = F.bid * NWAVES + F.wave, NGW = F.G * NWAVES;
        constexpr int I_IN = 16 * 96, I_OUT = 16 * 32, I_PQ = 16 * 64;
        for (int it = gw; it < I_IN + I_OUT + I_PQ; it += NGW) {
            int r = it;
            if (r < I_IN) { p0_transpose_item(p.w_in, D, NQKV, (bf16_t*)(ws + WS_WIN), scr, r, F.lane); continue; } r -= I_IN;
            if (r < I_OUT) { p0_transpose_item(p.w_out, D, D, (bf16_t*)(ws + WS_WOUT), scr, r, F.lane); continue; } r -= I_OUT;
            p0_transpose_item(p.peer_wq, D, 2048, (bf16_t*)(ws + WS_WPQ), scr, r, F.lane);
        }
    }
    const size_t gtid = (size_t)F.bid * NTHR + F.tid, gsz = (size_t)F.G * NTHR;
    cvt_stream(p.peer_keys, (bf16_t*)(ws + WS_KEYS), (size_t)8 * 2 * 128 * 128 / 4, gtid, gsz);
    { bf16_t* ki = (bf16_t*)(ws + WS_KEYSI);
      for (int i = (int)gtid; i < 8 * 2 * 16 * 128; i += (int)gsz) { const int key = i & 127, c = (i >> 7) & 15, hp = i >> 11;
          const float* sp = p.peer_keys + ((size_t)hp * 128 + key) * 128 + c * 8; const f32x4 a = *(const f32x4*)sp, b = *(const f32x4*)(sp + 4);
          u32x4 o; o.x = pk2(a.x, a.y); o.y = pk2(a.z, a.w); o.z = pk2(b.x, b.y); o.w = pk2(b.z, b.w); *(u32x4*)(ki + (size_t)i * 8) = o; } }
    {
        const int gw = F.bid * NWAVES + F.wave, NGW = F.G * NWAVES;
        for (int rr0 = gw * 4; rr0 < 2 * PE_NEXP; rr0 += NGW * 4) {
            f32x4 v[4][4]; float am[4];
#pragma unroll
            for (int q = 0; q < 4; ++q) { const int rr = rr0 + q, tbl = rr >= PE_NEXP, row = rr - tbl * PE_NEXP; const float* src = (tbl ? p.peer_v : p.peer_u) + (size_t)row * D;
#pragma unroll
                for (int j = 0; j < 4; ++j) v[q][j] = ((const f32x4*)src)[F.lane + 64 * j]; }
#pragma unroll
            for (int q = 0; q < 4; ++q) { float a = 0.f;
#pragma unroll
                for (int j = 0; j < 4; ++j) a = fmaxf(a, fmaxf(fmaxf(fabsf(v[q][j].x), fabsf(v[q][j].y)), fmaxf(fabsf(v[q][j].z), fabsf(v[q][j].w))));
                am[q] = wave_max(a); }
#pragma unroll
            for (int q = 0; q < 4; ++q) { const int rr = rr0 + q, tbl = rr >= PE_NEXP, row = rr - tbl * PE_NEXP;
                int e = am[q] > 0.f ? (int)floorf(log2f(240.f / am[q])) : 0; e = e < -100 ? -100 : (e > 100 ? 100 : e);
                const float sc = ldexpf(1.f, e);
                u32x4 o;
#pragma unroll
                for (int j = 0; j < 4; ++j) { int w = __builtin_amdgcn_cvt_pk_fp8_f32(v[q][j].x * sc, v[q][j].y * sc, 0, false); w = __builtin_amdgcn_cvt_pk_fp8_f32(v[q][j].z * sc, v[q][j].w * sc, w, true); o[j] = (unsigned)w; }
                *(u32x4*)(ws + (tbl ? WS_VB : WS_UB) + (size_t)row * 1024 + F.lane * 16) = o;
                if (F.lane == 0) ((float*)(ws + (tbl ? WS_VSC : WS_USC)))[row] = ldexpf(1.f, -e); }
        }
    }
    if (gtid == 0) {
        float s01 = 0.f, s23 = 0.f;
        for (int i = 0; i < 64; ++i) { s01 += p.diff_lambda[i] * p.diff_lambda[64 + i]; s23 += p.diff_lambda[128 + i] * p.diff_lambda[192 + i]; }
        *(float*)(ws + WS_LAM) = expf(s01) - expf(s23) + LAMBDA_INIT;
    }
    float* rope = (float*)(ws + WS_ROPE);
    for (int i = (int)gtid; i < 64 * 16; i += (int)gsz) { const int pos = i >> 4, f = i & 15; const float inv = exp2f(-(float)f * (13.287712379549449f / 16.f)); const float a = (float)pos * inv; rope[2 * i] = cosf(a); rope[2 * i + 1] = sinf(a); }
    bf16_t* bt = (bf16_t*)(ws + WS_BIAST);
    for (int i = (int)gtid; i < 8 * 15 * 4096; i += (int)gsz) {
        const int j = i & 7, kc = (i >> 3) & 63, cq = (i >> 9) & 7, hd = i >> 12, dr = hd % 15, h = hd / 15;
        const int cp = cq * 8 + j; int cs = cp - 8; cs = cs < 0 ? 0 : (cs > 48 ? 48 : cs);
        float v = NEG_BIG;
        if (kc >= cs && kc < cs + 16) v = p.rel_bias[(h * 15 + dr) * 31 + (kc - cp + 15)] * LOG2E;
        bt[i] = (bf16_t)f2bf(v);
    }
}

__device__ __forceinline__ void p1_hrows(Frame& F, const Params& p) {
    unsigned char* ws = p.ws;
    const float* modp = (const float*)(ws + WS_MODP);
    float* mod = (float*)(ws + WS_MOD);
    for (int i = F.bid * NTHR + F.tid; i < 9 * NMOD; i += F.G * NTHR) { float s = p.b_ada[i % NMOD];
#pragma unroll
        for (int ks = 0; ks < 8; ++ks) s += modp[(size_t)ks * 9 * NMOD + i];
        mod[i] = s; }
    const int rows_per = (MALL + F.G - 1) / F.G, r0 = F.bid * rows_per, r1 = min(MALL, r0 + rows_per);
    if (r0 >= r1) return;
    const int mr_lo = r0 < MLAT ? (r0 >> 12) : 8;
    LAS float* tab = (LAS float*)F.lds;
    for (int i = F.tid; i < 2 * 2048; i += NTHR) {
        const int which = i >> 11, ss = (i >> 10) & 1, col = i & 1023; const int mr = min(8, mr_lo + which);
        const int mi = mr * NMOD + (ss == 0 ? D : 0) + col;
        float s = p.b_ada[(ss == 0 ? D : 0) + col];
#pragma unroll
        for (int ks = 0; ks < 8; ++ks) s += modp[(size_t)ks * 9 * NMOD + mi];
        tab[i] = ss == 0 ? p.g_norm[col] * (1.f + s) : s;
    }
    __syncthreads();
    bf16_t* H = (bf16_t*)(ws + WS_H);
    f32x4 nx[2][4];
#define P1_LOAD(dst, rowa_) do { _Pragma("unroll") for (int q = 0; q < 2; ++q) { const int row = min((rowa_) + q * NWAVES, MALL - 1); \
            const float* xr = row < MLAT ? p.x + (size_t)row * D : p.ctx + (size_t)(row - MLAT) * D; \
            _Pragma("unroll") for (int j = 0; j < 4; ++j) dst[q][j] = ((const f32x4*)xr)[F.lane + 64 * j]; } } while (0)
    P1_LOAD(nx, r0 + F.wave);
    for (int rowa = r0 + F.wave; rowa < r1; rowa += 2 * NWAVES) {
        f32x4 v[2][4]; float ssq[2];
#pragma unroll
        for (int q = 0; q < 2; ++q)
#pragma unroll
            for (int j = 0; j < 4; ++j) v[q][j] = nx[q][j];
        if (rowa + 2 * NWAVES < r1) P1_LOAD(nx, rowa + 2 * NWAVES);
#pragma unroll
        for (int q = 0; q < 2; ++q) { float s = 0.f;
#pragma unroll
            for (int j = 0; j < 4; ++j) s += v[q][j].x * v[q][j].x + v[q][j].y * v[q][j].y + v[q][j].z * v[q][j].z + v[q][j].w * v[q][j].w;
            ssq[q] = wave_sum(s); }
#pragma unroll
        for (int q = 0; q < 2; ++q) { const int row = rowa + q * NWAVES; if (row < r1) {
            const int mr = row < MLAT ? (row >> 12) : 8; const LAS float* tb = tab + (mr - mr_lo) * 2048;
            const float rstd = rsqrtf(ssq[q] * (1.f / D) + EPS);
#pragma unroll
            for (int j = 0; j < 4; ++j) { const int col = (F.lane + 64 * j) * 4;
                const f32x4 sc = *(const LAS f32x4*)(tb + col), sh = *(const LAS f32x4*)(tb + 1024 + col);
                const f32x4 y = (v[q][j] * rstd) * sc + sh;
                u32x2 o; o.x = pk2(y.x, y.y); o.y = pk2(y.z, y.w);
                *(u32x2*)(H + (size_t)row * D + col) = o; } } }
    }
#undef P1_LOAD
}

struct EpiQKVFast {
    static constexpr bool PERM = true, AFTER_DRAIN = false;
    unsigned char* ws;
    __device__ __forceinline__ void operator()(const pg8::f32x4 (&acc)[2][2][4][2], const pg8::Unit& u, int wr, int wc, int fr, int fq) const {
        const bool lat = u.pm < 128;
        const int kind = u.pn >> 1;
        if (!lat && (kind == 0 || kind == 3)) return;
        const int b = lat ? (u.pm >> 4) : (u.pm - 128);
        const int tb = lat ? (u.pm & 15) * 256 : 0;
        const float* rope = (const float*)(ws + WS_ROPE);
#pragma unroll
        for (int bj = 0; bj < 2; ++bj) {
            const int cc = (u.pn & 1) * 256 + bj * 128 + wc * 32 + 8 * fq;
#pragma unroll
            for (int ai = 0; ai < 2; ++ai)
#pragma unroll
                for (int m = 0; m < 4; ++m) {
                    const int rowin = ai * 128 + wr * 64 + m * 16 + fr;
                    const int t = tb + rowin;
                    const int j = lat ? 256 + t : rowin;
                    f32x4 v0 = acc[ai][bj][m][0], v1 = acc[ai][bj][m][1];
                    bf16_t* dst;
                    if (kind == 0) { dst = (bf16_t*)(ws + WS_QA) + qa_idx(b, cc >> 6, t, cc & 63); v0 = v0 * C2; v1 = v1 * C2; }
                    else if (kind == 1) dst = (bf16_t*)(ws + WS_KA) + ka_idx(b, cc >> 6, j, cc & 63);
                    else if (kind == 2) dst = (bf16_t*)(ws + WS_VA) + va_idx(b, cc >> 6, j, cc & 63);
                    else if (kind == 5) dst = (bf16_t*)(ws + WS_VD) + vd_idx(b, cc >> 7, j, cc & 127);
                    else {
                        const int mm = cc >> 8, h = (cc >> 6) & 3, d = cc & 63;
                        if (lat) { const int i0 = d >> 1; const int pos = i0 < 16 ? (t >> 6) : (t & 63); const float* rp = rope + (pos * 16 + (i0 & 15)) * 2;
                            const f32x4 r0 = *(const f32x4*)rp, r1 = *(const f32x4*)(rp + 4);
                            f32x4 a0, a1;
                            a0.x = v0.x * r0.x - v0.y * r0.y; a0.y = v0.x * r0.y + v0.y * r0.x; a0.z = v0.z * r0.z - v0.w * r0.w; a0.w = v0.z * r0.w + v0.w * r0.z;
                            a1.x = v1.x * r1.x - v1.y * r1.y; a1.y = v1.x * r1.y + v1.y * r1.x; a1.z = v1.z * r1.z - v1.w * r1.w; a1.w = v1.z * r1.w + v1.w * r1.z;
                            v0 = a0; v1 = a1; }
                        if (kind == 3) { dst = (bf16_t*)(ws + WS_QD) + qd_idx(b, mm, h, t, d); v0 = v0 * C2; v1 = v1 * C2; }
                        else dst = (bf16_t*)(ws + WS_KD) + kd_idx(b, mm, h, j, d);
                    }
                    pg8::u32x4 w; w.x = pg8::cvt_pk_bf16(v0[0], v0[1]); w.y = pg8::cvt_pk_bf16(v0[2], v0[3]); w.z = pg8::cvt_pk_bf16(v1[0], v1[1]); w.w = pg8::cvt_pk_bf16(v1[2], v1[3]);
                    *(pg8::u32x4*)dst = w;
                }
        }
    }
};


struct EpiQ2Frag {
    static constexpr bool PERM = true, AFTER_DRAIN = false;
    bf16_t* O;
    __device__ __forceinline__ void operator()(const pg8::f32x4 (&acc)[2][2][4][2], const pg8::Unit& u, int wr, int wc, int fr, int fq) const {
        const int h = u.pn;
#pragma unroll
        for (int bj = 0; bj < 2; ++bj) {
            const int c8 = wc * 4 + fq;
#pragma unroll
            for (int ai = 0; ai < 2; ++ai)
#pragma unroll
                for (int m = 0; m < 4; ++m) {
                    const int row = u.pm * 256 + ai * 128 + wr * 64 + m * 16 + fr;
                    const size_t idx = ((((((size_t)(row >> 5) * 8 + h) * 2 + bj) * 8 + (c8 >> 1)) * 2 + (c8 & 1)) * 32 + (row & 31)) * 8;
                    const f32x4 v0 = acc[ai][bj][m][0], v1 = acc[ai][bj][m][1];
                    pg8::u32x4 w; w.x = pg8::cvt_pk_bf16(v0[0], v0[1]); w.y = pg8::cvt_pk_bf16(v0[2], v0[3]); w.z = pg8::cvt_pk_bf16(v1[0], v1[1]); w.w = pg8::cvt_pk_bf16(v1[2], v1[3]);
                    *(pg8::u32x4*)(O + idx) = w;
                }
        }
    }
};

__device__ __forceinline__ void p5_rows2(Frame& F, const Params& p) {
    unsigned char* ws = p.ws;
    const float* mod = (const float*)(ws + WS_MOD);
    const bf16_t* YO = (const bf16_t*)(ws + WS_YO);
    bf16_t* H2 = (bf16_t*)(ws + WS_H2);
    const int gw = F.bid * NWAVES + F.wave, NGW = F.G * NWAVES;
    const int rows_per = (MLAT + NGW - 1) / NGW;
    const int rend = min(MLAT, (gw + 1) * rows_per);
    f32x4 nxx[2][4]; u32x2 nxy[2][4];
#define P5_LOAD(rowa_) do { _Pragma("unroll") for (int q = 0; q < 2; ++q) { const int row = min((rowa_) + q, MLAT - 1); \
            _Pragma("unroll") for (int j = 0; j < 4; ++j) { nxx[q][j] = ((const f32x4*)(p.x + (size_t)row * D))[F.lane + 64 * j]; nxy[q][j] = ((const u32x2*)(YO + (size_t)row * D))[F.lane + 64 * j]; } } } while (0)
    P5_LOAD(gw * rows_per);
    for (int rowa = gw * rows_per; rowa < rend; rowa += 2) {
        f32x4 xv[2][4], yv[2][4]; float ssq[2];
#pragma unroll
        for (int q = 0; q < 2; ++q)
#pragma unroll
            for (int j = 0; j < 4; ++j) { xv[q][j] = nxx[q][j]; const u32x2 yw = nxy[q][j]; yv[q][j] = (f32x4){bflo(yw.x), bfhi(yw.x), bflo(yw.y), bfhi(yw.y)}; }
        if (rowa + 2 < rend) P5_LOAD(rowa + 2);
#pragma unroll
        for (int q = 0; q < 2; ++q) { float s = 0.f;
#pragma unroll
            for (int j = 0; j < 4; ++j) s += yv[q][j].x * yv[q][j].x + yv[q][j].y * yv[q][j].y + yv[q][j].z * yv[q][j].z + yv[q][j].w * yv[q][j].w;
            ssq[q] = wave_sum(s); }
#pragma unroll
        for (int q = 0; q < 2; ++q) { const int row = rowa + q; if (row < MLAT) {
            const int b = row >> 12; const float* mb = mod + b * NMOD;
            const float rstd = rsqrtf(ssq[q] * (1.f / D) + EPS);
            float s2 = 0.f;
#pragma unroll
            for (int j = 0; j < 4; ++j) { const int col = (F.lane + 64 * j) * 4;
                const f32x4 g1 = *(const f32x4*)(p.g_norm + D + col), gt1 = *(const f32x4*)(mb + 2 * D + col);
                xv[q][j] = xv[q][j] + gt1 * (yv[q][j] * rstd * g1);
                *(f32x4*)(p.out + (size_t)row * D + col) = xv[q][j];
                s2 += xv[q][j].x * xv[q][j].x + xv[q][j].y * xv[q][j].y + xv[q][j].z * xv[q][j].z + xv[q][j].w * xv[q][j].w; }
            const float rstd2 = rsqrtf(wave_sum(s2) * (1.f / D) + EPS);
#pragma unroll
            for (int j = 0; j < 4; ++j) { const int col = (F.lane + 64 * j) * 4;
                const f32x4 g2 = *(const f32x4*)(p.g_norm + 2 * D + col), sh2 = *(const f32x4*)(mb + 3 * D + col), sc2 = *(const f32x4*)(mb + 4 * D + col);
                const f32x4 y = (xv[q][j] * rstd2 * g2) * (sc2 + 1.f) + sh2;
                u32x2 o; o.x = pk2(y.x, y.y); o.y = pk2(y.z, y.w);
                *(u32x2*)(H2 + (size_t)row * D + col) = o; } } }
    }
#undef P5_LOAD
}

template <int J> __device__ __forceinline__ unsigned lane_xor(unsigned x, int lane) {
    if (J == 1) return (unsigned)__builtin_amdgcn_update_dpp(0, (int)x, 0xB1, 0xf, 0xf, false);
    if (J == 2) return (unsigned)__builtin_amdgcn_update_dpp(0, (int)x, 0x4E, 0xf, 0xf, false);
    if (J == 4) { const unsigned a = (unsigned)__builtin_amdgcn_update_dpp(0, (int)x, 0x104, 0xf, 0xf, false),
                                 b = (unsigned)__builtin_amdgcn_update_dpp(0, (int)x, 0x114, 0xf, 0xf, false);
                  return (lane & 4) ? b : a; }
    if (J == 8) return (unsigned)__builtin_amdgcn_update_dpp(0, (int)x, 0x128, 0xf, 0xf, false);
    if (J == 16) { auto r = __builtin_amdgcn_permlane16_swap(x, x, false, false); return (lane & 16) ? r[0] : r[1]; }
    auto r = __builtin_amdgcn_permlane32_swap(x, x, false, false); return (lane & 32) ? r[0] : r[1];
}
template <int K2, int J> __device__ __forceinline__ void bitonic_step128(unsigned& key0, unsigned& key1, int lane) {
    if (J == 64) { const unsigned lo = key0 < key1 ? key0 : key1, hi_ = key0 < key1 ? key1 : key0; key0 = lo; key1 = hi_; }
    else {
        const unsigned p0_ = lane_xor<J>(key0, lane), p1_ = lane_xor<J>(key1, lane);
        const bool lower = (lane & J) == 0;
        const bool asc0 = K2 == 128 ? true : ((lane & K2) == 0), asc1 = K2 == 128 ? true : (((64 + lane) & K2) == 0);
        const bool kmin0 = lower == asc0, kmin1 = lower == asc1;
        key0 = kmin0 ? (key0 < p0_ ? key0 : p0_) : (key0 < p0_ ? p0_ : key0);
        key1 = kmin1 ? (key1 < p1_ ? key1 : p1_) : (key1 < p1_ ? p1_ : key1);
    }
}
__device__ __forceinline__ void sort128_asc(unsigned& k0, unsigned& k1, int lane) {
    bitonic_step128<2, 1>(k0, k1, lane);
    bitonic_step128<4, 2>(k0, k1, lane); bitonic_step128<4, 1>(k0, k1, lane);
    bitonic_step128<8, 4>(k0, k1, lane); bitonic_step128<8, 2>(k0, k1, lane); bitonic_step128<8, 1>(k0, k1, lane);
    bitonic_step128<16, 8>(k0, k1, lane); bitonic_step128<16, 4>(k0, k1, lane); bitonic_step128<16, 2>(k0, k1, lane); bitonic_step128<16, 1>(k0, k1, lane);
    bitonic_step128<32, 16>(k0, k1, lane); bitonic_step128<32, 8>(k0, k1, lane); bitonic_step128<32, 4>(k0, k1, lane); bitonic_step128<32, 2>(k0, k1, lane); bitonic_step128<32, 1>(k0, k1, lane);
    bitonic_step128<64, 32>(k0, k1, lane); bitonic_step128<64, 16>(k0, k1, lane); bitonic_step128<64, 8>(k0, k1, lane); bitonic_step128<64, 4>(k0, k1, lane); bitonic_step128<64, 2>(k0, k1, lane); bitonic_step128<64, 1>(k0, k1, lane);
    bitonic_step128<128, 64>(k0, k1, lane); bitonic_step128<128, 32>(k0, k1, lane); bitonic_step128<128, 16>(k0, k1, lane); bitonic_step128<128, 8>(k0, k1, lane); bitonic_step128<128, 4>(k0, k1, lane); bitonic_step128<128, 2>(k0, k1, lane); bitonic_step128<128, 1>(k0, k1, lane);
}
__device__ __forceinline__ unsigned lane_xor_c(unsigned x, int j, int lane) {
    if (j == 1) return lane_xor<1>(x, lane); if (j == 2) return lane_xor<2>(x, lane); if (j == 4) return lane_xor<4>(x, lane);
    if (j == 8) return lane_xor<8>(x, lane); if (j == 16) return lane_xor<16>(x, lane); return lane_xor<32>(x, lane);
}
template <int R> __device__ __forceinline__ void sort_regs_asc(unsigned (&key)[R], int lane) {
#pragma unroll
    for (int k2 = 2; k2 <= 64 * R; k2 <<= 1)
#pragma unroll
        for (int j = k2 >> 1; j > 0; j >>= 1) {
            if (j >= 64) {
                const int jr = j >> 6;
#pragma unroll
                for (int r = 0; r < R; ++r) { const int rp = r ^ jr; if (rp > r) { const bool asc = ((r * 64) & k2) == 0;
                    const unsigned lo = key[r] < key[rp] ? key[r] : key[rp], hi_ = key[r] < key[rp] ? key[rp] : key[r];
                    key[r] = asc ? lo : hi_; key[rp] = asc ? hi_ : lo; } }
            } else {
                const bool lower = (lane & j) == 0;
#pragma unroll
                for (int r = 0; r < R; ++r) { const unsigned pv = lane_xor_c(key[r], j, lane);
                    const bool asc = k2 < 64 ? ((lane & k2) == 0) : (((r * 64) & k2) == 0);
                    const bool kmin = lower == asc;
                    key[r] = kmin ? (key[r] < pv ? key[r] : pv) : (key[r] < pv ? pv : key[r]); }
            }
        }
}
template <int MODE> __device__ __forceinline__ void p8_gather(Frame& F, const Params& p, const XcdBarrier& bar) {
    unsigned char* ws = p.ws;
    const bf16_t* H2 = (const bf16_t*)(ws + WS_H2); const unsigned char* U8 = ws + WS_UB; const unsigned char* V8 = ws + WS_VB;
    const int* EX = (const int*)(ws + WS_EXP); const float* GT = (const float*)(ws + WS_GATE); const float* SU = (const float*)(ws + WS_SU); const float* mod = (const float*)(ws + WS_MOD);
    const int gw = F.bid * NWAVES + F.wave, NGW = F.G * NWAVES, lane = F.lane;
    const int b5 = (lane >> 5) & 1, b4 = (lane >> 4) & 1, b3 = (lane >> 3) & 1;
    const int idx = b5 * 4 + b4 * 2 + b3;
    unsigned* ctr = (unsigned*)(ws + WS_CTL) + CW_P8CTR;
    int cnext = 0;
    if (lane == 0) cnext = (int)__hip_atomic_fetch_add(ctr, 1u, __ATOMIC_RELAXED, __HIP_MEMORY_SCOPE_AGENT);
    cnext = __builtin_amdgcn_readfirstlane(cnext);
    for (;;) {
        const int c = cnext;
        if (c >= MLAT / 2) break;
        if (lane == 0) cnext = (int)__hip_atomic_fetch_add(ctr, 1u, __ATOMIC_RELAXED, __HIP_MEMORY_SCOPE_AGENT);
        const int t0 = c * 2;
        float hv0[16], hv1[16], acc0[16], acc1[16];
#pragma unroll
        for (int j = 0; j < 4; ++j) { const u32x2 w0 = *(const u32x2*)(H2 + (size_t)t0 * D + (lane + 64 * j) * 4), w1 = *(const u32x2*)(H2 + (size_t)(t0 + 1) * D + (lane + 64 * j) * 4);
            hv0[4 * j] = bflo(w0.x); hv0[4 * j + 1] = bfhi(w0.x); hv0[4 * j + 2] = bflo(w0.y); hv0[4 * j + 3] = bfhi(w0.y);
            hv1[4 * j] = bflo(w1.x); hv1[4 * j + 1] = bfhi(w1.x); hv1[4 * j + 2] = bflo(w1.y); hv1[4 * j + 3] = bfhi(w1.y); }
#pragma unroll
        for (int i = 0; i < 16; ++i) { acc0[i] = 0.f; acc1[i] = 0.f; }
        unsigned key[4];
#pragma unroll
        for (int r = 0; r < 4; ++r) { const int n = r * 64 + lane; key[r] = ((unsigned)EX[(size_t)t0 * 128 + n] << 8) | (unsigned)n; }
        sort_regs_asc<4>(key, lane);
        const size_t tb_ = (size_t)t0 * 128;
        for (int bb = 0; bb < 32; ++bb) {
            const int rsel = bb >> 3; const unsigned kreg = rsel == 0 ? key[0] : (rsel == 1 ? key[1] : (rsel == 2 ? key[2] : key[3])); const int lb = (bb & 7) * 8;
            const unsigned kmine = (unsigned)__shfl((int)kreg, lb + idx);
            const float gl = GT[tb_ + (kmine & 255u)], sl = SU[tb_ + (kmine & 255u)];
            u32x4 ur[8], vr[8]; int slot[8];
#pragma unroll
            for (int i = 0; i < 8; ++i) { const unsigned ke = (unsigned)__builtin_amdgcn_readlane((int)kreg, lb + i); const int e = (int)(ke >> 8) & (MODE == 1 ? 1023 : 0xFFFF); slot[i] = (int)((ke >> 7) & 1u);
                ur[i] = *(const u32x4*)(U8 + (size_t)e * 1024 + lane * 16); vr[i] = *(const u32x4*)(V8 + (size_t)e * 1024 + lane * 16); }
            float d[8];
#pragma unroll
            for (int i = 0; i < 8; ++i) { float s = 0.f;
                if (slot[i] == 0) {
#pragma unroll
                    for (int j = 0; j < 4; ++j) { const f32x2 f0 = __builtin_amdgcn_cvt_pk_f32_fp8((int)ur[i][j], false), f1 = __builtin_amdgcn_cvt_pk_f32_fp8((int)ur[i][j], true);
                        s += hv0[4 * j] * f0.x + hv0[4 * j + 1] * f0.y + hv0[4 * j + 2] * f1.x + hv0[4 * j + 3] * f1.y; }
                } else {
#pragma unroll
                    for (int j = 0; j < 4; ++j) { const f32x2 f0 = __builtin_amdgcn_cvt_pk_f32_fp8((int)ur[i][j], false), f1 = __builtin_amdgcn_cvt_pk_f32_fp8((int)ur[i][j], true);
                        s += hv1[4 * j] * f0.x + hv1[4 * j + 1] * f0.y + hv1[4 * j + 2] * f1.x + hv1[4 * j + 3] * f1.y; }
                }
                d[i] = s; }
            float r4[4], r2[2], r1;
#pragma unroll
            for (int i = 0; i < 4; ++i) { auto rr = __builtin_amdgcn_permlane32_swap(__float_as_uint(d[i]), __float_as_uint(d[i + 4]), false, false); r4[i] = __uint_as_float(rr[0]) + __uint_as_float(rr[1]); }
#pragma unroll
            for (int i = 0; i < 2; ++i) { auto rr = __builtin_amdgcn_permlane16_swap(__float_as_uint(r4[i]), __float_as_uint(r4[i + 2]), false, false); r2[i] = __uint_as_float(rr[0]) + __uint_as_float(rr[1]); }
            { const float keep = b3 ? r2[1] : r2[0], send = b3 ? r2[0] : r2[1]; r1 = keep + __uint_as_float((unsigned)__builtin_amdgcn_update_dpp(0, (int)__float_as_uint(send), 0x128, 0xf, 0xf, false)); }
            r1 += __uint_as_float((unsigned)__builtin_amdgcn_update_dpp(0, (int)__float_as_uint(r1), 0xB1, 0xf, 0xf, false));
            r1 += __uint_as_float((unsigned)__builtin_amdgcn_update_dpp(0, (int)__float_as_uint(r1), 0x4E, 0xf, 0xf, false));
            r1 += __uint_as_float((unsigned)__builtin_amdgcn_update_dpp(0, (int)__float_as_uint(r1), 0x141, 0xf, 0xf, false));
            const float pre = r1 * sl;
            float act;
            { const float av = fabsf(pre), dd = av * 0.2316418882f + 1.0f; const float tt = __builtin_amdgcn_rcpf(dd);
              float q = tt * 0.5307027145f + (-0.7265760135f); q = q * tt + 0.7107068705f; q = q * tt + (-0.142248368f); q = q * tt + 0.127414796f; q = q * tt;
              const float ee = __builtin_amdgcn_exp2f((pre * pre) * (-0.72134752044f));
              const float mm = pre * (q * ee); act = pre < 0.f ? mm : pre - mm; }
            const float cfl = gl * act;
#pragma unroll
            for (int i = 0; i < 8; ++i) {
                const float cf = __uint_as_float((unsigned)__builtin_amdgcn_readlane((int)__float_as_uint(cfl), ((i >> 2) & 1) * 32 + ((i >> 1) & 1) * 16 + (i & 1) * 8));
                if (slot[i] == 0) {
#pragma unroll
                    for (int j = 0; j < 4; ++j) { const f32x2 f0 = __builtin_amdgcn_cvt_pk_f32_fp8((int)vr[i][j], false), f1 = __builtin_amdgcn_cvt_pk_f32_fp8((int)vr[i][j], true);
                        acc0[4 * j] += cf * f0.x; acc0[4 * j + 1] += cf * f0.y; acc0[4 * j + 2] += cf * f1.x; acc0[4 * j + 3] += cf * f1.y; }
                } else {
#pragma unroll
                    for (int j = 0; j < 4; ++j) { const f32x2 f0 = __builtin_amdgcn_cvt_pk_f32_fp8((int)vr[i][j], false), f1 = __builtin_amdgcn_cvt_pk_f32_fp8((int)vr[i][j], true);
                        acc1[4 * j] += cf * f0.x; acc1[4 * j + 1] += cf * f0.y; acc1[4 * j + 2] += cf * f1.x; acc1[4 * j + 3] += cf * f1.y; }
                }
            }
        }
#pragma unroll
        for (int sidx = 0; sidx < 2; ++sidx) {
            const int t = t0 + sidx;
            float s = 0.f;
#pragma unroll
            for (int i = 0; i < 16; ++i) { const float a = sidx ? acc1[i] : acc0[i]; s += a * a; }
            const float rstd = rsqrtf(wave_sum(s) * (1.f / D) + EPS);
            const float* mb = mod + (t >> 12) * NMOD + 5 * D; const float* g3 = p.g_norm + 3 * D;
#pragma unroll
            for (int j = 0; j < 4; ++j) { const int col = (lane + 64 * j) * 4;
                float* op = p.out + (size_t)t * D + col;
                const f32x4 x0 = *(const f32x4*)op, ga = *(const f32x4*)(g3 + col), ta = *(const f32x4*)(mb + col);
                const f32x4 pa = sidx ? (f32x4){acc1[4 * j], acc1[4 * j + 1], acc1[4 * j + 2], acc1[4 * j + 3]} : (f32x4){acc0[4 * j], acc0[4 * j + 1], acc0[4 * j + 2], acc0[4 * j + 3]};
                if (MODE == 0 || rstd == 123456.f) *(f32x4*)op = x0 + ta * (pa * rstd * ga); }
        }
        cnext = __builtin_amdgcn_readfirstlane(cnext);
    }
}

namespace att {
typedef short bf16x8 __attribute__((ext_vector_type(8)));
typedef short s16x4 __attribute__((ext_vector_type(4)));
typedef float f32x16 __attribute__((ext_vector_type(16)));
typedef __attribute__((address_space(3))) const unsigned char* lcp;
typedef __attribute__((address_space(3))) unsigned char* lp;
constexpr int NA_SLOT = 16384, NA_BIAS_OFF = 32768, WSF_OFF = 155648;
constexpr int DF_SLOT = 32768;
constexpr float THRL = 8.f;

__device__ __forceinline__ int crow(int r, int hi) { return (r & 3) + 8 * (r >> 2) + 4 * hi; }
__device__ __forceinline__ s16x4 vtr(lcp p) { return __builtin_bit_cast(s16x4, __builtin_amdgcn_ds_read_tr16_b64_v4i16((__attribute__((address_space(3))) s16x4*)p)); }
typedef float f32x2_t __attribute__((ext_vector_type(2))); typedef __bf16 bf16x2v_t __attribute__((ext_vector_type(2)));
__device__ __forceinline__ unsigned cvtpk(float lo, float hi) { f32x2_t v = {lo, hi}; bf16x2v_t b = __builtin_convertvector(v, bf16x2v_t); return __builtin_bit_cast(unsigned, b); }
__device__ __forceinline__ float swap_half(float v) { auto rr = __builtin_amdgcn_permlane32_swap(__float_as_uint(v), __float_as_uint(v), false, false); return __uint_as_float(rr[0]) == v ? __uint_as_float(rr[1]) : __uint_as_float(rr[0]); }
__device__ __forceinline__ void dma16(const void* gsrc, lp lds_dst) {
    unsigned keep; const unsigned dst = (unsigned)__builtin_amdgcn_readfirstlane((int)(unsigned)(size_t)lds_dst);
    asm volatile("s_mov_b32 %0, m0\n\ts_mov_b32 m0, %2\n\ts_nop 0\n\tglobal_load_lds_dwordx4 %1, off\n\ts_mov_b32 m0, %0" : "=&s"(keep) : "v"(gsrc), "s"(dst) : "memory");
}
__device__ __forceinline__ float max3f(float a, float b, float c) { float r; asm("v_max3_f32 %0, %1, %2, %3" : "=v"(r) : "v"(a), "v"(b), "v"(c)); return r; }
__device__ __forceinline__ float rowmax32(const f32x16& p0, const f32x16& p1) {
    float a = max3f(p0[0], p0[1], p1[0]), b = max3f(p0[2], p0[3], p1[1]); a = max3f(a, p1[2], p1[3]);
#pragma unroll
    for (int r = 4; r < 16; r += 4) { a = max3f(a, p0[r], p0[r + 1]); b = max3f(b, p0[r + 2], p0[r + 3]); a = max3f(a, p1[r], p1[r + 1]); b = max3f(b, p1[r + 2], p1[r + 3]); }
    float m = max3f(a, b, b);
    auto rr = __builtin_amdgcn_permlane32_swap(__float_as_uint(m), __float_as_uint(m), false, false);
    return max3f(__uint_as_float(rr[0]), __uint_as_float(rr[1]), __uint_as_float(rr[1]));
}

typedef __bf16 bf16x2_t __attribute__((ext_vector_type(2)));
__device__ __forceinline__ float psum_bf16(const u32x4 (&pw)[4], float acc) {
    const bf16x2_t ones = __builtin_bit_cast(bf16x2_t, 0x3F803F80u); float a0 = acc, a1 = 0.f;
#pragma unroll
    for (int k = 0; k < 4; ++k) { a0 = __builtin_amdgcn_fdot2_f32_bf16(__builtin_bit_cast(bf16x2_t, pw[k][0]), ones, a0, false); a1 = __builtin_amdgcn_fdot2_f32_bf16(__builtin_bit_cast(bf16x2_t, pw[k][1]), ones, a1, false);
        a0 = __builtin_amdgcn_fdot2_f32_bf16(__builtin_bit_cast(bf16x2_t, pw[k][2]), ones, a0, false); a1 = __builtin_amdgcn_fdot2_f32_bf16(__builtin_bit_cast(bf16x2_t, pw[k][3]), ones, a1, false); }
    return a0 + a1;
}
template <int NDV> struct FlashState { float mhat, l; f32x16 negm; f32x16 o[NDV]; };

template <int NDV, bool BIAS>
__device__ __forceinline__ void flash_tile(FlashState<NDV>& st, const bf16x8 (&qr)[4], lcp Kslot, lcp Vslot, lcp Bslot, const bf16x8 (&qoh)[2],
                                           __attribute__((address_space(3))) float* wsf, int r32, int hi, int lane, bool first) {
    f32x16 p0 = st.negm, p1 = st.negm;
    lcp kb = Kslot + hi * 1024 + r32 * 16;
    bf16x8 kf[8], bf_[4];
#pragma unroll
    for (int d0 = 0; d0 < 4; ++d0) { kf[2 * d0] = *(const __attribute__((address_space(3))) bf16x8*)(kb + d0 * 2048); kf[2 * d0 + 1] = *(const __attribute__((address_space(3))) bf16x8*)(kb + d0 * 2048 + 512); }
    if (BIAS) { lcp bb = Bslot + hi * 1024 + r32 * 16;
#pragma unroll
        for (int e = 0; e < 2; ++e) { bf_[2 * e] = *(const __attribute__((address_space(3))) bf16x8*)(bb + e * 2048); bf_[2 * e + 1] = *(const __attribute__((address_space(3))) bf16x8*)(bb + e * 2048 + 512); } }
    lcp vb = Vslot + ((lane >> 4) & 1) * 32 + (lane & 3) * 8 + (4 * hi + ((lane & 15) >> 2)) * 64;
    s16x4 va[8], vn[8];
#pragma unroll
    for (int ks = 0; ks < 4; ++ks) { va[2 * ks] = vtr(vb + ks * 1024); va[2 * ks + 1] = vtr(vb + ks * 1024 + 512); }
#pragma unroll
    for (int d0 = 0; d0 < 4; ++d0) { p0 = __builtin_amdgcn_mfma_f32_32x32x16_bf16(kf[2 * d0], qr[d0], p0, 0, 0, 0); p1 = __builtin_amdgcn_mfma_f32_32x32x16_bf16(kf[2 * d0 + 1], qr[d0], p1, 0, 0, 0); }
    if (BIAS) {
#pragma unroll
        for (int e = 0; e < 2; ++e) { p0 = __builtin_amdgcn_mfma_f32_32x32x16_bf16(bf_[2 * e], qoh[e], p0, 0, 0, 0); p1 = __builtin_amdgcn_mfma_f32_32x32x16_bf16(bf_[2 * e + 1], qoh[e], p1, 0, 0, 0); }
    }
    asm volatile("s_nop 15\n\ts_nop 7" : "+v"(p0), "+v"(p1));
    const float rm = rowmax32(p0, p1);
    if (first) {
        st.mhat += rm;
#pragma unroll
        for (int r = 0; r < 16; ++r) { p0[r] -= rm; p1[r] -= rm; st.negm[r] = -st.mhat; }
    } else if (__any(rm > THRL)) {
        const float dl = fmaxf(rm, 0.f); const float alpha = __builtin_amdgcn_exp2f(-dl); st.mhat += dl; st.l *= alpha;
        if (hi == 0) wsf[r32] = alpha;
        asm volatile("s_waitcnt lgkmcnt(0)" ::: "memory");
        float al[16];
#pragma unroll
        for (int r = 0; r < 16; ++r) al[r] = wsf[crow(r, hi)];
#pragma unroll
        for (int d = 0; d < NDV; ++d)
#pragma unroll
            for (int r = 0; r < 16; ++r) st.o[d][r] *= al[r];
#pragma unroll
        for (int r = 0; r < 16; ++r) { p0[r] -= dl; p1[r] -= dl; st.negm[r] = -st.mhat; }
    }
    float sacc = 0.f;
#pragma unroll
    for (int r = 0; r < 16; ++r) { p0[r] = __builtin_amdgcn_exp2f(p0[r]); p1[r] = __builtin_amdgcn_exp2f(p1[r]); sacc += p0[r] + p1[r]; }
    st.l += sacc;
    u32x4 pw[4];
#pragma unroll
    for (int i = 0; i < 4; ++i) { pw[0][i] = cvtpk(p0[2 * i], p0[2 * i + 1]); pw[1][i] = cvtpk(p0[8 + 2 * i], p0[8 + 2 * i + 1]); pw[2][i] = cvtpk(p1[2 * i], p1[2 * i + 1]); pw[3][i] = cvtpk(p1[8 + 2 * i], p1[8 + 2 * i + 1]); }
    __builtin_amdgcn_sched_barrier(0);
#pragma unroll
    for (int d0 = 0; d0 < NDV; ++d0) {
#pragma unroll
        for (int ks = 0; ks < 4; ++ks) {
            if (d0 < NDV - 1) { vn[2 * ks] = vtr(vb + (d0 + 1) * 4096 + ks * 1024); vn[2 * ks + 1] = vtr(vb + (d0 + 1) * 4096 + ks * 1024 + 512); }
            const bf16x8 vf = (bf16x8){va[2 * ks][0], va[2 * ks][1], va[2 * ks][2], va[2 * ks][3], va[2 * ks + 1][0], va[2 * ks + 1][1], va[2 * ks + 1][2], va[2 * ks + 1][3]};
            st.o[d0] = __builtin_amdgcn_mfma_f32_32x32x16_bf16(__builtin_bit_cast(bf16x8, pw[ks]), vf, st.o[d0], 0, 0, 0);
            __builtin_amdgcn_sched_barrier(0);
        }
#pragma unroll
        for (int i = 0; i < 8; ++i) va[i] = vn[i];
    }
}

constexpr int NA2_SLOT = 16384, NA2_BIAS_OFF = 65536;
__device__ __forceinline__ void na_units(Frame& F, const Params& p) {
    unsigned char* ws = p.ws;
    const bf16_t* QA = (const bf16_t*)(ws + WS_QA); const bf16_t* KA = (const bf16_t*)(ws + WS_KA); const bf16_t* VA = (const bf16_t*)(ws + WS_VA);
    const bf16_t* BT = (const bf16_t*)(ws + WS_BIAST); bf16_t* Y = (bf16_t*)(ws + WS_Y);
    const int lane = F.lane, r32 = lane & 31, hi = lane >> 5, wave = F.wave;
    lp lds = (lp)F.lds;
    __attribute__((address_space(3))) float* wsf = (__attribute__((address_space(3))) float*)(lds + WSF_OFF) + wave * 64;
    const int upw = 1024 / F.G;
    int cur_h = -1, cur_lo = -1, cur_hi = -1;
    bf16x8 qoh[2];
#pragma unroll
    for (int e = 0; e < 2; ++e)
#pragma unroll
        for (int j = 0; j < 8; ++j) qoh[e][j] = (16 * e + 8 * hi + j == r32) ? (short)0x3F80 : (short)0;
    for (int ui = 0; ui < upw; ++ui) {
        const int u = F.bid * upw + ui, bh = u >> 4, rg = u & 15, b = bh >> 3, h = bh & 7;
        const int r0 = rg * 4, r = r0 + (wave >> 1), ch = wave & 1;
        int rs = r - 4; rs = rs < 0 ? 0 : (rs > 56 ? 56 : rs);
        int kr_lo = r0 - 4; kr_lo = kr_lo < 0 ? 0 : (kr_lo > 56 ? 56 : kr_lo);
        int kr_hi = r0 + 3 - 4; kr_hi = kr_hi < 0 ? 0 : (kr_hi > 56 ? 56 : kr_hi); kr_hi += 7;
        const int T = 4 + (kr_hi - kr_lo + 1);
        int dr_lo = 99, dr_hi = -1;
#pragma unroll
        for (int q = 0; q < 4; ++q) { int s_ = r0 + q - 4; s_ = s_ < 0 ? 0 : (s_ > 56 ? 56 : s_); const int a = s_ - (r0 + q) + 7; dr_lo = a < dr_lo ? a : dr_lo; dr_hi = a + 7 > dr_hi ? a + 7 : dr_hi; }
        const bf16_t* Kb = KA + (size_t)bh * NKT * 4096; const bf16_t* Vb = VA + (size_t)bh * NKT * 4096;
        if (h != cur_h || dr_lo != cur_lo || dr_hi != cur_hi) {
            cur_h = h; cur_lo = dr_lo; cur_hi = dr_hi;
            const unsigned char* src = (const unsigned char*)(BT + ((size_t)h * 15 + dr_lo) * 4096);
            const int npc = (dr_hi - dr_lo + 1) * 8;
            for (int pi = wave; pi < npc; pi += 8) dma16(src + pi * 1024 + lane * 16, lds + NA2_BIAS_OFF + pi * 1024);
        }
        bf16x8 qr[4];
        { const bf16_t* qp = QA + ((size_t)bh * SEQ + r * 64 + ch * 32 + r32) * 64 + hi * 8;
#pragma unroll
          for (int d0 = 0; d0 < 4; ++d0) qr[d0] = *(const bf16x8*)(qp + d0 * 16); }
#define NA_DMA(i_) do { const int tg_ = (i_) < 4 ? (i_) : (4 + kr_lo + (i_) - 4); lp sl_ = lds + ((i_) & 3) * NA2_SLOT; \
            dma16((const unsigned char*)(Kb + (size_t)tg_ * 4096) + wave * 1024 + lane * 16, sl_ + wave * 1024); \
            dma16((const unsigned char*)(Vb + (size_t)tg_ * 4096) + wave * 1024 + lane * 16, sl_ + 8192 + wave * 1024); } while (0)
        NA_DMA(0); NA_DMA(1);
        FlashState<2> st; st.mhat = 0.f; st.l = 0.f;
#pragma unroll
        for (int rr = 0; rr < 16; ++rr) st.negm[rr] = 0.f;
#pragma unroll
        for (int d = 0; d < 2; ++d)
#pragma unroll
            for (int rr = 0; rr < 16; ++rr) st.o[d][rr] = 0.f;
        for (int i = 0; i < T; ++i) {
            if (i + 1 < T) asm volatile("s_waitcnt vmcnt(2)" ::: "memory"); else asm volatile("s_waitcnt vmcnt(0)" ::: "memory");
            __syncthreads();
            if (i + 2 < T) NA_DMA(i + 2);
            lcp sl = (lcp)(lds + (i & 3) * NA2_SLOT);
            if (i < 4) flash_tile<2, false>(st, qr, sl, sl + 8192, sl, qoh, wsf, r32, hi, lane, i == 0);
            else { const int kr = kr_lo + (i - 4);
                if (kr >= rs && kr < rs + 8) { const int dr = kr - r + 7;
                    flash_tile<2, true>(st, qr, sl, sl + 8192, (lcp)(lds + NA2_BIAS_OFF + (dr - dr_lo) * 8192 + ch * 4096), qoh, wsf, r32, hi, lane, false); } }
        }
#undef NA_DMA
        float lt = st.l; { auto rr = __builtin_amdgcn_permlane32_swap(__float_as_uint(lt), __float_as_uint(lt), false, false); lt = __uint_as_float(rr[0]) + __uint_as_float(rr[1]); }
        if (hi == 0) wsf[32 + r32] = lt;
        asm volatile("s_waitcnt lgkmcnt(0)" ::: "memory");
        bf16_t* yb = Y + ((size_t)b * SEQ + r * 64 + ch * 32) * D + h * 64 + r32;
#pragma unroll
        for (int rr = 0; rr < 16; ++rr) { const float rl = __builtin_amdgcn_rcpf(wsf[32 + crow(rr, hi)]);
#pragma unroll
            for (int d0 = 0; d0 < 2; ++d0) yb[(size_t)crow(rr, hi) * D + d0 * 32] = (bf16_t)f2bf(st.o[d0][rr] * rl); }
        __syncthreads();
    }
}

template <int MODE> __device__ __forceinline__ void diff_units_v2(Frame& F, const Params& p) {
    unsigned char* ws = p.ws;
    const bf16_t* QD = (const bf16_t*)(ws + WS_QD); const bf16_t* KD = (const bf16_t*)(ws + WS_KD); const bf16_t* VD = (const bf16_t*)(ws + WS_VD);
    bf16_t* Y = (bf16_t*)(ws + WS_Y);
    const float lam = *(const float*)(ws + WS_LAM);
    const int lane = F.lane, r32 = lane & 31, hi = lane >> 5, wave = F.wave, map = wave >> 2, qg = wave & 3;
    lp lds = (lp)F.lds;
    __attribute__((address_space(3))) float* wsf = (__attribute__((address_space(3))) float*)(lds + WSF_OFF) + wave * 64;
    __attribute__((address_space(3))) float* X = (__attribute__((address_space(3))) float*)lds;
    const int upw = 1024 / F.G;
    const int koff = map * 8192 + hi * 1024 + r32 * 16;
    const int voff = 16384 + ((lane >> 4) & 1) * 32 + (lane & 3) * 8 + (4 * hi + ((lane & 15) >> 2)) * 64;
    for (int ui = 0; ui < upw; ++ui) {
        int bh, qb;
        if (F.G == 256) { bh = (F.bid & 7) * 4 + ui; qb = F.bid >> 3; } else { const int u = F.bid * upw + ui; bh = u >> 5; qb = u & 31; }
        const int b = bh >> 2, h = bh & 3;
        const unsigned char* K1 = (const unsigned char*)(KD + (size_t)((b * 2 + 0) * 4 + h) * NKT * 4096);
        const unsigned char* K2 = (const unsigned char*)(KD + (size_t)((b * 2 + 1) * 4 + h) * NKT * 4096);
        const unsigned char* Vg = (const unsigned char*)(VD + (size_t)bh * NKT * 8192);
#define DF_DMA(t, slot) do { if (MODE != 1 && MODE != 3) { lp sl_ = lds + (slot) * DF_SLOT; \
            dma16(K1 + (size_t)(t) * 8192 + wave * 1024 + lane * 16, sl_ + wave * 1024); \
            dma16(K2 + (size_t)(t) * 8192 + wave * 1024 + lane * 16, sl_ + 8192 + wave * 1024); \
            dma16(Vg + (size_t)(t) * 16384 + wave * 1024 + lane * 16, sl_ + 16384 + wave * 1024); \
            dma16(Vg + (size_t)(t) * 16384 + 8192 + wave * 1024 + lane * 16, sl_ + 24576 + wave * 1024); } } while (0)
        DF_DMA(0, 0); DF_DMA(1, 1);
        const int q0 = qb * 128 + qg * 32;
        bf16x8 qr[4];
        { const bf16_t* qp = QD + ((size_t)((b * 2 + map) * 4 + h) * SEQ + q0 + r32) * 64 + hi * 8;
#pragma unroll
          for (int d0 = 0; d0 < 4; ++d0) qr[d0] = *(const bf16x8*)(qp + d0 * 16); }
        float mhat = 0.f, lsum = 0.f; f32x16 o[4], negm;
#pragma unroll
        for (int d = 0; d < 4; ++d)
#pragma unroll
            for (int rr = 0; rr < 16; ++rr) o[d][rr] = 0.f;
        asm volatile("s_waitcnt vmcnt(0)" ::: "memory");
        __syncthreads();
        f32x16 s0, s1;
#pragma unroll
        for (int rr = 0; rr < 16; ++rr) { s0[rr] = 0.f; s1[rr] = 0.f; }
        { lcp kb = (lcp)(lds + koff);
#pragma unroll
          for (int d0 = 0; d0 < 4; ++d0) {
              const bf16x8 b0 = *(const __attribute__((address_space(3))) bf16x8*)(kb + d0 * 2048), b1 = *(const __attribute__((address_space(3))) bf16x8*)(kb + d0 * 2048 + 512);
              s0 = __builtin_amdgcn_mfma_f32_32x32x16_bf16(b0, qr[d0], s0, 0, 0, 0); s1 = __builtin_amdgcn_mfma_f32_32x32x16_bf16(b1, qr[d0], s1, 0, 0, 0); } }
        { asm volatile("s_nop 15\n\ts_nop 7" : "+v"(s0), "+v"(s1)); const float rm0 = rowmax32(s0, s1); mhat = rm0;
#pragma unroll
          for (int rr = 0; rr < 16; ++rr) { s0[rr] -= rm0; s1[rr] -= rm0; negm[rr] = -rm0; } }
        u32x4 pw[4];
#define EXP4(X, B) do { X[B] = __builtin_amdgcn_exp2f(X[B]); X[B + 1] = __builtin_amdgcn_exp2f(X[B + 1]); X[B + 2] = __builtin_amdgcn_exp2f(X[B + 2]); X[B + 3] = __builtin_amdgcn_exp2f(X[B + 3]); sacc += X[B]; asm("" : "+v"(sacc)); sacc += X[B + 1]; asm("" : "+v"(sacc)); sacc += X[B + 2]; asm("" : "+v"(sacc)); sacc += X[B + 3]; asm("" : "+v"(sacc)); } while (0)
#define STAGE_A(t_) do { \
            lcp nxt = (lcp)(lds + (((t_) + 1) & 3) * DF_SLOT); \
            bf16x8 kf[8]; \
            _Pragma("unroll") for (int d0 = 0; d0 < 4; ++d0) { kf[2 * d0] = *(const __attribute__((address_space(3))) bf16x8*)(nxt + koff + d0 * 2048); kf[2 * d0 + 1] = *(const __attribute__((address_space(3))) bf16x8*)(nxt + koff + d0 * 2048 + 512); } \
            asm volatile("s_nop 15\n\ts_nop 7" : "+v"(s0), "+v"(s1)); \
            const float rm = rowmax32(s0, s1); \
            if (__any(rm > THRL)) { \
                const float dl = fmaxf(rm, 0.f); const float alpha = __builtin_amdgcn_exp2f(-dl); mhat += dl; lsum *= alpha; \
                if (hi == 0) wsf[r32] = alpha; \
                asm volatile("s_waitcnt lgkmcnt(0)" ::: "memory"); \
                float al[16]; \
                _Pragma("unroll") for (int r = 0; r < 16; ++r) al[r] = wsf[crow(r, hi)]; \
                _Pragma("unroll") for (int d = 0; d < 4; ++d) _Pragma("unroll") for (int r = 0; r < 16; ++r) o[d][r] *= al[r]; \
                _Pragma("unroll") for (int r = 0; r < 16; ++r) { s0[r] -= dl; s1[r] -= dl; negm[r] = -mhat; } \
            } \
            f32x16 n0, n1; float sacc = 0.f; \
            __builtin_amdgcn_sched_barrier(0); \
            n0 = __builtin_amdgcn_mfma_f32_32x32x16_bf16(kf[0], qr[0], negm, 0, 0, 0); EXP4(s0, 0);  __builtin_amdgcn_sched_barrier(0); \
            n1 = __builtin_amdgcn_mfma_f32_32x32x16_bf16(kf[1], qr[0], negm, 0, 0, 0); EXP4(s0, 4);  __builtin_amdgcn_sched_barrier(0); \
            n0 = __builtin_amdgcn_mfma_f32_32x32x16_bf16(kf[2], qr[1], n0, 0, 0, 0); EXP4(s0, 8);  __builtin_amdgcn_sched_barrier(0); \
            n1 = __builtin_amdgcn_mfma_f32_32x32x16_bf16(kf[3], qr[1], n1, 0, 0, 0); EXP4(s0, 12); __builtin_amdgcn_sched_barrier(0); \
            n0 = __builtin_amdgcn_mfma_f32_32x32x16_bf16(kf[4], qr[2], n0, 0, 0, 0); EXP4(s1, 0);  __builtin_amdgcn_sched_barrier(0); \
            n1 = __builtin_amdgcn_mfma_f32_32x32x16_bf16(kf[5], qr[2], n1, 0, 0, 0); EXP4(s1, 4);  __builtin_amdgcn_sched_barrier(0); \
            n0 = __builtin_amdgcn_mfma_f32_32x32x16_bf16(kf[6], qr[3], n0, 0, 0, 0); EXP4(s1, 8);  __builtin_amdgcn_sched_barrier(0); \
            n1 = __builtin_amdgcn_mfma_f32_32x32x16_bf16(kf[7], qr[3], n1, 0, 0, 0); EXP4(s1, 12); __builtin_amdgcn_sched_barrier(0); \
            _Pragma("unroll") for (int i = 0; i < 4; ++i) { pw[0][i] = cvtpk(s0[2 * i], s0[2 * i + 1]); pw[1][i] = cvtpk(s0[8 + 2 * i], s0[8 + 2 * i + 1]); pw[2][i] = cvtpk(s1[2 * i], s1[2 * i + 1]); pw[3][i] = cvtpk(s1[8 + 2 * i], s1[8 + 2 * i + 1]); } \
            lsum += sacc; \
            s0 = n0; s1 = n1; \
        } while (0)
#define STAGE_B(tl_) do { \
            lcp vb = (lcp)(lds + ((tl_) & 3) * DF_SLOT) + voff; \
            s16x4 va[8], vn[8]; \
            _Pragma("unroll") for (int ks = 0; ks < 4; ++ks) { va[2 * ks] = vtr(vb + ks * 1024); va[2 * ks + 1] = vtr(vb + ks * 1024 + 512); } \
            __builtin_amdgcn_sched_barrier(0); \
            _Pragma("unroll") for (int d0 = 0; d0 < 4; ++d0) { \
                _Pragma("unroll") for (int ks = 0; ks < 4; ++ks) { \
                    if (d0 < 3) { vn[2 * ks] = vtr(vb + (d0 + 1) * 4096 + ks * 1024); vn[2 * ks + 1] = vtr(vb + (d0 + 1) * 4096 + ks * 1024 + 512); } \
                    const bf16x8 vf = (bf16x8){va[2 * ks][0], va[2 * ks][1], va[2 * ks][2], va[2 * ks][3], va[2 * ks + 1][0], va[2 * ks + 1][1], va[2 * ks + 1][2], va[2 * ks + 1][3]}; \
                    o[d0] = __builtin_amdgcn_mfma_f32_32x32x16_bf16(__builtin_bit_cast(bf16x8, pw[ks]), vf, o[d0], 0, 0, 0); \
                    __builtin_amdgcn_sched_barrier(0); \
                } \
                _Pragma("unroll") for (int i = 0; i < 8; ++i) va[i] = vn[i]; \
            } \
        } while (0)
        for (int t = 0; t < NKT; ++t) {
            if (t > 0) { asm volatile("s_waitcnt vmcnt(0)" ::: "memory"); if (MODE != 3) __syncthreads(); }
            if (t + 2 < NKT) DF_DMA(t + 2, (t + 2) & 3);
            if (MODE != 2) {
                if (map == 1 && t > 0) STAGE_B(t - 1);
                STAGE_A(t);
                if (map == 0) STAGE_B(t);
            }
        }
        if (MODE != 2 && map == 1) STAGE_B(NKT - 1);
#undef STAGE_A
#undef STAGE_B
#undef EXP4
#undef DF_DMA
        float lt = lsum; { auto rr = __builtin_amdgcn_permlane32_swap(__float_as_uint(lt), __float_as_uint(lt), false, false); lt = __uint_as_float(rr[0]) + __uint_as_float(rr[1]); }
        if (hi == 0) wsf[32 + r32] = lt;
        asm volatile("s_waitcnt lgkmcnt(0)" ::: "memory");
#pragma unroll
        for (int rr = 0; rr < 16; ++rr) { const float rl = __builtin_amdgcn_rcpf(wsf[32 + crow(rr, hi)]);
#pragma unroll
            for (int d = 0; d < 4; ++d) o[d][rr] *= rl; }
        __syncthreads();
        if (map == 1) {
#pragma unroll
            for (int d = 0; d < 4; ++d)
#pragma unroll
                for (int rr = 0; rr < 16; ++rr) X[((qg * 4 + d) * 16 + rr) * 64 + lane] = o[d][rr];
        }
        __syncthreads();
        if (map == 0 && (MODE == 0 || lam == 123456.f)) {
            float ss[16];
#pragma unroll
            for (int rr = 0; rr < 16; ++rr) { float s = 0.f;
#pragma unroll
                for (int d = 0; d < 4; ++d) { const float v = o[d][rr] - lam * X[((qg * 4 + d) * 16 + rr) * 64 + lane]; o[d][rr] = v; s += v * v; }
                ss[rr] = s; }
#pragma unroll
            for (int oo = 1; oo < 32; oo <<= 1)
#pragma unroll
                for (int rr = 0; rr < 16; ++rr) ss[rr] += __shfl_xor(ss[rr], oo);
            float g[4];
#pragma unroll
            for (int d = 0; d < 4; ++d) g[d] = p.diff_subln[d * 32 + r32] * (1.f - LAMBDA_INIT);
            bf16_t* yb = Y + ((size_t)b * SEQ + q0) * D + 512 + h * 128 + r32;
#pragma unroll
            for (int rr = 0; rr < 16; ++rr) { const float rn = rsqrtf(ss[rr] * (1.f / 128.f) + EPS);
#pragma unroll
                for (int d = 0; d < 4; ++d) yb[(size_t)crow(rr, hi) * D + d * 32] = (bf16_t)f2bf(o[d][rr] * rn * g[d]); }
        }
        __syncthreads();
    }
}
}

__device__ __forceinline__ void p3_attention(Frame& F, const Params& p) {
    att::na_units(F, p);
    att::diff_units_v2<0>(F, p);
}

namespace tk {
typedef short bf16x8 __attribute__((ext_vector_type(8)));
typedef float f32x16 __attribute__((ext_vector_type(16)));
constexpr int WLK_OFF = 65536;
__device__ __forceinline__ unsigned ord(float f) { const unsigned u = __float_as_uint(f); return u ^ ((unsigned)((int)u >> 31) | 0x80000000u); }
__device__ __forceinline__ float unord(unsigned o) { return __uint_as_float(o ^ ((o & 0x80000000u) ? 0x80000000u : 0xFFFFFFFFu)); }
__device__ __forceinline__ void cs_desc(unsigned& a, unsigned& b) { const unsigned mx = a > b ? a : b, mn = a > b ? b : a; a = mx; b = mn; }
__device__ __forceinline__ void sort16_desc(unsigned (&v)[16]) {
#pragma unroll
    for (int k = 2; k <= 16; k <<= 1)
#pragma unroll
        for (int j = k >> 1; j > 0; j >>= 1)
#pragma unroll
            for (int i = 0; i < 16; ++i) { const int l = i ^ j; if (l > i) { if ((i & k) == 0 || k == 16) cs_desc(v[i], v[l]); else cs_desc(v[l], v[i]); } }
}
__device__ __forceinline__ void bmerge16_desc(unsigned (&v)[16]) {
#pragma unroll
    for (int j = 8; j > 0; j >>= 1)
#pragma unroll
        for (int i = 0; i < 16; ++i) { const int l = i ^ j; if (l > i) cs_desc(v[i], v[l]); }
}
__device__ __forceinline__ void merge_top16(unsigned (&a)[16], const unsigned (&b)[16]) {
#pragma unroll
    for (int i = 0; i < 16; ++i) a[i] = a[i] > b[15 - i] ? a[i] : b[15 - i];
    bmerge16_desc(a);
}
__device__ __forceinline__ void top16_of_64x2(unsigned (&v0)[16], unsigned (&v1)[16], unsigned (&v2)[16], unsigned (&v3)[16]) {
    sort16_desc(v0); sort16_desc(v1); sort16_desc(v2); sort16_desc(v3);
    merge_top16(v0, v1); merge_top16(v2, v3); merge_top16(v0, v2);
    unsigned pb[16];
#pragma unroll
    for (int i = 0; i < 16; ++i) pb[i] = (unsigned)__shfl_xor((int)v0[i], 32);
    merge_top16(v0, pb);
}
}

__device__ __forceinline__ void p7_topk(Frame& F, const Params& p) {
    using namespace tk;
    unsigned char* ws = p.ws;
    const bf16_t* Q2 = (const bf16_t*)(ws + WS_Q2); const unsigned char* KI = (const unsigned char*)(ws + WS_KEYSI);
    int* EX = (int*)(ws + WS_EXP); float* GT = (float*)(ws + WS_GATE); float* SUo = (float*)(ws + WS_SU);
    const float* USC = (const float*)(ws + WS_USC); const float* VSC = (const float*)(ws + WS_VSC);
    const int lane = F.lane, r32 = lane & 31, hi = lane >> 5, wave = F.wave;
    att::lp lds = (att::lp)F.lds;
    LAS int* W = (LAS int*)(F.lds + WLK_OFF + wave * 8192);
    const int ntask = 1024 / F.G;
    const int h = F.bid & 7;
    { const unsigned char* src = KI + (size_t)h * 65536;
      for (int k = 0; k < 8; ++k) { const int pi = wave + 8 * k; att::dma16(src + pi * 1024 + lane * 16, lds + pi * 1024); } }
    asm volatile("s_waitcnt vmcnt(0)" ::: "memory");
    __syncthreads();
    bf16x8 qf[8], qn[8];
    { const int tb32 = ((F.bid >> 3) * ntask) * 8 + wave;
      const bf16_t* qp = Q2 + ((((size_t)tb32 * 8 + h) * 2 + 0) * 8 * 2 + hi) * 256 + r32 * 8;
#pragma unroll
      for (int s = 0; s < 8; ++s) qn[s] = *(const bf16x8*)(qp + s * 512); }
    for (int ti = 0; ti < ntask; ++ti) {
        const int tb = (F.bid >> 3) * ntask + ti;
        const int t = tb * 256 + wave * 32 + r32;
        unsigned A[16], B[16];
#pragma unroll
        for (int pp = 0; pp < 2; ++pp) {
#pragma unroll
            for (int s = 0; s < 8; ++s) qf[s] = qn[s];
            { const int nti = pp == 0 ? ti : ti + 1, npp = pp ^ 1;
              if (nti < ntask) { const int tb32 = ((F.bid >> 3) * ntask + nti) * 8 + wave;
                  const bf16_t* qp = Q2 + ((((size_t)tb32 * 8 + h) * 2 + npp) * 8 * 2 + hi) * 256 + r32 * 8;
#pragma unroll
                  for (int s = 0; s < 8; ++s) qn[s] = *(const bf16x8*)(qp + s * 512); } }
            f32x16 acc[4];
#pragma unroll
            for (int kb = 0; kb < 4; ++kb)
#pragma unroll
                for (int r = 0; r < 16; ++r) acc[kb][r] = 0.f;
            att::lcp ab = (att::lcp)(lds + pp * 32768 + hi * 2048 + r32 * 16);
#pragma unroll
            for (int s = 0; s < 8; ++s)
#pragma unroll
                for (int kb = 0; kb < 4; ++kb) {
                    const bf16x8 a = *(const __attribute__((address_space(3))) bf16x8*)(ab + s * 4096 + kb * 512);
                    acc[kb] = __builtin_amdgcn_mfma_f32_32x32x16_bf16(a, qf[s], acc[kb], 0, 0, 0);
                }
            unsigned v0[16], v1[16], v2[16], v3[16];
#pragma unroll
            for (int r = 0; r < 16; ++r) {
                const int c = 127 - ((r & 3) + 8 * (r >> 2));
                v0[r] = (ord(acc[0][r]) & 0xFFFFFF80u) | (unsigned)(c - 0 - 4 * hi);
                v1[r] = (ord(acc[1][r]) & 0xFFFFFF80u) | (unsigned)(c - 32 - 4 * hi);
                v2[r] = (ord(acc[2][r]) & 0xFFFFFF80u) | (unsigned)(c - 64 - 4 * hi);
                v3[r] = (ord(acc[3][r]) & 0xFFFFFF80u) | (unsigned)(c - 96 - 4 * hi);
            }
            top16_of_64x2(v0, v1, v2, v3);
            if (pp == 0) {
#pragma unroll
                for (int i = 0; i < 16; ++i) A[i] = v0[i];
            } else {
#pragma unroll
                for (int i = 0; i < 16; ++i) B[i] = v0[i];
            }
        }
        float fa[16], fb[16];
#pragma unroll
        for (int i = 0; i < 16; ++i) { fa[i] = unord(A[i] & 0xFFFFFF80u); fb[i] = unord(B[i] & 0xFFFFFF80u);
            W[i * 64 + lane] = 127 - (int)(A[i] & 127u); W[(16 + i) * 64 + lane] = 127 - (int)(B[i] & 127u); }
        unsigned c0[16], c1[16], c2[16], c3[16];
#pragma unroll
        for (int j = 0; j < 16; ++j) c0[j] = (ord(fa[0] + fb[j]) & 0xFFFFFF00u) | (unsigned)(255 - j);
        {
            int n = 0;
#pragma unroll
            for (int i = 1; i < 16; ++i)
#pragma unroll
                for (int j = 0; j < 16; ++j) if ((i + 1) * (j + 1) <= 16) {
                    const unsigned key = (ord(fa[i] + fb[j]) & 0xFFFFFF00u) | (unsigned)(255 - (i * 16 + j));
                    if (n < 16) c1[n] = key; else if (n < 32) c2[n - 16] = key; else c3[n - 32] = key;
                    ++n;
                }
#pragma unroll
            for (int k = 2; k < 16; ++k) c3[k] = 0u;
        }
        sort16_desc(c1); sort16_desc(c2); sort16_desc(c3);
        merge_top16(c0, c1); merge_top16(c2, c3); merge_top16(c0, c2);
        float ev[16]; float l = 0.f; const float mx = unord(c0[0] & 0xFFFFFF00u);
#pragma unroll
        for (int k = 0; k < 16; ++k) { ev[k] = __expf(unord(c0[k] & 0xFFFFFF00u) - mx); l += ev[k]; }
        const float rl = 1.f / l;
        int ex[8]; float gt[8], su[8];
#pragma unroll
        for (int kk = 0; kk < 8; ++kk) {
            const unsigned key = hi ? c0[8 + kk] : c0[kk]; const float e = hi ? ev[8 + kk] : ev[kk];
            const int pos = 255 - (int)(key & 255u);
            ex[kk] = W[(pos >> 4) * 64 + lane] * 128 + W[(16 + (pos & 15)) * 64 + lane];
            gt[kk] = e * rl * VSC[ex[kk]]; su[kk] = USC[ex[kk]];
        }
        int* ep = EX + (size_t)t * 128 + h * 16 + hi * 8; float* gp = GT + (size_t)t * 128 + h * 16 + hi * 8;
        *(u32x4*)ep = (u32x4){(unsigned)ex[0], (unsigned)ex[1], (unsigned)ex[2], (unsigned)ex[3]}; *(u32x4*)(ep + 4) = (u32x4){(unsigned)ex[4], (unsigned)ex[5], (unsigned)ex[6], (unsigned)ex[7]};
        *(f32x4*)gp = (f32x4){gt[0], gt[1], gt[2], gt[3]}; *(f32x4*)(gp + 4) = (f32x4){gt[4], gt[5], gt[6], gt[7]};
        float* sp = SUo + (size_t)t * 128 + h * 16 + hi * 8;
        *(f32x4*)sp = (f32x4){su[0], su[1], su[2], su[3]}; *(f32x4*)(sp + 4) = (f32x4){su[4], su[5], su[6], su[7]};
    }
    __syncthreads();
}

#define P8_SYNC 0
#define P8_PARTITION 0
#define HAVE_P3 1
#define HAVE_P7 1
struct Args { Params p; int ph_lo, ph_hi, li, pad; };
__global__ void __launch_bounds__(NTHR, 2) mk_fwd(Args a) {
    extern __shared__ __attribute__((aligned(16))) unsigned char lds[];
    Frame F;
    F.lds = (LAS unsigned char*)lds;
    F.MISC = (volatile LAS unsigned*)(F.lds + MISC_OFF);
    F.tid = threadIdx.x; F.lane = F.tid & 63; F.wave = __builtin_amdgcn_readfirstlane(F.tid >> 6);
    F.G = gridDim.x; F.bid = blockIdx.x;
    const Params& p = a.p;
    gu32* ctl = (gu32*)(p.ws + WS_CTL);
    for (int u = F.tid; u < 128; u += NTHR) ((LAS unsigned*)(F.lds + MISC_OFF))[u] = 0u;
    __syncthreads();
    XcdBarrier bar = xcd_barrier_post((unsigned*)(ctl + CW_BAR) + a.li * XCD_BAR_WORDS, F.MISC + 8);
    const int lo = a.ph_lo, hi = a.ph_hi;
#ifdef PROBE_TS
    int nts_ = 0;
#define STAMP() do { if (threadIdx.x == 0 && nts_ < 12) { const unsigned long long t_ = __builtin_amdgcn_s_memrealtime(); F.MISC[32 + 2 * nts_] = (unsigned)t_; F.MISC[33 + 2 * nts_] = (unsigned)(t_ >> 32); } ++nts_; } while (0)
    STAMP();
#else
#define STAMP() do {} while (0)
#endif
#define IN(k) (lo <= (k) && (k) < hi)
#define REFRESH() do { F.lane = (int)__builtin_amdgcn_mbcnt_hi(~0u, __builtin_amdgcn_mbcnt_lo(~0u, 0u)); F.tid = F.wave * 64 + F.lane; } while (0)
#define SEAM(k) do { if (IN(k) && IN((k) + 1)) xcd_barrier(bar); STAMP(); } while (0)

#ifndef PROBE_DUP
#define PROBE_DUP -1
#endif
#define REP(k) for (int rep_ = 0; rep_ < (PROBE_DUP == (k) ? 2 : 1); ++rep_)
    if (IN(0)) { REP(0) p0_prologue(F, p); SEAM(0); }
    if (IN(1)) { REP(1) { p1_hrows(F, p); __syncthreads(); } SEAM(1); }
    if (IN(2)) {
        pg8::Gemm g{(const bf16_t*)(p.ws + WS_H), (const bf16_t*)(p.ws + WS_WIN), MALL, NQKV, D}; pg8::StaticOrder S; S.init(MALL, NQKV, F.G, F.bid);
        EpiQKVFast E{p.ws};
        REP(2) pg8::gemm_phase<EpiQKVFast, pg8::StaticOrder, true, true>(F.lds + RING_OFF, g, S, E);
        SEAM(2);
    }
#if HAVE_P3
    if (IN(3)) { REP(31) att::na_units(F, p); att::diff_units_v2<0>(F, p);
#if PROBE_DUP == 321
        att::diff_units_v2<1>(F, p);
#elif PROBE_DUP == 323
        att::diff_units_v2<3>(F, p);
#elif PROBE_DUP == 322
        att::diff_units_v2<2>(F, p);
#elif PROBE_DUP == 32
        att::diff_units_v2<0>(F, p);
#endif
        SEAM(3); }
#endif
    if (IN(4)) {
        pg8::Gemm g{(const bf16_t*)(p.ws + WS_Y), (const bf16_t*)(p.ws + WS_WOUT), MLAT, D, D}; pg8::StaticOrder S; S.init(MLAT, D, F.G, F.bid);
        pg8::EpiBf16<0> E{(bf16_t*)(p.ws + WS_YO), D, nullptr, 0, 0, 1.f};
        REP(4) pg8::gemm_phase<pg8::EpiBf16<0>, pg8::StaticOrder, true, true>(F.lds + RING_OFF, g, S, E);
        SEAM(4);
    }
    if (IN(5)) { REP(5) p5_rows2(F, p); SEAM(5); }
    if (IN(6)) {
        pg8::Gemm g{(const bf16_t*)(p.ws + WS_H2), (const bf16_t*)(p.ws + WS_WPQ), MLAT, 2048, D}; pg8::StaticOrder S; S.init(MLAT, 2048, F.G, F.bid);
        EpiQ2Frag E{(bf16_t*)(p.ws + WS_Q2)};
        REP(6) pg8::gemm_phase<EpiQ2Frag, pg8::StaticOrder, true, true>(F.lds + RING_OFF, g, S, E);
        SEAM(6);
    }
#if HAVE_P7
    if (IN(7)) { REP(7) p7_topk(F, p); SEAM(7); }
#endif
#if P8_PARTITION
    if (IN(8)) {
        p7b_sort(F, p); xcd_barrier(bar);
        for (int ch = 0; ch < 2; ++ch) { p8a_part(F, p, ch); xcd_barrier(bar); p8b_combine(F, p, ch); if (ch == 0) xcd_barrier(bar); }
    }
#else
    if (IN(8)) { p8_gather<0>(F, p, bar); }
#endif
#ifdef PROBE_TS
#ifdef PROBE_TS_ENDBAR
    xcd_barrier(bar);
#endif
    STAMP();
    if (blockIdx.x == 0 && threadIdx.x == 0) { const unsigned long long t1_ = ((unsigned long long)F.MISC[33 + 2 * (PROBE_TS + 1)] << 32) | F.MISC[32 + 2 * (PROBE_TS + 1)], t0_ = ((unsigned long long)F.MISC[33 + 2 * PROBE_TS] << 32) | F.MISC[32 + 2 * PROBE_TS];
        const unsigned long long dt = t1_ - t0_; const unsigned long long t_end = __builtin_amdgcn_s_memrealtime();
        while (__builtin_amdgcn_s_memrealtime() - t_end < 8ull * dt) __builtin_amdgcn_s_sleep(8); }
#endif
#undef IN
#undef SEAM
}

static void launch_mk(const Params& p, int lo, int hi, int li, hipStream_t stream) {
    Args a{}; a.p = p; a.ph_lo = lo; a.ph_hi = hi; a.li = li; a.pad = 0;
    hipLaunchKernelGGL(mk_fwd, dim3(256), dim3(NTHR), LDS_BYTES, stream, a);
}
extern "C" void kernel_launch(void* const* d_in, const int* in_sizes, int n_in, void* d_out, int out_size, void* d_ws, size_t ws_size, hipStream_t stream) {
    if (n_in != 16 || ws_size < WS_END) return;
    static bool attr_done = false;
    if (!attr_done) {
        (void)hipFuncSetAttribute((const void*)mk_fwd, hipFuncAttributeMaxDynamicSharedMemorySize, LDS_BYTES);
        attr_done = true;
    }
    Params p{};
    p.x = (const float*)d_in[0]; p.c = (const float*)d_in[1]; p.ctx = (const float*)d_in[2]; p.c_ctx = (const float*)d_in[3];
    p.w_ada = (const float*)d_in[4]; p.b_ada = (const float*)d_in[5]; p.g_norm = (const float*)d_in[6]; p.w_in = (const float*)d_in[7];
    p.rel_bias = (const float*)d_in[8]; p.diff_lambda = (const float*)d_in[9]; p.diff_subln = (const float*)d_in[10]; p.w_out = (const float*)d_in[11];
    p.peer_wq = (const float*)d_in[12]; p.peer_keys = (const float*)d_in[13]; p.peer_u = (const float*)d_in[14]; p.peer_v = (const float*)d_in[15];
    p.out = (float*)d_out; p.ws = (unsigned char*)d_ws;
    (void)hipMemsetAsync((char*)d_ws + WS_CTL, 0, CTL_ZERO_BYTES, stream);

    launch_mk(p, 0, 9, 0, stream);

}
```

```cpp
#include <hip/hip_runtime.h>
#include <stdint.h>
#include <math.h>

typedef unsigned short bf16_t;
typedef float f32x4 __attribute__((ext_vector_type(4)));
typedef unsigned u32x4 __attribute__((ext_vector_type(4)));
typedef unsigned u32x2 __attribute__((ext_vector_type(2)));
typedef float f32x2 __attribute__((ext_vector_type(2)));

constexpr int D = 1024, BATCH = 8, SEQ = 4096, CTX = 256, GW = 64;
constexpr int MLAT = BATCH * SEQ;
constexpr int MCTX = BATCH * CTX;
constexpr int MALL = MLAT + MCTX;
constexpr int NQKV = 3072;
constexpr int NKT = 68;
constexpr int NMOD = 6 * D;
constexpr int PE_H = 8, PE_NK = 128, PE_QD = 256, PE_TOPK = 16, PE_NEXP = 16384;
constexpr float EPS = 1e-6f;
constexpr float LOG2E = 1.4426950408889634f;
constexpr float C2 = 0.125f * LOG2E;
constexpr float LAMBDA_INIT = 0.2f;
constexpr float NEG_BIG = -30000.0f;

constexpr size_t MiB = 1u << 20;
constexpr size_t WS_CTL = 0;
constexpr size_t WS_MOD = 1 * MiB;
constexpr size_t WS_LAM = 1 * MiB + 256 * 1024;
constexpr size_t WS_ROPE = 1 * MiB + 512 * 1024;
constexpr size_t WS_USC = 1 * MiB + 640 * 1024;
constexpr size_t WS_VSC = 1 * MiB + 704 * 1024;
constexpr size_t WS_MODP = 2 * MiB;
constexpr size_t WS_BIAST = 4 * MiB;
constexpr size_t WS_KEYS = 5 * MiB;
constexpr size_t WS_KEYSI = 5 * MiB + 512 * 1024;
constexpr size_t WS_WIN = 6 * MiB;
constexpr size_t WS_WOUT = 12 * MiB;
constexpr size_t WS_WPQ = 14 * MiB;
constexpr size_t WS_UB = 18 * MiB;
constexpr size_t WS_VB = 50 * MiB;
constexpr size_t WS_EXP = 82 * MiB;
constexpr size_t WS_GATE = 98 * MiB;
constexpr size_t WS_H2 = 114 * MiB;
constexpr size_t WS_H = 178 * MiB;
constexpr size_t WS_Y = 178 * MiB;
constexpr size_t WS_QA = 246 * MiB;
constexpr size_t WS_KA = 278 * MiB;
constexpr size_t WS_VA = 312 * MiB;
constexpr size_t WS_QD = 346 * MiB;
constexpr size_t WS_KD = 378 * MiB;
constexpr size_t WS_VD = 412 * MiB;
constexpr size_t WS_YO = 246 * MiB;
constexpr size_t WS_Q2 = 246 * MiB;
constexpr size_t WS_PART = 178 * MiB;
constexpr size_t WS_DSCR = 464 * MiB;
constexpr size_t WS_SU = 446 * MiB;
constexpr size_t WS_END = 496 * MiB;

struct Params {
    const float *x, *c, *ctx, *c_ctx, *w_ada, *b_ada, *g_norm, *w_in, *rel_bias, *diff_lambda, *diff_subln, *w_out, *peer_wq, *peer_keys, *peer_u, *peer_v;
    float* out;
    unsigned char* ws;
};

__device__ __forceinline__ unsigned f2bf(float f) { unsigned u = __builtin_bit_cast(unsigned, f); return (u + 0x7fffu + ((u >> 16) & 1u)) >> 16; }
__device__ __forceinline__ unsigned pk2(float lo, float hi) { return f2bf(lo) | (f2bf(hi) << 16); }
__device__ __forceinline__ float bf2f(bf16_t h) { return __builtin_bit_cast(float, (unsigned)h << 16); }
__device__ __forceinline__ float bflo(unsigned w) { return __builtin_bit_cast(float, w << 16); }
__device__ __forceinline__ float bfhi(unsigned w) { return __builtin_bit_cast(float, w & 0xffff0000u); }
__device__ __forceinline__ float wave_sum(float v) {
    v += __uint_as_float((unsigned)__builtin_amdgcn_update_dpp(0, (int)__float_as_uint(v), 0xB1, 0xf, 0xf, false));
    v += __uint_as_float((unsigned)__builtin_amdgcn_update_dpp(0, (int)__float_as_uint(v), 0x4E, 0xf, 0xf, false));
    v += __uint_as_float((unsigned)__builtin_amdgcn_update_dpp(0, (int)__float_as_uint(v), 0x141, 0xf, 0xf, false));
    v += __uint_as_float((unsigned)__builtin_amdgcn_update_dpp(0, (int)__float_as_uint(v), 0x128, 0xf, 0xf, false));
    { auto r = __builtin_amdgcn_permlane16_swap(__float_as_uint(v), __float_as_uint(v), false, false); v = __uint_as_float(r[0]) + __uint_as_float(r[1]); }
    { auto r = __builtin_amdgcn_permlane32_swap(__float_as_uint(v), __float_as_uint(v), false, false); v = __uint_as_float(r[0]) + __uint_as_float(r[1]); }
    return v;
}
__device__ __forceinline__ float wave_max(float v) {
    v = fmaxf(v, __uint_as_float((unsigned)__builtin_amdgcn_update_dpp(0, (int)__float_as_uint(v), 0xB1, 0xf, 0xf, false)));
    v = fmaxf(v, __uint_as_float((unsigned)__builtin_amdgcn_update_dpp(0, (int)__float_as_uint(v), 0x4E, 0xf, 0xf, false)));
    v = fmaxf(v, __uint_as_float((unsigned)__builtin_amdgcn_update_dpp(0, (int)__float_as_uint(v), 0x141, 0xf, 0xf, false)));
    v = fmaxf(v, __uint_as_float((unsigned)__builtin_amdgcn_update_dpp(0, (int)__float_as_uint(v), 0x128, 0xf, 0xf, false)));
    { auto r = __builtin_amdgcn_permlane16_swap(__float_as_uint(v), __float_as_uint(v), false, false); v = fmaxf(__uint_as_float(r[0]), __uint_as_float(r[1])); }
    { auto r = __builtin_amdgcn_permlane32_swap(__float_as_uint(v), __float_as_uint(v), false, false); v = fmaxf(__uint_as_float(r[0]), __uint_as_float(r[1])); }
    return v;
}

__device__ __forceinline__ float half_max(float v) {
    v = fmaxf(v, __uint_as_float((unsigned)__builtin_amdgcn_update_dpp(0, (int)__float_as_uint(v), 0xB1, 0xf, 0xf, false)));
    v = fmaxf(v, __uint_as_float((unsigned)__builtin_amdgcn_update_dpp(0, (int)__float_as_uint(v), 0x4E, 0xf, 0xf, false)));
    v = fmaxf(v, __uint_as_float((unsigned)__builtin_amdgcn_update_dpp(0, (int)__float_as_uint(v), 0x141, 0xf, 0xf, false)));
    v = fmaxf(v, __uint_as_float((unsigned)__builtin_amdgcn_update_dpp(0, (int)__float_as_uint(v), 0x128, 0xf, 0xf, false)));
    { auto r = __builtin_amdgcn_permlane16_swap(__float_as_uint(v), __float_as_uint(v), false, false); v = fmaxf(__uint_as_float(r[0]), __uint_as_float(r[1])); }
    return v;
}
typedef float f32x16 __attribute__((ext_vector_type(16)));
typedef float f32x32 __attribute__((ext_vector_type(32)));
typedef unsigned u32x6 __attribute__((ext_vector_type(6)));

__device__ __forceinline__ u32x6 enc_fp6(f32x16 a, f32x16 b) { u32x6 w; asm volatile("v_cvt_scalef32_2xpk16_fp6_f32 %0, %1, %2, 1.0" : "=&v"(w) : "v"(a), "v"(b)); return w; }
__device__ __forceinline__ f32x32 dec_fp6(u32x6 w) { f32x32 r; asm volatile("v_cvt_scalef32_pk32_f32_fp6 %0, %1, 1.0" : "=&v"(r) : "v"(w)); return r; }

__device__ __forceinline__ int ktile_off(int k, int d) { return (d >> 3) * 512 + k * 8 + (d & 7); }
__device__ __forceinline__ int vtile_off(int k, int d) { return (d >> 5) * 2048 + (k >> 4) * 512 + (k & 15) * 32 + (d & 31); }
__device__ __forceinline__ size_t qa_idx(int b, int h, int t, int d) { return ((size_t)(b * 8 + h) * SEQ + t) * 64 + d; }
__device__ __forceinline__ size_t ka_idx(int b, int h, int j, int d) { return ((size_t)(b * 8 + h) * NKT + (j >> 6)) * 4096 + ktile_off(j & 63, d); }
__device__ __forceinline__ size_t va_idx(int b, int h, int j, int d) { return ((size_t)(b * 8 + h) * NKT + (j >> 6)) * 4096 + vtile_off(j & 63, d); }
__device__ __forceinline__ size_t qd_idx(int b, int m, int h, int t, int d) { return ((size_t)((b * 2 + m) * 4 + h) * SEQ + t) * 64 + d; }
__device__ __forceinline__ size_t kd_idx(int b, int m, int h, int j, int d) { return ((size_t)((b * 2 + m) * 4 + h) * NKT + (j >> 6)) * 4096 + ktile_off(j & 63, d); }
__device__ __forceinline__ size_t vd_idx(int b, int h, int j, int d) { return ((size_t)(b * 4 + h) * NKT + (j >> 6)) * 8192 + vtile_off(j & 63, d); }


namespace pg8 {
#define PG8_LAS __attribute__((address_space(3)))
typedef unsigned short bf16_t;
typedef short bf16x8 __attribute__((ext_vector_type(8)));
typedef float f32x4 __attribute__((ext_vector_type(4)));
typedef unsigned u32x4 __attribute__((ext_vector_type(4)));
constexpr int BM = 256, BK = 64, HALF = 128, HTB = HALF * BK * 2  , STAGE_BYTES = 8 * HTB, NXCD = 8, WGM = 8;

__host__ __device__ __forceinline__ int lds_byte(int r, int c) { const int st = (r >> 4) * 2 + (c >> 5), rr = r & 15, cc = c & 31, ob = rr * 64 + cc * 2; return st * 1024 + (ob ^ (((ob >> 9) & 1) << 5)); }
__host__ __device__ __forceinline__ void stage_rc(int b, int& R, int& C) { const int st = b / 1024, sb = b % 1024, swz = sb ^ (((sb >> 9) & 1) << 5); R = (st >> 1) * 16 + swz / 64; C = (st & 1) * 32 + (swz % 64) / 2; }
__host__ __device__ __forceinline__ int perm32(int rho) { const int n = rho >> 4, i = rho & 15; return 8 * (i >> 2) + 4 * n + (i & 3); }

struct Unit { int pm, pn; };
struct Gemm { const bf16_t* A; const bf16_t* Bt; int M, N, K; };

struct StaticOrder {
    int nM, nN, nwg, G, c;
    __host__ __device__ void init(int M, int N, int G_, int c_) { nM = M / BM; nN = N / BM; nwg = nM * nN; G = G_; c = c_; }
    __host__ __device__ bool next(int i, Unit& u) const {
        const long L = (long)i * G + c; if (L >= nwg) return false;
        int wgid = (int)L; { const int q = nwg / NXCD, r = nwg % NXCD, xcd = wgid % NXCD, off = wgid / NXCD; wgid = (xcd < r ? xcd * (q + 1) : r * (q + 1) + (xcd - r) * q) + off; }
        const int nig = WGM * nN, gid = wgid / nig, fm = gid * WGM, gsz = (nM - fm) < WGM ? (nM - fm) : WGM;
        u.pm = fm + ((wgid % nig) % gsz); u.pn = (wgid % nig) / gsz; return true;
    }
    __device__ __forceinline__ void a_ready(const Unit&) const {}
    __device__ __forceinline__ void done(const Unit&) const {}
};

__device__ __forceinline__ unsigned cvt_pk_bf16(float lo, float hi) { unsigned r; asm volatile("v_cvt_pk_bf16_f32 %0, %1, %2" : "=v"(r) : "v"(lo), "v"(hi)); return r; }
typedef float f32x2 __attribute__((ext_vector_type(2)));
__device__ __forceinline__ f32x2 gelu_pk(f32x2 v) {
    const f32x2 av = __builtin_elementwise_abs(v), d = av * 0.2316418882f + 1.0f;
    f32x2 t; t.x = __builtin_amdgcn_rcpf(d.x); t.y = __builtin_amdgcn_rcpf(d.y);
    f32x2 q = t * 0.5307027145f + (-0.7265760135f); q = q * t + 0.7107068705f; q = q * t + (-0.142248368f); q = q * t + 0.127414796f; q = q * t;
    const f32x2 s = (v * v) * (-0.72134752044f);
    f32x2 e; e.x = __builtin_amdgcn_exp2f(s.x); e.y = __builtin_amdgcn_exp2f(s.y);
    const f32x2 m = v * (q * e), r = v - m;
    f32x2 o; o.x = v.x < 0.f ? m.x : r.x; o.y = v.y < 0.f ? m.y : r.y; return o;
}

template <int ACT  > struct EpiBf16 {
    static constexpr bool PERM = true, AFTER_DRAIN = false; static_assert(ACT == 0 || ACT == 1, "EpiBf16: ACT is 0 (none) or 1 (gelu_pk)");
    bf16_t* O; int ldc; const float* bias; int split_cols; size_t split_stride; float scale0;
    __device__ __forceinline__ void operator()(const f32x4 (&acc)[2][2][4][2], const Unit& u, int wr, int wc, int fr, int fq) const {
        const int row0 = u.pm * BM + wr * 64 + fr; int colt = u.pn * BM; bf16_t* base = O;
        float sc = 1.f; if (split_cols) { const int t = colt / split_cols; base += (size_t)t * split_stride; colt -= t * split_cols; if (t == 0) sc = scale0; }
        const int col0 = colt + wc * 32 + 8 * fq, bcol0 = u.pn * BM + wc * 32 + 8 * fq;
        f32x4 bv[2][2];
#pragma unroll
        for (int bj = 0; bj < 2; ++bj)
#pragma unroll
            for (int n = 0; n < 2; ++n) bv[bj][n] = bias ? *(const f32x4*)(bias + bcol0 + bj * HALF + 4 * n) : (f32x4){0.f, 0.f, 0.f, 0.f};
#pragma unroll
        for (int ai = 0; ai < 2; ++ai)
#pragma unroll
            for (int m = 0; m < 4; ++m) { bf16_t* rowp = base + (size_t)(row0 + ai * HALF + m * 16) * ldc + col0;
#pragma unroll
                for (int bj = 0; bj < 2; ++bj) { f32x4 v0 = acc[ai][bj][m][0] + bv[bj][0], v1 = acc[ai][bj][m][1] + bv[bj][1];
                    if (ACT == 1) { f32x2 a = gelu_pk((f32x2){v0[0], v0[1]}), b = gelu_pk((f32x2){v0[2], v0[3]}), c = gelu_pk((f32x2){v1[0], v1[1]}), d = gelu_pk((f32x2){v1[2], v1[3]});
                        v0 = (f32x4){a.x, a.y, b.x, b.y}; v1 = (f32x4){c.x, c.y, d.x, d.y}; }
                    v0 = v0 * sc; v1 = v1 * sc; u32x4 w; w.x = cvt_pk_bf16(v0[0], v0[1]); w.y = cvt_pk_bf16(v0[2], v0[3]); w.z = cvt_pk_bf16(v1[0], v1[1]); w.w = cvt_pk_bf16(v1[2], v1[3]);
                    *(u32x4*)(rowp + bj * HALF) = w; } }
    }
};

template <class Epi, class Sched, bool ALIGN_EPI = false, bool SP2 = false>
__device__ __forceinline__ void gemm_phase(PG8_LAS unsigned char* lds, const Gemm g, const Sched& S, const Epi& E) {
    const int tid = threadIdx.x, wid = __builtin_amdgcn_readfirstlane(tid >> 6), lane = tid & 63, wr = wid >> 2, wc = wid & 3, fr = lane & 15, fq = lane >> 4;
    const int K = g.K, nt = K / BK;
    unsigned voffA[2], voffB[2];
#pragma unroll
    for (int i = 0; i < 2; ++i) { int R, C; stage_rc(tid * 16 + i * 8192, R, C); const int Rb = Epi::PERM ? ((R & ~31) + perm32(R & 31)) : R;
        voffA[i] = (unsigned)(R * K + C) * 2u; voffB[i] = (unsigned)(Rb * K + C) * 2u; }
    const size_t kstep = (size_t)(BK * 2);
    const size_t hstep = (size_t)HALF * K * 2;
    const size_t tstep = 2 * hstep;
    const unsigned ldsw = (unsigned)wid * 1024u;
    const int aoff = lds_byte(wr * 64 + fr, fq * 8), boff = lds_byte(wc * 32 + fr, fq * 8);
#define PG8_SA(b, h) (((b) * 2 + (h)) * HTB)
#define PG8_SB(b, h) ((4 + (b) * 2 + (h)) * HTB)
#define PG8_STAGE(bufoff, gbase, voff) do { _Pragma("unroll") for (int _i = 0; _i < 2; ++_i) \
        __builtin_amdgcn_global_load_lds((const unsigned*)((const char*)(gbase) + (voff)[_i]), (PG8_LAS unsigned*)(lds + (bufoff) + ldsw + _i * 8192), 16, 0, 0); } while (0)
#define PG8_LDA(dst, b, h) do { _Pragma("unroll") for (int m = 0; m < 4; ++m) _Pragma("unroll") for (int k = 0; k < 2; ++k) dst[m][k] = *(const PG8_LAS bf16x8*)(lds + PG8_SA(b, h) + aoff + m * 2048 + k * 1024); } while (0)
#define PG8_LDB(dst, b, h) do { _Pragma("unroll") for (int n = 0; n < 2; ++n) _Pragma("unroll") for (int k = 0; k < 2; ++k) dst[n][k] = *(const PG8_LAS bf16x8*)(lds + PG8_SB(b, h) + boff + n * 2048 + k * 1024); } while (0)
#define PG8_MMA(ai, bj, At, Bt) do { __builtin_amdgcn_s_setprio(1); _Pragma("unroll") for (int m = 0; m < 4; ++m) _Pragma("unroll") for (int n = 0; n < 2; ++n) _Pragma("unroll") for (int k = 0; k < 2; ++k) \
        acc[ai][bj][m][n] = __builtin_amdgcn_mfma_f32_16x16x32_bf16(Bt[n][k], At[m][k], acc[ai][bj][m][n], 0, 0, 0); __builtin_amdgcn_s_setprio(0); } while (0)
#define PG8_WAIT_V(n) asm volatile("s_waitcnt vmcnt(" #n ")" ::: "memory")
#define PG8_WAIT_L(n) asm volatile("s_waitcnt lgkmcnt(" #n ")" ::: "memory")
#define PG8_BAR __builtin_amdgcn_s_barrier()
#define PG8_SCHED __builtin_amdgcn_sched_barrier(0)
    Unit cur, nxt; int ui = 0;
    if (!S.next(0, cur)) return;
    f32x4 acc[2][2][4][2];
#pragma unroll
    for (int a = 0; a < 2; ++a)
#pragma unroll
        for (int b = 0; b < 2; ++b)
#pragma unroll
            for (int m = 0; m < 4; ++m)
#pragma unroll
                for (int n = 0; n < 2; ++n) acc[a][b][m][n] = (f32x4){0.f, 0.f, 0.f, 0.f};
    bf16x8 At[4][2], B0[2][2], B1[2][2];
    const char* cA = (const char*)g.A + (size_t)cur.pm * tstep; const char* cB = (const char*)g.Bt + (size_t)cur.pn * tstep;
    S.a_ready(cur);
    if constexpr (SP2) {
        PG8_STAGE(PG8_SB(0, 0), cB, voffB); PG8_STAGE(PG8_SB(0, 1), cB + hstep, voffB); PG8_STAGE(PG8_SA(0, 0), cA, voffA); PG8_STAGE(PG8_SA(0, 1), cA + hstep, voffA);
        if (wr == 1) PG8_BAR;
        PG8_WAIT_V(2); PG8_BAR;
        PG8_STAGE(PG8_SB(1, 0), cB + kstep, voffB); PG8_STAGE(PG8_SA(1, 0), cA + kstep, voffA); PG8_STAGE(PG8_SB(1, 1), cB + hstep + kstep, voffB);
        PG8_WAIT_V(6); PG8_BAR;
    } else {
        PG8_STAGE(PG8_SB(0, 0), cB, voffB); PG8_STAGE(PG8_SA(0, 0), cA, voffA); PG8_STAGE(PG8_SB(0, 1), cB + hstep, voffB); PG8_STAGE(PG8_SA(0, 1), cA + hstep, voffA);
        if (wr == 1) PG8_BAR;
        PG8_WAIT_V(4); PG8_BAR;
        PG8_STAGE(PG8_SB(1, 0), cB + kstep, voffB); PG8_STAGE(PG8_SA(1, 0), cA + kstep, voffA); PG8_STAGE(PG8_SB(1, 1), cB + hstep + kstep, voffB);
        PG8_WAIT_V(6); PG8_BAR;
    }
    for (;;) {
        const bool has_next = S.next(ui + 1, nxt);
        const char* nA = has_next ? (const char*)g.A + (size_t)nxt.pm * tstep : cA; const char* nB = has_next ? (const char*)g.Bt + (size_t)nxt.pn * tstep : cB;
        for (int t = 0; t < nt; t += 2) {
            const bool last = (t == nt - 2);
            const char* a1 = cA + (size_t)(t + 1) * kstep;
            const char* a2 = last ? nA : cA + (size_t)(t + 2) * kstep; const char* b2 = last ? nB : cB + (size_t)(t + 2) * kstep;
            const char* a3 = a2 + kstep; const char* b3 = b2 + kstep;
            if (last && has_next) S.a_ready(nxt);
            if constexpr (SP2) {
            PG8_LDB(B0, 0, 0); PG8_LDB(B1, 0, 1); PG8_SCHED; PG8_LDA(At, 0, 0); PG8_STAGE(PG8_SA(1, 1), a1 + hstep, voffA);
            PG8_WAIT_V(8); PG8_WAIT_L(0); PG8_BAR; PG8_MMA(0, 0, At, B0); PG8_MMA(0, 1, At, B1); PG8_BAR; PG8_SCHED;
            PG8_LDA(At, 0, 1); PG8_STAGE(PG8_SB(0, 0), b2, voffB); PG8_STAGE(PG8_SB(0, 1), b2 + hstep, voffB); PG8_STAGE(PG8_SA(0, 0), a2, voffA);
            PG8_WAIT_V(8); PG8_WAIT_L(0); PG8_BAR; PG8_MMA(1, 0, At, B0); PG8_MMA(1, 1, At, B1); PG8_BAR; PG8_SCHED;
            PG8_LDB(B0, 1, 0); PG8_LDB(B1, 1, 1); PG8_SCHED; PG8_LDA(At, 1, 0); PG8_STAGE(PG8_SA(0, 1), a2 + hstep, voffA);
            PG8_WAIT_V(8); PG8_WAIT_L(0); PG8_BAR; PG8_MMA(0, 0, At, B0); PG8_MMA(0, 1, At, B1); PG8_BAR; PG8_SCHED;
            PG8_LDA(At, 1, 1); PG8_STAGE(PG8_SB(1, 0), b3, voffB); PG8_STAGE(PG8_SB(1, 1), b3 + hstep, voffB); PG8_STAGE(PG8_SA(1, 0), a3, voffA);
            PG8_WAIT_V(8); PG8_WAIT_L(0); PG8_BAR; PG8_MMA(1, 0, At, B0); PG8_MMA(1, 1, At, B1); PG8_BAR; PG8_SCHED;
            } else {
            PG8_LDB(B0, 0, 0); PG8_SCHED; PG8_LDA(At, 0, 0); PG8_STAGE(PG8_SA(1, 1), a1 + hstep, voffA);
            PG8_WAIT_L(8); PG8_BAR; PG8_WAIT_L(0); PG8_MMA(0, 0, At, B0); PG8_BAR; PG8_SCHED;
            PG8_LDB(B1, 0, 1); PG8_STAGE(PG8_SB(0, 0), b2, voffB);
            PG8_BAR; PG8_WAIT_L(0); PG8_MMA(0, 1, At, B1); PG8_BAR;
            PG8_LDA(At, 0, 1); PG8_STAGE(PG8_SA(0, 0), a2, voffA);
            PG8_BAR; PG8_WAIT_L(0); PG8_MMA(1, 0, At, B0); PG8_BAR; PG8_SCHED;
            PG8_STAGE(PG8_SB(0, 1), b2 + hstep, voffB);
            PG8_WAIT_V(6); PG8_BAR; PG8_MMA(1, 1, At, B1); PG8_BAR;
            PG8_LDB(B0, 1, 0); PG8_SCHED; PG8_LDA(At, 1, 0); PG8_STAGE(PG8_SA(0, 1), a2 + hstep, voffA);
            PG8_WAIT_L(8); PG8_BAR; PG8_WAIT_L(0); PG8_MMA(0, 0, At, B0); PG8_BAR; PG8_SCHED;
            PG8_LDB(B1, 1, 1); PG8_STAGE(PG8_SB(1, 0), b3, voffB);
            PG8_BAR; PG8_WAIT_L(0); PG8_MMA(0, 1, At, B1); PG8_BAR;
            PG8_LDA(At, 1, 1); PG8_STAGE(PG8_SA(1, 0), a3, voffA);
            PG8_BAR; PG8_WAIT_L(0); PG8_MMA(1, 0, At, B0); PG8_BAR; PG8_SCHED;
            PG8_STAGE(PG8_SB(1, 1), b3 + hstep, voffB);
            PG8_WAIT_V(6); PG8_BAR; PG8_MMA(1, 1, At, B1); PG8_BAR;
            }
        }
        if constexpr (ALIGN_EPI) { if (wr == 0) PG8_BAR; }
        if constexpr (!Epi::AFTER_DRAIN) { E(acc, cur, wr, wc, fr, fq); S.done(cur); }
        if (!has_next) break;
#pragma unroll
        for (int a = 0; a < 2; ++a)
#pragma unroll
            for (int b = 0; b < 2; ++b)
#pragma unroll
                for (int m = 0; m < 4; ++m)
#pragma unroll
                    for (int n = 0; n < 2; ++n) acc[a][b][m][n] = (f32x4){0.f, 0.f, 0.f, 0.f};
        cur = nxt; cA = nA; cB = nB; ++ui;
        if constexpr (ALIGN_EPI) { if (wr == 1) PG8_BAR; }
    }
    PG8_WAIT_V(0);
    if constexpr (!ALIGN_EPI) { if (wr == 0) PG8_BAR; }
    PG8_BAR;
    if constexpr (Epi::AFTER_DRAIN) { E.fused(acc, cur, wr, wc, fr, fq, lds, wid, lane); S.done(cur); }
#undef PG8_SA
#undef PG8_SB
#undef PG8_STAGE
#undef PG8_LDA
#undef PG8_LDB
#undef PG8_MMA
#undef PG8_WAIT_V
#undef PG8_WAIT_L
#undef PG8_BAR
#undef PG8_SCHED
}
}

#define GAS __attribute__((address_space(1)))
#define LAS __attribute__((address_space(3)))
typedef unsigned v4u __attribute__((ext_vector_type(4)));
typedef float f32x4 __attribute__((ext_vector_type(4)));
typedef short bf16x8 __attribute__((ext_vector_type(8)));
typedef GAS unsigned gu32;
typedef GAS unsigned long long gu64;
#define RLX_AGENT __ATOMIC_RELAXED, __HIP_MEMORY_SCOPE_AGENT
#define LDS_WAIT() asm volatile("s_waitcnt lgkmcnt(0)" ::: "memory")
#define VM_WAIT() asm volatile("s_waitcnt vmcnt(0)" ::: "memory")
__device__ __forceinline__ unsigned long long rt() { return __builtin_amdgcn_s_memrealtime(); }

#define XB_TMO      128
#define XB_XCNT(j)  (256  + 64 * (j))
#define XB_XSUB(j)  (1280 + 64 * (j))
#define XB_XGEN(j)  (2304 + 64 * (j))
#define XB_TOP      3328
#define XB_TOPGEN   3392
#define XCD_BAR_WORDS 3456
#define XB_SPIN_CAP (1u << 18)

__device__ __forceinline__ unsigned xb_ld(unsigned* p)              { return __hip_atomic_load(p, __ATOMIC_RELAXED, __HIP_MEMORY_SCOPE_AGENT); }
__device__ __forceinline__ unsigned xb_add(unsigned* p, unsigned v) { return __hip_atomic_fetch_add(p, v, __ATOMIC_RELAXED, __HIP_MEMORY_SCOPE_AGENT); }
__device__ __forceinline__ unsigned xb_xcc_id() { return (unsigned)__builtin_amdgcn_s_getreg((3 << 11) | 20) & 0xFu; }
#define XB_SPIN(cond, bar) do { unsigned _sp = 0; while (cond) { __builtin_amdgcn_s_sleep(1); \
    if ((++_sp & 255u) == 0u) { if (xb_ld(&(bar)[XB_TMO])) break; if (_sp > XB_SPIN_CAP) { atomicAdd(&(bar)[XB_TMO], 1u); break; } } } } while (0)

struct XcdBarrier {
    unsigned* bar; unsigned x;
    volatile LAS unsigned* st;
};

__device__ __forceinline__ XcdBarrier xcd_barrier_post(unsigned* bar, volatile LAS unsigned* st) {
    XcdBarrier b; b.bar = bar; b.x = xb_xcc_id(); b.st = st;
    if (threadIdx.x == 0) (void)xb_add(&bar[XB_XCNT(b.x)], 1u);
    return b;
}
__device__ __forceinline__ void xcd_barrier_complete(unsigned* bar, unsigned x, unsigned& nloc, unsigned& nx) {
    const unsigned G = gridDim.x * gridDim.y * gridDim.z;
    unsigned sum, cnt, mine, sp = 0u;
    for (;;) {
        sum = 0u; cnt = 0u; mine = 0u;
#pragma unroll
        for (unsigned j = 0; j < 16; ++j) { const unsigned c = xb_ld(&bar[XB_XCNT(j)]); sum += c; cnt += (c > 0u) ? 1u : 0u; mine = (j == x) ? c : mine; }
        if (sum == G) break;
        __builtin_amdgcn_s_sleep(1);
        if ((++sp & 255u) == 0u) { if (xb_ld(&bar[XB_TMO])) break; if (sp > XB_SPIN_CAP) { atomicAdd(&bar[XB_TMO], 1u); break; } }
    }
    nloc = mine > 0u ? mine : 1u; nx = cnt > 0u ? cnt : 1u;
}

__device__ __forceinline__ void xcd_barrier(const XcdBarrier& b) {
    asm volatile("s_waitcnt vmcnt(0)" ::: "memory");
    __syncthreads();
    if (threadIdx.x == 0) {
        unsigned* bar = b.bar;
        __builtin_amdgcn_s_waitcnt(0);
        unsigned nloc = b.st[0], nx = b.st[1];
        if (nloc == 0u) { xcd_barrier_complete(bar, b.x, nloc, nx); b.st[0] = nloc; b.st[1] = nx; }
        const unsigned old = xb_add(&bar[XB_XSUB(b.x)], 1u);
        const unsigned gen = old / nloc;
        if (old + 1u == (gen + 1u) * nloc) {
            __builtin_amdgcn_fence(__ATOMIC_RELEASE, "agent");
            asm volatile("s_waitcnt vmcnt(0)" ::: "memory");
            const unsigned og = xb_add(&bar[XB_TOP], 1u);
            const unsigned tg = og / nx;
            if (og + 1u == (tg + 1u) * nx) xb_add(&bar[XB_TOPGEN], 1u);
            else XB_SPIN(xb_ld(&bar[XB_TOPGEN]) == tg, bar);
            __builtin_amdgcn_fence(__ATOMIC_ACQUIRE, "agent");
            xb_add(&bar[XB_XGEN(b.x)], 1u);
            asm volatile("s_waitcnt vmcnt(0)" ::: "memory");
        } else {
            XB_SPIN(xb_ld(&bar[XB_XGEN(b.x)]) == gen, bar);
            __builtin_amdgcn_fence(__ATOMIC_ACQUIRE, "agent");
            asm volatile("s_waitcnt vmcnt(0)" ::: "memory");
        }
    }
    __syncthreads();
}

constexpr int NWAVES = 8, NTHR = 512;
constexpr int RING_OFF = 0, RING_BYTES = 131072;
constexpr int LDS_BYTES = 159744;
constexpr int MISC_OFF = LDS_BYTES - 512;
constexpr size_t CTL_ZERO_BYTES = 65536;
constexpr int CW_P8CTR = 2048;
constexpr int CW_BAR = 4096;

struct Frame {
    LAS unsigned char* lds;
    volatile LAS unsigned* MISC;
    int tid, lane, wave, G, bid;
};

__device__ __forceinline__ void p0_transpose_item(const float* W, int K, int N, bf16_t* WT, LAS float* scr, int item, int lane) {
    const int nblk = N / 32, kb = item / nblk, nb = item % nblk, k0 = 64 * kb, n0 = 32 * nb;
    float tv[32];
#pragma unroll
    for (int i = 0; i < 32; ++i) tv[i] = W[(size_t)(k0 + 2 * i + (lane >> 5)) * N + n0 + (lane & 31)];
#pragma unroll
    for (int i = 0; i < 32; ++i) scr[(2 * i + (lane >> 5)) * 33 + (lane & 31)] = tv[i];
    LDS_WAIT(); asm volatile("" ::: "memory");
    const int c = lane & 7;
#pragma unroll
    for (int j = 0; j < 4; ++j) { const int n = (lane >> 3) + 8 * j; const LAS float* s = scr + (8 * c) * 33 + n;
        v4u o; o.x = pk2(s[0 * 33], s[1 * 33]); o.y = pk2(s[2 * 33], s[3 * 33]); o.z = pk2(s[4 * 33], s[5 * 33]); o.w = pk2(s[6 * 33], s[7 * 33]);
        *(GAS v4u*)(WT + (size_t)(n0 + n) * K + k0 + 8 * c) = o; }
    LDS_WAIT(); asm volatile("" ::: "memory");
}
__device__ __forceinline__ void cvt_stream(const float* src, bf16_t* dst, size_t n4, size_t gtid, size_t gsz) {
    for (size_t i = gtid; i < n4; i += gsz) { const f32x4 v = ((const f32x4*)src)[i]; u32x2 o; o.x = pk2(v.x, v.y); o.y = pk2(v.z, v.w); ((u32x2*)dst)[i] = o; }
}
__device__ __forceinline__ void p0_prologue(Frame& F, const Params& p) {
    unsigned char* ws = p.ws;
    for (int item = F.bid; item < 192; item += F.G) {
        LAS float* sil = (LAS float*)(F.lds);
        LAS float* red = (LAS float*)(F.lds + 8192);
        const int ks = item / 24, cc = item % 24;
        for (int i = F.tid; i < 9 * 128; i += NTHR) { const int r = i >> 7, k = ks * 128 + (i & 127); const float v = r < 8 ? p.c[r * 1024 + k] : p.c_ctx[k]; sil[i] = v / (1.f + __expf(-v)); }
        __syncthreads();
        f32x4 acc[9];
#pragma unroll
        for (int r = 0; r < 9; ++r) acc[r] = (f32x4){0.f, 0.f, 0.f, 0.f};
        const float* wp = p.w_ada + (size_t)(ks * 128 + F.wave * 16) * NMOD + cc * 256 + F.lane * 4;
#pragma unroll 4
        for (int kk = 0; kk < 16; ++kk) { const f32x4 w = *(const f32x4*)(wp + (size_t)kk * NMOD);
#pragma unroll
            for (int r = 0; r < 9; ++r) acc[r] += w * sil[r * 128 + F.wave * 16 + kk]; }
#pragma unroll
        for (int r = 0; r < 9; ++r) *(LAS f32x4*)(red + ((F.wave * 9 + r) * 256 + F.lane * 4)) = acc[r];
        __syncthreads();
        float* modp = (float*)(ws + WS_MODP);
        for (int i = F.tid; i < 9 * 256; i += NTHR) { const int r = i >> 8, c = i & 255; float s = 0.f;
#pragma unroll
            for (int w = 0; w < 8; ++w) s += red[(w * 9 + r) * 256 + c];
            modp[(size_t)(ks * 9 + r) * NMOD + cc * 256 + c] = s; }
        __syncthreads();
    }
    {
        LAS float* scr = (LAS float*)(F.lds + F.wave * 16384);
        const int gw = F.bid * NWAVES + F.wave, NGW = F.G * NWAVES;
        constexpr int I_IN = 16 * 96, I_OUT = 16 * 32, I_PQ = 16 * 64;
        for (int it = gw; it < I_IN + I_OUT + I_PQ; it += NGW) {
            int r = it;
            if (r < I_IN) { p0_transpose_item(p.w_in, D, NQKV, (bf16_t*)(ws + WS_WIN), scr, r, F.lane); continue; } r -= I_IN;
            if (r < I_OUT) { p0_transpose_item(p.w_out, D, D, (bf16_t*)(ws + WS_WOUT), scr, r, F.lane); continue; } r -= I_OUT;
            p0_transpose_item(p.peer_wq, D, 2048, (bf16_t*)(ws + WS_WPQ), scr, r, F.lane);
        }
    }
    const size_t gtid = (size_t)F.bid * NTHR + F.tid, gsz = (size_t)F.G * NTHR;
    cvt_stream(p.peer_keys, (bf16_t*)(ws + WS_KEYS), (size_t)8 * 2 * 128 * 128 / 4, gtid, gsz);
    { bf16_t* ki = (bf16_t*)(ws + WS_KEYSI);
      for (int i = (int)gtid; i < 8 * 2 * 16 * 128; i += (int)gsz) { const int key = i & 127, c = (i >> 7) & 15, hp = i >> 11;
          const float* sp = p.peer_keys + ((size_t)hp * 128 + key) * 128 + c * 8; const f32x4 a = *(const f32x4*)sp, b = *(const f32x4*)(sp + 4);
          u32x4 o; o.x = pk2(a.x, a.y); o.y = pk2(a.z, a.w); o.z = pk2(b.x, b.y); o.w = pk2(b.z, b.w); *(u32x4*)(ki + (size_t)i * 8) = o; } }
    {
        const int gw = F.bid * NWAVES + F.wave, NGW = F.G * NWAVES, l5 = F.lane & 31, hb = F.lane >> 5;
        for (int e0 = gw * 2; e0 < PE_NEXP; e0 += NGW * 2) {
            f32x4 x[2][8];
#pragma unroll
            for (int q = 0; q < 2; ++q) { const float* src = (hb ? p.peer_v : p.peer_u) + (size_t)(e0 + q) * D + l5 * 32;
#pragma unroll
                for (int j = 0; j < 8; ++j) x[q][j] = ((const f32x4*)src)[j]; }
#pragma unroll
            for (int q = 0; q < 2; ++q) {
                float am = 0.f;
#pragma unroll
                for (int j = 0; j < 8; ++j) am = fmaxf(am, fmaxf(fmaxf(fabsf(x[q][j].x), fabsf(x[q][j].y)), fmaxf(fabsf(x[q][j].z), fabsf(x[q][j].w))));
                am = half_max(am);
                int ex = am > 0.f ? (int)floorf(log2f(7.5f / am)) : 0; ex = ex < -100 ? -100 : (ex > 100 ? 100 : ex);
                const float sc = ldexpf(1.f, ex);
                f32x16 va, vb;
#pragma unroll
                for (int j = 0; j < 4; ++j) { va[4 * j] = x[q][j].x * sc; va[4 * j + 1] = x[q][j].y * sc; va[4 * j + 2] = x[q][j].z * sc; va[4 * j + 3] = x[q][j].w * sc;
                    vb[4 * j] = x[q][4 + j].x * sc; vb[4 * j + 1] = x[q][4 + j].y * sc; vb[4 * j + 2] = x[q][4 + j].z * sc; vb[4 * j + 3] = x[q][4 + j].w * sc; }
                const u32x6 w = enc_fp6(va, vb);
                unsigned* dst = (unsigned*)(ws + (hb ? WS_VB : WS_UB) + (size_t)(e0 + q) * 768 + l5 * 24);
                *(u32x2*)dst = (u32x2){w[0], w[1]}; *(u32x2*)(dst + 2) = (u32x2){w[2], w[3]}; *(u32x2*)(dst + 4) = (u32x2){w[4], w[5]};
                if (l5 == 0) ((float*)(ws + (hb ? WS_VSC : WS_USC)))[e0 + q] = ldexpf(1.f, -ex);
            }
        }
    }
    if (gtid == 0) {
        float s01 = 0.f, s23 = 0.f;
        for (int i = 0; i < 64; ++i) { s01 += p.diff_lambda[i] * p.diff_lambda[64 + i]; s23 += p.diff_lambda[128 + i] * p.diff_lambda[192 + i]; }
        *(float*)(ws + WS_LAM) = expf(s01) - expf(s23) + LAMBDA_INIT;
    }
    float* rope = (float*)(ws + WS_ROPE);
    for (int i = (int)gtid; i < 64 * 16; i += (int)gsz) { const int pos = i >> 4, f = i & 15; const float inv = exp2f(-(float)f * (13.287712379549449f / 16.f)); const float a = (float)pos * inv; rope[2 * i] = cosf(a); rope[2 * i + 1] = sinf(a); }
    bf16_t* bt = (bf16_t*)(ws + WS_BIAST);
    for (int i = (int)gtid; i < 8 * 15 * 4096; i += (int)gsz) {
        const int j = i & 7, kc = (i >> 3) & 63, cq = (i >> 9) & 7, hd = i >> 12, dr = hd % 15, h = hd / 15;
        const int cp = cq * 8 + j; int cs = cp - 8; cs = cs < 0 ? 0 : (cs > 48 ? 48 : cs);
        float v = NEG_BIG;
        if (kc >= cs && kc < cs + 16) v = p.rel_bias[(h * 15 + dr) * 31 + (kc - cp + 15)] * LOG2E;
        bt[i] = (bf16_t)f2bf(v);
    }
}

__device__ __forceinline__ void p1_hrows(Frame& F, const Params& p) {
    unsigned char* ws = p.ws;
    const float* modp = (const float*)(ws + WS_MODP);
    float* mod = (float*)(ws + WS_MOD);
    for (int i = F.bid * NTHR + F.tid; i < 9 * NMOD; i += F.G * NTHR) { float s = p.b_ada[i % NMOD];
#pragma unroll
        for (int ks = 0; ks < 8; ++ks) s += modp[(size_t)ks * 9 * NMOD + i];
        mod[i] = s; }
    const int rows_per = (MALL + F.G - 1) / F.G, r0 = F.bid * rows_per, r1 = min(MALL, r0 + rows_per);
    if (r0 >= r1) return;
    const int mr_lo = r0 < MLAT ? (r0 >> 12) : 8;
    LAS float* tab = (LAS float*)F.lds;
    for (int i = F.tid; i < 2 * 2048; i += NTHR) {
        const int which = i >> 11, ss = (i >> 10) & 1, col = i & 1023; const int mr = min(8, mr_lo + which);
        const int mi = mr * NMOD + (ss == 0 ? D : 0) + col;
        float s = p.b_ada[(ss == 0 ? D : 0) + col];
#pragma unroll
        for (int ks = 0; ks < 8; ++ks) s += modp[(size_t)ks * 9 * NMOD + mi];
        tab[i] = ss == 0 ? p.g_norm[col] * (1.f + s) : s;
    }
    __syncthreads();
    bf16_t* H = (bf16_t*)(ws + WS_H);
    f32x4 nx[2][4];
#define P1_LOAD(dst, rowa_) do { _Pragma("unroll") for (int q = 0; q < 2; ++q) { const int row = min((rowa_) + q * NWAVES, MALL - 1); \
            const float* xr = row < MLAT ? p.x + (size_t)row * D : p.ctx + (size_t)(row - MLAT) * D; \
            _Pragma("unroll") for (int j = 0; j < 4; ++j) dst[q][j] = ((const f32x4*)xr)[F.lane + 64 * j]; } } while (0)
    P1_LOAD(nx, r0 + F.wave);
    for (int rowa = r0 + F.wave; rowa < r1; rowa += 2 * NWAVES) {
        f32x4 v[2][4]; float ssq[2];
#pragma unroll
        for (int q = 0; q < 2; ++q)
#pragma unroll
            for (int j = 0; j < 4; ++j) v[q][j] = nx[q][j];
        if (rowa + 2 * NWAVES < r1) P1_LOAD(nx, rowa + 2 * NWAVES);
#pragma unroll
        for (int q = 0; q < 2; ++q) { float s = 0.f;
#pragma unroll
            for (int j = 0; j < 4; ++j) s += v[q][j].x * v[q][j].x + v[q][j].y * v[q][j].y + v[q][j].z * v[q][j].z + v[q][j].w * v[q][j].w;
            ssq[q] = wave_sum(s); }
#pragma unroll
        for (int q = 0; q < 2; ++q) { const int row = rowa + q * NWAVES; if (row < r1) {
            const int mr = row < MLAT ? (row >> 12) : 8; const LAS float* tb = tab + (mr - mr_lo) * 2048;
            const float rstd = rsqrtf(ssq[q] * (1.f / D) + EPS);
#pragma unroll
            for (int j = 0; j < 4; ++j) { const int col = (F.lane + 64 * j) * 4;
                const f32x4 sc = *(const LAS f32x4*)(tb + col), sh = *(const LAS f32x4*)(tb + 1024 + col);
                const f32x4 y = (v[q][j] * rstd) * sc + sh;
                u32x2 o; o.x = pk2(y.x, y.y); o.y = pk2(y.z, y.w);
                *(u32x2*)(H + (size_t)row * D + col) = o; } } }
    }
#undef P1_LOAD
}

struct EpiQKVFast {
    static constexpr bool PERM = true, AFTER_DRAIN = false;
    unsigned char* ws;
    __device__ __forceinline__ void operator()(const pg8::f32x4 (&acc)[2][2][4][2], const pg8::Unit& u, int wr, int wc, int fr, int fq) const {
        const bool lat = u.pm < 128;
        const int kind = u.pn >> 1;
        if (!lat && (kind == 0 || kind == 3)) return;
        const int b = lat ? (u.pm >> 4) : (u.pm - 128);
        const int tb = lat ? (u.pm & 15) * 256 : 0;
        const float* rope = (const float*)(ws + WS_ROPE);
#pragma unroll
        for (int bj = 0; bj < 2; ++bj) {
            const int cc = (u.pn & 1) * 256 + bj * 128 + wc * 32 + 8 * fq;
#pragma unroll
            for (int ai = 0; ai < 2; ++ai)
#pragma unroll
                for (int m = 0; m < 4; ++m) {
                    const int rowin = ai * 128 + wr * 64 + m * 16 + fr;
                    const int t = tb + rowin;
                    const int j = lat ? 256 + t : rowin;
                    f32x4 v0 = acc[ai][bj][m][0], v1 = acc[ai][bj][m][1];
                    bf16_t* dst;
                    if (kind == 0) { dst = (bf16_t*)(ws + WS_QA) + qa_idx(b, cc >> 6, t, cc & 63); v0 = v0 * C2; v1 = v1 * C2; }
                    else if (kind == 1) dst = (bf16_t*)(ws + WS_KA) + ka_idx(b, cc >> 6, j, cc & 63);
                    else if (kind == 2) dst = (bf16_t*)(ws + WS_VA) + va_idx(b, cc >> 6, j, cc & 63);
                    else if (kind == 5) dst = (bf16_t*)(ws + WS_VD) + vd_idx(b, cc >> 7, j, cc & 127);
                    else {
                        const int mm = cc >> 8, h = (cc >> 6) & 3, d = cc & 63;
                        if (lat) { const int i0 = d >> 1; const int pos = i0 < 16 ? (t >> 6) : (t & 63); const float* rp = rope + (pos * 16 + (i0 & 15)) * 2;
                            const f32x4 r0 = *(const f32x4*)rp, r1 = *(const f32x4*)(rp + 4);
                            f32x4 a0, a1;
                            a0.x = v0.x * r0.x - v0.y * r0.y; a0.y = v0.x * r0.y + v0.y * r0.x; a0.z = v0.z * r0.z - v0.w * r0.w; a0.w = v0.z * r0.w + v0.w * r0.z;
                            a1.x = v1.x * r1.x - v1.y * r1.y; a1.y = v1.x * r1.y + v1.y * r1.x; a1.z = v1.z * r1.z - v1.w * r1.w; a1.w = v1.z * r1.w + v1.w * r1.z;
                            v0 = a0; v1 = a1; }
                        if (kind == 3) { dst = (bf16_t*)(ws + WS_QD) + qd_idx(b, mm, h, t, d); v0 = v0 * C2; v1 = v1 * C2; }
                        else dst = (bf16_t*)(ws + WS_KD) + kd_idx(b, mm, h, j, d);
                    }
                    pg8::u32x4 w; w.x = pg8::cvt_pk_bf16(v0[0], v0[1]); w.y = pg8::cvt_pk_bf16(v0[2], v0[3]); w.z = pg8::cvt_pk_bf16(v1[0], v1[1]); w.w = pg8::cvt_pk_bf16(v1[2], v1[3]);
                    *(pg8::u32x4*)dst = w;
                }
        }
    }
};


struct EpiQ2Frag {
    static constexpr bool PERM = true, AFTER_DRAIN = false;
    bf16_t* O;
    __device__ __forceinline__ void operator()(const pg8::f32x4 (&acc)[2][2][4][2], const pg8::Unit& u, int wr, int wc, int fr, int fq) const {
        const int h = u.pn;
#pragma unroll
        for (int bj = 0; bj < 2; ++bj) {
            const int c8 = wc * 4 + fq;
#pragma unroll
            for (int ai = 0; ai < 2; ++ai)
#pragma unroll
                for (int m = 0; m < 4; ++m) {
                    const int row = u.pm * 256 + ai * 128 + wr * 64 + m * 16 + fr;
                    const size_t idx = ((((((size_t)(row >> 5) * 8 + h) * 2 + bj) * 8 + (c8 >> 1)) * 2 + (c8 & 1)) * 32 + (row & 31)) * 8;
                    const f32x4 v0 = acc[ai][bj][m][0], v1 = acc[ai][bj][m][1];
                    pg8::u32x4 w; w.x = pg8::cvt_pk_bf16(v0[0], v0[1]); w.y = pg8::cvt_pk_bf16(v0[2], v0[3]); w.z = pg8::cvt_pk_bf16(v1[0], v1[1]); w.w = pg8::cvt_pk_bf16(v1[2], v1[3]);
                    *(pg8::u32x4*)(O + idx) = w;
                }
        }
    }
};

__device__ __forceinline__ void p5_rows2(Frame& F, const Params& p) {
    unsigned char* ws = p.ws;
    const float* mod = (const float*)(ws + WS_MOD);
    const bf16_t* YO = (const bf16_t*)(ws + WS_YO);
    bf16_t* H2 = (bf16_t*)(ws + WS_H2);
    const int gw = F.bid * NWAVES + F.wave, NGW = F.G * NWAVES;
    const int rows_per = (MLAT + NGW - 1) / NGW;
    const int rend = min(MLAT, (gw + 1) * rows_per);
    f32x4 nxx[2][4]; u32x2 nxy[2][4];
#define P5_LOAD(rowa_) do { _Pragma("unroll") for (int q = 0; q < 2; ++q) { const int row = min((rowa_) + q, MLAT - 1); \
            _Pragma("unroll") for (int j = 0; j < 4; ++j) { nxx[q][j] = ((const f32x4*)(p.x + (size_t)row * D))[F.lane + 64 * j]; nxy[q][j] = ((const u32x2*)(YO + (size_t)row * D))[F.lane + 64 * j]; } } } while (0)
    P5_LOAD(gw * rows_per);
    for (int rowa = gw * rows_per; rowa < rend; rowa += 2) {
        f32x4 xv[2][4], yv[2][4]; float ssq[2];
#pragma unroll
        for (int q = 0; q < 2; ++q)
#pragma unroll
            for (int j = 0; j < 4; ++j) { xv[q][j] = nxx[q][j]; const u32x2 yw = nxy[q][j]; yv[q][j] = (f32x4){bflo(yw.x), bfhi(yw.x), bflo(yw.y), bfhi(yw.y)}; }
        if (rowa + 2 < rend) P5_LOAD(rowa + 2);
#pragma unroll
        for (int q = 0; q < 2; ++q) { float s = 0.f;
#pragma unroll
            for (int j = 0; j < 4; ++j) s += yv[q][j].x * yv[q][j].x + yv[q][j].y * yv[q][j].y + yv[q][j].z * yv[q][j].z + yv[q][j].w * yv[q][j].w;
            ssq[q] = wave_sum(s); }
#pragma unroll
        for (int q = 0; q < 2; ++q) { const int row = rowa + q; if (row < MLAT) {
            const int b = row >> 12; const float* mb = mod + b * NMOD;
            const float rstd = rsqrtf(ssq[q] * (1.f / D) + EPS);
            float s2 = 0.f;
#pragma unroll
            for (int j = 0; j < 4; ++j) { const int col = (F.lane + 64 * j) * 4;
                const f32x4 g1 = *(const f32x4*)(p.g_norm + D + col), gt1 = *(const f32x4*)(mb + 2 * D + col);
                xv[q][j] = xv[q][j] + gt1 * (yv[q][j] * rstd * g1);
                *(f32x4*)(p.out + (size_t)row * D + col) = xv[q][j];
                s2 += xv[q][j].x * xv[q][j].x + xv[q][j].y * xv[q][j].y + xv[q][j].z * xv[q][j].z + xv[q][j].w * xv[q][j].w; }
            const float rstd2 = rsqrtf(wave_sum(s2) * (1.f / D) + EPS);
#pragma unroll
            for (int j = 0; j < 4; ++j) { const int col = (F.lane + 64 * j) * 4;
                const f32x4 g2 = *(const f32x4*)(p.g_norm + 2 * D + col), sh2 = *(const f32x4*)(mb + 3 * D + col), sc2 = *(const f32x4*)(mb + 4 * D + col);
                const f32x4 y = (xv[q][j] * rstd2 * g2) * (sc2 + 1.f) + sh2;
                u32x2 o; o.x = pk2(y.x, y.y); o.y = pk2(y.z, y.w);
                *(u32x2*)(H2 + (size_t)row * D + col) = o; } } }
    }
#undef P5_LOAD
}

template <int J> __device__ __forceinline__ unsigned lane_xor(unsigned x, int lane) {
    if (J == 1) return (unsigned)__builtin_amdgcn_update_dpp(0, (int)x, 0xB1, 0xf, 0xf, false);
    if (J == 2) return (unsigned)__builtin_amdgcn_update_dpp(0, (int)x, 0x4E, 0xf, 0xf, false);
    if (J == 4) { const unsigned a = (unsigned)__builtin_amdgcn_update_dpp(0, (int)x, 0x104, 0xf, 0xf, false),
                                 b = (unsigned)__builtin_amdgcn_update_dpp(0, (int)x, 0x114, 0xf, 0xf, false);
                  return (lane & 4) ? b : a; }
    if (J == 8) return (unsigned)__builtin_amdgcn_update_dpp(0, (int)x, 0x128, 0xf, 0xf, false);
    if (J == 16) { auto r = __builtin_amdgcn_permlane16_swap(x, x, false, false); return (lane & 16) ? r[0] : r[1]; }
    auto r = __builtin_amdgcn_permlane32_swap(x, x, false, false); return (lane & 32) ? r[0] : r[1];
}
template <int K2, int J> __device__ __forceinline__ void bitonic_step128(unsigned& key0, unsigned& key1, int lane) {
    if (J == 64) { const unsigned lo = key0 < key1 ? key0 : key1, hi_ = key0 < key1 ? key1 : key0; key0 = lo; key1 = hi_; }
    else {
        const unsigned p0_ = lane_xor<J>(key0, lane), p1_ = lane_xor<J>(key1, lane);
        const bool lower = (lane & J) == 0;
        const bool asc0 = K2 == 128 ? true : ((lane & K2) == 0), asc1 = K2 == 128 ? true : (((64 + lane) & K2) == 0);
        const bool kmin0 = lower == asc0, kmin1 = lower == asc1;
        key0 = kmin0 ? (key0 < p0_ ? key0 : p0_) : (key0 < p0_ ? p0_ : key0);
        key1 = kmin1 ? (key1 < p1_ ? key1 : p1_) : (key1 < p1_ ? p1_ : key1);
    }
}
__device__ __forceinline__ void sort128_asc(unsigned& k0, unsigned& k1, int lane) {
    bitonic_step128<2, 1>(k0, k1, lane);
    bitonic_step128<4, 2>(k0, k1, lane); bitonic_step128<4, 1>(k0, k1, lane);
    bitonic_step128<8, 4>(k0, k1, lane); bitonic_step128<8, 2>(k0, k1, lane); bitonic_step128<8, 1>(k0, k1, lane);
    bitonic_step128<16, 8>(k0, k1, lane); bitonic_step128<16, 4>(k0, k1, lane); bitonic_step128<16, 2>(k0, k1, lane); bitonic_step128<16, 1>(k0, k1, lane);
    bitonic_step128<32, 16>(k0, k1, lane); bitonic_step128<32, 8>(k0, k1, lane); bitonic_step128<32, 4>(k0, k1, lane); bitonic_step128<32, 2>(k0, k1, lane); bitonic_step128<32, 1>(k0, k1, lane);
    bitonic_step128<64, 32>(k0, k1, lane); bitonic_step128<64, 16>(k0, k1, lane); bitonic_step128<64, 8>(k0, k1, lane); bitonic_step128<64, 4>(k0, k1, lane); bitonic_step128<64, 2>(k0, k1, lane); bitonic_step128<64, 1>(k0, k1, lane);
    bitonic_step128<128, 64>(k0, k1, lane); bitonic_step128<128, 32>(k0, k1, lane); bitonic_step128<128, 16>(k0, k1, lane); bitonic_step128<128, 8>(k0, k1, lane); bitonic_step128<128, 4>(k0, k1, lane); bitonic_step128<128, 2>(k0, k1, lane); bitonic_step128<128, 1>(k0, k1, lane);
}
__device__ __forceinline__ float e2m3_val(int k) { return k < 8 ? (float)k * 0.125f : ldexpf(1.f + (float)(k & 7) * 0.125f, (k >> 3) - 1); }
__device__ __forceinline__ int e2m3_idx(float x) { if (x < 1.f) return (int)(x * 8.f + 0.5f); const int e = x >= 4.f ? 2 : (x >= 2.f ? 1 : 0); return 8 * (e + 1) + (int)((x / (float)(1 << e) - 1.f) * 8.f + 0.5f); }
__device__ __forceinline__ float sum8(float v) {
    v += __uint_as_float((unsigned)__builtin_amdgcn_update_dpp(0, (int)__float_as_uint(v), 0xB1, 0xf, 0xf, false));
    v += __uint_as_float((unsigned)__builtin_amdgcn_update_dpp(0, (int)__float_as_uint(v), 0x4E, 0xf, 0xf, false));
    v += __uint_as_float((unsigned)__builtin_amdgcn_update_dpp(0, (int)__float_as_uint(v), 0x141, 0xf, 0xf, false));
    return v;
}
template <int MODE> __device__ __forceinline__ void p8_gather(Frame& F, const Params& p, const XcdBarrier& bar) {
    unsigned char* ws = p.ws;
    const bf16_t* H2 = (const bf16_t*)(ws + WS_H2); const unsigned char* U6 = ws + WS_UB; const unsigned char* V6 = ws + WS_VB;
    const int* EX = (const int*)(ws + WS_EXP); const float* GT = (const float*)(ws + WS_GATE); const float* SU = (const float*)(ws + WS_SU); const float* mod = (const float*)(ws + WS_MOD);
    const int lane = F.lane, l5 = lane & 31, b5 = (lane >> 5) & 1, b4 = (lane >> 4) & 1, b3 = (lane >> 3) & 1;
    const int ent = 2 * (2 * b4 + b3) + b5;
    LAS float* scr = (LAS float*)(F.lds + F.wave * 8192);
    int pi[32];
    { f32x16 ca, cb;
#pragma unroll
      for (int i = 0; i < 16; ++i) { ca[i] = e2m3_val(i); cb[i] = e2m3_val(16 + i); }
      const u32x6 cw = enc_fp6(ca, cb);
      const f32x32 cr = dec_fp6(cw);
#pragma unroll
      for (int j = 0; j < 32; ++j) pi[j] = __builtin_amdgcn_readfirstlane(e2m3_idx(cr[j])) & 31; }
    unsigned* ctr = (unsigned*)(ws + WS_CTL) + CW_P8CTR;
    int cnext = 0;
    if (lane == 0) cnext = (int)__hip_atomic_fetch_add(ctr, 1u, __ATOMIC_RELAXED, __HIP_MEMORY_SCOPE_AGENT);
    cnext = __builtin_amdgcn_readfirstlane(cnext);
    for (;;) {
        const int t = cnext;
        if (t >= MLAT) break;
        if (lane == 0) cnext = (int)__hip_atomic_fetch_add(ctr, 1u, __ATOMIC_RELAXED, __HIP_MEMORY_SCOPE_AGENT);
        const size_t tb_ = (size_t)t * 128;
        unsigned key0 = ((unsigned)EX[tb_ + lane] << 7) | (unsigned)lane, key1 = ((unsigned)EX[tb_ + 64 + lane] << 7) | (unsigned)(64 + lane);
        float hvp[32]; f32x32 acc;
        { const u32x4* hp = (const u32x4*)(H2 + (size_t)t * D + l5 * 32);
#pragma unroll
          for (int j = 0; j < 4; ++j) { const u32x4 w = hp[j]; scr[(8 * j + 0) * 64 + lane] = bflo(w.x); scr[(8 * j + 1) * 64 + lane] = bfhi(w.x); scr[(8 * j + 2) * 64 + lane] = bflo(w.y); scr[(8 * j + 3) * 64 + lane] = bfhi(w.y);
              scr[(8 * j + 4) * 64 + lane] = bflo(w.z); scr[(8 * j + 5) * 64 + lane] = bfhi(w.z); scr[(8 * j + 6) * 64 + lane] = bflo(w.w); scr[(8 * j + 7) * 64 + lane] = bfhi(w.w); }
#pragma unroll
          for (int j = 0; j < 32; ++j) { hvp[j] = scr[pi[j] * 64 + lane]; acc[j] = 0.f; } }
        sort128_asc(key0, key1, lane);
        for (int bb = 0; bb < 16; ++bb) {
            const unsigned kreg = bb < 8 ? key0 : key1; const int lb = (bb & 7) * 8;
            const unsigned kmine = (unsigned)__shfl((int)kreg, lb + ent);
            const float gl = GT[tb_ + (kmine & 127u)], sl = SU[tb_ + (kmine & 127u)];
            u32x6 u6[4], v6[4];
#pragma unroll
            for (int pr = 0; pr < 4; ++pr) { const int eA = (int)((unsigned)__builtin_amdgcn_readlane((int)kreg, lb + 2 * pr) >> 7), eB = (int)((unsigned)__builtin_amdgcn_readlane((int)kreg, lb + 2 * pr + 1) >> 7);
                const int e = (b5 ? eB : eA) & (MODE == 1 ? 1023 : 0xFFFF);
                const unsigned* up = (const unsigned*)(U6 + (size_t)e * 768 + l5 * 24); const unsigned* vp = (const unsigned*)(V6 + (size_t)e * 768 + l5 * 24);
                const u32x2 a0 = *(const u32x2*)up, a1 = *(const u32x2*)(up + 2), a2 = *(const u32x2*)(up + 4); u6[pr] = (u32x6){a0.x, a0.y, a1.x, a1.y, a2.x, a2.y};
                const u32x2 c0 = *(const u32x2*)vp, c1 = *(const u32x2*)(vp + 2), c2 = *(const u32x2*)(vp + 4); v6[pr] = (u32x6){c0.x, c0.y, c1.x, c1.y, c2.x, c2.y}; }
            float d[4];
#pragma unroll
            for (int pr = 0; pr < 4; ++pr) { const f32x32 ru = __builtin_amdgcn_cvt_scalef32_pk32_f32_fp6(u6[pr], 1.0f); float s0 = 0.f, s1 = 0.f;
#pragma unroll
                for (int c = 0; c < 32; c += 2) { s0 += hvp[c] * ru[c]; s1 += hvp[c + 1] * ru[c + 1]; }
                d[pr] = s0 + s1; asm volatile("" : "+v"(d[pr])); }
            float r2[2], r1;
#pragma unroll
            for (int i = 0; i < 2; ++i) { auto rr = __builtin_amdgcn_permlane16_swap(__float_as_uint(d[i]), __float_as_uint(d[i + 2]), false, false); r2[i] = __uint_as_float(rr[0]) + __uint_as_float(rr[1]); }
            { const float keep = b3 ? r2[1] : r2[0], send = b3 ? r2[0] : r2[1]; r1 = keep + __uint_as_float((unsigned)__builtin_amdgcn_update_dpp(0, (int)__float_as_uint(send), 0x128, 0xf, 0xf, false)); }
            r1 = sum8(r1);
            const float pre = r1 * sl;
            float act;
            { const float av = fabsf(pre), dd = av * 0.2316418882f + 1.0f; const float tt = __builtin_amdgcn_rcpf(dd);
              float q = tt * 0.5307027145f + (-0.7265760135f); q = q * tt + 0.7107068705f; q = q * tt + (-0.142248368f); q = q * tt + 0.127414796f; q = q * tt;
              const float ee = __builtin_amdgcn_exp2f((pre * pre) * (-0.72134752044f));
              const float mm = pre * (q * ee); act = pre < 0.f ? mm : pre - mm; }
            const float cfl = gl * act;
#pragma unroll
            for (int pr = 0; pr < 4; ++pr) {
                const float cfA = __uint_as_float((unsigned)__builtin_amdgcn_readlane((int)__float_as_uint(cfl), (pr >> 1) * 16 + (pr & 1) * 8));
                const float cfB = __uint_as_float((unsigned)__builtin_amdgcn_readlane((int)__float_as_uint(cfl), 32 + (pr >> 1) * 16 + (pr & 1) * 8));
                const float cf = b5 ? cfB : cfA;
                const f32x32 rv = __builtin_amdgcn_cvt_scalef32_pk32_f32_fp6(v6[pr], 1.0f);
#pragma unroll
                for (int c = 0; c < 32; ++c) acc[c] += cf * rv[c];
                asm volatile("" : "+v"(acc));
            }
        }
#pragma unroll
        for (int j = 0; j < 32; ++j) { auto rr = __builtin_amdgcn_permlane32_swap(__float_as_uint(acc[j]), __float_as_uint(acc[j]), false, false); scr[pi[j] * 64 + lane] = __uint_as_float(rr[0]) + __uint_as_float(rr[1]); }
        float at[16]; float s = 0.f;
#pragma unroll
        for (int k = 0; k < 16; ++k) { at[k] = scr[(16 * b5 + k) * 64 + lane]; s += at[k] * at[k]; }
        const float rstd = rsqrtf(wave_sum(s) * (1.f / D) + EPS);
        const float* mb = mod + (t >> 12) * NMOD + 5 * D; const float* g3 = p.g_norm + 3 * D;
#pragma unroll
        for (int j = 0; j < 4; ++j) { const int col = l5 * 32 + b5 * 16 + j * 4;
            float* op = p.out + (size_t)t * D + col;
            const f32x4 x0 = *(const f32x4*)op, ga = *(const f32x4*)(g3 + col), ta = *(const f32x4*)(mb + col);
            const f32x4 pa = (f32x4){at[4 * j], at[4 * j + 1], at[4 * j + 2], at[4 * j + 3]};
            if (MODE == 0 || rstd == 123456.f) *(f32x4*)op = x0 + ta * (pa * rstd * ga); }
        cnext = __builtin_amdgcn_readfirstlane(cnext);
    }
}

namespace att {
typedef short bf16x8 __attribute__((ext_vector_type(8)));
typedef short s16x4 __attribute__((ext_vector_type(4)));
typedef float f32x16 __attribute__((ext_vector_type(16)));
typedef __attribute__((address_space(3))) const unsigned char* lcp;
typedef __attribute__((address_space(3))) unsigned char* lp;
constexpr int NA_SLOT = 16384, NA_BIAS_OFF = 32768, WSF_OFF = 155648;
constexpr int DF_SLOT = 32768;
constexpr float THRL = 8.f;

__device__ __forceinline__ int crow(int r, int hi) { return (r & 3) + 8 * (r >> 2) + 4 * hi; }
__device__ __forceinline__ s16x4 vtr(lcp p) { return __builtin_bit_cast(s16x4, __builtin_amdgcn_ds_read_tr16_b64_v4i16((__attribute__((address_space(3))) s16x4*)p)); }
typedef float f32x2_t __attribute__((ext_vector_type(2))); typedef __bf16 bf16x2v_t __attribute__((ext_vector_type(2)));
__device__ __forceinline__ unsigned cvtpk(float lo, float hi) { f32x2_t v = {lo, hi}; bf16x2v_t b = __builtin_convertvector(v, bf16x2v_t); return __builtin_bit_cast(unsigned, b); }
__device__ __forceinline__ float swap_half(float v) { auto rr = __builtin_amdgcn_permlane32_swap(__float_as_uint(v), __float_as_uint(v), false, false); return __uint_as_float(rr[0]) == v ? __uint_as_float(rr[1]) : __uint_as_float(rr[0]); }
__device__ __forceinline__ void dma16(const void* gsrc, lp lds_dst) {
    unsigned keep; const unsigned dst = (unsigned)__builtin_amdgcn_readfirstlane((int)(unsigned)(size_t)lds_dst);
    asm volatile("s_mov_b32 %0, m0\n\ts_mov_b32 m0, %2\n\ts_nop 0\n\tglobal_load_lds_dwordx4 %1, off\n\ts_mov_b32 m0, %0" : "=&s"(keep) : "v"(gsrc), "s"(dst) : "memory");
}
__device__ __forceinline__ float max3f(float a, float b, float c) { float r; asm("v_max3_f32 %0, %1, %2, %3" : "=v"(r) : "v"(a), "v"(b), "v"(c)); return r; }
__device__ __forceinline__ float rowmax32(const f32x16& p0, const f32x16& p1) {
    float a = max3f(p0[0], p0[1], p1[0]), b = max3f(p0[2], p0[3], p1[1]); a = max3f(a, p1[2], p1[3]);
#pragma unroll
    for (int r = 4; r < 16; r += 4) { a = max3f(a, p0[r], p0[r + 1]); b = max3f(b, p0[r + 2], p0[r + 3]); a = max3f(a, p1[r], p1[r + 1]); b = max3f(b, p1[r + 2], p1[r + 3]); }
    float m = max3f(a, b, b);
    auto rr = __builtin_amdgcn_permlane32_swap(__float_as_uint(m), __float_as_uint(m), false, false);
    return max3f(__uint_as_float(rr[0]), __uint_as_float(rr[1]), __uint_as_float(rr[1]));
}

typedef __bf16 bf16x2_t __attribute__((ext_vector_type(2)));
__device__ __forceinline__ float psum_bf16(const u32x4 (&pw)[4], float acc) {
    const bf16x2_t ones = __builtin_bit_cast(bf16x2_t, 0x3F803F80u); float a0 = acc, a1 = 0.f;
#pragma unroll
    for (int k = 0; k < 4; ++k) { a0 = __builtin_amdgcn_fdot2_f32_bf16(__builtin_bit_cast(bf16x2_t, pw[k][0]), ones, a0, false); a1 = __builtin_amdgcn_fdot2_f32_bf16(__builtin_bit_cast(bf16x2_t, pw[k][1]), ones, a1, false);
        a0 = __builtin_amdgcn_fdot2_f32_bf16(__builtin_bit_cast(bf16x2_t, pw[k][2]), ones, a0, false); a1 = __builtin_amdgcn_fdot2_f32_bf16(__builtin_bit_cast(bf16x2_t, pw[k][3]), ones, a1, false); }
    return a0 + a1;
}
template <int NDV> struct FlashState { float mhat, l; f32x16 negm; f32x16 o[NDV]; };

template <int NDV, bool BIAS>
__device__ __forceinline__ void flash_tile(FlashState<NDV>& st, const bf16x8 (&qr)[4], lcp Kslot, lcp Vslot, lcp Bslot, const bf16x8 (&qoh)[2],
                                           __attribute__((address_space(3))) float* wsf, int r32, int hi, int lane, bool first) {
    f32x16 p0 = st.negm, p1 = st.negm;
    lcp kb = Kslot + hi * 1024 + r32 * 16;
    bf16x8 kf[8], bf_[4];
#pragma unroll
    for (int d0 = 0; d0 < 4; ++d0) { kf[2 * d0] = *(const __attribute__((address_space(3))) bf16x8*)(kb + d0 * 2048); kf[2 * d0 + 1] = *(const __attribute__((address_space(3))) bf16x8*)(kb + d0 * 2048 + 512); }
    if (BIAS) { lcp bb = Bslot + hi * 1024 + r32 * 16;
#pragma unroll
        for (int e = 0; e < 2; ++e) { bf_[2 * e] = *(const __attribute__((address_space(3))) bf16x8*)(bb + e * 2048); bf_[2 * e + 1] = *(const __attribute__((address_space(3))) bf16x8*)(bb + e * 2048 + 512); } }
    lcp vb = Vslot + ((lane >> 4) & 1) * 32 + (lane & 3) * 8 + (4 * hi + ((lane & 15) >> 2)) * 64;
    s16x4 va[8], vn[8];
#pragma unroll
    for (int ks = 0; ks < 4; ++ks) { va[2 * ks] = vtr(vb + ks * 1024); va[2 * ks + 1] = vtr(vb + ks * 1024 + 512); }
#pragma unroll
    for (int d0 = 0; d0 < 4; ++d0) { p0 = __builtin_amdgcn_mfma_f32_32x32x16_bf16(kf[2 * d0], qr[d0], p0, 0, 0, 0); p1 = __builtin_amdgcn_mfma_f32_32x32x16_bf16(kf[2 * d0 + 1], qr[d0], p1, 0, 0, 0); }
    if (BIAS) {
#pragma unroll
        for (int e = 0; e < 2; ++e) { p0 = __builtin_amdgcn_mfma_f32_32x32x16_bf16(bf_[2 * e], qoh[e], p0, 0, 0, 0); p1 = __builtin_amdgcn_mfma_f32_32x32x16_bf16(bf_[2 * e + 1], qoh[e], p1, 0, 0, 0); }
    }
    asm volatile("s_nop 15\n\ts_nop 7" : "+v"(p0), "+v"(p1));
    const float rm = rowmax32(p0, p1);
    if (first) {
        st.mhat += rm;
#pragma unroll
        for (int r = 0; r < 16; ++r) { p0[r] -= rm; p1[r] -= rm; st.negm[r] = -st.mhat; }
    } else if (__any(rm > THRL)) {
        const float dl = fmaxf(rm, 0.f); const float alpha = __builtin_amdgcn_exp2f(-dl); st.mhat += dl; st.l *= alpha;
        if (hi == 0) wsf[r32] = alpha;
        asm volatile("s_waitcnt lgkmcnt(0)" ::: "memory");
        float al[16];
#pragma unroll
        for (int r = 0; r < 16; ++r) al[r] = wsf[crow(r, hi)];
#pragma unroll
        for (int d = 0; d < NDV; ++d)
#pragma unroll
            for (int r = 0; r < 16; ++r) st.o[d][r] *= al[r];
#pragma unroll
        for (int r = 0; r < 16; ++r) { p0[r] -= dl; p1[r] -= dl; st.negm[r] = -st.mhat; }
    }
    float sacc = 0.f;
#pragma unroll
    for (int r = 0; r < 16; ++r) { p0[r] = __builtin_amdgcn_exp2f(p0[r]); p1[r] = __builtin_amdgcn_exp2f(p1[r]); sacc += p0[r] + p1[r]; }
    st.l += sacc;
    u32x4 pw[4];
#pragma unroll
    for (int i = 0; i < 4; ++i) { pw[0][i] = cvtpk(p0[2 * i], p0[2 * i + 1]); pw[1][i] = cvtpk(p0[8 + 2 * i], p0[8 + 2 * i + 1]); pw[2][i] = cvtpk(p1[2 * i], p1[2 * i + 1]); pw[3][i] = cvtpk(p1[8 + 2 * i], p1[8 + 2 * i + 1]); }
    __builtin_amdgcn_sched_barrier(0);
#pragma unroll
    for (int d0 = 0; d0 < NDV; ++d0) {
#pragma unroll
        for (int ks = 0; ks < 4; ++ks) {
            if (d0 < NDV - 1) { vn[2 * ks] = vtr(vb + (d0 + 1) * 4096 + ks * 1024); vn[2 * ks + 1] = vtr(vb + (d0 + 1) * 4096 + ks * 1024 + 512); }
            const bf16x8 vf = (bf16x8){va[2 * ks][0], va[2 * ks][1], va[2 * ks][2], va[2 * ks][3], va[2 * ks + 1][0], va[2 * ks + 1][1], va[2 * ks + 1][2], va[2 * ks + 1][3]};
            st.o[d0] = __builtin_amdgcn_mfma_f32_32x32x16_bf16(__builtin_bit_cast(bf16x8, pw[ks]), vf, st.o[d0], 0, 0, 0);
            __builtin_amdgcn_sched_barrier(0);
        }
#pragma unroll
        for (int i = 0; i < 8; ++i) va[i] = vn[i];
    }
}

constexpr int NA2_SLOT = 16384, NA2_BIAS_OFF = 65536;
__device__ __forceinline__ void na_units(Frame& F, const Params& p) {
    unsigned char* ws = p.ws;
    const bf16_t* QA = (const bf16_t*)(ws + WS_QA); const bf16_t* KA = (const bf16_t*)(ws + WS_KA); const bf16_t* VA = (const bf16_t*)(ws + WS_VA);
    const bf16_t* BT = (const bf16_t*)(ws + WS_BIAST); bf16_t* Y = (bf16_t*)(ws + WS_Y);
    const int lane = F.lane, r32 = lane & 31, hi = lane >> 5, wave = F.wave;
    lp lds = (lp)F.lds;
    __attribute__((address_space(3))) float* wsf = (__attribute__((address_space(3))) float*)(lds + WSF_OFF) + wave * 64;
    const int upw = 1024 / F.G;
    int cur_h = -1, cur_lo = -1, cur_hi = -1;
    bf16x8 qoh[2];
#pragma unroll
    for (int e = 0; e < 2; ++e)
#pragma unroll
        for (int j = 0; j < 8; ++j) qoh[e][j] = (16 * e + 8 * hi + j == r32) ? (short)0x3F80 : (short)0;
    for (int ui = 0; ui < upw; ++ui) {
        const int u = F.bid * upw + ui, bh = u >> 4, rg = u & 15, b = bh >> 3, h = bh & 7;
        const int r0 = rg * 4, r = r0 + (wave >> 1), ch = wave & 1;
        int rs = r - 4; rs = rs < 0 ? 0 : (rs > 56 ? 56 : rs);
        int kr_lo = r0 - 4; kr_lo = kr_lo < 0 ? 0 : (kr_lo > 56 ? 56 : kr_lo);
        int kr_hi = r0 + 3 - 4; kr_hi = kr_hi < 0 ? 0 : (kr_hi > 56 ? 56 : kr_hi); kr_hi += 7;
        const int T = 4 + (kr_hi - kr_lo + 1);
        int dr_lo = 99, dr_hi = -1;
#pragma unroll
        for (int q = 0; q < 4; ++q) { int s_ = r0 + q - 4; s_ = s_ < 0 ? 0 : (s_ > 56 ? 56 : s_); const int a = s_ - (r0 + q) + 7; dr_lo = a < dr_lo ? a : dr_lo; dr_hi = a + 7 > dr_hi ? a + 7 : dr_hi; }
        const bf16_t* Kb = KA + (size_t)bh * NKT * 4096; const bf16_t* Vb = VA + (size_t)bh * NKT * 4096;
        if (h != cur_h || dr_lo != cur_lo || dr_hi != cur_hi) {
            cur_h = h; cur_lo = dr_lo; cur_hi = dr_hi;
            const unsigned char* src = (const unsigned char*)(BT + ((size_t)h * 15 + dr_lo) * 4096);
            const int npc = (dr_hi - dr_lo + 1) * 8;
            for (int pi = wave; pi < npc; pi += 8) dma16(src + pi * 1024 + lane * 16, lds + NA2_BIAS_OFF + pi * 1024);
        }
        bf16x8 qr[4];
        { const bf16_t* qp = QA + ((size_t)bh * SEQ + r * 64 + ch * 32 + r32) * 64 + hi * 8;
#pragma unroll
          for (int d0 = 0; d0 < 4; ++d0) qr[d0] = *(const bf16x8*)(qp + d0 * 16); }
#define NA_DMA(i_) do { const int tg_ = (i_) < 4 ? (i_) : (4 + kr_lo + (i_) - 4); lp sl_ = lds + ((i_) & 3) * NA2_SLOT; \
            dma16((const unsigned char*)(Kb + (size_t)tg_ * 4096) + wave * 1024 + lane * 16, sl_ + wave * 1024); \
            dma16((const unsigned char*)(Vb + (size_t)tg_ * 4096) + wave * 1024 + lane * 16, sl_ + 8192 + wave * 1024); } while (0)
        NA_DMA(0); NA_DMA(1);
        FlashState<2> st; st.mhat = 0.f; st.l = 0.f;
#pragma unroll
        for (int rr = 0; rr < 16; ++rr) st.negm[rr] = 0.f;
#pragma unroll
        for (int d = 0; d < 2; ++d)
#pragma unroll
            for (int rr = 0; rr < 16; ++rr) st.o[d][rr] = 0.f;
        for (int i = 0; i < T; ++i) {
            if (i + 1 < T) asm volatile("s_waitcnt vmcnt(2)" ::: "memory"); else asm volatile("s_waitcnt vmcnt(0)" ::: "memory");
            __syncthreads();
            if (i + 2 < T) NA_DMA(i + 2);
            lcp sl = (lcp)(lds + (i & 3) * NA2_SLOT);
            if (i < 4) flash_tile<2, false>(st, qr, sl, sl + 8192, sl, qoh, wsf, r32, hi, lane, i == 0);
            else { const int kr = kr_lo + (i - 4);
                if (kr >= rs && kr < rs + 8) { const int dr = kr - r + 7;
                    flash_tile<2, true>(st, qr, sl, sl + 8192, (lcp)(lds + NA2_BIAS_OFF + (dr - dr_lo) * 8192 + ch * 4096), qoh, wsf, r32, hi, lane, false); } }
        }
#undef NA_DMA
        float lt = st.l; { auto rr = __builtin_amdgcn_permlane32_swap(__float_as_uint(lt), __float_as_uint(lt), false, false); lt = __uint_as_float(rr[0]) + __uint_as_float(rr[1]); }
        if (hi == 0) wsf[32 + r32] = lt;
        asm volatile("s_waitcnt lgkmcnt(0)" ::: "memory");
        bf16_t* yb = Y + ((size_t)b * SEQ + r * 64 + ch * 32) * D + h * 64 + r32;
#pragma unroll
        for (int rr = 0; rr < 16; ++rr) { const float rl = __builtin_amdgcn_rcpf(wsf[32 + crow(rr, hi)]);
#pragma unroll
            for (int d0 = 0; d0 < 2; ++d0) yb[(size_t)crow(rr, hi) * D + d0 * 32] = (bf16_t)f2bf(st.o[d0][rr] * rl); }
        __syncthreads();
    }
}

template <int MODE> __device__ __forceinline__ void diff_units_v2(Frame& F, const Params& p) {
    unsigned char* ws = p.ws;
    const bf16_t* QD = (const bf16_t*)(ws + WS_QD); const bf16_t* KD = (const bf16_t*)(ws + WS_KD); const bf16_t* VD = (const bf16_t*)(ws + WS_VD);
    bf16_t* Y = (bf16_t*)(ws + WS_Y);
    const float lam = *(const float*)(ws + WS_LAM);
    const int lane = F.lane, r32 = lane & 31, hi = lane >> 5, wave = F.wave, map = wave >> 2, qg = wave & 3;
    lp lds = (lp)F.lds;
    __attribute__((address_space(3))) float* wsf = (__attribute__((address_space(3))) float*)(lds + WSF_OFF) + wave * 64;
    __attribute__((address_space(3))) float* X = (__attribute__((address_space(3))) float*)lds;
    const int upw = 1024 / F.G;
    const int koff = map * 8192 + hi * 1024 + r32 * 16;
    const int voff = 16384 + ((lane >> 4) & 1) * 32 + (lane & 3) * 8 + (4 * hi + ((lane & 15) >> 2)) * 64;
    for (int ui = 0; ui < upw; ++ui) {
        int bh, qb;
        if (F.G == 256) { bh = (F.bid & 7) * 4 + ui; qb = F.bid >> 3; } else { const int u = F.bid * upw + ui; bh = u >> 5; qb = u & 31; }
        const int b = bh >> 2, h = bh & 3;
        const unsigned char* K1 = (const unsigned char*)(KD + (size_t)((b * 2 + 0) * 4 + h) * NKT * 4096);
        const unsigned char* K2 = (const unsigned char*)(KD + (size_t)((b * 2 + 1) * 4 + h) * NKT * 4096);
        const unsigned char* Vg = (const unsigned char*)(VD + (size_t)bh * NKT * 8192);
#define DF_DMA(t, slot) do { if (MODE != 1 && MODE != 3) { lp sl_ = lds + (slot) * DF_SLOT; \
            dma16(K1 + (size_t)(t) * 8192 + wave * 1024 + lane * 16, sl_ + wave * 1024); \
            dma16(K2 + (size_t)(t) * 8192 + wave * 1024 + lane * 16, sl_ + 8192 + wave * 1024); \
            dma16(Vg + (size_t)(t) * 16384 + wave * 1024 + lane * 16, sl_ + 16384 + wave * 1024); \
            dma16(Vg + (size_t)(t) * 16384 + 8192 + wave * 1024 + lane * 16, sl_ + 24576 + wave * 1024); } } while (0)
        DF_DMA(0, 0); DF_DMA(1, 1);
        const int q0 = qb * 128 + qg * 32;
        bf16x8 qr[4];
        { const bf16_t* qp = QD + ((size_t)((b * 2 + map) * 4 + h) * SEQ + q0 + r32) * 64 + hi * 8;
#pragma unroll
          for (int d0 = 0; d0 < 4; ++d0) qr[d0] = *(const bf16x8*)(qp + d0 * 16); }
        float mhat = 0.f, lsum = 0.f; f32x16 o[4], negm;
#pragma unroll
        for (int d = 0; d < 4; ++d)
#pragma unroll
            for (int rr = 0; rr < 16; ++rr) o[d][rr] = 0.f;
        asm volatile("s_waitcnt vmcnt(0)" ::: "memory");
        __syncthreads();
        f32x16 s0, s1;
#pragma unroll
        for (int rr = 0; rr < 16; ++rr) { s0[rr] = 0.f; s1[rr] = 0.f; }
        { lcp kb = (lcp)(lds + koff);
#pragma unroll
          for (int d0 = 0; d0 < 4; ++d0) {
              const bf16x8 b0 = *(const __attribute__((address_space(3))) bf16x8*)(kb + d0 * 2048), b1 = *(const __attribute__((address_space(3))) bf16x8*)(kb + d0 * 2048 + 512);
              s0 = __builtin_amdgcn_mfma_f32_32x32x16_bf16(b0, qr[d0], s0, 0, 0, 0); s1 = __builtin_amdgcn_mfma_f32_32x32x16_bf16(b1, qr[d0], s1, 0, 0, 0); } }
        { asm volatile("s_nop 15\n\ts_nop 7" : "+v"(s0), "+v"(s1)); const float rm0 = rowmax32(s0, s1); mhat = rm0;
#pragma unroll
          for (int rr = 0; rr < 16; ++rr) { s0[rr] -= rm0; s1[rr] -= rm0; negm[rr] = -rm0; } }
        u32x4 pw[4];
#define EXP4(X, B) do { X[B] = __builtin_amdgcn_exp2f(X[B]); X[B + 1] = __builtin_amdgcn_exp2f(X[B + 1]); X[B + 2] = __builtin_amdgcn_exp2f(X[B + 2]); X[B + 3] = __builtin_amdgcn_exp2f(X[B + 3]); sacc += X[B]; asm("" : "+v"(sacc)); sacc += X[B + 1]; asm("" : "+v"(sacc)); sacc += X[B + 2]; asm("" : "+v"(sacc)); sacc += X[B + 3]; asm("" : "+v"(sacc)); } while (0)
#define STAGE_A(t_) do { \
            lcp nxt = (lcp)(lds + (((t_) + 1) & 3) * DF_SLOT); \
            bf16x8 kf[8]; \
            _Pragma("unroll") for (int d0 = 0; d0 < 4; ++d0) { kf[2 * d0] = *(const __attribute__((address_space(3))) bf16x8*)(nxt + koff + d0 * 2048); kf[2 * d0 + 1] = *(const __attribute__((address_space(3))) bf16x8*)(nxt + koff + d0 * 2048 + 512); } \
            asm volatile("s_nop 15\n\ts_nop 7" : "+v"(s0), "+v"(s1)); \
            const float rm = rowmax32(s0, s1); \
            if (__any(rm > THRL)) { \
                const float dl = fmaxf(rm, 0.f); const float alpha = __builtin_amdgcn_exp2f(-dl); mhat += dl; lsum *= alpha; \
                if (hi == 0) wsf[r32] = alpha; \
                asm volatile("s_waitcnt lgkmcnt(0)" ::: "memory"); \
                float al[16]; \
                _Pragma("unroll") for (int r = 0; r < 16; ++r) al[r] = wsf[crow(r, hi)]; \
                _Pragma("unroll") for (int d = 0; d < 4; ++d) _Pragma("unroll") for (int r = 0; r < 16; ++r) o[d][r] *= al[r]; \
                _Pragma("unroll") for (int r = 0; r < 16; ++r) { s0[r] -= dl; s1[r] -= dl; negm[r] = -mhat; } \
            } \
            f32x16 n0, n1; float sacc = 0.f; \
            __builtin_amdgcn_sched_barrier(0); \
            n0 = __builtin_amdgcn_mfma_f32_32x32x16_bf16(kf[0], qr[0], negm, 0, 0, 0); EXP4(s0, 0);  __builtin_amdgcn_sched_barrier(0); \
            n1 = __builtin_amdgcn_mfma_f32_32x32x16_bf16(kf[1], qr[0], negm, 0, 0, 0); EXP4(s0, 4);  __builtin_amdgcn_sched_barrier(0); \
            n0 = __builtin_amdgcn_mfma_f32_32x32x16_bf16(kf[2], qr[1], n0, 0, 0, 0); EXP4(s0, 8);  __builtin_amdgcn_sched_barrier(0); \
            n1 = __builtin_amdgcn_mfma_f32_32x32x16_bf16(kf[3], qr[1], n1, 0, 0, 0); EXP4(s0, 12); __builtin_amdgcn_sched_barrier(0); \
            n0 = __builtin_amdgcn_mfma_f32_32x32x16_bf16(kf[4], qr[2], n0, 0, 0, 0); EXP4(s1, 0);  __builtin_amdgcn_sched_barrier(0); \
            n1 = __builtin_amdgcn_mfma_f32_32x32x16_bf16(kf[5], qr[2], n1, 0, 0, 0); EXP4(s1, 4);  __builtin_amdgcn_sched_barrier(0); \
            n0 = __builtin_amdgcn_mfma_f32_32x32x16_bf16(kf[6], qr[3], n0, 0, 0, 0); EXP4(s1, 8);  __builtin_amdgcn_sched_barrier(0); \
            n1 = __builtin_amdgcn_mfma_f32_32x32x16_bf16(kf[7], qr[3], n1, 0, 0, 0); EXP4(s1, 12); __builtin_amdgcn_sched_barrier(0); \
            _Pragma("unroll") for (int i = 0; i < 4; ++i) { pw[0][i] = cvtpk(s0[2 * i], s0[2 * i + 1]); pw[1][i] = cvtpk(s0[8 + 2 * i], s0[8 + 2 * i + 1]); pw[2][i] = cvtpk(s1[2 * i], s1[2 * i + 1]); pw[3][i] = cvtpk(s1[8 + 2 * i], s1[8 + 2 * i + 1]); } \
            lsum += sacc; \
            s0 = n0; s1 = n1; \
        } while (0)
#define STAGE_B(tl_) do { \
            lcp vb = (lcp)(lds + ((tl_) & 3) * DF_SLOT) + voff; \
            s16x4 va[8], vn[8]; \
            _Pragma("unroll") for (int ks = 0; ks < 4; ++ks) { va[2 * ks] = vtr(vb + ks * 1024); va[2 * ks + 1] = vtr(vb + ks * 1024 + 512); } \
            __builtin_amdgcn_sched_barrier(0); \
            _Pragma("unroll") for (int d0 = 0; d0 < 4; ++d0) { \
                _Pragma("unroll") for (int ks = 0; ks < 4; ++ks) { \
                    if (d0 < 3) { vn[2 * ks] = vtr(vb + (d0 + 1) * 4096 + ks * 1024); vn[2 * ks + 1] = vtr(vb + (d0 + 1) * 4096 + ks * 1024 + 512); } \
                    const bf16x8 vf = (bf16x8){va[2 * ks][0], va[2 * ks][1], va[2 * ks][2], va[2 * ks][3], va[2 * ks + 1][0], va[2 * ks + 1][1], va[2 * ks + 1][2], va[2 * ks + 1][3]}; \
                    o[d0] = __builtin_amdgcn_mfma_f32_32x32x16_bf16(__builtin_bit_cast(bf16x8, pw[ks]), vf, o[d0], 0, 0, 0); \
                    __builtin_amdgcn_sched_barrier(0); \
                } \
                _Pragma("unroll") for (int i = 0; i < 8; ++i) va[i] = vn[i]; \
            } \
        } while (0)
        for (int t = 0; t < NKT; ++t) {
            if (t > 0) { asm volatile("s_waitcnt vmcnt(0)" ::: "memory"); if (MODE != 3) __syncthreads(); }
            if (t + 2 < NKT) DF_DMA(t + 2, (t + 2) & 3);
            if (MODE != 2) {
                if (map == 1 && t > 0) STAGE_B(t - 1);
                STAGE_A(t);
                if (map == 0) STAGE_B(t);
            }
        }
        if (MODE != 2 && map == 1) STAGE_B(NKT - 1);
#undef STAGE_A
#undef STAGE_B
#undef EXP4
#undef DF_DMA
        float lt = lsum; { auto rr = __builtin_amdgcn_permlane32_swap(__float_as_uint(lt), __float_as_uint(lt), false, false); lt = __uint_as_float(rr[0]) + __uint_as_float(rr[1]); }
        if (hi == 0) wsf[32 + r32] = lt;
        asm volatile("s_waitcnt lgkmcnt(0)" ::: "memory");
#pragma unroll
        for (int rr = 0; rr < 16; ++rr) { const float rl = __builtin_amdgcn_rcpf(wsf[32 + crow(rr, hi)]);
#pragma unroll
            for (int d = 0; d < 4; ++d) o[d][rr] *= rl; }
        __syncthreads();
        if (map == 1) {
#pragma unroll
            for (int d = 0; d < 4; ++d)
#pragma unroll
                for (int rr = 0; rr < 16; ++rr) X[((qg * 4 + d) * 16 + rr) * 64 + lane] = o[d][rr];
        }
        __syncthreads();
        if (map == 0 && (MODE == 0 || lam == 123456.f)) {
            float ss[16];
#pragma unroll
            for (int rr = 0; rr < 16; ++rr) { float s = 0.f;
#pragma unroll
                for (int d = 0; d < 4; ++d) { const float v = o[d][rr] - lam * X[((qg * 4 + d) * 16 + rr) * 64 + lane]; o[d][rr] = v; s += v * v; }
                ss[rr] = s; }
#pragma unroll
            for (int oo = 1; oo < 32; oo <<= 1)
#pragma unroll
                for (int rr = 0; rr < 16; ++rr) ss[rr] += __shfl_xor(ss[rr], oo);
            float g[4];
#pragma unroll
            for (int d = 0; d < 4; ++d) g[d] = p.diff_subln[d * 32 + r32] * (1.f - LAMBDA_INIT);
            bf16_t* yb = Y + ((size_t)b * SEQ + q0) * D + 512 + h * 128 + r32;
#pragma unroll
            for (int rr = 0; rr < 16; ++rr) { const float rn = rsqrtf(ss[rr] * (1.f / 128.f) + EPS);
#pragma unroll
                for (int d = 0; d < 4; ++d) yb[(size_t)crow(rr, hi) * D + d * 32] = (bf16_t)f2bf(o[d][rr] * rn * g[d]); }
        }
        __syncthreads();
    }
}
}

__device__ __forceinline__ void p3_attention(Frame& F, const Params& p) {
    att::na_units(F, p);
    att::diff_units_v2<0>(F, p);
}

namespace tk {
typedef short bf16x8 __attribute__((ext_vector_type(8)));
typedef float f32x16 __attribute__((ext_vector_type(16)));
constexpr int WLK_OFF = 65536;
__device__ __forceinline__ unsigned ord(float f) { const unsigned u = __float_as_uint(f); return u ^ ((unsigned)((int)u >> 31) | 0x80000000u); }
__device__ __forceinline__ float unord(unsigned o) { return __uint_as_float(o ^ ((o & 0x80000000u) ? 0x80000000u : 0xFFFFFFFFu)); }
__device__ __forceinline__ void cs_desc(unsigned& a, unsigned& b) { const unsigned mx = a > b ? a : b, mn = a > b ? b : a; a = mx; b = mn; }
__device__ __forceinline__ void sort16_desc(unsigned (&v)[16]) {
#pragma unroll
    for (int k = 2; k <= 16; k <<= 1)
#pragma unroll
        for (int j = k >> 1; j > 0; j >>= 1)
#pragma unroll
            for (int i = 0; i < 16; ++i) { const int l = i ^ j; if (l > i) { if ((i & k) == 0 || k == 16) cs_desc(v[i], v[l]); else cs_desc(v[l], v[i]); } }
}
__device__ __forceinline__ void bmerge16_desc(unsigned (&v)[16]) {
#pragma unroll
    for (int j = 8; j > 0; j >>= 1)
#pragma unroll
        for (int i = 0; i < 16; ++i) { const int l = i ^ j; if (l > i) cs_desc(v[i], v[l]); }
}
__device__ __forceinline__ void merge_top16(unsigned (&a)[16], const unsigned (&b)[16]) {
#pragma unroll
    for (int i = 0; i < 16; ++i) a[i] = a[i] > b[15 - i] ? a[i] : b[15 - i];
    bmerge16_desc(a);
}
__device__ __forceinline__ void top16_of_64x2(unsigned (&v0)[16], unsigned (&v1)[16], unsigned (&v2)[16], unsigned (&v3)[16]) {
    sort16_desc(v0); sort16_desc(v1); sort16_desc(v2); sort16_desc(v3);
    merge_top16(v0, v1); merge_top16(v2, v3); merge_top16(v0, v2);
    unsigned pb[16];
#pragma unroll
    for (int i = 0; i < 16; ++i) pb[i] = (unsigned)__shfl_xor((int)v0[i], 32);
    merge_top16(v0, pb);
}
}

__device__ __forceinline__ void p7_topk(Frame& F, const Params& p) {
    using namespace tk;
    unsigned char* ws = p.ws;
    const bf16_t* Q2 = (const bf16_t*)(ws + WS_Q2); const unsigned char* KI = (const unsigned char*)(ws + WS_KEYSI);
    int* EX = (int*)(ws + WS_EXP); float* GT = (float*)(ws + WS_GATE); float* SUo = (float*)(ws + WS_SU);
    const float* USC = (const float*)(ws + WS_USC); const float* VSC = (const float*)(ws + WS_VSC);
    const int lane = F.lane, r32 = lane & 31, hi = lane >> 5, wave = F.wave;
    att::lp lds = (att::lp)F.lds;
    LAS int* W = (LAS int*)(F.lds + WLK_OFF + wave * 8192);
    const int ntask = 1024 / F.G;
    const int h = F.bid & 7;
    { const unsigned char* src = KI + (size_t)h * 65536;
      for (int k = 0; k < 8; ++k) { const int pi = wave + 8 * k; att::dma16(src + pi * 1024 + lane * 16, lds + pi * 1024); } }
    asm volatile("s_waitcnt vmcnt(0)" ::: "memory");
    __syncthreads();
    bf16x8 qf[8], qn[8];
    { const int tb32 = ((F.bid >> 3) * ntask) * 8 + wave;
      const bf16_t* qp = Q2 + ((((size_t)tb32 * 8 + h) * 2 + 0) * 8 * 2 + hi) * 256 + r32 * 8;
#pragma unroll
      for (int s = 0; s < 8; ++s) qn[s] = *(const bf16x8*)(qp + s * 512); }
    for (int ti = 0; ti < ntask; ++ti) {
        const int tb = (F.bid >> 3) * ntask + ti;
        const int t = tb * 256 + wave * 32 + r32;
        unsigned A[16], B[16];
#pragma unroll
        for (int pp = 0; pp < 2; ++pp) {
#pragma unroll
            for (int s = 0; s < 8; ++s) qf[s] = qn[s];
            { const int nti = pp == 0 ? ti : ti + 1, npp = pp ^ 1;
              if (nti < ntask) { const int tb32 = ((F.bid >> 3) * ntask + nti) * 8 + wave;
                  const bf16_t* qp = Q2 + ((((size_t)tb32 * 8 + h) * 2 + npp) * 8 * 2 + hi) * 256 + r32 * 8;
#pragma unroll
                  for (int s = 0; s < 8; ++s) qn[s] = *(const bf16x8*)(qp + s * 512); } }
            f32x16 acc[4];
#pragma unroll
            for (int kb = 0; kb < 4; ++kb)
#pragma unroll
                for (int r = 0; r < 16; ++r) acc[kb][r] = 0.f;
            att::lcp ab = (att::lcp)(lds + pp * 32768 + hi * 2048 + r32 * 16);
#pragma unroll
            for (int s = 0; s < 8; ++s)
#pragma unroll
                for (int kb = 0; kb < 4; ++kb) {
                    const bf16x8 a = *(const __attribute__((address_space(3))) bf16x8*)(ab + s * 4096 + kb * 512);
                    acc[kb] = __builtin_amdgcn_mfma_f32_32x32x16_bf16(a, qf[s], acc[kb], 0, 0, 0);
                }
            unsigned v0[16], v1[16], v2[16], v3[16];
#pragma unroll
            for (int r = 0; r < 16; ++r) {
                const int c = 127 - ((r & 3) + 8 * (r >> 2));
                v0[r] = (ord(acc[0][r]) & 0xFFFFFF80u) | (unsigned)(c - 0 - 4 * hi);
                v1[r] = (ord(acc[1][r]) & 0xFFFFFF80u) | (unsigned)(c - 32 - 4 * hi);
                v2[r] = (ord(acc[2][r]) & 0xFFFFFF80u) | (unsigned)(c - 64 - 4 * hi);
                v3[r] = (ord(acc[3][r]) & 0xFFFFFF80u) | (unsigned)(c - 96 - 4 * hi);
            }
            top16_of_64x2(v0, v1, v2, v3);
            if (pp == 0) {
#pragma unroll
                for (int i = 0; i < 16; ++i) A[i] = v0[i];
            } else {
#pragma unroll
                for (int i = 0; i < 16; ++i) B[i] = v0[i];
            }
        }
        float fa[16], fb[16];
#pragma unroll
        for (int i = 0; i < 16; ++i) { fa[i] = unord(A[i] & 0xFFFFFF80u); fb[i] = unord(B[i] & 0xFFFFFF80u);
            W[i * 64 + lane] = 127 - (int)(A[i] & 127u); W[(16 + i) * 64 + lane] = 127 - (int)(B[i] & 127u); }
        unsigned c0[16], c1[16], c2[16], c3[16];
#pragma unroll
        for (int j = 0; j < 16; ++j) c0[j] = (ord(fa[0] + fb[j]) & 0xFFFFFF00u) | (unsigned)(255 - j);
        {
            int n = 0;
#pragma unroll
            for (int i = 1; i < 16; ++i)
#pragma unroll
                for (int j = 0; j < 16; ++j) if ((i + 1) * (j + 1) <= 16) {
                    const unsigned key = (ord(fa[i] + fb[j]) & 0xFFFFFF00u) | (unsigned)(255 - (i * 16 + j));
                    if (n < 16) c1[n] = key; else if (n < 32) c2[n - 16] = key; else c3[n - 32] = key;
                    ++n;
                }
#pragma unroll
            for (int k = 2; k < 16; ++k) c3[k] = 0u;
        }
        sort16_desc(c1); sort16_desc(c2); sort16_desc(c3);
        merge_top16(c0, c1); merge_top16(c2, c3); merge_top16(c0, c2);
        float ev[16]; float l = 0.f; const float mx = unord(c0[0] & 0xFFFFFF00u);
#pragma unroll
        for (int k = 0; k < 16; ++k) { ev[k] = __expf(unord(c0[k] & 0xFFFFFF00u) - mx); l += ev[k]; }
        const float rl = 1.f / l;
        int ex[8]; float gt[8], su[8];
#pragma unroll
        for (int kk = 0; kk < 8; ++kk) {
            const unsigned key = hi ? c0[8 + kk] : c0[kk]; const float e = hi ? ev[8 + kk] : ev[kk];
            const int pos = 255 - (int)(key & 255u);
            ex[kk] = W[(pos >> 4) * 64 + lane] * 128 + W[(16 + (pos & 15)) * 64 + lane];
            gt[kk] = e * rl * VSC[ex[kk]]; su[kk] = USC[ex[kk]];
        }
        int* ep = EX + (size_t)t * 128 + h * 16 + hi * 8; float* gp = GT + (size_t)t * 128 + h * 16 + hi * 8;
        *(u32x4*)ep = (u32x4){(unsigned)ex[0], (unsigned)ex[1], (unsigned)ex[2], (unsigned)ex[3]}; *(u32x4*)(ep + 4) = (u32x4){(unsigned)ex[4], (unsigned)ex[5], (unsigned)ex[6], (unsigned)ex[7]};
        *(f32x4*)gp = (f32x4){gt[0], gt[1], gt[2], gt[3]}; *(f32x4*)(gp + 4) = (f32x4){gt[4], gt[5], gt[6], gt[7]};
        float* sp = SUo + (size_t)t * 128 + h * 16 + hi * 8;
        *(f32x4*)sp = (f32x4){su[0], su[1], su[2], su[3]}; *(f32x4*)(sp + 4) = (f32x4){su[4], su[5], su[6], su[7]};
    }
    __syncthreads();
}

#define P8_SYNC 0
#define P8_PARTITION 0
#define HAVE_P3 1
#define HAVE_P7 1
struct Args { Params p; int ph_lo, ph_hi, li, pad; };
__global__ void __launch_bounds__(NTHR, 2) mk_fwd(Args a) {
    extern __shared__ __attribute__((aligned(16))) unsigned char lds[];
    Frame F;
    F.lds = (LAS unsigned char*)lds;
    F.MISC = (volatile LAS unsigned*)(F.lds + MISC_OFF);
    F.tid = threadIdx.x; F.lane = F.tid & 63; F.wave = __builtin_amdgcn_readfirstlane(F.tid >> 6);
    F.G = gridDim.x; F.bid = blockIdx.x;
    const Params& p = a.p;
    gu32* ctl = (gu32*)(p.ws + WS_CTL);
    for (int u = F.tid; u < 128; u += NTHR) ((LAS unsigned*)(F.lds + MISC_OFF))[u] = 0u;
    __syncthreads();
    XcdBarrier bar = xcd_barrier_post((unsigned*)(ctl + CW_BAR) + a.li * XCD_BAR_WORDS, F.MISC + 8);
    const int lo = a.ph_lo, hi = a.ph_hi;
#ifdef PROBE_TS
    int nts_ = 0;
#define STAMP() do { if (threadIdx.x == 0 && nts_ < 12) { const unsigned long long t_ = __builtin_amdgcn_s_memrealtime(); F.MISC[32 + 2 * nts_] = (unsigned)t_; F.MISC[33 + 2 * nts_] = (unsigned)(t_ >> 32); } ++nts_; } while (0)
    STAMP();
#else
#define STAMP() do {} while (0)
#endif
#define IN(k) (lo <= (k) && (k) < hi)
#define REFRESH() do { F.lane = (int)__builtin_amdgcn_mbcnt_hi(~0u, __builtin_amdgcn_mbcnt_lo(~0u, 0u)); F.tid = F.wave * 64 + F.lane; } while (0)
#define SEAM(k) do { if (IN(k) && IN((k) + 1)) xcd_barrier(bar); STAMP(); } while (0)

#ifndef PROBE_DUP
#define PROBE_DUP -1
#endif
#define REP(k) for (int rep_ = 0; rep_ < (PROBE_DUP == (k) ? 2 : 1); ++rep_)
    if (IN(0)) { REP(0) p0_prologue(F, p); SEAM(0); }
    if (IN(1)) { REP(1) { p1_hrows(F, p); __syncthreads(); } SEAM(1); }
    if (IN(2)) {
        pg8::Gemm g{(const bf16_t*)(p.ws + WS_H), (const bf16_t*)(p.ws + WS_WIN), MALL, NQKV, D}; pg8::StaticOrder S; S.init(MALL, NQKV, F.G, F.bid);
        EpiQKVFast E{p.ws};
        REP(2) pg8::gemm_phase<EpiQKVFast, pg8::StaticOrder, true, true>(F.lds + RING_OFF, g, S, E);
        SEAM(2);
    }
#if HAVE_P3
    if (IN(3)) { REP(31) att::na_units(F, p); att::diff_units_v2<0>(F, p);
#if PROBE_DUP == 321
        att::diff_units_v2<1>(F, p);
#elif PROBE_DUP == 323
        att::diff_units_v2<3>(F, p);
#elif PROBE_DUP == 322
        att::diff_units_v2<2>(F, p);
#elif PROBE_DUP == 32
        att::diff_units_v2<0>(F, p);
#endif
        SEAM(3); }
#endif
    if (IN(4)) {
        pg8::Gemm g{(const bf16_t*)(p.ws + WS_Y), (const bf16_t*)(p.ws + WS_WOUT), MLAT, D, D}; pg8::StaticOrder S; S.init(MLAT, D, F.G, F.bid);
        pg8::EpiBf16<0> E{(bf16_t*)(p.ws + WS_YO), D, nullptr, 0, 0, 1.f};
        REP(4) pg8::gemm_phase<pg8::EpiBf16<0>, pg8::StaticOrder, true, true>(F.lds + RING_OFF, g, S, E);
        SEAM(4);
    }
    if (IN(5)) { REP(5) p5_rows2(F, p); SEAM(5); }
    if (IN(6)) {
        pg8::Gemm g{(const bf16_t*)(p.ws + WS_H2), (const bf16_t*)(p.ws + WS_WPQ), MLAT, 2048, D}; pg8::StaticOrder S; S.init(MLAT, 2048, F.G, F.bid);
        EpiQ2Frag E{(bf16_t*)(p.ws + WS_Q2)};
        REP(6) pg8::gemm_phase<EpiQ2Frag, pg8::StaticOrder, true, true>(F.lds + RING_OFF, g, S, E);
        SEAM(6);
    }
#if HAVE_P7
    if (IN(7)) { REP(7) p7_topk(F, p); SEAM(7); }
#endif
#if P8_PARTITION
    if (IN(8)) {
        p7b_sort(F, p); xcd_barrier(bar);
        for (int ch = 0; ch < 2; ++ch) { p8a_part(F, p, ch); xcd_barrier(bar); p8b_combine(F, p, ch); if (ch == 0) xcd_barrier(bar); }
    }
#else
    if (IN(8)) { p8_gather<0>(F, p, bar); }
#endif
#ifdef PROBE_TS
#ifdef PROBE_TS_ENDBAR
    xcd_barrier(bar);
#endif
    STAMP();
    if (blockIdx.x == 0 && threadIdx.x == 0) { const unsigned long long t1_ = ((unsigned long long)F.MISC[33 + 2 * (PROBE_TS + 1)] << 32) | F.MISC[32 + 2 * (PROBE_TS + 1)], t0_ = ((unsigned long long)F.MISC[33 + 2 * PROBE_TS] << 32) | F.MISC[32 + 2 * PROBE_TS];
        const unsigned long long dt = t1_ - t0_; const unsigned long long t_end = __builtin_amdgcn_s_memrealtime();
        while (__builtin_amdgcn_s_memrealtime() - t_end < 8ull * dt) __builtin_amdgcn_s_sleep(8); }
#endif
#undef IN
#undef SEAM
}

static void launch_mk(const Params& p, int lo, int hi, int li, hipStream_t stream) {
    Args a{}; a.p = p; a.ph_lo = lo; a.ph_hi = hi; a.li = li; a.pad = 0;
    hipLaunchKernelGGL(mk_fwd, dim3(256), dim3(NTHR), LDS_BYTES, stream, a);
}
extern "C" void kernel_launch(void* const* d_in, const int* in_sizes, int n_in, void* d_out, int out_size, void* d_ws, size_t ws_size, hipStream_t stream) {
    if (n_in != 16 || ws_size < WS_END) return;
    static bool attr_done = false;
    if (!attr_done) {
        (void)hipFuncSetAttribute((const void*)mk_fwd, hipFuncAttributeMaxDynamicSharedMemorySize, LDS_BYTES);
        attr_done = true;
    }
    Params p{};
    p.x = (const float*)d_in[0]; p.c = (const float*)d_in[1]; p.ctx = (const float*)d_in[2]; p.c_ctx = (const float*)d_in[3];
    p.w_ada = (const float*)d_in[4]; p.b_ada = (const float*)d_in[5]; p.g_norm = (const float*)d_in[6]; p.w_in = (const float*)d_in[7];
    p.rel_bias = (const float*)d_in[8]; p.diff_lambda = (const float*)d_in[9]; p.diff_subln = (const float*)d_in[10]; p.w_out = (const float*)d_in[11];
    p.peer_wq = (const float*)d_in[12]; p.peer_keys = (const float*)d_in[13]; p.peer_u = (const float*)d_in[14]; p.peer_v = (const float*)d_in[15];
    p.out = (float*)d_out; p.ws = (unsigned char*)d_ws;
    (void)hipMemsetAsync((char*)d_ws + WS_CTL, 0, CTL_ZERO_BYTES, stream);

    launch_mk(p, 0, 9, 0, stream);

}
```

```cpp
#include <hip/hip_runtime.h>
#include <stdint.h>
#include <math.h>

typedef unsigned short bf16_t;
typedef float f32x4 __attribute__((ext_vector_type(4)));
typedef unsigned u32x4 __attribute__((ext_vector_type(4)));
typedef unsigned u32x2 __attribute__((ext_vector_type(2)));
typedef float f32x2 __attribute__((ext_vector_type(2)));

constexpr int D = 1024, BATCH = 8, SEQ = 4096, CTX = 256, GW = 64;
constexpr int MLAT = BATCH * SEQ;
constexpr int MCTX = BATCH * CTX;
constexpr int MALL = MLAT + MCTX;
constexpr int NQKV = 3072;
constexpr int NKT = 68;
constexpr int NMOD = 6 * D;
constexpr int PE_H = 8, PE_NK = 128, PE_QD = 256, PE_TOPK = 16, PE_NEXP = 16384;
constexpr float EPS = 1e-6f;
constexpr float LOG2E = 1.4426950408889634f;
constexpr float C2 = 0.125f * LOG2E;
constexpr float LAMBDA_INIT = 0.2f;
constexpr float NEG_BIG = -30000.0f;

constexpr size_t MiB = 1u << 20;
constexpr size_t WS_CTL = 0;
constexpr size_t WS_MOD = 1 * MiB;
constexpr size_t WS_LAM = 1 * MiB + 256 * 1024;
constexpr size_t WS_ROPE = 1 * MiB + 512 * 1024;
constexpr size_t WS_USC = 1 * MiB + 640 * 1024;
constexpr size_t WS_VSC = 1 * MiB + 704 * 1024;
constexpr size_t WS_MODP = 2 * MiB;
constexpr size_t WS_BIAST = 4 * MiB;
constexpr size_t WS_KEYS = 5 * MiB;
constexpr size_t WS_KEYSI = 5 * MiB + 512 * 1024;
constexpr size_t WS_WIN = 6 * MiB;
constexpr size_t WS_WOUT = 12 * MiB;
constexpr size_t WS_WPQ = 14 * MiB;
constexpr size_t WS_UB = 18 * MiB;
constexpr size_t WS_VB = 50 * MiB;
constexpr size_t WS_EXP = 82 * MiB;
constexpr size_t WS_GATE = 98 * MiB;
constexpr size_t WS_H2 = 114 * MiB;
constexpr size_t WS_H = 178 * MiB;
constexpr size_t WS_Y = 178 * MiB;
constexpr size_t WS_QA = 246 * MiB;
constexpr size_t WS_KA = 278 * MiB;
constexpr size_t WS_VA = 312 * MiB;
constexpr size_t WS_QD = 346 * MiB;
constexpr size_t WS_KD = 378 * MiB;
constexpr size_t WS_VD = 412 * MiB;
constexpr size_t WS_YO = 246 * MiB;
constexpr size_t WS_Q2 = 246 * MiB;
constexpr size_t WS_PART = 178 * MiB;
constexpr size_t WS_DSCR = 464 * MiB;
constexpr size_t WS_SU = 446 * MiB;
constexpr size_t WS_END = 496 * MiB;

struct Params {
    const float *x, *c, *ctx, *c_ctx, *w_ada, *b_ada, *g_norm, *w_in, *rel_bias, *diff_lambda, *diff_subln, *w_out, *peer_wq, *peer_keys, *peer_u, *peer_v;
    float* out;
    unsigned char* ws;
};

__device__ __forceinline__ unsigned f2bf(float f) { unsigned u = __builtin_bit_cast(unsigned, f); return (u + 0x7fffu + ((u >> 16) & 1u)) >> 16; }
__device__ __forceinline__ unsigned pk2(float lo, float hi) { return f2bf(lo) | (f2bf(hi) << 16); }
__device__ __forceinline__ float bf2f(bf16_t h) { return __builtin_bit_cast(float, (unsigned)h << 16); }
__device__ __forceinline__ float bflo(unsigned w) { return __builtin_bit_cast(float, w << 16); }
__device__ __forceinline__ float bfhi(unsigned w) { return __builtin_bit_cast(float, w & 0xffff0000u); }
__device__ __forceinline__ float wave_sum(float v) {
    v += __uint_as_float((unsigned)__builtin_amdgcn_update_dpp(0, (int)__float_as_uint(v), 0xB1, 0xf, 0xf, false));
    v += __uint_as_float((unsigned)__builtin_amdgcn_update_dpp(0, (int)__float_as_uint(v), 0x4E, 0xf, 0xf, false));
    v += __uint_as_float((unsigned)__builtin_amdgcn_update_dpp(0, (int)__float_as_uint(v), 0x141, 0xf, 0xf, false));
    v += __uint_as_float((unsigned)__builtin_amdgcn_update_dpp(0, (int)__float_as_uint(v), 0x128, 0xf, 0xf, false));
    { auto r = __builtin_amdgcn_permlane16_swap(__float_as_uint(v), __float_as_uint(v), false, false); v = __uint_as_float(r[0]) + __uint_as_float(r[1]); }
    { auto r = __builtin_amdgcn_permlane32_swap(__float_as_uint(v), __float_as_uint(v), false, false); v = __uint_as_float(r[0]) + __uint_as_float(r[1]); }
    return v;
}
__device__ __forceinline__ float wave_max(float v) {
    v = fmaxf(v, __uint_as_float((unsigned)__builtin_amdgcn_update_dpp(0, (int)__float_as_uint(v), 0xB1, 0xf, 0xf, false)));
    v = fmaxf(v, __uint_as_float((unsigned)__builtin_amdgcn_update_dpp(0, (int)__float_as_uint(v), 0x4E, 0xf, 0xf, false)));
    v = fmaxf(v, __uint_as_float((unsigned)__builtin_amdgcn_update_dpp(0, (int)__float_as_uint(v), 0x141, 0xf, 0xf, false)));
    v = fmaxf(v, __uint_as_float((unsigned)__builtin_amdgcn_update_dpp(0, (int)__float_as_uint(v), 0x128, 0xf, 0xf, false)));
    { auto r = __builtin_amdgcn_permlane16_swap(__float_as_uint(v), __float_as_uint(v), false, false); v = fmaxf(__uint_as_float(r[0]), __uint_as_float(r[1])); }
    { auto r = __builtin_amdgcn_permlane32_swap(__float_as_uint(v), __float_as_uint(v), false, false); v = fmaxf(__uint_as_float(r[0]), __uint_as_float(r[1])); }
    return v;
}

__device__ __forceinline__ float half_max(float v) {
    v = fmaxf(v, __uint_as_float((unsigned)__builtin_amdgcn_update_dpp(0, (int)__float_as_uint(v), 0xB1, 0xf, 0xf, false)));
    v = fmaxf(v, __uint_as_float((unsigned)__builtin_amdgcn_update_dpp(0, (int)__float_as_uint(v), 0x4E, 0xf, 0xf, false)));
    v = fmaxf(v, __uint_as_float((unsigned)__builtin_amdgcn_update_dpp(0, (int)__float_as_uint(v), 0x141, 0xf, 0xf, false)));
    v = fmaxf(v, __uint_as_float((unsigned)__builtin_amdgcn_update_dpp(0, (int)__float_as_uint(v), 0x128, 0xf, 0xf, false)));
    { auto r = __builtin_amdgcn_permlane16_swap(__float_as_uint(v), __float_as_uint(v), false, false); v = fmaxf(__uint_as_float(r[0]), __uint_as_float(r[1])); }
    return v;
}
typedef float f32x16 __attribute__((ext_vector_type(16)));
typedef float f32x32 __attribute__((ext_vector_type(32)));
typedef unsigned u32x6 __attribute__((ext_vector_type(6)));

__device__ __forceinline__ u32x6 enc_fp6(f32x16 a, f32x16 b) { u32x6 w; asm volatile("v_cvt_scalef32_2xpk16_fp6_f32 %0, %1, %2, 1.0" : "=&v"(w) : "v"(a), "v"(b)); return w; }
__device__ __forceinline__ f32x32 dec_fp6(u32x6 w) { f32x32 r; asm volatile("v_cvt_scalef32_pk32_f32_fp6 %0, %1, 1.0" : "=&v"(r) : "v"(w)); return r; }

__device__ __forceinline__ int ktile_off(int k, int d) { return (d >> 3) * 512 + k * 8 + (d & 7); }
__device__ __forceinline__ int vtile_off(int k, int d) { return (d >> 5) * 2048 + (k >> 4) * 512 + (k & 15) * 32 + (d & 31); }
__device__ __forceinline__ size_t qa_idx(int b, int h, int t, int d) { return ((size_t)(b * 8 + h) * SEQ + t) * 64 + d; }
__device__ __forceinline__ size_t ka_idx(int b, int h, int j, int d) { return ((size_t)(b * 8 + h) * NKT + (j >> 6)) * 4096 + ktile_off(j & 63, d); }
__device__ __forceinline__ size_t va_idx(int b, int h, int j, int d) { return ((size_t)(b * 8 + h) * NKT + (j >> 6)) * 4096 + vtile_off(j & 63, d); }
__device__ __forceinline__ size_t qd_idx(int b, int m, int h, int t, int d) { return ((size_t)((b * 2 + m) * 4 + h) * SEQ + t) * 64 + d; }
__device__ __forceinline__ size_t kd_idx(int b, int m, int h, int j, int d) { return ((size_t)((b * 2 + m) * 4 + h) * NKT + (j >> 6)) * 4096 + ktile_off(j & 63, d); }
__device__ __forceinline__ size_t vd_idx(int b, int h, int j, int d) { return ((size_t)(b * 4 + h) * NKT + (j >> 6)) * 8192 + vtile_off(j & 63, d); }


namespace pg8 {
#define PG8_LAS __attribute__((address_space(3)))
typedef unsigned short bf16_t;
typedef short bf16x8 __attribute__((ext_vector_type(8)));
typedef float f32x4 __attribute__((ext_vector_type(4)));
typedef unsigned u32x4 __attribute__((ext_vector_type(4)));
constexpr int BM = 256, BK = 64, HALF = 128, HTB = HALF * BK * 2  , STAGE_BYTES = 8 * HTB, NXCD = 8, WGM = 8;

__host__ __device__ __forceinline__ int lds_byte(int r, int c) { const int st = (r >> 4) * 2 + (c >> 5), rr = r & 15, cc = c & 31, ob = rr * 64 + cc * 2; return st * 1024 + (ob ^ (((ob >> 9) & 1) << 5)); }
__host__ __device__ __forceinline__ void stage_rc(int b, int& R, int& C) { const int st = b / 1024, sb = b % 1024, swz = sb ^ (((sb >> 9) & 1) << 5); R = (st >> 1) * 16 + swz / 64; C = (st & 1) * 32 + (swz % 64) / 2; }
__host__ __device__ __forceinline__ int perm32(int rho) { const int n = rho >> 4, i = rho & 15; return 8 * (i >> 2) + 4 * n + (i & 3); }

struct Unit { int pm, pn; };
struct Gemm { const bf16_t* A; const bf16_t* Bt; int M, N, K; };

struct StaticOrder {
    int nM, nN, nwg, G, c;
    __host__ __device__ void init(int M, int N, int G_, int c_) { nM = M / BM; nN = N / BM; nwg = nM * nN; G = G_; c = c_; }
    __host__ __device__ bool next(int i, Unit& u) const {
        const long L = (long)i * G + c; if (L >= nwg) return false;
        int wgid = (int)L; { const int q = nwg / NXCD, r = nwg % NXCD, xcd = wgid % NXCD, off = wgid / NXCD; wgid = (xcd < r ? xcd * (q + 1) : r * (q + 1) + (xcd - r) * q) + off; }
        const int nig = WGM * nN, gid = wgid / nig, fm = gid * WGM, gsz = (nM - fm) < WGM ? (nM - fm) : WGM;
        u.pm = fm + ((wgid % nig) % gsz); u.pn = (wgid % nig) / gsz; return true;
    }
    __device__ __forceinline__ void a_ready(const Unit&) const {}
    __device__ __forceinline__ void done(const Unit&) const {}
};

__device__ __forceinline__ unsigned cvt_pk_bf16(float lo, float hi) { unsigned r; asm volatile("v_cvt_pk_bf16_f32 %0, %1, %2" : "=v"(r) : "v"(lo), "v"(hi)); return r; }
typedef float f32x2 __attribute__((ext_vector_type(2)));
__device__ __forceinline__ f32x2 gelu_pk(f32x2 v) {
    const f32x2 av = __builtin_elementwise_abs(v), d = av * 0.2316418882f + 1.0f;
    f32x2 t; t.x = __builtin_amdgcn_rcpf(d.x); t.y = __builtin_amdgcn_rcpf(d.y);
    f32x2 q = t * 0.5307027145f + (-0.7265760135f); q = q * t + 0.7107068705f; q = q * t + (-0.142248368f); q = q * t + 0.127414796f; q = q * t;
    const f32x2 s = (v * v) * (-0.72134752044f);
    f32x2 e; e.x = __builtin_amdgcn_exp2f(s.x); e.y = __builtin_amdgcn_exp2f(s.y);
    const f32x2 m = v * (q * e), r = v - m;
    f32x2 o; o.x = v.x < 0.f ? m.x : r.x; o.y = v.y < 0.f ? m.y : r.y; return o;
}

template <int ACT  > struct EpiBf16 {
    static constexpr bool PERM = true, AFTER_DRAIN = false; static_assert(ACT == 0 || ACT == 1, "EpiBf16: ACT is 0 (none) or 1 (gelu_pk)");
    bf16_t* O; int ldc; const float* bias; int split_cols; size_t split_stride; float scale0;
    __device__ __forceinline__ void operator()(const f32x4 (&acc)[2][2][4][2], const Unit& u, int wr, int wc, int fr, int fq) const {
        const int row0 = u.pm * BM + wr * 64 + fr; int colt = u.pn * BM; bf16_t* base = O;
        float sc = 1.f; if (split_cols) { const int t = colt / split_cols; base += (size_t)t * split_stride; colt -= t * split_cols; if (t == 0) sc = scale0; }
        const int col0 = colt + wc * 32 + 8 * fq, bcol0 = u.pn * BM + wc * 32 + 8 * fq;
        f32x4 bv[2][2];
#pragma unroll
        for (int bj = 0; bj < 2; ++bj)
#pragma unroll
            for (int n = 0; n < 2; ++n) bv[bj][n] = bias ? *(const f32x4*)(bias + bcol0 + bj * HALF + 4 * n) : (f32x4){0.f, 0.f, 0.f, 0.f};
#pragma unroll
        for (int ai = 0; ai < 2; ++ai)
#pragma unroll
            for (int m = 0; m < 4; ++m) { bf16_t* rowp = base + (size_t)(row0 + ai * HALF + m * 16) * ldc + col0;
#pragma unroll
                for (int bj = 0; bj < 2; ++bj) { f32x4 v0 = acc[ai][bj][m][0] + bv[bj][0], v1 = acc[ai][bj][m][1] + bv[bj][1];
                    if (ACT == 1) { f32x2 a = gelu_pk((f32x2){v0[0], v0[1]}), b = gelu_pk((f32x2){v0[2], v0[3]}), c = gelu_pk((f32x2){v1[0], v1[1]}), d = gelu_pk((f32x2){v1[2], v1[3]});
                        v0 = (f32x4){a.x, a.y, b.x, b.y}; v1 = (f32x4){c.x, c.y, d.x, d.y}; }
                    v0 = v0 * sc; v1 = v1 * sc; u32x4 w; w.x = cvt_pk_bf16(v0[0], v0[1]); w.y = cvt_pk_bf16(v0[2], v0[3]); w.z = cvt_pk_bf16(v1[0], v1[1]); w.w = cvt_pk_bf16(v1[2], v1[3]);
                    *(u32x4*)(rowp + bj * HALF) = w; } }
    }
};

template <class Epi, class Sched, bool ALIGN_EPI = false, bool SP2 = false>
__device__ __forceinline__ void gemm_phase(PG8_LAS unsigned char* lds, const Gemm g, const Sched& S, const Epi& E) {
    const int tid = threadIdx.x, wid = __builtin_amdgcn_readfirstlane(tid >> 6), lane = tid & 63, wr = wid >> 2, wc = wid & 3, fr = lane & 15, fq = lane >> 4;
    const int K = g.K, nt = K / BK;
    unsigned voffA[2], voffB[2];
#pragma unroll
    for (int i = 0; i < 2; ++i) { int R, C; stage_rc(tid * 16 + i * 8192, R, C); const int Rb = Epi::PERM ? ((R & ~31) + perm32(R & 31)) : R;
        voffA[i] = (unsigned)(R * K + C) * 2u; voffB[i] = (unsigned)(Rb * K + C) * 2u; }
    const size_t kstep = (size_t)(BK * 2);
    const size_t hstep = (size_t)HALF * K * 2;
    const size_t tstep = 2 * hstep;
    const unsigned ldsw = (unsigned)wid * 1024u;
    const int aoff = lds_byte(wr * 64 + fr, fq * 8), boff = lds_byte(wc * 32 + fr, fq * 8);
#define PG8_SA(b, h) (((b) * 2 + (h)) * HTB)
#define PG8_SB(b, h) ((4 + (b) * 2 + (h)) * HTB)
#define PG8_STAGE(bufoff, gbase, voff) do { _Pragma("unroll") for (int _i = 0; _i < 2; ++_i) \
        __builtin_amdgcn_global_load_lds((const unsigned*)((const char*)(gbase) + (voff)[_i]), (PG8_LAS unsigned*)(lds + (bufoff) + ldsw + _i * 8192), 16, 0, 0); } while (0)
#define PG8_LDA(dst, b, h) do { _Pragma("unroll") for (int m = 0; m < 4; ++m) _Pragma("unroll") for (int k = 0; k < 2; ++k) dst[m][k] = *(const PG8_LAS bf16x8*)(lds + PG8_SA(b, h) + aoff + m * 2048 + k * 1024); } while (0)
#define PG8_LDB(dst, b, h) do { _Pragma("unroll") for (int n = 0; n < 2; ++n) _Pragma("unroll") for (int k = 0; k < 2; ++k) dst[n][k] = *(const PG8_LAS bf16x8*)(lds + PG8_SB(b, h) + boff + n * 2048 + k * 1024); } while (0)
#define PG8_MMA(ai, bj, At, Bt) do { __builtin_amdgcn_s_setprio(1); _Pragma("unroll") for (int m = 0; m < 4; ++m) _Pragma("unroll") for (int n = 0; n < 2; ++n) _Pragma("unroll") for (int k = 0; k < 2; ++k) \
        acc[ai][bj][m][n] = __builtin_amdgcn_mfma_f32_16x16x32_bf16(Bt[n][k], At[m][k], acc[ai][bj][m][n], 0, 0, 0); __builtin_amdgcn_s_setprio(0); } while (0)
#define PG8_WAIT_V(n) asm volatile("s_waitcnt vmcnt(" #n ")" ::: "memory")
#define PG8_WAIT_L(n) asm volatile("s_waitcnt lgkmcnt(" #n ")" ::: "memory")
#define PG8_BAR __builtin_amdgcn_s_barrier()
#define PG8_SCHED __builtin_amdgcn_sched_barrier(0)
    Unit cur, nxt; int ui = 0;
    if (!S.next(0, cur)) return;
    f32x4 acc[2][2][4][2];
#pragma unroll
    for (int a = 0; a < 2; ++a)
#pragma unroll
        for (int b = 0; b < 2; ++b)
#pragma unroll
            for (int m = 0; m < 4; ++m)
#pragma unroll
                for (int n = 0; n < 2; ++n) acc[a][b][m][n] = (f32x4){0.f, 0.f, 0.f, 0.f};
    bf16x8 At[4][2], B0[2][2], B1[2][2];
    const char* cA = (const char*)g.A + (size_t)cur.pm * tstep; const char* cB = (const char*)g.Bt + (size_t)cur.pn * tstep;
    S.a_ready(cur);
    if constexpr (SP2) {
        PG8_STAGE(PG8_SB(0, 0), cB, voffB); PG8_STAGE(PG8_SB(0, 1), cB + hstep, voffB); PG8_STAGE(PG8_SA(0, 0), cA, voffA); PG8_STAGE(PG8_SA(0, 1), cA + hstep, voffA);
        if (wr == 1) PG8_BAR;
        PG8_WAIT_V(2); PG8_BAR;
        PG8_STAGE(PG8_SB(1, 0), cB + kstep, voffB); PG8_STAGE(PG8_SA(1, 0), cA + kstep, voffA); PG8_STAGE(PG8_SB(1, 1), cB + hstep + kstep, voffB);
        PG8_WAIT_V(6); PG8_BAR;
    } else {
        PG8_STAGE(PG8_SB(0, 0), cB, voffB); PG8_STAGE(PG8_SA(0, 0), cA, voffA); PG8_STAGE(PG8_SB(0, 1), cB + hstep, voffB); PG8_STAGE(PG8_SA(0, 1), cA + hstep, voffA);
        if (wr == 1) PG8_BAR;
        PG8_WAIT_V(4); PG8_BAR;
        PG8_STAGE(PG8_SB(1, 0), cB + kstep, voffB); PG8_STAGE(PG8_SA(1, 0), cA + kstep, voffA); PG8_STAGE(PG8_SB(1, 1), cB + hstep + kstep, voffB);
        PG8_WAIT_V(6); PG8_BAR;
    }
    for (;;) {
        const bool has_next = S.next(ui + 1, nxt);
        const char* nA = has_next ? (const char*)g.A + (size_t)nxt.pm * tstep : cA; const char* nB = has_next ? (const char*)g.Bt + (size_t)nxt.pn * tstep : cB;
        for (int t = 0; t < nt; t += 2) {
            const bool last = (t == nt - 2);
            const char* a1 = cA + (size_t)(t + 1) * kstep;
            const char* a2 = last ? nA : cA + (size_t)(t + 2) * kstep; const char* b2 = last ? nB : cB + (size_t)(t + 2) * kstep;
            const char* a3 = a2 + kstep; const char* b3 = b2 + kstep;
            if (last && has_next) S.a_ready(nxt);
            if constexpr (SP2) {
            PG8_LDB(B0, 0, 0); PG8_LDB(B1, 0, 1); PG8_SCHED; PG8_LDA(At, 0, 0); PG8_STAGE(PG8_SA(1, 1), a1 + hstep, voffA);
            PG8_WAIT_V(8); PG8_WAIT_L(0); PG8_BAR; PG8_MMA(0, 0, At, B0); PG8_MMA(0, 1, At, B1); PG8_BAR; PG8_SCHED;
            PG8_LDA(At, 0, 1); PG8_STAGE(PG8_SB(0, 0), b2, voffB); PG8_STAGE(PG8_SB(0, 1), b2 + hstep, voffB); PG8_STAGE(PG8_SA(0, 0), a2, voffA);
            PG8_WAIT_V(8); PG8_WAIT_L(0); PG8_BAR; PG8_MMA(1, 0, At, B0); PG8_MMA(1, 1, At, B1); PG8_BAR; PG8_SCHED;
            PG8_LDB(B0, 1, 0); PG8_LDB(B1, 1, 1); PG8_SCHED; PG8_LDA(At, 1, 0); PG8_STAGE(PG8_SA(0, 1), a2 + hstep, voffA);
            PG8_WAIT_V(8); PG8_WAIT_L(0); PG8_BAR; PG8_MMA(0, 0, At, B0); PG8_MMA(0, 1, At, B1); PG8_BAR; PG8_SCHED;
            PG8_LDA(At, 1, 1); PG8_STAGE(PG8_SB(1, 0), b3, voffB); PG8_STAGE(PG8_SB(1, 1), b3 + hstep, voffB); PG8_STAGE(PG8_SA(1, 0), a3, voffA);
            PG8_WAIT_V(8); PG8_WAIT_L(0); PG8_BAR; PG8_MMA(1, 0, At, B0); PG8_MMA(1, 1, At, B1); PG8_BAR; PG8_SCHED;
            } else {
            PG8_LDB(B0, 0, 0); PG8_SCHED; PG8_LDA(At, 0, 0); PG8_STAGE(PG8_SA(1, 1), a1 + hstep, voffA);
            PG8_WAIT_L(8); PG8_BAR; PG8_WAIT_L(0); PG8_MMA(0, 0, At, B0); PG8_BAR; PG8_SCHED;
            PG8_LDB(B1, 0, 1); PG8_STAGE(PG8_SB(0, 0), b2, voffB);
            PG8_BAR; PG8_WAIT_L(0); PG8_MMA(0, 1, At, B1); PG8_BAR;
            PG8_LDA(At, 0, 1); PG8_STAGE(PG8_SA(0, 0), a2, voffA);
            PG8_BAR; PG8_WAIT_L(0); PG8_MMA(1, 0, At, B0); PG8_BAR; PG8_SCHED;
            PG8_STAGE(PG8_SB(0, 1), b2 + hstep, voffB);
            PG8_WAIT_V(6); PG8_BAR; PG8_MMA(1, 1, At, B1); PG8_BAR;
            PG8_LDB(B0, 1, 0); PG8_SCHED; PG8_LDA(At, 1, 0); PG8_STAGE(PG8_SA(0, 1), a2 + hstep, voffA);
            PG8_WAIT_L(8); PG8_BAR; PG8_WAIT_L(0); PG8_MMA(0, 0, At, B0); PG8_BAR; PG8_SCHED;
            PG8_LDB(B1, 1, 1); PG8_STAGE(PG8_SB(1, 0), b3, voffB);
            PG8_BAR; PG8_WAIT_L(0); PG8_MMA(0, 1, At, B1); PG8_BAR;
            PG8_LDA(At, 1, 1); PG8_STAGE(PG8_SA(1, 0), a3, voffA);
            PG8_BAR; PG8_WAIT_L(0); PG8_MMA(1, 0, At, B0); PG8_BAR; PG8_SCHED;
            PG8_STAGE(PG8_SB(1, 1), b3 + hstep, voffB);
            PG8_WAIT_V(6); PG8_BAR; PG8_MMA(1, 1, At, B1); PG8_BAR;
            }
        }
        if constexpr (ALIGN_EPI) { if (wr == 0) PG8_BAR; }
        if constexpr (!Epi::AFTER_DRAIN) { E(acc, cur, wr, wc, fr, fq); S.done(cur); }
        if (!has_next) break;
#pragma unroll
        for (int a = 0; a < 2; ++a)
#pragma unroll
            for (int b = 0; b < 2; ++b)
#pragma unroll
                for (int m = 0; m < 4; ++m)
#pragma unroll
                    for (int n = 0; n < 2; ++n) acc[a][b][m][n] = (f32x4){0.f, 0.f, 0.f, 0.f};
        cur = nxt; cA = nA; cB = nB; ++ui;
        if constexpr (ALIGN_EPI) { if (wr == 1) PG8_BAR; }
    }
    PG8_WAIT_V(0);
    if constexpr (!ALIGN_EPI) { if (wr == 0) PG8_BAR; }
    PG8_BAR;
    if constexpr (Epi::AFTER_DRAIN) { E.fused(acc, cur, wr, wc, fr, fq, lds, wid, lane); S.done(cur); }
#undef PG8_SA
#undef PG8_SB
#undef PG8_STAGE
#undef PG8_LDA
#undef PG8_LDB
#undef PG8_MMA
#undef PG8_WAIT_V
#undef PG8_WAIT_L
#undef PG8_BAR
#undef PG8_SCHED
}
}

#define GAS __attribute__((address_space(1)))
#define LAS __attribute__((address_space(3)))
typedef unsigned v4u __attribute__((ext_vector_type(4)));
typedef float f32x4 __attribute__((ext_vector_type(4)));
typedef short bf16x8 __attribute__((ext_vector_type(8)));
typedef GAS unsigned gu32;
typedef GAS unsigned long long gu64;
#define RLX_AGENT __ATOMIC_RELAXED, __HIP_MEMORY_SCOPE_AGENT
#define LDS_WAIT() asm volatile("s_waitcnt lgkmcnt(0)" ::: "memory")
#define VM_WAIT() asm volatile("s_waitcnt vmcnt(0)" ::: "memory")
__device__ __forceinline__ unsigned long long rt() { return __builtin_amdgcn_s_memrealtime(); }

#define XB_TMO      128
#define XB_XCNT(j)  (256  + 64 * (j))
#define XB_XSUB(j)  (1280 + 64 * (j))
#define XB_XGEN(j)  (2304 + 64 * (j))
#define XB_TOP      3328
#define XB_TOPGEN   3392
#define XCD_BAR_WORDS 3456
#define XB_SPIN_CAP (1u << 18)

__device__ __forceinline__ unsigned xb_ld(unsigned* p)              { return __hip_atomic_load(p, __ATOMIC_RELAXED, __HIP_MEMORY_SCOPE_AGENT); }
__device__ __forceinline__ unsigned xb_add(unsigned* p, unsigned v) { return __hip_atomic_fetch_add(p, v, __ATOMIC_RELAXED, __HIP_MEMORY_SCOPE_AGENT); }
__device__ __forceinline__ unsigned xb_xcc_id() { return (unsigned)__builtin_amdgcn_s_getreg((3 << 11) | 20) & 0xFu; }
#define XB_SPIN(cond, bar) do { unsigned _sp = 0; while (cond) { __builtin_amdgcn_s_sleep(1); \
    if ((++_sp & 255u) == 0u) { if (xb_ld(&(bar)[XB_TMO])) break; if (_sp > XB_SPIN_CAP) { atomicAdd(&(bar)[XB_TMO], 1u); break; } } } } while (0)

struct XcdBarrier {
    unsigned* bar; unsigned x;
    volatile LAS unsigned* st;
};

__device__ __forceinline__ XcdBarrier xcd_barrier_post(unsigned* bar, volatile LAS unsigned* st) {
    XcdBarrier b; b.bar = bar; b.x = xb_xcc_id(); b.st = st;
    if (threadIdx.x == 0) (void)xb_add(&bar[XB_XCNT(b.x)], 1u);
    return b;
}
__device__ __forceinline__ void xcd_barrier_complete(unsigned* bar, unsigned x, unsigned& nloc, unsigned& nx) {
    const unsigned G = gridDim.x * gridDim.y * gridDim.z;
    unsigned sum, cnt, mine, sp = 0u;
    for (;;) {
        sum = 0u; cnt = 0u; mine = 0u;
#pragma unroll
        for (unsigned j = 0; j < 16; ++j) { const unsigned c = xb_ld(&bar[XB_XCNT(j)]); sum += c; cnt += (c > 0u) ? 1u : 0u; mine = (j == x) ? c : mine; }
        if (sum == G) break;
        __builtin_amdgcn_s_sleep(1);
        if ((++sp & 255u) == 0u) { if (xb_ld(&bar[XB_TMO])) break; if (sp > XB_SPIN_CAP) { atomicAdd(&bar[XB_TMO], 1u); break; } }
    }
    nloc = mine > 0u ? mine : 1u; nx = cnt > 0u ? cnt : 1u;
}

__device__ __forceinline__ void xcd_barrier(const XcdBarrier& b) {
    asm volatile("s_waitcnt vmcnt(0)" ::: "memory");
    __syncthreads();
    if (threadIdx.x == 0) {
        unsigned* bar = b.bar;
        __builtin_amdgcn_s_waitcnt(0);
        unsigned nloc = b.st[0], nx = b.st[1];
        if (nloc == 0u) { xcd_barrier_complete(bar, b.x, nloc, nx); b.st[0] = nloc; b.st[1] = nx; }
        const unsigned old = xb_add(&bar[XB_XSUB(b.x)], 1u);
        const unsigned gen = old / nloc;
        if (old + 1u == (gen + 1u) * nloc) {
            __builtin_amdgcn_fence(__ATOMIC_RELEASE, "agent");
            asm volatile("s_waitcnt vmcnt(0)" ::: "memory");
            const unsigned og = xb_add(&bar[XB_TOP], 1u);
            const unsigned tg = og / nx;
            if (og + 1u == (tg + 1u) * nx) xb_add(&bar[XB_TOPGEN], 1u);
            else XB_SPIN(xb_ld(&bar[XB_TOPGEN]) == tg, bar);
            __builtin_amdgcn_fence(__ATOMIC_ACQUIRE, "agent");
            xb_add(&bar[XB_XGEN(b.x)], 1u);
            asm volatile("s_waitcnt vmcnt(0)" ::: "memory");
        } else {
            XB_SPIN(xb_ld(&bar[XB_XGEN(b.x)]) == gen, bar);
            __builtin_amdgcn_fence(__ATOMIC_ACQUIRE, "agent");
            asm volatile("s_waitcnt vmcnt(0)" ::: "memory");
        }
    }
    __syncthreads();
}

constexpr int NWAVES = 8, NTHR = 512;
constexpr int RING_OFF = 0, RING_BYTES = 131072;
constexpr int LDS_BYTES = 159744;
constexpr int MISC_OFF = LDS_BYTES - 512;
constexpr size_t CTL_ZERO_BYTES = 65536;
constexpr int CW_P8CTR = 2048;
constexpr int CW_BAR = 4096;

struct Frame {
    LAS unsigned char* lds;
    volatile LAS unsigned* MISC;
    int tid, lane, wave, G, bid;
};

__device__ __forceinline__ void p0_transpose_item(const float* W, int K, int N, bf16_t* WT, LAS float* scr, int item, int lane) {
    const int nblk = N / 32, kb = item / nblk, nb = item % nblk, k0 = 64 * kb, n0 = 32 * nb;
    float tv[32];
#pragma unroll
    for (int i = 0; i < 32; ++i) tv[i] = W[(size_t)(k0 + 2 * i + (lane >> 5)) * N + n0 + (lane & 31)];
#pragma unroll
    for (int i = 0; i < 32; ++i) scr[(2 * i + (lane >> 5)) * 33 + (lane & 31)] = tv[i];
    LDS_WAIT(); asm volatile("" ::: "memory");
    const int c = lane & 7;
#pragma unroll
    for (int j = 0; j < 4; ++j) { const int n = (lane >> 3) + 8 * j; const LAS float* s = scr + (8 * c) * 33 + n;
        v4u o; o.x = pk2(s[0 * 33], s[1 * 33]); o.y = pk2(s[2 * 33], s[3 * 33]); o.z = pk2(s[4 * 33], s[5 * 33]); o.w = pk2(s[6 * 33], s[7 * 33]);
        *(GAS v4u*)(WT + (size_t)(n0 + n) * K + k0 + 8 * c) = o; }
    LDS_WAIT(); asm volatile("" ::: "memory");
}
__device__ __forceinline__ void cvt_stream(const float* src, bf16_t* dst, size_t n4, size_t gtid, size_t gsz) {
    for (size_t i = gtid; i < n4; i += gsz) { const f32x4 v = ((const f32x4*)src)[i]; u32x2 o; o.x = pk2(v.x, v.y); o.y = pk2(v.z, v.w); ((u32x2*)dst)[i] = o; }
}
__device__ __forceinline__ void p0_prologue(Frame& F, const Params& p) {
    unsigned char* ws = p.ws;
    for (int item = F.bid; item < 192; item += F.G) {
        LAS float* sil = (LAS float*)(F.lds);
        LAS float* red = (LAS float*)(F.lds + 8192);
        const int ks = item / 24, cc = item % 24;
        for (int i = F.tid; i < 9 * 128; i += NTHR) { const int r = i >> 7, k = ks * 128 + (i & 127); const float v = r < 8 ? p.c[r * 1024 + k] : p.c_ctx[k]; sil[i] = v / (1.f + __expf(-v)); }
        __syncthreads();
        f32x4 acc[9];
#pragma unroll
        for (int r = 0; r < 9; ++r) acc[r] = (f32x4){0.f, 0.f, 0.f, 0.f};
        const float* wp = p.w_ada + (size_t)(ks * 128 + F.wave * 16) * NMOD + cc * 256 + F.lane * 4;
#pragma unroll 4
        for (int kk = 0; kk < 16; ++kk) { const f32x4 w = *(const f32x4*)(wp + (size_t)kk * NMOD);
#pragma unroll
            for (int r = 0; r < 9; ++r) acc[r] += w * sil[r * 128 + F.wave * 16 + kk]; }
#pragma unroll
        for (int r = 0; r < 9; ++r) *(LAS f32x4*)(red + ((F.wave * 9 + r) * 256 + F.lane * 4)) = acc[r];
        __syncthreads();
        float* modp = (float*)(ws + WS_MODP);
        for (int i = F.tid; i < 9 * 256; i += NTHR) { const int r = i >> 8, c = i & 255; float s = 0.f;
#pragma unroll
            for (int w = 0; w < 8; ++w) s += red[(w * 9 + r) * 256 + c];
            modp[(size_t)(ks * 9 + r) * NMOD + cc * 256 + c] = s; }
        __syncthreads();
    }
    {
        LAS float* scr = (LAS float*)(F.lds + F.wave * 16384);
        const int gw = F.bid * NWAVES + F.wave, NGW = F.G * NWAVES;
        constexpr int I_IN = 16 * 96, I_OUT = 16 * 32, I_PQ = 16 * 64;
        for (int it = gw; it < I_IN + I_OUT + I_PQ; it += NGW) {
            int r = it;
            if (r < I_IN) { p0_transpose_item(p.w_in, D, NQKV, (bf16_t*)(ws + WS_WIN), scr, r, F.lane); continue; } r -= I_IN;
            if (r < I_OUT) { p0_transpose_item(p.w_out, D, D, (bf16_t*)(ws + WS_WOUT), scr, r, F.lane); continue; } r -= I_OUT;
            p0_transpose_item(p.peer_wq, D, 2048, (bf16_t*)(ws + WS_WPQ), scr, r, F.lane);
        }
    }
    const size_t gtid = (size_t)F.bid * NTHR + F.tid, gsz = (size_t)F.G * NTHR;
    cvt_stream(p.peer_keys, (bf16_t*)(ws + WS_KEYS), (size_t)8 * 2 * 128 * 128 / 4, gtid, gsz);
    { bf16_t* ki = (bf16_t*)(ws + WS_KEYSI);
      for (int i = (int)gtid; i < 8 * 2 * 16 * 128; i += (int)gsz) { const int key = i & 127, c = (i >> 7) & 15, hp = i >> 11;
          const float* sp = p.peer_keys + ((size_t)hp * 128 + key) * 128 + c * 8; const f32x4 a = *(const f32x4*)sp, b = *(const f32x4*)(sp + 4);
          u32x4 o; o.x = pk2(a.x, a.y); o.y = pk2(a.z, a.w); o.z = pk2(b.x, b.y); o.w = pk2(b.z, b.w); *(u32x4*)(ki + (size_t)i * 8) = o; } }
    {
        const int gw = F.bid * NWAVES + F.wave, NGW = F.G * NWAVES, l5 = F.lane & 31, hb = F.lane >> 5;
        for (int e0 = gw * 2; e0 < PE_NEXP; e0 += NGW * 2) {
            f32x4 x[2][8];
#pragma unroll
            for (int q = 0; q < 2; ++q) { const float* src = (hb ? p.peer_v : p.peer_u) + (size_t)(e0 + q) * D + l5 * 32;
#pragma unroll
                for (int j = 0; j < 8; ++j) x[q][j] = ((const f32x4*)src)[j]; }
#pragma unroll
            for (int q = 0; q < 2; ++q) {
                float am = 0.f;
#pragma unroll
                for (int j = 0; j < 8; ++j) am = fmaxf(am, fmaxf(fmaxf(fabsf(x[q][j].x), fabsf(x[q][j].y)), fmaxf(fabsf(x[q][j].z), fabsf(x[q][j].w))));
                am = half_max(am);
                const float top = hb ? 6.0f : 7.5f;
                const float sc = am > 0.f ? top / am : 1.f, inv = am > 0.f ? am / top : 1.f;
                f32x16 va, vb;
#pragma unroll
                for (int j = 0; j < 4; ++j) { va[4 * j] = x[q][j].x * sc; va[4 * j + 1] = x[q][j].y * sc; va[4 * j + 2] = x[q][j].z * sc; va[4 * j + 3] = x[q][j].w * sc;
                    vb[4 * j] = x[q][4 + j].x * sc; vb[4 * j + 1] = x[q][4 + j].y * sc; vb[4 * j + 2] = x[q][4 + j].z * sc; vb[4 * j + 3] = x[q][4 + j].w * sc; }
                if (hb == 0) {
                    const u32x6 w = enc_fp6(va, vb);
                    unsigned* dst = (unsigned*)(ws + WS_UB + (size_t)(e0 + q) * 768 + l5 * 24);
                    *(u32x2*)dst = (u32x2){w[0], w[1]}; *(u32x2*)(dst + 2) = (u32x2){w[2], w[3]}; *(u32x2*)(dst + 4) = (u32x2){w[4], w[5]};
                } else {
                    u32x4 o = (u32x4){0u, 0u, 0u, 0u};
#pragma unroll
                    for (int j = 0; j < 2; ++j) {
                        o[j] = __builtin_amdgcn_cvt_scalef32_pk_fp4_f32(o[j], va[8 * j + 0], va[8 * j + 1], 1.0f, 0); o[j] = __builtin_amdgcn_cvt_scalef32_pk_fp4_f32(o[j], va[8 * j + 2], va[8 * j + 3], 1.0f, 1);
                        o[j] = __builtin_amdgcn_cvt_scalef32_pk_fp4_f32(o[j], va[8 * j + 4], va[8 * j + 5], 1.0f, 2); o[j] = __builtin_amdgcn_cvt_scalef32_pk_fp4_f32(o[j], va[8 * j + 6], va[8 * j + 7], 1.0f, 3);
                        o[2 + j] = __builtin_amdgcn_cvt_scalef32_pk_fp4_f32(o[2 + j], vb[8 * j + 0], vb[8 * j + 1], 1.0f, 0); o[2 + j] = __builtin_amdgcn_cvt_scalef32_pk_fp4_f32(o[2 + j], vb[8 * j + 2], vb[8 * j + 3], 1.0f, 1);
                        o[2 + j] = __builtin_amdgcn_cvt_scalef32_pk_fp4_f32(o[2 + j], vb[8 * j + 4], vb[8 * j + 5], 1.0f, 2); o[2 + j] = __builtin_amdgcn_cvt_scalef32_pk_fp4_f32(o[2 + j], vb[8 * j + 6], vb[8 * j + 7], 1.0f, 3); }
                    *(u32x4*)(ws + WS_VB + (size_t)(e0 + q) * 512 + l5 * 16) = o;
                }
                if (l5 == 0) ((float*)(ws + (hb ? WS_VSC : WS_USC)))[e0 + q] = inv;
            }
        }
    }
    if (gtid == 0) {
        float s01 = 0.f, s23 = 0.f;
        for (int i = 0; i < 64; ++i) { s01 += p.diff_lambda[i] * p.diff_lambda[64 + i]; s23 += p.diff_lambda[128 + i] * p.diff_lambda[192 + i]; }
        *(float*)(ws + WS_LAM) = expf(s01) - expf(s23) + LAMBDA_INIT;
    }
    float* rope = (float*)(ws + WS_ROPE);
    for (int i = (int)gtid; i < 64 * 16; i += (int)gsz) { const int pos = i >> 4, f = i & 15; const float inv = exp2f(-(float)f * (13.287712379549449f / 16.f)); const float a = (float)pos * inv; rope[2 * i] = cosf(a); rope[2 * i + 1] = sinf(a); }
    bf16_t* bt = (bf16_t*)(ws + WS_BIAST);
    for (int i = (int)gtid; i < 8 * 15 * 4096; i += (int)gsz) {
        const int j = i & 7, kc = (i >> 3) & 63, cq = (i >> 9) & 7, hd = i >> 12, dr = hd % 15, h = hd / 15;
        const int cp = cq * 8 + j; int cs = cp - 8; cs = cs < 0 ? 0 : (cs > 48 ? 48 : cs);
        float v = NEG_BIG;
        if (kc >= cs && kc < cs + 16) v = p.rel_bias[(h * 15 + dr) * 31 + (kc - cp + 15)] * LOG2E;
        bt[i] = (bf16_t)f2bf(v);
    }
}

__device__ __forceinline__ void p1_hrows(Frame& F, const Params& p) {
    unsigned char* ws = p.ws;
    const float* modp = (const float*)(ws + WS_MODP);
    float* mod = (float*)(ws + WS_MOD);
    for (int i = F.bid * NTHR + F.tid; i < 9 * NMOD; i += F.G * NTHR) { float s = p.b_ada[i % NMOD];
#pragma unroll
        for (int ks = 0; ks < 8; ++ks) s += modp[(size_t)ks * 9 * NMOD + i];
        mod[i] = s; }
    const int rows_per = (MALL + F.G - 1) / F.G, r0 = F.bid * rows_per, r1 = min(MALL, r0 + rows_per);
    if (r0 >= r1) return;
    const int mr_lo = r0 < MLAT ? (r0 >> 12) : 8;
    LAS float* tab = (LAS float*)F.lds;
    for (int i = F.tid; i < 2 * 2048; i += NTHR) {
        const int which = i >> 11, ss = (i >> 10) & 1, col = i & 1023; const int mr = min(8, mr_lo + which);
        const int mi = mr * NMOD + (ss == 0 ? D : 0) + col;
        float s = p.b_ada[(ss == 0 ? D : 0) + col];
#pragma unroll
        for (int ks = 0; ks < 8; ++ks) s += modp[(size_t)ks * 9 * NMOD + mi];
        tab[i] = ss == 0 ? p.g_norm[col] * (1.f + s) : s;
    }
    __syncthreads();
    bf16_t* H = (bf16_t*)(ws + WS_H);
    f32x4 nx[2][4];
#define P1_LOAD(dst, rowa_) do { _Pragma("unroll") for (int q = 0; q < 2; ++q) { const int row = min((rowa_) + q * NWAVES, MALL - 1); \
            const float* xr = row < MLAT ? p.x + (size_t)row * D : p.ctx + (size_t)(row - MLAT) * D; \
            _Pragma("unroll") for (int j = 0; j < 4; ++j) dst[q][j] = ((const f32x4*)xr)[F.lane + 64 * j]; } } while (0)
    P1_LOAD(nx, r0 + F.wave);
    for (int rowa = r0 + F.wave; rowa < r1; rowa += 2 * NWAVES) {
        f32x4 v[2][4]; float ssq[2];
#pragma unroll
        for (int q = 0; q < 2; ++q)
#pragma unroll
            for (int j = 0; j < 4; ++j) v[q][j] = nx[q][j];
        if (rowa + 2 * NWAVES < r1) P1_LOAD(nx, rowa + 2 * NWAVES);
#pragma unroll
        for (int q = 0; q < 2; ++q) { float s = 0.f;
#pragma unroll
            for (int j = 0; j < 4; ++j) s += v[q][j].x * v[q][j].x + v[q][j].y * v[q][j].y + v[q][j].z * v[q][j].z + v[q][j].w * v[q][j].w;
            ssq[q] = wave_sum(s); }
#pragma unroll
        for (int q = 0; q < 2; ++q) { const int row = rowa + q * NWAVES; if (row < r1) {
            const int mr = row < MLAT ? (row >> 12) : 8; const LAS float* tb = tab + (mr - mr_lo) * 2048;
            const float rstd = rsqrtf(ssq[q] * (1.f / D) + EPS);
#pragma unroll
            for (int j = 0; j < 4; ++j) { const int col = (F.lane + 64 * j) * 4;
                const f32x4 sc = *(const LAS f32x4*)(tb + col), sh = *(const LAS f32x4*)(tb + 1024 + col);
                const f32x4 y = (v[q][j] * rstd) * sc + sh;
                u32x2 o; o.x = pk2(y.x, y.y); o.y = pk2(y.z, y.w);
                *(u32x2*)(H + (size_t)row * D + col) = o; } } }
    }
#undef P1_LOAD
}

struct EpiQKVFast {
    static constexpr bool PERM = true, AFTER_DRAIN = false;
    unsigned char* ws;
    __device__ __forceinline__ void operator()(const pg8::f32x4 (&acc)[2][2][4][2], const pg8::Unit& u, int wr, int wc, int fr, int fq) const {
        const bool lat = u.pm < 128;
        const int kind = u.pn >> 1;
        if (!lat && (kind == 0 || kind == 3)) return;
        const int b = lat ? (u.pm >> 4) : (u.pm - 128);
        const int tb = lat ? (u.pm & 15) * 256 : 0;
        const float* rope = (const float*)(ws + WS_ROPE);
#pragma unroll
        for (int bj = 0; bj < 2; ++bj) {
            const int cc = (u.pn & 1) * 256 + bj * 128 + wc * 32 + 8 * fq;
#pragma unroll
            for (int ai = 0; ai < 2; ++ai)
#pragma unroll
                for (int m = 0; m < 4; ++m) {
                    const int rowin = ai * 128 + wr * 64 + m * 16 + fr;
                    const int t = tb + rowin;
                    const int j = lat ? 256 + t : rowin;
                    f32x4 v0 = acc[ai][bj][m][0], v1 = acc[ai][bj][m][1];
                    bf16_t* dst;
                    if (kind == 0) { dst = (bf16_t*)(ws + WS_QA) + qa_idx(b, cc >> 6, t, cc & 63); v0 = v0 * C2; v1 = v1 * C2; }
                    else if (kind == 1) dst = (bf16_t*)(ws + WS_KA) + ka_idx(b, cc >> 6, j, cc & 63);
                    else if (kind == 2) dst = (bf16_t*)(ws + WS_VA) + va_idx(b, cc >> 6, j, cc & 63);
                    else if (kind == 5) dst = (bf16_t*)(ws + WS_VD) + vd_idx(b, cc >> 7, j, cc & 127);
                    else {
                        const int mm = cc >> 8, h = (cc >> 6) & 3, d = cc & 63;
                        if (lat) { const int i0 = d >> 1; const int pos = i0 < 16 ? (t >> 6) : (t & 63); const float* rp = rope + (pos * 16 + (i0 & 15)) * 2;
                            const f32x4 r0 = *(const f32x4*)rp, r1 = *(const f32x4*)(rp + 4);
                            f32x4 a0, a1;
                            a0.x = v0.x * r0.x - v0.y * r0.y; a0.y = v0.x * r0.y + v0.y * r0.x; a0.z = v0.z * r0.z - v0.w * r0.w; a0.w = v0.z * r0.w + v0.w * r0.z;
                            a1.x = v1.x * r1.x - v1.y * r1.y; a1.y = v1.x * r1.y + v1.y * r1.x; a1.z = v1.z * r1.z - v1.w * r1.w; a1.w = v1.z * r1.w + v1.w * r1.z;
                            v0 = a0; v1 = a1; }
                        if (kind == 3) { dst = (bf16_t*)(ws + WS_QD) + qd_idx(b, mm, h, t, d); v0 = v0 * C2; v1 = v1 * C2; }
                        else dst = (bf16_t*)(ws + WS_KD) + kd_idx(b, mm, h, j, d);
                    }
                    pg8::u32x4 w; w.x = pg8::cvt_pk_bf16(v0[0], v0[1]); w.y = pg8::cvt_pk_bf16(v0[2], v0[3]); w.z = pg8::cvt_pk_bf16(v1[0], v1[1]); w.w = pg8::cvt_pk_bf16(v1[2], v1[3]);
                    *(pg8::u32x4*)dst = w;
                }
        }
    }
};


struct EpiQ2Frag {
    static constexpr bool PERM = true, AFTER_DRAIN = false;
    bf16_t* O;
    __device__ __forceinline__ void operator()(const pg8::f32x4 (&acc)[2][2][4][2], const pg8::Unit& u, int wr, int wc, int fr, int fq) const {
        const int h = u.pn;
#pragma unroll
        for (int bj = 0; bj < 2; ++bj) {
            const int c8 = wc * 4 + fq;
#pragma unroll
            for (int ai = 0; ai < 2; ++ai)
#pragma unroll
                for (int m = 0; m < 4; ++m) {
                    const int row = u.pm * 256 + ai * 128 + wr * 64 + m * 16 + fr;
                    const size_t idx = ((((((size_t)(row >> 5) * 8 + h) * 2 + bj) * 8 + (c8 >> 1)) * 2 + (c8 & 1)) * 32 + (row & 31)) * 8;
                    const f32x4 v0 = acc[ai][bj][m][0], v1 = acc[ai][bj][m][1];
                    pg8::u32x4 w; w.x = pg8::cvt_pk_bf16(v0[0], v0[1]); w.y = pg8::cvt_pk_bf16(v0[2], v0[3]); w.z = pg8::cvt_pk_bf16(v1[0], v1[1]); w.w = pg8::cvt_pk_bf16(v1[2], v1[3]);
                    *(pg8::u32x4*)(O + idx) = w;
                }
        }
    }
};

__device__ __forceinline__ void p5_rows2(Frame& F, const Params& p) {
    unsigned char* ws = p.ws;
    const float* mod = (const float*)(ws + WS_MOD);
    const bf16_t* YO = (const bf16_t*)(ws + WS_YO);
    bf16_t* H2 = (bf16_t*)(ws + WS_H2);
    const int gw = F.bid * NWAVES + F.wave, NGW = F.G * NWAVES;
    const int rows_per = (MLAT + NGW - 1) / NGW;
    const int rend = min(MLAT, (gw + 1) * rows_per);
    f32x4 nxx[2][4]; u32x2 nxy[2][4];
#define P5_LOAD(rowa_) do { _Pragma("unroll") for (int q = 0; q < 2; ++q) { const int row = min((rowa_) + q, MLAT - 1); \
            _Pragma("unroll") for (int j = 0; j < 4; ++j) { nxx[q][j] = ((const f32x4*)(p.x + (size_t)row * D))[F.lane + 64 * j]; nxy[q][j] = ((const u32x2*)(YO + (size_t)row * D))[F.lane + 64 * j]; } } } while (0)
    P5_LOAD(gw * rows_per);
    for (int rowa = gw * rows_per; rowa < rend; rowa += 2) {
        f32x4 xv[2][4], yv[2][4]; float ssq[2];
#pragma unroll
        for (int q = 0; q < 2; ++q)
#pragma unroll
            for (int j = 0; j < 4; ++j) { xv[q][j] = nxx[q][j]; const u32x2 yw = nxy[q][j]; yv[q][j] = (f32x4){bflo(yw.x), bfhi(yw.x), bflo(yw.y), bfhi(yw.y)}; }
        if (rowa + 2 < rend) P5_LOAD(rowa + 2);
#pragma unroll
        for (int q = 0; q < 2; ++q) { float s = 0.f;
#pragma unroll
            for (int j = 0; j < 4; ++j) s += yv[q][j].x * yv[q][j].x + yv[q][j].y * yv[q][j].y + yv[q][j].z * yv[q][j].z + yv[q][j].w * yv[q][j].w;
            ssq[q] = wave_sum(s); }
#pragma unroll
        for (int q = 0; q < 2; ++q) { const int row = rowa + q; if (row < MLAT) {
            const int b = row >> 12; const float* mb = mod + b * NMOD;
            const float rstd = rsqrtf(ssq[q] * (1.f / D) + EPS);
            float s2 = 0.f;
#pragma unroll
            for (int j = 0; j < 4; ++j) { const int col = (F.lane + 64 * j) * 4;
                const f32x4 g1 = *(const f32x4*)(p.g_norm + D + col), gt1 = *(const f32x4*)(mb + 2 * D + col);
                xv[q][j] = xv[q][j] + gt1 * (yv[q][j] * rstd * g1);
                *(f32x4*)(p.out + (size_t)row * D + col) = xv[q][j];
                s2 += xv[q][j].x * xv[q][j].x + xv[q][j].y * xv[q][j].y + xv[q][j].z * xv[q][j].z + xv[q][j].w * xv[q][j].w; }
            const float rstd2 = rsqrtf(wave_sum(s2) * (1.f / D) + EPS);
#pragma unroll
            for (int j = 0; j < 4; ++j) { const int col = (F.lane + 64 * j) * 4;
                const f32x4 g2 = *(const f32x4*)(p.g_norm + 2 * D + col), sh2 = *(const f32x4*)(mb + 3 * D + col), sc2 = *(const f32x4*)(mb + 4 * D + col);
                const f32x4 y = (xv[q][j] * rstd2 * g2) * (sc2 + 1.f) + sh2;
                u32x2 o; o.x = pk2(y.x, y.y); o.y = pk2(y.z, y.w);
                *(u32x2*)(H2 + (size_t)row * D + col) = o; } } }
    }
#undef P5_LOAD
}

template <int J> __device__ __forceinline__ unsigned lane_xor(unsigned x, int lane) {
    if (J == 1) return (unsigned)__builtin_amdgcn_update_dpp(0, (int)x, 0xB1, 0xf, 0xf, false);
    if (J == 2) return (unsigned)__builtin_amdgcn_update_dpp(0, (int)x, 0x4E, 0xf, 0xf, false);
    if (J == 4) { const unsigned a = (unsigned)__builtin_amdgcn_update_dpp(0, (int)x, 0x104, 0xf, 0xf, false),
                                 b = (unsigned)__builtin_amdgcn_update_dpp(0, (int)x, 0x114, 0xf, 0xf, false);
                  return (lane & 4) ? b : a; }
    if (J == 8) return (unsigned)__builtin_amdgcn_update_dpp(0, (int)x, 0x128, 0xf, 0xf, false);
    if (J == 16) { auto r = __builtin_amdgcn_permlane16_swap(x, x, false, false); return (lane & 16) ? r[0] : r[1]; }
    auto r = __builtin_amdgcn_permlane32_swap(x, x, false, false); return (lane & 32) ? r[0] : r[1];
}
template <int K2, int J> __device__ __forceinline__ void bitonic_step128(unsigned& key0, unsigned& key1, int lane) {
    if (J == 64) { const unsigned lo = key0 < key1 ? key0 : key1, hi_ = key0 < key1 ? key1 : key0; key0 = lo; key1 = hi_; }
    else {
        const unsigned p0_ = lane_xor<J>(key0, lane), p1_ = lane_xor<J>(key1, lane);
        const bool lower = (lane & J) == 0;
        const bool asc0 = K2 == 128 ? true : ((lane & K2) == 0), asc1 = K2 == 128 ? true : (((64 + lane) & K2) == 0);
        const bool kmin0 = lower == asc0, kmin1 = lower == asc1;
        key0 = kmin0 ? (key0 < p0_ ? key0 : p0_) : (key0 < p0_ ? p0_ : key0);
        key1 = kmin1 ? (key1 < p1_ ? key1 : p1_) : (key1 < p1_ ? p1_ : key1);
    }
}
__device__ __forceinline__ void sort128_asc(unsigned& k0, unsigned& k1, int lane) {
    bitonic_step128<2, 1>(k0, k1, lane);
    bitonic_step128<4, 2>(k0, k1, lane); bitonic_step128<4, 1>(k0, k1, lane);
    bitonic_step128<8, 4>(k0, k1, lane); bitonic_step128<8, 2>(k0, k1, lane); bitonic_step128<8, 1>(k0, k1, lane);
    bitonic_step128<16, 8>(k0, k1, lane); bitonic_step128<16, 4>(k0, k1, lane); bitonic_step128<16, 2>(k0, k1, lane); bitonic_step128<16, 1>(k0, k1, lane);
    bitonic_step128<32, 16>(k0, k1, lane); bitonic_step128<32, 8>(k0, k1, lane); bitonic_step128<32, 4>(k0, k1, lane); bitonic_step128<32, 2>(k0, k1, lane); bitonic_step128<32, 1>(k0, k1, lane);
    bitonic_step128<64, 32>(k0, k1, lane); bitonic_step128<64, 16>(k0, k1, lane); bitonic_step128<64, 8>(k0, k1, lane); bitonic_step128<64, 4>(k0, k1, lane); bitonic_step128<64, 2>(k0, k1, lane); bitonic_step128<64, 1>(k0, k1, lane);
    bitonic_step128<128, 64>(k0, k1, lane); bitonic_step128<128, 32>(k0, k1, lane); bitonic_step128<128, 16>(k0, k1, lane); bitonic_step128<128, 8>(k0, k1, lane); bitonic_step128<128, 4>(k0, k1, lane); bitonic_step128<128, 2>(k0, k1, lane); bitonic_step128<128, 1>(k0, k1, lane);
}
__device__ __forceinline__ float e2m3_val(int k) { return k < 8 ? (float)k * 0.125f : ldexpf(1.f + (float)(k & 7) * 0.125f, (k >> 3) - 1); }
__device__ __forceinline__ int e2m3_idx(float x) { if (x < 1.f) return (int)(x * 8.f + 0.5f); const int e = x >= 4.f ? 2 : (x >= 2.f ? 1 : 0); return 8 * (e + 1) + (int)((x / (float)(1 << e) - 1.f) * 8.f + 0.5f); }
__device__ __forceinline__ float sum8(float v) {
    v += __uint_as_float((unsigned)__builtin_amdgcn_update_dpp(0, (int)__float_as_uint(v), 0xB1, 0xf, 0xf, false));
    v += __uint_as_float((unsigned)__builtin_amdgcn_update_dpp(0, (int)__float_as_uint(v), 0x4E, 0xf, 0xf, false));
    v += __uint_as_float((unsigned)__builtin_amdgcn_update_dpp(0, (int)__float_as_uint(v), 0x141, 0xf, 0xf, false));
    return v;
}
template <int MODE> __device__ __forceinline__ void p8_gather(Frame& F, const Params& p, const XcdBarrier& bar) {
    unsigned char* ws = p.ws;
    const bf16_t* H2 = (const bf16_t*)(ws + WS_H2); const unsigned char* U6 = ws + WS_UB; const unsigned char* V6 = ws + WS_VB;
    const int* EX = (const int*)(ws + WS_EXP); const float* GT = (const float*)(ws + WS_GATE); const float* SU = (const float*)(ws + WS_SU); const float* mod = (const float*)(ws + WS_MOD);
    const int lane = F.lane, l5 = lane & 31, b5 = (lane >> 5) & 1, b4 = (lane >> 4) & 1, b3 = (lane >> 3) & 1;
    const int ent = 2 * (2 * b4 + b3) + b5;
    LAS float* scr = (LAS float*)(F.lds + F.wave * 8192);
    int pi[32];
    { f32x16 ca, cb;
#pragma unroll
      for (int i = 0; i < 16; ++i) { ca[i] = e2m3_val(i); cb[i] = e2m3_val(16 + i); }
      const u32x6 cw = enc_fp6(ca, cb);
      const f32x32 cr = dec_fp6(cw);
#pragma unroll
      for (int j = 0; j < 32; ++j) pi[j] = __builtin_amdgcn_readfirstlane(e2m3_idx(cr[j])) & 31; }
    int sw4;
    { const unsigned cw = __builtin_amdgcn_cvt_scalef32_pk_fp4_f32(0u, 1.0f, 2.0f, 1.0f, 0); const f32x2 cr = __builtin_amdgcn_cvt_scalef32_pk_f32_fp4(cw, 1.0f, 0);
      sw4 = __builtin_amdgcn_readfirstlane(cr.x == 1.0f ? 0 : 1); }
    unsigned* ctr = (unsigned*)(ws + WS_CTL) + CW_P8CTR + (MODE != 0 ? 16 : 0);
    int cnext = 0;
    if (lane == 0) cnext = (int)__hip_atomic_fetch_add(ctr, 1u, __ATOMIC_RELAXED, __HIP_MEMORY_SCOPE_AGENT);
    cnext = __builtin_amdgcn_readfirstlane(cnext);
    for (;;) {
        const int t = cnext;
        if (t >= MLAT) break;
        if (lane == 0) cnext = (int)__hip_atomic_fetch_add(ctr, 1u, __ATOMIC_RELAXED, __HIP_MEMORY_SCOPE_AGENT);
        const size_t tb_ = (size_t)t * 128;
        unsigned key0 = ((unsigned)EX[tb_ + lane] << 7) | (unsigned)lane, key1 = ((unsigned)EX[tb_ + 64 + lane] << 7) | (unsigned)(64 + lane);
        float hvp[32]; f32x32 acc;
        { const u32x4* hp = (const u32x4*)(H2 + (size_t)t * D + l5 * 32);
#pragma unroll
          for (int j = 0; j < 4; ++j) { const u32x4 w = hp[j]; scr[(8 * j + 0) * 64 + lane] = bflo(w.x); scr[(8 * j + 1) * 64 + lane] = bfhi(w.x); scr[(8 * j + 2) * 64 + lane] = bflo(w.y); scr[(8 * j + 3) * 64 + lane] = bfhi(w.y);
              scr[(8 * j + 4) * 64 + lane] = bflo(w.z); scr[(8 * j + 5) * 64 + lane] = bfhi(w.z); scr[(8 * j + 6) * 64 + lane] = bflo(w.w); scr[(8 * j + 7) * 64 + lane] = bfhi(w.w); }
#pragma unroll
          for (int j = 0; j < 32; ++j) { hvp[j] = scr[pi[j] * 64 + lane]; acc[j] = 0.f; } }
        sort128_asc(key0, key1, lane);
        for (int bb = 0; bb < 16; ++bb) {
            const unsigned kreg = bb < 8 ? key0 : key1; const int lb = (bb & 7) * 8;
            const unsigned kmine = (unsigned)__shfl((int)kreg, lb + ent);
            const float gl = GT[tb_ + (kmine & 127u)], sl = SU[tb_ + (kmine & 127u)];
            u32x6 u6[4]; u32x4 v4[4];
#pragma unroll
            for (int pr = 0; pr < 4; ++pr) { const int eA = (int)((unsigned)__builtin_amdgcn_readlane((int)kreg, lb + 2 * pr) >> 7), eB = (int)((unsigned)__builtin_amdgcn_readlane((int)kreg, lb + 2 * pr + 1) >> 7);
                const int e = (b5 ? eB : eA) & (MODE == 1 ? 1023 : (MODE == 3 ? 7 : 0xFFFF));
                const unsigned* up = (const unsigned*)(U6 + (size_t)e * 768 + l5 * 24);
                const u32x2 a0 = *(const u32x2*)up, a1 = *(const u32x2*)(up + 2), a2 = *(const u32x2*)(up + 4); u6[pr] = (u32x6){a0.x, a0.y, a1.x, a1.y, a2.x, a2.y};
                v4[pr] = *(const u32x4*)(V6 + (size_t)e * 512 + l5 * 16); }
            float d[4];
#pragma unroll
            for (int pr = 0; pr < 4; ++pr) { const f32x32 ru = __builtin_amdgcn_cvt_scalef32_pk32_f32_fp6(u6[pr], 1.0f); float s0 = 0.f, s1 = 0.f;
#pragma unroll
                for (int c = 0; c < 32; c += 2) { s0 += hvp[c] * ru[c]; s1 += hvp[c + 1] * ru[c + 1]; }
                d[pr] = s0 + s1; asm volatile("" : "+v"(d[pr])); }
            float r2[2], r1;
#pragma unroll
            for (int i = 0; i < 2; ++i) { auto rr = __builtin_amdgcn_permlane16_swap(__float_as_uint(d[i]), __float_as_uint(d[i + 2]), false, false); r2[i] = __uint_as_float(rr[0]) + __uint_as_float(rr[1]); }
            { const float keep = b3 ? r2[1] : r2[0], send = b3 ? r2[0] : r2[1]; r1 = keep + __uint_as_float((unsigned)__builtin_amdgcn_update_dpp(0, (int)__float_as_uint(send), 0x128, 0xf, 0xf, false)); }
            r1 = sum8(r1);
            const float pre = r1 * sl;
            float act;
            { const float av = fabsf(pre), dd = av * 0.2316418882f + 1.0f; const float tt = __builtin_amdgcn_rcpf(dd);
              float q = tt * 0.5307027145f + (-0.7265760135f); q = q * tt + 0.7107068705f; q = q * tt + (-0.142248368f); q = q * tt + 0.127414796f; q = q * tt;
              const float ee = __builtin_amdgcn_exp2f((pre * pre) * (-0.72134752044f));
              const float mm = pre * (q * ee); act = pre < 0.f ? mm : pre - mm; }
            const float cfl = gl * act;
#pragma unroll
            for (int pr = 0; pr < 4; ++pr) {
                const float cfA = __uint_as_float((unsigned)__builtin_amdgcn_readlane((int)__float_as_uint(cfl), (pr >> 1) * 16 + (pr & 1) * 8));
                const float cfB = __uint_as_float((unsigned)__builtin_amdgcn_readlane((int)__float_as_uint(cfl), 32 + (pr >> 1) * 16 + (pr & 1) * 8));
                const float cf = b5 ? cfB : cfA;
#pragma unroll
                for (int j = 0; j < 4; ++j)
#pragma unroll
                    for (int bsel = 0; bsel < 4; ++bsel) { const f32x2 rv = bsel == 0 ? __builtin_amdgcn_cvt_scalef32_pk_f32_fp4(v4[pr][j], 1.0f, 0) : bsel == 1 ? __builtin_amdgcn_cvt_scalef32_pk_f32_fp4(v4[pr][j], 1.0f, 1)
                            : bsel == 2 ? __builtin_amdgcn_cvt_scalef32_pk_f32_fp4(v4[pr][j], 1.0f, 2) : __builtin_amdgcn_cvt_scalef32_pk_f32_fp4(v4[pr][j], 1.0f, 3);
                        acc[8 * j + 2 * bsel] += cf * rv.x; acc[8 * j + 2 * bsel + 1] += cf * rv.y; }
                asm volatile("" : "+v"(acc));
            }
        }
#pragma unroll
        for (int j = 0; j < 32; ++j) { auto rr = __builtin_amdgcn_permlane32_swap(__float_as_uint(acc[j]), __float_as_uint(acc[j]), false, false); scr[(j ^ sw4) * 64 + lane] = __uint_as_float(rr[0]) + __uint_as_float(rr[1]); }
        float at[16]; float s = 0.f;
#pragma unroll
        for (int k = 0; k < 16; ++k) { at[k] = scr[(16 * b5 + k) * 64 + lane]; s += at[k] * at[k]; }
        const float rstd = rsqrtf(wave_sum(s) * (1.f / D) + EPS);
        const float* mb = mod + (t >> 12) * NMOD + 5 * D; const float* g3 = p.g_norm + 3 * D;
#pragma unroll
        for (int j = 0; j < 4; ++j) { const int col = l5 * 32 + b5 * 16 + j * 4;
            float* op = p.out + (size_t)t * D + col;
            const f32x4 x0 = *(const f32x4*)op, ga = *(const f32x4*)(g3 + col), ta = *(const f32x4*)(mb + col);
            const f32x4 pa = (f32x4){at[4 * j], at[4 * j + 1], at[4 * j + 2], at[4 * j + 3]};
            if (MODE == 0 || rstd == 123456.f) *(f32x4*)op = x0 + ta * (pa * rstd * ga); }
        cnext = __builtin_amdgcn_readfirstlane(cnext);
    }
}

namespace att {
typedef short bf16x8 __attribute__((ext_vector_type(8)));
typedef short s16x4 __attribute__((ext_vector_type(4)));
typedef float f32x16 __attribute__((ext_vector_type(16)));
typedef __attribute__((address_space(3))) const unsigned char* lcp;
typedef __attribute__((address_space(3))) unsigned char* lp;
constexpr int NA_SLOT = 16384, NA_BIAS_OFF = 32768, WSF_OFF = 155648;
constexpr int DF_SLOT = 32768;
constexpr float THRL = 8.f;

__device__ __forceinline__ int crow(int r, int hi) { return (r & 3) + 8 * (r >> 2) + 4 * hi; }
__device__ __forceinline__ s16x4 vtr(lcp p) { return __builtin_bit_cast(s16x4, __builtin_amdgcn_ds_read_tr16_b64_v4i16((__attribute__((address_space(3))) s16x4*)p)); }
typedef float f32x2_t __attribute__((ext_vector_type(2))); typedef __bf16 bf16x2v_t __attribute__((ext_vector_type(2)));
__device__ __forceinline__ unsigned cvtpk(float lo, float hi) { f32x2_t v = {lo, hi}; bf16x2v_t b = __builtin_convertvector(v, bf16x2v_t); return __builtin_bit_cast(unsigned, b); }
__device__ __forceinline__ float swap_half(float v) { auto rr = __builtin_amdgcn_permlane32_swap(__float_as_uint(v), __float_as_uint(v), false, false); return __uint_as_float(rr[0]) == v ? __uint_as_float(rr[1]) : __uint_as_float(rr[0]); }
__device__ __forceinline__ void dma16(const void* gsrc, lp lds_dst) {
    unsigned keep; const unsigned dst = (unsigned)__builtin_amdgcn_readfirstlane((int)(unsigned)(size_t)lds_dst);
    asm volatile("s_mov_b32 %0, m0\n\ts_mov_b32 m0, %2\n\ts_nop 0\n\tglobal_load_lds_dwordx4 %1, off\n\ts_mov_b32 m0, %0" : "=&s"(keep) : "v"(gsrc), "s"(dst) : "memory");
}
__device__ __forceinline__ float max3f(float a, float b, float c) { float r; asm("v_max3_f32 %0, %1, %2, %3" : "=v"(r) : "v"(a), "v"(b), "v"(c)); return r; }
__device__ __forceinline__ float rowmax32(const f32x16& p0, const f32x16& p1) {
    float a = max3f(p0[0], p0[1], p1[0]), b = max3f(p0[2], p0[3], p1[1]); a = max3f(a, p1[2], p1[3]);
#pragma unroll
    for (int r = 4; r < 16; r += 4) { a = max3f(a, p0[r], p0[r + 1]); b = max3f(b, p0[r + 2], p0[r + 3]); a = max3f(a, p1[r], p1[r + 1]); b = max3f(b, p1[r + 2], p1[r + 3]); }
    float m = max3f(a, b, b);
    auto rr = __builtin_amdgcn_permlane32_swap(__float_as_uint(m), __float_as_uint(m), false, false);
    return max3f(__uint_as_float(rr[0]), __uint_as_float(rr[1]), __uint_as_float(rr[1]));
}

typedef __bf16 bf16x2_t __attribute__((ext_vector_type(2)));
__device__ __forceinline__ float psum_bf16(const u32x4 (&pw)[4], float acc) {
    const bf16x2_t ones = __builtin_bit_cast(bf16x2_t, 0x3F803F80u); float a0 = acc, a1 = 0.f;
#pragma unroll
    for (int k = 0; k < 4; ++k) { a0 = __builtin_amdgcn_fdot2_f32_bf16(__builtin_bit_cast(bf16x2_t, pw[k][0]), ones, a0, false); a1 = __builtin_amdgcn_fdot2_f32_bf16(__builtin_bit_cast(bf16x2_t, pw[k][1]), ones, a1, false);
        a0 = __builtin_amdgcn_fdot2_f32_bf16(__builtin_bit_cast(bf16x2_t, pw[k][2]), ones, a0, false); a1 = __builtin_amdgcn_fdot2_f32_bf16(__builtin_bit_cast(bf16x2_t, pw[k][3]), ones, a1, false); }
    return a0 + a1;
}
template <int NDV> struct FlashState { float mhat, l; f32x16 negm; f32x16 o[NDV]; };

template <int NDV, bool BIAS>
__device__ __forceinline__ void flash_tile(FlashState<NDV>& st, const bf16x8 (&qr)[4], lcp Kslot, lcp Vslot, lcp Bslot, const bf16x8 (&qoh)[2],
                                           __attribute__((address_space(3))) float* wsf, int r32, int hi, int lane, bool first) {
    f32x16 p0 = st.negm, p1 = st.negm;
    lcp kb = Kslot + hi * 1024 + r32 * 16;
    bf16x8 kf[8], bf_[4];
#pragma unroll
    for (int d0 = 0; d0 < 4; ++d0) { kf[2 * d0] = *(const __attribute__((address_space(3))) bf16x8*)(kb + d0 * 2048); kf[2 * d0 + 1] = *(const __attribute__((address_space(3))) bf16x8*)(kb + d0 * 2048 + 512); }
    if (BIAS) { lcp bb = Bslot + hi * 1024 + r32 * 16;
#pragma unroll
        for (int e = 0; e < 2; ++e) { bf_[2 * e] = *(const __attribute__((address_space(3))) bf16x8*)(bb + e * 2048); bf_[2 * e + 1] = *(const __attribute__((address_space(3))) bf16x8*)(bb + e * 2048 + 512); } }
    lcp vb = Vslot + ((lane >> 4) & 1) * 32 + (lane & 3) * 8 + (4 * hi + ((lane & 15) >> 2)) * 64;
    s16x4 va[8], vn[8];
#pragma unroll
    for (int ks = 0; ks < 4; ++ks) { va[2 * ks] = vtr(vb + ks * 1024); va[2 * ks + 1] = vtr(vb + ks * 1024 + 512); }
#pragma unroll
    for (int d0 = 0; d0 < 4; ++d0) { p0 = __builtin_amdgcn_mfma_f32_32x32x16_bf16(kf[2 * d0], qr[d0], p0, 0, 0, 0); p1 = __builtin_amdgcn_mfma_f32_32x32x16_bf16(kf[2 * d0 + 1], qr[d0], p1, 0, 0, 0); }
    if (BIAS) {
#pragma unroll
        for (int e = 0; e < 2; ++e) { p0 = __builtin_amdgcn_mfma_f32_32x32x16_bf16(bf_[2 * e], qoh[e], p0, 0, 0, 0); p1 = __builtin_amdgcn_mfma_f32_32x32x16_bf16(bf_[2 * e + 1], qoh[e], p1, 0, 0, 0); }
    }
    asm volatile("s_nop 15\n\ts_nop 7" : "+v"(p0), "+v"(p1));
    const float rm = rowmax32(p0, p1);
    if (first) {
        st.mhat += rm;
#pragma unroll
        for (int r = 0; r < 16; ++r) { p0[r] -= rm; p1[r] -= rm; st.negm[r] = -st.mhat; }
    } else if (__any(rm > THRL)) {
        const float dl = fmaxf(rm, 0.f); const float alpha = __builtin_amdgcn_exp2f(-dl); st.mhat += dl; st.l *= alpha;
        if (hi == 0) wsf[r32] = alpha;
        asm volatile("s_waitcnt lgkmcnt(0)" ::: "memory");
        float al[16];
#pragma unroll
        for (int r = 0; r < 16; ++r) al[r] = wsf[crow(r, hi)];
#pragma unroll
        for (int d = 0; d < NDV; ++d)
#pragma unroll
            for (int r = 0; r < 16; ++r) st.o[d][r] *= al[r];
#pragma unroll
        for (int r = 0; r < 16; ++r) { p0[r] -= dl; p1[r] -= dl; st.negm[r] = -st.mhat; }
    }
    float sacc = 0.f;
#pragma unroll
    for (int r = 0; r < 16; ++r) { p0[r] = __builtin_amdgcn_exp2f(p0[r]); p1[r] = __builtin_amdgcn_exp2f(p1[r]); sacc += p0[r] + p1[r]; }
    st.l += sacc;
    u32x4 pw[4];
#pragma unroll
    for (int i = 0; i < 4; ++i) { pw[0][i] = cvtpk(p0[2 * i], p0[2 * i + 1]); pw[1][i] = cvtpk(p0[8 + 2 * i], p0[8 + 2 * i + 1]); pw[2][i] = cvtpk(p1[2 * i], p1[2 * i + 1]); pw[3][i] = cvtpk(p1[8 + 2 * i], p1[8 + 2 * i + 1]); }
    __builtin_amdgcn_sched_barrier(0);
#pragma unroll
    for (int d0 = 0; d0 < NDV; ++d0) {
#pragma unroll
        for (int ks = 0; ks < 4; ++ks) {
            if (d0 < NDV - 1) { vn[2 * ks] = vtr(vb + (d0 + 1) * 4096 + ks * 1024); vn[2 * ks + 1] = vtr(vb + (d0 + 1) * 4096 + ks * 1024 + 512); }
            const bf16x8 vf = (bf16x8){va[2 * ks][0], va[2 * ks][1], va[2 * ks][2], va[2 * ks][3], va[2 * ks + 1][0], va[2 * ks + 1][1], va[2 * ks + 1][2], va[2 * ks + 1][3]};
            st.o[d0] = __builtin_amdgcn_mfma_f32_32x32x16_bf16(__builtin_bit_cast(bf16x8, pw[ks]), vf, st.o[d0], 0, 0, 0);
            __builtin_amdgcn_sched_barrier(0);
        }
#pragma unroll
        for (int i = 0; i < 8; ++i) va[i] = vn[i];
    }
}

constexpr int NA2_SLOT = 16384, NA2_BIAS_OFF = 65536;
__device__ __forceinline__ void na_units(Frame& F, const Params& p) {
    unsigned char* ws = p.ws;
    const bf16_t* QA = (const bf16_t*)(ws + WS_QA); const bf16_t* KA = (const bf16_t*)(ws + WS_KA); const bf16_t* VA = (const bf16_t*)(ws + WS_VA);
    const bf16_t* BT = (const bf16_t*)(ws + WS_BIAST); bf16_t* Y = (bf16_t*)(ws + WS_Y);
    const int lane = F.lane, r32 = lane & 31, hi = lane >> 5, wave = F.wave;
    lp lds = (lp)F.lds;
    __attribute__((address_space(3))) float* wsf = (__attribute__((address_space(3))) float*)(lds + WSF_OFF) + wave * 64;
    const int upw = 1024 / F.G;
    int cur_h = -1, cur_lo = -1, cur_hi = -1;
    bf16x8 qoh[2];
#pragma unroll
    for (int e = 0; e < 2; ++e)
#pragma unroll
        for (int j = 0; j < 8; ++j) qoh[e][j] = (16 * e + 8 * hi + j == r32) ? (short)0x3F80 : (short)0;
    for (int ui = 0; ui < upw; ++ui) {
        const int u = F.bid * upw + ui, bh = u >> 4, rg = u & 15, b = bh >> 3, h = bh & 7;
        const int r0 = rg * 4, r = r0 + (wave >> 1), ch = wave & 1;
        int rs = r - 4; rs = rs < 0 ? 0 : (rs > 56 ? 56 : rs);
        int kr_lo = r0 - 4; kr_lo = kr_lo < 0 ? 0 : (kr_lo > 56 ? 56 : kr_lo);
        int kr_hi = r0 + 3 - 4; kr_hi = kr_hi < 0 ? 0 : (kr_hi > 56 ? 56 : kr_hi); kr_hi += 7;
        const int T = 4 + (kr_hi - kr_lo + 1);
        int dr_lo = 99, dr_hi = -1;
#pragma unroll
        for (int q = 0; q < 4; ++q) { int s_ = r0 + q - 4; s_ = s_ < 0 ? 0 : (s_ > 56 ? 56 : s_); const int a = s_ - (r0 + q) + 7; dr_lo = a < dr_lo ? a : dr_lo; dr_hi = a + 7 > dr_hi ? a + 7 : dr_hi; }
        const bf16_t* Kb = KA + (size_t)bh * NKT * 4096; const bf16_t* Vb = VA + (size_t)bh * NKT * 4096;
        if (h != cur_h || dr_lo != cur_lo || dr_hi != cur_hi) {
            cur_h = h; cur_lo = dr_lo; cur_hi = dr_hi;
            const unsigned char* src = (const unsigned char*)(BT + ((size_t)h * 15 + dr_lo) * 4096);
            const int npc = (dr_hi - dr_lo + 1) * 8;
            for (int pi = wave; pi < npc; pi += 8) dma16(src + pi * 1024 + lane * 16, lds + NA2_BIAS_OFF + pi * 1024);
        }
        bf16x8 qr[4];
        { const bf16_t* qp = QA + ((size_t)bh * SEQ + r * 64 + ch * 32 + r32) * 64 + hi * 8;
#pragma unroll
          for (int d0 = 0; d0 < 4; ++d0) qr[d0] = *(const bf16x8*)(qp + d0 * 16); }
#define NA_DMA(i_) do { const int tg_ = (i_) < 4 ? (i_) : (4 + kr_lo + (i_) - 4); lp sl_ = lds + ((i_) & 3) * NA2_SLOT; \
            dma16((const unsigned char*)(Kb + (size_t)tg_ * 4096) + wave * 1024 + lane * 16, sl_ + wave * 1024); \
            dma16((const unsigned char*)(Vb + (size_t)tg_ * 4096) + wave * 1024 + lane * 16, sl_ + 8192 + wave * 1024); } while (0)
        NA_DMA(0); NA_DMA(1);
        FlashState<2> st; st.mhat = 0.f; st.l = 0.f;
#pragma unroll
        for (int rr = 0; rr < 16; ++rr) st.negm[rr] = 0.f;
#pragma unroll
        for (int d = 0; d < 2; ++d)
#pragma unroll
            for (int rr = 0; rr < 16; ++rr) st.o[d][rr] = 0.f;
        for (int i = 0; i < T; ++i) {
            if (i + 1 < T) asm volatile("s_waitcnt vmcnt(2)" ::: "memory"); else asm volatile("s_waitcnt vmcnt(0)" ::: "memory");
            __syncthreads();
            if (i + 2 < T) NA_DMA(i + 2);
            lcp sl = (lcp)(lds + (i & 3) * NA2_SLOT);
            if (i < 4) flash_tile<2, false>(st, qr, sl, sl + 8192, sl, qoh, wsf, r32, hi, lane, i == 0);
            else { const int kr = kr_lo + (i - 4);
                if (kr >= rs && kr < rs + 8) { const int dr = kr - r + 7;
                    flash_tile<2, true>(st, qr, sl, sl + 8192, (lcp)(lds + NA2_BIAS_OFF + (dr - dr_lo) * 8192 + ch * 4096), qoh, wsf, r32, hi, lane, false); } }
        }
#undef NA_DMA
        float lt = st.l; { auto rr = __builtin_amdgcn_permlane32_swap(__float_as_uint(lt), __float_as_uint(lt), false, false); lt = __uint_as_float(rr[0]) + __uint_as_float(rr[1]); }
        if (hi == 0) wsf[32 + r32] = lt;
        asm volatile("s_waitcnt lgkmcnt(0)" ::: "memory");
        bf16_t* yb = Y + ((size_t)b * SEQ + r * 64 + ch * 32) * D + h * 64 + r32;
#pragma unroll
        for (int rr = 0; rr < 16; ++rr) { const float rl = __builtin_amdgcn_rcpf(wsf[32 + crow(rr, hi)]);
#pragma unroll
            for (int d0 = 0; d0 < 2; ++d0) yb[(size_t)crow(rr, hi) * D + d0 * 32] = (bf16_t)f2bf(st.o[d0][rr] * rl); }
        __syncthreads();
    }
}

template <int MODE> __device__ __forceinline__ void diff_units_v2(Frame& F, const Params& p) {
    unsigned char* ws = p.ws;
    const bf16_t* QD = (const bf16_t*)(ws + WS_QD); const bf16_t* KD = (const bf16_t*)(ws + WS_KD); const bf16_t* VD = (const bf16_t*)(ws + WS_VD);
    bf16_t* Y = (bf16_t*)(ws + WS_Y);
    const float lam = *(const float*)(ws + WS_LAM);
    const int lane = F.lane, r32 = lane & 31, hi = lane >> 5, wave = F.wave, map = wave >> 2, qg = wave & 3;
    lp lds = (lp)F.lds;
    __attribute__((address_space(3))) float* wsf = (__attribute__((address_space(3))) float*)(lds + WSF_OFF) + wave * 64;
    __attribute__((address_space(3))) float* X = (__attribute__((address_space(3))) float*)lds;
    const int upw = 1024 / F.G;
    const int koff = map * 8192 + hi * 1024 + r32 * 16;
    const int voff = 16384 + ((lane >> 4) & 1) * 32 + (lane & 3) * 8 + (4 * hi + ((lane & 15) >> 2)) * 64;
    for (int ui = 0; ui < upw; ++ui) {
        int bh, qb;
        if (F.G == 256) { bh = (F.bid & 7) * 4 + ui; qb = F.bid >> 3; } else { const int u = F.bid * upw + ui; bh = u >> 5; qb = u & 31; }
        const int b = bh >> 2, h = bh & 3;
        const unsigned char* K1 = (const unsigned char*)(KD + (size_t)((b * 2 + 0) * 4 + h) * NKT * 4096);
        const unsigned char* K2 = (const unsigned char*)(KD + (size_t)((b * 2 + 1) * 4 + h) * NKT * 4096);
        const unsigned char* Vg = (const unsigned char*)(VD + (size_t)bh * NKT * 8192);
#define DF_DMA(t, slot) do { if (MODE != 1 && MODE != 3) { lp sl_ = lds + (slot) * DF_SLOT; \
            dma16(K1 + (size_t)(t) * 8192 + wave * 1024 + lane * 16, sl_ + wave * 1024); \
            dma16(K2 + (size_t)(t) * 8192 + wave * 1024 + lane * 16, sl_ + 8192 + wave * 1024); \
            dma16(Vg + (size_t)(t) * 16384 + wave * 1024 + lane * 16, sl_ + 16384 + wave * 1024); \
            dma16(Vg + (size_t)(t) * 16384 + 8192 + wave * 1024 + lane * 16, sl_ + 24576 + wave * 1024); } } while (0)
        DF_DMA(0, 0); DF_DMA(1, 1);
        const int q0 = qb * 128 + qg * 32;
        bf16x8 qr[4];
        { const bf16_t* qp = QD + ((size_t)((b * 2 + map) * 4 + h) * SEQ + q0 + r32) * 64 + hi * 8;
#pragma unroll
          for (int d0 = 0; d0 < 4; ++d0) qr[d0] = *(const bf16x8*)(qp + d0 * 16); }
        float mhat = 0.f, lsum = 0.f; f32x16 o[4], negm;
#pragma unroll
        for (int d = 0; d < 4; ++d)
#pragma unroll
            for (int rr = 0; rr < 16; ++rr) o[d][rr] = 0.f;
        asm volatile("s_waitcnt vmcnt(0)" ::: "memory");
        __syncthreads();
        f32x16 s0, s1;
#pragma unroll
        for (int rr = 0; rr < 16; ++rr) { s0[rr] = 0.f; s1[rr] = 0.f; }
        { lcp kb = (lcp)(lds + koff);
#pragma unroll
          for (int d0 = 0; d0 < 4; ++d0) {
              const bf16x8 b0 = *(const __attribute__((address_space(3))) bf16x8*)(kb + d0 * 2048), b1 = *(const __attribute__((address_space(3))) bf16x8*)(kb + d0 * 2048 + 512);
              s0 = __builtin_amdgcn_mfma_f32_32x32x16_bf16(b0, qr[d0], s0, 0, 0, 0); s1 = __builtin_amdgcn_mfma_f32_32x32x16_bf16(b1, qr[d0], s1, 0, 0, 0); } }
        { asm volatile("s_nop 15\n\ts_nop 7" : "+v"(s0), "+v"(s1)); const float rm0 = rowmax32(s0, s1); mhat = rm0;
#pragma unroll
          for (int rr = 0; rr < 16; ++rr) { s0[rr] -= rm0; s1[rr] -= rm0; negm[rr] = -rm0; } }
        u32x4 pw[4];
#define EXP4(X, B) do { X[B] = __builtin_amdgcn_exp2f(X[B]); X[B + 1] = __builtin_amdgcn_exp2f(X[B + 1]); X[B + 2] = __builtin_amdgcn_exp2f(X[B + 2]); X[B + 3] = __builtin_amdgcn_exp2f(X[B + 3]); sacc += X[B]; asm("" : "+v"(sacc)); sacc += X[B + 1]; asm("" : "+v"(sacc)); sacc += X[B + 2]; asm("" : "+v"(sacc)); sacc += X[B + 3]; asm("" : "+v"(sacc)); } while (0)
#define STAGE_A(t_) do { \
            lcp nxt = (lcp)(lds + (((t_) + 1) & 3) * DF_SLOT); \
            bf16x8 kf[8]; \
            _Pragma("unroll") for (int d0 = 0; d0 < 4; ++d0) { kf[2 * d0] = *(const __attribute__((address_space(3))) bf16x8*)(nxt + koff + d0 * 2048); kf[2 * d0 + 1] = *(const __attribute__((address_space(3))) bf16x8*)(nxt + koff + d0 * 2048 + 512); } \
            asm volatile("s_nop 15\n\ts_nop 7" : "+v"(s0), "+v"(s1)); \
            const float rm = rowmax32(s0, s1); \
            if (__any(rm > THRL)) { \
                const float dl = fmaxf(rm, 0.f); const float alpha = __builtin_amdgcn_exp2f(-dl); mhat += dl; lsum *= alpha; \
                if (hi == 0) wsf[r32] = alpha; \
                asm volatile("s_waitcnt lgkmcnt(0)" ::: "memory"); \
                float al[16]; \
                _Pragma("unroll") for (int r = 0; r < 16; ++r) al[r] = wsf[crow(r, hi)]; \
                _Pragma("unroll") for (int d = 0; d < 4; ++d) _Pragma("unroll") for (int r = 0; r < 16; ++r) o[d][r] *= al[r]; \
                _Pragma("unroll") for (int r = 0; r < 16; ++r) { s0[r] -= dl; s1[r] -= dl; negm[r] = -mhat; } \
            } \
            f32x16 n0, n1; float sacc = 0.f; \
            __builtin_amdgcn_sched_barrier(0); \
            n0 = __builtin_amdgcn_mfma_f32_32x32x16_bf16(kf[0], qr[0], negm, 0, 0, 0); EXP4(s0, 0);  __builtin_amdgcn_sched_barrier(0); \
            n1 = __builtin_amdgcn_mfma_f32_32x32x16_bf16(kf[1], qr[0], negm, 0, 0, 0); EXP4(s0, 4);  __builtin_amdgcn_sched_barrier(0); \
            n0 = __builtin_amdgcn_mfma_f32_32x32x16_bf16(kf[2], qr[1], n0, 0, 0, 0); EXP4(s0, 8);  __builtin_amdgcn_sched_barrier(0); \
            n1 = __builtin_amdgcn_mfma_f32_32x32x16_bf16(kf[3], qr[1], n1, 0, 0, 0); EXP4(s0, 12); __builtin_amdgcn_sched_barrier(0); \
            n0 = __builtin_amdgcn_mfma_f32_32x32x16_bf16(kf[4], qr[2], n0, 0, 0, 0); EXP4(s1, 0);  __builtin_amdgcn_sched_barrier(0); \
            n1 = __builtin_amdgcn_mfma_f32_32x32x16_bf16(kf[5], qr[2], n1, 0, 0, 0); EXP4(s1, 4);  __builtin_amdgcn_sched_barrier(0); \
            n0 = __builtin_amdgcn_mfma_f32_32x32x16_bf16(kf[6], qr[3], n0, 0, 0, 0); EXP4(s1, 8);  __builtin_amdgcn_sched_barrier(0); \
            n1 = __builtin_amdgcn_mfma_f32_32x32x16_bf16(kf[7], qr[3], n1, 0, 0, 0); EXP4(s1, 12); __builtin_amdgcn_sched_barrier(0); \
            _Pragma("unroll") for (int i = 0; i < 4; ++i) { pw[0][i] = cvtpk(s0[2 * i], s0[2 * i + 1]); pw[1][i] = cvtpk(s0[8 + 2 * i], s0[8 + 2 * i + 1]); pw[2][i] = cvtpk(s1[2 * i], s1[2 * i + 1]); pw[3][i] = cvtpk(s1[8 + 2 * i], s1[8 + 2 * i + 1]); } \
            lsum += sacc; \
            s0 = n0; s1 = n1; \
        } while (0)
#define STAGE_B(tl_) do { \
            lcp vb = (lcp)(lds + ((tl_) & 3) * DF_SLOT) + voff; \
            s16x4 va[8], vn[8]; \
            _Pragma("unroll") for (int ks = 0; ks < 4; ++ks) { va[2 * ks] = vtr(vb + ks * 1024); va[2 * ks + 1] = vtr(vb + ks * 1024 + 512); } \
            __builtin_amdgcn_sched_barrier(0); \
            _Pragma("unroll") for (int d0 = 0; d0 < 4; ++d0) { \
                _Pragma("unroll") for (int ks = 0; ks < 4; ++ks) { \
                    if (d0 < 3) { vn[2 * ks] = vtr(vb + (d0 + 1) * 4096 + ks * 1024); vn[2 * ks + 1] = vtr(vb + (d0 + 1) * 4096 + ks * 1024 + 512); } \
                    const bf16x8 vf = (bf16x8){va[2 * ks][0], va[2 * ks][1], va[2 * ks][2], va[2 * ks][3], va[2 * ks + 1][0], va[2 * ks + 1][1], va[2 * ks + 1][2], va[2 * ks + 1][3]}; \
                    o[d0] = __builtin_amdgcn_mfma_f32_32x32x16_bf16(__builtin_bit_cast(bf16x8, pw[ks]), vf, o[d0], 0, 0, 0); \
                    __builtin_amdgcn_sched_barrier(0); \
                } \
                _Pragma("unroll") for (int i = 0; i < 8; ++i) va[i] = vn[i]; \
            } \
        } while (0)
        for (int t = 0; t < NKT; ++t) {
            if (t > 0) { asm volatile("s_waitcnt vmcnt(0)" ::: "memory"); if (MODE != 3) __syncthreads(); }
            if (t + 2 < NKT) DF_DMA(t + 2, (t + 2) & 3);
            if (MODE != 2) {
                if (map == 1 && t > 0) STAGE_B(t - 1);
                STAGE_A(t);
                if (map == 0) STAGE_B(t);
            }
        }
        if (MODE != 2 && map == 1) STAGE_B(NKT - 1);
#undef STAGE_A
#undef STAGE_B
#undef EXP4
#undef DF_DMA
        float lt = lsum; { auto rr = __builtin_amdgcn_permlane32_swap(__float_as_uint(lt), __float_as_uint(lt), false, false); lt = __uint_as_float(rr[0]) + __uint_as_float(rr[1]); }
        if (hi == 0) wsf[32 + r32] = lt;
        asm volatile("s_waitcnt lgkmcnt(0)" ::: "memory");
#pragma unroll
        for (int rr = 0; rr < 16; ++rr) { const float rl = __builtin_amdgcn_rcpf(wsf[32 + crow(rr, hi)]);
#pragma unroll
            for (int d = 0; d < 4; ++d) o[d][rr] *= rl; }
        __syncthreads();
        if (map == 1) {
#pragma unroll
            for (int d = 0; d < 4; ++d)
#pragma unroll
                for (int rr = 0; rr < 16; ++rr) X[((qg * 4 + d) * 16 + rr) * 64 + lane] = o[d][rr];
        }
        __syncthreads();
        if (map == 0 && (MODE == 0 || lam == 123456.f)) {
            float ss[16];
#pragma unroll
            for (int rr = 0; rr < 16; ++rr) { float s = 0.f;
#pragma unroll
                for (int d = 0; d < 4; ++d) { const float v = o[d][rr] - lam * X[((qg * 4 + d) * 16 + rr) * 64 + lane]; o[d][rr] = v; s += v * v; }
                ss[rr] = s; }
#pragma unroll
            for (int oo = 1; oo < 32; oo <<= 1)
#pragma unroll
                for (int rr = 0; rr < 16; ++rr) ss[rr] += __shfl_xor(ss[rr], oo);
            float g[4];
#pragma unroll
            for (int d = 0; d < 4; ++d) g[d] = p.diff_subln[d * 32 + r32] * (1.f - LAMBDA_INIT);
            bf16_t* yb = Y + ((size_t)b * SEQ + q0) * D + 512 + h * 128 + r32;
#pragma unroll
            for (int rr = 0; rr < 16; ++rr) { const float rn = rsqrtf(ss[rr] * (1.f / 128.f) + EPS);
#pragma unroll
                for (int d = 0; d < 4; ++d) yb[(size_t)crow(rr, hi) * D + d * 32] = (bf16_t)f2bf(o[d][rr] * rn * g[d]); }
        }
        __syncthreads();
    }
}
}

__device__ __forceinline__ void p3_attention(Frame& F, const Params& p) {
    att::na_units(F, p);
    att::diff_units_v2<0>(F, p);
}

namespace tk {
typedef short bf16x8 __attribute__((ext_vector_type(8)));
typedef float f32x16 __attribute__((ext_vector_type(16)));
constexpr int WLK_OFF = 65536;
__device__ __forceinline__ unsigned ord(float f) { const unsigned u = __float_as_uint(f); return u ^ ((unsigned)((int)u >> 31) | 0x80000000u); }
__device__ __forceinline__ float unord(unsigned o) { return __uint_as_float(o ^ ((o & 0x80000000u) ? 0x80000000u : 0xFFFFFFFFu)); }
__device__ __forceinline__ void cs_desc(unsigned& a, unsigned& b) { const unsigned mx = a > b ? a : b, mn = a > b ? b : a; a = mx; b = mn; }
__device__ __forceinline__ void sort16_desc(unsigned (&v)[16]) {
#pragma unroll
    for (int k = 2; k <= 16; k <<= 1)
#pragma unroll
        for (int j = k >> 1; j > 0; j >>= 1)
#pragma unroll
            for (int i = 0; i < 16; ++i) { const int l = i ^ j; if (l > i) { if ((i & k) == 0 || k == 16) cs_desc(v[i], v[l]); else cs_desc(v[l], v[i]); } }
}
__device__ __forceinline__ void bmerge16_desc(unsigned (&v)[16]) {
#pragma unroll
    for (int j = 8; j > 0; j >>= 1)
#pragma unroll
        for (int i = 0; i < 16; ++i) { const int l = i ^ j; if (l > i) cs_desc(v[i], v[l]); }
}
__device__ __forceinline__ void merge_top16(unsigned (&a)[16], const unsigned (&b)[16]) {
#pragma unroll
    for (int i = 0; i < 16; ++i) a[i] = a[i] > b[15 - i] ? a[i] : b[15 - i];
    bmerge16_desc(a);
}
__device__ __forceinline__ void top16_of_64x2(unsigned (&v0)[16], unsigned (&v1)[16], unsigned (&v2)[16], unsigned (&v3)[16]) {
    sort16_desc(v0); sort16_desc(v1); sort16_desc(v2); sort16_desc(v3);
    merge_top16(v0, v1); merge_top16(v2, v3); merge_top16(v0, v2);
    unsigned pb[16];
#pragma unroll
    for (int i = 0; i < 16; ++i) pb[i] = (unsigned)__shfl_xor((int)v0[i], 32);
    merge_top16(v0, pb);
}
}

__device__ __forceinline__ void p7_topk(Frame& F, const Params& p) {
    using namespace tk;
    unsigned char* ws = p.ws;
    const bf16_t* Q2 = (const bf16_t*)(ws + WS_Q2); const unsigned char* KI = (const unsigned char*)(ws + WS_KEYSI);
    int* EX = (int*)(ws + WS_EXP); float* GT = (float*)(ws + WS_GATE); float* SUo = (float*)(ws + WS_SU);
    const float* USC = (const float*)(ws + WS_USC); const float* VSC = (const float*)(ws + WS_VSC);
    const int lane = F.lane, r32 = lane & 31, hi = lane >> 5, wave = F.wave;
    att::lp lds = (att::lp)F.lds;
    LAS int* W = (LAS int*)(F.lds + WLK_OFF + wave * 8192);
    const int ntask = 1024 / F.G;
    const int h = F.bid & 7;
    { const unsigned char* src = KI + (size_t)h * 65536;
      for (int k = 0; k < 8; ++k) { const int pi = wave + 8 * k; att::dma16(src + pi * 1024 + lane * 16, lds + pi * 1024); } }
    asm volatile("s_waitcnt vmcnt(0)" ::: "memory");
    __syncthreads();
    bf16x8 qf[8], qn[8];
    { const int tb32 = ((F.bid >> 3) * ntask) * 8 + wave;
      const bf16_t* qp = Q2 + ((((size_t)tb32 * 8 + h) * 2 + 0) * 8 * 2 + hi) * 256 + r32 * 8;
#pragma unroll
      for (int s = 0; s < 8; ++s) qn[s] = *(const bf16x8*)(qp + s * 512); }
    for (int ti = 0; ti < ntask; ++ti) {
        const int tb = (F.bid >> 3) * ntask + ti;
        const int t = tb * 256 + wave * 32 + r32;
        unsigned A[16], B[16];
#pragma unroll
        for (int pp = 0; pp < 2; ++pp) {
#pragma unroll
            for (int s = 0; s < 8; ++s) qf[s] = qn[s];
            { const int nti = pp == 0 ? ti : ti + 1, npp = pp ^ 1;
              if (nti < ntask) { const int tb32 = ((F.bid >> 3) * ntask + nti) * 8 + wave;
                  const bf16_t* qp = Q2 + ((((size_t)tb32 * 8 + h) * 2 + npp) * 8 * 2 + hi) * 256 + r32 * 8;
#pragma unroll
                  for (int s = 0; s < 8; ++s) qn[s] = *(const bf16x8*)(qp + s * 512); } }
            f32x16 acc[4];
#pragma unroll
            for (int kb = 0; kb < 4; ++kb)
#pragma unroll
                for (int r = 0; r < 16; ++r) acc[kb][r] = 0.f;
            att::lcp ab = (att::lcp)(lds + pp * 32768 + hi * 2048 + r32 * 16);
#pragma unroll
            for (int s = 0; s < 8; ++s)
#pragma unroll
                for (int kb = 0; kb < 4; ++kb) {
                    const bf16x8 a = *(const __attribute__((address_space(3))) bf16x8*)(ab + s * 4096 + kb * 512);
                    acc[kb] = __builtin_amdgcn_mfma_f32_32x32x16_bf16(a, qf[s], acc[kb], 0, 0, 0);
                }
            unsigned v0[16], v1[16], v2[16], v3[16];
#pragma unroll
            for (int r = 0; r < 16; ++r) {
                const int c = 127 - ((r & 3) + 8 * (r >> 2));
                v0[r] = (ord(acc[0][r]) & 0xFFFFFF80u) | (unsigned)(c - 0 - 4 * hi);
                v1[r] = (ord(acc[1][r]) & 0xFFFFFF80u) | (unsigned)(c - 32 - 4 * hi);
                v2[r] = (ord(acc[2][r]) & 0xFFFFFF80u) | (unsigned)(c - 64 - 4 * hi);
                v3[r] = (ord(acc[3][r]) & 0xFFFFFF80u) | (unsigned)(c - 96 - 4 * hi);
            }
            top16_of_64x2(v0, v1, v2, v3);
            if (pp == 0) {
#pragma unroll
                for (int i = 0; i < 16; ++i) A[i] = v0[i];
            } else {
#pragma unroll
                for (int i = 0; i < 16; ++i) B[i] = v0[i];
            }
        }
        float fa[16], fb[16];
#pragma unroll
        for (int i = 0; i < 16; ++i) { fa[i] = unord(A[i] & 0xFFFFFF80u); fb[i] = unord(B[i] & 0xFFFFFF80u);
            W[i * 64 + lane] = 127 - (int)(A[i] & 127u); W[(16 + i) * 64 + lane] = 127 - (int)(B[i] & 127u); }
        unsigned c0[16], c1[16], c2[16], c3[16];
#pragma unroll
        for (int j = 0; j < 16; ++j) c0[j] = (ord(fa[0] + fb[j]) & 0xFFFFFF00u) | (unsigned)(255 - j);
        {
            int n = 0;
#pragma unroll
            for (int i = 1; i < 16; ++i)
#pragma unroll
                for (int j = 0; j < 16; ++j) if ((i + 1) * (j + 1) <= 16) {
                    const unsigned key = (ord(fa[i] + fb[j]) & 0xFFFFFF00u) | (unsigned)(255 - (i * 16 + j));
                    if (n < 16) c1[n] = key; else if (n < 32) c2[n - 16] = key; else c3[n - 32] = key;
                    ++n;
                }
#pragma unroll
            for (int k = 2; k < 16; ++k) c3[k] = 0u;
        }
        sort16_desc(c1); sort16_desc(c2); sort16_desc(c3);
        merge_top16(c0, c1); merge_top16(c2, c3); merge_top16(c0, c2);
        float ev[16]; float l = 0.f; const float mx = unord(c0[0] & 0xFFFFFF00u);
#pragma unroll
        for (int k = 0; k < 16; ++k) { ev[k] = __expf(unord(c0[k] & 0xFFFFFF00u) - mx); l += ev[k]; }
        const float rl = 1.f / l;
        int ex[8]; float gt[8], su[8];
#pragma unroll
        for (int kk = 0; kk < 8; ++kk) {
            const unsigned key = hi ? c0[8 + kk] : c0[kk]; const float e = hi ? ev[8 + kk] : ev[kk];
            const int pos = 255 - (int)(key & 255u);
            ex[kk] = W[(pos >> 4) * 64 + lane] * 128 + W[(16 + (pos & 15)) * 64 + lane];
            gt[kk] = e * rl * VSC[ex[kk]]; su[kk] = USC[ex[kk]];
        }
        int* ep = EX + (size_t)t * 128 + h * 16 + hi * 8; float* gp = GT + (size_t)t * 128 + h * 16 + hi * 8;
        *(u32x4*)ep = (u32x4){(unsigned)ex[0], (unsigned)ex[1], (unsigned)ex[2], (unsigned)ex[3]}; *(u32x4*)(ep + 4) = (u32x4){(unsigned)ex[4], (unsigned)ex[5], (unsigned)ex[6], (unsigned)ex[7]};
        *(f32x4*)gp = (f32x4){gt[0], gt[1], gt[2], gt[3]}; *(f32x4*)(gp + 4) = (f32x4){gt[4], gt[5], gt[6], gt[7]};
        float* sp = SUo + (size_t)t * 128 + h * 16 + hi * 8;
        *(f32x4*)sp = (f32x4){su[0], su[1], su[2], su[3]}; *(f32x4*)(sp + 4) = (f32x4){su[4], su[5], su[6], su[7]};
    }
    __syncthreads();
}

#define P8_SYNC 0
#define P8_PARTITION 0
#define HAVE_P3 1
#define HAVE_P7 1
struct Args { Params p; int ph_lo, ph_hi, li, pad; };
__global__ void __launch_bounds__(NTHR, 2) mk_fwd(Args a) {
    extern __shared__ __attribute__((aligned(16))) unsigned char lds[];
    Frame F;
    F.lds = (LAS unsigned char*)lds;
    F.MISC = (volatile LAS unsigned*)(F.lds + MISC_OFF);
    F.tid = threadIdx.x; F.lane = F.tid & 63; F.wave = __builtin_amdgcn_readfirstlane(F.tid >> 6);
    F.G = gridDim.x; F.bid = blockIdx.x;
    const Params& p = a.p;
    gu32* ctl = (gu32*)(p.ws + WS_CTL);
    for (int u = F.tid; u < 128; u += NTHR) ((LAS unsigned*)(F.lds + MISC_OFF))[u] = 0u;
    __syncthreads();
    XcdBarrier bar = xcd_barrier_post((unsigned*)(ctl + CW_BAR) + a.li * XCD_BAR_WORDS, F.MISC + 8);
    const int lo = a.ph_lo, hi = a.ph_hi;
#ifdef PROBE_TS
    int nts_ = 0;
#define STAMP() do { if (threadIdx.x == 0 && nts_ < 12) { const unsigned long long t_ = __builtin_amdgcn_s_memrealtime(); F.MISC[32 + 2 * nts_] = (unsigned)t_; F.MISC[33 + 2 * nts_] = (unsigned)(t_ >> 32); } ++nts_; } while (0)
    STAMP();
#else
#define STAMP() do {} while (0)
#endif
#define IN(k) (lo <= (k) && (k) < hi)
#define REFRESH() do { F.lane = (int)__builtin_amdgcn_mbcnt_hi(~0u, __builtin_amdgcn_mbcnt_lo(~0u, 0u)); F.tid = F.wave * 64 + F.lane; } while (0)
#define SEAM(k) do { if (IN(k) && IN((k) + 1)) xcd_barrier(bar); STAMP(); } while (0)

#ifndef PROBE_DUP
#define PROBE_DUP -1
#endif
#define REP(k) for (int rep_ = 0; rep_ < (PROBE_DUP == (k) ? 2 : 1); ++rep_)
    if (IN(0)) { REP(0) p0_prologue(F, p); SEAM(0); }
    if (IN(1)) { REP(1) { p1_hrows(F, p); __syncthreads(); } SEAM(1); }
    if (IN(2)) {
        pg8::Gemm g{(const bf16_t*)(p.ws + WS_H), (const bf16_t*)(p.ws + WS_WIN), MALL, NQKV, D}; pg8::StaticOrder S; S.init(MALL, NQKV, F.G, F.bid);
        EpiQKVFast E{p.ws};
        REP(2) pg8::gemm_phase<EpiQKVFast, pg8::StaticOrder, true, true>(F.lds + RING_OFF, g, S, E);
        SEAM(2);
    }
#if HAVE_P3
    if (IN(3)) { REP(31) att::na_units(F, p); att::diff_units_v2<0>(F, p);
#if PROBE_DUP == 321
        att::diff_units_v2<1>(F, p);
#elif PROBE_DUP == 323
        att::diff_units_v2<3>(F, p);
#elif PROBE_DUP == 322
        att::diff_units_v2<2>(F, p);
#elif PROBE_DUP == 32
        att::diff_units_v2<0>(F, p);
#endif
        SEAM(3); }
#endif
    if (IN(4)) {
        pg8::Gemm g{(const bf16_t*)(p.ws + WS_Y), (const bf16_t*)(p.ws + WS_WOUT), MLAT, D, D}; pg8::StaticOrder S; S.init(MLAT, D, F.G, F.bid);
        pg8::EpiBf16<0> E{(bf16_t*)(p.ws + WS_YO), D, nullptr, 0, 0, 1.f};
        REP(4) pg8::gemm_phase<pg8::EpiBf16<0>, pg8::StaticOrder, true, true>(F.lds + RING_OFF, g, S, E);
        SEAM(4);
    }
    if (IN(5)) { REP(5) p5_rows2(F, p); SEAM(5); }
    if (IN(6)) {
        pg8::Gemm g{(const bf16_t*)(p.ws + WS_H2), (const bf16_t*)(p.ws + WS_WPQ), MLAT, 2048, D}; pg8::StaticOrder S; S.init(MLAT, 2048, F.G, F.bid);
        EpiQ2Frag E{(bf16_t*)(p.ws + WS_Q2)};
        REP(6) pg8::gemm_phase<EpiQ2Frag, pg8::StaticOrder, true, true>(F.lds + RING_OFF, g, S, E);
        SEAM(6);
    }
#if HAVE_P7
    if (IN(7)) { REP(7) p7_topk(F, p); SEAM(7); }
#endif
#if P8_PARTITION
    if (IN(8)) {
        p7b_sort(F, p); xcd_barrier(bar);
        for (int ch = 0; ch < 2; ++ch) { p8a_part(F, p, ch); xcd_barrier(bar); p8b_combine(F, p, ch); if (ch == 0) xcd_barrier(bar); }
    }
#else
    if (IN(8)) {
#if PROBE_DUP == 81
        p8_gather<1>(F, p, bar);
#elif PROBE_DUP == 82
        p8_gather<2>(F, p, bar);
#elif PROBE_DUP == 83
        p8_gather<3>(F, p, bar);
#endif
        p8_gather<0>(F, p, bar); }
#endif
#ifdef PROBE_TS
#ifdef PROBE_TS_ENDBAR
    xcd_barrier(bar);
#endif
    STAMP();
    if (blockIdx.x == 0 && threadIdx.x == 0) { const unsigned long long t1_ = ((unsigned long long)F.MISC[33 + 2 * (PROBE_TS + 1)] << 32) | F.MISC[32 + 2 * (PROBE_TS + 1)], t0_ = ((unsigned long long)F.MISC[33 + 2 * PROBE_TS] << 32) | F.MISC[32 + 2 * PROBE_TS];
        const unsigned long long dt = t1_ - t0_; const unsigned long long t_end = __builtin_amdgcn_s_memrealtime();
        while (__builtin_amdgcn_s_memrealtime() - t_end < 8ull * dt) __builtin_amdgcn_s_sleep(8); }
#endif
#undef IN
#undef SEAM
}

static void launch_mk(const Params& p, int lo, int hi, int li, hipStream_t stream) {
    Args a{}; a.p = p; a.ph_lo = lo; a.ph_hi = hi; a.li = li; a.pad = 0;
    hipLaunchKernelGGL(mk_fwd, dim3(256), dim3(NTHR), LDS_BYTES, stream, a);
}
extern "C" void kernel_launch(void* const* d_in, const int* in_sizes, int n_in, void* d_out, int out_size, void* d_ws, size_t ws_size, hipStream_t stream) {
    if (n_in != 16 || ws_size < WS_END) return;
    static bool attr_done = false;
    if (!attr_done) {
        (void)hipFuncSetAttribute((const void*)mk_fwd, hipFuncAttributeMaxDynamicSharedMemorySize, LDS_BYTES);
        attr_done = true;
    }
    Params p{};
    p.x = (const float*)d_in[0]; p.c = (const float*)d_in[1]; p.ctx = (const float*)d_in[2]; p.c_ctx = (const float*)d_in[3];
    p.w_ada = (const float*)d_in[4]; p.b_ada = (const float*)d_in[5]; p.g_norm = (const float*)d_in[6]; p.w_in = (const float*)d_in[7];
    p.rel_bias = (const float*)d_in[8]; p.diff_lambda = (const float*)d_in[9]; p.diff_subln = (const float*)d_in[10]; p.w_out = (const float*)d_in[11];
    p.peer_wq = (const float*)d_in[12]; p.peer_keys = (const float*)d_in[13]; p.peer_u = (const float*)d_in[14]; p.peer_v = (const float*)d_in[15];
    p.out = (float*)d_out; p.ws = (unsigned char*)d_ws;
    (void)hipMemsetAsync((char*)d_ws + WS_CTL, 0, CTL_ZERO_BYTES, stream);

    launch_mk(p, 0, 9, 0, stream);

}
```

```cpp
#include <hip/hip_runtime.h>
#include <stdint.h>
#include <math.h>

typedef unsigned short bf16_t;
typedef float f32x4 __attribute__((ext_vector_type(4)));
typedef unsigned u32x4 __attribute__((ext_vector_type(4)));
typedef unsigned u32x2 __attribute__((ext_vector_type(2)));
typedef float f32x2 __attribute__((ext_vector_type(2)));

constexpr int D = 1024, BATCH = 8, SEQ = 4096, CTX = 256, GW = 64;
constexpr int MLAT = BATCH * SEQ;
constexpr int MCTX = BATCH * CTX;
constexpr int MALL = MLAT + MCTX;
constexpr int NQKV = 3072;
constexpr int NKT = 68;
constexpr int NMOD = 6 * D;
constexpr int PE_H = 8, PE_NK = 128, PE_QD = 256, PE_TOPK = 16, PE_NEXP = 16384;
constexpr float EPS = 1e-6f;
constexpr float LOG2E = 1.4426950408889634f;
constexpr float C2 = 0.125f * LOG2E;
constexpr float LAMBDA_INIT = 0.2f;
constexpr float NEG_BIG = -30000.0f;

constexpr size_t MiB = 1u << 20;
constexpr size_t WS_CTL = 0;
constexpr size_t WS_MOD = 1 * MiB;
constexpr size_t WS_LAM = 1 * MiB + 256 * 1024;
constexpr size_t WS_ROPE = 1 * MiB + 512 * 1024;
constexpr size_t WS_USC = 1 * MiB + 640 * 1024;
constexpr size_t WS_VSC = 1 * MiB + 704 * 1024;
constexpr size_t WS_MODP = 2 * MiB;
constexpr size_t WS_BIAST = 4 * MiB;
constexpr size_t WS_KEYS = 5 * MiB;
constexpr size_t WS_KEYSI = 5 * MiB + 512 * 1024;
constexpr size_t WS_WIN = 6 * MiB;
constexpr size_t WS_WOUT = 12 * MiB;
constexpr size_t WS_WPQ = 14 * MiB;
constexpr size_t WS_UB = 18 * MiB;
constexpr size_t WS_VB = 50 * MiB;
constexpr size_t WS_EXP = 82 * MiB;
constexpr size_t WS_GATE = 98 * MiB;
constexpr size_t WS_H2 = 114 * MiB;
constexpr size_t WS_H = 178 * MiB;
constexpr size_t WS_Y = 178 * MiB;
constexpr size_t WS_QA = 246 * MiB;
constexpr size_t WS_KA = 278 * MiB;
constexpr size_t WS_VA = 312 * MiB;
constexpr size_t WS_QD = 346 * MiB;
constexpr size_t WS_KD = 378 * MiB;
constexpr size_t WS_VD = 412 * MiB;
constexpr size_t WS_YO = 246 * MiB;
constexpr size_t WS_Q2 = 246 * MiB;
constexpr size_t WS_PART = 178 * MiB;
constexpr size_t WS_DSCR = 464 * MiB;
constexpr size_t WS_SU = 446 * MiB;
constexpr size_t WS_END = 496 * MiB;

struct Params {
    const float *x, *c, *ctx, *c_ctx, *w_ada, *b_ada, *g_norm, *w_in, *rel_bias, *diff_lambda, *diff_subln, *w_out, *peer_wq, *peer_keys, *peer_u, *peer_v;
    float* out;
    unsigned char* ws;
};

__device__ __forceinline__ unsigned f2bf(float f) { unsigned u = __builtin_bit_cast(unsigned, f); return (u + 0x7fffu + ((u >> 16) & 1u)) >> 16; }
__device__ __forceinline__ unsigned pk2(float lo, float hi) { return f2bf(lo) | (f2bf(hi) << 16); }
__device__ __forceinline__ float bf2f(bf16_t h) { return __builtin_bit_cast(float, (unsigned)h << 16); }
__device__ __forceinline__ float bflo(unsigned w) { return __builtin_bit_cast(float, w << 16); }
__device__ __forceinline__ float bfhi(unsigned w) { return __builtin_bit_cast(float, w & 0xffff0000u); }
__device__ __forceinline__ float wave_sum(float v) {
    v += __uint_as_float((unsigned)__builtin_amdgcn_update_dpp(0, (int)__float_as_uint(v), 0xB1, 0xf, 0xf, false));
    v += __uint_as_float((unsigned)__builtin_amdgcn_update_dpp(0, (int)__float_as_uint(v), 0x4E, 0xf, 0xf, false));
    v += __uint_as_float((unsigned)__builtin_amdgcn_update_dpp(0, (int)__float_as_uint(v), 0x141, 0xf, 0xf, false));
    v += __uint_as_float((unsigned)__builtin_amdgcn_update_dpp(0, (int)__float_as_uint(v), 0x128, 0xf, 0xf, false));
    { auto r = __builtin_amdgcn_permlane16_swap(__float_as_uint(v), __float_as_uint(v), false, false); v = __uint_as_float(r[0]) + __uint_as_float(r[1]); }
    { auto r = __builtin_amdgcn_permlane32_swap(__float_as_uint(v), __float_as_uint(v), false, false); v = __uint_as_float(r[0]) + __uint_as_float(r[1]); }
    return v;
}
__device__ __forceinline__ float wave_max(float v) {
    v = fmaxf(v, __uint_as_float((unsigned)__builtin_amdgcn_update_dpp(0, (int)__float_as_uint(v), 0xB1, 0xf, 0xf, false)));
    v = fmaxf(v, __uint_as_float((unsigned)__builtin_amdgcn_update_dpp(0, (int)__float_as_uint(v), 0x4E, 0xf, 0xf, false)));
    v = fmaxf(v, __uint_as_float((unsigned)__builtin_amdgcn_update_dpp(0, (int)__float_as_uint(v), 0x141, 0xf, 0xf, false)));
    v = fmaxf(v, __uint_as_float((unsigned)__builtin_amdgcn_update_dpp(0, (int)__float_as_uint(v), 0x128, 0xf, 0xf, false)));
    { auto r = __builtin_amdgcn_permlane16_swap(__float_as_uint(v), __float_as_uint(v), false, false); v = fmaxf(__uint_as_float(r[0]), __uint_as_float(r[1])); }
    { auto r = __builtin_amdgcn_permlane32_swap(__float_as_uint(v), __float_as_uint(v), false, false); v = fmaxf(__uint_as_float(r[0]), __uint_as_float(r[1])); }
    return v;
}

__device__ __forceinline__ float half_max(float v) {
    v = fmaxf(v, __uint_as_float((unsigned)__builtin_amdgcn_update_dpp(0, (int)__float_as_uint(v), 0xB1, 0xf, 0xf, false)));
    v = fmaxf(v, __uint_as_float((unsigned)__builtin_amdgcn_update_dpp(0, (int)__float_as_uint(v), 0x4E, 0xf, 0xf, false)));
    v = fmaxf(v, __uint_as_float((unsigned)__builtin_amdgcn_update_dpp(0, (int)__float_as_uint(v), 0x141, 0xf, 0xf, false)));
    v = fmaxf(v, __uint_as_float((unsigned)__builtin_amdgcn_update_dpp(0, (int)__float_as_uint(v), 0x128, 0xf, 0xf, false)));
    { auto r = __builtin_amdgcn_permlane16_swap(__float_as_uint(v), __float_as_uint(v), false, false); v = fmaxf(__uint_as_float(r[0]), __uint_as_float(r[1])); }
    return v;
}
typedef float f32x16 __attribute__((ext_vector_type(16)));
typedef float f32x32 __attribute__((ext_vector_type(32)));
typedef unsigned u32x6 __attribute__((ext_vector_type(6)));

__device__ __forceinline__ u32x6 enc_fp6(f32x16 a, f32x16 b) { u32x6 w; asm volatile("v_cvt_scalef32_2xpk16_fp6_f32 %0, %1, %2, 1.0" : "=&v"(w) : "v"(a), "v"(b)); return w; }
__device__ __forceinline__ f32x32 dec_fp6(u32x6 w) { f32x32 r; asm volatile("v_cvt_scalef32_pk32_f32_fp6 %0, %1, 1.0" : "=&v"(r) : "v"(w)); return r; }

__device__ __forceinline__ int ktile_off(int k, int d) { return (d >> 3) * 512 + k * 8 + (d & 7); }
__device__ __forceinline__ int vtile_off(int k, int d) { return (d >> 5) * 2048 + (k >> 4) * 512 + (k & 15) * 32 + (d & 31); }
__device__ __forceinline__ size_t qa_idx(int b, int h, int t, int d) { return ((size_t)(b * 8 + h) * SEQ + t) * 64 + d; }
__device__ __forceinline__ size_t ka_idx(int b, int h, int j, int d) { return ((size_t)(b * 8 + h) * NKT + (j >> 6)) * 4096 + ktile_off(j & 63, d); }
__device__ __forceinline__ size_t va_idx(int b, int h, int j, int d) { return ((size_t)(b * 8 + h) * NKT + (j >> 6)) * 4096 + vtile_off(j & 63, d); }
__device__ __forceinline__ size_t qd_idx(int b, int m, int h, int t, int d) { return ((size_t)((b * 2 + m) * 4 + h) * SEQ + t) * 64 + d; }
__device__ __forceinline__ size_t kd_idx(int b, int m, int h, int j, int d) { return ((size_t)((b * 2 + m) * 4 + h) * NKT + (j >> 6)) * 4096 + ktile_off(j & 63, d); }
__device__ __forceinline__ size_t vd_idx(int b, int h, int j, int d) { return ((size_t)(b * 4 + h) * NKT + (j >> 6)) * 8192 + vtile_off(j & 63, d); }


namespace pg8 {
#define PG8_LAS __attribute__((address_space(3)))
typedef unsigned short bf16_t;
typedef short bf16x8 __attribute__((ext_vector_type(8)));
typedef float f32x4 __attribute__((ext_vector_type(4)));
typedef unsigned u32x4 __attribute__((ext_vector_type(4)));
constexpr int BM = 256, BK = 64, HALF = 128, HTB = HALF * BK * 2  , STAGE_BYTES = 8 * HTB, NXCD = 8, WGM = 8;

__host__ __device__ __forceinline__ int lds_byte(int r, int c) { const int st = (r >> 4) * 2 + (c >> 5), rr = r & 15, cc = c & 31, ob = rr * 64 + cc * 2; return st * 1024 + (ob ^ (((ob >> 9) & 1) << 5)); }
__host__ __device__ __forceinline__ void stage_rc(int b, int& R, int& C) { const int st = b / 1024, sb = b % 1024, swz = sb ^ (((sb >> 9) & 1) << 5); R = (st >> 1) * 16 + swz / 64; C = (st & 1) * 32 + (swz % 64) / 2; }
__host__ __device__ __forceinline__ int perm32(int rho) { const int n = rho >> 4, i = rho & 15; return 8 * (i >> 2) + 4 * n + (i & 3); }

struct Unit { int pm, pn; };
struct Gemm { const bf16_t* A; const bf16_t* Bt; int M, N, K; };

struct StaticOrder {
    int nM, nN, nwg, G, c;
    __host__ __device__ void init(int M, int N, int G_, int c_) { nM = M / BM; nN = N / BM; nwg = nM * nN; G = G_; c = c_; }
    __host__ __device__ bool next(int i, Unit& u) const {
        const long L = (long)i * G + c; if (L >= nwg) return false;
        int wgid = (int)L; { const int q = nwg / NXCD, r = nwg % NXCD, xcd = wgid % NXCD, off = wgid / NXCD; wgid = (xcd < r ? xcd * (q + 1) : r * (q + 1) + (xcd - r) * q) + off; }
        const int nig = WGM * nN, gid = wgid / nig, fm = gid * WGM, gsz = (nM - fm) < WGM ? (nM - fm) : WGM;
        u.pm = fm + ((wgid % nig) % gsz); u.pn = (wgid % nig) / gsz; return true;
    }
    __device__ __forceinline__ void a_ready(const Unit&) const {}
    __device__ __forceinline__ void done(const Unit&) const {}
};

__device__ __forceinline__ unsigned cvt_pk_bf16(float lo, float hi) { unsigned r; asm volatile("v_cvt_pk_bf16_f32 %0, %1, %2" : "=v"(r) : "v"(lo), "v"(hi)); return r; }
typedef float f32x2 __attribute__((ext_vector_type(2)));
__device__ __forceinline__ f32x2 gelu_pk(f32x2 v) {
    const f32x2 av = __builtin_elementwise_abs(v), d = av * 0.2316418882f + 1.0f;
    f32x2 t; t.x = __builtin_amdgcn_rcpf(d.x); t.y = __builtin_amdgcn_rcpf(d.y);
    f32x2 q = t * 0.5307027145f + (-0.7265760135f); q = q * t + 0.7107068705f; q = q * t + (-0.142248368f); q = q * t + 0.127414796f; q = q * t;
    const f32x2 s = (v * v) * (-0.72134752044f);
    f32x2 e; e.x = __builtin_amdgcn_exp2f(s.x); e.y = __builtin_amdgcn_exp2f(s.y);
    const f32x2 m = v * (q * e), r = v - m;
    f32x2 o; o.x = v.x < 0.f ? m.x : r.x; o.y = v.y < 0.f ? m.y : r.y; return o;
}

template <int ACT  > struct EpiBf16 {
    static constexpr bool PERM = true, AFTER_DRAIN = false; static_assert(ACT == 0 || ACT == 1, "EpiBf16: ACT is 0 (none) or 1 (gelu_pk)");
    bf16_t* O; int ldc; const float* bias; int split_cols; size_t split_stride; float scale0;
    __device__ __forceinline__ void operator()(const f32x4 (&acc)[2][2][4][2], const Unit& u, int wr, int wc, int fr, int fq) const {
        const int row0 = u.pm * BM + wr * 64 + fr; int colt = u.pn * BM; bf16_t* base = O;
        float sc = 1.f; if (split_cols) { const int t = colt / split_cols; base += (size_t)t * split_stride; colt -= t * split_cols; if (t == 0) sc = scale0; }
        const int col0 = colt + wc * 32 + 8 * fq, bcol0 = u.pn * BM + wc * 32 + 8 * fq;
        f32x4 bv[2][2];
#pragma unroll
        for (int bj = 0; bj < 2; ++bj)
#pragma unroll
            for (int n = 0; n < 2; ++n) bv[bj][n] = bias ? *(const f32x4*)(bias + bcol0 + bj * HALF + 4 * n) : (f32x4){0.f, 0.f, 0.f, 0.f};
#pragma unroll
        for (int ai = 0; ai < 2; ++ai)
#pragma unroll
            for (int m = 0; m < 4; ++m) { bf16_t* rowp = base + (size_t)(row0 + ai * HALF + m * 16) * ldc + col0;
#pragma unroll
                for (int bj = 0; bj < 2; ++bj) { f32x4 v0 = acc[ai][bj][m][0] + bv[bj][0], v1 = acc[ai][bj][m][1] + bv[bj][1];
                    if (ACT == 1) { f32x2 a = gelu_pk((f32x2){v0[0], v0[1]}), b = gelu_pk((f32x2){v0[2], v0[3]}), c = gelu_pk((f32x2){v1[0], v1[1]}), d = gelu_pk((f32x2){v1[2], v1[3]});
                        v0 = (f32x4){a.x, a.y, b.x, b.y}; v1 = (f32x4){c.x, c.y, d.x, d.y}; }
                    v0 = v0 * sc; v1 = v1 * sc; u32x4 w; w.x = cvt_pk_bf16(v0[0], v0[1]); w.y = cvt_pk_bf16(v0[2], v0[3]); w.z = cvt_pk_bf16(v1[0], v1[1]); w.w = cvt_pk_bf16(v1[2], v1[3]);
                    *(u32x4*)(rowp + bj * HALF) = w; } }
    }
};

template <class Epi, class Sched, bool ALIGN_EPI = false, bool SP2 = false>
__device__ __forceinline__ void gemm_phase(PG8_LAS unsigned char* lds, const Gemm g, const Sched& S, const Epi& E) {
    const int tid = threadIdx.x, wid = __builtin_amdgcn_readfirstlane(tid >> 6), lane = tid & 63, wr = wid >> 2, wc = wid & 3, fr = lane & 15, fq = lane >> 4;
    const int K = g.K, nt = K / BK;
    unsigned voffA[2], voffB[2];
#pragma unroll
    for (int i = 0; i < 2; ++i) { int R, C; stage_rc(tid * 16 + i * 8192, R, C); const int Rb = Epi::PERM ? ((R & ~31) + perm32(R & 31)) : R;
        voffA[i] = (unsigned)(R * K + C) * 2u; voffB[i] = (unsigned)(Rb * K + C) * 2u; }
    const size_t kstep = (size_t)(BK * 2);
    const size_t hstep = (size_t)HALF * K * 2;
    const size_t tstep = 2 * hstep;
    const unsigned ldsw = (unsigned)wid * 1024u;
    const int aoff = lds_byte(wr * 64 + fr, fq * 8), boff = lds_byte(wc * 32 + fr, fq * 8);
#define PG8_SA(b, h) (((b) * 2 + (h)) * HTB)
#define PG8_SB(b, h) ((4 + (b) * 2 + (h)) * HTB)
#define PG8_STAGE(bufoff, gbase, voff) do { _Pragma("unroll") for (int _i = 0; _i < 2; ++_i) \
        __builtin_amdgcn_global_load_lds((const unsigned*)((const char*)(gbase) + (voff)[_i]), (PG8_LAS unsigned*)(lds + (bufoff) + ldsw + _i * 8192), 16, 0, 0); } while (0)
#define PG8_LDA(dst, b, h) do { _Pragma("unroll") for (int m = 0; m < 4; ++m) _Pragma("unroll") for (int k = 0; k < 2; ++k) dst[m][k] = *(const PG8_LAS bf16x8*)(lds + PG8_SA(b, h) + aoff + m * 2048 + k * 1024); } while (0)
#define PG8_LDB(dst, b, h) do { _Pragma("unroll") for (int n = 0; n < 2; ++n) _Pragma("unroll") for (int k = 0; k < 2; ++k) dst[n][k] = *(const PG8_LAS bf16x8*)(lds + PG8_SB(b, h) + boff + n * 2048 + k * 1024); } while (0)
#define PG8_MMA(ai, bj, At, Bt) do { __builtin_amdgcn_s_setprio(1); _Pragma("unroll") for (int m = 0; m < 4; ++m) _Pragma("unroll") for (int n = 0; n < 2; ++n) _Pragma("unroll") for (int k = 0; k < 2; ++k) \
        acc[ai][bj][m][n] = __builtin_amdgcn_mfma_f32_16x16x32_bf16(Bt[n][k], At[m][k], acc[ai][bj][m][n], 0, 0, 0); __builtin_amdgcn_s_setprio(0); } while (0)
#define PG8_WAIT_V(n) asm volatile("s_waitcnt vmcnt(" #n ")" ::: "memory")
#define PG8_WAIT_L(n) asm volatile("s_waitcnt lgkmcnt(" #n ")" ::: "memory")
#define PG8_BAR __builtin_amdgcn_s_barrier()
#define PG8_SCHED __builtin_amdgcn_sched_barrier(0)
    Unit cur, nxt; int ui = 0;
    if (!S.next(0, cur)) return;
    f32x4 acc[2][2][4][2];
#pragma unroll
    for (int a = 0; a < 2; ++a)
#pragma unroll
        for (int b = 0; b < 2; ++b)
#pragma unroll
            for (int m = 0; m < 4; ++m)
#pragma unroll
                for (int n = 0; n < 2; ++n) acc[a][b][m][n] = (f32x4){0.f, 0.f, 0.f, 0.f};
    bf16x8 At[4][2], B0[2][2], B1[2][2];
    const char* cA = (const char*)g.A + (size_t)cur.pm * tstep; const char* cB = (const char*)g.Bt + (size_t)cur.pn * tstep;
    S.a_ready(cur);
    if constexpr (SP2) {
        PG8_STAGE(PG8_SB(0, 0), cB, voffB); PG8_STAGE(PG8_SB(0, 1), cB + hstep, voffB); PG8_STAGE(PG8_SA(0, 0), cA, voffA); PG8_STAGE(PG8_SA(0, 1), cA + hstep, voffA);
        if (wr == 1) PG8_BAR;
        PG8_WAIT_V(2); PG8_BAR;
        PG8_STAGE(PG8_SB(1, 0), cB + kstep, voffB); PG8_STAGE(PG8_SA(1, 0), cA + kstep, voffA); PG8_STAGE(PG8_SB(1, 1), cB + hstep + kstep, voffB);
        PG8_WAIT_V(6); PG8_BAR;
    } else {
        PG8_STAGE(PG8_SB(0, 0), cB, voffB); PG8_STAGE(PG8_SA(0, 0), cA, voffA); PG8_STAGE(PG8_SB(0, 1), cB + hstep, voffB); PG8_STAGE(PG8_SA(0, 1), cA + hstep, voffA);
        if (wr == 1) PG8_BAR;
        PG8_WAIT_V(4); PG8_BAR;
        PG8_STAGE(PG8_SB(1, 0), cB + kstep, voffB); PG8_STAGE(PG8_SA(1, 0), cA + kstep, voffA); PG8_STAGE(PG8_SB(1, 1), cB + hstep + kstep, voffB);
        PG8_WAIT_V(6); PG8_BAR;
    }
    for (;;) {
        const bool has_next = S.next(ui + 1, nxt);
        const char* nA = has_next ? (const char*)g.A + (size_t)nxt.pm * tstep : cA; const char* nB = has_next ? (const char*)g.Bt + (size_t)nxt.pn * tstep : cB;
        for (int t = 0; t < nt; t += 2) {
            const bool last = (t == nt - 2);
            const char* a1 = cA + (size_t)(t + 1) * kstep;
            const char* a2 = last ? nA : cA + (size_t)(t + 2) * kstep; const char* b2 = last ? nB : cB + (size_t)(t + 2) * kstep;
            const char* a3 = a2 + kstep; const char* b3 = b2 + kstep;
            if (last && has_next) S.a_ready(nxt);
            if constexpr (SP2) {
            PG8_LDB(B0, 0, 0); PG8_LDB(B1, 0, 1); PG8_SCHED; PG8_LDA(At, 0, 0); PG8_STAGE(PG8_SA(1, 1), a1 + hstep, voffA);
            PG8_WAIT_V(8); PG8_WAIT_L(0); PG8_BAR; PG8_MMA(0, 0, At, B0); PG8_MMA(0, 1, At, B1); PG8_BAR; PG8_SCHED;
            PG8_LDA(At, 0, 1); PG8_STAGE(PG8_SB(0, 0), b2, voffB); PG8_STAGE(PG8_SB(0, 1), b2 + hstep, voffB); PG8_STAGE(PG8_SA(0, 0), a2, voffA);
            PG8_WAIT_V(8); PG8_WAIT_L(0); PG8_BAR; PG8_MMA(1, 0, At, B0); PG8_MMA(1, 1, At, B1); PG8_BAR; PG8_SCHED;
            PG8_LDB(B0, 1, 0); PG8_LDB(B1, 1, 1); PG8_SCHED; PG8_LDA(At, 1, 0); PG8_STAGE(PG8_SA(0, 1), a2 + hstep, voffA);
            PG8_WAIT_V(8); PG8_WAIT_L(0); PG8_BAR; PG8_MMA(0, 0, At, B0); PG8_MMA(0, 1, At, B1); PG8_BAR; PG8_SCHED;
            PG8_LDA(At, 1, 1); PG8_STAGE(PG8_SB(1, 0), b3, voffB); PG8_STAGE(PG8_SB(1, 1), b3 + hstep, voffB); PG8_STAGE(PG8_SA(1, 0), a3, voffA);
            PG8_WAIT_V(8); PG8_WAIT_L(0); PG8_BAR; PG8_MMA(1, 0, At, B0); PG8_MMA(1, 1, At, B1); PG8_BAR; PG8_SCHED;
            } else {
            PG8_LDB(B0, 0, 0); PG8_SCHED; PG8_LDA(At, 0, 0); PG8_STAGE(PG8_SA(1, 1), a1 + hstep, voffA);
            PG8_WAIT_L(8); PG8_BAR; PG8_WAIT_L(0); PG8_MMA(0, 0, At, B0); PG8_BAR; PG8_SCHED;
            PG8_LDB(B1, 0, 1); PG8_STAGE(PG8_SB(0, 0), b2, voffB);
            PG8_BAR; PG8_WAIT_L(0); PG8_MMA(0, 1, At, B1); PG8_BAR;
            PG8_LDA(At, 0, 1); PG8_STAGE(PG8_SA(0, 0), a2, voffA);
            PG8_BAR; PG8_WAIT_L(0); PG8_MMA(1, 0, At, B0); PG8_BAR; PG8_SCHED;
            PG8_STAGE(PG8_SB(0, 1), b2 + hstep, voffB);
            PG8_WAIT_V(6); PG8_BAR; PG8_MMA(1, 1, At, B1); PG8_BAR;
            PG8_LDB(B0, 1, 0); PG8_SCHED; PG8_LDA(At, 1, 0); PG8_STAGE(PG8_SA(0, 1), a2 + hstep, voffA);
            PG8_WAIT_L(8); PG8_BAR; PG8_WAIT_L(0); PG8_MMA(0, 0, At, B0); PG8_BAR; PG8_SCHED;
            PG8_LDB(B1, 1, 1); PG8_STAGE(PG8_SB(1, 0), b3, voffB);
            PG8_BAR; PG8_WAIT_L(0); PG8_MMA(0, 1, At, B1); PG8_BAR;
            PG8_LDA(At, 1, 1); PG8_STAGE(PG8_SA(1, 0), a3, voffA);
            PG8_BAR; PG8_WAIT_L(0); PG8_MMA(1, 0, At, B0); PG8_BAR; PG8_SCHED;
            PG8_STAGE(PG8_SB(1, 1), b3 + hstep, voffB);
            PG8_WAIT_V(6); PG8_BAR; PG8_MMA(1, 1, At, B1); PG8_BAR;
            }
        }
        if constexpr (ALIGN_EPI) { if (wr == 0) PG8_BAR; }
        if constexpr (!Epi::AFTER_DRAIN) { E(acc, cur, wr, wc, fr, fq); S.done(cur); }
        if (!has_next) break;
#pragma unroll
        for (int a = 0; a < 2; ++a)
#pragma unroll
            for (int b = 0; b < 2; ++b)
#pragma unroll
                for (int m = 0; m < 4; ++m)
#pragma unroll
                    for (int n = 0; n < 2; ++n) acc[a][b][m][n] = (f32x4){0.f, 0.f, 0.f, 0.f};
        cur = nxt; cA = nA; cB = nB; ++ui;
        if constexpr (ALIGN_EPI) { if (wr == 1) PG8_BAR; }
    }
    PG8_WAIT_V(0);
    if constexpr (!ALIGN_EPI) { if (wr == 0) PG8_BAR; }
    PG8_BAR;
    if constexpr (Epi::AFTER_DRAIN) { E.fused(acc, cur, wr, wc, fr, fq, lds, wid, lane); S.done(cur); }
#undef PG8_SA
#undef PG8_SB
#undef PG8_STAGE
#undef PG8_LDA
#undef PG8_LDB
#undef PG8_MMA
#undef PG8_WAIT_V
#undef PG8_WAIT_L
#undef PG8_BAR
#undef PG8_SCHED
}
}

#define GAS __attribute__((address_space(1)))
#define LAS __attribute__((address_space(3)))
typedef unsigned v4u __attribute__((ext_vector_type(4)));
typedef float f32x4 __attribute__((ext_vector_type(4)));
typedef short bf16x8 __attribute__((ext_vector_type(8)));
typedef GAS unsigned gu32;
typedef GAS unsigned long long gu64;
#define RLX_AGENT __ATOMIC_RELAXED, __HIP_MEMORY_SCOPE_AGENT
#define LDS_WAIT() asm volatile("s_waitcnt lgkmcnt(0)" ::: "memory")
#define VM_WAIT() asm volatile("s_waitcnt vmcnt(0)" ::: "memory")
__device__ __forceinline__ unsigned long long rt() { return __builtin_amdgcn_s_memrealtime(); }

#define XB_TMO      128
#define XB_XCNT(j)  (256  + 64 * (j))
#define XB_XSUB(j)  (1280 + 64 * (j))
#define XB_XGEN(j)  (2304 + 64 * (j))
#define XB_TOP      3328
#define XB_TOPGEN   3392
#define XCD_BAR_WORDS 3456
#define XB_SPIN_CAP (1u << 18)

__device__ __forceinline__ unsigned xb_ld(unsigned* p)              { return __hip_atomic_load(p, __ATOMIC_RELAXED, __HIP_MEMORY_SCOPE_AGENT); }
__device__ __forceinline__ unsigned xb_add(unsigned* p, unsigned v) { return __hip_atomic_fetch_add(p, v, __ATOMIC_RELAXED, __HIP_MEMORY_SCOPE_AGENT); }
__device__ __forceinline__ unsigned xb_xcc_id() { return (unsigned)__builtin_amdgcn_s_getreg((3 << 11) | 20) & 0xFu; }
#define XB_SPIN(cond, bar) do { unsigned _sp = 0; while (cond) { __builtin_amdgcn_s_sleep(1); \
    if ((++_sp & 255u) == 0u) { if (xb_ld(&(bar)[XB_TMO])) break; if (_sp > XB_SPIN_CAP) { atomicAdd(&(bar)[XB_TMO], 1u); break; } } } } while (0)

struct XcdBarrier {
    unsigned* bar; unsigned x;
    volatile LAS unsigned* st;
};

__device__ __forceinline__ XcdBarrier xcd_barrier_post(unsigned* bar, volatile LAS unsigned* st) {
    XcdBarrier b; b.bar = bar; b.x = xb_xcc_id(); b.st = st;
    if (threadIdx.x == 0) (void)xb_add(&bar[XB_XCNT(b.x)], 1u);
    return b;
}
__device__ __forceinline__ void xcd_barrier_complete(unsigned* bar, unsigned x, unsigned& nloc, unsigned& nx) {
    const unsigned G = gridDim.x * gridDim.y * gridDim.z;
    unsigned sum, cnt, mine, sp = 0u;
    for (;;) {
        sum = 0u; cnt = 0u; mine = 0u;
#pragma unroll
        for (unsigned j = 0; j < 16; ++j) { const unsigned c = xb_ld(&bar[XB_XCNT(j)]); sum += c; cnt += (c > 0u) ? 1u : 0u; mine = (j == x) ? c : mine; }
        if (sum == G) break;
        __builtin_amdgcn_s_sleep(1);
        if ((++sp & 255u) == 0u) { if (xb_ld(&bar[XB_TMO])) break; if (sp > XB_SPIN_CAP) { atomicAdd(&bar[XB_TMO], 1u); break; } }
    }
    nloc = mine > 0u ? mine : 1u; nx = cnt > 0u ? cnt : 1u;
}

__device__ __forceinline__ void xcd_barrier(const XcdBarrier& b) {
    asm volatile("s_waitcnt vmcnt(0)" ::: "memory");
    __syncthreads();
    if (threadIdx.x == 0) {
        unsigned* bar = b.bar;
        __builtin_amdgcn_s_waitcnt(0);
        unsigned nloc = b.st[0], nx = b.st[1];
        if (nloc == 0u) { xcd_barrier_complete(bar, b.x, nloc, nx); b.st[0] = nloc; b.st[1] = nx; }
        const unsigned old = xb_add(&bar[XB_XSUB(b.x)], 1u);
        const unsigned gen = old / nloc;
        if (old + 1u == (gen + 1u) * nloc) {
            __builtin_amdgcn_fence(__ATOMIC_RELEASE, "agent");
            asm volatile("s_waitcnt vmcnt(0)" ::: "memory");
            const unsigned og = xb_add(&bar[XB_TOP], 1u);
            const unsigned tg = og / nx;
            if (og + 1u == (tg + 1u) * nx) xb_add(&bar[XB_TOPGEN], 1u);
            else XB_SPIN(xb_ld(&bar[XB_TOPGEN]) == tg, bar);
            __builtin_amdgcn_fence(__ATOMIC_ACQUIRE, "agent");
            xb_add(&bar[XB_XGEN(b.x)], 1u);
            asm volatile("s_waitcnt vmcnt(0)" ::: "memory");
        } else {
            XB_SPIN(xb_ld(&bar[XB_XGEN(b.x)]) == gen, bar);
            __builtin_amdgcn_fence(__ATOMIC_ACQUIRE, "agent");
            asm volatile("s_waitcnt vmcnt(0)" ::: "memory");
        }
    }
    __syncthreads();
}

constexpr int NWAVES = 8, NTHR = 512;
constexpr int RING_OFF = 0, RING_BYTES = 131072;
constexpr int LDS_BYTES = 159744;
constexpr int MISC_OFF = LDS_BYTES - 512;
constexpr size_t CTL_ZERO_BYTES = 65536;
constexpr int CW_P8CTR = 2048;
constexpr int CW_BAR = 4096;

struct Frame {
    LAS unsigned char* lds;
    volatile LAS unsigned* MISC;
    int tid, lane, wave, G, bid;
};

__device__ __forceinline__ void p0_transpose_item(const float* W, int K, int N, bf16_t* WT, LAS float* scr, int item, int lane) {
    const int nblk = N / 32, kb = item / nblk, nb = item % nblk, k0 = 64 * kb, n0 = 32 * nb;
    float tv[32];
#pragma unroll
    for (int i = 0; i < 32; ++i) tv[i] = W[(size_t)(k0 + 2 * i + (lane >> 5)) * N + n0 + (lane & 31)];
#pragma unroll
    for (int i = 0; i < 32; ++i) scr[(2 * i + (lane >> 5)) * 33 + (lane & 31)] = tv[i];
    LDS_WAIT(); asm volatile("" ::: "memory");
    const int c = lane & 7;
#pragma unroll
    for (int j = 0; j < 4; ++j) { const int n = (lane >> 3) + 8 * j; const LAS float* s = scr + (8 * c) * 33 + n;
        v4u o; o.x = pk2(s[0 * 33], s[1 * 33]); o.y = pk2(s[2 * 33], s[3 * 33]); o.z = pk2(s[4 * 33], s[5 * 33]); o.w = pk2(s[6 * 33], s[7 * 33]);
        *(GAS v4u*)(WT + (size_t)(n0 + n) * K + k0 + 8 * c) = o; }
    LDS_WAIT(); asm volatile("" ::: "memory");
}
__device__ __forceinline__ void cvt_stream(const float* src, bf16_t* dst, size_t n4, size_t gtid, size_t gsz) {
    for (size_t i = gtid; i < n4; i += gsz) { const f32x4 v = ((const f32x4*)src)[i]; u32x2 o; o.x = pk2(v.x, v.y); o.y = pk2(v.z, v.w); ((u32x2*)dst)[i] = o; }
}
__device__ __forceinline__ void p0_prologue(Frame& F, const Params& p) {
    unsigned char* ws = p.ws;
    for (int item = F.bid; item < 192; item += F.G) {
        LAS float* sil = (LAS float*)(F.lds);
        LAS float* red = (LAS float*)(F.lds + 8192);
        const int ks = item / 24, cc = item % 24;
        for (int i = F.tid; i < 9 * 128; i += NTHR) { const int r = i >> 7, k = ks * 128 + (i & 127); const float v = r < 8 ? p.c[r * 1024 + k] : p.c_ctx[k]; sil[i] = v / (1.f + __expf(-v)); }
        __syncthreads();
        f32x4 acc[9];
#pragma unroll
        for (int r = 0; r < 9; ++r) acc[r] = (f32x4){0.f, 0.f, 0.f, 0.f};
        const float* wp = p.w_ada + (size_t)(ks * 128 + F.wave * 16) * NMOD + cc * 256 + F.lane * 4;
#pragma unroll 4
        for (int kk = 0; kk < 16; ++kk) { const f32x4 w = *(const f32x4*)(wp + (size_t)kk * NMOD);
#pragma unroll
            for (int r = 0; r < 9; ++r) acc[r] += w * sil[r * 128 + F.wave * 16 + kk]; }
#pragma unroll
        for (int r = 0; r < 9; ++r) *(LAS f32x4*)(red + ((F.wave * 9 + r) * 256 + F.lane * 4)) = acc[r];
        __syncthreads();
        float* modp = (float*)(ws + WS_MODP);
        for (int i = F.tid; i < 9 * 256; i += NTHR) { const int r = i >> 8, c = i & 255; float s = 0.f;
#pragma unroll
            for (int w = 0; w < 8; ++w) s += red[(w * 9 + r) * 256 + c];
            modp[(size_t)(ks * 9 + r) * NMOD + cc * 256 + c] = s; }
        __syncthreads();
    }
    {
        LAS float* scr = (LAS float*)(F.lds + F.wave * 16384);
        const int gw = F.bid * NWAVES + F.wave, NGW = F.G * NWAVES;
        constexpr int I_IN = 16 * 96, I_OUT = 16 * 32, I_PQ = 16 * 64;
        for (int it = gw; it < I_IN + I_OUT + I_PQ; it += NGW) {
            int r = it;
            if (r < I_IN) { p0_transpose_item(p.w_in, D, NQKV, (bf16_t*)(ws + WS_WIN), scr, r, F.lane); continue; } r -= I_IN;
            if (r < I_OUT) { p0_transpose_item(p.w_out, D, D, (bf16_t*)(ws + WS_WOUT), scr, r, F.lane); continue; } r -= I_OUT;
            p0_transpose_item(p.peer_wq, D, 2048, (bf16_t*)(ws + WS_WPQ), scr, r, F.lane);
        }
    }
    const size_t gtid = (size_t)F.bid * NTHR + F.tid, gsz = (size_t)F.G * NTHR;
    cvt_stream(p.peer_keys, (bf16_t*)(ws + WS_KEYS), (size_t)8 * 2 * 128 * 128 / 4, gtid, gsz);
    { bf16_t* ki = (bf16_t*)(ws + WS_KEYSI);
      for (int i = (int)gtid; i < 8 * 2 * 16 * 128; i += (int)gsz) { const int key = i & 127, c = (i >> 7) & 15, hp = i >> 11;
          const float* sp = p.peer_keys + ((size_t)hp * 128 + key) * 128 + c * 8; const f32x4 a = *(const f32x4*)sp, b = *(const f32x4*)(sp + 4);
          u32x4 o; o.x = pk2(a.x, a.y); o.y = pk2(a.z, a.w); o.z = pk2(b.x, b.y); o.w = pk2(b.z, b.w); *(u32x4*)(ki + (size_t)i * 8) = o; } }
    {
        const int gw = F.bid * NWAVES + F.wave, NGW = F.G * NWAVES, l5 = F.lane & 31, hb = F.lane >> 5;
        for (int e0 = gw * 2; e0 < PE_NEXP; e0 += NGW * 2) {
            f32x4 x[2][8];
#pragma unroll
            for (int q = 0; q < 2; ++q) { const float* src = (hb ? p.peer_v : p.peer_u) + (size_t)(e0 + q) * D + l5 * 32;
#pragma unroll
                for (int j = 0; j < 8; ++j) x[q][j] = ((const f32x4*)src)[j]; }
#pragma unroll
            for (int q = 0; q < 2; ++q) {
                float am = 0.f;
#pragma unroll
                for (int j = 0; j < 8; ++j) am = fmaxf(am, fmaxf(fmaxf(fabsf(x[q][j].x), fabsf(x[q][j].y)), fmaxf(fabsf(x[q][j].z), fabsf(x[q][j].w))));
                am = half_max(am);
                const float top = 6.0f;
                const float sc = am > 0.f ? top / am : 1.f, inv = am > 0.f ? am / top : 1.f;
                f32x16 va, vb;
#pragma unroll
                for (int j = 0; j < 4; ++j) { va[4 * j] = x[q][j].x * sc; va[4 * j + 1] = x[q][j].y * sc; va[4 * j + 2] = x[q][j].z * sc; va[4 * j + 3] = x[q][j].w * sc;
                    vb[4 * j] = x[q][4 + j].x * sc; vb[4 * j + 1] = x[q][4 + j].y * sc; vb[4 * j + 2] = x[q][4 + j].z * sc; vb[4 * j + 3] = x[q][4 + j].w * sc; }
                {
                    u32x4 o = (u32x4){0u, 0u, 0u, 0u};
#pragma unroll
                    for (int j = 0; j < 2; ++j) {
                        o[j] = __builtin_amdgcn_cvt_scalef32_pk_fp4_f32(o[j], va[8 * j + 0], va[8 * j + 1], 1.0f, 0); o[j] = __builtin_amdgcn_cvt_scalef32_pk_fp4_f32(o[j], va[8 * j + 2], va[8 * j + 3], 1.0f, 1);
                        o[j] = __builtin_amdgcn_cvt_scalef32_pk_fp4_f32(o[j], va[8 * j + 4], va[8 * j + 5], 1.0f, 2); o[j] = __builtin_amdgcn_cvt_scalef32_pk_fp4_f32(o[j], va[8 * j + 6], va[8 * j + 7], 1.0f, 3);
                        o[2 + j] = __builtin_amdgcn_cvt_scalef32_pk_fp4_f32(o[2 + j], vb[8 * j + 0], vb[8 * j + 1], 1.0f, 0); o[2 + j] = __builtin_amdgcn_cvt_scalef32_pk_fp4_f32(o[2 + j], vb[8 * j + 2], vb[8 * j + 3], 1.0f, 1);
                        o[2 + j] = __builtin_amdgcn_cvt_scalef32_pk_fp4_f32(o[2 + j], vb[8 * j + 4], vb[8 * j + 5], 1.0f, 2); o[2 + j] = __builtin_amdgcn_cvt_scalef32_pk_fp4_f32(o[2 + j], vb[8 * j + 6], vb[8 * j + 7], 1.0f, 3); }
                    *(u32x4*)(ws + (hb ? WS_VB : WS_UB) + (size_t)(e0 + q) * 512 + l5 * 16) = o;
                }
                if (l5 == 0) ((float*)(ws + (hb ? WS_VSC : WS_USC)))[e0 + q] = inv;
            }
        }
    }
    if (gtid == 0) {
        float s01 = 0.f, s23 = 0.f;
        for (int i = 0; i < 64; ++i) { s01 += p.diff_lambda[i] * p.diff_lambda[64 + i]; s23 += p.diff_lambda[128 + i] * p.diff_lambda[192 + i]; }
        *(float*)(ws + WS_LAM) = expf(s01) - expf(s23) + LAMBDA_INIT;
    }
    float* rope = (float*)(ws + WS_ROPE);
    for (int i = (int)gtid; i < 64 * 16; i += (int)gsz) { const int pos = i >> 4, f = i & 15; const float inv = exp2f(-(float)f * (13.287712379549449f / 16.f)); const float a = (float)pos * inv; rope[2 * i] = cosf(a); rope[2 * i + 1] = sinf(a); }
    bf16_t* bt = (bf16_t*)(ws + WS_BIAST);
    for (int i = (int)gtid; i < 8 * 15 * 4096; i += (int)gsz) {
        const int j = i & 7, kc = (i >> 3) & 63, cq = (i >> 9) & 7, hd = i >> 12, dr = hd % 15, h = hd / 15;
        const int cp = cq * 8 + j; int cs = cp - 8; cs = cs < 0 ? 0 : (cs > 48 ? 48 : cs);
        float v = NEG_BIG;
        if (kc >= cs && kc < cs + 16) v = p.rel_bias[(h * 15 + dr) * 31 + (kc - cp + 15)] * LOG2E;
        bt[i] = (bf16_t)f2bf(v);
    }
}

__device__ __forceinline__ void p1_hrows(Frame& F, const Params& p) {
    unsigned char* ws = p.ws;
    const float* modp = (const float*)(ws + WS_MODP);
    float* mod = (float*)(ws + WS_MOD);
    for (int i = F.bid * NTHR + F.tid; i < 9 * NMOD; i += F.G * NTHR) { float s = p.b_ada[i % NMOD];
#pragma unroll
        for (int ks = 0; ks < 8; ++ks) s += modp[(size_t)ks * 9 * NMOD + i];
        mod[i] = s; }
    const int rows_per = (MALL + F.G - 1) / F.G, r0 = F.bid * rows_per, r1 = min(MALL, r0 + rows_per);
    if (r0 >= r1) return;
    const int mr_lo = r0 < MLAT ? (r0 >> 12) : 8;
    LAS float* tab = (LAS float*)F.lds;
    for (int i = F.tid; i < 2 * 2048; i += NTHR) {
        const int which = i >> 11, ss = (i >> 10) & 1, col = i & 1023; const int mr = min(8, mr_lo + which);
        const int mi = mr * NMOD + (ss == 0 ? D : 0) + col;
        float s = p.b_ada[(ss == 0 ? D : 0) + col];
#pragma unroll
        for (int ks = 0; ks < 8; ++ks) s += modp[(size_t)ks * 9 * NMOD + mi];
        tab[i] = ss == 0 ? p.g_norm[col] * (1.f + s) : s;
    }
    __syncthreads();
    bf16_t* H = (bf16_t*)(ws + WS_H);
    f32x4 nx[2][4];
#define P1_LOAD(dst, rowa_) do { _Pragma("unroll") for (int q = 0; q < 2; ++q) { const int row = min((rowa_) + q * NWAVES, MALL - 1); \
            const float* xr = row < MLAT ? p.x + (size_t)row * D : p.ctx + (size_t)(row - MLAT) * D; \
            _Pragma("unroll") for (int j = 0; j < 4; ++j) dst[q][j] = ((const f32x4*)xr)[F.lane + 64 * j]; } } while (0)
    P1_LOAD(nx, r0 + F.wave);
    for (int rowa = r0 + F.wave; rowa < r1; rowa += 2 * NWAVES) {
        f32x4 v[2][4]; float ssq[2];
#pragma unroll
        for (int q = 0; q < 2; ++q)
#pragma unroll
            for (int j = 0; j < 4; ++j) v[q][j] = nx[q][j];
        if (rowa + 2 * NWAVES < r1) P1_LOAD(nx, rowa + 2 * NWAVES);
#pragma unroll
        for (int q = 0; q < 2; ++q) { float s = 0.f;
#pragma unroll
            for (int j = 0; j < 4; ++j) s += v[q][j].x * v[q][j].x + v[q][j].y * v[q][j].y + v[q][j].z * v[q][j].z + v[q][j].w * v[q][j].w;
            ssq[q] = wave_sum(s); }
#pragma unroll
        for (int q = 0; q < 2; ++q) { const int row = rowa + q * NWAVES; if (row < r1) {
            const int mr = row < MLAT ? (row >> 12) : 8; const LAS float* tb = tab + (mr - mr_lo) * 2048;
            const float rstd = rsqrtf(ssq[q] * (1.f / D) + EPS);
#pragma unroll
            for (int j = 0; j < 4; ++j) { const int col = (F.lane + 64 * j) * 4;
                const f32x4 sc = *(const LAS f32x4*)(tb + col), sh = *(const LAS f32x4*)(tb + 1024 + col);
                const f32x4 y = (v[q][j] * rstd) * sc + sh;
                u32x2 o; o.x = pk2(y.x, y.y); o.y = pk2(y.z, y.w);
                *(u32x2*)(H + (size_t)row * D + col) = o; } } }
    }
#undef P1_LOAD
}

struct EpiQKVFast {
    static constexpr bool PERM = true, AFTER_DRAIN = false;
    unsigned char* ws;
    __device__ __forceinline__ void operator()(const pg8::f32x4 (&acc)[2][2][4][2], const pg8::Unit& u, int wr, int wc, int fr, int fq) const {
        const bool lat = u.pm < 128;
        const int kind = u.pn >> 1;
        if (!lat && (kind == 0 || kind == 3)) return;
        const int b = lat ? (u.pm >> 4) : (u.pm - 128);
        const int tb = lat ? (u.pm & 15) * 256 : 0;
        const float* rope = (const float*)(ws + WS_ROPE);
#pragma unroll
        for (int bj = 0; bj < 2; ++bj) {
            const int cc = (u.pn & 1) * 256 + bj * 128 + wc * 32 + 8 * fq;
#pragma unroll
            for (int ai = 0; ai < 2; ++ai)
#pragma unroll
                for (int m = 0; m < 4; ++m) {
                    const int rowin = ai * 128 + wr * 64 + m * 16 + fr;
                    const int t = tb + rowin;
                    const int j = lat ? 256 + t : rowin;
                    f32x4 v0 = acc[ai][bj][m][0], v1 = acc[ai][bj][m][1];
                    bf16_t* dst;
                    if (kind == 0) { dst = (bf16_t*)(ws + WS_QA) + qa_idx(b, cc >> 6, t, cc & 63); v0 = v0 * C2; v1 = v1 * C2; }
                    else if (kind == 1) dst = (bf16_t*)(ws + WS_KA) + ka_idx(b, cc >> 6, j, cc & 63);
                    else if (kind == 2) dst = (bf16_t*)(ws + WS_VA) + va_idx(b, cc >> 6, j, cc & 63);
                    else if (kind == 5) dst = (bf16_t*)(ws + WS_VD) + vd_idx(b, cc >> 7, j, cc & 127);
                    else {
                        const int mm = cc >> 8, h = (cc >> 6) & 3, d = cc & 63;
                        if (lat) { const int i0 = d >> 1; const int pos = i0 < 16 ? (t >> 6) : (t & 63); const float* rp = rope + (pos * 16 + (i0 & 15)) * 2;
                            const f32x4 r0 = *(const f32x4*)rp, r1 = *(const f32x4*)(rp + 4);
                            f32x4 a0, a1;
                            a0.x = v0.x * r0.x - v0.y * r0.y; a0.y = v0.x * r0.y + v0.y * r0.x; a0.z = v0.z * r0.z - v0.w * r0.w; a0.w = v0.z * r0.w + v0.w * r0.z;
                            a1.x = v1.x * r1.x - v1.y * r1.y; a1.y = v1.x * r1.y + v1.y * r1.x; a1.z = v1.z * r1.z - v1.w * r1.w; a1.w = v1.z * r1.w + v1.w * r1.z;
                            v0 = a0; v1 = a1; }
                        if (kind == 3) { dst = (bf16_t*)(ws + WS_QD) + qd_idx(b, mm, h, t, d); v0 = v0 * C2; v1 = v1 * C2; }
                        else dst = (bf16_t*)(ws + WS_KD) + kd_idx(b, mm, h, j, d);
                    }
                    pg8::u32x4 w; w.x = pg8::cvt_pk_bf16(v0[0], v0[1]); w.y = pg8::cvt_pk_bf16(v0[2], v0[3]); w.z = pg8::cvt_pk_bf16(v1[0], v1[1]); w.w = pg8::cvt_pk_bf16(v1[2], v1[3]);
                    *(pg8::u32x4*)dst = w;
                }
        }
    }
};


struct EpiQ2Frag {
    static constexpr bool PERM = true, AFTER_DRAIN = false;
    bf16_t* O;
    __device__ __forceinline__ void operator()(const pg8::f32x4 (&acc)[2][2][4][2], const pg8::Unit& u, int wr, int wc, int fr, int fq) const {
        const int h = u.pn;
#pragma unroll
        for (int bj = 0; bj < 2; ++bj) {
            const int c8 = wc * 4 + fq;
#pragma unroll
            for (int ai = 0; ai < 2; ++ai)
#pragma unroll
                for (int m = 0; m < 4; ++m) {
                    const int row = u.pm * 256 + ai * 128 + wr * 64 + m * 16 + fr;
                    const size_t idx = ((((((size_t)(row >> 5) * 8 + h) * 2 + bj) * 8 + (c8 >> 1)) * 2 + (c8 & 1)) * 32 + (row & 31)) * 8;
                    const f32x4 v0 = acc[ai][bj][m][0], v1 = acc[ai][bj][m][1];
                    pg8::u32x4 w; w.x = pg8::cvt_pk_bf16(v0[0], v0[1]); w.y = pg8::cvt_pk_bf16(v0[2], v0[3]); w.z = pg8::cvt_pk_bf16(v1[0], v1[1]); w.w = pg8::cvt_pk_bf16(v1[2], v1[3]);
                    *(pg8::u32x4*)(O + idx) = w;
                }
        }
    }
};

__device__ __forceinline__ void p5_rows2(Frame& F, const Params& p) {
    unsigned char* ws = p.ws;
    const float* mod = (const float*)(ws + WS_MOD);
    const bf16_t* YO = (const bf16_t*)(ws + WS_YO);
    bf16_t* H2 = (bf16_t*)(ws + WS_H2);
    const int gw = F.bid * NWAVES + F.wave, NGW = F.G * NWAVES;
    const int rows_per = (MLAT + NGW - 1) / NGW;
    const int rend = min(MLAT, (gw + 1) * rows_per);
    f32x4 nxx[2][4]; u32x2 nxy[2][4];
#define P5_LOAD(rowa_) do { _Pragma("unroll") for (int q = 0; q < 2; ++q) { const int row = min((rowa_) + q, MLAT - 1); \
            _Pragma("unroll") for (int j = 0; j < 4; ++j) { nxx[q][j] = ((const f32x4*)(p.x + (size_t)row * D))[F.lane + 64 * j]; nxy[q][j] = ((const u32x2*)(YO + (size_t)row * D))[F.lane + 64 * j]; } } } while (0)
    P5_LOAD(gw * rows_per);
    for (int rowa = gw * rows_per; rowa < rend; rowa += 2) {
        f32x4 xv[2][4], yv[2][4]; float ssq[2];
#pragma unroll
        for (int q = 0; q < 2; ++q)
#pragma unroll
            for (int j = 0; j < 4; ++j) { xv[q][j] = nxx[q][j]; const u32x2 yw = nxy[q][j]; yv[q][j] = (f32x4){bflo(yw.x), bfhi(yw.x), bflo(yw.y), bfhi(yw.y)}; }
        if (rowa + 2 < rend) P5_LOAD(rowa + 2);
#pragma unroll
        for (int q = 0; q < 2; ++q) { float s = 0.f;
#pragma unroll
            for (int j = 0; j < 4; ++j) s += yv[q][j].x * yv[q][j].x + yv[q][j].y * yv[q][j].y + yv[q][j].z * yv[q][j].z + yv[q][j].w * yv[q][j].w;
            ssq[q] = wave_sum(s); }
#pragma unroll
        for (int q = 0; q < 2; ++q) { const int row = rowa + q; if (row < MLAT) {
            const int b = row >> 12; const float* mb = mod + b * NMOD;
            const float rstd = rsqrtf(ssq[q] * (1.f / D) + EPS);
            float s2 = 0.f;
#pragma unroll
            for (int j = 0; j < 4; ++j) { const int col = (F.lane + 64 * j) * 4;
                const f32x4 g1 = *(const f32x4*)(p.g_norm + D + col), gt1 = *(const f32x4*)(mb + 2 * D + col);
                xv[q][j] = xv[q][j] + gt1 * (yv[q][j] * rstd * g1);
                *(f32x4*)(p.out + (size_t)row * D + col) = xv[q][j];
                s2 += xv[q][j].x * xv[q][j].x + xv[q][j].y * xv[q][j].y + xv[q][j].z * xv[q][j].z + xv[q][j].w * xv[q][j].w; }
            const float rstd2 = rsqrtf(wave_sum(s2) * (1.f / D) + EPS);
#pragma unroll
            for (int j = 0; j < 4; ++j) { const int col = (F.lane + 64 * j) * 4;
                const f32x4 g2 = *(const f32x4*)(p.g_norm + 2 * D + col), sh2 = *(const f32x4*)(mb + 3 * D + col), sc2 = *(const f32x4*)(mb + 4 * D + col);
                const f32x4 y = (xv[q][j] * rstd2 * g2) * (sc2 + 1.f) + sh2;
                u32x2 o; o.x = pk2(y.x, y.y); o.y = pk2(y.z, y.w);
                *(u32x2*)(H2 + (size_t)row * D + col) = o; } } }
    }
#undef P5_LOAD
}

template <int J> __device__ __forceinline__ unsigned lane_xor(unsigned x, int lane) {
    if (J == 1) return (unsigned)__builtin_amdgcn_update_dpp(0, (int)x, 0xB1, 0xf, 0xf, false);
    if (J == 2) return (unsigned)__builtin_amdgcn_update_dpp(0, (int)x, 0x4E, 0xf, 0xf, false);
    if (J == 4) { const unsigned a = (unsigned)__builtin_amdgcn_update_dpp(0, (int)x, 0x104, 0xf, 0xf, false),
                                 b = (unsigned)__builtin_amdgcn_update_dpp(0, (int)x, 0x114, 0xf, 0xf, false);
                  return (lane & 4) ? b : a; }
    if (J == 8) return (unsigned)__builtin_amdgcn_update_dpp(0, (int)x, 0x128, 0xf, 0xf, false);
    if (J == 16) { auto r = __builtin_amdgcn_permlane16_swap(x, x, false, false); return (lane & 16) ? r[0] : r[1]; }
    auto r = __builtin_amdgcn_permlane32_swap(x, x, false, false); return (lane & 32) ? r[0] : r[1];
}
template <int K2, int J> __device__ __forceinline__ void bitonic_step128(unsigned& key0, unsigned& key1, int lane) {
    if (J == 64) { const unsigned lo = key0 < key1 ? key0 : key1, hi_ = key0 < key1 ? key1 : key0; key0 = lo; key1 = hi_; }
    else {
        const unsigned p0_ = lane_xor<J>(key0, lane), p1_ = lane_xor<J>(key1, lane);
        const bool lower = (lane & J) == 0;
        const bool asc0 = K2 == 128 ? true : ((lane & K2) == 0), asc1 = K2 == 128 ? true : (((64 + lane) & K2) == 0);
        const bool kmin0 = lower == asc0, kmin1 = lower == asc1;
        key0 = kmin0 ? (key0 < p0_ ? key0 : p0_) : (key0 < p0_ ? p0_ : key0);
        key1 = kmin1 ? (key1 < p1_ ? key1 : p1_) : (key1 < p1_ ? p1_ : key1);
    }
}
__device__ __forceinline__ void sort128_asc(unsigned& k0, unsigned& k1, int lane) {
    bitonic_step128<2, 1>(k0, k1, lane);
    bitonic_step128<4, 2>(k0, k1, lane); bitonic_step128<4, 1>(k0, k1, lane);
    bitonic_step128<8, 4>(k0, k1, lane); bitonic_step128<8, 2>(k0, k1, lane); bitonic_step128<8, 1>(k0, k1, lane);
    bitonic_step128<16, 8>(k0, k1, lane); bitonic_step128<16, 4>(k0, k1, lane); bitonic_step128<16, 2>(k0, k1, lane); bitonic_step128<16, 1>(k0, k1, lane);
    bitonic_step128<32, 16>(k0, k1, lane); bitonic_step128<32, 8>(k0, k1, lane); bitonic_step128<32, 4>(k0, k1, lane); bitonic_step128<32, 2>(k0, k1, lane); bitonic_step128<32, 1>(k0, k1, lane);
    bitonic_step128<64, 32>(k0, k1, lane); bitonic_step128<64, 16>(k0, k1, lane); bitonic_step128<64, 8>(k0, k1, lane); bitonic_step128<64, 4>(k0, k1, lane); bitonic_step128<64, 2>(k0, k1, lane); bitonic_step128<64, 1>(k0, k1, lane);
    bitonic_step128<128, 64>(k0, k1, lane); bitonic_step128<128, 32>(k0, k1, lane); bitonic_step128<128, 16>(k0, k1, lane); bitonic_step128<128, 8>(k0, k1, lane); bitonic_step128<128, 4>(k0, k1, lane); bitonic_step128<128, 2>(k0, k1, lane); bitonic_step128<128, 1>(k0, k1, lane);
}
__device__ __forceinline__ float e2m3_val(int k) { return k < 8 ? (float)k * 0.125f : ldexpf(1.f + (float)(k & 7) * 0.125f, (k >> 3) - 1); }
__device__ __forceinline__ int e2m3_idx(float x) { if (x < 1.f) return (int)(x * 8.f + 0.5f); const int e = x >= 4.f ? 2 : (x >= 2.f ? 1 : 0); return 8 * (e + 1) + (int)((x / (float)(1 << e) - 1.f) * 8.f + 0.5f); }
__device__ __forceinline__ float sum8(float v) {
    v += __uint_as_float((unsigned)__builtin_amdgcn_update_dpp(0, (int)__float_as_uint(v), 0xB1, 0xf, 0xf, false));
    v += __uint_as_float((unsigned)__builtin_amdgcn_update_dpp(0, (int)__float_as_uint(v), 0x4E, 0xf, 0xf, false));
    v += __uint_as_float((unsigned)__builtin_amdgcn_update_dpp(0, (int)__float_as_uint(v), 0x141, 0xf, 0xf, false));
    return v;
}
template <int MODE> __device__ __forceinline__ void p8_gather(Frame& F, const Params& p, const XcdBarrier& bar) {
    unsigned char* ws = p.ws;
    const bf16_t* H2 = (const bf16_t*)(ws + WS_H2); const unsigned char* U6 = ws + WS_UB; const unsigned char* V6 = ws + WS_VB;
    const int* EX = (const int*)(ws + WS_EXP); const float* GT = (const float*)(ws + WS_GATE); const float* SU = (const float*)(ws + WS_SU); const float* mod = (const float*)(ws + WS_MOD);
    const int lane = F.lane, l5 = lane & 31, b5 = (lane >> 5) & 1, b4 = (lane >> 4) & 1, b3 = (lane >> 3) & 1;
    const int ent = 2 * (2 * b4 + b3) + b5;
    LAS float* scr = (LAS float*)(F.lds + F.wave * 8192);
    int sw4;
    { const unsigned cw = __builtin_amdgcn_cvt_scalef32_pk_fp4_f32(0u, 1.0f, 2.0f, 1.0f, 0); const f32x2 cr = __builtin_amdgcn_cvt_scalef32_pk_f32_fp4(cw, 1.0f, 0);
      sw4 = __builtin_amdgcn_readfirstlane(cr.x == 1.0f ? 0 : 1); }
    unsigned* ctr = (unsigned*)(ws + WS_CTL) + CW_P8CTR + (MODE != 0 ? 16 : 0);
    int cnext = 0;
    if (lane == 0) cnext = (int)__hip_atomic_fetch_add(ctr, 1u, __ATOMIC_RELAXED, __HIP_MEMORY_SCOPE_AGENT);
    cnext = __builtin_amdgcn_readfirstlane(cnext);
    for (;;) {
        const int t = cnext;
        if (t >= MLAT) break;
        if (lane == 0) cnext = (int)__hip_atomic_fetch_add(ctr, 1u, __ATOMIC_RELAXED, __HIP_MEMORY_SCOPE_AGENT);
        const size_t tb_ = (size_t)t * 128;
        unsigned key0 = ((unsigned)EX[tb_ + lane] << 7) | (unsigned)lane, key1 = ((unsigned)EX[tb_ + 64 + lane] << 7) | (unsigned)(64 + lane);
        f32x2 hv2[16]; f32x32 acc;
        { const u32x4* hp = (const u32x4*)(H2 + (size_t)t * D + l5 * 32);
#pragma unroll
          for (int j = 0; j < 4; ++j) { const u32x4 w = hp[j];
              const float e0_ = bflo(w.x), e1_ = bfhi(w.x), e2_ = bflo(w.y), e3_ = bfhi(w.y), e4_ = bflo(w.z), e5_ = bfhi(w.z), e6_ = bflo(w.w), e7_ = bfhi(w.w);
              hv2[4 * j + 0] = sw4 ? (f32x2){e1_, e0_} : (f32x2){e0_, e1_}; hv2[4 * j + 1] = sw4 ? (f32x2){e3_, e2_} : (f32x2){e2_, e3_};
              hv2[4 * j + 2] = sw4 ? (f32x2){e5_, e4_} : (f32x2){e4_, e5_}; hv2[4 * j + 3] = sw4 ? (f32x2){e7_, e6_} : (f32x2){e6_, e7_}; }
#pragma unroll
          for (int j = 0; j < 32; ++j) acc[j] = 0.f; }
        sort128_asc(key0, key1, lane);
        for (int bb = 0; bb < 16; ++bb) {
            const unsigned kreg = bb < 8 ? key0 : key1; const int lb = (bb & 7) * 8;
            const unsigned kmine = (unsigned)__shfl((int)kreg, lb + ent);
            const float gl = GT[tb_ + (kmine & 127u)], sl = SU[tb_ + (kmine & 127u)];
            u32x4 u4[4], v4[4];
#pragma unroll
            for (int pr = 0; pr < 4; ++pr) { const int eA = (int)((unsigned)__builtin_amdgcn_readlane((int)kreg, lb + 2 * pr) >> 7), eB = (int)((unsigned)__builtin_amdgcn_readlane((int)kreg, lb + 2 * pr + 1) >> 7);
                const int e = (b5 ? eB : eA) & (MODE == 1 ? 1023 : (MODE == 3 ? 7 : 0xFFFF));
                u4[pr] = *(const u32x4*)(U6 + (size_t)e * 512 + l5 * 16); v4[pr] = *(const u32x4*)(V6 + (size_t)e * 512 + l5 * 16); }
            float d[4];
#pragma unroll
            for (int pr = 0; pr < 4; ++pr) { f32x2 s = (f32x2){0.f, 0.f};
#pragma unroll
                for (int j = 0; j < 4; ++j) {
                    s += hv2[4 * j + 0] * __builtin_amdgcn_cvt_scalef32_pk_f32_fp4(u4[pr][j], 1.0f, 0); s += hv2[4 * j + 1] * __builtin_amdgcn_cvt_scalef32_pk_f32_fp4(u4[pr][j], 1.0f, 1);
                    s += hv2[4 * j + 2] * __builtin_amdgcn_cvt_scalef32_pk_f32_fp4(u4[pr][j], 1.0f, 2); s += hv2[4 * j + 3] * __builtin_amdgcn_cvt_scalef32_pk_f32_fp4(u4[pr][j], 1.0f, 3); }
                d[pr] = s.x + s.y; asm volatile("" : "+v"(d[pr])); }
            float r2[2], r1;
#pragma unroll
            for (int i = 0; i < 2; ++i) { auto rr = __builtin_amdgcn_permlane16_swap(__float_as_uint(d[i]), __float_as_uint(d[i + 2]), false, false); r2[i] = __uint_as_float(rr[0]) + __uint_as_float(rr[1]); }
            { const float keep = b3 ? r2[1] : r2[0], send = b3 ? r2[0] : r2[1]; r1 = keep + __uint_as_float((unsigned)__builtin_amdgcn_update_dpp(0, (int)__float_as_uint(send), 0x128, 0xf, 0xf, false)); }
            r1 = sum8(r1);
            const float pre = r1 * sl;
            float act;
            { const float av = fabsf(pre), dd = av * 0.2316418882f + 1.0f; const float tt = __builtin_amdgcn_rcpf(dd);
              float q = tt * 0.5307027145f + (-0.7265760135f); q = q * tt + 0.7107068705f; q = q * tt + (-0.142248368f); q = q * tt + 0.127414796f; q = q * tt;
              const float ee = __builtin_amdgcn_exp2f((pre * pre) * (-0.72134752044f));
              const float mm = pre * (q * ee); act = pre < 0.f ? mm : pre - mm; }
            const float cfl = gl * act;
#pragma unroll
            for (int pr = 0; pr < 4; ++pr) {
                const float cfA = __uint_as_float((unsigned)__builtin_amdgcn_readlane((int)__float_as_uint(cfl), (pr >> 1) * 16 + (pr & 1) * 8));
                const float cfB = __uint_as_float((unsigned)__builtin_amdgcn_readlane((int)__float_as_uint(cfl), 32 + (pr >> 1) * 16 + (pr & 1) * 8));
                const float cf = b5 ? cfB : cfA;
#pragma unroll
                for (int j = 0; j < 4; ++j)
#pragma unroll
                    for (int bsel = 0; bsel < 4; ++bsel) { const f32x2 rv = bsel == 0 ? __builtin_amdgcn_cvt_scalef32_pk_f32_fp4(v4[pr][j], 1.0f, 0) : bsel == 1 ? __builtin_amdgcn_cvt_scalef32_pk_f32_fp4(v4[pr][j], 1.0f, 1)
                            : bsel == 2 ? __builtin_amdgcn_cvt_scalef32_pk_f32_fp4(v4[pr][j], 1.0f, 2) : __builtin_amdgcn_cvt_scalef32_pk_f32_fp4(v4[pr][j], 1.0f, 3);
                        acc[8 * j + 2 * bsel] += cf * rv.x; acc[8 * j + 2 * bsel + 1] += cf * rv.y; }
                asm volatile("" : "+v"(acc));
            }
        }
#pragma unroll
        for (int j = 0; j < 32; ++j) { auto rr = __builtin_amdgcn_permlane32_swap(__float_as_uint(acc[j]), __float_as_uint(acc[j]), false, false); scr[(j ^ sw4) * 64 + lane] = __uint_as_float(rr[0]) + __uint_as_float(rr[1]); }
        float at[16]; float s = 0.f;
#pragma unroll
        for (int k = 0; k < 16; ++k) { at[k] = scr[(16 * b5 + k) * 64 + lane]; s += at[k] * at[k]; }
        const float rstd = rsqrtf(wave_sum(s) * (1.f / D) + EPS);
        const float* mb = mod + (t >> 12) * NMOD + 5 * D; const float* g3 = p.g_norm + 3 * D;
#pragma unroll
        for (int j = 0; j < 4; ++j) { const int col = l5 * 32 + b5 * 16 + j * 4;
            float* op = p.out + (size_t)t * D + col;
            const f32x4 x0 = *(const f32x4*)op, ga = *(const f32x4*)(g3 + col), ta = *(const f32x4*)(mb + col);
            const f32x4 pa = (f32x4){at[4 * j], at[4 * j + 1], at[4 * j + 2], at[4 * j + 3]};
            if (MODE == 0 || rstd == 123456.f) *(f32x4*)op = x0 + ta * (pa * rstd * ga); }
        cnext = __builtin_amdgcn_readfirstlane(cnext);
    }
}

namespace att {
typedef short bf16x8 __attribute__((ext_vector_type(8)));
typedef short s16x4 __attribute__((ext_vector_type(4)));
typedef float f32x16 __attribute__((ext_vector_type(16)));
typedef __attribute__((address_space(3))) const unsigned char* lcp;
typedef __attribute__((address_space(3))) unsigned char* lp;
constexpr int NA_SLOT = 16384, NA_BIAS_OFF = 32768, WSF_OFF = 155648;
constexpr int DF_SLOT = 32768;
constexpr float THRL = 8.f;

__device__ __forceinline__ int crow(int r, int hi) { return (r & 3) + 8 * (r >> 2) + 4 * hi; }
__device__ __forceinline__ s16x4 vtr(lcp p) { return __builtin_bit_cast(s16x4, __builtin_amdgcn_ds_read_tr16_b64_v4i16((__attribute__((address_space(3))) s16x4*)p)); }
typedef float f32x2_t __attribute__((ext_vector_type(2))); typedef __bf16 bf16x2v_t __attribute__((ext_vector_type(2)));
__device__ __forceinline__ unsigned cvtpk(float lo, float hi) { f32x2_t v = {lo, hi}; bf16x2v_t b = __builtin_convertvector(v, bf16x2v_t); return __builtin_bit_cast(unsigned, b); }
__device__ __forceinline__ float swap_half(float v) { auto rr = __builtin_amdgcn_permlane32_swap(__float_as_uint(v), __float_as_uint(v), false, false); return __uint_as_float(rr[0]) == v ? __uint_as_float(rr[1]) : __uint_as_float(rr[0]); }
__device__ __forceinline__ void dma16(const void* gsrc, lp lds_dst) {
    unsigned keep; const unsigned dst = (unsigned)__builtin_amdgcn_readfirstlane((int)(unsigned)(size_t)lds_dst);
    asm volatile("s_mov_b32 %0, m0\n\ts_mov_b32 m0, %2\n\ts_nop 0\n\tglobal_load_lds_dwordx4 %1, off\n\ts_mov_b32 m0, %0" : "=&s"(keep) : "v"(gsrc), "s"(dst) : "memory");
}
__device__ __forceinline__ float max3f(float a, float b, float c) { float r; asm("v_max3_f32 %0, %1, %2, %3" : "=v"(r) : "v"(a), "v"(b), "v"(c)); return r; }
__device__ __forceinline__ float rowmax32(const f32x16& p0, const f32x16& p1) {
    float a = max3f(p0[0], p0[1], p1[0]), b = max3f(p0[2], p0[3], p1[1]); a = max3f(a, p1[2], p1[3]);
#pragma unroll
    for (int r = 4; r < 16; r += 4) { a = max3f(a, p0[r], p0[r + 1]); b = max3f(b, p0[r + 2], p0[r + 3]); a = max3f(a, p1[r], p1[r + 1]); b = max3f(b, p1[r + 2], p1[r + 3]); }
    float m = max3f(a, b, b);
    auto rr = __builtin_amdgcn_permlane32_swap(__float_as_uint(m), __float_as_uint(m), false, false);
    return max3f(__uint_as_float(rr[0]), __uint_as_float(rr[1]), __uint_as_float(rr[1]));
}

typedef __bf16 bf16x2_t __attribute__((ext_vector_type(2)));
__device__ __forceinline__ float psum_bf16(const u32x4 (&pw)[4], float acc) {
    const bf16x2_t ones = __builtin_bit_cast(bf16x2_t, 0x3F803F80u); float a0 = acc, a1 = 0.f;
#pragma unroll
    for (int k = 0; k < 4; ++k) { a0 = __builtin_amdgcn_fdot2_f32_bf16(__builtin_bit_cast(bf16x2_t, pw[k][0]), ones, a0, false); a1 = __builtin_amdgcn_fdot2_f32_bf16(__builtin_bit_cast(bf16x2_t, pw[k][1]), ones, a1, false);
        a0 = __builtin_amdgcn_fdot2_f32_bf16(__builtin_bit_cast(bf16x2_t, pw[k][2]), ones, a0, false); a1 = __builtin_amdgcn_fdot2_f32_bf16(__builtin_bit_cast(bf16x2_t, pw[k][3]), ones, a1, false); }
    return a0 + a1;
}
template <int NDV> struct FlashState { float mhat, l; f32x16 negm; f32x16 o[NDV]; };

template <int NDV, bool BIAS>
__device__ __forceinline__ void flash_tile(FlashState<NDV>& st, const bf16x8 (&qr)[4], lcp Kslot, lcp Vslot, lcp Bslot, const bf16x8 (&qoh)[2],
                                           __attribute__((address_space(3))) float* wsf, int r32, int hi, int lane, bool first) {
    f32x16 p0 = st.negm, p1 = st.negm;
    lcp kb = Kslot + hi * 1024 + r32 * 16;
    bf16x8 kf[8], bf_[4];
#pragma unroll
    for (int d0 = 0; d0 < 4; ++d0) { kf[2 * d0] = *(const __attribute__((address_space(3))) bf16x8*)(kb + d0 * 2048); kf[2 * d0 + 1] = *(const __attribute__((address_space(3))) bf16x8*)(kb + d0 * 2048 + 512); }
    if (BIAS) { lcp bb = Bslot + hi * 1024 + r32 * 16;
#pragma unroll
        for (int e = 0; e < 2; ++e) { bf_[2 * e] = *(const __attribute__((address_space(3))) bf16x8*)(bb + e * 2048); bf_[2 * e + 1] = *(const __attribute__((address_space(3))) bf16x8*)(bb + e * 2048 + 512); } }
    lcp vb = Vslot + ((lane >> 4) & 1) * 32 + (lane & 3) * 8 + (4 * hi + ((lane & 15) >> 2)) * 64;
    s16x4 va[8], vn[8];
#pragma unroll
    for (int ks = 0; ks < 4; ++ks) { va[2 * ks] = vtr(vb + ks * 1024); va[2 * ks + 1] = vtr(vb + ks * 1024 + 512); }
#pragma unroll
    for (int d0 = 0; d0 < 4; ++d0) { p0 = __builtin_amdgcn_mfma_f32_32x32x16_bf16(kf[2 * d0], qr[d0], p0, 0, 0, 0); p1 = __builtin_amdgcn_mfma_f32_32x32x16_bf16(kf[2 * d0 + 1], qr[d0], p1, 0, 0, 0); }
    if (BIAS) {
#pragma unroll
        for (int e = 0; e < 2; ++e) { p0 = __builtin_amdgcn_mfma_f32_32x32x16_bf16(bf_[2 * e], qoh[e], p0, 0, 0, 0); p1 = __builtin_amdgcn_mfma_f32_32x32x16_bf16(bf_[2 * e + 1], qoh[e], p1, 0, 0, 0); }
    }
    asm volatile("s_nop 15\n\ts_nop 7" : "+v"(p0), "+v"(p1));
    const float rm = rowmax32(p0, p1);
    if (first) {
        st.mhat += rm;
#pragma unroll
        for (int r = 0; r < 16; ++r) { p0[r] -= rm; p1[r] -= rm; st.negm[r] = -st.mhat; }
    } else if (__any(rm > THRL)) {
        const float dl = fmaxf(rm, 0.f); const float alpha = __builtin_amdgcn_exp2f(-dl); st.mhat += dl; st.l *= alpha;
        if (hi == 0) wsf[r32] = alpha;
        asm volatile("s_waitcnt lgkmcnt(0)" ::: "memory");
        float al[16];
#pragma unroll
        for (int r = 0; r < 16; ++r) al[r] = wsf[crow(r, hi)];
#pragma unroll
        for (int d = 0; d < NDV; ++d)
#pragma unroll
            for (int r = 0; r < 16; ++r) st.o[d][r] *= al[r];
#pragma unroll
        for (int r = 0; r < 16; ++r) { p0[r] -= dl; p1[r] -= dl; st.negm[r] = -st.mhat; }
    }
    float sacc = 0.f;
#pragma unroll
    for (int r = 0; r < 16; ++r) { p0[r] = __builtin_amdgcn_exp2f(p0[r]); p1[r] = __builtin_amdgcn_exp2f(p1[r]); sacc += p0[r] + p1[r]; }
    st.l += sacc;
    u32x4 pw[4];
#pragma unroll
    for (int i = 0; i < 4; ++i) { pw[0][i] = cvtpk(p0[2 * i], p0[2 * i + 1]); pw[1][i] = cvtpk(p0[8 + 2 * i], p0[8 + 2 * i + 1]); pw[2][i] = cvtpk(p1[2 * i], p1[2 * i + 1]); pw[3][i] = cvtpk(p1[8 + 2 * i], p1[8 + 2 * i + 1]); }
    __builtin_amdgcn_sched_barrier(0);
#pragma unroll
    for (int d0 = 0; d0 < NDV; ++d0) {
#pragma unroll
        for (int ks = 0; ks < 4; ++ks) {
            if (d0 < NDV - 1) { vn[2 * ks] = vtr(vb + (d0 + 1) * 4096 + ks * 1024); vn[2 * ks + 1] = vtr(vb + (d0 + 1) * 4096 + ks * 1024 + 512); }
            const bf16x8 vf = (bf16x8){va[2 * ks][0], va[2 * ks][1], va[2 * ks][2], va[2 * ks][3], va[2 * ks + 1][0], va[2 * ks + 1][1], va[2 * ks + 1][2], va[2 * ks + 1][3]};
            st.o[d0] = __builtin_amdgcn_mfma_f32_32x32x16_bf16(__builtin_bit_cast(bf16x8, pw[ks]), vf, st.o[d0], 0, 0, 0);
            __builtin_amdgcn_sched_barrier(0);
        }
#pragma unroll
        for (int i = 0; i < 8; ++i) va[i] = vn[i];
    }
}

constexpr int NA2_SLOT = 16384, NA2_BIAS_OFF = 65536;
__device__ __forceinline__ void na_units(Frame& F, const Params& p) {
    unsigned char* ws = p.ws;
    const bf16_t* QA = (const bf16_t*)(ws + WS_QA); const bf16_t* KA = (const bf16_t*)(ws + WS_KA); const bf16_t* VA = (const bf16_t*)(ws + WS_VA);
    const bf16_t* BT = (const bf16_t*)(ws + WS_BIAST); bf16_t* Y = (bf16_t*)(ws + WS_Y);
    const int lane = F.lane, r32 = lane & 31, hi = lane >> 5, wave = F.wave;
    lp lds = (lp)F.lds;
    __attribute__((address_space(3))) float* wsf = (__attribute__((address_space(3))) float*)(lds + WSF_OFF) + wave * 64;
    const int upw = 1024 / F.G;
    int cur_h = -1, cur_lo = -1, cur_hi = -1;
    bf16x8 qoh[2];
#pragma unroll
    for (int e = 0; e < 2; ++e)
#pragma unroll
        for (int j = 0; j < 8; ++j) qoh[e][j] = (16 * e + 8 * hi + j == r32) ? (short)0x3F80 : (short)0;
    for (int ui = 0; ui < upw; ++ui) {
        const int u = F.bid * upw + ui, bh = u >> 4, rg = u & 15, b = bh >> 3, h = bh & 7;
        const int r0 = rg * 4, r = r0 + (wave >> 1), ch = wave & 1;
        int rs = r - 4; rs = rs < 0 ? 0 : (rs > 56 ? 56 : rs);
        int kr_lo = r0 - 4; kr_lo = kr_lo < 0 ? 0 : (kr_lo > 56 ? 56 : kr_lo);
        int kr_hi = r0 + 3 - 4; kr_hi = kr_hi < 0 ? 0 : (kr_hi > 56 ? 56 : kr_hi); kr_hi += 7;
        const int T = 4 + (kr_hi - kr_lo + 1);
        int dr_lo = 99, dr_hi = -1;
#pragma unroll
        for (int q = 0; q < 4; ++q) { int s_ = r0 + q - 4; s_ = s_ < 0 ? 0 : (s_ > 56 ? 56 : s_); const int a = s_ - (r0 + q) + 7; dr_lo = a < dr_lo ? a : dr_lo; dr_hi = a + 7 > dr_hi ? a + 7 : dr_hi; }
        const bf16_t* Kb = KA + (size_t)bh * NKT * 4096; const bf16_t* Vb = VA + (size_t)bh * NKT * 4096;
        if (h != cur_h || dr_lo != cur_lo || dr_hi != cur_hi) {
            cur_h = h; cur_lo = dr_lo; cur_hi = dr_hi;
            const unsigned char* src = (const unsigned char*)(BT + ((size_t)h * 15 + dr_lo) * 4096);
            const int npc = (dr_hi - dr_lo + 1) * 8;
            for (int pi = wave; pi < npc; pi += 8) dma16(src + pi * 1024 + lane * 16, lds + NA2_BIAS_OFF + pi * 1024);
        }
        bf16x8 qr[4];
        { const bf16_t* qp = QA + ((size_t)bh * SEQ + r * 64 + ch * 32 + r32) * 64 + hi * 8;
#pragma unroll
          for (int d0 = 0; d0 < 4; ++d0) qr[d0] = *(const bf16x8*)(qp + d0 * 16); }
#define NA_DMA(i_) do { const int tg_ = (i_) < 4 ? (i_) : (4 + kr_lo + (i_) - 4); lp sl_ = lds + ((i_) & 3) * NA2_SLOT; \
            dma16((const unsigned char*)(Kb + (size_t)tg_ * 4096) + wave * 1024 + lane * 16, sl_ + wave * 1024); \
            dma16((const unsigned char*)(Vb + (size_t)tg_ * 4096) + wave * 1024 + lane * 16, sl_ + 8192 + wave * 1024); } while (0)
        NA_DMA(0); NA_DMA(1);
        FlashState<2> st; st.mhat = 0.f; st.l = 0.f;
#pragma unroll
        for (int rr = 0; rr < 16; ++rr) st.negm[rr] = 0.f;
#pragma unroll
        for (int d = 0; d < 2; ++d)
#pragma unroll
            for (int rr = 0; rr < 16; ++rr) st.o[d][rr] = 0.f;
        for (int i = 0; i < T; ++i) {
            if (i + 1 < T) asm volatile("s_waitcnt vmcnt(2)" ::: "memory"); else asm volatile("s_waitcnt vmcnt(0)" ::: "memory");
            __syncthreads();
            if (i + 2 < T) NA_DMA(i + 2);
            lcp sl = (lcp)(lds + (i & 3) * NA2_SLOT);
            if (i < 4) flash_tile<2, false>(st, qr, sl, sl + 8192, sl, qoh, wsf, r32, hi, lane, i == 0);
            else { const int kr = kr_lo + (i - 4);
                if (kr >= rs && kr < rs + 8) { const int dr = kr - r + 7;
                    flash_tile<2, true>(st, qr, sl, sl + 8192, (lcp)(lds + NA2_BIAS_OFF + (dr - dr_lo) * 8192 + ch * 4096), qoh, wsf, r32, hi, lane, false); } }
        }
#undef NA_DMA
        float lt = st.l; { auto rr = __builtin_amdgcn_permlane32_swap(__float_as_uint(lt), __float_as_uint(lt), false, false); lt = __uint_as_float(rr[0]) + __uint_as_float(rr[1]); }
        if (hi == 0) wsf[32 + r32] = lt;
        asm volatile("s_waitcnt lgkmcnt(0)" ::: "memory");
        bf16_t* yb = Y + ((size_t)b * SEQ + r * 64 + ch * 32) * D + h * 64 + r32;
#pragma unroll
        for (int rr = 0; rr < 16; ++rr) { const float rl = __builtin_amdgcn_rcpf(wsf[32 + crow(rr, hi)]);
#pragma unroll
            for (int d0 = 0; d0 < 2; ++d0) yb[(size_t)crow(rr, hi) * D + d0 * 32] = (bf16_t)f2bf(st.o[d0][rr] * rl); }
        __syncthreads();
    }
}

template <int MODE> __device__ __forceinline__ void diff_units_v2(Frame& F, const Params& p) {
    unsigned char* ws = p.ws;
    const bf16_t* QD = (const bf16_t*)(ws + WS_QD); const bf16_t* KD = (const bf16_t*)(ws + WS_KD); const bf16_t* VD = (const bf16_t*)(ws + WS_VD);
    bf16_t* Y = (bf16_t*)(ws + WS_Y);
    const float lam = *(const float*)(ws + WS_LAM);
    const int lane = F.lane, r32 = lane & 31, hi = lane >> 5, wave = F.wave, map = wave >> 2, qg = wave & 3;
    lp lds = (lp)F.lds;
    __attribute__((address_space(3))) float* wsf = (__attribute__((address_space(3))) float*)(lds + WSF_OFF) + wave * 64;
    __attribute__((address_space(3))) float* X = (__attribute__((address_space(3))) float*)lds;
    const int upw = 1024 / F.G;
    const int koff = map * 8192 + hi * 1024 + r32 * 16;
    const int voff = 16384 + ((lane >> 4) & 1) * 32 + (lane & 3) * 8 + (4 * hi + ((lane & 15) >> 2)) * 64;
    for (int ui = 0; ui < upw; ++ui) {
        int bh, qb;
        if (F.G == 256) { bh = (F.bid & 7) * 4 + ui; qb = F.bid >> 3; } else { const int u = F.bid * upw + ui; bh = u >> 5; qb = u & 31; }
        const int b = bh >> 2, h = bh & 3;
        const unsigned char* K1 = (const unsigned char*)(KD + (size_t)((b * 2 + 0) * 4 + h) * NKT * 4096);
        const unsigned char* K2 = (const unsigned char*)(KD + (size_t)((b * 2 + 1) * 4 + h) * NKT * 4096);
        const unsigned char* Vg = (const unsigned char*)(VD + (size_t)bh * NKT * 8192);
#define DF_DMA(t, slot) do { if (MODE != 1 && MODE != 3) { lp sl_ = lds + (slot) * DF_SLOT; \
            dma16(K1 + (size_t)(t) * 8192 + wave * 1024 + lane * 16, sl_ + wave * 1024); \
            dma16(K2 + (size_t)(t) * 8192 + wave * 1024 + lane * 16, sl_ + 8192 + wave * 1024); \
            dma16(Vg + (size_t)(t) * 16384 + wave * 1024 + lane * 16, sl_ + 16384 + wave * 1024); \
            dma16(Vg + (size_t)(t) * 16384 + 8192 + wave * 1024 + lane * 16, sl_ + 24576 + wave * 1024); } } while (0)
        DF_DMA(0, 0); DF_DMA(1, 1);
        const int q0 = qb * 128 + qg * 32;
        bf16x8 qr[4];
        { const bf16_t* qp = QD + ((size_t)((b * 2 + map) * 4 + h) * SEQ + q0 + r32) * 64 + hi * 8;
#pragma unroll
          for (int d0 = 0; d0 < 4; ++d0) qr[d0] = *(const bf16x8*)(qp + d0 * 16); }
        float mhat = 0.f, lsum = 0.f; f32x16 o[4], negm;
#pragma unroll
        for (int d = 0; d < 4; ++d)
#pragma unroll
            for (int rr = 0; rr < 16; ++rr) o[d][rr] = 0.f;
        asm volatile("s_waitcnt vmcnt(0)" ::: "memory");
        __syncthreads();
        f32x16 s0, s1;
#pragma unroll
        for (int rr = 0; rr < 16; ++rr) { s0[rr] = 0.f; s1[rr] = 0.f; }
        { lcp kb = (lcp)(lds + koff);
#pragma unroll
          for (int d0 = 0; d0 < 4; ++d0) {
              const bf16x8 b0 = *(const __attribute__((address_space(3))) bf16x8*)(kb + d0 * 2048), b1 = *(const __attribute__((address_space(3))) bf16x8*)(kb + d0 * 2048 + 512);
              s0 = __builtin_amdgcn_mfma_f32_32x32x16_bf16(b0, qr[d0], s0, 0, 0, 0); s1 = __builtin_amdgcn_mfma_f32_32x32x16_bf16(b1, qr[d0], s1, 0, 0, 0); } }
        { asm volatile("s_nop 15\n\ts_nop 7" : "+v"(s0), "+v"(s1)); const float rm0 = rowmax32(s0, s1); mhat = rm0;
#pragma unroll
          for (int rr = 0; rr < 16; ++rr) { s0[rr] -= rm0; s1[rr] -= rm0; negm[rr] = -rm0; } }
        u32x4 pw[4];
#define EXP4(X, B) do { X[B] = __builtin_amdgcn_exp2f(X[B]); X[B + 1] = __builtin_amdgcn_exp2f(X[B + 1]); X[B + 2] = __builtin_amdgcn_exp2f(X[B + 2]); X[B + 3] = __builtin_amdgcn_exp2f(X[B + 3]); sacc += X[B]; asm("" : "+v"(sacc)); sacc += X[B + 1]; asm("" : "+v"(sacc)); sacc += X[B + 2]; asm("" : "+v"(sacc)); sacc += X[B + 3]; asm("" : "+v"(sacc)); } while (0)
#define STAGE_A(t_) do { \
            lcp nxt = (lcp)(lds + (((t_) + 1) & 3) * DF_SLOT); \
            bf16x8 kf[8]; \
            _Pragma("unroll") for (int d0 = 0; d0 < 4; ++d0) { kf[2 * d0] = *(const __attribute__((address_space(3))) bf16x8*)(nxt + koff + d0 * 2048); kf[2 * d0 + 1] = *(const __attribute__((address_space(3))) bf16x8*)(nxt + koff + d0 * 2048 + 512); } \
            asm volatile("s_nop 15\n\ts_nop 7" : "+v"(s0), "+v"(s1)); \
            const float rm = rowmax32(s0, s1); \
            if (__any(rm > THRL)) { \
                const float dl = fmaxf(rm, 0.f); const float alpha = __builtin_amdgcn_exp2f(-dl); mhat += dl; lsum *= alpha; \
                if (hi == 0) wsf[r32] = alpha; \
                asm volatile("s_waitcnt lgkmcnt(0)" ::: "memory"); \
                float al[16]; \
                _Pragma("unroll") for (int r = 0; r < 16; ++r) al[r] = wsf[crow(r, hi)]; \
                _Pragma("unroll") for (int d = 0; d < 4; ++d) _Pragma("unroll") for (int r = 0; r < 16; ++r) o[d][r] *= al[r]; \
                _Pragma("unroll") for (int r = 0; r < 16; ++r) { s0[r] -= dl; s1[r] -= dl; negm[r] = -mhat; } \
            } \
            f32x16 n0, n1; float sacc = 0.f; \
            __builtin_amdgcn_sched_barrier(0); \
            n0 = __builtin_amdgcn_mfma_f32_32x32x16_bf16(kf[0], qr[0], negm, 0, 0, 0); EXP4(s0, 0);  __builtin_amdgcn_sched_barrier(0); \
            n1 = __builtin_amdgcn_mfma_f32_32x32x16_bf16(kf[1], qr[0], negm, 0, 0, 0); EXP4(s0, 4);  __builtin_amdgcn_sched_barrier(0); \
            n0 = __builtin_amdgcn_mfma_f32_32x32x16_bf16(kf[2], qr[1], n0, 0, 0, 0); EXP4(s0, 8);  __builtin_amdgcn_sched_barrier(0); \
            n1 = __builtin_amdgcn_mfma_f32_32x32x16_bf16(kf[3], qr[1], n1, 0, 0, 0); EXP4(s0, 12); __builtin_amdgcn_sched_barrier(0); \
            n0 = __builtin_amdgcn_mfma_f32_32x32x16_bf16(kf[4], qr[2], n0, 0, 0, 0); EXP4(s1, 0);  __builtin_amdgcn_sched_barrier(0); \
            n1 = __builtin_amdgcn_mfma_f32_32x32x16_bf16(kf[5], qr[2], n1, 0, 0, 0); EXP4(s1, 4);  __builtin_amdgcn_sched_barrier(0); \
            n0 = __builtin_amdgcn_mfma_f32_32x32x16_bf16(kf[6], qr[3], n0, 0, 0, 0); EXP4(s1, 8);  __builtin_amdgcn_sched_barrier(0); \
            n1 = __builtin_amdgcn_mfma_f32_32x32x16_bf16(kf[7], qr[3], n1, 0, 0, 0); EXP4(s1, 12); __builtin_amdgcn_sched_barrier(0); \
            _Pragma("unroll") for (int i = 0; i < 4; ++i) { pw[0][i] = cvtpk(s0[2 * i], s0[2 * i + 1]); pw[1][i] = cvtpk(s0[8 + 2 * i], s0[8 + 2 * i + 1]); pw[2][i] = cvtpk(s1[2 * i], s1[2 * i + 1]); pw[3][i] = cvtpk(s1[8 + 2 * i], s1[8 + 2 * i + 1]); } \
            lsum += sacc; \
            s0 = n0; s1 = n1; \
        } while (0)
#define STAGE_B(tl_) do { \
            lcp vb = (lcp)(lds + ((tl_) & 3) * DF_SLOT) + voff; \
            s16x4 va[8], vn[8]; \
            _Pragma("unroll") for (int ks = 0; ks < 4; ++ks) { va[2 * ks] = vtr(vb + ks * 1024); va[2 * ks + 1] = vtr(vb + ks * 1024 + 512); } \
            __builtin_amdgcn_sched_barrier(0); \
            _Pragma("unroll") for (int d0 = 0; d0 < 4; ++d0) { \
                _Pragma("unroll") for (int ks = 0; ks < 4; ++ks) { \
                    if (d0 < 3) { vn[2 * ks] = vtr(vb + (d0 + 1) * 4096 + ks * 1024); vn[2 * ks + 1] = vtr(vb + (d0 + 1) * 4096 + ks * 1024 + 512); } \
                    const bf16x8 vf = (bf16x8){va[2 * ks][0], va[2 * ks][1], va[2 * ks][2], va[2 * ks][3], va[2 * ks + 1][0], va[2 * ks + 1][1], va[2 * ks + 1][2], va[2 * ks + 1][3]}; \
                    o[d0] = __builtin_amdgcn_mfma_f32_32x32x16_bf16(__builtin_bit_cast(bf16x8, pw[ks]), vf, o[d0], 0, 0, 0); \
                    __builtin_amdgcn_sched_barrier(0); \
                } \
                _Pragma("unroll") for (int i = 0; i < 8; ++i) va[i] = vn[i]; \
            } \
        } while (0)
        for (int t = 0; t < NKT; ++t) {
            if (t > 0) { asm volatile("s_waitcnt vmcnt(0)" ::: "memory"); if (MODE != 3) __syncthreads(); }
            if (t + 2 < NKT) DF_DMA(t + 2, (t + 2) & 3);
            if (MODE != 2) {
                if (map == 1 && t > 0) STAGE_B(t - 1);
                STAGE_A(t);
                if (map == 0) STAGE_B(t);
            }
        }
        if (MODE != 2 && map == 1) STAGE_B(NKT - 1);
#undef STAGE_A
#undef STAGE_B
#undef EXP4
#undef DF_DMA
        float lt = lsum; { auto rr = __builtin_amdgcn_permlane32_swap(__float_as_uint(lt), __float_as_uint(lt), false, false); lt = __uint_as_float(rr[0]) + __uint_as_float(rr[1]); }
        if (hi == 0) wsf[32 + r32] = lt;
        asm volatile("s_waitcnt lgkmcnt(0)" ::: "memory");
#pragma unroll
        for (int rr = 0; rr < 16; ++rr) { const float rl = __builtin_amdgcn_rcpf(wsf[32 + crow(rr, hi)]);
#pragma unroll
            for (int d = 0; d < 4; ++d) o[d][rr] *= rl; }
        __syncthreads();
        if (map == 1) {
#pragma unroll
            for (int d = 0; d < 4; ++d)
#pragma unroll
                for (int rr = 0; rr < 16; ++rr) X[((qg * 4 + d) * 16 + rr) * 64 + lane] = o[d][rr];
        }
        __syncthreads();
        if (map == 0 && (MODE == 0 || lam == 123456.f)) {
            float ss[16];
#pragma unroll
            for (int rr = 0; rr < 16; ++rr) { float s = 0.f;
#pragma unroll
                for (int d = 0; d < 4; ++d) { const float v = o[d][rr] - lam * X[((qg * 4 + d) * 16 + rr) * 64 + lane]; o[d][rr] = v; s += v * v; }
                ss[rr] = s; }
#pragma unroll
            for (int oo = 1; oo < 32; oo <<= 1)
#pragma unroll
                for (int rr = 0; rr < 16; ++rr) ss[rr] += __shfl_xor(ss[rr], oo);
            float g[4];
#pragma unroll
            for (int d = 0; d < 4; ++d) g[d] = p.diff_subln[d * 32 + r32] * (1.f - LAMBDA_INIT);
            bf16_t* yb = Y + ((size_t)b * SEQ + q0) * D + 512 + h * 128 + r32;
#pragma unroll
            for (int rr = 0; rr < 16; ++rr) { const float rn = rsqrtf(ss[rr] * (1.f / 128.f) + EPS);
#pragma unroll
                for (int d = 0; d < 4; ++d) yb[(size_t)crow(rr, hi) * D + d * 32] = (bf16_t)f2bf(o[d][rr] * rn * g[d]); }
        }
        __syncthreads();
    }
}
}

__device__ __forceinline__ void p3_attention(Frame& F, const Params& p) {
    att::na_units(F, p);
    att::diff_units_v2<0>(F, p);
}

namespace tk {
typedef short bf16x8 __attribute__((ext_vector_type(8)));
typedef float f32x16 __attribute__((ext_vector_type(16)));
constexpr int WLK_OFF = 65536;
__device__ __forceinline__ unsigned ord(float f) { const unsigned u = __float_as_uint(f); return u ^ ((unsigned)((int)u >> 31) | 0x80000000u); }
__device__ __forceinline__ float unord(unsigned o) { return __uint_as_float(o ^ ((o & 0x80000000u) ? 0x80000000u : 0xFFFFFFFFu)); }
__device__ __forceinline__ void cs_desc(unsigned& a, unsigned& b) { const unsigned mx = a > b ? a : b, mn = a > b ? b : a; a = mx; b = mn; }
__device__ __forceinline__ void sort16_desc(unsigned (&v)[16]) {
#pragma unroll
    for (int k = 2; k <= 16; k <<= 1)
#pragma unroll
        for (int j = k >> 1; j > 0; j >>= 1)
#pragma unroll
            for (int i = 0; i < 16; ++i) { const int l = i ^ j; if (l > i) { if ((i & k) == 0 || k == 16) cs_desc(v[i], v[l]); else cs_desc(v[l], v[i]); } }
}
__device__ __forceinline__ void bmerge16_desc(unsigned (&v)[16]) {
#pragma unroll
    for (int j = 8; j > 0; j >>= 1)
#pragma unroll
        for (int i = 0; i < 16; ++i) { const int l = i ^ j; if (l > i) cs_desc(v[i], v[l]); }
}
__device__ __forceinline__ void merge_top16(unsigned (&a)[16], const unsigned (&b)[16]) {
#pragma unroll
    for (int i = 0; i < 16; ++i) a[i] = a[i] > b[15 - i] ? a[i] : b[15 - i];
    bmerge16_desc(a);
}
__device__ __forceinline__ void top16_of_64x2(unsigned (&v0)[16], unsigned (&v1)[16], unsigned (&v2)[16], unsigned (&v3)[16]) {
    sort16_desc(v0); sort16_desc(v1); sort16_desc(v2); sort16_desc(v3);
    merge_top16(v0, v1); merge_top16(v2, v3); merge_top16(v0, v2);
    unsigned pb[16];
#pragma unroll
    for (int i = 0; i < 16; ++i) pb[i] = (unsigned)__shfl_xor((int)v0[i], 32);
    merge_top16(v0, pb);
}
}

__device__ __forceinline__ void p7_topk(Frame& F, const Params& p) {
    using namespace tk;
    unsigned char* ws = p.ws;
    const bf16_t* Q2 = (const bf16_t*)(ws + WS_Q2); const unsigned char* KI = (const unsigned char*)(ws + WS_KEYSI);
    int* EX = (int*)(ws + WS_EXP); float* GT = (float*)(ws + WS_GATE); float* SUo = (float*)(ws + WS_SU);
    const float* USC = (const float*)(ws + WS_USC); const float* VSC = (const float*)(ws + WS_VSC);
    const int lane = F.lane, r32 = lane & 31, hi = lane >> 5, wave = F.wave;
    att::lp lds = (att::lp)F.lds;
    LAS int* W = (LAS int*)(F.lds + WLK_OFF + wave * 8192);
    const int ntask = 1024 / F.G;
    const int h = F.bid & 7;
    { const unsigned char* src = KI + (size_t)h * 65536;
      for (int k = 0; k < 8; ++k) { const int pi = wave + 8 * k; att::dma16(src + pi * 1024 + lane * 16, lds + pi * 1024); } }
    asm volatile("s_waitcnt vmcnt(0)" ::: "memory");
    __syncthreads();
    bf16x8 qf[8], qn[8];
    { const int tb32 = ((F.bid >> 3) * ntask) * 8 + wave;
      const bf16_t* qp = Q2 + ((((size_t)tb32 * 8 + h) * 2 + 0) * 8 * 2 + hi) * 256 + r32 * 8;
#pragma unroll
      for (int s = 0; s < 8; ++s) qn[s] = *(const bf16x8*)(qp + s * 512); }
    for (int ti = 0; ti < ntask; ++ti) {
        const int tb = (F.bid >> 3) * ntask + ti;
        const int t = tb * 256 + wave * 32 + r32;
        unsigned A[16], B[16];
#pragma unroll
        for (int pp = 0; pp < 2; ++pp) {
#pragma unroll
            for (int s = 0; s < 8; ++s) qf[s] = qn[s];
            { const int nti = pp == 0 ? ti : ti + 1, npp = pp ^ 1;
              if (nti < ntask) { const int tb32 = ((F.bid >> 3) * ntask + nti) * 8 + wave;
                  const bf16_t* qp = Q2 + ((((size_t)tb32 * 8 + h) * 2 + npp) * 8 * 2 + hi) * 256 + r32 * 8;
#pragma unroll
                  for (int s = 0; s < 8; ++s) qn[s] = *(const bf16x8*)(qp + s * 512); } }
            f32x16 acc[4];
#pragma unroll
            for (int kb = 0; kb < 4; ++kb)
#pragma unroll
                for (int r = 0; r < 16; ++r) acc[kb][r] = 0.f;
            att::lcp ab = (att::lcp)(lds + pp * 32768 + hi * 2048 + r32 * 16);
#pragma unroll
            for (int s = 0; s < 8; ++s)
#pragma unroll
                for (int kb = 0; kb < 4; ++kb) {
                    const bf16x8 a = *(const __attribute__((address_space(3))) bf16x8*)(ab + s * 4096 + kb * 512);
                    acc[kb] = __builtin_amdgcn_mfma_f32_32x32x16_bf16(a, qf[s], acc[kb], 0, 0, 0);
                }
            unsigned v0[16], v1[16], v2[16], v3[16];
#pragma unroll
            for (int r = 0; r < 16; ++r) {
                const int c = 127 - ((r & 3) + 8 * (r >> 2));
                v0[r] = (ord(acc[0][r]) & 0xFFFFFF80u) | (unsigned)(c - 0 - 4 * hi);
                v1[r] = (ord(acc[1][r]) & 0xFFFFFF80u) | (unsigned)(c - 32 - 4 * hi);
                v2[r] = (ord(acc[2][r]) & 0xFFFFFF80u) | (unsigned)(c - 64 - 4 * hi);
                v3[r] = (ord(acc[3][r]) & 0xFFFFFF80u) | (unsigned)(c - 96 - 4 * hi);
            }
            top16_of_64x2(v0, v1, v2, v3);
            if (pp == 0) {
#pragma unroll
                for (int i = 0; i < 16; ++i) A[i] = v0[i];
            } else {
#pragma unroll
                for (int i = 0; i < 16; ++i) B[i] = v0[i];
            }
        }
        float fa[16], fb[16];
#pragma unroll
        for (int i = 0; i < 16; ++i) { fa[i] = unord(A[i] & 0xFFFFFF80u); fb[i] = unord(B[i] & 0xFFFFFF80u);
            W[i * 64 + lane] = 127 - (int)(A[i] & 127u); W[(16 + i) * 64 + lane] = 127 - (int)(B[i] & 127u); }
        unsigned c0[16], c1[16], c2[16], c3[16];
#pragma unroll
        for (int j = 0; j < 16; ++j) c0[j] = (ord(fa[0] + fb[j]) & 0xFFFFFF00u) | (unsigned)(255 - j);
        {
            int n = 0;
#pragma unroll
            for (int i = 1; i < 16; ++i)
#pragma unroll
                for (int j = 0; j < 16; ++j) if ((i + 1) * (j + 1) <= 16) {
                    const unsigned key = (ord(fa[i] + fb[j]) & 0xFFFFFF00u) | (unsigned)(255 - (i * 16 + j));
                    if (n < 16) c1[n] = key; else if (n < 32) c2[n - 16] = key; else c3[n - 32] = key;
                    ++n;
                }
#pragma unroll
            for (int k = 2; k < 16; ++k) c3[k] = 0u;
        }
        sort16_desc(c1); sort16_desc(c2); sort16_desc(c3);
        merge_top16(c0, c1); merge_top16(c2, c3); merge_top16(c0, c2);
        float ev[16]; float l = 0.f; const float mx = unord(c0[0] & 0xFFFFFF00u);
#pragma unroll
        for (int k = 0; k < 16; ++k) { ev[k] = __expf(unord(c0[k] & 0xFFFFFF00u) - mx); l += ev[k]; }
        const float rl = 1.f / l;
        int ex[8]; float gt[8], su[8];
#pragma unroll
        for (int kk = 0; kk < 8; ++kk) {
            const unsigned key = hi ? c0[8 + kk] : c0[kk]; const float e = hi ? ev[8 + kk] : ev[kk];
            const int pos = 255 - (int)(key & 255u);
            ex[kk] = W[(pos >> 4) * 64 + lane] * 128 + W[(16 + (pos & 15)) * 64 + lane];
            gt[kk] = e * rl * VSC[ex[kk]]; su[kk] = USC[ex[kk]];
        }
        int* ep = EX + (size_t)t * 128 + h * 16 + hi * 8; float* gp = GT + (size_t)t * 128 + h * 16 + hi * 8;
        *(u32x4*)ep = (u32x4){(unsigned)ex[0], (unsigned)ex[1], (unsigned)ex[2], (unsigned)ex[3]}; *(u32x4*)(ep + 4) = (u32x4){(unsigned)ex[4], (unsigned)ex[5], (unsigned)ex[6], (unsigned)ex[7]};
        *(f32x4*)gp = (f32x4){gt[0], gt[1], gt[2], gt[3]}; *(f32x4*)(gp + 4) = (f32x4){gt[4], gt[5], gt[6], gt[7]};
        float* sp = SUo + (size_t)t * 128 + h * 16 + hi * 8;
        *(f32x4*)sp = (f32x4){su[0], su[1], su[2], su[3]}; *(f32x4*)(sp + 4) = (f32x4){su[4], su[5], su[6], su[7]};
    }
    __syncthreads();
}

#define P8_SYNC 0
#define P8_PARTITION 0
#define HAVE_P3 1
#define HAVE_P7 1
struct Args { Params p; int ph_lo, ph_hi, li, pad; };
__global__ void __launch_bounds__(NTHR, 2) mk_fwd(Args a) {
    extern __shared__ __attribute__((aligned(16))) unsigned char lds[];
    Frame F;
    F.lds = (LAS unsigned char*)lds;
    F.MISC = (volatile LAS unsigned*)(F.lds + MISC_OFF);
    F.tid = threadIdx.x; F.lane = F.tid & 63; F.wave = __builtin_amdgcn_readfirstlane(F.tid >> 6);
    F.G = gridDim.x; F.bid = blockIdx.x;
    const Params& p = a.p;
    gu32* ctl = (gu32*)(p.ws + WS_CTL);
    for (int u = F.tid; u < 128; u += NTHR) ((LAS unsigned*)(F.lds + MISC_OFF))[u] = 0u;
    __syncthreads();
    XcdBarrier bar = xcd_barrier_post((unsigned*)(ctl + CW_BAR) + a.li * XCD_BAR_WORDS, F.MISC + 8);
    const int lo = a.ph_lo, hi = a.ph_hi;
#ifdef PROBE_TS
    int nts_ = 0;
#define STAMP() do { if (threadIdx.x == 0 && nts_ < 12) { const unsigned long long t_ = __builtin_amdgcn_s_memrealtime(); F.MISC[32 + 2 * nts_] = (unsigned)t_; F.MISC[33 + 2 * nts_] = (unsigned)(t_ >> 32); } ++nts_; } while (0)
    STAMP();
#else
#define STAMP() do {} while (0)
#endif
#define IN(k) (lo <= (k) && (k) < hi)
#define REFRESH() do { F.lane = (int)__builtin_amdgcn_mbcnt_hi(~0u, __builtin_amdgcn_mbcnt_lo(~0u, 0u)); F.tid = F.wave * 64 + F.lane; } while (0)
#define SEAM(k) do { if (IN(k) && IN((k) + 1)) xcd_barrier(bar); STAMP(); } while (0)

#ifndef PROBE_DUP
#define PROBE_DUP -1
#endif
#define REP(k) for (int rep_ = 0; rep_ < (PROBE_DUP == (k) ? 2 : 1); ++rep_)
    if (IN(0)) { REP(0) p0_prologue(F, p); SEAM(0); }
    if (IN(1)) { REP(1) { p1_hrows(F, p); __syncthreads(); } SEAM(1); }
    if (IN(2)) {
        pg8::Gemm g{(const bf16_t*)(p.ws + WS_H), (const bf16_t*)(p.ws + WS_WIN), MALL, NQKV, D}; pg8::StaticOrder S; S.init(MALL, NQKV, F.G, F.bid);
        EpiQKVFast E{p.ws};
        REP(2) pg8::gemm_phase<EpiQKVFast, pg8::StaticOrder, true, true>(F.lds + RING_OFF, g, S, E);
        SEAM(2);
    }
#if HAVE_P3
    if (IN(3)) { REP(31) att::na_units(F, p); att::diff_units_v2<0>(F, p);
#if PROBE_DUP == 321
        att::diff_units_v2<1>(F, p);
#elif PROBE_DUP == 323
        att::diff_units_v2<3>(F, p);
#elif PROBE_DUP == 322
        att::diff_units_v2<2>(F, p);
#elif PROBE_DUP == 32
        att::diff_units_v2<0>(F, p);
#endif
        SEAM(3); }
#endif
    if (IN(4)) {
        pg8::Gemm g{(const bf16_t*)(p.ws + WS_Y), (const bf16_t*)(p.ws + WS_WOUT), MLAT, D, D}; pg8::StaticOrder S; S.init(MLAT, D, F.G, F.bid);
        pg8::EpiBf16<0> E{(bf16_t*)(p.ws + WS_YO), D, nullptr, 0, 0, 1.f};
        REP(4) pg8::gemm_phase<pg8::EpiBf16<0>, pg8::StaticOrder, true, true>(F.lds + RING_OFF, g, S, E);
        SEAM(4);
    }
    if (IN(5)) { REP(5) p5_rows2(F, p); SEAM(5); }
    if (IN(6)) {
        pg8::Gemm g{(const bf16_t*)(p.ws + WS_H2), (const bf16_t*)(p.ws + WS_WPQ), MLAT, 2048, D}; pg8::StaticOrder S; S.init(MLAT, 2048, F.G, F.bid);
        EpiQ2Frag E{(bf16_t*)(p.ws + WS_Q2)};
        REP(6) pg8::gemm_phase<EpiQ2Frag, pg8::StaticOrder, true, true>(F.lds + RING_OFF, g, S, E);
        SEAM(6);
    }
#if HAVE_P7
    if (IN(7)) { REP(7) p7_topk(F, p); SEAM(7); }
#endif
#if P8_PARTITION
    if (IN(8)) {
        p7b_sort(F, p); xcd_barrier(bar);
        for (int ch = 0; ch < 2; ++ch) { p8a_part(F, p, ch); xcd_barrier(bar); p8b_combine(F, p, ch); if (ch == 0) xcd_barrier(bar); }
    }
#else
    if (IN(8)) {
#if PROBE_DUP == 81
        p8_gather<1>(F, p, bar);
#elif PROBE_DUP == 82
        p8_gather<2>(F, p, bar);
#elif PROBE_DUP == 83
        p8_gather<3>(F, p, bar);
#endif
        p8_gather<0>(F, p, bar); }
#endif
#ifdef PROBE_TS
#ifdef PROBE_TS_ENDBAR
    xcd_barrier(bar);
#endif
    STAMP();
    if (blockIdx.x == 0 && threadIdx.x == 0) { const unsigned long long t1_ = ((unsigned long long)F.MISC[33 + 2 * (PROBE_TS + 1)] << 32) | F.MISC[32 + 2 * (PROBE_TS + 1)], t0_ = ((unsigned long long)F.MISC[33 + 2 * PROBE_TS] << 32) | F.MISC[32 + 2 * PROBE_TS];
        const unsigned long long dt = t1_ - t0_; const unsigned long long t_end = __builtin_amdgcn_s_memrealtime();
        while (__builtin_amdgcn_s_memrealtime() - t_end < 8ull * dt) __builtin_amdgcn_s_sleep(8); }
#endif
#undef IN
#undef SEAM
}

static void launch_mk(const Params& p, int lo, int hi, int li, hipStream_t stream) {
    Args a{}; a.p = p; a.ph_lo = lo; a.ph_hi = hi; a.li = li; a.pad = 0;
    hipLaunchKernelGGL(mk_fwd, dim3(256), dim3(NTHR), LDS_BYTES, stream, a);
}
extern "C" void kernel_launch(void* const* d_in, const int* in_sizes, int n_in, void* d_out, int out_size, void* d_ws, size_t ws_size, hipStream_t stream) {
    if (n_in != 16 || ws_size < WS_END) return;
    static bool attr_done = false;
    if (!attr_done) {
        (void)hipFuncSetAttribute((const void*)mk_fwd, hipFuncAttributeMaxDynamicSharedMemorySize, LDS_BYTES);
        attr_done = true;
    }
    Params p{};
    p.x = (const float*)d_in[0]; p.c = (const float*)d_in[1]; p.ctx = (const float*)d_in[2]; p.c_ctx = (const float*)d_in[3];
    p.w_ada = (const float*)d_in[4]; p.b_ada = (const float*)d_in[5]; p.g_norm = (const float*)d_in[6]; p.w_in = (const float*)d_in[7];
    p.rel_bias = (const float*)d_in[8]; p.diff_lambda = (const float*)d_in[9]; p.diff_subln = (const float*)d_in[10]; p.w_out = (const float*)d_in[11];
    p.peer_wq = (const float*)d_in[12]; p.peer_keys = (const float*)d_in[13]; p.peer_u = (const float*)d_in[14]; p.peer_v = (const float*)d_in[15];
    p.out = (float*)d_out; p.ws = (unsigned char*)d_ws;
    (void)hipMemsetAsync((char*)d_ws + WS_CTL, 0, CTL_ZERO_BYTES, stream);

    launch_mk(p, 0, 9, 0, stream);

}
```

```cpp
#include <hip/hip_runtime.h>
#include <stdint.h>
#include <math.h>

typedef unsigned short bf16_t;
typedef float f32x4 __attribute__((ext_vector_type(4)));
typedef unsigned u32x4 __attribute__((ext_vector_type(4)));
typedef unsigned u32x2 __attribute__((ext_vector_type(2)));
typedef float f32x2 __attribute__((ext_vector_type(2)));

constexpr int D = 1024, BATCH = 8, SEQ = 4096, CTX = 256, GW = 64;
constexpr int MLAT = BATCH * SEQ;
constexpr int MCTX = BATCH * CTX;
constexpr int MALL = MLAT + MCTX;
constexpr int NQKV = 3072;
constexpr int NKT = 68;
constexpr int NMOD = 6 * D;
constexpr int PE_H = 8, PE_NK = 128, PE_QD = 256, PE_TOPK = 16, PE_NEXP = 16384;
constexpr float EPS = 1e-6f;
constexpr float LOG2E = 1.4426950408889634f;
constexpr float C2 = 0.125f * LOG2E;
constexpr float LAMBDA_INIT = 0.2f;
constexpr float NEG_BIG = -30000.0f;

constexpr size_t MiB = 1u << 20;
constexpr size_t WS_CTL = 0;
constexpr size_t WS_MOD = 1 * MiB;
constexpr size_t WS_LAM = 1 * MiB + 256 * 1024;
constexpr size_t WS_ROPE = 1 * MiB + 512 * 1024;
constexpr size_t WS_USC = 1 * MiB + 640 * 1024;
constexpr size_t WS_VSC = 1 * MiB + 704 * 1024;
constexpr size_t WS_MODP = 2 * MiB;
constexpr size_t WS_BIAST = 4 * MiB;
constexpr size_t WS_KEYS = 5 * MiB;
constexpr size_t WS_KEYSI = 5 * MiB + 512 * 1024;
constexpr size_t WS_WIN = 6 * MiB;
constexpr size_t WS_WOUT = 12 * MiB;
constexpr size_t WS_WPQ = 14 * MiB;
constexpr size_t WS_UB = 18 * MiB;
constexpr size_t WS_VB = 50 * MiB;
constexpr size_t WS_EXP = 82 * MiB;
constexpr size_t WS_GATE = 98 * MiB;
constexpr size_t WS_H2 = 114 * MiB;
constexpr size_t WS_H = 178 * MiB;
constexpr size_t WS_Y = 178 * MiB;
constexpr size_t WS_QA = 246 * MiB;
constexpr size_t WS_KA = 278 * MiB;
constexpr size_t WS_VA = 312 * MiB;
constexpr size_t WS_QD = 346 * MiB;
constexpr size_t WS_KD = 378 * MiB;
constexpr size_t WS_VD = 412 * MiB;
constexpr size_t WS_YO = 246 * MiB;
constexpr size_t WS_Q2 = 246 * MiB;
constexpr size_t WS_PART = 178 * MiB;
constexpr size_t WS_DSCR = 464 * MiB;
constexpr size_t WS_SU = 446 * MiB;
constexpr size_t WS_END = 496 * MiB;

struct Params {
    const float *x, *c, *ctx, *c_ctx, *w_ada, *b_ada, *g_norm, *w_in, *rel_bias, *diff_lambda, *diff_subln, *w_out, *peer_wq, *peer_keys, *peer_u, *peer_v;
    float* out;
    unsigned char* ws;
};

__device__ __forceinline__ unsigned f2bf(float f) { unsigned u = __builtin_bit_cast(unsigned, f); return (u + 0x7fffu + ((u >> 16) & 1u)) >> 16; }
__device__ __forceinline__ unsigned pk2(float lo, float hi) { return f2bf(lo) | (f2bf(hi) << 16); }
__device__ __forceinline__ float bf2f(bf16_t h) { return __builtin_bit_cast(float, (unsigned)h << 16); }
__device__ __forceinline__ float bflo(unsigned w) { return __builtin_bit_cast(float, w << 16); }
__device__ __forceinline__ float bfhi(unsigned w) { return __builtin_bit_cast(float, w & 0xffff0000u); }
__device__ __forceinline__ float wave_sum(float v) {
    v += __uint_as_float((unsigned)__builtin_amdgcn_update_dpp(0, (int)__float_as_uint(v), 0xB1, 0xf, 0xf, false));
    v += __uint_as_float((unsigned)__builtin_amdgcn_update_dpp(0, (int)__float_as_uint(v), 0x4E, 0xf, 0xf, false));
    v += __uint_as_float((unsigned)__builtin_amdgcn_update_dpp(0, (int)__float_as_uint(v), 0x141, 0xf, 0xf, false));
    v += __uint_as_float((unsigned)__builtin_amdgcn_update_dpp(0, (int)__float_as_uint(v), 0x128, 0xf, 0xf, false));
    { auto r = __builtin_amdgcn_permlane16_swap(__float_as_uint(v), __float_as_uint(v), false, false); v = __uint_as_float(r[0]) + __uint_as_float(r[1]); }
    { auto r = __builtin_amdgcn_permlane32_swap(__float_as_uint(v), __float_as_uint(v), false, false); v = __uint_as_float(r[0]) + __uint_as_float(r[1]); }
    return v;
}
__device__ __forceinline__ float wave_max(float v) {
    v = fmaxf(v, __uint_as_float((unsigned)__builtin_amdgcn_update_dpp(0, (int)__float_as_uint(v), 0xB1, 0xf, 0xf, false)));
    v = fmaxf(v, __uint_as_float((unsigned)__builtin_amdgcn_update_dpp(0, (int)__float_as_uint(v), 0x4E, 0xf, 0xf, false)));
    v = fmaxf(v, __uint_as_float((unsigned)__builtin_amdgcn_update_dpp(0, (int)__float_as_uint(v), 0x141, 0xf, 0xf, false)));
    v = fmaxf(v, __uint_as_float((unsigned)__builtin_amdgcn_update_dpp(0, (int)__float_as_uint(v), 0x128, 0xf, 0xf, false)));
    { auto r = __builtin_amdgcn_permlane16_swap(__float_as_uint(v), __float_as_uint(v), false, false); v = fmaxf(__uint_as_float(r[0]), __uint_as_float(r[1])); }
    { auto r = __builtin_amdgcn_permlane32_swap(__float_as_uint(v), __float_as_uint(v), false, false); v = fmaxf(__uint_as_float(r[0]), __uint_as_float(r[1])); }
    return v;
}

__device__ __forceinline__ float half_max(float v) {
    v = fmaxf(v, __uint_as_float((unsigned)__builtin_amdgcn_update_dpp(0, (int)__float_as_uint(v), 0xB1, 0xf, 0xf, false)));
    v = fmaxf(v, __uint_as_float((unsigned)__builtin_amdgcn_update_dpp(0, (int)__float_as_uint(v), 0x4E, 0xf, 0xf, false)));
    v = fmaxf(v, __uint_as_float((unsigned)__builtin_amdgcn_update_dpp(0, (int)__float_as_uint(v), 0x141, 0xf, 0xf, false)));
    v = fmaxf(v, __uint_as_float((unsigned)__builtin_amdgcn_update_dpp(0, (int)__float_as_uint(v), 0x128, 0xf, 0xf, false)));
    { auto r = __builtin_amdgcn_permlane16_swap(__float_as_uint(v), __float_as_uint(v), false, false); v = fmaxf(__uint_as_float(r[0]), __uint_as_float(r[1])); }
    return v;
}
typedef float f32x16 __attribute__((ext_vector_type(16)));
typedef float f32x32 __attribute__((ext_vector_type(32)));
typedef unsigned u32x6 __attribute__((ext_vector_type(6)));

__device__ __forceinline__ u32x6 enc_fp6(f32x16 a, f32x16 b) { u32x6 w; asm volatile("v_cvt_scalef32_2xpk16_fp6_f32 %0, %1, %2, 1.0" : "=&v"(w) : "v"(a), "v"(b)); return w; }
__device__ __forceinline__ f32x32 dec_fp6(u32x6 w) { f32x32 r; asm volatile("v_cvt_scalef32_pk32_f32_fp6 %0, %1, 1.0" : "=&v"(r) : "v"(w)); return r; }

typedef short hs16x4 __attribute__((ext_vector_type(4)));
typedef __bf16 hbf16x2 __attribute__((ext_vector_type(2)));

__device__ __forceinline__ int ktile_off(int k, int d) { return (d >> 3) * 512 + k * 8 + (d & 7); }
__device__ __forceinline__ int vtile_off(int k, int d) { return (d >> 5) * 2048 + (k >> 4) * 512 + (k & 15) * 32 + (d & 31); }
__device__ __forceinline__ size_t qa_idx(int b, int h, int t, int d) { return ((size_t)(b * 8 + h) * SEQ + t) * 64 + d; }
__device__ __forceinline__ size_t ka_idx(int b, int h, int j, int d) { return ((size_t)(b * 8 + h) * NKT + (j >> 6)) * 4096 + ktile_off(j & 63, d); }
__device__ __forceinline__ size_t va_idx(int b, int h, int j, int d) { return ((size_t)(b * 8 + h) * NKT + (j >> 6)) * 4096 + vtile_off(j & 63, d); }
__device__ __forceinline__ size_t qd_idx(int b, int m, int h, int t, int d) { return ((size_t)((b * 2 + m) * 4 + h) * SEQ + t) * 64 + d; }
__device__ __forceinline__ size_t kd_idx(int b, int m, int h, int j, int d) { return ((size_t)((b * 2 + m) * 4 + h) * NKT + (j >> 6)) * 4096 + ktile_off(j & 63, d); }
__device__ __forceinline__ size_t vd_idx(int b, int h, int j, int d) { return ((size_t)(b * 4 + h) * NKT + (j >> 6)) * 8192 + vtile_off(j & 63, d); }


namespace pg8 {
#define PG8_LAS __attribute__((address_space(3)))
typedef unsigned short bf16_t;
typedef short bf16x8 __attribute__((ext_vector_type(8)));
typedef float f32x4 __attribute__((ext_vector_type(4)));
typedef unsigned u32x4 __attribute__((ext_vector_type(4)));
constexpr int BM = 256, BK = 64, HALF = 128, HTB = HALF * BK * 2  , STAGE_BYTES = 8 * HTB, NXCD = 8, WGM = 8;

__host__ __device__ __forceinline__ int lds_byte(int r, int c) { const int st = (r >> 4) * 2 + (c >> 5), rr = r & 15, cc = c & 31, ob = rr * 64 + cc * 2; return st * 1024 + (ob ^ (((ob >> 9) & 1) << 5)); }
__host__ __device__ __forceinline__ void stage_rc(int b, int& R, int& C) { const int st = b / 1024, sb = b % 1024, swz = sb ^ (((sb >> 9) & 1) << 5); R = (st >> 1) * 16 + swz / 64; C = (st & 1) * 32 + (swz % 64) / 2; }
__host__ __device__ __forceinline__ int perm32(int rho) { const int n = rho >> 4, i = rho & 15; return 8 * (i >> 2) + 4 * n + (i & 3); }

struct Unit { int pm, pn; };
struct Gemm { const bf16_t* A; const bf16_t* Bt; int M, N, K; };

struct StaticOrder {
    int nM, nN, nwg, G, c;
    __host__ __device__ void init(int M, int N, int G_, int c_) { nM = M / BM; nN = N / BM; nwg = nM * nN; G = G_; c = c_; }
    __host__ __device__ bool next(int i, Unit& u) const {
        const long L = (long)i * G + c; if (L >= nwg) return false;
        int wgid = (int)L; { const int q = nwg / NXCD, r = nwg % NXCD, xcd = wgid % NXCD, off = wgid / NXCD; wgid = (xcd < r ? xcd * (q + 1) : r * (q + 1) + (xcd - r) * q) + off; }
        const int nig = WGM * nN, gid = wgid / nig, fm = gid * WGM, gsz = (nM - fm) < WGM ? (nM - fm) : WGM;
        u.pm = fm + ((wgid % nig) % gsz); u.pn = (wgid % nig) / gsz; return true;
    }
    __device__ __forceinline__ void a_ready(const Unit&) const {}
    __device__ __forceinline__ void done(const Unit&) const {}
};

__device__ __forceinline__ unsigned cvt_pk_bf16(float lo, float hi) { unsigned r; asm volatile("v_cvt_pk_bf16_f32 %0, %1, %2" : "=v"(r) : "v"(lo), "v"(hi)); return r; }
typedef float f32x2 __attribute__((ext_vector_type(2)));
__device__ __forceinline__ f32x2 gelu_pk(f32x2 v) {
    const f32x2 av = __builtin_elementwise_abs(v), d = av * 0.2316418882f + 1.0f;
    f32x2 t; t.x = __builtin_amdgcn_rcpf(d.x); t.y = __builtin_amdgcn_rcpf(d.y);
    f32x2 q = t * 0.5307027145f + (-0.7265760135f); q = q * t + 0.7107068705f; q = q * t + (-0.142248368f); q = q * t + 0.127414796f; q = q * t;
    const f32x2 s = (v * v) * (-0.72134752044f);
    f32x2 e; e.x = __builtin_amdgcn_exp2f(s.x); e.y = __builtin_amdgcn_exp2f(s.y);
    const f32x2 m = v * (q * e), r = v - m;
    f32x2 o; o.x = v.x < 0.f ? m.x : r.x; o.y = v.y < 0.f ? m.y : r.y; return o;
}

template <int ACT  > struct EpiBf16 {
    static constexpr bool PERM = true, AFTER_DRAIN = false; static_assert(ACT == 0 || ACT == 1, "EpiBf16: ACT is 0 (none) or 1 (gelu_pk)");
    bf16_t* O; int ldc; const float* bias; int split_cols; size_t split_stride; float scale0;
    __device__ __forceinline__ void operator()(const f32x4 (&acc)[2][2][4][2], const Unit& u, int wr, int wc, int fr, int fq) const {
        const int row0 = u.pm * BM + wr * 64 + fr; int colt = u.pn * BM; bf16_t* base = O;
        float sc = 1.f; if (split_cols) { const int t = colt / split_cols; base += (size_t)t * split_stride; colt -= t * split_cols; if (t == 0) sc = scale0; }
        const int col0 = colt + wc * 32 + 8 * fq, bcol0 = u.pn * BM + wc * 32 + 8 * fq;
        f32x4 bv[2][2];
#pragma unroll
        for (int bj = 0; bj < 2; ++bj)
#pragma unroll
            for (int n = 0; n < 2; ++n) bv[bj][n] = bias ? *(const f32x4*)(bias + bcol0 + bj * HALF + 4 * n) : (f32x4){0.f, 0.f, 0.f, 0.f};
#pragma unroll
        for (int ai = 0; ai < 2; ++ai)
#pragma unroll
            for (int m = 0; m < 4; ++m) { bf16_t* rowp = base + (size_t)(row0 + ai * HALF + m * 16) * ldc + col0;
#pragma unroll
                for (int bj = 0; bj < 2; ++bj) { f32x4 v0 = acc[ai][bj][m][0] + bv[bj][0], v1 = acc[ai][bj][m][1] + bv[bj][1];
                    if (ACT == 1) { f32x2 a = gelu_pk((f32x2){v0[0], v0[1]}), b = gelu_pk((f32x2){v0[2], v0[3]}), c = gelu_pk((f32x2){v1[0], v1[1]}), d = gelu_pk((f32x2){v1[2], v1[3]});
                        v0 = (f32x4){a.x, a.y, b.x, b.y}; v1 = (f32x4){c.x, c.y, d.x, d.y}; }
                    v0 = v0 * sc; v1 = v1 * sc; u32x4 w; w.x = cvt_pk_bf16(v0[0], v0[1]); w.y = cvt_pk_bf16(v0[2], v0[3]); w.z = cvt_pk_bf16(v1[0], v1[1]); w.w = cvt_pk_bf16(v1[2], v1[3]);
                    *(u32x4*)(rowp + bj * HALF) = w; } }
    }
};

template <class Epi, class Sched, bool ALIGN_EPI = false, bool SP2 = false>
__device__ __forceinline__ void gemm_phase(PG8_LAS unsigned char* lds, const Gemm g, const Sched& S, const Epi& E) {
    const int tid = threadIdx.x, wid = __builtin_amdgcn_readfirstlane(tid >> 6), lane = tid & 63, wr = wid >> 2, wc = wid & 3, fr = lane & 15, fq = lane >> 4;
    const int K = g.K, nt = K / BK;
    unsigned voffA[2], voffB[2];
#pragma unroll
    for (int i = 0; i < 2; ++i) { int R, C; stage_rc(tid * 16 + i * 8192, R, C); const int Rb = Epi::PERM ? ((R & ~31) + perm32(R & 31)) : R;
        voffA[i] = (unsigned)(R * K + C) * 2u; voffB[i] = (unsigned)(Rb * K + C) * 2u; }
    const size_t kstep = (size_t)(BK * 2);
    const size_t hstep = (size_t)HALF * K * 2;
    const size_t tstep = 2 * hstep;
    const unsigned ldsw = (unsigned)wid * 1024u;
    const int aoff = lds_byte(wr * 64 + fr, fq * 8), boff = lds_byte(wc * 32 + fr, fq * 8);
#define PG8_SA(b, h) (((b) * 2 + (h)) * HTB)
#define PG8_SB(b, h) ((4 + (b) * 2 + (h)) * HTB)
#define PG8_STAGE(bufoff, gbase, voff) do { _Pragma("unroll") for (int _i = 0; _i < 2; ++_i) \
        __builtin_amdgcn_global_load_lds((const unsigned*)((const char*)(gbase) + (voff)[_i]), (PG8_LAS unsigned*)(lds + (bufoff) + ldsw + _i * 8192), 16, 0, 0); } while (0)
#define PG8_LDA(dst, b, h) do { _Pragma("unroll") for (int m = 0; m < 4; ++m) _Pragma("unroll") for (int k = 0; k < 2; ++k) dst[m][k] = *(const PG8_LAS bf16x8*)(lds + PG8_SA(b, h) + aoff + m * 2048 + k * 1024); } while (0)
#define PG8_LDB(dst, b, h) do { _Pragma("unroll") for (int n = 0; n < 2; ++n) _Pragma("unroll") for (int k = 0; k < 2; ++k) dst[n][k] = *(const PG8_LAS bf16x8*)(lds + PG8_SB(b, h) + boff + n * 2048 + k * 1024); } while (0)
#define PG8_MMA(ai, bj, At, Bt) do { __builtin_amdgcn_s_setprio(1); _Pragma("unroll") for (int m = 0; m < 4; ++m) _Pragma("unroll") for (int n = 0; n < 2; ++n) _Pragma("unroll") for (int k = 0; k < 2; ++k) \
        acc[ai][bj][m][n] = __builtin_amdgcn_mfma_f32_16x16x32_bf16(Bt[n][k], At[m][k], acc[ai][bj][m][n], 0, 0, 0); __builtin_amdgcn_s_setprio(0); } while (0)
#define PG8_WAIT_V(n) asm volatile("s_waitcnt vmcnt(" #n ")" ::: "memory")
#define PG8_WAIT_L(n) asm volatile("s_waitcnt lgkmcnt(" #n ")" ::: "memory")
#define PG8_BAR __builtin_amdgcn_s_barrier()
#define PG8_SCHED __builtin_amdgcn_sched_barrier(0)
    Unit cur, nxt; int ui = 0;
    if (!S.next(0, cur)) return;
    f32x4 acc[2][2][4][2];
#pragma unroll
    for (int a = 0; a < 2; ++a)
#pragma unroll
        for (int b = 0; b < 2; ++b)
#pragma unroll
            for (int m = 0; m < 4; ++m)
#pragma unroll
                for (int n = 0; n < 2; ++n) acc[a][b][m][n] = (f32x4){0.f, 0.f, 0.f, 0.f};
    bf16x8 At[4][2], B0[2][2], B1[2][2];
    const char* cA = (const char*)g.A + (size_t)cur.pm * tstep; const char* cB = (const char*)g.Bt + (size_t)cur.pn * tstep;
    S.a_ready(cur);
    if constexpr (SP2) {
        PG8_STAGE(PG8_SB(0, 0), cB, voffB); PG8_STAGE(PG8_SB(0, 1), cB + hstep, voffB); PG8_STAGE(PG8_SA(0, 0), cA, voffA); PG8_STAGE(PG8_SA(0, 1), cA + hstep, voffA);
        if (wr == 1) PG8_BAR;
        PG8_WAIT_V(2); PG8_BAR;
        PG8_STAGE(PG8_SB(1, 0), cB + kstep, voffB); PG8_STAGE(PG8_SA(1, 0), cA + kstep, voffA); PG8_STAGE(PG8_SB(1, 1), cB + hstep + kstep, voffB);
        PG8_WAIT_V(6); PG8_BAR;
    } else {
        PG8_STAGE(PG8_SB(0, 0), cB, voffB); PG8_STAGE(PG8_SA(0, 0), cA, voffA); PG8_STAGE(PG8_SB(0, 1), cB + hstep, voffB); PG8_STAGE(PG8_SA(0, 1), cA + hstep, voffA);
        if (wr == 1) PG8_BAR;
        PG8_WAIT_V(4); PG8_BAR;
        PG8_STAGE(PG8_SB(1, 0), cB + kstep, voffB); PG8_STAGE(PG8_SA(1, 0), cA + kstep, voffA); PG8_STAGE(PG8_SB(1, 1), cB + hstep + kstep, voffB);
        PG8_WAIT_V(6); PG8_BAR;
    }
    for (;;) {
        const bool has_next = S.next(ui + 1, nxt);
        const char* nA = has_next ? (const char*)g.A + (size_t)nxt.pm * tstep : cA; const char* nB = has_next ? (const char*)g.Bt + (size_t)nxt.pn * tstep : cB;
        for (int t = 0; t < nt; t += 2) {
            const bool last = (t == nt - 2);
            const char* a1 = cA + (size_t)(t + 1) * kstep;
            const char* a2 = last ? nA : cA + (size_t)(t + 2) * kstep; const char* b2 = last ? nB : cB + (size_t)(t + 2) * kstep;
            const char* a3 = a2 + kstep; const char* b3 = b2 + kstep;
            if (last && has_next) S.a_ready(nxt);
            if constexpr (SP2) {
            PG8_LDB(B0, 0, 0); PG8_LDB(B1, 0, 1); PG8_SCHED; PG8_LDA(At, 0, 0); PG8_STAGE(PG8_SA(1, 1), a1 + hstep, voffA);
            PG8_WAIT_V(8); PG8_WAIT_L(0); PG8_BAR; PG8_MMA(0, 0, At, B0); PG8_MMA(0, 1, At, B1); PG8_BAR; PG8_SCHED;
            PG8_LDA(At, 0, 1); PG8_STAGE(PG8_SB(0, 0), b2, voffB); PG8_STAGE(PG8_SB(0, 1), b2 + hstep, voffB); PG8_STAGE(PG8_SA(0, 0), a2, voffA);
            PG8_WAIT_V(8); PG8_WAIT_L(0); PG8_BAR; PG8_MMA(1, 0, At, B0); PG8_MMA(1, 1, At, B1); PG8_BAR; PG8_SCHED;
            PG8_LDB(B0, 1, 0); PG8_LDB(B1, 1, 1); PG8_SCHED; PG8_LDA(At, 1, 0); PG8_STAGE(PG8_SA(0, 1), a2 + hstep, voffA);
            PG8_WAIT_V(8); PG8_WAIT_L(0); PG8_BAR; PG8_MMA(0, 0, At, B0); PG8_MMA(0, 1, At, B1); PG8_BAR; PG8_SCHED;
            PG8_LDA(At, 1, 1); PG8_STAGE(PG8_SB(1, 0), b3, voffB); PG8_STAGE(PG8_SB(1, 1), b3 + hstep, voffB); PG8_STAGE(PG8_SA(1, 0), a3, voffA);
            PG8_WAIT_V(8); PG8_WAIT_L(0); PG8_BAR; PG8_MMA(1, 0, At, B0); PG8_MMA(1, 1, At, B1); PG8_BAR; PG8_SCHED;
            } else {
            PG8_LDB(B0, 0, 0); PG8_SCHED; PG8_LDA(At, 0, 0); PG8_STAGE(PG8_SA(1, 1), a1 + hstep, voffA);
            PG8_WAIT_L(8); PG8_BAR; PG8_WAIT_L(0); PG8_MMA(0, 0, At, B0); PG8_BAR; PG8_SCHED;
            PG8_LDB(B1, 0, 1); PG8_STAGE(PG8_SB(0, 0), b2, voffB);
            PG8_BAR; PG8_WAIT_L(0); PG8_MMA(0, 1, At, B1); PG8_BAR;
            PG8_LDA(At, 0, 1); PG8_STAGE(PG8_SA(0, 0), a2, voffA);
            PG8_BAR; PG8_WAIT_L(0); PG8_MMA(1, 0, At, B0); PG8_BAR; PG8_SCHED;
            PG8_STAGE(PG8_SB(0, 1), b2 + hstep, voffB);
            PG8_WAIT_V(6); PG8_BAR; PG8_MMA(1, 1, At, B1); PG8_BAR;
            PG8_LDB(B0, 1, 0); PG8_SCHED; PG8_LDA(At, 1, 0); PG8_STAGE(PG8_SA(0, 1), a2 + hstep, voffA);
            PG8_WAIT_L(8); PG8_BAR; PG8_WAIT_L(0); PG8_MMA(0, 0, At, B0); PG8_BAR; PG8_SCHED;
            PG8_LDB(B1, 1, 1); PG8_STAGE(PG8_SB(1, 0), b3, voffB);
            PG8_BAR; PG8_WAIT_L(0); PG8_MMA(0, 1, At, B1); PG8_BAR;
            PG8_LDA(At, 1, 1); PG8_STAGE(PG8_SA(1, 0), a3, voffA);
            PG8_BAR; PG8_WAIT_L(0); PG8_MMA(1, 0, At, B0); PG8_BAR; PG8_SCHED;
            PG8_STAGE(PG8_SB(1, 1), b3 + hstep, voffB);
            PG8_WAIT_V(6); PG8_BAR; PG8_MMA(1, 1, At, B1); PG8_BAR;
            }
        }
        if constexpr (ALIGN_EPI) { if (wr == 0) PG8_BAR; }
        if constexpr (!Epi::AFTER_DRAIN) { E(acc, cur, wr, wc, fr, fq); S.done(cur); }
        if (!has_next) break;
#pragma unroll
        for (int a = 0; a < 2; ++a)
#pragma unroll
            for (int b = 0; b < 2; ++b)
#pragma unroll
                for (int m = 0; m < 4; ++m)
#pragma unroll
                    for (int n = 0; n < 2; ++n) acc[a][b][m][n] = (f32x4){0.f, 0.f, 0.f, 0.f};
        cur = nxt; cA = nA; cB = nB; ++ui;
        if constexpr (ALIGN_EPI) { if (wr == 1) PG8_BAR; }
    }
    PG8_WAIT_V(0);
    if constexpr (!ALIGN_EPI) { if (wr == 0) PG8_BAR; }
    PG8_BAR;
    if constexpr (Epi::AFTER_DRAIN) { E.fused(acc, cur, wr, wc, fr, fq, lds, wid, lane); S.done(cur); }
#undef PG8_SA
#undef PG8_SB
#undef PG8_STAGE
#undef PG8_LDA
#undef PG8_LDB
#undef PG8_MMA
#undef PG8_WAIT_V
#undef PG8_WAIT_L
#undef PG8_BAR
#undef PG8_SCHED
}
}

#define GAS __attribute__((address_space(1)))
#define LAS __attribute__((address_space(3)))
typedef unsigned v4u __attribute__((ext_vector_type(4)));
typedef float f32x4 __attribute__((ext_vector_type(4)));
typedef short bf16x8 __attribute__((ext_vector_type(8)));
typedef GAS unsigned gu32;
typedef GAS unsigned long long gu64;
#define RLX_AGENT __ATOMIC_RELAXED, __HIP_MEMORY_SCOPE_AGENT
#define LDS_WAIT() asm volatile("s_waitcnt lgkmcnt(0)" ::: "memory")
#define VM_WAIT() asm volatile("s_waitcnt vmcnt(0)" ::: "memory")
__device__ __forceinline__ unsigned long long rt() { return __builtin_amdgcn_s_memrealtime(); }

#define XB_TMO      128
#define XB_XCNT(j)  (256  + 64 * (j))
#define XB_XSUB(j)  (1280 + 64 * (j))
#define XB_XGEN(j)  (2304 + 64 * (j))
#define XB_TOP      3328
#define XB_TOPGEN   3392
#define XCD_BAR_WORDS 3456
#define XB_SPIN_CAP (1u << 18)

__device__ __forceinline__ unsigned xb_ld(unsigned* p)              { return __hip_atomic_load(p, __ATOMIC_RELAXED, __HIP_MEMORY_SCOPE_AGENT); }
__device__ __forceinline__ unsigned xb_add(unsigned* p, unsigned v) { return __hip_atomic_fetch_add(p, v, __ATOMIC_RELAXED, __HIP_MEMORY_SCOPE_AGENT); }
__device__ __forceinline__ unsigned xb_xcc_id() { return (unsigned)__builtin_amdgcn_s_getreg((3 << 11) | 20) & 0xFu; }
#define XB_SPIN(cond, bar) do { unsigned _sp = 0; while (cond) { __builtin_amdgcn_s_sleep(1); \
    if ((++_sp & 255u) == 0u) { if (xb_ld(&(bar)[XB_TMO])) break; if (_sp > XB_SPIN_CAP) { atomicAdd(&(bar)[XB_TMO], 1u); break; } } } } while (0)

struct XcdBarrier {
    unsigned* bar; unsigned x;
    volatile LAS unsigned* st;
};

__device__ __forceinline__ XcdBarrier xcd_barrier_post(unsigned* bar, volatile LAS unsigned* st) {
    XcdBarrier b; b.bar = bar; b.x = xb_xcc_id(); b.st = st;
    if (threadIdx.x == 0) (void)xb_add(&bar[XB_XCNT(b.x)], 1u);
    return b;
}
__device__ __forceinline__ void xcd_barrier_complete(unsigned* bar, unsigned x, unsigned& nloc, unsigned& nx) {
    const unsigned G = gridDim.x * gridDim.y * gridDim.z;
    unsigned sum, cnt, mine, sp = 0u;
    for (;;) {
        sum = 0u; cnt = 0u; mine = 0u;
#pragma unroll
        for (unsigned j = 0; j < 16; ++j) { const unsigned c = xb_ld(&bar[XB_XCNT(j)]); sum += c; cnt += (c > 0u) ? 1u : 0u; mine = (j == x) ? c : mine; }
        if (sum == G) break;
        __builtin_amdgcn_s_sleep(1);
        if ((++sp & 255u) == 0u) { if (xb_ld(&bar[XB_TMO])) break; if (sp > XB_SPIN_CAP) { atomicAdd(&bar[XB_TMO], 1u); break; } }
    }
    nloc = mine > 0u ? mine : 1u; nx = cnt > 0u ? cnt : 1u;
}

__device__ __forceinline__ void xcd_barrier(const XcdBarrier& b) {
    asm volatile("s_waitcnt vmcnt(0)" ::: "memory");
    __syncthreads();
    if (threadIdx.x == 0) {
        unsigned* bar = b.bar;
        __builtin_amdgcn_s_waitcnt(0);
        unsigned nloc = b.st[0], nx = b.st[1];
        if (nloc == 0u) { xcd_barrier_complete(bar, b.x, nloc, nx); b.st[0] = nloc; b.st[1] = nx; }
        const unsigned old = xb_add(&bar[XB_XSUB(b.x)], 1u);
        const unsigned gen = old / nloc;
        if (old + 1u == (gen + 1u) * nloc) {
            __builtin_amdgcn_fence(__ATOMIC_RELEASE, "agent");
            asm volatile("s_waitcnt vmcnt(0)" ::: "memory");
            const unsigned og = xb_add(&bar[XB_TOP], 1u);
            const unsigned tg = og / nx;
            if (og + 1u == (tg + 1u) * nx) xb_add(&bar[XB_TOPGEN], 1u);
            else XB_SPIN(xb_ld(&bar[XB_TOPGEN]) == tg, bar);
            __builtin_amdgcn_fence(__ATOMIC_ACQUIRE, "agent");
            xb_add(&bar[XB_XGEN(b.x)], 1u);
            asm volatile("s_waitcnt vmcnt(0)" ::: "memory");
        } else {
            XB_SPIN(xb_ld(&bar[XB_XGEN(b.x)]) == gen, bar);
            __builtin_amdgcn_fence(__ATOMIC_ACQUIRE, "agent");
            asm volatile("s_waitcnt vmcnt(0)" ::: "memory");
        }
    }
    __syncthreads();
}

constexpr int NWAVES = 8, NTHR = 512;
constexpr int RING_OFF = 0, RING_BYTES = 131072;
constexpr int LDS_BYTES = 159744;
constexpr int MISC_OFF = LDS_BYTES - 512;
constexpr size_t CTL_ZERO_BYTES = 65536;
constexpr int CW_P8CTR = 2048;
constexpr int CW_BAR = 4096;

struct Frame {
    LAS unsigned char* lds;
    volatile LAS unsigned* MISC;
    int tid, lane, wave, G, bid;
};

__device__ __forceinline__ void p0_transpose_item(const float* W, int K, int N, bf16_t* WT, LAS float* scr, int item, int lane) {
    const int nblk = N / 32, kb = item / nblk, nb = item % nblk, k0 = 64 * kb, n0 = 32 * nb;
    float tv[32];
#pragma unroll
    for (int i = 0; i < 32; ++i) tv[i] = W[(size_t)(k0 + 2 * i + (lane >> 5)) * N + n0 + (lane & 31)];
#pragma unroll
    for (int i = 0; i < 32; ++i) scr[(2 * i + (lane >> 5)) * 33 + (lane & 31)] = tv[i];
    LDS_WAIT(); asm volatile("" ::: "memory");
    const int c = lane & 7;
#pragma unroll
    for (int j = 0; j < 4; ++j) { const int n = (lane >> 3) + 8 * j; const LAS float* s = scr + (8 * c) * 33 + n;
        v4u o; o.x = pk2(s[0 * 33], s[1 * 33]); o.y = pk2(s[2 * 33], s[3 * 33]); o.z = pk2(s[4 * 33], s[5 * 33]); o.w = pk2(s[6 * 33], s[7 * 33]);
        *(GAS v4u*)(WT + (size_t)(n0 + n) * K + k0 + 8 * c) = o; }
    LDS_WAIT(); asm volatile("" ::: "memory");
}
__device__ __forceinline__ void cvt_stream(const float* src, bf16_t* dst, size_t n4, size_t gtid, size_t gsz) {
    for (size_t i = gtid; i < n4; i += gsz) { const f32x4 v = ((const f32x4*)src)[i]; u32x2 o; o.x = pk2(v.x, v.y); o.y = pk2(v.z, v.w); ((u32x2*)dst)[i] = o; }
}
__device__ __forceinline__ void p0_prologue(Frame& F, const Params& p) {
    unsigned char* ws = p.ws;
    for (int item = F.bid; item < 192; item += F.G) {
        LAS float* sil = (LAS float*)(F.lds);
        LAS float* red = (LAS float*)(F.lds + 8192);
        const int ks = item / 24, cc = item % 24;
        for (int i = F.tid; i < 9 * 128; i += NTHR) { const int r = i >> 7, k = ks * 128 + (i & 127); const float v = r < 8 ? p.c[r * 1024 + k] : p.c_ctx[k]; sil[i] = v / (1.f + __expf(-v)); }
        __syncthreads();
        f32x4 acc[9];
#pragma unroll
        for (int r = 0; r < 9; ++r) acc[r] = (f32x4){0.f, 0.f, 0.f, 0.f};
        const float* wp = p.w_ada + (size_t)(ks * 128 + F.wave * 16) * NMOD + cc * 256 + F.lane * 4;
#pragma unroll 4
        for (int kk = 0; kk < 16; ++kk) { const f32x4 w = *(const f32x4*)(wp + (size_t)kk * NMOD);
#pragma unroll
            for (int r = 0; r < 9; ++r) acc[r] += w * sil[r * 128 + F.wave * 16 + kk]; }
#pragma unroll
        for (int r = 0; r < 9; ++r) *(LAS f32x4*)(red + ((F.wave * 9 + r) * 256 + F.lane * 4)) = acc[r];
        __syncthreads();
        float* modp = (float*)(ws + WS_MODP);
        for (int i = F.tid; i < 9 * 256; i += NTHR) { const int r = i >> 8, c = i & 255; float s = 0.f;
#pragma unroll
            for (int w = 0; w < 8; ++w) s += red[(w * 9 + r) * 256 + c];
            modp[(size_t)(ks * 9 + r) * NMOD + cc * 256 + c] = s; }
        __syncthreads();
    }
    {
        LAS float* scr = (LAS float*)(F.lds + F.wave * 16384);
        const int gw = F.bid * NWAVES + F.wave, NGW = F.G * NWAVES;
        constexpr int I_IN = 16 * 96, I_OUT = 16 * 32, I_PQ = 16 * 64;
        for (int it = gw; it < I_IN + I_OUT + I_PQ; it += NGW) {
            int r = it;
            if (r < I_IN) { p0_transpose_item(p.w_in, D, NQKV, (bf16_t*)(ws + WS_WIN), scr, r, F.lane); continue; } r -= I_IN;
            if (r < I_OUT) { p0_transpose_item(p.w_out, D, D, (bf16_t*)(ws + WS_WOUT), scr, r, F.lane); continue; } r -= I_OUT;
            p0_transpose_item(p.peer_wq, D, 2048, (bf16_t*)(ws + WS_WPQ), scr, r, F.lane);
        }
    }
    const size_t gtid = (size_t)F.bid * NTHR + F.tid, gsz = (size_t)F.G * NTHR;
    cvt_stream(p.peer_keys, (bf16_t*)(ws + WS_KEYS), (size_t)8 * 2 * 128 * 128 / 4, gtid, gsz);
    { bf16_t* ki = (bf16_t*)(ws + WS_KEYSI);
      for (int i = (int)gtid; i < 8 * 2 * 16 * 128; i += (int)gsz) { const int key = i & 127, c = (i >> 7) & 15, hp = i >> 11;
          const float* sp = p.peer_keys + ((size_t)hp * 128 + key) * 128 + c * 8; const f32x4 a = *(const f32x4*)sp, b = *(const f32x4*)(sp + 4);
          u32x4 o; o.x = pk2(a.x, a.y); o.y = pk2(a.z, a.w); o.z = pk2(b.x, b.y); o.w = pk2(b.z, b.w); *(u32x4*)(ki + (size_t)i * 8) = o; } }
    {
        const int gw = F.bid * NWAVES + F.wave, NGW = F.G * NWAVES, l5 = F.lane & 31, hb = F.lane >> 5;
        for (int e0 = gw * 2; e0 < PE_NEXP; e0 += NGW * 2) {
            f32x4 x[2][8];
#pragma unroll
            for (int q = 0; q < 2; ++q) { const float* src = (hb ? p.peer_v : p.peer_u) + (size_t)(e0 + q) * D + l5 * 32;
#pragma unroll
                for (int j = 0; j < 8; ++j) x[q][j] = ((const f32x4*)src)[j]; }
#pragma unroll
            for (int q = 0; q < 2; ++q) {
                float am = 0.f;
#pragma unroll
                for (int j = 0; j < 8; ++j) am = fmaxf(am, fmaxf(fmaxf(fabsf(x[q][j].x), fabsf(x[q][j].y)), fmaxf(fabsf(x[q][j].z), fabsf(x[q][j].w))));
                am = half_max(am);
                const float top = 6.0f;
                const float sc = am > 0.f ? top / am : 1.f, inv = am > 0.f ? am / top : 1.f;
                f32x16 va, vb;
#pragma unroll
                for (int j = 0; j < 4; ++j) { va[4 * j] = x[q][j].x * sc; va[4 * j + 1] = x[q][j].y * sc; va[4 * j + 2] = x[q][j].z * sc; va[4 * j + 3] = x[q][j].w * sc;
                    vb[4 * j] = x[q][4 + j].x * sc; vb[4 * j + 1] = x[q][4 + j].y * sc; vb[4 * j + 2] = x[q][4 + j].z * sc; vb[4 * j + 3] = x[q][4 + j].w * sc; }
                {
                    u32x4 o = (u32x4){0u, 0u, 0u, 0u};
#pragma unroll
                    for (int j = 0; j < 2; ++j) {
                        o[j] = __builtin_amdgcn_cvt_scalef32_pk_fp4_f32(o[j], va[8 * j + 0], va[8 * j + 1], 1.0f, 0); o[j] = __builtin_amdgcn_cvt_scalef32_pk_fp4_f32(o[j], va[8 * j + 2], va[8 * j + 3], 1.0f, 1);
                        o[j] = __builtin_amdgcn_cvt_scalef32_pk_fp4_f32(o[j], va[8 * j + 4], va[8 * j + 5], 1.0f, 2); o[j] = __builtin_amdgcn_cvt_scalef32_pk_fp4_f32(o[j], va[8 * j + 6], va[8 * j + 7], 1.0f, 3);
                        o[2 + j] = __builtin_amdgcn_cvt_scalef32_pk_fp4_f32(o[2 + j], vb[8 * j + 0], vb[8 * j + 1], 1.0f, 0); o[2 + j] = __builtin_amdgcn_cvt_scalef32_pk_fp4_f32(o[2 + j], vb[8 * j + 2], vb[8 * j + 3], 1.0f, 1);
                        o[2 + j] = __builtin_amdgcn_cvt_scalef32_pk_fp4_f32(o[2 + j], vb[8 * j + 4], vb[8 * j + 5], 1.0f, 2); o[2 + j] = __builtin_amdgcn_cvt_scalef32_pk_fp4_f32(o[2 + j], vb[8 * j + 6], vb[8 * j + 7], 1.0f, 3); }
                    *(u32x4*)(ws + (hb ? WS_VB : WS_UB) + (size_t)(e0 + q) * 512 + l5 * 16) = o;
                }
                if (l5 == 0) ((float*)(ws + (hb ? WS_VSC : WS_USC)))[e0 + q] = inv;
            }
        }
    }
    if (gtid == 0) {
        float s01 = 0.f, s23 = 0.f;
        for (int i = 0; i < 64; ++i) { s01 += p.diff_lambda[i] * p.diff_lambda[64 + i]; s23 += p.diff_lambda[128 + i] * p.diff_lambda[192 + i]; }
        *(float*)(ws + WS_LAM) = expf(s01) - expf(s23) + LAMBDA_INIT;
    }
    float* rope = (float*)(ws + WS_ROPE);
    for (int i = (int)gtid; i < 64 * 16; i += (int)gsz) { const int pos = i >> 4, f = i & 15; const float inv = exp2f(-(float)f * (13.287712379549449f / 16.f)); const float a = (float)pos * inv; rope[2 * i] = cosf(a); rope[2 * i + 1] = sinf(a); }
    bf16_t* bt = (bf16_t*)(ws + WS_BIAST);
    for (int i = (int)gtid; i < 8 * 15 * 4096; i += (int)gsz) {
        const int j = i & 7, kc = (i >> 3) & 63, cq = (i >> 9) & 7, hd = i >> 12, dr = hd % 15, h = hd / 15;
        const int cp = cq * 8 + j; int cs = cp - 8; cs = cs < 0 ? 0 : (cs > 48 ? 48 : cs);
        float v = NEG_BIG;
        if (kc >= cs && kc < cs + 16) v = p.rel_bias[(h * 15 + dr) * 31 + (kc - cp + 15)] * LOG2E;
        bt[i] = (bf16_t)f2bf(v);
    }
}

__device__ __forceinline__ void p1_hrows(Frame& F, const Params& p) {
    unsigned char* ws = p.ws;
    const float* modp = (const float*)(ws + WS_MODP);
    float* mod = (float*)(ws + WS_MOD);
    for (int i = F.bid * NTHR + F.tid; i < 9 * NMOD; i += F.G * NTHR) { float s = p.b_ada[i % NMOD];
#pragma unroll
        for (int ks = 0; ks < 8; ++ks) s += modp[(size_t)ks * 9 * NMOD + i];
        mod[i] = s; }
    const int rows_per = (MALL + F.G - 1) / F.G, r0 = F.bid * rows_per, r1 = min(MALL, r0 + rows_per);
    if (r0 >= r1) return;
    const int mr_lo = r0 < MLAT ? (r0 >> 12) : 8;
    LAS float* tab = (LAS float*)F.lds;
    for (int i = F.tid; i < 2 * 2048; i += NTHR) {
        const int which = i >> 11, ss = (i >> 10) & 1, col = i & 1023; const int mr = min(8, mr_lo + which);
        const int mi = mr * NMOD + (ss == 0 ? D : 0) + col;
        float s = p.b_ada[(ss == 0 ? D : 0) + col];
#pragma unroll
        for (int ks = 0; ks < 8; ++ks) s += modp[(size_t)ks * 9 * NMOD + mi];
        tab[i] = ss == 0 ? p.g_norm[col] * (1.f + s) : s;
    }
    __syncthreads();
    bf16_t* H = (bf16_t*)(ws + WS_H);
    f32x4 nx[2][4];
#define P1_LOAD(dst, rowa_) do { _Pragma("unroll") for (int q = 0; q < 2; ++q) { const int row = min((rowa_) + q * NWAVES, MALL - 1); \
            const float* xr = row < MLAT ? p.x + (size_t)row * D : p.ctx + (size_t)(row - MLAT) * D; \
            _Pragma("unroll") for (int j = 0; j < 4; ++j) dst[q][j] = ((const f32x4*)xr)[F.lane + 64 * j]; } } while (0)
    P1_LOAD(nx, r0 + F.wave);
    for (int rowa = r0 + F.wave; rowa < r1; rowa += 2 * NWAVES) {
        f32x4 v[2][4]; float ssq[2];
#pragma unroll
        for (int q = 0; q < 2; ++q)
#pragma unroll
            for (int j = 0; j < 4; ++j) v[q][j] = nx[q][j];
        if (rowa + 2 * NWAVES < r1) P1_LOAD(nx, rowa + 2 * NWAVES);
#pragma unroll
        for (int q = 0; q < 2; ++q) { float s = 0.f;
#pragma unroll
            for (int j = 0; j < 4; ++j) s += v[q][j].x * v[q][j].x + v[q][j].y * v[q][j].y + v[q][j].z * v[q][j].z + v[q][j].w * v[q][j].w;
            ssq[q] = wave_sum(s); }
#pragma unroll
        for (int q = 0; q < 2; ++q) { const int row = rowa + q * NWAVES; if (row < r1) {
            const int mr = row < MLAT ? (row >> 12) : 8; const LAS float* tb = tab + (mr - mr_lo) * 2048;
            const float rstd = rsqrtf(ssq[q] * (1.f / D) + EPS);
#pragma unroll
            for (int j = 0; j < 4; ++j) { const int col = (F.lane + 64 * j) * 4;
                const f32x4 sc = *(const LAS f32x4*)(tb + col), sh = *(const LAS f32x4*)(tb + 1024 + col);
                const f32x4 y = (v[q][j] * rstd) * sc + sh;
                u32x2 o; o.x = pk2(y.x, y.y); o.y = pk2(y.z, y.w);
                *(u32x2*)(H + (size_t)row * D + col) = o; } } }
    }
#undef P1_LOAD
}

struct EpiQKVFast {
    static constexpr bool PERM = true, AFTER_DRAIN = false;
    unsigned char* ws;
    __device__ __forceinline__ void operator()(const pg8::f32x4 (&acc)[2][2][4][2], const pg8::Unit& u, int wr, int wc, int fr, int fq) const {
        const bool lat = u.pm < 128;
        const int kind = u.pn >> 1;
        if (!lat && (kind == 0 || kind == 3)) return;
        const int b = lat ? (u.pm >> 4) : (u.pm - 128);
        const int tb = lat ? (u.pm & 15) * 256 : 0;
        const float* rope = (const float*)(ws + WS_ROPE);
#pragma unroll
        for (int bj = 0; bj < 2; ++bj) {
            const int cc = (u.pn & 1) * 256 + bj * 128 + wc * 32 + 8 * fq;
#pragma unroll
            for (int ai = 0; ai < 2; ++ai)
#pragma unroll
                for (int m = 0; m < 4; ++m) {
                    const int rowin = ai * 128 + wr * 64 + m * 16 + fr;
                    const int t = tb + rowin;
                    const int j = lat ? 256 + t : rowin;
                    f32x4 v0 = acc[ai][bj][m][0], v1 = acc[ai][bj][m][1];
                    bf16_t* dst;
                    if (kind == 0) { dst = (bf16_t*)(ws + WS_QA) + qa_idx(b, cc >> 6, t, cc & 63); v0 = v0 * C2; v1 = v1 * C2; }
                    else if (kind == 1) dst = (bf16_t*)(ws + WS_KA) + ka_idx(b, cc >> 6, j, cc & 63);
                    else if (kind == 2) dst = (bf16_t*)(ws + WS_VA) + va_idx(b, cc >> 6, j, cc & 63);
                    else if (kind == 5) dst = (bf16_t*)(ws + WS_VD) + vd_idx(b, cc >> 7, j, cc & 127);
                    else {
                        const int mm = cc >> 8, h = (cc >> 6) & 3, d = cc & 63;
                        if (lat) { const int i0 = d >> 1; const int pos = i0 < 16 ? (t >> 6) : (t & 63); const float* rp = rope + (pos * 16 + (i0 & 15)) * 2;
                            const f32x4 r0 = *(const f32x4*)rp, r1 = *(const f32x4*)(rp + 4);
                            f32x4 a0, a1;
                            a0.x = v0.x * r0.x - v0.y * r0.y; a0.y = v0.x * r0.y + v0.y * r0.x; a0.z = v0.z * r0.z - v0.w * r0.w; a0.w = v0.z * r0.w + v0.w * r0.z;
                            a1.x = v1.x * r1.x - v1.y * r1.y; a1.y = v1.x * r1.y + v1.y * r1.x; a1.z = v1.z * r1.z - v1.w * r1.w; a1.w = v1.z * r1.w + v1.w * r1.z;
                            v0 = a0; v1 = a1; }
                        if (kind == 3) { dst = (bf16_t*)(ws + WS_QD) + qd_idx(b, mm, h, t, d); v0 = v0 * C2; v1 = v1 * C2; }
                        else dst = (bf16_t*)(ws + WS_KD) + kd_idx(b, mm, h, j, d);
                    }
                    pg8::u32x4 w; w.x = pg8::cvt_pk_bf16(v0[0], v0[1]); w.y = pg8::cvt_pk_bf16(v0[2], v0[3]); w.z = pg8::cvt_pk_bf16(v1[0], v1[1]); w.w = pg8::cvt_pk_bf16(v1[2], v1[3]);
                    *(pg8::u32x4*)dst = w;
                }
        }
    }
};


struct EpiQ2Frag {
    static constexpr bool PERM = true, AFTER_DRAIN = false;
    bf16_t* O;
    __device__ __forceinline__ void operator()(const pg8::f32x4 (&acc)[2][2][4][2], const pg8::Unit& u, int wr, int wc, int fr, int fq) const {
        const int h = u.pn;
#pragma unroll
        for (int bj = 0; bj < 2; ++bj) {
            const int c8 = wc * 4 + fq;
#pragma unroll
            for (int ai = 0; ai < 2; ++ai)
#pragma unroll
                for (int m = 0; m < 4; ++m) {
                    const int row = u.pm * 256 + ai * 128 + wr * 64 + m * 16 + fr;
                    const size_t idx = ((((((size_t)(row >> 5) * 8 + h) * 2 + bj) * 8 + (c8 >> 1)) * 2 + (c8 & 1)) * 32 + (row & 31)) * 8;
                    const f32x4 v0 = acc[ai][bj][m][0], v1 = acc[ai][bj][m][1];
                    pg8::u32x4 w; w.x = pg8::cvt_pk_bf16(v0[0], v0[1]); w.y = pg8::cvt_pk_bf16(v0[2], v0[3]); w.z = pg8::cvt_pk_bf16(v1[0], v1[1]); w.w = pg8::cvt_pk_bf16(v1[2], v1[3]);
                    *(pg8::u32x4*)(O + idx) = w;
                }
        }
    }
};

__device__ __forceinline__ void p5_rows2(Frame& F, const Params& p) {
    unsigned char* ws = p.ws;
    const float* mod = (const float*)(ws + WS_MOD);
    const bf16_t* YO = (const bf16_t*)(ws + WS_YO);
    bf16_t* H2 = (bf16_t*)(ws + WS_H2);
    const int gw = F.bid * NWAVES + F.wave, NGW = F.G * NWAVES;
    const int rows_per = (MLAT + NGW - 1) / NGW;
    const int rend = min(MLAT, (gw + 1) * rows_per);
    f32x4 nxx[2][4]; u32x2 nxy[2][4];
#define P5_LOAD(rowa_) do { _Pragma("unroll") for (int q = 0; q < 2; ++q) { const int row = min((rowa_) + q, MLAT - 1); \
            _Pragma("unroll") for (int j = 0; j < 4; ++j) { nxx[q][j] = ((const f32x4*)(p.x + (size_t)row * D))[F.lane + 64 * j]; nxy[q][j] = ((const u32x2*)(YO + (size_t)row * D))[F.lane + 64 * j]; } } } while (0)
    P5_LOAD(gw * rows_per);
    for (int rowa = gw * rows_per; rowa < rend; rowa += 2) {
        f32x4 xv[2][4], yv[2][4]; float ssq[2];
#pragma unroll
        for (int q = 0; q < 2; ++q)
#pragma unroll
            for (int j = 0; j < 4; ++j) { xv[q][j] = nxx[q][j]; const u32x2 yw = nxy[q][j]; yv[q][j] = (f32x4){bflo(yw.x), bfhi(yw.x), bflo(yw.y), bfhi(yw.y)}; }
        if (rowa + 2 < rend) P5_LOAD(rowa + 2);
#pragma unroll
        for (int q = 0; q < 2; ++q) { float s = 0.f;
#pragma unroll
            for (int j = 0; j < 4; ++j) s += yv[q][j].x * yv[q][j].x + yv[q][j].y * yv[q][j].y + yv[q][j].z * yv[q][j].z + yv[q][j].w * yv[q][j].w;
            ssq[q] = wave_sum(s); }
#pragma unroll
        for (int q = 0; q < 2; ++q) { const int row = rowa + q; if (row < MLAT) {
            const int b = row >> 12; const float* mb = mod + b * NMOD;
            const float rstd = rsqrtf(ssq[q] * (1.f / D) + EPS);
            float s2 = 0.f;
#pragma unroll
            for (int j = 0; j < 4; ++j) { const int col = (F.lane + 64 * j) * 4;
                const f32x4 g1 = *(const f32x4*)(p.g_norm + D + col), gt1 = *(const f32x4*)(mb + 2 * D + col);
                xv[q][j] = xv[q][j] + gt1 * (yv[q][j] * rstd * g1);
                *(f32x4*)(p.out + (size_t)row * D + col) = xv[q][j];
                s2 += xv[q][j].x * xv[q][j].x + xv[q][j].y * xv[q][j].y + xv[q][j].z * xv[q][j].z + xv[q][j].w * xv[q][j].w; }
            const float rstd2 = rsqrtf(wave_sum(s2) * (1.f / D) + EPS);
#pragma unroll
            for (int j = 0; j < 4; ++j) { const int col = (F.lane + 64 * j) * 4;
                const f32x4 g2 = *(const f32x4*)(p.g_norm + 2 * D + col), sh2 = *(const f32x4*)(mb + 3 * D + col), sc2 = *(const f32x4*)(mb + 4 * D + col);
                const f32x4 y = (xv[q][j] * rstd2 * g2) * (sc2 + 1.f) + sh2;
                u32x2 o; o.x = pk2(y.x, y.y); o.y = pk2(y.z, y.w);
                *(u32x2*)(H2 + (size_t)row * D + col) = o; } } }
    }
#undef P5_LOAD
}

template <int J> __device__ __forceinline__ unsigned lane_xor(unsigned x, int lane) {
    if (J == 1) return (unsigned)__builtin_amdgcn_update_dpp(0, (int)x, 0xB1, 0xf, 0xf, false);
    if (J == 2) return (unsigned)__builtin_amdgcn_update_dpp(0, (int)x, 0x4E, 0xf, 0xf, false);
    if (J == 4) { const unsigned a = (unsigned)__builtin_amdgcn_update_dpp(0, (int)x, 0x104, 0xf, 0xf, false),
                                 b = (unsigned)__builtin_amdgcn_update_dpp(0, (int)x, 0x114, 0xf, 0xf, false);
                  return (lane & 4) ? b : a; }
    if (J == 8) return (unsigned)__builtin_amdgcn_update_dpp(0, (int)x, 0x128, 0xf, 0xf, false);
    if (J == 16) { auto r = __builtin_amdgcn_permlane16_swap(x, x, false, false); return (lane & 16) ? r[0] : r[1]; }
    auto r = __builtin_amdgcn_permlane32_swap(x, x, false, false); return (lane & 32) ? r[0] : r[1];
}
template <int K2, int J> __device__ __forceinline__ void bitonic_step128(unsigned& key0, unsigned& key1, int lane) {
    if (J == 64) { const unsigned lo = key0 < key1 ? key0 : key1, hi_ = key0 < key1 ? key1 : key0; key0 = lo; key1 = hi_; }
    else {
        const unsigned p0_ = lane_xor<J>(key0, lane), p1_ = lane_xor<J>(key1, lane);
        const bool lower = (lane & J) == 0;
        const bool asc0 = K2 == 128 ? true : ((lane & K2) == 0), asc1 = K2 == 128 ? true : (((64 + lane) & K2) == 0);
        const bool kmin0 = lower == asc0, kmin1 = lower == asc1;
        key0 = kmin0 ? (key0 < p0_ ? key0 : p0_) : (key0 < p0_ ? p0_ : key0);
        key1 = kmin1 ? (key1 < p1_ ? key1 : p1_) : (key1 < p1_ ? p1_ : key1);
    }
}
__device__ __forceinline__ void sort128_asc(unsigned& k0, unsigned& k1, int lane) {
    bitonic_step128<2, 1>(k0, k1, lane);
    bitonic_step128<4, 2>(k0, k1, lane); bitonic_step128<4, 1>(k0, k1, lane);
    bitonic_step128<8, 4>(k0, k1, lane); bitonic_step128<8, 2>(k0, k1, lane); bitonic_step128<8, 1>(k0, k1, lane);
    bitonic_step128<16, 8>(k0, k1, lane); bitonic_step128<16, 4>(k0, k1, lane); bitonic_step128<16, 2>(k0, k1, lane); bitonic_step128<16, 1>(k0, k1, lane);
    bitonic_step128<32, 16>(k0, k1, lane); bitonic_step128<32, 8>(k0, k1, lane); bitonic_step128<32, 4>(k0, k1, lane); bitonic_step128<32, 2>(k0, k1, lane); bitonic_step128<32, 1>(k0, k1, lane);
    bitonic_step128<64, 32>(k0, k1, lane); bitonic_step128<64, 16>(k0, k1, lane); bitonic_step128<64, 8>(k0, k1, lane); bitonic_step128<64, 4>(k0, k1, lane); bitonic_step128<64, 2>(k0, k1, lane); bitonic_step128<64, 1>(k0, k1, lane);
    bitonic_step128<128, 64>(k0, k1, lane); bitonic_step128<128, 32>(k0, k1, lane); bitonic_step128<128, 16>(k0, k1, lane); bitonic_step128<128, 8>(k0, k1, lane); bitonic_step128<128, 4>(k0, k1, lane); bitonic_step128<128, 2>(k0, k1, lane); bitonic_step128<128, 1>(k0, k1, lane);
}
__device__ __forceinline__ float e2m3_val(int k) { return k < 8 ? (float)k * 0.125f : ldexpf(1.f + (float)(k & 7) * 0.125f, (k >> 3) - 1); }
__device__ __forceinline__ int e2m3_idx(float x) { if (x < 1.f) return (int)(x * 8.f + 0.5f); const int e = x >= 4.f ? 2 : (x >= 2.f ? 1 : 0); return 8 * (e + 1) + (int)((x / (float)(1 << e) - 1.f) * 8.f + 0.5f); }
__device__ __forceinline__ float sum8(float v) {
    v += __uint_as_float((unsigned)__builtin_amdgcn_update_dpp(0, (int)__float_as_uint(v), 0xB1, 0xf, 0xf, false));
    v += __uint_as_float((unsigned)__builtin_amdgcn_update_dpp(0, (int)__float_as_uint(v), 0x4E, 0xf, 0xf, false));
    v += __uint_as_float((unsigned)__builtin_amdgcn_update_dpp(0, (int)__float_as_uint(v), 0x141, 0xf, 0xf, false));
    return v;
}
template <int MODE> __device__ __forceinline__ void p8_gather(Frame& F, const Params& p, const XcdBarrier& bar) {
    unsigned char* ws = p.ws;
    const bf16_t* H2 = (const bf16_t*)(ws + WS_H2); const unsigned char* U6 = ws + WS_UB; const unsigned char* V6 = ws + WS_VB;
    const int* EX = (const int*)(ws + WS_EXP); const float* GT = (const float*)(ws + WS_GATE); const float* SU = (const float*)(ws + WS_SU); const float* mod = (const float*)(ws + WS_MOD);
    const int lane = F.lane, l5 = lane & 31, b5 = (lane >> 5) & 1, b4 = (lane >> 4) & 1, b3 = (lane >> 3) & 1;
    const int ent = 2 * (2 * b4 + b3) + b5;
    LAS float* scr = (LAS float*)(F.lds + F.wave * 8192);
    int sw4;
    { const unsigned cw = __builtin_amdgcn_cvt_scalef32_pk_fp4_f32(0u, 1.0f, 2.0f, 1.0f, 0); const f32x2 cr = __builtin_amdgcn_cvt_scalef32_pk_f32_fp4(cw, 1.0f, 0);
      sw4 = __builtin_amdgcn_readfirstlane(cr.x == 1.0f ? 0 : 1); }
    const unsigned mlo = (lane & 3) == 0 ? 0x0000FFFFu : ((lane & 3) == 1 ? 0xFFFF0000u : 0u), mhi = (lane & 3) == 2 ? 0x0000FFFFu : ((lane & 3) == 3 ? 0xFFFF0000u : 0u);
#define FP4BF(w_, b_) __builtin_bit_cast(unsigned, __builtin_amdgcn_cvt_scalef32_pk_bf16_fp4((w_), 1.0f, (b_)))
    unsigned* ctr = (unsigned*)(ws + WS_CTL) + CW_P8CTR + (MODE != 0 ? 16 : 0);
    int cnext = 0;
    if (lane == 0) cnext = (int)__hip_atomic_fetch_add(ctr, 1u, __ATOMIC_RELAXED, __HIP_MEMORY_SCOPE_AGENT);
    cnext = __builtin_amdgcn_readfirstlane(cnext);
    for (;;) {
        const int t = cnext;
        if (t >= MLAT) break;
        if (lane == 0) cnext = (int)__hip_atomic_fetch_add(ctr, 1u, __ATOMIC_RELAXED, __HIP_MEMORY_SCOPE_AGENT);
        const size_t tb_ = (size_t)t * 128;
        unsigned key0 = ((unsigned)EX[tb_ + lane] << 7) | (unsigned)lane, key1 = ((unsigned)EX[tb_ + 64 + lane] << 7) | (unsigned)(64 + lane);
        hs16x4 hb[8]; f32x4 acc[8];
        { const u32x4* hp = (const u32x4*)(H2 + (size_t)t * D + l5 * 32);
#pragma unroll
          for (int j = 0; j < 4; ++j) { u32x4 w = hp[j];
              if (sw4) { w.x = __builtin_amdgcn_alignbit(w.x, w.x, 16); w.y = __builtin_amdgcn_alignbit(w.y, w.y, 16); w.z = __builtin_amdgcn_alignbit(w.z, w.z, 16); w.w = __builtin_amdgcn_alignbit(w.w, w.w, 16); }
              hb[2 * j] = __builtin_bit_cast(hs16x4, (u32x2){w.x, w.y}); hb[2 * j + 1] = __builtin_bit_cast(hs16x4, (u32x2){w.z, w.w}); }
#pragma unroll
          for (int j = 0; j < 8; ++j) acc[j] = (f32x4){0.f, 0.f, 0.f, 0.f}; }
        sort128_asc(key0, key1, lane);
        for (int bb = 0; bb < 16; ++bb) {
            const unsigned kreg = bb < 8 ? key0 : key1; const int lb = (bb & 7) * 8;
            const unsigned kmine = (unsigned)__shfl((int)kreg, lb + ent);
            const float gl = GT[tb_ + (kmine & 127u)], sl = SU[tb_ + (kmine & 127u)];
            u32x4 u4[4], v4[4];
#pragma unroll
            for (int pr = 0; pr < 4; ++pr) { const int eA = (int)((unsigned)__builtin_amdgcn_readlane((int)kreg, lb + 2 * pr) >> 7), eB = (int)((unsigned)__builtin_amdgcn_readlane((int)kreg, lb + 2 * pr + 1) >> 7);
                const int e = (b5 ? eB : eA) & (MODE == 1 ? 1023 : (MODE == 3 ? 7 : 0xFFFF));
                u4[pr] = *(const u32x4*)(U6 + (size_t)e * 512 + l5 * 16); v4[pr] = *(const u32x4*)(V6 + (size_t)e * 512 + l5 * 16); }
            float d[4];
#pragma unroll
            for (int pr = 0; pr < 4; ++pr) {
                f32x4 d0 = (f32x4){0.f, 0.f, 0.f, 0.f}, d1 = d0;
#pragma unroll
                for (int j = 0; j < 4; ++j) {
                    const unsigned c0 = FP4BF(u4[pr][j], 0), c1 = FP4BF(u4[pr][j], 1), c2 = FP4BF(u4[pr][j], 2), c3 = FP4BF(u4[pr][j], 3);
                    d0 = __builtin_amdgcn_mfma_f32_4x4x4bf16_1k(__builtin_bit_cast(hs16x4, (u32x2){c0, c1}), hb[2 * j], d0, 0, 0, 0);
                    d1 = __builtin_amdgcn_mfma_f32_4x4x4bf16_1k(__builtin_bit_cast(hs16x4, (u32x2){c2, c3}), hb[2 * j + 1], d1, 0, 0, 0); }
                const f32x4 s = d0 + d1;
                d[pr] = (lane & 2) ? ((lane & 1) ? s[3] : s[2]) : ((lane & 1) ? s[1] : s[0]); }
            float r2[2], r1;
#pragma unroll
            for (int i = 0; i < 2; ++i) { auto rr = __builtin_amdgcn_permlane16_swap(__float_as_uint(d[i]), __float_as_uint(d[i + 2]), false, false); r2[i] = __uint_as_float(rr[0]) + __uint_as_float(rr[1]); }
            { const float keep = b3 ? r2[1] : r2[0], send = b3 ? r2[0] : r2[1]; r1 = keep + __uint_as_float((unsigned)__builtin_amdgcn_update_dpp(0, (int)__float_as_uint(send), 0x128, 0xf, 0xf, false)); }
            r1 = sum8(r1);
            const float pre = r1 * sl;
            float act;
            { const float av = fabsf(pre), dd = av * 0.2316418882f + 1.0f; const float tt = __builtin_amdgcn_rcpf(dd);
              float q = tt * 0.5307027145f + (-0.7265760135f); q = q * tt + 0.7107068705f; q = q * tt + (-0.142248368f); q = q * tt + 0.127414796f; q = q * tt;
              const float ee = __builtin_amdgcn_exp2f((pre * pre) * (-0.72134752044f));
              const float mm = pre * (q * ee); act = pre < 0.f ? mm : pre - mm; }
            const float cfl = gl * act;
#pragma unroll
            for (int pr = 0; pr < 4; ++pr) {
                const float cfA = __uint_as_float((unsigned)__builtin_amdgcn_readlane((int)__float_as_uint(cfl), (pr >> 1) * 16 + (pr & 1) * 8));
                const float cfB = __uint_as_float((unsigned)__builtin_amdgcn_readlane((int)__float_as_uint(cfl), 32 + (pr >> 1) * 16 + (pr & 1) * 8));
                const float cf = b5 ? cfB : cfA;
                const unsigned cfpk = __builtin_bit_cast(unsigned, __builtin_convertvector((f32x2){cf, cf}, hbf16x2));
                const hs16x4 Aop = __builtin_bit_cast(hs16x4, (u32x2){cfpk & mlo, cfpk & mhi});
#pragma unroll
                for (int j = 0; j < 4; ++j) {
                    const unsigned c0 = FP4BF(v4[pr][j], 0), c1 = FP4BF(v4[pr][j], 1), c2 = FP4BF(v4[pr][j], 2), c3 = FP4BF(v4[pr][j], 3);
                    acc[2 * j] = __builtin_amdgcn_mfma_f32_4x4x4bf16_1k(Aop, __builtin_bit_cast(hs16x4, (u32x2){c0, c1}), acc[2 * j], 0, 0, 0);
                    acc[2 * j + 1] = __builtin_amdgcn_mfma_f32_4x4x4bf16_1k(Aop, __builtin_bit_cast(hs16x4, (u32x2){c2, c3}), acc[2 * j + 1], 0, 0, 0); }
            }
        }
#pragma unroll
        for (int j = 0; j < 32; ++j) { const float av = acc[j >> 2][j & 3]; auto rr = __builtin_amdgcn_permlane32_swap(__float_as_uint(av), __float_as_uint(av), false, false); scr[(j ^ sw4) * 64 + lane] = __uint_as_float(rr[0]) + __uint_as_float(rr[1]); }
        float at[16]; float s = 0.f;
#pragma unroll
        for (int k = 0; k < 16; ++k) { at[k] = scr[(16 * b5 + k) * 64 + lane]; s += at[k] * at[k]; }
        const float rstd = rsqrtf(wave_sum(s) * (1.f / D) + EPS);
        const float* mb = mod + (t >> 12) * NMOD + 5 * D; const float* g3 = p.g_norm + 3 * D;
#pragma unroll
        for (int j = 0; j < 4; ++j) { const int col = l5 * 32 + b5 * 16 + j * 4;
            float* op = p.out + (size_t)t * D + col;
            const f32x4 x0 = *(const f32x4*)op, ga = *(const f32x4*)(g3 + col), ta = *(const f32x4*)(mb + col);
            const f32x4 pa = (f32x4){at[4 * j], at[4 * j + 1], at[4 * j + 2], at[4 * j + 3]};
            if (MODE == 0 || rstd == 123456.f) *(f32x4*)op = x0 + ta * (pa * rstd * ga); }
        cnext = __builtin_amdgcn_readfirstlane(cnext);
    }
}

namespace att {
typedef short bf16x8 __attribute__((ext_vector_type(8)));
typedef short s16x4 __attribute__((ext_vector_type(4)));
typedef float f32x16 __attribute__((ext_vector_type(16)));
typedef __attribute__((address_space(3))) const unsigned char* lcp;
typedef __attribute__((address_space(3))) unsigned char* lp;
constexpr int NA_SLOT = 16384, NA_BIAS_OFF = 32768, WSF_OFF = 155648;
constexpr int DF_SLOT = 32768;
constexpr float THRL = 8.f;

__device__ __forceinline__ int crow(int r, int hi) { return (r & 3) + 8 * (r >> 2) + 4 * hi; }
__device__ __forceinline__ s16x4 vtr(lcp p) { return __builtin_bit_cast(s16x4, __builtin_amdgcn_ds_read_tr16_b64_v4i16((__attribute__((address_space(3))) s16x4*)p)); }
typedef float f32x2_t __attribute__((ext_vector_type(2))); typedef __bf16 bf16x2v_t __attribute__((ext_vector_type(2)));
__device__ __forceinline__ unsigned cvtpk(float lo, float hi) { f32x2_t v = {lo, hi}; bf16x2v_t b = __builtin_convertvector(v, bf16x2v_t); return __builtin_bit_cast(unsigned, b); }
__device__ __forceinline__ float swap_half(float v) { auto rr = __builtin_amdgcn_permlane32_swap(__float_as_uint(v), __float_as_uint(v), false, false); return __uint_as_float(rr[0]) == v ? __uint_as_float(rr[1]) : __uint_as_float(rr[0]); }
__device__ __forceinline__ void dma16(const void* gsrc, lp lds_dst) {
    unsigned keep; const unsigned dst = (unsigned)__builtin_amdgcn_readfirstlane((int)(unsigned)(size_t)lds_dst);
    asm volatile("s_mov_b32 %0, m0\n\ts_mov_b32 m0, %2\n\ts_nop 0\n\tglobal_load_lds_dwordx4 %1, off\n\ts_mov_b32 m0, %0" : "=&s"(keep) : "v"(gsrc), "s"(dst) : "memory");
}
__device__ __forceinline__ float max3f(float a, float b, float c) { float r; asm("v_max3_f32 %0, %1, %2, %3" : "=v"(r) : "v"(a), "v"(b), "v"(c)); return r; }
__device__ __forceinline__ float rowmax32(const f32x16& p0, const f32x16& p1) {
    float a = max3f(p0[0], p0[1], p1[0]), b = max3f(p0[2], p0[3], p1[1]); a = max3f(a, p1[2], p1[3]);
#pragma unroll
    for (int r = 4; r < 16; r += 4) { a = max3f(a, p0[r], p0[r + 1]); b = max3f(b, p0[r + 2], p0[r + 3]); a = max3f(a, p1[r], p1[r + 1]); b = max3f(b, p1[r + 2], p1[r + 3]); }
    float m = max3f(a, b, b);
    auto rr = __builtin_amdgcn_permlane32_swap(__float_as_uint(m), __float_as_uint(m), false, false);
    return max3f(__uint_as_float(rr[0]), __uint_as_float(rr[1]), __uint_as_float(rr[1]));
}

typedef __bf16 bf16x2_t __attribute__((ext_vector_type(2)));
__device__ __forceinline__ float psum_bf16(const u32x4 (&pw)[4], float acc) {
    const bf16x2_t ones = __builtin_bit_cast(bf16x2_t, 0x3F803F80u); float a0 = acc, a1 = 0.f;
#pragma unroll
    for (int k = 0; k < 4; ++k) { a0 = __builtin_amdgcn_fdot2_f32_bf16(__builtin_bit_cast(bf16x2_t, pw[k][0]), ones, a0, false); a1 = __builtin_amdgcn_fdot2_f32_bf16(__builtin_bit_cast(bf16x2_t, pw[k][1]), ones, a1, false);
        a0 = __builtin_amdgcn_fdot2_f32_bf16(__builtin_bit_cast(bf16x2_t, pw[k][2]), ones, a0, false); a1 = __builtin_amdgcn_fdot2_f32_bf16(__builtin_bit_cast(bf16x2_t, pw[k][3]), ones, a1, false); }
    return a0 + a1;
}
template <int NDV> struct FlashState { float mhat, l; f32x16 negm; f32x16 o[NDV]; };

template <int NDV, bool BIAS>
__device__ __forceinline__ void flash_tile(FlashState<NDV>& st, const bf16x8 (&qr)[4], lcp Kslot, lcp Vslot, lcp Bslot, const bf16x8 (&qoh)[2],
                                           __attribute__((address_space(3))) float* wsf, int r32, int hi, int lane, bool first) {
    f32x16 p0 = st.negm, p1 = st.negm;
    lcp kb = Kslot + hi * 1024 + r32 * 16;
    bf16x8 kf[8], bf_[4];
#pragma unroll
    for (int d0 = 0; d0 < 4; ++d0) { kf[2 * d0] = *(const __attribute__((address_space(3))) bf16x8*)(kb + d0 * 2048); kf[2 * d0 + 1] = *(const __attribute__((address_space(3))) bf16x8*)(kb + d0 * 2048 + 512); }
    if (BIAS) { lcp bb = Bslot + hi * 1024 + r32 * 16;
#pragma unroll
        for (int e = 0; e < 2; ++e) { bf_[2 * e] = *(const __attribute__((address_space(3))) bf16x8*)(bb + e * 2048); bf_[2 * e + 1] = *(const __attribute__((address_space(3))) bf16x8*)(bb + e * 2048 + 512); } }
    lcp vb = Vslot + ((lane >> 4) & 1) * 32 + (lane & 3) * 8 + (4 * hi + ((lane & 15) >> 2)) * 64;
    s16x4 va[8], vn[8];
#pragma unroll
    for (int ks = 0; ks < 4; ++ks) { va[2 * ks] = vtr(vb + ks * 1024); va[2 * ks + 1] = vtr(vb + ks * 1024 + 512); }
#pragma unroll
    for (int d0 = 0; d0 < 4; ++d0) { p0 = __builtin_amdgcn_mfma_f32_32x32x16_bf16(kf[2 * d0], qr[d0], p0, 0, 0, 0); p1 = __builtin_amdgcn_mfma_f32_32x32x16_bf16(kf[2 * d0 + 1], qr[d0], p1, 0, 0, 0); }
    if (BIAS) {
#pragma unroll
        for (int e = 0; e < 2; ++e) { p0 = __builtin_amdgcn_mfma_f32_32x32x16_bf16(bf_[2 * e], qoh[e], p0, 0, 0, 0); p1 = __builtin_amdgcn_mfma_f32_32x32x16_bf16(bf_[2 * e + 1], qoh[e], p1, 0, 0, 0); }
    }
    asm volatile("s_nop 15\n\ts_nop 7" : "+v"(p0), "+v"(p1));
    const float rm = rowmax32(p0, p1);
    if (first) {
        st.mhat += rm;
#pragma unroll
        for (int r = 0; r < 16; ++r) { p0[r] -= rm; p1[r] -= rm; st.negm[r] = -st.mhat; }
    } else if (__any(rm > THRL)) {
        const float dl = fmaxf(rm, 0.f); const float alpha = __builtin_amdgcn_exp2f(-dl); st.mhat += dl; st.l *= alpha;
        if (hi == 0) wsf[r32] = alpha;
        asm volatile("s_waitcnt lgkmcnt(0)" ::: "memory");
        float al[16];
#pragma unroll
        for (int r = 0; r < 16; ++r) al[r] = wsf[crow(r, hi)];
#pragma unroll
        for (int d = 0; d < NDV; ++d)
#pragma unroll
            for (int r = 0; r < 16; ++r) st.o[d][r] *= al[r];
#pragma unroll
        for (int r = 0; r < 16; ++r) { p0[r] -= dl; p1[r] -= dl; st.negm[r] = -st.mhat; }
    }
    float sacc = 0.f;
#pragma unroll
    for (int r = 0; r < 16; ++r) { p0[r] = __builtin_amdgcn_exp2f(p0[r]); p1[r] = __builtin_amdgcn_exp2f(p1[r]); sacc += p0[r] + p1[r]; }
    st.l += sacc;
    u32x4 pw[4];
#pragma unroll
    for (int i = 0; i < 4; ++i) { pw[0][i] = cvtpk(p0[2 * i], p0[2 * i + 1]); pw[1][i] = cvtpk(p0[8 + 2 * i], p0[8 + 2 * i + 1]); pw[2][i] = cvtpk(p1[2 * i], p1[2 * i + 1]); pw[3][i] = cvtpk(p1[8 + 2 * i], p1[8 + 2 * i + 1]); }
    __builtin_amdgcn_sched_barrier(0);
#pragma unroll
    for (int d0 = 0; d0 < NDV; ++d0) {
#pragma unroll
        for (int ks = 0; ks < 4; ++ks) {
            if (d0 < NDV - 1) { vn[2 * ks] = vtr(vb + (d0 + 1) * 4096 + ks * 1024); vn[2 * ks + 1] = vtr(vb + (d0 + 1) * 4096 + ks * 1024 + 512); }
            const bf16x8 vf = (bf16x8){va[2 * ks][0], va[2 * ks][1], va[2 * ks][2], va[2 * ks][3], va[2 * ks + 1][0], va[2 * ks + 1][1], va[2 * ks + 1][2], va[2 * ks + 1][3]};
            st.o[d0] = __builtin_amdgcn_mfma_f32_32x32x16_bf16(__builtin_bit_cast(bf16x8, pw[ks]), vf, st.o[d0], 0, 0, 0);
            __builtin_amdgcn_sched_barrier(0);
        }
#pragma unroll
        for (int i = 0; i < 8; ++i) va[i] = vn[i];
    }
}

constexpr int NA2_SLOT = 16384, NA2_BIAS_OFF = 65536;
__device__ __forceinline__ void na_units(Frame& F, const Params& p) {
    unsigned char* ws = p.ws;
    const bf16_t* QA = (const bf16_t*)(ws + WS_QA); const bf16_t* KA = (const bf16_t*)(ws + WS_KA); const bf16_t* VA = (const bf16_t*)(ws + WS_VA);
    const bf16_t* BT = (const bf16_t*)(ws + WS_BIAST); bf16_t* Y = (bf16_t*)(ws + WS_Y);
    const int lane = F.lane, r32 = lane & 31, hi = lane >> 5, wave = F.wave;
    lp lds = (lp)F.lds;
    __attribute__((address_space(3))) float* wsf = (__attribute__((address_space(3))) float*)(lds + WSF_OFF) + wave * 64;
    const int upw = 1024 / F.G;
    int cur_h = -1, cur_lo = -1, cur_hi = -1;
    bf16x8 qoh[2];
#pragma unroll
    for (int e = 0; e < 2; ++e)
#pragma unroll
        for (int j = 0; j < 8; ++j) qoh[e][j] = (16 * e + 8 * hi + j == r32) ? (short)0x3F80 : (short)0;
    for (int ui = 0; ui < upw; ++ui) {
        const int u = F.bid * upw + ui, bh = u >> 4, rg = u & 15, b = bh >> 3, h = bh & 7;
        const int r0 = rg * 4, r = r0 + (wave >> 1), ch = wave & 1;
        int rs = r - 4; rs = rs < 0 ? 0 : (rs > 56 ? 56 : rs);
        int kr_lo = r0 - 4; kr_lo = kr_lo < 0 ? 0 : (kr_lo > 56 ? 56 : kr_lo);
        int kr_hi = r0 + 3 - 4; kr_hi = kr_hi < 0 ? 0 : (kr_hi > 56 ? 56 : kr_hi); kr_hi += 7;
        const int T = 4 + (kr_hi - kr_lo + 1);
        int dr_lo = 99, dr_hi = -1;
#pragma unroll
        for (int q = 0; q < 4; ++q) { int s_ = r0 + q - 4; s_ = s_ < 0 ? 0 : (s_ > 56 ? 56 : s_); const int a = s_ - (r0 + q) + 7; dr_lo = a < dr_lo ? a : dr_lo; dr_hi = a + 7 > dr_hi ? a + 7 : dr_hi; }
        const bf16_t* Kb = KA + (size_t)bh * NKT * 4096; const bf16_t* Vb = VA + (size_t)bh * NKT * 4096;
        if (h != cur_h || dr_lo != cur_lo || dr_hi != cur_hi) {
            cur_h = h; cur_lo = dr_lo; cur_hi = dr_hi;
            const unsigned char* src = (const unsigned char*)(BT + ((size_t)h * 15 + dr_lo) * 4096);
            const int npc = (dr_hi - dr_lo + 1) * 8;
            for (int pi = wave; pi < npc; pi += 8) dma16(src + pi * 1024 + lane * 16, lds + NA2_BIAS_OFF + pi * 1024);
        }
        bf16x8 qr[4];
        { const bf16_t* qp = QA + ((size_t)bh * SEQ + r * 64 + ch * 32 + r32) * 64 + hi * 8;
#pragma unroll
          for (int d0 = 0; d0 < 4; ++d0) qr[d0] = *(const bf16x8*)(qp + d0 * 16); }
#define NA_DMA(i_) do { const int tg_ = (i_) < 4 ? (i_) : (4 + kr_lo + (i_) - 4); lp sl_ = lds + ((i_) & 3) * NA2_SLOT; \
            dma16((const unsigned char*)(Kb + (size_t)tg_ * 4096) + wave * 1024 + lane * 16, sl_ + wave * 1024); \
            dma16((const unsigned char*)(Vb + (size_t)tg_ * 4096) + wave * 1024 + lane * 16, sl_ + 8192 + wave * 1024); } while (0)
        NA_DMA(0); NA_DMA(1);
        FlashState<2> st; st.mhat = 0.f; st.l = 0.f;
#pragma unroll
        for (int rr = 0; rr < 16; ++rr) st.negm[rr] = 0.f;
#pragma unroll
        for (int d = 0; d < 2; ++d)
#pragma unroll
            for (int rr = 0; rr < 16; ++rr) st.o[d][rr] = 0.f;
        for (int i = 0; i < T; ++i) {
            if (i + 1 < T) asm volatile("s_waitcnt vmcnt(2)" ::: "memory"); else asm volatile("s_waitcnt vmcnt(0)" ::: "memory");
            __syncthreads();
            if (i + 2 < T) NA_DMA(i + 2);
            lcp sl = (lcp)(lds + (i & 3) * NA2_SLOT);
            if (i < 4) flash_tile<2, false>(st, qr, sl, sl + 8192, sl, qoh, wsf, r32, hi, lane, i == 0);
            else { const int kr = kr_lo + (i - 4);
                if (kr >= rs && kr < rs + 8) { const int dr = kr - r + 7;
                    flash_tile<2, true>(st, qr, sl, sl + 8192, (lcp)(lds + NA2_BIAS_OFF + (dr - dr_lo) * 8192 + ch * 4096), qoh, wsf, r32, hi, lane, false); } }
        }
#undef NA_DMA
        float lt = st.l; { auto rr = __builtin_amdgcn_permlane32_swap(__float_as_uint(lt), __float_as_uint(lt), false, false); lt = __uint_as_float(rr[0]) + __uint_as_float(rr[1]); }
        if (hi == 0) wsf[32 + r32] = lt;
        asm volatile("s_waitcnt lgkmcnt(0)" ::: "memory");
        bf16_t* yb = Y + ((size_t)b * SEQ + r * 64 + ch * 32) * D + h * 64 + r32;
#pragma unroll
        for (int rr = 0; rr < 16; ++rr) { const float rl = __builtin_amdgcn_rcpf(wsf[32 + crow(rr, hi)]);
#pragma unroll
            for (int d0 = 0; d0 < 2; ++d0) yb[(size_t)crow(rr, hi) * D + d0 * 32] = (bf16_t)f2bf(st.o[d0][rr] * rl); }
        __syncthreads();
    }
}

template <int MODE> __device__ __forceinline__ void diff_units_v2(Frame& F, const Params& p) {
    unsigned char* ws = p.ws;
    const bf16_t* QD = (const bf16_t*)(ws + WS_QD); const bf16_t* KD = (const bf16_t*)(ws + WS_KD); const bf16_t* VD = (const bf16_t*)(ws + WS_VD);
    bf16_t* Y = (bf16_t*)(ws + WS_Y);
    const float lam = *(const float*)(ws + WS_LAM);
    const int lane = F.lane, r32 = lane & 31, hi = lane >> 5, wave = F.wave, map = wave >> 2, qg = wave & 3;
    lp lds = (lp)F.lds;
    __attribute__((address_space(3))) float* wsf = (__attribute__((address_space(3))) float*)(lds + WSF_OFF) + wave * 64;
    __attribute__((address_space(3))) float* X = (__attribute__((address_space(3))) float*)lds;
    const int upw = 1024 / F.G;
    const int koff = map * 8192 + hi * 1024 + r32 * 16;
    const int voff = 16384 + ((lane >> 4) & 1) * 32 + (lane & 3) * 8 + (4 * hi + ((lane & 15) >> 2)) * 64;
    for (int ui = 0; ui < upw; ++ui) {
        int bh, qb;
        if (F.G == 256) { bh = (F.bid & 7) * 4 + ui; qb = F.bid >> 3; } else { const int u = F.bid * upw + ui; bh = u >> 5; qb = u & 31; }
        const int b = bh >> 2, h = bh & 3;
        const unsigned char* K1 = (const unsigned char*)(KD + (size_t)((b * 2 + 0) * 4 + h) * NKT * 4096);
        const unsigned char* K2 = (const unsigned char*)(KD + (size_t)((b * 2 + 1) * 4 + h) * NKT * 4096);
        const unsigned char* Vg = (const unsigned char*)(VD + (size_t)bh * NKT * 8192);
#define DF_DMA(t, slot) do { if (MODE != 1 && MODE != 3) { lp sl_ = lds + (slot) * DF_SLOT; \
            dma16(K1 + (size_t)(t) * 8192 + wave * 1024 + lane * 16, sl_ + wave * 1024); \
            dma16(K2 + (size_t)(t) * 8192 + wave * 1024 + lane * 16, sl_ + 8192 + wave * 1024); \
            dma16(Vg + (size_t)(t) * 16384 + wave * 1024 + lane * 16, sl_ + 16384 + wave * 1024); \
            dma16(Vg + (size_t)(t) * 16384 + 8192 + wave * 1024 + lane * 16, sl_ + 24576 + wave * 1024); } } while (0)
        DF_DMA(0, 0); DF_DMA(1, 1);
        const int q0 = qb * 128 + qg * 32;
        bf16x8 qr[4];
        { const bf16_t* qp = QD + ((size_t)((b * 2 + map) * 4 + h) * SEQ + q0 + r32) * 64 + hi * 8;
#pragma unroll
          for (int d0 = 0; d0 < 4; ++d0) qr[d0] = *(const bf16x8*)(qp + d0 * 16); }
        float mhat = 0.f, lsum = 0.f; f32x16 o[4], negm;
#pragma unroll
        for (int d = 0; d < 4; ++d)
#pragma unroll
            for (int rr = 0; rr < 16; ++rr) o[d][rr] = 0.f;
        asm volatile("s_waitcnt vmcnt(0)" ::: "memory");
        __syncthreads();
        f32x16 s0, s1;
#pragma unroll
        for (int rr = 0; rr < 16; ++rr) { s0[rr] = 0.f; s1[rr] = 0.f; }
        { lcp kb = (lcp)(lds + koff);
#pragma unroll
          for (int d0 = 0; d0 < 4; ++d0) {
              const bf16x8 b0 = *(const __attribute__((address_space(3))) bf16x8*)(kb + d0 * 2048), b1 = *(const __attribute__((address_space(3))) bf16x8*)(kb + d0 * 2048 + 512);
              s0 = __builtin_amdgcn_mfma_f32_32x32x16_bf16(b0, qr[d0], s0, 0, 0, 0); s1 = __builtin_amdgcn_mfma_f32_32x32x16_bf16(b1, qr[d0], s1, 0, 0, 0); } }
        { asm volatile("s_nop 15\n\ts_nop 7" : "+v"(s0), "+v"(s1)); const float rm0 = rowmax32(s0, s1); mhat = rm0;
#pragma unroll
          for (int rr = 0; rr < 16; ++rr) { s0[rr] -= rm0; s1[rr] -= rm0; negm[rr] = -rm0; } }
        u32x4 pw[4];
#define EXP4(X, B) do { X[B] = __builtin_amdgcn_exp2f(X[B]); X[B + 1] = __builtin_amdgcn_exp2f(X[B + 1]); X[B + 2] = __builtin_amdgcn_exp2f(X[B + 2]); X[B + 3] = __builtin_amdgcn_exp2f(X[B + 3]); sacc += X[B]; asm("" : "+v"(sacc)); sacc += X[B + 1]; asm("" : "+v"(sacc)); sacc += X[B + 2]; asm("" : "+v"(sacc)); sacc += X[B + 3]; asm("" : "+v"(sacc)); } while (0)
#define STAGE_A(t_) do { \
            lcp nxt = (lcp)(lds + (((t_) + 1) & 3) * DF_SLOT); \
            bf16x8 kf[8]; \
            _Pragma("unroll") for (int d0 = 0; d0 < 4; ++d0) { kf[2 * d0] = *(const __attribute__((address_space(3))) bf16x8*)(nxt + koff + d0 * 2048); kf[2 * d0 + 1] = *(const __attribute__((address_space(3))) bf16x8*)(nxt + koff + d0 * 2048 + 512); } \
            asm volatile("s_nop 15\n\ts_nop 7" : "+v"(s0), "+v"(s1)); \
            const float rm = rowmax32(s0, s1); \
            if (__any(rm > THRL)) { \
                const float dl = fmaxf(rm, 0.f); const float alpha = __builtin_amdgcn_exp2f(-dl); mhat += dl; lsum *= alpha; \
                if (hi == 0) wsf[r32] = alpha; \
                asm volatile("s_waitcnt lgkmcnt(0)" ::: "memory"); \
                float al[16]; \
                _Pragma("unroll") for (int r = 0; r < 16; ++r) al[r] = wsf[crow(r, hi)]; \
                _Pragma("unroll") for (int d = 0; d < 4; ++d) _Pragma("unroll") for (int r = 0; r < 16; ++r) o[d][r] *= al[r]; \
                _Pragma("unroll") for (int r = 0; r < 16; ++r) { s0[r] -= dl; s1[r] -= dl; negm[r] = -mhat; } \
            } \
            f32x16 n0, n1; float sacc = 0.f; \
            __builtin_amdgcn_sched_barrier(0); \
            n0 = __builtin_amdgcn_mfma_f32_32x32x16_bf16(kf[0], qr[0], negm, 0, 0, 0); EXP4(s0, 0);  __builtin_amdgcn_sched_barrier(0); \
            n1 = __builtin_amdgcn_mfma_f32_32x32x16_bf16(kf[1], qr[0], negm, 0, 0, 0); EXP4(s0, 4);  __builtin_amdgcn_sched_barrier(0); \
            n0 = __builtin_amdgcn_mfma_f32_32x32x16_bf16(kf[2], qr[1], n0, 0, 0, 0); EXP4(s0, 8);  __builtin_amdgcn_sched_barrier(0); \
            n1 = __builtin_amdgcn_mfma_f32_32x32x16_bf16(kf[3], qr[1], n1, 0, 0, 0); EXP4(s0, 12); __builtin_amdgcn_sched_barrier(0); \
            n0 = __builtin_amdgcn_mfma_f32_32x32x16_bf16(kf[4], qr[2], n0, 0, 0, 0); EXP4(s1, 0);  __builtin_amdgcn_sched_barrier(0); \
            n1 = __builtin_amdgcn_mfma_f32_32x32x16_bf16(kf[5], qr[2], n1, 0, 0, 0); EXP4(s1, 4);  __builtin_amdgcn_sched_barrier(0); \
            n0 = __builtin_amdgcn_mfma_f32_32x32x16_bf16(kf[6], qr[3], n0, 0, 0, 0); EXP4(s1, 8);  __builtin_amdgcn_sched_barrier(0); \
            n1 = __builtin_amdgcn_mfma_f32_32x32x16_bf16(kf[7], qr[3], n1, 0, 0, 0); EXP4(s1, 12); __builtin_amdgcn_sched_barrier(0); \
            _Pragma("unroll") for (int i = 0; i < 4; ++i) { pw[0][i] = cvtpk(s0[2 * i], s0[2 * i + 1]); pw[1][i] = cvtpk(s0[8 + 2 * i], s0[8 + 2 * i + 1]); pw[2][i] = cvtpk(s1[2 * i], s1[2 * i + 1]); pw[3][i] = cvtpk(s1[8 + 2 * i], s1[8 + 2 * i + 1]); } \
            lsum += sacc; \
            s0 = n0; s1 = n1; \
        } while (0)
#define STAGE_B(tl_) do { \
            lcp vb = (lcp)(lds + ((tl_) & 3) * DF_SLOT) + voff; \
            s16x4 va[8], vn[8]; \
            _Pragma("unroll") for (int ks = 0; ks < 4; ++ks) { va[2 * ks] = vtr(vb + ks * 1024); va[2 * ks + 1] = vtr(vb + ks * 1024 + 512); } \
            __builtin_amdgcn_sched_barrier(0); \
            _Pragma("unroll") for (int d0 = 0; d0 < 4; ++d0) { \
                _Pragma("unroll") for (int ks = 0; ks < 4; ++ks) { \
                    if (d0 < 3) { vn[2 * ks] = vtr(vb + (d0 + 1) * 4096 + ks * 1024); vn[2 * ks + 1] = vtr(vb + (d0 + 1) * 4096 + ks * 1024 + 512); } \
                    const bf16x8 vf = (bf16x8){va[2 * ks][0], va[2 * ks][1], va[2 * ks][2], va[2 * ks][3], va[2 * ks + 1][0], va[2 * ks + 1][1], va[2 * ks + 1][2], va[2 * ks + 1][3]}; \
                    o[d0] = __builtin_amdgcn_mfma_f32_32x32x16_bf16(__builtin_bit_cast(bf16x8, pw[ks]), vf, o[d0], 0, 0, 0); \
                    __builtin_amdgcn_sched_barrier(0); \
                } \
                _Pragma("unroll") for (int i = 0; i < 8; ++i) va[i] = vn[i]; \
            } \
        } while (0)
        for (int t = 0; t < NKT; ++t) {
            if (t > 0) { asm volatile("s_waitcnt vmcnt(0)" ::: "memory"); if (MODE != 3) __syncthreads(); }
            if (t + 2 < NKT) DF_DMA(t + 2, (t + 2) & 3);
            if (MODE != 2) {
                if (map == 1 && t > 0) STAGE_B(t - 1);
                STAGE_A(t);
                if (map == 0) STAGE_B(t);
            }
        }
        if (MODE != 2 && map == 1) STAGE_B(NKT - 1);
#undef STAGE_A
#undef STAGE_B
#undef EXP4
#undef DF_DMA
        float lt = lsum; { auto rr = __builtin_amdgcn_permlane32_swap(__float_as_uint(lt), __float_as_uint(lt), false, false); lt = __uint_as_float(rr[0]) + __uint_as_float(rr[1]); }
        if (hi == 0) wsf[32 + r32] = lt;
        asm volatile("s_waitcnt lgkmcnt(0)" ::: "memory");
#pragma unroll
        for (int rr = 0; rr < 16; ++rr) { const float rl = __builtin_amdgcn_rcpf(wsf[32 + crow(rr, hi)]);
#pragma unroll
            for (int d = 0; d < 4; ++d) o[d][rr] *= rl; }
        __syncthreads();
        if (map == 1) {
#pragma unroll
            for (int d = 0; d < 4; ++d)
#pragma unroll
                for (int rr = 0; rr < 16; ++rr) X[((qg * 4 + d) * 16 + rr) * 64 + lane] = o[d][rr];
        }
        __syncthreads();
        if (map == 0 && (MODE == 0 || lam == 123456.f)) {
            float ss[16];
#pragma unroll
            for (int rr = 0; rr < 16; ++rr) { float s = 0.f;
#pragma unroll
                for (int d = 0; d < 4; ++d) { const float v = o[d][rr] - lam * X[((qg * 4 + d) * 16 + rr) * 64 + lane]; o[d][rr] = v; s += v * v; }
                ss[rr] = s; }
#pragma unroll
            for (int oo = 1; oo < 32; oo <<= 1)
#pragma unroll
                for (int rr = 0; rr < 16; ++rr) ss[rr] += __shfl_xor(ss[rr], oo);
            float g[4];
#pragma unroll
            for (int d = 0; d < 4; ++d) g[d] = p.diff_subln[d * 32 + r32] * (1.f - LAMBDA_INIT);
            bf16_t* yb = Y + ((size_t)b * SEQ + q0) * D + 512 + h * 128 + r32;
#pragma unroll
            for (int rr = 0; rr < 16; ++rr) { const float rn = rsqrtf(ss[rr] * (1.f / 128.f) + EPS);
#pragma unroll
                for (int d = 0; d < 4; ++d) yb[(size_t)crow(rr, hi) * D + d * 32] = (bf16_t)f2bf(o[d][rr] * rn * g[d]); }
        }
        __syncthreads();
    }
}
}

__device__ __forceinline__ void p3_attention(Frame& F, const Params& p) {
    att::na_units(F, p);
    att::diff_units_v2<0>(F, p);
}

namespace tk {
typedef short bf16x8 __attribute__((ext_vector_type(8)));
typedef float f32x16 __attribute__((ext_vector_type(16)));
constexpr int WLK_OFF = 65536;
__device__ __forceinline__ unsigned ord(float f) { const unsigned u = __float_as_uint(f); return u ^ ((unsigned)((int)u >> 31) | 0x80000000u); }
__device__ __forceinline__ float unord(unsigned o) { return __uint_as_float(o ^ ((o & 0x80000000u) ? 0x80000000u : 0xFFFFFFFFu)); }
__device__ __forceinline__ void cs_desc(unsigned& a, unsigned& b) { const unsigned mx = a > b ? a : b, mn = a > b ? b : a; a = mx; b = mn; }
__device__ __forceinline__ void sort16_desc(unsigned (&v)[16]) {
#pragma unroll
    for (int k = 2; k <= 16; k <<= 1)
#pragma unroll
        for (int j = k >> 1; j > 0; j >>= 1)
#pragma unroll
            for (int i = 0; i < 16; ++i) { const int l = i ^ j; if (l > i) { if ((i & k) == 0 || k == 16) cs_desc(v[i], v[l]); else cs_desc(v[l], v[i]); } }
}
__device__ __forceinline__ void bmerge16_desc(unsigned (&v)[16]) {
#pragma unroll
    for (int j = 8; j > 0; j >>= 1)
#pragma unroll
        for (int i = 0; i < 16; ++i) { const int l = i ^ j; if (l > i) cs_desc(v[i], v[l]); }
}
__device__ __forceinline__ void merge_top16(unsigned (&a)[16], const unsigned (&b)[16]) {
#pragma unroll
    for (int i = 0; i < 16; ++i) a[i] = a[i] > b[15 - i] ? a[i] : b[15 - i];
    bmerge16_desc(a);
}
__device__ __forceinline__ void top16_of_64x2(unsigned (&v0)[16], unsigned (&v1)[16], unsigned (&v2)[16], unsigned (&v3)[16]) {
    sort16_desc(v0); sort16_desc(v1); sort16_desc(v2); sort16_desc(v3);
    merge_top16(v0, v1); merge_top16(v2, v3); merge_top16(v0, v2);
    unsigned pb[16];
#pragma unroll
    for (int i = 0; i < 16; ++i) pb[i] = (unsigned)__shfl_xor((int)v0[i], 32);
    merge_top16(v0, pb);
}
}

__device__ __forceinline__ void p7_topk(Frame& F, const Params& p) {
    using namespace tk;
    unsigned char* ws = p.ws;
    const bf16_t* Q2 = (const bf16_t*)(ws + WS_Q2); const unsigned char* KI = (const unsigned char*)(ws + WS_KEYSI);
    int* EX = (int*)(ws + WS_EXP); float* GT = (float*)(ws + WS_GATE); float* SUo = (float*)(ws + WS_SU);
    const float* USC = (const float*)(ws + WS_USC); const float* VSC = (const float*)(ws + WS_VSC);
    const int lane = F.lane, r32 = lane & 31, hi = lane >> 5, wave = F.wave;
    att::lp lds = (att::lp)F.lds;
    LAS int* W = (LAS int*)(F.lds + WLK_OFF + wave * 8192);
    const int ntask = 1024 / F.G;
    const int h = F.bid & 7;
    { const unsigned char* src = KI + (size_t)h * 65536;
      for (int k = 0; k < 8; ++k) { const int pi = wave + 8 * k; att::dma16(src + pi * 1024 + lane * 16, lds + pi * 1024); } }
    asm volatile("s_waitcnt vmcnt(0)" ::: "memory");
    __syncthreads();
    bf16x8 qf[8], qn[8];
    { const int tb32 = ((F.bid >> 3) * ntask) * 8 + wave;
      const bf16_t* qp = Q2 + ((((size_t)tb32 * 8 + h) * 2 + 0) * 8 * 2 + hi) * 256 + r32 * 8;
#pragma unroll
      for (int s = 0; s < 8; ++s) qn[s] = *(const bf16x8*)(qp + s * 512); }
    for (int ti = 0; ti < ntask; ++ti) {
        const int tb = (F.bid >> 3) * ntask + ti;
        const int t = tb * 256 + wave * 32 + r32;
        unsigned A[16], B[16];
#pragma unroll
        for (int pp = 0; pp < 2; ++pp) {
#pragma unroll
            for (int s = 0; s < 8; ++s) qf[s] = qn[s];
            { const int nti = pp == 0 ? ti : ti + 1, npp = pp ^ 1;
              if (nti < ntask) { const int tb32 = ((F.bid >> 3) * ntask + nti) * 8 + wave;
                  const bf16_t* qp = Q2 + ((((size_t)tb32 * 8 + h) * 2 + npp) * 8 * 2 + hi) * 256 + r32 * 8;
#pragma unroll
                  for (int s = 0; s < 8; ++s) qn[s] = *(const bf16x8*)(qp + s * 512); } }
            f32x16 acc[4];
#pragma unroll
            for (int kb = 0; kb < 4; ++kb)
#pragma unroll
                for (int r = 0; r < 16; ++r) acc[kb][r] = 0.f;
            att::lcp ab = (att::lcp)(lds + pp * 32768 + hi * 2048 + r32 * 16);
#pragma unroll
            for (int s = 0; s < 8; ++s)
#pragma unroll
                for (int kb = 0; kb < 4; ++kb) {
                    const bf16x8 a = *(const __attribute__((address_space(3))) bf16x8*)(ab + s * 4096 + kb * 512);
                    acc[kb] = __builtin_amdgcn_mfma_f32_32x32x16_bf16(a, qf[s], acc[kb], 0, 0, 0);
                }
            unsigned v0[16], v1[16], v2[16], v3[16];
#pragma unroll
            for (int r = 0; r < 16; ++r) {
                const int c = 127 - ((r & 3) + 8 * (r >> 2));
                v0[r] = (ord(acc[0][r]) & 0xFFFFFF80u) | (unsigned)(c - 0 - 4 * hi);
                v1[r] = (ord(acc[1][r]) & 0xFFFFFF80u) | (unsigned)(c - 32 - 4 * hi);
                v2[r] = (ord(acc[2][r]) & 0xFFFFFF80u) | (unsigned)(c - 64 - 4 * hi);
                v3[r] = (ord(acc[3][r]) & 0xFFFFFF80u) | (unsigned)(c - 96 - 4 * hi);
            }
            top16_of_64x2(v0, v1, v2, v3);
            if (pp == 0) {
#pragma unroll
                for (int i = 0; i < 16; ++i) A[i] = v0[i];
            } else {
#pragma unroll
                for (int i = 0; i < 16; ++i) B[i] = v0[i];
            }
        }
        float fa[16], fb[16];
#pragma unroll
        for (int i = 0; i < 16; ++i) { fa[i] = unord(A[i] & 0xFFFFFF80u); fb[i] = unord(B[i] & 0xFFFFFF80u);
            W[i * 64 + lane] = 127 - (int)(A[i] & 127u); W[(16 + i) * 64 + lane] = 127 - (int)(B[i] & 127u); }
        unsigned c0[16], c1[16], c2[16], c3[16];
#pragma unroll
        for (int j = 0; j < 16; ++j) c0[j] = (ord(fa[0] + fb[j]) & 0xFFFFFF00u) | (unsigned)(255 - j);
        {
            int n = 0;
#pragma unroll
            for (int i = 1; i < 16; ++i)
#pragma unroll
                for (int j = 0; j < 16; ++j) if ((i + 1) * (j + 1) <= 16) {
                    const unsigned key = (ord(fa[i] + fb[j]) & 0xFFFFFF00u) | (unsigned)(255 - (i * 16 + j));
                    if (n < 16) c1[n] = key; else if (n < 32) c2[n - 16] = key; else c3[n - 32] = key;
                    ++n;
                }
#pragma unroll
            for (int k = 2; k < 16; ++k) c3[k] = 0u;
        }
        sort16_desc(c1); sort16_desc(c2); sort16_desc(c3);
        merge_top16(c0, c1); merge_top16(c2, c3); merge_top16(c0, c2);
        float ev[16]; float l = 0.f; const float mx = unord(c0[0] & 0xFFFFFF00u);
#pragma unroll
        for (int k = 0; k < 16; ++k) { ev[k] = __expf(unord(c0[k] & 0xFFFFFF00u) - mx); l += ev[k]; }
        const float rl = 1.f / l;
        int ex[8]; float gt[8], su[8];
#pragma unroll
        for (int kk = 0; kk < 8; ++kk) {
            const unsigned key = hi ? c0[8 + kk] : c0[kk]; const float e = hi ? ev[8 + kk] : ev[kk];
            const int pos = 255 - (int)(key & 255u);
            ex[kk] = W[(pos >> 4) * 64 + lane] * 128 + W[(16 + (pos & 15)) * 64 + lane];
            gt[kk] = e * rl * VSC[ex[kk]]; su[kk] = USC[ex[kk]];
        }
        int* ep = EX + (size_t)t * 128 + h * 16 + hi * 8; float* gp = GT + (size_t)t * 128 + h * 16 + hi * 8;
        *(u32x4*)ep = (u32x4){(unsigned)ex[0], (unsigned)ex[1], (unsigned)ex[2], (unsigned)ex[3]}; *(u32x4*)(ep + 4) = (u32x4){(unsigned)ex[4], (unsigned)ex[5], (unsigned)ex[6], (unsigned)ex[7]};
        *(f32x4*)gp = (f32x4){gt[0], gt[1], gt[2], gt[3]}; *(f32x4*)(gp + 4) = (f32x4){gt[4], gt[5], gt[6], gt[7]};
        float* sp = SUo + (size_t)t * 128 + h * 16 + hi * 8;
        *(f32x4*)sp = (f32x4){su[0], su[1], su[2], su[3]}; *(f32x4*)(sp + 4) = (f32x4){su[4], su[5], su[6], su[7]};
    }
    __syncthreads();
}

#define P8_SYNC 0
#define P8_PARTITION 0
#define HAVE_P3 1
#define HAVE_P7 1
struct Args { Params p; int ph_lo, ph_hi, li, pad; };
__global__ void __launch_bounds__(NTHR, 2) mk_fwd(Args a) {
    extern __shared__ __attribute__((aligned(16))) unsigned char lds[];
    Frame F;
    F.lds = (LAS unsigned char*)lds;
    F.MISC = (volatile LAS unsigned*)(F.lds + MISC_OFF);
    F.tid = threadIdx.x; F.lane = F.tid & 63; F.wave = __builtin_amdgcn_readfirstlane(F.tid >> 6);
    F.G = gridDim.x; F.bid = blockIdx.x;
    const Params& p = a.p;
    gu32* ctl = (gu32*)(p.ws + WS_CTL);
    for (int u = F.tid; u < 128; u += NTHR) ((LAS unsigned*)(F.lds + MISC_OFF))[u] = 0u;
    __syncthreads();
    XcdBarrier bar = xcd_barrier_post((unsigned*)(ctl + CW_BAR) + a.li * XCD_BAR_WORDS, F.MISC + 8);
    const int lo = a.ph_lo, hi = a.ph_hi;
#ifdef PROBE_TS
    int nts_ = 0;
#define STAMP() do { if (threadIdx.x == 0 && nts_ < 12) { const unsigned long long t_ = __builtin_amdgcn_s_memrealtime(); F.MISC[32 + 2 * nts_] = (unsigned)t_; F.MISC[33 + 2 * nts_] = (unsigned)(t_ >> 32); } ++nts_; } while (0)
    STAMP();
#else
#define STAMP() do {} while (0)
#endif
#define IN(k) (lo <= (k) && (k) < hi)
#define REFRESH() do { F.lane = (int)__builtin_amdgcn_mbcnt_hi(~0u, __builtin_amdgcn_mbcnt_lo(~0u, 0u)); F.tid = F.wave * 64 + F.lane; } while (0)
#define SEAM(k) do { if (IN(k) && IN((k) + 1)) xcd_barrier(bar); STAMP(); } while (0)

#ifndef PROBE_DUP
#define PROBE_DUP -1
#endif
#define REP(k) for (int rep_ = 0; rep_ < (PROBE_DUP == (k) ? 2 : 1); ++rep_)
    if (IN(0)) { REP(0) p0_prologue(F, p); SEAM(0); }
    if (IN(1)) { REP(1) { p1_hrows(F, p); __syncthreads(); } SEAM(1); }
    if (IN(2)) {
        pg8::Gemm g{(const bf16_t*)(p.ws + WS_H), (const bf16_t*)(p.ws + WS_WIN), MALL, NQKV, D}; pg8::StaticOrder S; S.init(MALL, NQKV, F.G, F.bid);
        EpiQKVFast E{p.ws};
        REP(2) pg8::gemm_phase<EpiQKVFast, pg8::StaticOrder, true, true>(F.lds + RING_OFF, g, S, E);
        SEAM(2);
    }
#if HAVE_P3
    if (IN(3)) { REP(31) att::na_units(F, p); att::diff_units_v2<0>(F, p);
#if PROBE_DUP == 321
        att::diff_units_v2<1>(F, p);
#elif PROBE_DUP == 323
        att::diff_units_v2<3>(F, p);
#elif PROBE_DUP == 322
        att::diff_units_v2<2>(F, p);
#elif PROBE_DUP == 32
        att::diff_units_v2<0>(F, p);
#endif
        SEAM(3); }
#endif
    if (IN(4)) {
        pg8::Gemm g{(const bf16_t*)(p.ws + WS_Y), (const bf16_t*)(p.ws + WS_WOUT), MLAT, D, D}; pg8::StaticOrder S; S.init(MLAT, D, F.G, F.bid);
        pg8::EpiBf16<0> E{(bf16_t*)(p.ws + WS_YO), D, nullptr, 0, 0, 1.f};
        REP(4) pg8::gemm_phase<pg8::EpiBf16<0>, pg8::StaticOrder, true, true>(F.lds + RING_OFF, g, S, E);
        SEAM(4);
    }
    if (IN(5)) { REP(5) p5_rows2(F, p); SEAM(5); }
    if (IN(6)) {
        pg8::Gemm g{(const bf16_t*)(p.ws + WS_H2), (const bf16_t*)(p.ws + WS_WPQ), MLAT, 2048, D}; pg8::StaticOrder S; S.init(MLAT, 2048, F.G, F.bid);
        EpiQ2Frag E{(bf16_t*)(p.ws + WS_Q2)};
        REP(6) pg8::gemm_phase<EpiQ2Frag, pg8::StaticOrder, true, true>(F.lds + RING_OFF, g, S, E);
        SEAM(6);
    }
#if HAVE_P7
    if (IN(7)) { REP(7) p7_topk(F, p); SEAM(7); }
#endif
#if P8_PARTITION
    if (IN(8)) {
        p7b_sort(F, p); xcd_barrier(bar);
        for (int ch = 0; ch < 2; ++ch) { p8a_part(F, p, ch); xcd_barrier(bar); p8b_combine(F, p, ch); if (ch == 0) xcd_barrier(bar); }
    }
#else
    if (IN(8)) {
#if PROBE_DUP == 81
        p8_gather<1>(F, p, bar);
#elif PROBE_DUP == 82
        p8_gather<2>(F, p, bar);
#elif PROBE_DUP == 83
        p8_gather<3>(F, p, bar);
#endif
        p8_gather<0>(F, p, bar); }
#endif
#ifdef PROBE_TS
#ifdef PROBE_TS_ENDBAR
    xcd_barrier(bar);
#endif
    STAMP();
    if (blockIdx.x == 0 && threadIdx.x == 0) { const unsigned long long t1_ = ((unsigned long long)F.MISC[33 + 2 * (PROBE_TS + 1)] << 32) | F.MISC[32 + 2 * (PROBE_TS + 1)], t0_ = ((unsigned long long)F.MISC[33 + 2 * PROBE_TS] << 32) | F.MISC[32 + 2 * PROBE_TS];
        const unsigned long long dt = t1_ - t0_; const unsigned long long t_end = __builtin_amdgcn_s_memrealtime();
        while (__builtin_amdgcn_s_memrealtime() - t_end < 8ull * dt) __builtin_amdgcn_s_sleep(8); }
#endif
#undef IN
#undef SEAM
}

static void launch_mk(const Params& p, int lo, int hi, int li, hipStream_t stream) {
    Args a{}; a.p = p; a.ph_lo = lo; a.ph_hi = hi; a.li = li; a.pad = 0;
    hipLaunchKernelGGL(mk_fwd, dim3(256), dim3(NTHR), LDS_BYTES, stream, a);
}
extern "C" void kernel_launch(void* const* d_in, const int* in_sizes, int n_in, void* d_out, int out_size, void* d_ws, size_t ws_size, hipStream_t stream) {
    if (n_in != 16 || ws_size < WS_END) return;
    static bool attr_done = false;
    if (!attr_done) {
        (void)hipFuncSetAttribute((const void*)mk_fwd, hipFuncAttributeMaxDynamicSharedMemorySize, LDS_BYTES);
        attr_done = true;
    }
    Params p{};
    p.x = (const float*)d_in[0]; p.c = (const float*)d_in[1]; p.ctx = (const float*)d_in[2]; p.c_ctx = (const float*)d_in[3];
    p.w_ada = (const float*)d_in[4]; p.b_ada = (const float*)d_in[5]; p.g_norm = (const float*)d_in[6]; p.w_in = (const float*)d_in[7];
    p.rel_bias = (const float*)d_in[8]; p.diff_lambda = (const float*)d_in[9]; p.diff_subln = (const float*)d_in[10]; p.w_out = (const float*)d_in[11];
    p.peer_wq = (const float*)d_in[12]; p.peer_keys = (const float*)d_in[13]; p.peer_u = (const float*)d_in[14]; p.peer_v = (const float*)d_in[15];
    p.out = (float*)d_out; p.ws = (unsigned char*)d_ws;
    (void)hipMemsetAsync((char*)d_ws + WS_CTL, 0, CTL_ZERO_BYTES, stream);

    launch_mk(p, 0, 9, 0, stream);

}
```

```cpp
#include <hip/hip_runtime.h>
#include <stdint.h>
#include <math.h>

typedef unsigned short bf16_t;
typedef float f32x4 __attribute__((ext_vector_type(4)));
typedef unsigned u32x4 __attribute__((ext_vector_type(4)));
typedef unsigned u32x2 __attribute__((ext_vector_type(2)));
typedef float f32x2 __attribute__((ext_vector_type(2)));

constexpr int D = 1024, BATCH = 8, SEQ = 4096, CTX = 256, GW = 64;
constexpr int MLAT = BATCH * SEQ;
constexpr int MCTX = BATCH * CTX;
constexpr int MALL = MLAT + MCTX;
constexpr int NQKV = 3072;
constexpr int NKT = 68;
constexpr int NMOD = 6 * D;
constexpr int PE_H = 8, PE_NK = 128, PE_QD = 256, PE_TOPK = 16, PE_NEXP = 16384;
constexpr float EPS = 1e-6f;
constexpr float LOG2E = 1.4426950408889634f;
constexpr float C2 = 0.125f * LOG2E;
constexpr float LAMBDA_INIT = 0.2f;
constexpr float NEG_BIG = -30000.0f;

constexpr size_t MiB = 1u << 20;
constexpr size_t WS_CTL = 0;
constexpr size_t WS_MOD = 1 * MiB;
constexpr size_t WS_LAM = 1 * MiB + 256 * 1024;
constexpr size_t WS_ROPE = 1 * MiB + 512 * 1024;
constexpr size_t WS_USC = 1 * MiB + 640 * 1024;
constexpr size_t WS_VSC = 1 * MiB + 704 * 1024;
constexpr size_t WS_MODP = 2 * MiB;
constexpr size_t WS_BIAST = 4 * MiB;
constexpr size_t WS_KEYS = 5 * MiB;
constexpr size_t WS_KEYSI = 5 * MiB + 512 * 1024;
constexpr size_t WS_WIN = 6 * MiB;
constexpr size_t WS_WOUT = 12 * MiB;
constexpr size_t WS_WPQ = 14 * MiB;
constexpr size_t WS_UB = 18 * MiB;
constexpr size_t WS_VB = 50 * MiB;
constexpr size_t WS_EXP = 82 * MiB;
constexpr size_t WS_GATE = 98 * MiB;
constexpr size_t WS_H2 = 114 * MiB;
constexpr size_t WS_H = 178 * MiB;
constexpr size_t WS_Y = 178 * MiB;
constexpr size_t WS_QA = 246 * MiB;
constexpr size_t WS_KA = 278 * MiB;
constexpr size_t WS_VA = 312 * MiB;
constexpr size_t WS_QD = 346 * MiB;
constexpr size_t WS_KD = 378 * MiB;
constexpr size_t WS_VD = 412 * MiB;
constexpr size_t WS_YO = 246 * MiB;
constexpr size_t WS_Q2 = 246 * MiB;
constexpr size_t WS_PART = 178 * MiB;
constexpr size_t WS_DSCR = 464 * MiB;
constexpr size_t WS_SU = 446 * MiB;
constexpr size_t WS_END = 496 * MiB;

struct Params {
    const float *x, *c, *ctx, *c_ctx, *w_ada, *b_ada, *g_norm, *w_in, *rel_bias, *diff_lambda, *diff_subln, *w_out, *peer_wq, *peer_keys, *peer_u, *peer_v;
    float* out;
    unsigned char* ws;
};

__device__ __forceinline__ unsigned f2bf(float f) { unsigned u = __builtin_bit_cast(unsigned, f); return (u + 0x7fffu + ((u >> 16) & 1u)) >> 16; }
__device__ __forceinline__ unsigned pk2(float lo, float hi) { return f2bf(lo) | (f2bf(hi) << 16); }
__device__ __forceinline__ float bf2f(bf16_t h) { return __builtin_bit_cast(float, (unsigned)h << 16); }
__device__ __forceinline__ float bflo(unsigned w) { return __builtin_bit_cast(float, w << 16); }
__device__ __forceinline__ float bfhi(unsigned w) { return __builtin_bit_cast(float, w & 0xffff0000u); }
__device__ __forceinline__ float wave_sum(float v) {
    v += __uint_as_float((unsigned)__builtin_amdgcn_update_dpp(0, (int)__float_as_uint(v), 0xB1, 0xf, 0xf, false));
    v += __uint_as_float((unsigned)__builtin_amdgcn_update_dpp(0, (int)__float_as_uint(v), 0x4E, 0xf, 0xf, false));
    v += __uint_as_float((unsigned)__builtin_amdgcn_update_dpp(0, (int)__float_as_uint(v), 0x141, 0xf, 0xf, false));
    v += __uint_as_float((unsigned)__builtin_amdgcn_update_dpp(0, (int)__float_as_uint(v), 0x128, 0xf, 0xf, false));
    { auto r = __builtin_amdgcn_permlane16_swap(__float_as_uint(v), __float_as_uint(v), false, false); v = __uint_as_float(r[0]) + __uint_as_float(r[1]); }
    { auto r = __builtin_amdgcn_permlane32_swap(__float_as_uint(v), __float_as_uint(v), false, false); v = __uint_as_float(r[0]) + __uint_as_float(r[1]); }
    return v;
}
__device__ __forceinline__ float wave_max(float v) {
    v = fmaxf(v, __uint_as_float((unsigned)__builtin_amdgcn_update_dpp(0, (int)__float_as_uint(v), 0xB1, 0xf, 0xf, false)));
    v = fmaxf(v, __uint_as_float((unsigned)__builtin_amdgcn_update_dpp(0, (int)__float_as_uint(v), 0x4E, 0xf, 0xf, false)));
    v = fmaxf(v, __uint_as_float((unsigned)__builtin_amdgcn_update_dpp(0, (int)__float_as_uint(v), 0x141, 0xf, 0xf, false)));
    v = fmaxf(v, __uint_as_float((unsigned)__builtin_amdgcn_update_dpp(0, (int)__float_as_uint(v), 0x128, 0xf, 0xf, false)));
    { auto r = __builtin_amdgcn_permlane16_swap(__float_as_uint(v), __float_as_uint(v), false, false); v = fmaxf(__uint_as_float(r[0]), __uint_as_float(r[1])); }
    { auto r = __builtin_amdgcn_permlane32_swap(__float_as_uint(v), __float_as_uint(v), false, false); v = fmaxf(__uint_as_float(r[0]), __uint_as_float(r[1])); }
    return v;
}

__device__ __forceinline__ float half_max(float v) {
    v = fmaxf(v, __uint_as_float((unsigned)__builtin_amdgcn_update_dpp(0, (int)__float_as_uint(v), 0xB1, 0xf, 0xf, false)));
    v = fmaxf(v, __uint_as_float((unsigned)__builtin_amdgcn_update_dpp(0, (int)__float_as_uint(v), 0x4E, 0xf, 0xf, false)));
    v = fmaxf(v, __uint_as_float((unsigned)__builtin_amdgcn_update_dpp(0, (int)__float_as_uint(v), 0x141, 0xf, 0xf, false)));
    v = fmaxf(v, __uint_as_float((unsigned)__builtin_amdgcn_update_dpp(0, (int)__float_as_uint(v), 0x128, 0xf, 0xf, false)));
    { auto r = __builtin_amdgcn_permlane16_swap(__float_as_uint(v), __float_as_uint(v), false, false); v = fmaxf(__uint_as_float(r[0]), __uint_as_float(r[1])); }
    return v;
}
typedef float f32x16 __attribute__((ext_vector_type(16)));
typedef float f32x32 __attribute__((ext_vector_type(32)));
typedef unsigned u32x6 __attribute__((ext_vector_type(6)));

__device__ __forceinline__ u32x6 enc_fp6(f32x16 a, f32x16 b) { u32x6 w; asm volatile("v_cvt_scalef32_2xpk16_fp6_f32 %0, %1, %2, 1.0" : "=&v"(w) : "v"(a), "v"(b)); return w; }
__device__ __forceinline__ f32x32 dec_fp6(u32x6 w) { f32x32 r; asm volatile("v_cvt_scalef32_pk32_f32_fp6 %0, %1, 1.0" : "=&v"(r) : "v"(w)); return r; }

typedef short hs16x4 __attribute__((ext_vector_type(4)));
typedef __bf16 hbf16x2 __attribute__((ext_vector_type(2)));

typedef unsigned u32x16 __attribute__((ext_vector_type(16)));

__device__ __forceinline__ int ktile_off(int k, int d) { return (d >> 3) * 512 + k * 8 + (d & 7); }
__device__ __forceinline__ int vtile_off(int k, int d) { return (d >> 5) * 2048 + (k >> 4) * 512 + (k & 15) * 32 + (d & 31); }
__device__ __forceinline__ size_t qa_idx(int b, int h, int t, int d) { return ((size_t)(b * 8 + h) * SEQ + t) * 64 + d; }
__device__ __forceinline__ size_t ka_idx(int b, int h, int j, int d) { return ((size_t)(b * 8 + h) * NKT + (j >> 6)) * 4096 + ktile_off(j & 63, d); }
__device__ __forceinline__ size_t va_idx(int b, int h, int j, int d) { return ((size_t)(b * 8 + h) * NKT + (j >> 6)) * 4096 + vtile_off(j & 63, d); }
__device__ __forceinline__ size_t qd_idx(int b, int m, int h, int t, int d) { return ((size_t)((b * 2 + m) * 4 + h) * SEQ + t) * 64 + d; }
__device__ __forceinline__ size_t kd_idx(int b, int m, int h, int j, int d) { return ((size_t)((b * 2 + m) * 4 + h) * NKT + (j >> 6)) * 4096 + ktile_off(j & 63, d); }
__device__ __forceinline__ size_t vd_idx(int b, int h, int j, int d) { return ((size_t)(b * 4 + h) * NKT + (j >> 6)) * 8192 + vtile_off(j & 63, d); }


namespace pg8 {
#define PG8_LAS __attribute__((address_space(3)))
typedef unsigned short bf16_t;
typedef short bf16x8 __attribute__((ext_vector_type(8)));
typedef float f32x4 __attribute__((ext_vector_type(4)));
typedef unsigned u32x4 __attribute__((ext_vector_type(4)));
constexpr int BM = 256, BK = 64, HALF = 128, HTB = HALF * BK * 2  , STAGE_BYTES = 8 * HTB, NXCD = 8, WGM = 8;

__host__ __device__ __forceinline__ int lds_byte(int r, int c) { const int st = (r >> 4) * 2 + (c >> 5), rr = r & 15, cc = c & 31, ob = rr * 64 + cc * 2; return st * 1024 + (ob ^ (((ob >> 9) & 1) << 5)); }
__host__ __device__ __forceinline__ void stage_rc(int b, int& R, int& C) { const int st = b / 1024, sb = b % 1024, swz = sb ^ (((sb >> 9) & 1) << 5); R = (st >> 1) * 16 + swz / 64; C = (st & 1) * 32 + (swz % 64) / 2; }
__host__ __device__ __forceinline__ int perm32(int rho) { const int n = rho >> 4, i = rho & 15; return 8 * (i >> 2) + 4 * n + (i & 3); }

struct Unit { int pm, pn; };
struct Gemm { const bf16_t* A; const bf16_t* Bt; int M, N, K; };

struct StaticOrder {
    int nM, nN, nwg, G, c;
    __host__ __device__ void init(int M, int N, int G_, int c_) { nM = M / BM; nN = N / BM; nwg = nM * nN; G = G_; c = c_; }
    __host__ __device__ bool next(int i, Unit& u) const {
        const long L = (long)i * G + c; if (L >= nwg) return false;
        int wgid = (int)L; { const int q = nwg / NXCD, r = nwg % NXCD, xcd = wgid % NXCD, off = wgid / NXCD; wgid = (xcd < r ? xcd * (q + 1) : r * (q + 1) + (xcd - r) * q) + off; }
        const int nig = WGM * nN, gid = wgid / nig, fm = gid * WGM, gsz = (nM - fm) < WGM ? (nM - fm) : WGM;
        u.pm = fm + ((wgid % nig) % gsz); u.pn = (wgid % nig) / gsz; return true;
    }
    __device__ __forceinline__ void a_ready(const Unit&) const {}
    __device__ __forceinline__ void done(const Unit&) const {}
};

__device__ __forceinline__ unsigned cvt_pk_bf16(float lo, float hi) { unsigned r; asm volatile("v_cvt_pk_bf16_f32 %0, %1, %2" : "=v"(r) : "v"(lo), "v"(hi)); return r; }
typedef float f32x2 __attribute__((ext_vector_type(2)));
__device__ __forceinline__ f32x2 gelu_pk(f32x2 v) {
    const f32x2 av = __builtin_elementwise_abs(v), d = av * 0.2316418882f + 1.0f;
    f32x2 t; t.x = __builtin_amdgcn_rcpf(d.x); t.y = __builtin_amdgcn_rcpf(d.y);
    f32x2 q = t * 0.5307027145f + (-0.7265760135f); q = q * t + 0.7107068705f; q = q * t + (-0.142248368f); q = q * t + 0.127414796f; q = q * t;
    const f32x2 s = (v * v) * (-0.72134752044f);
    f32x2 e; e.x = __builtin_amdgcn_exp2f(s.x); e.y = __builtin_amdgcn_exp2f(s.y);
    const f32x2 m = v * (q * e), r = v - m;
    f32x2 o; o.x = v.x < 0.f ? m.x : r.x; o.y = v.y < 0.f ? m.y : r.y; return o;
}

template <int ACT  > struct EpiBf16 {
    static constexpr bool PERM = true, AFTER_DRAIN = false; static_assert(ACT == 0 || ACT == 1, "EpiBf16: ACT is 0 (none) or 1 (gelu_pk)");
    bf16_t* O; int ldc; const float* bias; int split_cols; size_t split_stride; float scale0;
    __device__ __forceinline__ void operator()(const f32x4 (&acc)[2][2][4][2], const Unit& u, int wr, int wc, int fr, int fq) const {
        const int row0 = u.pm * BM + wr * 64 + fr; int colt = u.pn * BM; bf16_t* base = O;
        float sc = 1.f; if (split_cols) { const int t = colt / split_cols; base += (size_t)t * split_stride; colt -= t * split_cols; if (t == 0) sc = scale0; }
        const int col0 = colt + wc * 32 + 8 * fq, bcol0 = u.pn * BM + wc * 32 + 8 * fq;
        f32x4 bv[2][2];
#pragma unroll
        for (int bj = 0; bj < 2; ++bj)
#pragma unroll
            for (int n = 0; n < 2; ++n) bv[bj][n] = bias ? *(const f32x4*)(bias + bcol0 + bj * HALF + 4 * n) : (f32x4){0.f, 0.f, 0.f, 0.f};
#pragma unroll
        for (int ai = 0; ai < 2; ++ai)
#pragma unroll
            for (int m = 0; m < 4; ++m) { bf16_t* rowp = base + (size_t)(row0 + ai * HALF + m * 16) * ldc + col0;
#pragma unroll
                for (int bj = 0; bj < 2; ++bj) { f32x4 v0 = acc[ai][bj][m][0] + bv[bj][0], v1 = acc[ai][bj][m][1] + bv[bj][1];
                    if (ACT == 1) { f32x2 a = gelu_pk((f32x2){v0[0], v0[1]}), b = gelu_pk((f32x2){v0[2], v0[3]}), c = gelu_pk((f32x2){v1[0], v1[1]}), d = gelu_pk((f32x2){v1[2], v1[3]});
                        v0 = (f32x4){a.x, a.y, b.x, b.y}; v1 = (f32x4){c.x, c.y, d.x, d.y}; }
                    v0 = v0 * sc; v1 = v1 * sc; u32x4 w; w.x = cvt_pk_bf16(v0[0], v0[1]); w.y = cvt_pk_bf16(v0[2], v0[3]); w.z = cvt_pk_bf16(v1[0], v1[1]); w.w = cvt_pk_bf16(v1[2], v1[3]);
                    *(u32x4*)(rowp + bj * HALF) = w; } }
    }
};

template <class Epi, class Sched, bool ALIGN_EPI = false, bool SP2 = false>
__device__ __forceinline__ void gemm_phase(PG8_LAS unsigned char* lds, const Gemm g, const Sched& S, const Epi& E) {
    const int tid = threadIdx.x, wid = __builtin_amdgcn_readfirstlane(tid >> 6), lane = tid & 63, wr = wid >> 2, wc = wid & 3, fr = lane & 15, fq = lane >> 4;
    const int K = g.K, nt = K / BK;
    unsigned voffA[2], voffB[2];
#pragma unroll
    for (int i = 0; i < 2; ++i) { int R, C; stage_rc(tid * 16 + i * 8192, R, C); const int Rb = Epi::PERM ? ((R & ~31) + perm32(R & 31)) : R;
        voffA[i] = (unsigned)(R * K + C) * 2u; voffB[i] = (unsigned)(Rb * K + C) * 2u; }
    const size_t kstep = (size_t)(BK * 2);
    const size_t hstep = (size_t)HALF * K * 2;
    const size_t tstep = 2 * hstep;
    const unsigned ldsw = (unsigned)wid * 1024u;
    const int aoff = lds_byte(wr * 64 + fr, fq * 8), boff = lds_byte(wc * 32 + fr, fq * 8);
#define PG8_SA(b, h) (((b) * 2 + (h)) * HTB)
#define PG8_SB(b, h) ((4 + (b) * 2 + (h)) * HTB)
#define PG8_STAGE(bufoff, gbase, voff) do { _Pragma("unroll") for (int _i = 0; _i < 2; ++_i) \
        __builtin_amdgcn_global_load_lds((const unsigned*)((const char*)(gbase) + (voff)[_i]), (PG8_LAS unsigned*)(lds + (bufoff) + ldsw + _i * 8192), 16, 0, 0); } while (0)
#define PG8_LDA(dst, b, h) do { _Pragma("unroll") for (int m = 0; m < 4; ++m) _Pragma("unroll") for (int k = 0; k < 2; ++k) dst[m][k] = *(const PG8_LAS bf16x8*)(lds + PG8_SA(b, h) + aoff + m * 2048 + k * 1024); } while (0)
#define PG8_LDB(dst, b, h) do { _Pragma("unroll") for (int n = 0; n < 2; ++n) _Pragma("unroll") for (int k = 0; k < 2; ++k) dst[n][k] = *(const PG8_LAS bf16x8*)(lds + PG8_SB(b, h) + boff + n * 2048 + k * 1024); } while (0)
#define PG8_MMA(ai, bj, At, Bt) do { __builtin_amdgcn_s_setprio(1); _Pragma("unroll") for (int m = 0; m < 4; ++m) _Pragma("unroll") for (int n = 0; n < 2; ++n) _Pragma("unroll") for (int k = 0; k < 2; ++k) \
        acc[ai][bj][m][n] = __builtin_amdgcn_mfma_f32_16x16x32_bf16(Bt[n][k], At[m][k], acc[ai][bj][m][n], 0, 0, 0); __builtin_amdgcn_s_setprio(0); } while (0)
#define PG8_WAIT_V(n) asm volatile("s_waitcnt vmcnt(" #n ")" ::: "memory")
#define PG8_WAIT_L(n) asm volatile("s_waitcnt lgkmcnt(" #n ")" ::: "memory")
#define PG8_BAR __builtin_amdgcn_s_barrier()
#define PG8_SCHED __builtin_amdgcn_sched_barrier(0)
    Unit cur, nxt; int ui = 0;
    if (!S.next(0, cur)) return;
    f32x4 acc[2][2][4][2];
#pragma unroll
    for (int a = 0; a < 2; ++a)
#pragma unroll
        for (int b = 0; b < 2; ++b)
#pragma unroll
            for (int m = 0; m < 4; ++m)
#pragma unroll
                for (int n = 0; n < 2; ++n) acc[a][b][m][n] = (f32x4){0.f, 0.f, 0.f, 0.f};
    bf16x8 At[4][2], B0[2][2], B1[2][2];
    const char* cA = (const char*)g.A + (size_t)cur.pm * tstep; const char* cB = (const char*)g.Bt + (size_t)cur.pn * tstep;
    S.a_ready(cur);
    if constexpr (SP2) {
        PG8_STAGE(PG8_SB(0, 0), cB, voffB); PG8_STAGE(PG8_SB(0, 1), cB + hstep, voffB); PG8_STAGE(PG8_SA(0, 0), cA, voffA); PG8_STAGE(PG8_SA(0, 1), cA + hstep, voffA);
        if (wr == 1) PG8_BAR;
        PG8_WAIT_V(2); PG8_BAR;
        PG8_STAGE(PG8_SB(1, 0), cB + kstep, voffB); PG8_STAGE(PG8_SA(1, 0), cA + kstep, voffA); PG8_STAGE(PG8_SB(1, 1), cB + hstep + kstep, voffB);
        PG8_WAIT_V(6); PG8_BAR;
    } else {
        PG8_STAGE(PG8_SB(0, 0), cB, voffB); PG8_STAGE(PG8_SA(0, 0), cA, voffA); PG8_STAGE(PG8_SB(0, 1), cB + hstep, voffB); PG8_STAGE(PG8_SA(0, 1), cA + hstep, voffA);
        if (wr == 1) PG8_BAR;
        PG8_WAIT_V(4); PG8_BAR;
        PG8_STAGE(PG8_SB(1, 0), cB + kstep, voffB); PG8_STAGE(PG8_SA(1, 0), cA + kstep, voffA); PG8_STAGE(PG8_SB(1, 1), cB + hstep + kstep, voffB);
        PG8_WAIT_V(6); PG8_BAR;
    }
    for (;;) {
        const bool has_next = S.next(ui + 1, nxt);
        const char* nA = has_next ? (const char*)g.A + (size_t)nxt.pm * tstep : cA; const char* nB = has_next ? (const char*)g.Bt + (size_t)nxt.pn * tstep : cB;
        for (int t = 0; t < nt; t += 2) {
            const bool last = (t == nt - 2);
            const char* a1 = cA + (size_t)(t + 1) * kstep;
            const char* a2 = last ? nA : cA + (size_t)(t + 2) * kstep; const char* b2 = last ? nB : cB + (size_t)(t + 2) * kstep;
            const char* a3 = a2 + kstep; const char* b3 = b2 + kstep;
            if (last && has_next) S.a_ready(nxt);
            if constexpr (SP2) {
            PG8_LDB(B0, 0, 0); PG8_LDB(B1, 0, 1); PG8_SCHED; PG8_LDA(At, 0, 0); PG8_STAGE(PG8_SA(1, 1), a1 + hstep, voffA);
            PG8_WAIT_V(8); PG8_WAIT_L(0); PG8_BAR; PG8_MMA(0, 0, At, B0); PG8_MMA(0, 1, At, B1); PG8_BAR; PG8_SCHED;
            PG8_LDA(At, 0, 1); PG8_STAGE(PG8_SB(0, 0), b2, voffB); PG8_STAGE(PG8_SB(0, 1), b2 + hstep, voffB); PG8_STAGE(PG8_SA(0, 0), a2, voffA);
            PG8_WAIT_V(8); PG8_WAIT_L(0); PG8_BAR; PG8_MMA(1, 0, At, B0); PG8_MMA(1, 1, At, B1); PG8_BAR; PG8_SCHED;
            PG8_LDB(B0, 1, 0); PG8_LDB(B1, 1, 1); PG8_SCHED; PG8_LDA(At, 1, 0); PG8_STAGE(PG8_SA(0, 1), a2 + hstep, voffA);
            PG8_WAIT_V(8); PG8_WAIT_L(0); PG8_BAR; PG8_MMA(0, 0, At, B0); PG8_MMA(0, 1, At, B1); PG8_BAR; PG8_SCHED;
            PG8_LDA(At, 1, 1); PG8_STAGE(PG8_SB(1, 0), b3, voffB); PG8_STAGE(PG8_SB(1, 1), b3 + hstep, voffB); PG8_STAGE(PG8_SA(1, 0), a3, voffA);
            PG8_WAIT_V(8); PG8_WAIT_L(0); PG8_BAR; PG8_MMA(1, 0, At, B0); PG8_MMA(1, 1, At, B1); PG8_BAR; PG8_SCHED;
            } else {
            PG8_LDB(B0, 0, 0); PG8_SCHED; PG8_LDA(At, 0, 0); PG8_STAGE(PG8_SA(1, 1), a1 + hstep, voffA);
            PG8_WAIT_L(8); PG8_BAR; PG8_WAIT_L(0); PG8_MMA(0, 0, At, B0); PG8_BAR; PG8_SCHED;
            PG8_LDB(B1, 0, 1); PG8_STAGE(PG8_SB(0, 0), b2, voffB);
            PG8_BAR; PG8_WAIT_L(0); PG8_MMA(0, 1, At, B1); PG8_BAR;
            PG8_LDA(At, 0, 1); PG8_STAGE(PG8_SA(0, 0), a2, voffA);
            PG8_BAR; PG8_WAIT_L(0); PG8_MMA(1, 0, At, B0); PG8_BAR; PG8_SCHED;
            PG8_STAGE(PG8_SB(0, 1), b2 + hstep, voffB);
            PG8_WAIT_V(6); PG8_BAR; PG8_MMA(1, 1, At, B1); PG8_BAR;
            PG8_LDB(B0, 1, 0); PG8_SCHED; PG8_LDA(At, 1, 0); PG8_STAGE(PG8_SA(0, 1), a2 + hstep, voffA);
            PG8_WAIT_L(8); PG8_BAR; PG8_WAIT_L(0); PG8_MMA(0, 0, At, B0); PG8_BAR; PG8_SCHED;
            PG8_LDB(B1, 1, 1); PG8_STAGE(PG8_SB(1, 0), b3, voffB);
            PG8_BAR; PG8_WAIT_L(0); PG8_MMA(0, 1, At, B1); PG8_BAR;
            PG8_LDA(At, 1, 1); PG8_STAGE(PG8_SA(1, 0), a3, voffA);
            PG8_BAR; PG8_WAIT_L(0); PG8_MMA(1, 0, At, B0); PG8_BAR; PG8_SCHED;
            PG8_STAGE(PG8_SB(1, 1), b3 + hstep, voffB);
            PG8_WAIT_V(6); PG8_BAR; PG8_MMA(1, 1, At, B1); PG8_BAR;
            }
        }
        if constexpr (ALIGN_EPI) { if (wr == 0) PG8_BAR; }
        if constexpr (!Epi::AFTER_DRAIN) { E(acc, cur, wr, wc, fr, fq); S.done(cur); }
        if (!has_next) break;
#pragma unroll
        for (int a = 0; a < 2; ++a)
#pragma unroll
            for (int b = 0; b < 2; ++b)
#pragma unroll
                for (int m = 0; m < 4; ++m)
#pragma unroll
                    for (int n = 0; n < 2; ++n) acc[a][b][m][n] = (f32x4){0.f, 0.f, 0.f, 0.f};
        cur = nxt; cA = nA; cB = nB; ++ui;
        if constexpr (ALIGN_EPI) { if (wr == 1) PG8_BAR; }
    }
    PG8_WAIT_V(0);
    if constexpr (!ALIGN_EPI) { if (wr == 0) PG8_BAR; }
    PG8_BAR;
    if constexpr (Epi::AFTER_DRAIN) { E.fused(acc, cur, wr, wc, fr, fq, lds, wid, lane); S.done(cur); }
#undef PG8_SA
#undef PG8_SB
#undef PG8_STAGE
#undef PG8_LDA
#undef PG8_LDB
#undef PG8_MMA
#undef PG8_WAIT_V
#undef PG8_WAIT_L
#undef PG8_BAR
#undef PG8_SCHED
}
}

#define GAS __attribute__((address_space(1)))
#define LAS __attribute__((address_space(3)))
typedef unsigned v4u __attribute__((ext_vector_type(4)));
typedef float f32x4 __attribute__((ext_vector_type(4)));
typedef short bf16x8 __attribute__((ext_vector_type(8)));
typedef GAS unsigned gu32;
typedef GAS unsigned long long gu64;
#define RLX_AGENT __ATOMIC_RELAXED, __HIP_MEMORY_SCOPE_AGENT
#define LDS_WAIT() asm volatile("s_waitcnt lgkmcnt(0)" ::: "memory")
#define VM_WAIT() asm volatile("s_waitcnt vmcnt(0)" ::: "memory")
__device__ __forceinline__ unsigned long long rt() { return __builtin_amdgcn_s_memrealtime(); }

#define XB_TMO      128
#define XB_XCNT(j)  (256  + 64 * (j))
#define XB_XSUB(j)  (1280 + 64 * (j))
#define XB_XGEN(j)  (2304 + 64 * (j))
#define XB_TOP      3328
#define XB_TOPGEN   3392
#define XCD_BAR_WORDS 3456
#define XB_SPIN_CAP (1u << 18)

__device__ __forceinline__ unsigned xb_ld(unsigned* p)              { return __hip_atomic_load(p, __ATOMIC_RELAXED, __HIP_MEMORY_SCOPE_AGENT); }
__device__ __forceinline__ unsigned xb_add(unsigned* p, unsigned v) { return __hip_atomic_fetch_add(p, v, __ATOMIC_RELAXED, __HIP_MEMORY_SCOPE_AGENT); }
__device__ __forceinline__ unsigned xb_xcc_id() { return (unsigned)__builtin_amdgcn_s_getreg((3 << 11) | 20) & 0xFu; }
#define XB_SPIN(cond, bar) do { unsigned _sp = 0; while (cond) { __builtin_amdgcn_s_sleep(1); \
    if ((++_sp & 255u) == 0u) { if (xb_ld(&(bar)[XB_TMO])) break; if (_sp > XB_SPIN_CAP) { atomicAdd(&(bar)[XB_TMO], 1u); break; } } } } while (0)

struct XcdBarrier {
    unsigned* bar; unsigned x;
    volatile LAS unsigned* st;
};

__device__ __forceinline__ XcdBarrier xcd_barrier_post(unsigned* bar, volatile LAS unsigned* st) {
    XcdBarrier b; b.bar = bar; b.x = xb_xcc_id(); b.st = st;
    if (threadIdx.x == 0) (void)xb_add(&bar[XB_XCNT(b.x)], 1u);
    return b;
}
__device__ __forceinline__ void xcd_barrier_complete(unsigned* bar, unsigned x, unsigned& nloc, unsigned& nx) {
    const unsigned G = gridDim.x * gridDim.y * gridDim.z;
    unsigned sum, cnt, mine, sp = 0u;
    for (;;) {
        sum = 0u; cnt = 0u; mine = 0u;
#pragma unroll
        for (unsigned j = 0; j < 16; ++j) { const unsigned c = xb_ld(&bar[XB_XCNT(j)]); sum += c; cnt += (c > 0u) ? 1u : 0u; mine = (j == x) ? c : mine; }
        if (sum == G) break;
        __builtin_amdgcn_s_sleep(1);
        if ((++sp & 255u) == 0u) { if (xb_ld(&bar[XB_TMO])) break; if (sp > XB_SPIN_CAP) { atomicAdd(&bar[XB_TMO], 1u); break; } }
    }
    nloc = mine > 0u ? mine : 1u; nx = cnt > 0u ? cnt : 1u;
}

__device__ __forceinline__ void xcd_barrier(const XcdBarrier& b) {
    asm volatile("s_waitcnt vmcnt(0)" ::: "memory");
    __syncthreads();
    if (threadIdx.x == 0) {
        unsigned* bar = b.bar;
        __builtin_amdgcn_s_waitcnt(0);
        unsigned nloc = b.st[0], nx = b.st[1];
        if (nloc == 0u) { xcd_barrier_complete(bar, b.x, nloc, nx); b.st[0] = nloc; b.st[1] = nx; }
        const unsigned old = xb_add(&bar[XB_XSUB(b.x)], 1u);
        const unsigned gen = old / nloc;
        if (old + 1u == (gen + 1u) * nloc) {
            __builtin_amdgcn_fence(__ATOMIC_RELEASE, "agent");
            asm volatile("s_waitcnt vmcnt(0)" ::: "memory");
            const unsigned og = xb_add(&bar[XB_TOP], 1u);
            const unsigned tg = og / nx;
            if (og + 1u == (tg + 1u) * nx) xb_add(&bar[XB_TOPGEN], 1u);
            else XB_SPIN(xb_ld(&bar[XB_TOPGEN]) == tg, bar);
            __builtin_amdgcn_fence(__ATOMIC_ACQUIRE, "agent");
            xb_add(&bar[XB_XGEN(b.x)], 1u);
            asm volatile("s_waitcnt vmcnt(0)" ::: "memory");
        } else {
            XB_SPIN(xb_ld(&bar[XB_XGEN(b.x)]) == gen, bar);
            __builtin_amdgcn_fence(__ATOMIC_ACQUIRE, "agent");
            asm volatile("s_waitcnt vmcnt(0)" ::: "memory");
        }
    }
    __syncthreads();
}

constexpr int NWAVES = 8, NTHR = 512;
constexpr int RING_OFF = 0, RING_BYTES = 131072;
constexpr int LDS_BYTES = 159744;
constexpr int MISC_OFF = LDS_BYTES - 512;
constexpr size_t CTL_ZERO_BYTES = 65536;
constexpr int CW_P8CTR = 2048;
constexpr int CW_BAR = 4096;

struct Frame {
    LAS unsigned char* lds;
    volatile LAS unsigned* MISC;
    int tid, lane, wave, G, bid;
};

__device__ __forceinline__ void p0_transpose_item(const float* W, int K, int N, bf16_t* WT, LAS float* scr, int item, int lane) {
    const int nblk = N / 32, kb = item / nblk, nb = item % nblk, k0 = 64 * kb, n0 = 32 * nb;
    float tv[32];
#pragma unroll
    for (int i = 0; i < 32; ++i) tv[i] = W[(size_t)(k0 + 2 * i + (lane >> 5)) * N + n0 + (lane & 31)];
#pragma unroll
    for (int i = 0; i < 32; ++i) scr[(2 * i + (lane >> 5)) * 33 + (lane & 31)] = tv[i];
    LDS_WAIT(); asm volatile("" ::: "memory");
    const int c = lane & 7;
#pragma unroll
    for (int j = 0; j < 4; ++j) { const int n = (lane >> 3) + 8 * j; const LAS float* s = scr + (8 * c) * 33 + n;
        v4u o; o.x = pk2(s[0 * 33], s[1 * 33]); o.y = pk2(s[2 * 33], s[3 * 33]); o.z = pk2(s[4 * 33], s[5 * 33]); o.w = pk2(s[6 * 33], s[7 * 33]);
        *(GAS v4u*)(WT + (size_t)(n0 + n) * K + k0 + 8 * c) = o; }
    LDS_WAIT(); asm volatile("" ::: "memory");
}
__device__ __forceinline__ void cvt_stream(const float* src, bf16_t* dst, size_t n4, size_t gtid, size_t gsz) {
    for (size_t i = gtid; i < n4; i += gsz) { const f32x4 v = ((const f32x4*)src)[i]; u32x2 o; o.x = pk2(v.x, v.y); o.y = pk2(v.z, v.w); ((u32x2*)dst)[i] = o; }
}
__device__ __forceinline__ void p0_prologue(Frame& F, const Params& p) {
    unsigned char* ws = p.ws;
    for (int item = F.bid; item < 192; item += F.G) {
        LAS float* sil = (LAS float*)(F.lds);
        LAS float* red = (LAS float*)(F.lds + 8192);
        const int ks = item / 24, cc = item % 24;
        for (int i = F.tid; i < 9 * 128; i += NTHR) { const int r = i >> 7, k = ks * 128 + (i & 127); const float v = r < 8 ? p.c[r * 1024 + k] : p.c_ctx[k]; sil[i] = v / (1.f + __expf(-v)); }
        __syncthreads();
        f32x4 acc[9];
#pragma unroll
        for (int r = 0; r < 9; ++r) acc[r] = (f32x4){0.f, 0.f, 0.f, 0.f};
        const float* wp = p.w_ada + (size_t)(ks * 128 + F.wave * 16) * NMOD + cc * 256 + F.lane * 4;
#pragma unroll 4
        for (int kk = 0; kk < 16; ++kk) { const f32x4 w = *(const f32x4*)(wp + (size_t)kk * NMOD);
#pragma unroll
            for (int r = 0; r < 9; ++r) acc[r] += w * sil[r * 128 + F.wave * 16 + kk]; }
#pragma unroll
        for (int r = 0; r < 9; ++r) *(LAS f32x4*)(red + ((F.wave * 9 + r) * 256 + F.lane * 4)) = acc[r];
        __syncthreads();
        float* modp = (float*)(ws + WS_MODP);
        for (int i = F.tid; i < 9 * 256; i += NTHR) { const int r = i >> 8, c = i & 255; float s = 0.f;
#pragma unroll
            for (int w = 0; w < 8; ++w) s += red[(w * 9 + r) * 256 + c];
            modp[(size_t)(ks * 9 + r) * NMOD + cc * 256 + c] = s; }
        __syncthreads();
    }
    {
        LAS float* scr = (LAS float*)(F.lds + F.wave * 16384);
        const int gw = F.bid * NWAVES + F.wave, NGW = F.G * NWAVES;
        constexpr int I_IN = 16 * 96, I_OUT = 16 * 32, I_PQ = 16 * 64;
        for (int it = gw; it < I_IN + I_OUT + I_PQ; it += NGW) {
            int r = it;
            if (r < I_IN) { p0_transpose_item(p.w_in, D, NQKV, (bf16_t*)(ws + WS_WIN), scr, r, F.lane); continue; } r -= I_IN;
            if (r < I_OUT) { p0_transpose_item(p.w_out, D, D, (bf16_t*)(ws + WS_WOUT), scr, r, F.lane); continue; } r -= I_OUT;
            p0_transpose_item(p.peer_wq, D, 2048, (bf16_t*)(ws + WS_WPQ), scr, r, F.lane);
        }
    }
    const size_t gtid = (size_t)F.bid * NTHR + F.tid, gsz = (size_t)F.G * NTHR;
    cvt_stream(p.peer_keys, (bf16_t*)(ws + WS_KEYS), (size_t)8 * 2 * 128 * 128 / 4, gtid, gsz);
    { bf16_t* ki = (bf16_t*)(ws + WS_KEYSI);
      for (int i = (int)gtid; i < 8 * 2 * 16 * 128; i += (int)gsz) { const int key = i & 127, c = (i >> 7) & 15, hp = i >> 11;
          const float* sp = p.peer_keys + ((size_t)hp * 128 + key) * 128 + c * 8; const f32x4 a = *(const f32x4*)sp, b = *(const f32x4*)(sp + 4);
          u32x4 o; o.x = pk2(a.x, a.y); o.y = pk2(a.z, a.w); o.z = pk2(b.x, b.y); o.w = pk2(b.z, b.w); *(u32x4*)(ki + (size_t)i * 8) = o; } }
    {
        const int gw = F.bid * NWAVES + F.wave, NGW = F.G * NWAVES, l5 = F.lane & 31, hb = F.lane >> 5;
        for (int e0 = gw * 2; e0 < PE_NEXP; e0 += NGW * 2) {
            f32x4 x[2][8];
#pragma unroll
            for (int q = 0; q < 2; ++q) { const float* src = (hb ? p.peer_v : p.peer_u) + (size_t)(e0 + q) * D + l5 * 32;
#pragma unroll
                for (int j = 0; j < 8; ++j) x[q][j] = ((const f32x4*)src)[j]; }
#pragma unroll
            for (int q = 0; q < 2; ++q) {
                float am = 0.f;
#pragma unroll
                for (int j = 0; j < 8; ++j) am = fmaxf(am, fmaxf(fmaxf(fabsf(x[q][j].x), fabsf(x[q][j].y)), fmaxf(fabsf(x[q][j].z), fabsf(x[q][j].w))));
                am = half_max(am);
                const float top = 6.0f;
                const float sc = am > 0.f ? top / am : 1.f, inv = am > 0.f ? am / top : 1.f;
                f32x16 va, vb;
#pragma unroll
                for (int j = 0; j < 4; ++j) { va[4 * j] = x[q][j].x * sc; va[4 * j + 1] = x[q][j].y * sc; va[4 * j + 2] = x[q][j].z * sc; va[4 * j + 3] = x[q][j].w * sc;
                    vb[4 * j] = x[q][4 + j].x * sc; vb[4 * j + 1] = x[q][4 + j].y * sc; vb[4 * j + 2] = x[q][4 + j].z * sc; vb[4 * j + 3] = x[q][4 + j].w * sc; }
                {
                    u32x4 o = (u32x4){0u, 0u, 0u, 0u};
#pragma unroll
                    for (int j = 0; j < 2; ++j) {
                        o[j] = __builtin_amdgcn_cvt_scalef32_pk_fp4_f32(o[j], va[8 * j + 0], va[8 * j + 1], 1.0f, 0); o[j] = __builtin_amdgcn_cvt_scalef32_pk_fp4_f32(o[j], va[8 * j + 2], va[8 * j + 3], 1.0f, 1);
                        o[j] = __builtin_amdgcn_cvt_scalef32_pk_fp4_f32(o[j], va[8 * j + 4], va[8 * j + 5], 1.0f, 2); o[j] = __builtin_amdgcn_cvt_scalef32_pk_fp4_f32(o[j], va[8 * j + 6], va[8 * j + 7], 1.0f, 3);
                        o[2 + j] = __builtin_amdgcn_cvt_scalef32_pk_fp4_f32(o[2 + j], vb[8 * j + 0], vb[8 * j + 1], 1.0f, 0); o[2 + j] = __builtin_amdgcn_cvt_scalef32_pk_fp4_f32(o[2 + j], vb[8 * j + 2], vb[8 * j + 3], 1.0f, 1);
                        o[2 + j] = __builtin_amdgcn_cvt_scalef32_pk_fp4_f32(o[2 + j], vb[8 * j + 4], vb[8 * j + 5], 1.0f, 2); o[2 + j] = __builtin_amdgcn_cvt_scalef32_pk_fp4_f32(o[2 + j], vb[8 * j + 6], vb[8 * j + 7], 1.0f, 3); }
                    *(u32x4*)(ws + (hb ? WS_VB : WS_UB) + (size_t)(e0 + q) * 512 + l5 * 16) = o;
                }
                if (l5 == 0) ((float*)(ws + (hb ? WS_VSC : WS_USC)))[e0 + q] = inv;
            }
        }
    }
    if (gtid == 0) {
        float s01 = 0.f, s23 = 0.f;
        for (int i = 0; i < 64; ++i) { s01 += p.diff_lambda[i] * p.diff_lambda[64 + i]; s23 += p.diff_lambda[128 + i] * p.diff_lambda[192 + i]; }
        *(float*)(ws + WS_LAM) = expf(s01) - expf(s23) + LAMBDA_INIT;
    }
    float* rope = (float*)(ws + WS_ROPE);
    for (int i = (int)gtid; i < 64 * 16; i += (int)gsz) { const int pos = i >> 4, f = i & 15; const float inv = exp2f(-(float)f * (13.287712379549449f / 16.f)); const float a = (float)pos * inv; rope[2 * i] = cosf(a); rope[2 * i + 1] = sinf(a); }
    bf16_t* bt = (bf16_t*)(ws + WS_BIAST);
    for (int i = (int)gtid; i < 8 * 15 * 4096; i += (int)gsz) {
        const int j = i & 7, kc = (i >> 3) & 63, cq = (i >> 9) & 7, hd = i >> 12, dr = hd % 15, h = hd / 15;
        const int cp = cq * 8 + j; int cs = cp - 8; cs = cs < 0 ? 0 : (cs > 48 ? 48 : cs);
        float v = NEG_BIG;
        if (kc >= cs && kc < cs + 16) v = p.rel_bias[(h * 15 + dr) * 31 + (kc - cp + 15)] * LOG2E;
        bt[i] = (bf16_t)f2bf(v);
    }
}

__device__ __forceinline__ void p1_hrows(Frame& F, const Params& p) {
    unsigned char* ws = p.ws;
    const float* modp = (const float*)(ws + WS_MODP);
    float* mod = (float*)(ws + WS_MOD);
    for (int i = F.bid * NTHR + F.tid; i < 9 * NMOD; i += F.G * NTHR) { float s = p.b_ada[i % NMOD];
#pragma unroll
        for (int ks = 0; ks < 8; ++ks) s += modp[(size_t)ks * 9 * NMOD + i];
        mod[i] = s; }
    const int rows_per = (MALL + F.G - 1) / F.G, r0 = F.bid * rows_per, r1 = min(MALL, r0 + rows_per);
    if (r0 >= r1) return;
    const int mr_lo = r0 < MLAT ? (r0 >> 12) : 8;
    LAS float* tab = (LAS float*)F.lds;
    for (int i = F.tid; i < 2 * 2048; i += NTHR) {
        const int which = i >> 11, ss = (i >> 10) & 1, col = i & 1023; const int mr = min(8, mr_lo + which);
        const int mi = mr * NMOD + (ss == 0 ? D : 0) + col;
        float s = p.b_ada[(ss == 0 ? D : 0) + col];
#pragma unroll
        for (int ks = 0; ks < 8; ++ks) s += modp[(size_t)ks * 9 * NMOD + mi];
        tab[i] = ss == 0 ? p.g_norm[col] * (1.f + s) : s;
    }
    __syncthreads();
    bf16_t* H = (bf16_t*)(ws + WS_H);
    f32x4 nx[2][4];
#define P1_LOAD(dst, rowa_) do { _Pragma("unroll") for (int q = 0; q < 2; ++q) { const int row = min((rowa_) + q * NWAVES, MALL - 1); \
            const float* xr = row < MLAT ? p.x + (size_t)row * D : p.ctx + (size_t)(row - MLAT) * D; \
            _Pragma("unroll") for (int j = 0; j < 4; ++j) dst[q][j] = ((const f32x4*)xr)[F.lane + 64 * j]; } } while (0)
    P1_LOAD(nx, r0 + F.wave);
    for (int rowa = r0 + F.wave; rowa < r1; rowa += 2 * NWAVES) {
        f32x4 v[2][4]; float ssq[2];
#pragma unroll
        for (int q = 0; q < 2; ++q)
#pragma unroll
            for (int j = 0; j < 4; ++j) v[q][j] = nx[q][j];
        if (rowa + 2 * NWAVES < r1) P1_LOAD(nx, rowa + 2 * NWAVES);
#pragma unroll
        for (int q = 0; q < 2; ++q) { float s = 0.f;
#pragma unroll
            for (int j = 0; j < 4; ++j) s += v[q][j].x * v[q][j].x + v[q][j].y * v[q][j].y + v[q][j].z * v[q][j].z + v[q][j].w * v[q][j].w;
            ssq[q] = wave_sum(s); }
#pragma unroll
        for (int q = 0; q < 2; ++q) { const int row = rowa + q * NWAVES; if (row < r1) {
            const int mr = row < MLAT ? (row >> 12) : 8; const LAS float* tb = tab + (mr - mr_lo) * 2048;
            const float rstd = rsqrtf(ssq[q] * (1.f / D) + EPS);
#pragma unroll
            for (int j = 0; j < 4; ++j) { const int col = (F.lane + 64 * j) * 4;
                const f32x4 sc = *(const LAS f32x4*)(tb + col), sh = *(const LAS f32x4*)(tb + 1024 + col);
                const f32x4 y = (v[q][j] * rstd) * sc + sh;
                u32x2 o; o.x = pk2(y.x, y.y); o.y = pk2(y.z, y.w);
                *(u32x2*)(H + (size_t)row * D + col) = o; } } }
    }
#undef P1_LOAD
}

struct EpiQKVFast {
    static constexpr bool PERM = true, AFTER_DRAIN = false;
    unsigned char* ws;
    __device__ __forceinline__ void operator()(const pg8::f32x4 (&acc)[2][2][4][2], const pg8::Unit& u, int wr, int wc, int fr, int fq) const {
        const bool lat = u.pm < 128;
        const int kind = u.pn >> 1;
        if (!lat && (kind == 0 || kind == 3)) return;
        const int b = lat ? (u.pm >> 4) : (u.pm - 128);
        const int tb = lat ? (u.pm & 15) * 256 : 0;
        const float* rope = (const float*)(ws + WS_ROPE);
#pragma unroll
        for (int bj = 0; bj < 2; ++bj) {
            const int cc = (u.pn & 1) * 256 + bj * 128 + wc * 32 + 8 * fq;
#pragma unroll
            for (int ai = 0; ai < 2; ++ai)
#pragma unroll
                for (int m = 0; m < 4; ++m) {
                    const int rowin = ai * 128 + wr * 64 + m * 16 + fr;
                    const int t = tb + rowin;
                    const int j = lat ? 256 + t : rowin;
                    f32x4 v0 = acc[ai][bj][m][0], v1 = acc[ai][bj][m][1];
                    bf16_t* dst;
                    if (kind == 0) { dst = (bf16_t*)(ws + WS_QA) + qa_idx(b, cc >> 6, t, cc & 63); v0 = v0 * C2; v1 = v1 * C2; }
                    else if (kind == 1) dst = (bf16_t*)(ws + WS_KA) + ka_idx(b, cc >> 6, j, cc & 63);
                    else if (kind == 2) dst = (bf16_t*)(ws + WS_VA) + va_idx(b, cc >> 6, j, cc & 63);
                    else if (kind == 5) dst = (bf16_t*)(ws + WS_VD) + vd_idx(b, cc >> 7, j, cc & 127);
                    else {
                        const int mm = cc >> 8, h = (cc >> 6) & 3, d = cc & 63;
                        if (lat) { const int i0 = d >> 1; const int pos = i0 < 16 ? (t >> 6) : (t & 63); const float* rp = rope + (pos * 16 + (i0 & 15)) * 2;
                            const f32x4 r0 = *(const f32x4*)rp, r1 = *(const f32x4*)(rp + 4);
                            f32x4 a0, a1;
                            a0.x = v0.x * r0.x - v0.y * r0.y; a0.y = v0.x * r0.y + v0.y * r0.x; a0.z = v0.z * r0.z - v0.w * r0.w; a0.w = v0.z * r0.w + v0.w * r0.z;
                            a1.x = v1.x * r1.x - v1.y * r1.y; a1.y = v1.x * r1.y + v1.y * r1.x; a1.z = v1.z * r1.z - v1.w * r1.w; a1.w = v1.z * r1.w + v1.w * r1.z;
                            v0 = a0; v1 = a1; }
                        if (kind == 3) { dst = (bf16_t*)(ws + WS_QD) + qd_idx(b, mm, h, t, d); v0 = v0 * C2; v1 = v1 * C2; }
                        else dst = (bf16_t*)(ws + WS_KD) + kd_idx(b, mm, h, j, d);
                    }
                    pg8::u32x4 w; w.x = pg8::cvt_pk_bf16(v0[0], v0[1]); w.y = pg8::cvt_pk_bf16(v0[2], v0[3]); w.z = pg8::cvt_pk_bf16(v1[0], v1[1]); w.w = pg8::cvt_pk_bf16(v1[2], v1[3]);
                    *(pg8::u32x4*)dst = w;
                }
        }
    }
};


struct EpiQ2Frag {
    static constexpr bool PERM = true, AFTER_DRAIN = false;
    bf16_t* O;
    __device__ __forceinline__ void operator()(const pg8::f32x4 (&acc)[2][2][4][2], const pg8::Unit& u, int wr, int wc, int fr, int fq) const {
        const int h = u.pn;
#pragma unroll
        for (int bj = 0; bj < 2; ++bj) {
            const int c8 = wc * 4 + fq;
#pragma unroll
            for (int ai = 0; ai < 2; ++ai)
#pragma unroll
                for (int m = 0; m < 4; ++m) {
                    const int row = u.pm * 256 + ai * 128 + wr * 64 + m * 16 + fr;
                    const size_t idx = ((((((size_t)(row >> 5) * 8 + h) * 2 + bj) * 8 + (c8 >> 1)) * 2 + (c8 & 1)) * 32 + (row & 31)) * 8;
                    const f32x4 v0 = acc[ai][bj][m][0], v1 = acc[ai][bj][m][1];
                    pg8::u32x4 w; w.x = pg8::cvt_pk_bf16(v0[0], v0[1]); w.y = pg8::cvt_pk_bf16(v0[2], v0[3]); w.z = pg8::cvt_pk_bf16(v1[0], v1[1]); w.w = pg8::cvt_pk_bf16(v1[2], v1[3]);
                    *(pg8::u32x4*)(O + idx) = w;
                }
        }
    }
};

__device__ __forceinline__ void p5_rows2(Frame& F, const Params& p) {
    unsigned char* ws = p.ws;
    const float* mod = (const float*)(ws + WS_MOD);
    const bf16_t* YO = (const bf16_t*)(ws + WS_YO);
    bf16_t* H2 = (bf16_t*)(ws + WS_H2);
    const int gw = F.bid * NWAVES + F.wave, NGW = F.G * NWAVES;
    const int rows_per = (MLAT + NGW - 1) / NGW;
    const int rend = min(MLAT, (gw + 1) * rows_per);
    f32x4 nxx[2][4]; u32x2 nxy[2][4];
#define P5_LOAD(rowa_) do { _Pragma("unroll") for (int q = 0; q < 2; ++q) { const int row = min((rowa_) + q, MLAT - 1); \
            _Pragma("unroll") for (int j = 0; j < 4; ++j) { nxx[q][j] = ((const f32x4*)(p.x + (size_t)row * D))[F.lane + 64 * j]; nxy[q][j] = ((const u32x2*)(YO + (size_t)row * D))[F.lane + 64 * j]; } } } while (0)
    P5_LOAD(gw * rows_per);
    for (int rowa = gw * rows_per; rowa < rend; rowa += 2) {
        f32x4 xv[2][4], yv[2][4]; float ssq[2];
#pragma unroll
        for (int q = 0; q < 2; ++q)
#pragma unroll
            for (int j = 0; j < 4; ++j) { xv[q][j] = nxx[q][j]; const u32x2 yw = nxy[q][j]; yv[q][j] = (f32x4){bflo(yw.x), bfhi(yw.x), bflo(yw.y), bfhi(yw.y)}; }
        if (rowa + 2 < rend) P5_LOAD(rowa + 2);
#pragma unroll
        for (int q = 0; q < 2; ++q) { float s = 0.f;
#pragma unroll
            for (int j = 0; j < 4; ++j) s += yv[q][j].x * yv[q][j].x + yv[q][j].y * yv[q][j].y + yv[q][j].z * yv[q][j].z + yv[q][j].w * yv[q][j].w;
            ssq[q] = wave_sum(s); }
#pragma unroll
        for (int q = 0; q < 2; ++q) { const int row = rowa + q; if (row < MLAT) {
            const int b = row >> 12; const float* mb = mod + b * NMOD;
            const float rstd = rsqrtf(ssq[q] * (1.f / D) + EPS);
            float s2 = 0.f;
#pragma unroll
            for (int j = 0; j < 4; ++j) { const int col = (F.lane + 64 * j) * 4;
                const f32x4 g1 = *(const f32x4*)(p.g_norm + D + col), gt1 = *(const f32x4*)(mb + 2 * D + col);
                xv[q][j] = xv[q][j] + gt1 * (yv[q][j] * rstd * g1);
                *(f32x4*)(p.out + (size_t)row * D + col) = xv[q][j];
                s2 += xv[q][j].x * xv[q][j].x + xv[q][j].y * xv[q][j].y + xv[q][j].z * xv[q][j].z + xv[q][j].w * xv[q][j].w; }
            const float rstd2 = rsqrtf(wave_sum(s2) * (1.f / D) + EPS);
#pragma unroll
            for (int j = 0; j < 4; ++j) { const int col = (F.lane + 64 * j) * 4;
                const f32x4 g2 = *(const f32x4*)(p.g_norm + 2 * D + col), sh2 = *(const f32x4*)(mb + 3 * D + col), sc2 = *(const f32x4*)(mb + 4 * D + col);
                const f32x4 y = (xv[q][j] * rstd2 * g2) * (sc2 + 1.f) + sh2;
                u32x2 o; o.x = pk2(y.x, y.y); o.y = pk2(y.z, y.w);
                *(u32x2*)(H2 + (size_t)row * D + col) = o; } } }
    }
#undef P5_LOAD
}

template <int J> __device__ __forceinline__ unsigned lane_xor(unsigned x, int lane) {
    if (J == 1) return (unsigned)__builtin_amdgcn_update_dpp(0, (int)x, 0xB1, 0xf, 0xf, false);
    if (J == 2) return (unsigned)__builtin_amdgcn_update_dpp(0, (int)x, 0x4E, 0xf, 0xf, false);
    if (J == 4) { const unsigned a = (unsigned)__builtin_amdgcn_update_dpp(0, (int)x, 0x104, 0xf, 0xf, false),
                                 b = (unsigned)__builtin_amdgcn_update_dpp(0, (int)x, 0x114, 0xf, 0xf, false);
                  return (lane & 4) ? b : a; }
    if (J == 8) return (unsigned)__builtin_amdgcn_update_dpp(0, (int)x, 0x128, 0xf, 0xf, false);
    if (J == 16) { auto r = __builtin_amdgcn_permlane16_swap(x, x, false, false); return (lane & 16) ? r[0] : r[1]; }
    auto r = __builtin_amdgcn_permlane32_swap(x, x, false, false); return (lane & 32) ? r[0] : r[1];
}
template <int K2, int J> __device__ __forceinline__ void bitonic_step128(unsigned& key0, unsigned& key1, int lane) {
    if (J == 64) { const unsigned lo = key0 < key1 ? key0 : key1, hi_ = key0 < key1 ? key1 : key0; key0 = lo; key1 = hi_; }
    else {
        const unsigned p0_ = lane_xor<J>(key0, lane), p1_ = lane_xor<J>(key1, lane);
        const bool lower = (lane & J) == 0;
        const bool asc0 = K2 == 128 ? true : ((lane & K2) == 0), asc1 = K2 == 128 ? true : (((64 + lane) & K2) == 0);
        const bool kmin0 = lower == asc0, kmin1 = lower == asc1;
        key0 = kmin0 ? (key0 < p0_ ? key0 : p0_) : (key0 < p0_ ? p0_ : key0);
        key1 = kmin1 ? (key1 < p1_ ? key1 : p1_) : (key1 < p1_ ? p1_ : key1);
    }
}
__device__ __forceinline__ void sort128_asc(unsigned& k0, unsigned& k1, int lane) {
    bitonic_step128<2, 1>(k0, k1, lane);
    bitonic_step128<4, 2>(k0, k1, lane); bitonic_step128<4, 1>(k0, k1, lane);
    bitonic_step128<8, 4>(k0, k1, lane); bitonic_step128<8, 2>(k0, k1, lane); bitonic_step128<8, 1>(k0, k1, lane);
    bitonic_step128<16, 8>(k0, k1, lane); bitonic_step128<16, 4>(k0, k1, lane); bitonic_step128<16, 2>(k0, k1, lane); bitonic_step128<16, 1>(k0, k1, lane);
    bitonic_step128<32, 16>(k0, k1, lane); bitonic_step128<32, 8>(k0, k1, lane); bitonic_step128<32, 4>(k0, k1, lane); bitonic_step128<32, 2>(k0, k1, lane); bitonic_step128<32, 1>(k0, k1, lane);
    bitonic_step128<64, 32>(k0, k1, lane); bitonic_step128<64, 16>(k0, k1, lane); bitonic_step128<64, 8>(k0, k1, lane); bitonic_step128<64, 4>(k0, k1, lane); bitonic_step128<64, 2>(k0, k1, lane); bitonic_step128<64, 1>(k0, k1, lane);
    bitonic_step128<128, 64>(k0, k1, lane); bitonic_step128<128, 32>(k0, k1, lane); bitonic_step128<128, 16>(k0, k1, lane); bitonic_step128<128, 8>(k0, k1, lane); bitonic_step128<128, 4>(k0, k1, lane); bitonic_step128<128, 2>(k0, k1, lane); bitonic_step128<128, 1>(k0, k1, lane);
}
__device__ __forceinline__ float e2m3_val(int k) { return k < 8 ? (float)k * 0.125f : ldexpf(1.f + (float)(k & 7) * 0.125f, (k >> 3) - 1); }
__device__ __forceinline__ int e2m3_idx(float x) { if (x < 1.f) return (int)(x * 8.f + 0.5f); const int e = x >= 4.f ? 2 : (x >= 2.f ? 1 : 0); return 8 * (e + 1) + (int)((x / (float)(1 << e) - 1.f) * 8.f + 0.5f); }
__device__ __forceinline__ float sum8(float v) {
    v += __uint_as_float((unsigned)__builtin_amdgcn_update_dpp(0, (int)__float_as_uint(v), 0xB1, 0xf, 0xf, false));
    v += __uint_as_float((unsigned)__builtin_amdgcn_update_dpp(0, (int)__float_as_uint(v), 0x4E, 0xf, 0xf, false));
    v += __uint_as_float((unsigned)__builtin_amdgcn_update_dpp(0, (int)__float_as_uint(v), 0x141, 0xf, 0xf, false));
    return v;
}
template <int MODE> __device__ __forceinline__ void p8_gather(Frame& F, const Params& p, const XcdBarrier& bar) {
    unsigned char* ws = p.ws;
    const bf16_t* H2 = (const bf16_t*)(ws + WS_H2); const unsigned char* U6 = ws + WS_UB; const unsigned char* V6 = ws + WS_VB;
    const int* EX = (const int*)(ws + WS_EXP); const float* GT = (const float*)(ws + WS_GATE); const float* SU = (const float*)(ws + WS_SU); const float* mod = (const float*)(ws + WS_MOD);
    const int lane = F.lane, l5 = lane & 31, b5 = (lane >> 5) & 1, b4 = (lane >> 4) & 1, b3 = (lane >> 3) & 1;
    const int ent = 2 * (2 * b4 + b3) + b5;
    LAS float* scr = (LAS float*)(F.lds + F.wave * 8192);
    int sw4;
    { const unsigned cw = __builtin_amdgcn_cvt_scalef32_pk_fp4_f32(0u, 1.0f, 2.0f, 1.0f, 0); const f32x2 cr = __builtin_amdgcn_cvt_scalef32_pk_f32_fp4(cw, 1.0f, 0);
      sw4 = __builtin_amdgcn_readfirstlane(cr.x == 1.0f ? 0 : 1); }
    const unsigned mlo = (lane & 3) == 0 ? 0x0000FFFFu : ((lane & 3) == 1 ? 0xFFFF0000u : 0u), mhi = (lane & 3) == 2 ? 0x0000FFFFu : ((lane & 3) == 3 ? 0xFFFF0000u : 0u);
#define FP4BF(w_, b_) __builtin_bit_cast(unsigned, __builtin_amdgcn_cvt_scalef32_pk_bf16_fp4((w_), 1.0f, (b_)))
    const unsigned char* ubase = U6 + l5 * 16; const unsigned char* vbase = V6 + l5 * 16;
    unsigned* ctr = (unsigned*)(ws + WS_CTL) + CW_P8CTR + (MODE != 0 ? 16 : 0);
    int cnext = 0;
    if (lane == 0) cnext = (int)__hip_atomic_fetch_add(ctr, 1u, __ATOMIC_RELAXED, __HIP_MEMORY_SCOPE_AGENT);
    cnext = __builtin_amdgcn_readfirstlane(cnext);
    for (;;) {
        const int t = cnext;
        if (t >= MLAT) break;
        if (lane == 0) cnext = (int)__hip_atomic_fetch_add(ctr, 1u, __ATOMIC_RELAXED, __HIP_MEMORY_SCOPE_AGENT);
        const size_t tb_ = (size_t)t * 128;
        unsigned key0 = ((unsigned)EX[tb_ + lane] << 7) | (unsigned)lane, key1 = ((unsigned)EX[tb_ + 64 + lane] << 7) | (unsigned)(64 + lane);
        hs16x4 hb[8]; f32x4 acc[8];
        { const u32x4* hp = (const u32x4*)(H2 + (size_t)t * D + l5 * 32);
#pragma unroll
          for (int j = 0; j < 4; ++j) { u32x4 w = hp[j];
              if (sw4) { w.x = __builtin_amdgcn_alignbit(w.x, w.x, 16); w.y = __builtin_amdgcn_alignbit(w.y, w.y, 16); w.z = __builtin_amdgcn_alignbit(w.z, w.z, 16); w.w = __builtin_amdgcn_alignbit(w.w, w.w, 16); }
              hb[2 * j] = __builtin_bit_cast(hs16x4, (u32x2){w.x, w.y}); hb[2 * j + 1] = __builtin_bit_cast(hs16x4, (u32x2){w.z, w.w}); }
#pragma unroll
          for (int j = 0; j < 8; ++j) acc[j] = (f32x4){0.f, 0.f, 0.f, 0.f}; }
        sort128_asc(key0, key1, lane);
        const unsigned off0 = (key0 & ~127u) << 2, off1 = (key1 & ~127u) << 2;
        for (int bb = 0; bb < 16; ++bb) {
            const unsigned kreg = bb < 8 ? key0 : key1, koff = bb < 8 ? off0 : off1; const int lb = (bb & 7) * 8;
            const unsigned kmine = (unsigned)__builtin_amdgcn_ds_bpermute((lb + ent) * 4, (int)kreg);
            unsigned eo[4];
#pragma unroll
            for (int pr = 0; pr < 4; ++pr) eo[pr] = (unsigned)__builtin_amdgcn_ds_bpermute((lb + 2 * pr + b5) * 4, (int)koff) & (MODE == 1 ? 0x7FFFFu : (MODE == 3 ? 0xFFFu : 0xFFFFFFFFu));
            u32x4 u4[4], v4[4];
#pragma unroll
            for (int pr = 0; pr < 4; ++pr) { u4[pr] = *(const u32x4*)(ubase + eo[pr]); v4[pr] = *(const u32x4*)(vbase + eo[pr]); }
            const float gl = GT[tb_ + (kmine & 127u)], sl = SU[tb_ + (kmine & 127u)];
            if (MODE == 4) { unsigned xa = 0u;
#pragma unroll
                for (int pr = 0; pr < 4; ++pr) xa ^= u4[pr].x ^ u4[pr].y ^ u4[pr].z ^ u4[pr].w ^ v4[pr].x ^ v4[pr].y ^ v4[pr].z ^ v4[pr].w;
                acc[0][0] += __uint_as_float(xa & 0x007FFFFFu) + gl + sl; continue; }
            f32x4 dq[4];
#pragma unroll
            for (int pr = 0; pr < 4; ++pr) dq[pr] = (f32x4){0.f, 0.f, 0.f, 0.f};
#pragma unroll
            for (int j = 0; j < 4; ++j) {
#pragma unroll
                for (int pr = 0; pr < 4; ++pr) { const unsigned c0 = FP4BF(u4[pr][j], 0), c1 = FP4BF(u4[pr][j], 1);
                    dq[pr] = __builtin_amdgcn_mfma_f32_4x4x4bf16_1k(__builtin_bit_cast(hs16x4, (u32x2){c0, c1}), hb[2 * j], dq[pr], 0, 0, 0); }
#pragma unroll
                for (int pr = 0; pr < 4; ++pr) { const unsigned c2 = FP4BF(u4[pr][j], 2), c3 = FP4BF(u4[pr][j], 3);
                    dq[pr] = __builtin_amdgcn_mfma_f32_4x4x4bf16_1k(__builtin_bit_cast(hs16x4, (u32x2){c2, c3}), hb[2 * j + 1], dq[pr], 0, 0, 0); }
            }
            float d[4];
#pragma unroll
            for (int pr = 0; pr < 4; ++pr) d[pr] = (lane & 2) ? ((lane & 1) ? dq[pr][3] : dq[pr][2]) : ((lane & 1) ? dq[pr][1] : dq[pr][0]);
            float r2[2], r1;
#pragma unroll
            for (int i = 0; i < 2; ++i) { auto rr = __builtin_amdgcn_permlane16_swap(__float_as_uint(d[i]), __float_as_uint(d[i + 2]), false, false); r2[i] = __uint_as_float(rr[0]) + __uint_as_float(rr[1]); }
            { const float keep = b3 ? r2[1] : r2[0], send = b3 ? r2[0] : r2[1]; r1 = keep + __uint_as_float((unsigned)__builtin_amdgcn_update_dpp(0, (int)__float_as_uint(send), 0x128, 0xf, 0xf, false)); }
            r1 = sum8(r1);
            const float pre = r1 * sl;
            float act;
            { const float av = fabsf(pre), dd = av * 0.2316418882f + 1.0f; const float tt = __builtin_amdgcn_rcpf(dd);
              float q = tt * 0.5307027145f + (-0.7265760135f); q = q * tt + 0.7107068705f; q = q * tt + (-0.142248368f); q = q * tt + 0.127414796f; q = q * tt;
              const float ee = __builtin_amdgcn_exp2f((pre * pre) * (-0.72134752044f));
              const float mm = pre * (q * ee); act = pre < 0.f ? mm : pre - mm; }
            const float cfl = gl * act;
            const unsigned cfpk_l = __builtin_bit_cast(unsigned, __builtin_convertvector((f32x2){cfl, cfl}, hbf16x2));
#pragma unroll
            for (int pr = 0; pr < 4; ++pr) {
                const unsigned cfpk = (unsigned)__builtin_amdgcn_ds_bpermute(((pr >> 1) * 16 + (pr & 1) * 8 + 32 * b5) * 4, (int)cfpk_l);
                const hs16x4 Aop = __builtin_bit_cast(hs16x4, (u32x2){cfpk & mlo, cfpk & mhi});
#pragma unroll
                for (int j = 0; j < 4; ++j) {
                    const unsigned c0 = FP4BF(v4[pr][j], 0), c1 = FP4BF(v4[pr][j], 1), c2 = FP4BF(v4[pr][j], 2), c3 = FP4BF(v4[pr][j], 3);
                    acc[2 * j] = __builtin_amdgcn_mfma_f32_4x4x4bf16_1k(Aop, __builtin_bit_cast(hs16x4, (u32x2){c0, c1}), acc[2 * j], 0, 0, 0);
                    acc[2 * j + 1] = __builtin_amdgcn_mfma_f32_4x4x4bf16_1k(Aop, __builtin_bit_cast(hs16x4, (u32x2){c2, c3}), acc[2 * j + 1], 0, 0, 0); }
            }
        }
#pragma unroll
        for (int j = 0; j < 32; ++j) { const float av = acc[j >> 2][j & 3]; auto rr = __builtin_amdgcn_permlane32_swap(__float_as_uint(av), __float_as_uint(av), false, false); scr[(j ^ sw4) * 64 + lane] = __uint_as_float(rr[0]) + __uint_as_float(rr[1]); }
        float at[16]; float s = 0.f;
#pragma unroll
        for (int k = 0; k < 16; ++k) { at[k] = scr[(16 * b5 + k) * 64 + lane]; s += at[k] * at[k]; }
        const float rstd = rsqrtf(wave_sum(s) * (1.f / D) + EPS);
        const float* mb = mod + (t >> 12) * NMOD + 5 * D; const float* g3 = p.g_norm + 3 * D;
#pragma unroll
        for (int j = 0; j < 4; ++j) { const int col = l5 * 32 + b5 * 16 + j * 4;
            float* op = p.out + (size_t)t * D + col;
            const f32x4 x0 = *(const f32x4*)op, ga = *(const f32x4*)(g3 + col), ta = *(const f32x4*)(mb + col);
            const f32x4 pa = (f32x4){at[4 * j], at[4 * j + 1], at[4 * j + 2], at[4 * j + 3]};
            if (MODE == 0 || rstd == 123456.f) *(f32x4*)op = x0 + ta * (pa * rstd * ga); }
        cnext = __builtin_amdgcn_readfirstlane(cnext);
    }
}

namespace att {
typedef short bf16x8 __attribute__((ext_vector_type(8)));
typedef short s16x4 __attribute__((ext_vector_type(4)));
typedef float f32x16 __attribute__((ext_vector_type(16)));
typedef __attribute__((address_space(3))) const unsigned char* lcp;
typedef __attribute__((address_space(3))) unsigned char* lp;
constexpr int NA_SLOT = 16384, NA_BIAS_OFF = 32768, WSF_OFF = 155648;
constexpr int DF_SLOT = 32768;
constexpr float THRL = 8.f;

__device__ __forceinline__ int crow(int r, int hi) { return (r & 3) + 8 * (r >> 2) + 4 * hi; }
__device__ __forceinline__ s16x4 vtr(lcp p) { return __builtin_bit_cast(s16x4, __builtin_amdgcn_ds_read_tr16_b64_v4i16((__attribute__((address_space(3))) s16x4*)p)); }
typedef float f32x2_t __attribute__((ext_vector_type(2))); typedef __bf16 bf16x2v_t __attribute__((ext_vector_type(2)));
__device__ __forceinline__ unsigned cvtpk(float lo, float hi) { f32x2_t v = {lo, hi}; bf16x2v_t b = __builtin_convertvector(v, bf16x2v_t); return __builtin_bit_cast(unsigned, b); }
__device__ __forceinline__ float swap_half(float v) { auto rr = __builtin_amdgcn_permlane32_swap(__float_as_uint(v), __float_as_uint(v), false, false); return __uint_as_float(rr[0]) == v ? __uint_as_float(rr[1]) : __uint_as_float(rr[0]); }
__device__ __forceinline__ void dma16(const void* gsrc, lp lds_dst) {
    unsigned keep; const unsigned dst = (unsigned)__builtin_amdgcn_readfirstlane((int)(unsigned)(size_t)lds_dst);
    asm volatile("s_mov_b32 %0, m0\n\ts_mov_b32 m0, %2\n\ts_nop 0\n\tglobal_load_lds_dwordx4 %1, off\n\ts_mov_b32 m0, %0" : "=&s"(keep) : "v"(gsrc), "s"(dst) : "memory");
}
__device__ __forceinline__ float max3f(float a, float b, float c) { float r; asm("v_max3_f32 %0, %1, %2, %3" : "=v"(r) : "v"(a), "v"(b), "v"(c)); return r; }
__device__ __forceinline__ float rowmax32(const f32x16& p0, const f32x16& p1) {
    float a = max3f(p0[0], p0[1], p1[0]), b = max3f(p0[2], p0[3], p1[1]); a = max3f(a, p1[2], p1[3]);
#pragma unroll
    for (int r = 4; r < 16; r += 4) { a = max3f(a, p0[r], p0[r + 1]); b = max3f(b, p0[r + 2], p0[r + 3]); a = max3f(a, p1[r], p1[r + 1]); b = max3f(b, p1[r + 2], p1[r + 3]); }
    float m = max3f(a, b, b);
    auto rr = __builtin_amdgcn_permlane32_swap(__float_as_uint(m), __float_as_uint(m), false, false);
    return max3f(__uint_as_float(rr[0]), __uint_as_float(rr[1]), __uint_as_float(rr[1]));
}

typedef __bf16 bf16x2_t __attribute__((ext_vector_type(2)));
__device__ __forceinline__ float psum_bf16(const u32x4 (&pw)[4], float acc) {
    const bf16x2_t ones = __builtin_bit_cast(bf16x2_t, 0x3F803F80u); float a0 = acc, a1 = 0.f;
#pragma unroll
    for (int k = 0; k < 4; ++k) { a0 = __builtin_amdgcn_fdot2_f32_bf16(__builtin_bit_cast(bf16x2_t, pw[k][0]), ones, a0, false); a1 = __builtin_amdgcn_fdot2_f32_bf16(__builtin_bit_cast(bf16x2_t, pw[k][1]), ones, a1, false);
        a0 = __builtin_amdgcn_fdot2_f32_bf16(__builtin_bit_cast(bf16x2_t, pw[k][2]), ones, a0, false); a1 = __builtin_amdgcn_fdot2_f32_bf16(__builtin_bit_cast(bf16x2_t, pw[k][3]), ones, a1, false); }
    return a0 + a1;
}
template <int NDV> struct FlashState { float mhat, l; f32x16 negm; f32x16 o[NDV]; };

template <int NDV, bool BIAS>
__device__ __forceinline__ void flash_tile(FlashState<NDV>& st, const bf16x8 (&qr)[4], lcp Kslot, lcp Vslot, lcp Bslot, const bf16x8 (&qoh)[2],
                                           __attribute__((address_space(3))) float* wsf, int r32, int hi, int lane, bool first) {
    f32x16 p0 = st.negm, p1 = st.negm;
    lcp kb = Kslot + hi * 1024 + r32 * 16;
    bf16x8 kf[8], bf_[4];
#pragma unroll
    for (int d0 = 0; d0 < 4; ++d0) { kf[2 * d0] = *(const __attribute__((address_space(3))) bf16x8*)(kb + d0 * 2048); kf[2 * d0 + 1] = *(const __attribute__((address_space(3))) bf16x8*)(kb + d0 * 2048 + 512); }
    if (BIAS) { lcp bb = Bslot + hi * 1024 + r32 * 16;
#pragma unroll
        for (int e = 0; e < 2; ++e) { bf_[2 * e] = *(const __attribute__((address_space(3))) bf16x8*)(bb + e * 2048); bf_[2 * e + 1] = *(const __attribute__((address_space(3))) bf16x8*)(bb + e * 2048 + 512); } }
    lcp vb = Vslot + ((lane >> 4) & 1) * 32 + (lane & 3) * 8 + (4 * hi + ((lane & 15) >> 2)) * 64;
    s16x4 va[8], vn[8];
#pragma unroll
    for (int ks = 0; ks < 4; ++ks) { va[2 * ks] = vtr(vb + ks * 1024); va[2 * ks + 1] = vtr(vb + ks * 1024 + 512); }
#pragma unroll
    for (int d0 = 0; d0 < 4; ++d0) { p0 = __builtin_amdgcn_mfma_f32_32x32x16_bf16(kf[2 * d0], qr[d0], p0, 0, 0, 0); p1 = __builtin_amdgcn_mfma_f32_32x32x16_bf16(kf[2 * d0 + 1], qr[d0], p1, 0, 0, 0); }
    if (BIAS) {
#pragma unroll
        for (int e = 0; e < 2; ++e) { p0 = __builtin_amdgcn_mfma_f32_32x32x16_bf16(bf_[2 * e], qoh[e], p0, 0, 0, 0); p1 = __builtin_amdgcn_mfma_f32_32x32x16_bf16(bf_[2 * e + 1], qoh[e], p1, 0, 0, 0); }
    }
    asm volatile("s_nop 15\n\ts_nop 7" : "+v"(p0), "+v"(p1));
    const float rm = rowmax32(p0, p1);
    if (first) {
        st.mhat += rm;
#pragma unroll
        for (int r = 0; r < 16; ++r) { p0[r] -= rm; p1[r] -= rm; st.negm[r] = -st.mhat; }
    } else if (__any(rm > THRL)) {
        const float dl = fmaxf(rm, 0.f); const float alpha = __builtin_amdgcn_exp2f(-dl); st.mhat += dl; st.l *= alpha;
        if (hi == 0) wsf[r32] = alpha;
        asm volatile("s_waitcnt lgkmcnt(0)" ::: "memory");
        float al[16];
#pragma unroll
        for (int r = 0; r < 16; ++r) al[r] = wsf[crow(r, hi)];
#pragma unroll
        for (int d = 0; d < NDV; ++d)
#pragma unroll
            for (int r = 0; r < 16; ++r) st.o[d][r] *= al[r];
#pragma unroll
        for (int r = 0; r < 16; ++r) { p0[r] -= dl; p1[r] -= dl; st.negm[r] = -st.mhat; }
    }
    float sacc = 0.f;
#pragma unroll
    for (int r = 0; r < 16; ++r) { p0[r] = __builtin_amdgcn_exp2f(p0[r]); p1[r] = __builtin_amdgcn_exp2f(p1[r]); sacc += p0[r] + p1[r]; }
    st.l += sacc;
    u32x4 pw[4];
#pragma unroll
    for (int i = 0; i < 4; ++i) { pw[0][i] = cvtpk(p0[2 * i], p0[2 * i + 1]); pw[1][i] = cvtpk(p0[8 + 2 * i], p0[8 + 2 * i + 1]); pw[2][i] = cvtpk(p1[2 * i], p1[2 * i + 1]); pw[3][i] = cvtpk(p1[8 + 2 * i], p1[8 + 2 * i + 1]); }
    __builtin_amdgcn_sched_barrier(0);
#pragma unroll
    for (int d0 = 0; d0 < NDV; ++d0) {
#pragma unroll
        for (int ks = 0; ks < 4; ++ks) {
            if (d0 < NDV - 1) { vn[2 * ks] = vtr(vb + (d0 + 1) * 4096 + ks * 1024); vn[2 * ks + 1] = vtr(vb + (d0 + 1) * 4096 + ks * 1024 + 512); }
            const bf16x8 vf = (bf16x8){va[2 * ks][0], va[2 * ks][1], va[2 * ks][2], va[2 * ks][3], va[2 * ks + 1][0], va[2 * ks + 1][1], va[2 * ks + 1][2], va[2 * ks + 1][3]};
            st.o[d0] = __builtin_amdgcn_mfma_f32_32x32x16_bf16(__builtin_bit_cast(bf16x8, pw[ks]), vf, st.o[d0], 0, 0, 0);
            __builtin_amdgcn_sched_barrier(0);
        }
#pragma unroll
        for (int i = 0; i < 8; ++i) va[i] = vn[i];
    }
}

constexpr int NA2_SLOT = 16384, NA2_BIAS_OFF = 65536;
__device__ __forceinline__ void na_units(Frame& F, const Params& p) {
    unsigned char* ws = p.ws;
    const bf16_t* QA = (const bf16_t*)(ws + WS_QA); const bf16_t* KA = (const bf16_t*)(ws + WS_KA); const bf16_t* VA = (const bf16_t*)(ws + WS_VA);
    const bf16_t* BT = (const bf16_t*)(ws + WS_BIAST); bf16_t* Y = (bf16_t*)(ws + WS_Y);
    const int lane = F.lane, r32 = lane & 31, hi = lane >> 5, wave = F.wave;
    lp lds = (lp)F.lds;
    __attribute__((address_space(3))) float* wsf = (__attribute__((address_space(3))) float*)(lds + WSF_OFF) + wave * 64;
    const int upw = 1024 / F.G;
    int cur_h = -1, cur_lo = -1, cur_hi = -1;
    bf16x8 qoh[2];
#pragma unroll
    for (int e = 0; e < 2; ++e)
#pragma unroll
        for (int j = 0; j < 8; ++j) qoh[e][j] = (16 * e + 8 * hi + j == r32) ? (short)0x3F80 : (short)0;
    for (int ui = 0; ui < upw; ++ui) {
        const int u = F.bid * upw + ui, bh = u >> 4, rg = u & 15, b = bh >> 3, h = bh & 7;
        const int r0 = rg * 4, r = r0 + (wave >> 1), ch = wave & 1;
        int rs = r - 4; rs = rs < 0 ? 0 : (rs > 56 ? 56 : rs);
        int kr_lo = r0 - 4; kr_lo = kr_lo < 0 ? 0 : (kr_lo > 56 ? 56 : kr_lo);
        int kr_hi = r0 + 3 - 4; kr_hi = kr_hi < 0 ? 0 : (kr_hi > 56 ? 56 : kr_hi); kr_hi += 7;
        const int T = 4 + (kr_hi - kr_lo + 1);
        int dr_lo = 99, dr_hi = -1;
#pragma unroll
        for (int q = 0; q < 4; ++q) { int s_ = r0 + q - 4; s_ = s_ < 0 ? 0 : (s_ > 56 ? 56 : s_); const int a = s_ - (r0 + q) + 7; dr_lo = a < dr_lo ? a : dr_lo; dr_hi = a + 7 > dr_hi ? a + 7 : dr_hi; }
        const bf16_t* Kb = KA + (size_t)bh * NKT * 4096; const bf16_t* Vb = VA + (size_t)bh * NKT * 4096;
        if (h != cur_h || dr_lo != cur_lo || dr_hi != cur_hi) {
            cur_h = h; cur_lo = dr_lo; cur_hi = dr_hi;
            const unsigned char* src = (const unsigned char*)(BT + ((size_t)h * 15 + dr_lo) * 4096);
            const int npc = (dr_hi - dr_lo + 1) * 8;
            for (int pi = wave; pi < npc; pi += 8) dma16(src + pi * 1024 + lane * 16, lds + NA2_BIAS_OFF + pi * 1024);
        }
        bf16x8 qr[4];
        { const bf16_t* qp = QA + ((size_t)bh * SEQ + r * 64 + ch * 32 + r32) * 64 + hi * 8;
#pragma unroll
          for (int d0 = 0; d0 < 4; ++d0) qr[d0] = *(const bf16x8*)(qp + d0 * 16); }
#define NA_DMA(i_) do { const int tg_ = (i_) < 4 ? (i_) : (4 + kr_lo + (i_) - 4); lp sl_ = lds + ((i_) & 3) * NA2_SLOT; \
            dma16((const unsigned char*)(Kb + (size_t)tg_ * 4096) + wave * 1024 + lane * 16, sl_ + wave * 1024); \
            dma16((const unsigned char*)(Vb + (size_t)tg_ * 4096) + wave * 1024 + lane * 16, sl_ + 8192 + wave * 1024); } while (0)
        NA_DMA(0); NA_DMA(1);
        FlashState<2> st; st.mhat = 0.f; st.l = 0.f;
#pragma unroll
        for (int rr = 0; rr < 16; ++rr) st.negm[rr] = 0.f;
#pragma unroll
        for (int d = 0; d < 2; ++d)
#pragma unroll
            for (int rr = 0; rr < 16; ++rr) st.o[d][rr] = 0.f;
        for (int i = 0; i < T; ++i) {
            if (i + 1 < T) asm volatile("s_waitcnt vmcnt(2)" ::: "memory"); else asm volatile("s_waitcnt vmcnt(0)" ::: "memory");
            __syncthreads();
            if (i + 2 < T) NA_DMA(i + 2);
            lcp sl = (lcp)(lds + (i & 3) * NA2_SLOT);
            if (i < 4) flash_tile<2, false>(st, qr, sl, sl + 8192, sl, qoh, wsf, r32, hi, lane, i == 0);
            else { const int kr = kr_lo + (i - 4);
                if (kr >= rs && kr < rs + 8) { const int dr = kr - r + 7;
                    flash_tile<2, true>(st, qr, sl, sl + 8192, (lcp)(lds + NA2_BIAS_OFF + (dr - dr_lo) * 8192 + ch * 4096), qoh, wsf, r32, hi, lane, false); } }
        }
#undef NA_DMA
        float lt = st.l; { auto rr = __builtin_amdgcn_permlane32_swap(__float_as_uint(lt), __float_as_uint(lt), false, false); lt = __uint_as_float(rr[0]) + __uint_as_float(rr[1]); }
        if (hi == 0) wsf[32 + r32] = lt;
        asm volatile("s_waitcnt lgkmcnt(0)" ::: "memory");
        bf16_t* yb = Y + ((size_t)b * SEQ + r * 64 + ch * 32) * D + h * 64 + r32;
#pragma unroll
        for (int rr = 0; rr < 16; ++rr) { const float rl = __builtin_amdgcn_rcpf(wsf[32 + crow(rr, hi)]);
#pragma unroll
            for (int d0 = 0; d0 < 2; ++d0) yb[(size_t)crow(rr, hi) * D + d0 * 32] = (bf16_t)f2bf(st.o[d0][rr] * rl); }
        __syncthreads();
    }
}

template <int MODE> __device__ __forceinline__ void diff_units_v2(Frame& F, const Params& p) {
    unsigned char* ws = p.ws;
    const bf16_t* QD = (const bf16_t*)(ws + WS_QD); const bf16_t* KD = (const bf16_t*)(ws + WS_KD); const bf16_t* VD = (const bf16_t*)(ws + WS_VD);
    bf16_t* Y = (bf16_t*)(ws + WS_Y);
    const float lam = *(const float*)(ws + WS_LAM);
    const int lane = F.lane, r32 = lane & 31, hi = lane >> 5, wave = F.wave, map = wave >> 2, qg = wave & 3;
    lp lds = (lp)F.lds;
    __attribute__((address_space(3))) float* wsf = (__attribute__((address_space(3))) float*)(lds + WSF_OFF) + wave * 64;
    __attribute__((address_space(3))) float* X = (__attribute__((address_space(3))) float*)lds;
    const int upw = 1024 / F.G;
    const int koff = map * 8192 + hi * 1024 + r32 * 16;
    const int voff = 16384 + ((lane >> 4) & 1) * 32 + (lane & 3) * 8 + (4 * hi + ((lane & 15) >> 2)) * 64;
    for (int ui = 0; ui < upw; ++ui) {
        int bh, qb;
        if (F.G == 256) { bh = (F.bid & 7) * 4 + ui; qb = F.bid >> 3; } else { const int u = F.bid * upw + ui; bh = u >> 5; qb = u & 31; }
        const int b = bh >> 2, h = bh & 3;
        const unsigned char* K1 = (const unsigned char*)(KD + (size_t)((b * 2 + 0) * 4 + h) * NKT * 4096);
        const unsigned char* K2 = (const unsigned char*)(KD + (size_t)((b * 2 + 1) * 4 + h) * NKT * 4096);
        const unsigned char* Vg = (const unsigned char*)(VD + (size_t)bh * NKT * 8192);
#define DF_DMA(t, slot) do { if (MODE != 1 && MODE != 3) { lp sl_ = lds + (slot) * DF_SLOT; \
            dma16(K1 + (size_t)(t) * 8192 + wave * 1024 + lane * 16, sl_ + wave * 1024); \
            dma16(K2 + (size_t)(t) * 8192 + wave * 1024 + lane * 16, sl_ + 8192 + wave * 1024); \
            dma16(Vg + (size_t)(t) * 16384 + wave * 1024 + lane * 16, sl_ + 16384 + wave * 1024); \
            dma16(Vg + (size_t)(t) * 16384 + 8192 + wave * 1024 + lane * 16, sl_ + 24576 + wave * 1024); } } while (0)
        DF_DMA(0, 0); DF_DMA(1, 1);
        const int q0 = qb * 128 + qg * 32;
        bf16x8 qr[4];
        { const bf16_t* qp = QD + ((size_t)((b * 2 + map) * 4 + h) * SEQ + q0 + r32) * 64 + hi * 8;
#pragma unroll
          for (int d0 = 0; d0 < 4; ++d0) qr[d0] = *(const bf16x8*)(qp + d0 * 16); }
        float mhat = 0.f, lsum = 0.f; f32x16 o[4], negm;
#pragma unroll
        for (int d = 0; d < 4; ++d)
#pragma unroll
            for (int rr = 0; rr < 16; ++rr) o[d][rr] = 0.f;
        asm volatile("s_waitcnt vmcnt(0)" ::: "memory");
        __syncthreads();
        f32x16 s0, s1;
#pragma unroll
        for (int rr = 0; rr < 16; ++rr) { s0[rr] = 0.f; s1[rr] = 0.f; }
        { lcp kb = (lcp)(lds + koff);
#pragma unroll
          for (int d0 = 0; d0 < 4; ++d0) {
              const bf16x8 b0 = *(const __attribute__((address_space(3))) bf16x8*)(kb + d0 * 2048), b1 = *(const __attribute__((address_space(3))) bf16x8*)(kb + d0 * 2048 + 512);
              s0 = __builtin_amdgcn_mfma_f32_32x32x16_bf16(b0, qr[d0], s0, 0, 0, 0); s1 = __builtin_amdgcn_mfma_f32_32x32x16_bf16(b1, qr[d0], s1, 0, 0, 0); } }
        { asm volatile("s_nop 15\n\ts_nop 7" : "+v"(s0), "+v"(s1)); const float rm0 = rowmax32(s0, s1); mhat = rm0;
#pragma unroll
          for (int rr = 0; rr < 16; ++rr) { s0[rr] -= rm0; s1[rr] -= rm0; negm[rr] = -rm0; } }
        u32x4 pw[4];
#define EXP4(X, B) do { X[B] = __builtin_amdgcn_exp2f(X[B]); X[B + 1] = __builtin_amdgcn_exp2f(X[B + 1]); X[B + 2] = __builtin_amdgcn_exp2f(X[B + 2]); X[B + 3] = __builtin_amdgcn_exp2f(X[B + 3]); sacc += X[B]; asm("" : "+v"(sacc)); sacc += X[B + 1]; asm("" : "+v"(sacc)); sacc += X[B + 2]; asm("" : "+v"(sacc)); sacc += X[B + 3]; asm("" : "+v"(sacc)); } while (0)
#define STAGE_A(t_) do { \
            lcp nxt = (lcp)(lds + (((t_) + 1) & 3) * DF_SLOT); \
            bf16x8 kf[8]; \
            _Pragma("unroll") for (int d0 = 0; d0 < 4; ++d0) { kf[2 * d0] = *(const __attribute__((address_space(3))) bf16x8*)(nxt + koff + d0 * 2048); kf[2 * d0 + 1] = *(const __attribute__((address_space(3))) bf16x8*)(nxt + koff + d0 * 2048 + 512); } \
            asm volatile("s_nop 15\n\ts_nop 7" : "+v"(s0), "+v"(s1)); \
            const float rm = rowmax32(s0, s1); \
            if (__any(rm > THRL)) { \
                const float dl = fmaxf(rm, 0.f); const float alpha = __builtin_amdgcn_exp2f(-dl); mhat += dl; lsum *= alpha; \
                if (hi == 0) wsf[r32] = alpha; \
                asm volatile("s_waitcnt lgkmcnt(0)" ::: "memory"); \
                float al[16]; \
                _Pragma("unroll") for (int r = 0; r < 16; ++r) al[r] = wsf[crow(r, hi)]; \
                _Pragma("unroll") for (int d = 0; d < 4; ++d) _Pragma("unroll") for (int r = 0; r < 16; ++r) o[d][r] *= al[r]; \
                _Pragma("unroll") for (int r = 0; r < 16; ++r) { s0[r] -= dl; s1[r] -= dl; negm[r] = -mhat; } \
            } \
            f32x16 n0, n1; float sacc = 0.f; \
            __builtin_amdgcn_sched_barrier(0); \
            n0 = __builtin_amdgcn_mfma_f32_32x32x16_bf16(kf[0], qr[0], negm, 0, 0, 0); EXP4(s0, 0);  __builtin_amdgcn_sched_barrier(0); \
            n1 = __builtin_amdgcn_mfma_f32_32x32x16_bf16(kf[1], qr[0], negm, 0, 0, 0); EXP4(s0, 4);  __builtin_amdgcn_sched_barrier(0); \
            n0 = __builtin_amdgcn_mfma_f32_32x32x16_bf16(kf[2], qr[1], n0, 0, 0, 0); EXP4(s0, 8);  __builtin_amdgcn_sched_barrier(0); \
            n1 = __builtin_amdgcn_mfma_f32_32x32x16_bf16(kf[3], qr[1], n1, 0, 0, 0); EXP4(s0, 12); __builtin_amdgcn_sched_barrier(0); \
            n0 = __builtin_amdgcn_mfma_f32_32x32x16_bf16(kf[4], qr[2], n0, 0, 0, 0); EXP4(s1, 0);  __builtin_amdgcn_sched_barrier(0); \
            n1 = __builtin_amdgcn_mfma_f32_32x32x16_bf16(kf[5], qr[2], n1, 0, 0, 0); EXP4(s1, 4);  __builtin_amdgcn_sched_barrier(0); \
            n0 = __builtin_amdgcn_mfma_f32_32x32x16_bf16(kf[6], qr[3], n0, 0, 0, 0); EXP4(s1, 8);  __builtin_amdgcn_sched_barrier(0); \
            n1 = __builtin_amdgcn_mfma_f32_32x32x16_bf16(kf[7], qr[3], n1, 0, 0, 0); EXP4(s1, 12); __builtin_amdgcn_sched_barrier(0); \
            _Pragma("unroll") for (int i = 0; i < 4; ++i) { pw[0][i] = cvtpk(s0[2 * i], s0[2 * i + 1]); pw[1][i] = cvtpk(s0[8 + 2 * i], s0[8 + 2 * i + 1]); pw[2][i] = cvtpk(s1[2 * i], s1[2 * i + 1]); pw[3][i] = cvtpk(s1[8 + 2 * i], s1[8 + 2 * i + 1]); } \
            lsum += sacc; \
            s0 = n0; s1 = n1; \
        } while (0)
#define STAGE_B(tl_) do { \
            lcp vb = (lcp)(lds + ((tl_) & 3) * DF_SLOT) + voff; \
            s16x4 va[8], vn[8]; \
            _Pragma("unroll") for (int ks = 0; ks < 4; ++ks) { va[2 * ks] = vtr(vb + ks * 1024); va[2 * ks + 1] = vtr(vb + ks * 1024 + 512); } \
            __builtin_amdgcn_sched_barrier(0); \
            _Pragma("unroll") for (int d0 = 0; d0 < 4; ++d0) { \
                _Pragma("unroll") for (int ks = 0; ks < 4; ++ks) { \
                    if (d0 < 3) { vn[2 * ks] = vtr(vb + (d0 + 1) * 4096 + ks * 1024); vn[2 * ks + 1] = vtr(vb + (d0 + 1) * 4096 + ks * 1024 + 512); } \
                    const bf16x8 vf = (bf16x8){va[2 * ks][0], va[2 * ks][1], va[2 * ks][2], va[2 * ks][3], va[2 * ks + 1][0], va[2 * ks + 1][1], va[2 * ks + 1][2], va[2 * ks + 1][3]}; \
                    o[d0] = __builtin_amdgcn_mfma_f32_32x32x16_bf16(__builtin_bit_cast(bf16x8, pw[ks]), vf, o[d0], 0, 0, 0); \
                    __builtin_amdgcn_sched_barrier(0); \
                } \
                _Pragma("unroll") for (int i = 0; i < 8; ++i) va[i] = vn[i]; \
            } \
        } while (0)
        for (int t = 0; t < NKT; ++t) {
            if (t > 0) { asm volatile("s_waitcnt vmcnt(0)" ::: "memory"); if (MODE != 3) __syncthreads(); }
            if (t + 2 < NKT) DF_DMA(t + 2, (t + 2) & 3);
            if (MODE != 2) {
                if (map == 1 && t > 0) STAGE_B(t - 1);
                STAGE_A(t);
                if (map == 0) STAGE_B(t);
            }
        }
        if (MODE != 2 && map == 1) STAGE_B(NKT - 1);
#undef STAGE_A
#undef STAGE_B
#undef EXP4
#undef DF_DMA
        float lt = lsum; { auto rr = __builtin_amdgcn_permlane32_swap(__float_as_uint(lt), __float_as_uint(lt), false, false); lt = __uint_as_float(rr[0]) + __uint_as_float(rr[1]); }
        if (hi == 0) wsf[32 + r32] = lt;
        asm volatile("s_waitcnt lgkmcnt(0)" ::: "memory");
#pragma unroll
        for (int rr = 0; rr < 16; ++rr) { const float rl = __builtin_amdgcn_rcpf(wsf[32 + crow(rr, hi)]);
#pragma unroll
            for (int d = 0; d < 4; ++d) o[d][rr] *= rl; }
        __syncthreads();
        if (map == 1) {
#pragma unroll
            for (int d = 0; d < 4; ++d)
#pragma unroll
                for (int rr = 0; rr < 16; ++rr) X[((qg * 4 + d) * 16 + rr) * 64 + lane] = o[d][rr];
        }
        __syncthreads();
        if (map == 0 && (MODE == 0 || lam == 123456.f)) {
            float ss[16];
#pragma unroll
            for (int rr = 0; rr < 16; ++rr) { float s = 0.f;
#pragma unroll
                for (int d = 0; d < 4; ++d) { const float v = o[d][rr] - lam * X[((qg * 4 + d) * 16 + rr) * 64 + lane]; o[d][rr] = v; s += v * v; }
                ss[rr] = s; }
#pragma unroll
            for (int oo = 1; oo < 32; oo <<= 1)
#pragma unroll
                for (int rr = 0; rr < 16; ++rr) ss[rr] += __shfl_xor(ss[rr], oo);
            float g[4];
#pragma unroll
            for (int d = 0; d < 4; ++d) g[d] = p.diff_subln[d * 32 + r32] * (1.f - LAMBDA_INIT);
            bf16_t* yb = Y + ((size_t)b * SEQ + q0) * D + 512 + h * 128 + r32;
#pragma unroll
            for (int rr = 0; rr < 16; ++rr) { const float rn = rsqrtf(ss[rr] * (1.f / 128.f) + EPS);
#pragma unroll
                for (int d = 0; d < 4; ++d) yb[(size_t)crow(rr, hi) * D + d * 32] = (bf16_t)f2bf(o[d][rr] * rn * g[d]); }
        }
        __syncthreads();
    }
}
}

__device__ __forceinline__ void p3_attention(Frame& F, const Params& p) {
    att::na_units(F, p);
    att::diff_units_v2<0>(F, p);
}

namespace tk {
typedef short bf16x8 __attribute__((ext_vector_type(8)));
typedef float f32x16 __attribute__((ext_vector_type(16)));
constexpr int WLK_OFF = 65536;
__device__ __forceinline__ unsigned ord(float f) { const unsigned u = __float_as_uint(f); return u ^ ((unsigned)((int)u >> 31) | 0x80000000u); }
__device__ __forceinline__ float unord(unsigned o) { return __uint_as_float(o ^ ((o & 0x80000000u) ? 0x80000000u : 0xFFFFFFFFu)); }
__device__ __forceinline__ void cs_desc(unsigned& a, unsigned& b) { const unsigned mx = a > b ? a : b, mn = a > b ? b : a; a = mx; b = mn; }
__device__ __forceinline__ void sort16_desc(unsigned (&v)[16]) {
#pragma unroll
    for (int k = 2; k <= 16; k <<= 1)
#pragma unroll
        for (int j = k >> 1; j > 0; j >>= 1)
#pragma unroll
            for (int i = 0; i < 16; ++i) { const int l = i ^ j; if (l > i) { if ((i & k) == 0 || k == 16) cs_desc(v[i], v[l]); else cs_desc(v[l], v[i]); } }
}
__device__ __forceinline__ void bmerge16_desc(unsigned (&v)[16]) {
#pragma unroll
    for (int j = 8; j > 0; j >>= 1)
#pragma unroll
        for (int i = 0; i < 16; ++i) { const int l = i ^ j; if (l > i) cs_desc(v[i], v[l]); }
}
__device__ __forceinline__ void merge_top16(unsigned (&a)[16], const unsigned (&b)[16]) {
#pragma unroll
    for (int i = 0; i < 16; ++i) a[i] = a[i] > b[15 - i] ? a[i] : b[15 - i];
    bmerge16_desc(a);
}
__device__ __forceinline__ void top16_of_64x2(unsigned (&v0)[16], unsigned (&v1)[16], unsigned (&v2)[16], unsigned (&v3)[16]) {
    sort16_desc(v0); sort16_desc(v1); sort16_desc(v2); sort16_desc(v3);
    merge_top16(v0, v1); merge_top16(v2, v3); merge_top16(v0, v2);
    unsigned pb[16];
#pragma unroll
    for (int i = 0; i < 16; ++i) pb[i] = (unsigned)__shfl_xor((int)v0[i], 32);
    merge_top16(v0, pb);
}
}

__device__ __forceinline__ void p7_topk(Frame& F, const Params& p) {
    using namespace tk;
    unsigned char* ws = p.ws;
    const bf16_t* Q2 = (const bf16_t*)(ws + WS_Q2); const unsigned char* KI = (const unsigned char*)(ws + WS_KEYSI);
    int* EX = (int*)(ws + WS_EXP); float* GT = (float*)(ws + WS_GATE); float* SUo = (float*)(ws + WS_SU);
    const float* USC = (const float*)(ws + WS_USC); const float* VSC = (const float*)(ws + WS_VSC);
    const int lane = F.lane, r32 = lane & 31, hi = lane >> 5, wave = F.wave;
    att::lp lds = (att::lp)F.lds;
    LAS int* W = (LAS int*)(F.lds + WLK_OFF + wave * 8192);
    const int ntask = 1024 / F.G;
    const int h = F.bid & 7;
    { const unsigned char* src = KI + (size_t)h * 65536;
      for (int k = 0; k < 8; ++k) { const int pi = wave + 8 * k; att::dma16(src + pi * 1024 + lane * 16, lds + pi * 1024); } }
    asm volatile("s_waitcnt vmcnt(0)" ::: "memory");
    __syncthreads();
    bf16x8 qf[8], qn[8];
    { const int tb32 = ((F.bid >> 3) * ntask) * 8 + wave;
      const bf16_t* qp = Q2 + ((((size_t)tb32 * 8 + h) * 2 + 0) * 8 * 2 + hi) * 256 + r32 * 8;
#pragma unroll
      for (int s = 0; s < 8; ++s) qn[s] = *(const bf16x8*)(qp + s * 512); }
    for (int ti = 0; ti < ntask; ++ti) {
        const int tb = (F.bid >> 3) * ntask + ti;
        const int t = tb * 256 + wave * 32 + r32;
        unsigned A[16], B[16];
#pragma unroll
        for (int pp = 0; pp < 2; ++pp) {
#pragma unroll
            for (int s = 0; s < 8; ++s) qf[s] = qn[s];
            { const int nti = pp == 0 ? ti : ti + 1, npp = pp ^ 1;
              if (nti < ntask) { const int tb32 = ((F.bid >> 3) * ntask + nti) * 8 + wave;
                  const bf16_t* qp = Q2 + ((((size_t)tb32 * 8 + h) * 2 + npp) * 8 * 2 + hi) * 256 + r32 * 8;
#pragma unroll
                  for (int s = 0; s < 8; ++s) qn[s] = *(const bf16x8*)(qp + s * 512); } }
            f32x16 acc[4];
#pragma unroll
            for (int kb = 0; kb < 4; ++kb)
#pragma unroll
                for (int r = 0; r < 16; ++r) acc[kb][r] = 0.f;
            att::lcp ab = (att::lcp)(lds + pp * 32768 + hi * 2048 + r32 * 16);
#pragma unroll
            for (int s = 0; s < 8; ++s)
#pragma unroll
                for (int kb = 0; kb < 4; ++kb) {
                    const bf16x8 a = *(const __attribute__((address_space(3))) bf16x8*)(ab + s * 4096 + kb * 512);
                    acc[kb] = __builtin_amdgcn_mfma_f32_32x32x16_bf16(a, qf[s], acc[kb], 0, 0, 0);
                }
            unsigned v0[16], v1[16], v2[16], v3[16];
#pragma unroll
            for (int r = 0; r < 16; ++r) {
                const int c = 127 - ((r & 3) + 8 * (r >> 2));
                v0[r] = (ord(acc[0][r]) & 0xFFFFFF80u) | (unsigned)(c - 0 - 4 * hi);
                v1[r] = (ord(acc[1][r]) & 0xFFFFFF80u) | (unsigned)(c - 32 - 4 * hi);
                v2[r] = (ord(acc[2][r]) & 0xFFFFFF80u) | (unsigned)(c - 64 - 4 * hi);
                v3[r] = (ord(acc[3][r]) & 0xFFFFFF80u) | (unsigned)(c - 96 - 4 * hi);
            }
            top16_of_64x2(v0, v1, v2, v3);
            if (pp == 0) {
#pragma unroll
                for (int i = 0; i < 16; ++i) A[i] = v0[i];
            } else {
#pragma unroll
                for (int i = 0; i < 16; ++i) B[i] = v0[i];
            }
        }
        float fa[16], fb[16];
#pragma unroll
        for (int i = 0; i < 16; ++i) { fa[i] = unord(A[i] & 0xFFFFFF80u); fb[i] = unord(B[i] & 0xFFFFFF80u);
            W[i * 64 + lane] = 127 - (int)(A[i] & 127u); W[(16 + i) * 64 + lane] = 127 - (int)(B[i] & 127u); }
        unsigned c0[16], c1[16], c2[16], c3[16];
#pragma unroll
        for (int j = 0; j < 16; ++j) c0[j] = (ord(fa[0] + fb[j]) & 0xFFFFFF00u) | (unsigned)(255 - j);
        {
            int n = 0;
#pragma unroll
            for (int i = 1; i < 16; ++i)
#pragma unroll
                for (int j = 0; j < 16; ++j) if ((i + 1) * (j + 1) <= 16) {
                    const unsigned key = (ord(fa[i] + fb[j]) & 0xFFFFFF00u) | (unsigned)(255 - (i * 16 + j));
                    if (n < 16) c1[n] = key; else if (n < 32) c2[n - 16] = key; else c3[n - 32] = key;
                    ++n;
                }
#pragma unroll
            for (int k = 2; k < 16; ++k) c3[k] = 0u;
        }
        sort16_desc(c1); sort16_desc(c2); sort16_desc(c3);
        merge_top16(c0, c1); merge_top16(c2, c3); merge_top16(c0, c2);
        float ev[16]; float l = 0.f; const float mx = unord(c0[0] & 0xFFFFFF00u);
#pragma unroll
        for (int k = 0; k < 16; ++k) { ev[k] = __expf(unord(c0[k] & 0xFFFFFF00u) - mx); l += ev[k]; }
        const float rl = 1.f / l;
        int ex[8]; float gt[8], su[8];
#pragma unroll
        for (int kk = 0; kk < 8; ++kk) {
            const unsigned key = hi ? c0[8 + kk] : c0[kk]; const float e = hi ? ev[8 + kk] : ev[kk];
            const int pos = 255 - (int)(key & 255u);
            ex[kk] = W[(pos >> 4) * 64 + lane] * 128 + W[(16 + (pos & 15)) * 64 + lane];
            gt[kk] = e * rl * VSC[ex[kk]]; su[kk] = USC[ex[kk]];
        }
        int* ep = EX + (size_t)t * 128 + h * 16 + hi * 8; float* gp = GT + (size_t)t * 128 + h * 16 + hi * 8;
        *(u32x4*)ep = (u32x4){(unsigned)ex[0], (unsigned)ex[1], (unsigned)ex[2], (unsigned)ex[3]}; *(u32x4*)(ep + 4) = (u32x4){(unsigned)ex[4], (unsigned)ex[5], (unsigned)ex[6], (unsigned)ex[7]};
        *(f32x4*)gp = (f32x4){gt[0], gt[1], gt[2], gt[3]}; *(f32x4*)(gp + 4) = (f32x4){gt[4], gt[5], gt[6], gt[7]};
        float* sp = SUo + (size_t)t * 128 + h * 16 + hi * 8;
        *(f32x4*)sp = (f32x4){su[0], su[1], su[2], su[3]}; *(f32x4*)(sp + 4) = (f32x4){su[4], su[5], su[6], su[7]};
    }
    __syncthreads();
}

#define P8_SYNC 0
#define P8_PARTITION 0
#define HAVE_P3 1
#define HAVE_P7 1
struct Args { Params p; int ph_lo, ph_hi, li, pad; };
__global__ void __launch_bounds__(NTHR, 2) mk_fwd(Args a) {
    extern __shared__ __attribute__((aligned(16))) unsigned char lds[];
    Frame F;
    F.lds = (LAS unsigned char*)lds;
    F.MISC = (volatile LAS unsigned*)(F.lds + MISC_OFF);
    F.tid = threadIdx.x; F.lane = F.tid & 63; F.wave = __builtin_amdgcn_readfirstlane(F.tid >> 6);
    F.G = gridDim.x; F.bid = blockIdx.x;
    const Params& p = a.p;
    gu32* ctl = (gu32*)(p.ws + WS_CTL);
    for (int u = F.tid; u < 128; u += NTHR) ((LAS unsigned*)(F.lds + MISC_OFF))[u] = 0u;
    __syncthreads();
    XcdBarrier bar = xcd_barrier_post((unsigned*)(ctl + CW_BAR) + a.li * XCD_BAR_WORDS, F.MISC + 8);
    const int lo = a.ph_lo, hi = a.ph_hi;
#ifdef PROBE_TS
    int nts_ = 0;
#define STAMP() do { if (threadIdx.x == 0 && nts_ < 12) { const unsigned long long t_ = __builtin_amdgcn_s_memrealtime(); F.MISC[32 + 2 * nts_] = (unsigned)t_; F.MISC[33 + 2 * nts_] = (unsigned)(t_ >> 32); } ++nts_; } while (0)
    STAMP();
#else
#define STAMP() do {} while (0)
#endif
#define IN(k) (lo <= (k) && (k) < hi)
#define REFRESH() do { F.lane = (int)__builtin_amdgcn_mbcnt_hi(~0u, __builtin_amdgcn_mbcnt_lo(~0u, 0u)); F.tid = F.wave * 64 + F.lane; } while (0)
#define SEAM(k) do { if (IN(k) && IN((k) + 1)) xcd_barrier(bar); STAMP(); } while (0)

#ifndef PROBE_DUP
#define PROBE_DUP -1
#endif
#define REP(k) for (int rep_ = 0; rep_ < (PROBE_DUP == (k) ? 2 : 1); ++rep_)
    if (IN(0)) { REP(0) p0_prologue(F, p); SEAM(0); }
    if (IN(1)) { REP(1) { p1_hrows(F, p); __syncthreads(); } SEAM(1); }
    if (IN(2)) {
        pg8::Gemm g{(const bf16_t*)(p.ws + WS_H), (const bf16_t*)(p.ws + WS_WIN), MALL, NQKV, D}; pg8::StaticOrder S; S.init(MALL, NQKV, F.G, F.bid);
        EpiQKVFast E{p.ws};
        REP(2) pg8::gemm_phase<EpiQKVFast, pg8::StaticOrder, true, true>(F.lds + RING_OFF, g, S, E);
        SEAM(2);
    }
#if HAVE_P3
    if (IN(3)) { REP(31) att::na_units(F, p); att::diff_units_v2<0>(F, p);
#if PROBE_DUP == 321
        att::diff_units_v2<1>(F, p);
#elif PROBE_DUP == 323
        att::diff_units_v2<3>(F, p);
#elif PROBE_DUP == 322
        att::diff_units_v2<2>(F, p);
#elif PROBE_DUP == 32
        att::diff_units_v2<0>(F, p);
#endif
        SEAM(3); }
#endif
    if (IN(4)) {
        pg8::Gemm g{(const bf16_t*)(p.ws + WS_Y), (const bf16_t*)(p.ws + WS_WOUT), MLAT, D, D}; pg8::StaticOrder S; S.init(MLAT, D, F.G, F.bid);
        pg8::EpiBf16<0> E{(bf16_t*)(p.ws + WS_YO), D, nullptr, 0, 0, 1.f};
        REP(4) pg8::gemm_phase<pg8::EpiBf16<0>, pg8::StaticOrder, true, true>(F.lds + RING_OFF, g, S, E);
        SEAM(4);
    }
    if (IN(5)) { REP(5) p5_rows2(F, p); SEAM(5); }
    if (IN(6)) {
        pg8::Gemm g{(const bf16_t*)(p.ws + WS_H2), (const bf16_t*)(p.ws + WS_WPQ), MLAT, 2048, D}; pg8::StaticOrder S; S.init(MLAT, 2048, F.G, F.bid);
        EpiQ2Frag E{(bf16_t*)(p.ws + WS_Q2)};
        REP(6) pg8::gemm_phase<EpiQ2Frag, pg8::StaticOrder, true, true>(F.lds + RING_OFF, g, S, E);
        SEAM(6);
    }
#if HAVE_P7
    if (IN(7)) { REP(7) p7_topk(F, p); SEAM(7); }
#endif
#if P8_PARTITION
    if (IN(8)) {
        p7b_sort(F, p); xcd_barrier(bar);
        for (int ch = 0; ch < 2; ++ch) { p8a_part(F, p, ch); xcd_barrier(bar); p8b_combine(F, p, ch); if (ch == 0) xcd_barrier(bar); }
    }
#else
    if (IN(8)) {
#if PROBE_DUP == 81
        p8_gather<1>(F, p, bar);
#elif PROBE_DUP == 82
        p8_gather<2>(F, p, bar);
#elif PROBE_DUP == 83
        p8_gather<3>(F, p, bar);
#elif PROBE_DUP == 84
        p8_gather<4>(F, p, bar);
#endif
        p8_gather<0>(F, p, bar); }
#endif
#ifdef PROBE_TS
#ifdef PROBE_TS_ENDBAR
    xcd_barrier(bar);
#endif
    STAMP();
    if (blockIdx.x == 0 && threadIdx.x == 0) { const unsigned long long t1_ = ((unsigned long long)F.MISC[33 + 2 * (PROBE_TS + 1)] << 32) | F.MISC[32 + 2 * (PROBE_TS + 1)], t0_ = ((unsigned long long)F.MISC[33 + 2 * PROBE_TS] << 32) | F.MISC[32 + 2 * PROBE_TS];
        const unsigned long long dt = t1_ - t0_; const unsigned long long t_end = __builtin_amdgcn_s_memrealtime();
        while (__builtin_amdgcn_s_memrealtime() - t_end < 8ull * dt) __builtin_amdgcn_s_sleep(8); }
#endif
#undef IN
#undef SEAM
}

static void launch_mk(const Params& p, int lo, int hi, int li, hipStream_t stream) {
    Args a{}; a.p = p; a.ph_lo = lo; a.ph_hi = hi; a.li = li; a.pad = 0;
    hipLaunchKernelGGL(mk_fwd, dim3(256), dim3(NTHR), LDS_BYTES, stream, a);
}
extern "C" void kernel_launch(void* const* d_in, const int* in_sizes, int n_in, void* d_out, int out_size, void* d_ws, size_t ws_size, hipStream_t stream) {
    if (n_in != 16 || ws_size < WS_END) return;
    static bool attr_done = false;
    if (!attr_done) {
        (void)hipFuncSetAttribute((const void*)mk_fwd, hipFuncAttributeMaxDynamicSharedMemorySize, LDS_BYTES);
        attr_done = true;
    }
    Params p{};
    p.x = (const float*)d_in[0]; p.c = (const float*)d_in[1]; p.ctx = (const float*)d_in[2]; p.c_ctx = (const float*)d_in[3];
    p.w_ada = (const float*)d_in[4]; p.b_ada = (const float*)d_in[5]; p.g_norm = (const float*)d_in[6]; p.w_in = (const float*)d_in[7];
    p.rel_bias = (const float*)d_in[8]; p.diff_lambda = (const float*)d_in[9]; p.diff_subln = (const float*)d_in[10]; p.w_out = (const float*)d_in[11];
    p.peer_wq = (const float*)d_in[12]; p.peer_keys = (const float*)d_in[13]; p.peer_u = (const float*)d_in[14]; p.peer_v = (const float*)d_in[15];
    p.out = (float*)d_out; p.ws = (unsigned char*)d_ws;
    (void)hipMemsetAsync((char*)d_ws + WS_CTL, 0, CTL_ZERO_BYTES, stream);

    launch_mk(p, 0, 9, 0, stream);

}
```

```cpp
#include <hip/hip_runtime.h>
#include <stdint.h>
#include <math.h>

typedef unsigned short bf16_t;
typedef float f32x4 __attribute__((ext_vector_type(4)));
typedef unsigned u32x4 __attribute__((ext_vector_type(4)));
typedef unsigned u32x2 __attribute__((ext_vector_type(2)));
typedef float f32x2 __attribute__((ext_vector_type(2)));

constexpr int D = 1024, BATCH = 8, SEQ = 4096, CTX = 256, GW = 64;
constexpr int MLAT = BATCH * SEQ;
constexpr int MCTX = BATCH * CTX;
constexpr int MALL = MLAT + MCTX;
constexpr int NQKV = 3072;
constexpr int NKT = 68;
constexpr int NMOD = 6 * D;
constexpr int PE_H = 8, PE_NK = 128, PE_QD = 256, PE_TOPK = 16, PE_NEXP = 16384;
constexpr float EPS = 1e-6f;
constexpr float LOG2E = 1.4426950408889634f;
constexpr float C2 = 0.125f * LOG2E;
constexpr float LAMBDA_INIT = 0.2f;
constexpr float NEG_BIG = -30000.0f;

constexpr size_t MiB = 1u << 20;
constexpr size_t WS_CTL = 0;
constexpr size_t WS_MOD = 1 * MiB;
constexpr size_t WS_LAM = 1 * MiB + 256 * 1024;
constexpr size_t WS_ROPE = 1 * MiB + 512 * 1024;
constexpr size_t WS_USC = 1 * MiB + 640 * 1024;
constexpr size_t WS_VSC = 1 * MiB + 704 * 1024;
constexpr size_t WS_MODP = 2 * MiB;
constexpr size_t WS_BIAST = 4 * MiB;
constexpr size_t WS_KEYS = 5 * MiB;
constexpr size_t WS_KEYSI = 5 * MiB + 512 * 1024;
constexpr size_t WS_WIN = 6 * MiB;
constexpr size_t WS_WOUT = 12 * MiB;
constexpr size_t WS_WPQ = 14 * MiB;
constexpr size_t WS_UB = 18 * MiB;
constexpr size_t WS_VB = 50 * MiB;
constexpr size_t WS_EXP = 82 * MiB;
constexpr size_t WS_GATE = 98 * MiB;
constexpr size_t WS_H2 = 114 * MiB;
constexpr size_t WS_H = 178 * MiB;
constexpr size_t WS_Y = 178 * MiB;
constexpr size_t WS_QA = 246 * MiB;
constexpr size_t WS_KA = 278 * MiB;
constexpr size_t WS_VA = 312 * MiB;
constexpr size_t WS_QD = 346 * MiB;
constexpr size_t WS_KD = 378 * MiB;
constexpr size_t WS_VD = 412 * MiB;
constexpr size_t WS_XN = 178 * MiB;
constexpr size_t WS_YO = 246 * MiB;
constexpr size_t WS_Q2 = 246 * MiB;
constexpr size_t WS_PART = 178 * MiB;
constexpr size_t WS_DSCR = 464 * MiB;
constexpr size_t WS_SU = 446 * MiB;
constexpr size_t WS_END = 496 * MiB;

struct Params {
    const float *x, *c, *ctx, *c_ctx, *w_ada, *b_ada, *g_norm, *w_in, *rel_bias, *diff_lambda, *diff_subln, *w_out, *peer_wq, *peer_keys, *peer_u, *peer_v;
    float* out;
    unsigned char* ws;
};

__device__ __forceinline__ unsigned f2bf(float f) { unsigned u = __builtin_bit_cast(unsigned, f); return (u + 0x7fffu + ((u >> 16) & 1u)) >> 16; }
__device__ __forceinline__ unsigned pk2(float lo, float hi) { return f2bf(lo) | (f2bf(hi) << 16); }
__device__ __forceinline__ float bf2f(bf16_t h) { return __builtin_bit_cast(float, (unsigned)h << 16); }
__device__ __forceinline__ float bflo(unsigned w) { return __builtin_bit_cast(float, w << 16); }
__device__ __forceinline__ float bfhi(unsigned w) { return __builtin_bit_cast(float, w & 0xffff0000u); }
__device__ __forceinline__ float wave_sum(float v) {
    v += __uint_as_float((unsigned)__builtin_amdgcn_update_dpp(0, (int)__float_as_uint(v), 0xB1, 0xf, 0xf, false));
    v += __uint_as_float((unsigned)__builtin_amdgcn_update_dpp(0, (int)__float_as_uint(v), 0x4E, 0xf, 0xf, false));
    v += __uint_as_float((unsigned)__builtin_amdgcn_update_dpp(0, (int)__float_as_uint(v), 0x141, 0xf, 0xf, false));
    v += __uint_as_float((unsigned)__builtin_amdgcn_update_dpp(0, (int)__float_as_uint(v), 0x128, 0xf, 0xf, false));
    { auto r = __builtin_amdgcn_permlane16_swap(__float_as_uint(v), __float_as_uint(v), false, false); v = __uint_as_float(r[0]) + __uint_as_float(r[1]); }
    { auto r = __builtin_amdgcn_permlane32_swap(__float_as_uint(v), __float_as_uint(v), false, false); v = __uint_as_float(r[0]) + __uint_as_float(r[1]); }
    return v;
}
__device__ __forceinline__ float wave_max(float v) {
    v = fmaxf(v, __uint_as_float((unsigned)__builtin_amdgcn_update_dpp(0, (int)__float_as_uint(v), 0xB1, 0xf, 0xf, false)));
    v = fmaxf(v, __uint_as_float((unsigned)__builtin_amdgcn_update_dpp(0, (int)__float_as_uint(v), 0x4E, 0xf, 0xf, false)));
    v = fmaxf(v, __uint_as_float((unsigned)__builtin_amdgcn_update_dpp(0, (int)__float_as_uint(v), 0x141, 0xf, 0xf, false)));
    v = fmaxf(v, __uint_as_float((unsigned)__builtin_amdgcn_update_dpp(0, (int)__float_as_uint(v), 0x128, 0xf, 0xf, false)));
    { auto r = __builtin_amdgcn_permlane16_swap(__float_as_uint(v), __float_as_uint(v), false, false); v = fmaxf(__uint_as_float(r[0]), __uint_as_float(r[1])); }
    { auto r = __builtin_amdgcn_permlane32_swap(__float_as_uint(v), __float_as_uint(v), false, false); v = fmaxf(__uint_as_float(r[0]), __uint_as_float(r[1])); }
    return v;
}

__device__ __forceinline__ float half_max(float v) {
    v = fmaxf(v, __uint_as_float((unsigned)__builtin_amdgcn_update_dpp(0, (int)__float_as_uint(v), 0xB1, 0xf, 0xf, false)));
    v = fmaxf(v, __uint_as_float((unsigned)__builtin_amdgcn_update_dpp(0, (int)__float_as_uint(v), 0x4E, 0xf, 0xf, false)));
    v = fmaxf(v, __uint_as_float((unsigned)__builtin_amdgcn_update_dpp(0, (int)__float_as_uint(v), 0x141, 0xf, 0xf, false)));
    v = fmaxf(v, __uint_as_float((unsigned)__builtin_amdgcn_update_dpp(0, (int)__float_as_uint(v), 0x128, 0xf, 0xf, false)));
    { auto r = __builtin_amdgcn_permlane16_swap(__float_as_uint(v), __float_as_uint(v), false, false); v = fmaxf(__uint_as_float(r[0]), __uint_as_float(r[1])); }
    return v;
}
typedef float f32x16 __attribute__((ext_vector_type(16)));
typedef float f32x32 __attribute__((ext_vector_type(32)));
typedef unsigned u32x6 __attribute__((ext_vector_type(6)));

__device__ __forceinline__ u32x6 enc_fp6(f32x16 a, f32x16 b) { u32x6 w; asm volatile("v_cvt_scalef32_2xpk16_fp6_f32 %0, %1, %2, 1.0" : "=&v"(w) : "v"(a), "v"(b)); return w; }
__device__ __forceinline__ f32x32 dec_fp6(u32x6 w) { f32x32 r; asm volatile("v_cvt_scalef32_pk32_f32_fp6 %0, %1, 1.0" : "=&v"(r) : "v"(w)); return r; }

typedef short hs16x4 __attribute__((ext_vector_type(4)));
typedef __bf16 hbf16x2 __attribute__((ext_vector_type(2)));

typedef unsigned u32x16 __attribute__((ext_vector_type(16)));

__device__ __forceinline__ int ktile_off(int k, int d) { return (d >> 3) * 512 + k * 8 + (d & 7); }
__device__ __forceinline__ int vtile_off(int k, int d) { return (d >> 5) * 2048 + (k >> 4) * 512 + (k & 15) * 32 + (d & 31); }
__device__ __forceinline__ size_t qa_idx(int b, int h, int t, int d) { return ((size_t)(b * 8 + h) * SEQ + t) * 64 + d; }
__device__ __forceinline__ size_t ka_idx(int b, int h, int j, int d) { return ((size_t)(b * 8 + h) * NKT + (j >> 6)) * 4096 + ktile_off(j & 63, d); }
__device__ __forceinline__ size_t va_idx(int b, int h, int j, int d) { return ((size_t)(b * 8 + h) * NKT + (j >> 6)) * 4096 + vtile_off(j & 63, d); }
__device__ __forceinline__ size_t qd_idx(int b, int m, int h, int t, int d) { return ((size_t)((b * 2 + m) * 4 + h) * SEQ + t) * 64 + d; }
__device__ __forceinline__ size_t kd_idx(int b, int m, int h, int j, int d) { return ((size_t)((b * 2 + m) * 4 + h) * NKT + (j >> 6)) * 4096 + ktile_off(j & 63, d); }
__device__ __forceinline__ size_t vd_idx(int b, int h, int j, int d) { return ((size_t)(b * 4 + h) * NKT + (j >> 6)) * 8192 + vtile_off(j & 63, d); }


namespace pg8 {
#define PG8_LAS __attribute__((address_space(3)))
typedef unsigned short bf16_t;
typedef short bf16x8 __attribute__((ext_vector_type(8)));
typedef float f32x4 __attribute__((ext_vector_type(4)));
typedef unsigned u32x4 __attribute__((ext_vector_type(4)));
constexpr int BM = 256, BK = 64, HALF = 128, HTB = HALF * BK * 2  , STAGE_BYTES = 8 * HTB, NXCD = 8, WGM = 8;

__host__ __device__ __forceinline__ int lds_byte(int r, int c) { const int st = (r >> 4) * 2 + (c >> 5), rr = r & 15, cc = c & 31, ob = rr * 64 + cc * 2; return st * 1024 + (ob ^ (((ob >> 9) & 1) << 5)); }
__host__ __device__ __forceinline__ void stage_rc(int b, int& R, int& C) { const int st = b / 1024, sb = b % 1024, swz = sb ^ (((sb >> 9) & 1) << 5); R = (st >> 1) * 16 + swz / 64; C = (st & 1) * 32 + (swz % 64) / 2; }
__host__ __device__ __forceinline__ int perm32(int rho) { const int n = rho >> 4, i = rho & 15; return 8 * (i >> 2) + 4 * n + (i & 3); }

struct Unit { int pm, pn; };
struct Gemm { const bf16_t* A; const bf16_t* Bt; int M, N, K; };

struct StaticOrder {
    int nM, nN, nwg, G, c;
    __host__ __device__ void init(int M, int N, int G_, int c_) { nM = M / BM; nN = N / BM; nwg = nM * nN; G = G_; c = c_; }
    __host__ __device__ bool next(int i, Unit& u) const {
        const long L = (long)i * G + c; if (L >= nwg) return false;
        int wgid = (int)L; { const int q = nwg / NXCD, r = nwg % NXCD, xcd = wgid % NXCD, off = wgid / NXCD; wgid = (xcd < r ? xcd * (q + 1) : r * (q + 1) + (xcd - r) * q) + off; }
        const int nig = WGM * nN, gid = wgid / nig, fm = gid * WGM, gsz = (nM - fm) < WGM ? (nM - fm) : WGM;
        u.pm = fm + ((wgid % nig) % gsz); u.pn = (wgid % nig) / gsz; return true;
    }
    __device__ __forceinline__ void a_ready(const Unit&) const {}
    __device__ __forceinline__ void done(const Unit&) const {}
};

__device__ __forceinline__ unsigned cvt_pk_bf16(float lo, float hi) { unsigned r; asm volatile("v_cvt_pk_bf16_f32 %0, %1, %2" : "=v"(r) : "v"(lo), "v"(hi)); return r; }
typedef float f32x2 __attribute__((ext_vector_type(2)));
__device__ __forceinline__ f32x2 gelu_pk(f32x2 v) {
    const f32x2 av = __builtin_elementwise_abs(v), d = av * 0.2316418882f + 1.0f;
    f32x2 t; t.x = __builtin_amdgcn_rcpf(d.x); t.y = __builtin_amdgcn_rcpf(d.y);
    f32x2 q = t * 0.5307027145f + (-0.7265760135f); q = q * t + 0.7107068705f; q = q * t + (-0.142248368f); q = q * t + 0.127414796f; q = q * t;
    const f32x2 s = (v * v) * (-0.72134752044f);
    f32x2 e; e.x = __builtin_amdgcn_exp2f(s.x); e.y = __builtin_amdgcn_exp2f(s.y);
    const f32x2 m = v * (q * e), r = v - m;
    f32x2 o; o.x = v.x < 0.f ? m.x : r.x; o.y = v.y < 0.f ? m.y : r.y; return o;
}

template <int ACT  > struct EpiBf16 {
    static constexpr bool PERM = true, AFTER_DRAIN = false; static_assert(ACT == 0 || ACT == 1, "EpiBf16: ACT is 0 (none) or 1 (gelu_pk)");
    bf16_t* O; int ldc; const float* bias; int split_cols; size_t split_stride; float scale0;
    __device__ __forceinline__ void operator()(const f32x4 (&acc)[2][2][4][2], const Unit& u, int wr, int wc, int fr, int fq) const {
        const int row0 = u.pm * BM + wr * 64 + fr; int colt = u.pn * BM; bf16_t* base = O;
        float sc = 1.f; if (split_cols) { const int t = colt / split_cols; base += (size_t)t * split_stride; colt -= t * split_cols; if (t == 0) sc = scale0; }
        const int col0 = colt + wc * 32 + 8 * fq, bcol0 = u.pn * BM + wc * 32 + 8 * fq;
        f32x4 bv[2][2];
#pragma unroll
        for (int bj = 0; bj < 2; ++bj)
#pragma unroll
            for (int n = 0; n < 2; ++n) bv[bj][n] = bias ? *(const f32x4*)(bias + bcol0 + bj * HALF + 4 * n) : (f32x4){0.f, 0.f, 0.f, 0.f};
#pragma unroll
        for (int ai = 0; ai < 2; ++ai)
#pragma unroll
            for (int m = 0; m < 4; ++m) { bf16_t* rowp = base + (size_t)(row0 + ai * HALF + m * 16) * ldc + col0;
#pragma unroll
                for (int bj = 0; bj < 2; ++bj) { f32x4 v0 = acc[ai][bj][m][0] + bv[bj][0], v1 = acc[ai][bj][m][1] + bv[bj][1];
                    if (ACT == 1) { f32x2 a = gelu_pk((f32x2){v0[0], v0[1]}), b = gelu_pk((f32x2){v0[2], v0[3]}), c = gelu_pk((f32x2){v1[0], v1[1]}), d = gelu_pk((f32x2){v1[2], v1[3]});
                        v0 = (f32x4){a.x, a.y, b.x, b.y}; v1 = (f32x4){c.x, c.y, d.x, d.y}; }
                    v0 = v0 * sc; v1 = v1 * sc; u32x4 w; w.x = cvt_pk_bf16(v0[0], v0[1]); w.y = cvt_pk_bf16(v0[2], v0[3]); w.z = cvt_pk_bf16(v1[0], v1[1]); w.w = cvt_pk_bf16(v1[2], v1[3]);
                    *(u32x4*)(rowp + bj * HALF) = w; } }
    }
};

template <class Epi, class Sched, bool ALIGN_EPI = false, bool SP2 = false>
__device__ __forceinline__ void gemm_phase(PG8_LAS unsigned char* lds, const Gemm g, const Sched& S, const Epi& E) {
    const int tid = threadIdx.x, wid = __builtin_amdgcn_readfirstlane(tid >> 6), lane = tid & 63, wr = wid >> 2, wc = wid & 3, fr = lane & 15, fq = lane >> 4;
    const int K = g.K, nt = K / BK;
    unsigned voffA[2], voffB[2];
#pragma unroll
    for (int i = 0; i < 2; ++i) { int R, C; stage_rc(tid * 16 + i * 8192, R, C); const int Rb = Epi::PERM ? ((R & ~31) + perm32(R & 31)) : R;
        voffA[i] = (unsigned)(R * K + C) * 2u; voffB[i] = (unsigned)(Rb * K + C) * 2u; }
    const size_t kstep = (size_t)(BK * 2);
    const size_t hstep = (size_t)HALF * K * 2;
    const size_t tstep = 2 * hstep;
    const unsigned ldsw = (unsigned)wid * 1024u;
    const int aoff = lds_byte(wr * 64 + fr, fq * 8), boff = lds_byte(wc * 32 + fr, fq * 8);
#define PG8_SA(b, h) (((b) * 2 + (h)) * HTB)
#define PG8_SB(b, h) ((4 + (b) * 2 + (h)) * HTB)
#define PG8_STAGE(bufoff, gbase, voff) do { _Pragma("unroll") for (int _i = 0; _i < 2; ++_i) \
        __builtin_amdgcn_global_load_lds((const unsigned*)((const char*)(gbase) + (voff)[_i]), (PG8_LAS unsigned*)(lds + (bufoff) + ldsw + _i * 8192), 16, 0, 0); } while (0)
#define PG8_LDA(dst, b, h) do { _Pragma("unroll") for (int m = 0; m < 4; ++m) _Pragma("unroll") for (int k = 0; k < 2; ++k) dst[m][k] = *(const PG8_LAS bf16x8*)(lds + PG8_SA(b, h) + aoff + m * 2048 + k * 1024); } while (0)
#define PG8_LDB(dst, b, h) do { _Pragma("unroll") for (int n = 0; n < 2; ++n) _Pragma("unroll") for (int k = 0; k < 2; ++k) dst[n][k] = *(const PG8_LAS bf16x8*)(lds + PG8_SB(b, h) + boff + n * 2048 + k * 1024); } while (0)
#define PG8_MMA(ai, bj, At, Bt) do { __builtin_amdgcn_s_setprio(1); _Pragma("unroll") for (int m = 0; m < 4; ++m) _Pragma("unroll") for (int n = 0; n < 2; ++n) _Pragma("unroll") for (int k = 0; k < 2; ++k) \
        acc[ai][bj][m][n] = __builtin_amdgcn_mfma_f32_16x16x32_bf16(Bt[n][k], At[m][k], acc[ai][bj][m][n], 0, 0, 0); __builtin_amdgcn_s_setprio(0); } while (0)
#define PG8_WAIT_V(n) asm volatile("s_waitcnt vmcnt(" #n ")" ::: "memory")
#define PG8_WAIT_L(n) asm volatile("s_waitcnt lgkmcnt(" #n ")" ::: "memory")
#define PG8_BAR __builtin_amdgcn_s_barrier()
#define PG8_SCHED __builtin_amdgcn_sched_barrier(0)
    Unit cur, nxt; int ui = 0;
    if (!S.next(0, cur)) return;
    f32x4 acc[2][2][4][2];
#pragma unroll
    for (int a = 0; a < 2; ++a)
#pragma unroll
        for (int b = 0; b < 2; ++b)
#pragma unroll
            for (int m = 0; m < 4; ++m)
#pragma unroll
                for (int n = 0; n < 2; ++n) acc[a][b][m][n] = (f32x4){0.f, 0.f, 0.f, 0.f};
    bf16x8 At[4][2], B0[2][2], B1[2][2];
    const char* cA = (const char*)g.A + (size_t)cur.pm * tstep; const char* cB = (const char*)g.Bt + (size_t)cur.pn * tstep;
    S.a_ready(cur);
    if constexpr (SP2) {
        PG8_STAGE(PG8_SB(0, 0), cB, voffB); PG8_STAGE(PG8_SB(0, 1), cB + hstep, voffB); PG8_STAGE(PG8_SA(0, 0), cA, voffA); PG8_STAGE(PG8_SA(0, 1), cA + hstep, voffA);
        if (wr == 1) PG8_BAR;
        PG8_WAIT_V(2); PG8_BAR;
        PG8_STAGE(PG8_SB(1, 0), cB + kstep, voffB); PG8_STAGE(PG8_SA(1, 0), cA + kstep, voffA); PG8_STAGE(PG8_SB(1, 1), cB + hstep + kstep, voffB);
        PG8_WAIT_V(6); PG8_BAR;
    } else {
        PG8_STAGE(PG8_SB(0, 0), cB, voffB); PG8_STAGE(PG8_SA(0, 0), cA, voffA); PG8_STAGE(PG8_SB(0, 1), cB + hstep, voffB); PG8_STAGE(PG8_SA(0, 1), cA + hstep, voffA);
        if (wr == 1) PG8_BAR;
        PG8_WAIT_V(4); PG8_BAR;
        PG8_STAGE(PG8_SB(1, 0), cB + kstep, voffB); PG8_STAGE(PG8_SA(1, 0), cA + kstep, voffA); PG8_STAGE(PG8_SB(1, 1), cB + hstep + kstep, voffB);
        PG8_WAIT_V(6); PG8_BAR;
    }
    for (;;) {
        const bool has_next = S.next(ui + 1, nxt);
        const char* nA = has_next ? (const char*)g.A + (size_t)nxt.pm * tstep : cA; const char* nB = has_next ? (const char*)g.Bt + (size_t)nxt.pn * tstep : cB;
        for (int t = 0; t < nt; t += 2) {
            const bool last = (t == nt - 2);
            const char* a1 = cA + (size_t)(t + 1) * kstep;
            const char* a2 = last ? nA : cA + (size_t)(t + 2) * kstep; const char* b2 = last ? nB : cB + (size_t)(t + 2) * kstep;
            const char* a3 = a2 + kstep; const char* b3 = b2 + kstep;
            if (last && has_next) S.a_ready(nxt);
            if constexpr (SP2) {
            PG8_LDB(B0, 0, 0); PG8_LDB(B1, 0, 1); PG8_SCHED; PG8_LDA(At, 0, 0); PG8_STAGE(PG8_SA(1, 1), a1 + hstep, voffA);
            PG8_WAIT_V(8); PG8_WAIT_L(0); PG8_BAR; PG8_MMA(0, 0, At, B0); PG8_MMA(0, 1, At, B1); PG8_BAR; PG8_SCHED;
            PG8_LDA(At, 0, 1); PG8_STAGE(PG8_SB(0, 0), b2, voffB); PG8_STAGE(PG8_SB(0, 1), b2 + hstep, voffB); PG8_STAGE(PG8_SA(0, 0), a2, voffA);
            PG8_WAIT_V(8); PG8_WAIT_L(0); PG8_BAR; PG8_MMA(1, 0, At, B0); PG8_MMA(1, 1, At, B1); PG8_BAR; PG8_SCHED;
            PG8_LDB(B0, 1, 0); PG8_LDB(B1, 1, 1); PG8_SCHED; PG8_LDA(At, 1, 0); PG8_STAGE(PG8_SA(0, 1), a2 + hstep, voffA);
            PG8_WAIT_V(8); PG8_WAIT_L(0); PG8_BAR; PG8_MMA(0, 0, At, B0); PG8_MMA(0, 1, At, B1); PG8_BAR; PG8_SCHED;
            PG8_LDA(At, 1, 1); PG8_STAGE(PG8_SB(1, 0), b3, voffB); PG8_STAGE(PG8_SB(1, 1), b3 + hstep, voffB); PG8_STAGE(PG8_SA(1, 0), a3, voffA);
            PG8_WAIT_V(8); PG8_WAIT_L(0); PG8_BAR; PG8_MMA(1, 0, At, B0); PG8_MMA(1, 1, At, B1); PG8_BAR; PG8_SCHED;
            } else {
            PG8_LDB(B0, 0, 0); PG8_SCHED; PG8_LDA(At, 0, 0); PG8_STAGE(PG8_SA(1, 1), a1 + hstep, voffA);
            PG8_WAIT_L(8); PG8_BAR; PG8_WAIT_L(0); PG8_MMA(0, 0, At, B0); PG8_BAR; PG8_SCHED;
            PG8_LDB(B1, 0, 1); PG8_STAGE(PG8_SB(0, 0), b2, voffB);
            PG8_BAR; PG8_WAIT_L(0); PG8_MMA(0, 1, At, B1); PG8_BAR;
            PG8_LDA(At, 0, 1); PG8_STAGE(PG8_SA(0, 0), a2, voffA);
            PG8_BAR; PG8_WAIT_L(0); PG8_MMA(1, 0, At, B0); PG8_BAR; PG8_SCHED;
            PG8_STAGE(PG8_SB(0, 1), b2 + hstep, voffB);
            PG8_WAIT_V(6); PG8_BAR; PG8_MMA(1, 1, At, B1); PG8_BAR;
            PG8_LDB(B0, 1, 0); PG8_SCHED; PG8_LDA(At, 1, 0); PG8_STAGE(PG8_SA(0, 1), a2 + hstep, voffA);
            PG8_WAIT_L(8); PG8_BAR; PG8_WAIT_L(0); PG8_MMA(0, 0, At, B0); PG8_BAR; PG8_SCHED;
            PG8_LDB(B1, 1, 1); PG8_STAGE(PG8_SB(1, 0), b3, voffB);
            PG8_BAR; PG8_WAIT_L(0); PG8_MMA(0, 1, At, B1); PG8_BAR;
            PG8_LDA(At, 1, 1); PG8_STAGE(PG8_SA(1, 0), a3, voffA);
            PG8_BAR; PG8_WAIT_L(0); PG8_MMA(1, 0, At, B0); PG8_BAR; PG8_SCHED;
            PG8_STAGE(PG8_SB(1, 1), b3 + hstep, voffB);
            PG8_WAIT_V(6); PG8_BAR; PG8_MMA(1, 1, At, B1); PG8_BAR;
            }
        }
        if constexpr (ALIGN_EPI) { if (wr == 0) PG8_BAR; }
        if constexpr (!Epi::AFTER_DRAIN) { E(acc, cur, wr, wc, fr, fq); S.done(cur); }
        if (!has_next) break;
#pragma unroll
        for (int a = 0; a < 2; ++a)
#pragma unroll
            for (int b = 0; b < 2; ++b)
#pragma unroll
                for (int m = 0; m < 4; ++m)
#pragma unroll
                    for (int n = 0; n < 2; ++n) acc[a][b][m][n] = (f32x4){0.f, 0.f, 0.f, 0.f};
        cur = nxt; cA = nA; cB = nB; ++ui;
        if constexpr (ALIGN_EPI) { if (wr == 1) PG8_BAR; }
    }
    PG8_WAIT_V(0);
    if constexpr (!ALIGN_EPI) { if (wr == 0) PG8_BAR; }
    PG8_BAR;
    if constexpr (Epi::AFTER_DRAIN) { E.fused(acc, cur, wr, wc, fr, fq, lds, wid, lane); S.done(cur); }
#undef PG8_SA
#undef PG8_SB
#undef PG8_STAGE
#undef PG8_LDA
#undef PG8_LDB
#undef PG8_MMA
#undef PG8_WAIT_V
#undef PG8_WAIT_L
#undef PG8_BAR
#undef PG8_SCHED
}
}

#define GAS __attribute__((address_space(1)))
#define LAS __attribute__((address_space(3)))
typedef unsigned v4u __attribute__((ext_vector_type(4)));
typedef float f32x4 __attribute__((ext_vector_type(4)));
typedef short bf16x8 __attribute__((ext_vector_type(8)));
typedef GAS unsigned gu32;
typedef GAS unsigned long long gu64;
#define RLX_AGENT __ATOMIC_RELAXED, __HIP_MEMORY_SCOPE_AGENT
#define LDS_WAIT() asm volatile("s_waitcnt lgkmcnt(0)" ::: "memory")
#define VM_WAIT() asm volatile("s_waitcnt vmcnt(0)" ::: "memory")
__device__ __forceinline__ unsigned long long rt() { return __builtin_amdgcn_s_memrealtime(); }

#define XB_TMO      128
#define XB_XCNT(j)  (256  + 64 * (j))
#define XB_XSUB(j)  (1280 + 64 * (j))
#define XB_XGEN(j)  (2304 + 64 * (j))
#define XB_TOP      3328
#define XB_TOPGEN   3392
#define XCD_BAR_WORDS 3456
#define XB_SPIN_CAP (1u << 18)

__device__ __forceinline__ unsigned xb_ld(unsigned* p)              { return __hip_atomic_load(p, __ATOMIC_RELAXED, __HIP_MEMORY_SCOPE_AGENT); }
__device__ __forceinline__ unsigned xb_add(unsigned* p, unsigned v) { return __hip_atomic_fetch_add(p, v, __ATOMIC_RELAXED, __HIP_MEMORY_SCOPE_AGENT); }
__device__ __forceinline__ unsigned xb_xcc_id() { return (unsigned)__builtin_amdgcn_s_getreg((3 << 11) | 20) & 0xFu; }
#define XB_SPIN(cond, bar) do { unsigned _sp = 0; while (cond) { __builtin_amdgcn_s_sleep(1); \
    if ((++_sp & 255u) == 0u) { if (xb_ld(&(bar)[XB_TMO])) break; if (_sp > XB_SPIN_CAP) { atomicAdd(&(bar)[XB_TMO], 1u); break; } } } } while (0)

struct XcdBarrier {
    unsigned* bar; unsigned x;
    volatile LAS unsigned* st;
};

__device__ __forceinline__ XcdBarrier xcd_barrier_post(unsigned* bar, volatile LAS unsigned* st) {
    XcdBarrier b; b.bar = bar; b.x = xb_xcc_id(); b.st = st;
    if (threadIdx.x == 0) (void)xb_add(&bar[XB_XCNT(b.x)], 1u);
    return b;
}
__device__ __forceinline__ void xcd_barrier_complete(unsigned* bar, unsigned x, unsigned& nloc, unsigned& nx) {
    const unsigned G = gridDim.x * gridDim.y * gridDim.z;
    unsigned sum, cnt, mine, sp = 0u;
    for (;;) {
        sum = 0u; cnt = 0u; mine = 0u;
#pragma unroll
        for (unsigned j = 0; j < 16; ++j) { const unsigned c = xb_ld(&bar[XB_XCNT(j)]); sum += c; cnt += (c > 0u) ? 1u : 0u; mine = (j == x) ? c : mine; }
        if (sum == G) break;
        __builtin_amdgcn_s_sleep(1);
        if ((++sp & 255u) == 0u) { if (xb_ld(&bar[XB_TMO])) break; if (sp > XB_SPIN_CAP) { atomicAdd(&bar[XB_TMO], 1u); break; } }
    }
    nloc = mine > 0u ? mine : 1u; nx = cnt > 0u ? cnt : 1u;
}

__device__ __forceinline__ void xcd_barrier(const XcdBarrier& b) {
    asm volatile("s_waitcnt vmcnt(0)" ::: "memory");
    __syncthreads();
    if (threadIdx.x == 0) {
        unsigned* bar = b.bar;
        __builtin_amdgcn_s_waitcnt(0);
        unsigned nloc = b.st[0], nx = b.st[1];
        if (nloc == 0u) { xcd_barrier_complete(bar, b.x, nloc, nx); b.st[0] = nloc; b.st[1] = nx; }
        const unsigned old = xb_add(&bar[XB_XSUB(b.x)], 1u);
        const unsigned gen = old / nloc;
        if (old + 1u == (gen + 1u) * nloc) {
            __builtin_amdgcn_fence(__ATOMIC_RELEASE, "agent");
            asm volatile("s_waitcnt vmcnt(0)" ::: "memory");
            const unsigned og = xb_add(&bar[XB_TOP], 1u);
            const unsigned tg = og / nx;
            if (og + 1u == (tg + 1u) * nx) xb_add(&bar[XB_TOPGEN], 1u);
            else XB_SPIN(xb_ld(&bar[XB_TOPGEN]) == tg, bar);
            __builtin_amdgcn_fence(__ATOMIC_ACQUIRE, "agent");
            xb_add(&bar[XB_XGEN(b.x)], 1u);
            asm volatile("s_waitcnt vmcnt(0)" ::: "memory");
        } else {
            XB_SPIN(xb_ld(&bar[XB_XGEN(b.x)]) == gen, bar);
            __builtin_amdgcn_fence(__ATOMIC_ACQUIRE, "agent");
            asm volatile("s_waitcnt vmcnt(0)" ::: "memory");
        }
    }
    __syncthreads();
}

constexpr int NWAVES = 8, NTHR = 512;
constexpr int RING_OFF = 0, RING_BYTES = 131072;
constexpr int LDS_BYTES = 159744;
constexpr int MISC_OFF = LDS_BYTES - 512;
constexpr size_t CTL_ZERO_BYTES = 65536;
constexpr int CW_P8CTR = 2048;
constexpr int CW_BAR = 4096;

struct Frame {
    LAS unsigned char* lds;
    volatile LAS unsigned* MISC;
    int tid, lane, wave, G, bid;
};

__device__ __forceinline__ void p0_transpose_item(const float* W, int K, int N, bf16_t* WT, LAS float* scr, int item, int lane) {
    const int nblk = N / 32, kb = item / nblk, nb = item % nblk, k0 = 64 * kb, n0 = 32 * nb;
    float tv[32];
#pragma unroll
    for (int i = 0; i < 32; ++i) tv[i] = W[(size_t)(k0 + 2 * i + (lane >> 5)) * N + n0 + (lane & 31)];
#pragma unroll
    for (int i = 0; i < 32; ++i) scr[(2 * i + (lane >> 5)) * 33 + (lane & 31)] = tv[i];
    LDS_WAIT(); asm volatile("" ::: "memory");
    const int c = lane & 7;
#pragma unroll
    for (int j = 0; j < 4; ++j) { const int n = (lane >> 3) + 8 * j; const LAS float* s = scr + (8 * c) * 33 + n;
        v4u o; o.x = pk2(s[0 * 33], s[1 * 33]); o.y = pk2(s[2 * 33], s[3 * 33]); o.z = pk2(s[4 * 33], s[5 * 33]); o.w = pk2(s[6 * 33], s[7 * 33]);
        *(GAS v4u*)(WT + (size_t)(n0 + n) * K + k0 + 8 * c) = o; }
    LDS_WAIT(); asm volatile("" ::: "memory");
}
__device__ __forceinline__ void cvt_stream(const float* src, bf16_t* dst, size_t n4, size_t gtid, size_t gsz) {
    for (size_t i = gtid; i < n4; i += gsz) { const f32x4 v = ((const f32x4*)src)[i]; u32x2 o; o.x = pk2(v.x, v.y); o.y = pk2(v.z, v.w); ((u32x2*)dst)[i] = o; }
}
__device__ __forceinline__ void p0_prologue(Frame& F, const Params& p) {
    unsigned char* ws = p.ws;
    for (int item = F.bid; item < 192; item += F.G) {
        LAS float* sil = (LAS float*)(F.lds);
        LAS float* red = (LAS float*)(F.lds + 8192);
        const int ks = item / 24, cc = item % 24;
        for (int i = F.tid; i < 9 * 128; i += NTHR) { const int r = i >> 7, k = ks * 128 + (i & 127); const float v = r < 8 ? p.c[r * 1024 + k] : p.c_ctx[k]; sil[i] = v / (1.f + __expf(-v)); }
        __syncthreads();
        f32x4 acc[9];
#pragma unroll
        for (int r = 0; r < 9; ++r) acc[r] = (f32x4){0.f, 0.f, 0.f, 0.f};
        const float* wp = p.w_ada + (size_t)(ks * 128 + F.wave * 16) * NMOD + cc * 256 + F.lane * 4;
#pragma unroll 4
        for (int kk = 0; kk < 16; ++kk) { const f32x4 w = *(const f32x4*)(wp + (size_t)kk * NMOD);
#pragma unroll
            for (int r = 0; r < 9; ++r) acc[r] += w * sil[r * 128 + F.wave * 16 + kk]; }
#pragma unroll
        for (int r = 0; r < 9; ++r) *(LAS f32x4*)(red + ((F.wave * 9 + r) * 256 + F.lane * 4)) = acc[r];
        __syncthreads();
        float* modp = (float*)(ws + WS_MODP);
        for (int i = F.tid; i < 9 * 256; i += NTHR) { const int r = i >> 8, c = i & 255; float s = 0.f;
#pragma unroll
            for (int w = 0; w < 8; ++w) s += red[(w * 9 + r) * 256 + c];
            modp[(size_t)(ks * 9 + r) * NMOD + cc * 256 + c] = s; }
        __syncthreads();
    }
    {
        LAS float* scr = (LAS float*)(F.lds + F.wave * 16384);
        const int gw = F.bid * NWAVES + F.wave, NGW = F.G * NWAVES;
        constexpr int I_IN = 16 * 96, I_OUT = 16 * 32, I_PQ = 16 * 64;
        for (int it = gw; it < I_IN + I_OUT + I_PQ; it += NGW) {
            int r = it;
            if (r < I_IN) { p0_transpose_item(p.w_in, D, NQKV, (bf16_t*)(ws + WS_WIN), scr, r, F.lane); continue; } r -= I_IN;
            if (r < I_OUT) { p0_transpose_item(p.w_out, D, D, (bf16_t*)(ws + WS_WOUT), scr, r, F.lane); continue; } r -= I_OUT;
            p0_transpose_item(p.peer_wq, D, 2048, (bf16_t*)(ws + WS_WPQ), scr, r, F.lane);
        }
    }
    const size_t gtid = (size_t)F.bid * NTHR + F.tid, gsz = (size_t)F.G * NTHR;
    cvt_stream(p.peer_keys, (bf16_t*)(ws + WS_KEYS), (size_t)8 * 2 * 128 * 128 / 4, gtid, gsz);
    { bf16_t* ki = (bf16_t*)(ws + WS_KEYSI);
      for (int i = (int)gtid; i < 8 * 2 * 16 * 128; i += (int)gsz) { const int key = i & 127, c = (i >> 7) & 15, hp = i >> 11;
          const float* sp = p.peer_keys + ((size_t)hp * 128 + key) * 128 + c * 8; const f32x4 a = *(const f32x4*)sp, b = *(const f32x4*)(sp + 4);
          u32x4 o; o.x = pk2(a.x, a.y); o.y = pk2(a.z, a.w); o.z = pk2(b.x, b.y); o.w = pk2(b.z, b.w); *(u32x4*)(ki + (size_t)i * 8) = o; } }
    {
        const int gw = F.bid * NWAVES + F.wave, NGW = F.G * NWAVES, l5 = F.lane & 31, hb = F.lane >> 5;
        for (int e0 = gw * 2; e0 < PE_NEXP; e0 += NGW * 2) {
            f32x4 x[2][8];
#pragma unroll
            for (int q = 0; q < 2; ++q) { const float* src = (hb ? p.peer_v : p.peer_u) + (size_t)(e0 + q) * D + l5 * 32;
#pragma unroll
                for (int j = 0; j < 8; ++j) x[q][j] = ((const f32x4*)src)[j]; }
#pragma unroll
            for (int q = 0; q < 2; ++q) {
                float am = 0.f;
#pragma unroll
                for (int j = 0; j < 8; ++j) am = fmaxf(am, fmaxf(fmaxf(fabsf(x[q][j].x), fabsf(x[q][j].y)), fmaxf(fabsf(x[q][j].z), fabsf(x[q][j].w))));
                am = half_max(am);
                const float top = 6.0f;
                const float sc = am > 0.f ? top / am : 1.f, inv = am > 0.f ? am / top : 1.f;
                f32x16 va, vb;
#pragma unroll
                for (int j = 0; j < 4; ++j) { va[4 * j] = x[q][j].x * sc; va[4 * j + 1] = x[q][j].y * sc; va[4 * j + 2] = x[q][j].z * sc; va[4 * j + 3] = x[q][j].w * sc;
                    vb[4 * j] = x[q][4 + j].x * sc; vb[4 * j + 1] = x[q][4 + j].y * sc; vb[4 * j + 2] = x[q][4 + j].z * sc; vb[4 * j + 3] = x[q][4 + j].w * sc; }
                {
                    u32x4 o = (u32x4){0u, 0u, 0u, 0u};
#pragma unroll
                    for (int j = 0; j < 2; ++j) {
                        o[j] = __builtin_amdgcn_cvt_scalef32_pk_fp4_f32(o[j], va[8 * j + 0], va[8 * j + 1], 1.0f, 0); o[j] = __builtin_amdgcn_cvt_scalef32_pk_fp4_f32(o[j], va[8 * j + 2], va[8 * j + 3], 1.0f, 1);
                        o[j] = __builtin_amdgcn_cvt_scalef32_pk_fp4_f32(o[j], va[8 * j + 4], va[8 * j + 5], 1.0f, 2); o[j] = __builtin_amdgcn_cvt_scalef32_pk_fp4_f32(o[j], va[8 * j + 6], va[8 * j + 7], 1.0f, 3);
                        o[2 + j] = __builtin_amdgcn_cvt_scalef32_pk_fp4_f32(o[2 + j], vb[8 * j + 0], vb[8 * j + 1], 1.0f, 0); o[2 + j] = __builtin_amdgcn_cvt_scalef32_pk_fp4_f32(o[2 + j], vb[8 * j + 2], vb[8 * j + 3], 1.0f, 1);
                        o[2 + j] = __builtin_amdgcn_cvt_scalef32_pk_fp4_f32(o[2 + j], vb[8 * j + 4], vb[8 * j + 5], 1.0f, 2); o[2 + j] = __builtin_amdgcn_cvt_scalef32_pk_fp4_f32(o[2 + j], vb[8 * j + 6], vb[8 * j + 7], 1.0f, 3); }
                    *(u32x4*)(ws + (hb ? WS_VB : WS_UB) + (size_t)(e0 + q) * 512 + l5 * 16) = o;
                }
                if (l5 == 0) ((float*)(ws + (hb ? WS_VSC : WS_USC)))[e0 + q] = inv;
            }
        }
    }
    if (gtid == 0) {
        float s01 = 0.f, s23 = 0.f;
        for (int i = 0; i < 64; ++i) { s01 += p.diff_lambda[i] * p.diff_lambda[64 + i]; s23 += p.diff_lambda[128 + i] * p.diff_lambda[192 + i]; }
        *(float*)(ws + WS_LAM) = expf(s01) - expf(s23) + LAMBDA_INIT;
    }
    float* rope = (float*)(ws + WS_ROPE);
    for (int i = (int)gtid; i < 64 * 16; i += (int)gsz) { const int pos = i >> 4, f = i & 15; const float inv = exp2f(-(float)f * (13.287712379549449f / 16.f)); const float a = (float)pos * inv; rope[2 * i] = cosf(a); rope[2 * i + 1] = sinf(a); }
    bf16_t* bt = (bf16_t*)(ws + WS_BIAST);
    for (int i = (int)gtid; i < 8 * 15 * 4096; i += (int)gsz) {
        const int j = i & 7, kc = (i >> 3) & 63, cq = (i >> 9) & 7, hd = i >> 12, dr = hd % 15, h = hd / 15;
        const int cp = cq * 8 + j; int cs = cp - 8; cs = cs < 0 ? 0 : (cs > 48 ? 48 : cs);
        float v = NEG_BIG;
        if (kc >= cs && kc < cs + 16) v = p.rel_bias[(h * 15 + dr) * 31 + (kc - cp + 15)] * LOG2E;
        bt[i] = (bf16_t)f2bf(v);
    }
}

__device__ __forceinline__ void p1_hrows(Frame& F, const Params& p) {
    unsigned char* ws = p.ws;
    const float* modp = (const float*)(ws + WS_MODP);
    float* mod = (float*)(ws + WS_MOD);
    for (int i = F.bid * NTHR + F.tid; i < 9 * NMOD; i += F.G * NTHR) { float s = p.b_ada[i % NMOD];
#pragma unroll
        for (int ks = 0; ks < 8; ++ks) s += modp[(size_t)ks * 9 * NMOD + i];
        mod[i] = s; }
    const int rows_per = (MALL + F.G - 1) / F.G, r0 = F.bid * rows_per, r1 = min(MALL, r0 + rows_per);
    if (r0 >= r1) return;
    const int mr_lo = r0 < MLAT ? (r0 >> 12) : 8;
    LAS float* tab = (LAS float*)F.lds;
    for (int i = F.tid; i < 2 * 2048; i += NTHR) {
        const int which = i >> 11, ss = (i >> 10) & 1, col = i & 1023; const int mr = min(8, mr_lo + which);
        const int mi = mr * NMOD + (ss == 0 ? D : 0) + col;
        float s = p.b_ada[(ss == 0 ? D : 0) + col];
#pragma unroll
        for (int ks = 0; ks < 8; ++ks) s += modp[(size_t)ks * 9 * NMOD + mi];
        tab[i] = ss == 0 ? p.g_norm[col] * (1.f + s) : s;
    }
    __syncthreads();
    bf16_t* H = (bf16_t*)(ws + WS_H);
    f32x4 nx[2][4];
#define P1_LOAD(dst, rowa_) do { _Pragma("unroll") for (int q = 0; q < 2; ++q) { const int row = min((rowa_) + q * NWAVES, MALL - 1); \
            const float* xr = row < MLAT ? p.x + (size_t)row * D : p.ctx + (size_t)(row - MLAT) * D; \
            _Pragma("unroll") for (int j = 0; j < 4; ++j) dst[q][j] = ((const f32x4*)xr)[F.lane + 64 * j]; } } while (0)
    P1_LOAD(nx, r0 + F.wave);
    for (int rowa = r0 + F.wave; rowa < r1; rowa += 2 * NWAVES) {
        f32x4 v[2][4]; float ssq[2];
#pragma unroll
        for (int q = 0; q < 2; ++q)
#pragma unroll
            for (int j = 0; j < 4; ++j) v[q][j] = nx[q][j];
        if (rowa + 2 * NWAVES < r1) P1_LOAD(nx, rowa + 2 * NWAVES);
#pragma unroll
        for (int q = 0; q < 2; ++q) { float s = 0.f;
#pragma unroll
            for (int j = 0; j < 4; ++j) s += v[q][j].x * v[q][j].x + v[q][j].y * v[q][j].y + v[q][j].z * v[q][j].z + v[q][j].w * v[q][j].w;
            ssq[q] = wave_sum(s); }
#pragma unroll
        for (int q = 0; q < 2; ++q) { const int row = rowa + q * NWAVES; if (row < r1) {
            const int mr = row < MLAT ? (row >> 12) : 8; const LAS float* tb = tab + (mr - mr_lo) * 2048;
            const float rstd = rsqrtf(ssq[q] * (1.f / D) + EPS);
#pragma unroll
            for (int j = 0; j < 4; ++j) { const int col = (F.lane + 64 * j) * 4;
                const f32x4 sc = *(const LAS f32x4*)(tb + col), sh = *(const LAS f32x4*)(tb + 1024 + col);
                const f32x4 y = (v[q][j] * rstd) * sc + sh;
                u32x2 o; o.x = pk2(y.x, y.y); o.y = pk2(y.z, y.w);
                *(u32x2*)(H + (size_t)row * D + col) = o; } } }
    }
#undef P1_LOAD
}

struct EpiQKVFast {
    static constexpr bool PERM = true, AFTER_DRAIN = false;
    unsigned char* ws;
    __device__ __forceinline__ void operator()(const pg8::f32x4 (&acc)[2][2][4][2], const pg8::Unit& u, int wr, int wc, int fr, int fq) const {
        const bool lat = u.pm < 128;
        const int kind = u.pn >> 1;
        if (!lat && (kind == 0 || kind == 3)) return;
        const int b = lat ? (u.pm >> 4) : (u.pm - 128);
        const int tb = lat ? (u.pm & 15) * 256 : 0;
        const float* rope = (const float*)(ws + WS_ROPE);
#pragma unroll
        for (int bj = 0; bj < 2; ++bj) {
            const int cc = (u.pn & 1) * 256 + bj * 128 + wc * 32 + 8 * fq;
#pragma unroll
            for (int ai = 0; ai < 2; ++ai)
#pragma unroll
                for (int m = 0; m < 4; ++m) {
                    const int rowin = ai * 128 + wr * 64 + m * 16 + fr;
                    const int t = tb + rowin;
                    const int j = lat ? 256 + t : rowin;
                    f32x4 v0 = acc[ai][bj][m][0], v1 = acc[ai][bj][m][1];
                    bf16_t* dst;
                    if (kind == 0) { dst = (bf16_t*)(ws + WS_QA) + qa_idx(b, cc >> 6, t, cc & 63); v0 = v0 * C2; v1 = v1 * C2; }
                    else if (kind == 1) dst = (bf16_t*)(ws + WS_KA) + ka_idx(b, cc >> 6, j, cc & 63);
                    else if (kind == 2) dst = (bf16_t*)(ws + WS_VA) + va_idx(b, cc >> 6, j, cc & 63);
                    else if (kind == 5) dst = (bf16_t*)(ws + WS_VD) + vd_idx(b, cc >> 7, j, cc & 127);
                    else {
                        const int mm = cc >> 8, h = (cc >> 6) & 3, d = cc & 63;
                        if (lat) { const int i0 = d >> 1; const int pos = i0 < 16 ? (t >> 6) : (t & 63); const float* rp = rope + (pos * 16 + (i0 & 15)) * 2;
                            const f32x4 r0 = *(const f32x4*)rp, r1 = *(const f32x4*)(rp + 4);
                            f32x4 a0, a1;
                            a0.x = v0.x * r0.x - v0.y * r0.y; a0.y = v0.x * r0.y + v0.y * r0.x; a0.z = v0.z * r0.z - v0.w * r0.w; a0.w = v0.z * r0.w + v0.w * r0.z;
                            a1.x = v1.x * r1.x - v1.y * r1.y; a1.y = v1.x * r1.y + v1.y * r1.x; a1.z = v1.z * r1.z - v1.w * r1.w; a1.w = v1.z * r1.w + v1.w * r1.z;
                            v0 = a0; v1 = a1; }
                        if (kind == 3) { dst = (bf16_t*)(ws + WS_QD) + qd_idx(b, mm, h, t, d); v0 = v0 * C2; v1 = v1 * C2; }
                        else dst = (bf16_t*)(ws + WS_KD) + kd_idx(b, mm, h, j, d);
                    }
                    pg8::u32x4 w; w.x = pg8::cvt_pk_bf16(v0[0], v0[1]); w.y = pg8::cvt_pk_bf16(v0[2], v0[3]); w.z = pg8::cvt_pk_bf16(v1[0], v1[1]); w.w = pg8::cvt_pk_bf16(v1[2], v1[3]);
                    *(pg8::u32x4*)dst = w;
                }
        }
    }
};


struct EpiQ2Frag {
    static constexpr bool PERM = true, AFTER_DRAIN = false;
    bf16_t* O;
    __device__ __forceinline__ void operator()(const pg8::f32x4 (&acc)[2][2][4][2], const pg8::Unit& u, int wr, int wc, int fr, int fq) const {
        const int h = u.pn;
#pragma unroll
        for (int bj = 0; bj < 2; ++bj) {
            const int c8 = wc * 4 + fq;
#pragma unroll
            for (int ai = 0; ai < 2; ++ai)
#pragma unroll
                for (int m = 0; m < 4; ++m) {
                    const int row = u.pm * 256 + ai * 128 + wr * 64 + m * 16 + fr;
                    const size_t idx = ((((((size_t)(row >> 5) * 8 + h) * 2 + bj) * 8 + (c8 >> 1)) * 2 + (c8 & 1)) * 32 + (row & 31)) * 8;
                    const f32x4 v0 = acc[ai][bj][m][0], v1 = acc[ai][bj][m][1];
                    pg8::u32x4 w; w.x = pg8::cvt_pk_bf16(v0[0], v0[1]); w.y = pg8::cvt_pk_bf16(v0[2], v0[3]); w.z = pg8::cvt_pk_bf16(v1[0], v1[1]); w.w = pg8::cvt_pk_bf16(v1[2], v1[3]);
                    *(pg8::u32x4*)(O + idx) = w;
                }
        }
    }
};

__device__ __forceinline__ void p5_rows2(Frame& F, const Params& p) {
    unsigned char* ws = p.ws;
    const float* mod = (const float*)(ws + WS_MOD);
    const bf16_t* YO = (const bf16_t*)(ws + WS_YO);
    bf16_t* H2 = (bf16_t*)(ws + WS_H2); bf16_t* XN = (bf16_t*)(ws + WS_XN);
    const int gw = F.bid * NWAVES + F.wave, NGW = F.G * NWAVES;
    const int rows_per = (MLAT + NGW - 1) / NGW;
    const int rend = min(MLAT, (gw + 1) * rows_per);
    f32x4 nxx[2][4]; u32x2 nxy[2][4];
#define P5_LOAD(rowa_) do { _Pragma("unroll") for (int q = 0; q < 2; ++q) { const int row = min((rowa_) + q, MLAT - 1); \
            _Pragma("unroll") for (int j = 0; j < 4; ++j) { nxx[q][j] = ((const f32x4*)(p.x + (size_t)row * D))[F.lane + 64 * j]; nxy[q][j] = ((const u32x2*)(YO + (size_t)row * D))[F.lane + 64 * j]; } } } while (0)
    P5_LOAD(gw * rows_per);
    for (int rowa = gw * rows_per; rowa < rend; rowa += 2) {
        f32x4 xv[2][4], yv[2][4]; float ssq[2];
#pragma unroll
        for (int q = 0; q < 2; ++q)
#pragma unroll
            for (int j = 0; j < 4; ++j) { xv[q][j] = nxx[q][j]; const u32x2 yw = nxy[q][j]; yv[q][j] = (f32x4){bflo(yw.x), bfhi(yw.x), bflo(yw.y), bfhi(yw.y)}; }
        if (rowa + 2 < rend) P5_LOAD(rowa + 2);
#pragma unroll
        for (int q = 0; q < 2; ++q) { float s = 0.f;
#pragma unroll
            for (int j = 0; j < 4; ++j) s += yv[q][j].x * yv[q][j].x + yv[q][j].y * yv[q][j].y + yv[q][j].z * yv[q][j].z + yv[q][j].w * yv[q][j].w;
            ssq[q] = wave_sum(s); }
#pragma unroll
        for (int q = 0; q < 2; ++q) { const int row = rowa + q; if (row < MLAT) {
            const int b = row >> 12; const float* mb = mod + b * NMOD;
            const float rstd = rsqrtf(ssq[q] * (1.f / D) + EPS);
            float s2 = 0.f;
#pragma unroll
            for (int j = 0; j < 4; ++j) { const int col = (F.lane + 64 * j) * 4;
                const f32x4 g1 = *(const f32x4*)(p.g_norm + D + col), gt1 = *(const f32x4*)(mb + 2 * D + col);
                xv[q][j] = xv[q][j] + gt1 * (yv[q][j] * rstd * g1);
                { u32x2 xo; xo.x = pk2(xv[q][j].x, xv[q][j].y); xo.y = pk2(xv[q][j].z, xv[q][j].w); *(u32x2*)(XN + (size_t)row * D + col) = xo; }
                s2 += xv[q][j].x * xv[q][j].x + xv[q][j].y * xv[q][j].y + xv[q][j].z * xv[q][j].z + xv[q][j].w * xv[q][j].w; }
            const float rstd2 = rsqrtf(wave_sum(s2) * (1.f / D) + EPS);
#pragma unroll
            for (int j = 0; j < 4; ++j) { const int col = (F.lane + 64 * j) * 4;
                const f32x4 g2 = *(const f32x4*)(p.g_norm + 2 * D + col), sh2 = *(const f32x4*)(mb + 3 * D + col), sc2 = *(const f32x4*)(mb + 4 * D + col);
                const f32x4 y = (xv[q][j] * rstd2 * g2) * (sc2 + 1.f) + sh2;
                u32x2 o; o.x = pk2(y.x, y.y); o.y = pk2(y.z, y.w);
                *(u32x2*)(H2 + (size_t)row * D + col) = o; } } }
    }
#undef P5_LOAD
}

template <int J> __device__ __forceinline__ unsigned lane_xor(unsigned x, int lane) {
    if (J == 1) return (unsigned)__builtin_amdgcn_update_dpp(0, (int)x, 0xB1, 0xf, 0xf, false);
    if (J == 2) return (unsigned)__builtin_amdgcn_update_dpp(0, (int)x, 0x4E, 0xf, 0xf, false);
    if (J == 4) { const unsigned a = (unsigned)__builtin_amdgcn_update_dpp(0, (int)x, 0x104, 0xf, 0xf, false),
                                 b = (unsigned)__builtin_amdgcn_update_dpp(0, (int)x, 0x114, 0xf, 0xf, false);
                  return (lane & 4) ? b : a; }
    if (J == 8) return (unsigned)__builtin_amdgcn_update_dpp(0, (int)x, 0x128, 0xf, 0xf, false);
    if (J == 16) { auto r = __builtin_amdgcn_permlane16_swap(x, x, false, false); return (lane & 16) ? r[0] : r[1]; }
    auto r = __builtin_amdgcn_permlane32_swap(x, x, false, false); return (lane & 32) ? r[0] : r[1];
}
template <int K2, int J> __device__ __forceinline__ void bitonic_step128(unsigned& key0, unsigned& key1, int lane) {
    if (J == 64) { const unsigned lo = key0 < key1 ? key0 : key1, hi_ = key0 < key1 ? key1 : key0; key0 = lo; key1 = hi_; }
    else {
        const unsigned p0_ = lane_xor<J>(key0, lane), p1_ = lane_xor<J>(key1, lane);
        const bool lower = (lane & J) == 0;
        const bool asc0 = K2 == 128 ? true : ((lane & K2) == 0), asc1 = K2 == 128 ? true : (((64 + lane) & K2) == 0);
        const bool kmin0 = lower == asc0, kmin1 = lower == asc1;
        key0 = kmin0 ? (key0 < p0_ ? key0 : p0_) : (key0 < p0_ ? p0_ : key0);
        key1 = kmin1 ? (key1 < p1_ ? key1 : p1_) : (key1 < p1_ ? p1_ : key1);
    }
}
__device__ __forceinline__ void sort128_asc(unsigned& k0, unsigned& k1, int lane) {
    bitonic_step128<2, 1>(k0, k1, lane);
    bitonic_step128<4, 2>(k0, k1, lane); bitonic_step128<4, 1>(k0, k1, lane);
    bitonic_step128<8, 4>(k0, k1, lane); bitonic_step128<8, 2>(k0, k1, lane); bitonic_step128<8, 1>(k0, k1, lane);
    bitonic_step128<16, 8>(k0, k1, lane); bitonic_step128<16, 4>(k0, k1, lane); bitonic_step128<16, 2>(k0, k1, lane); bitonic_step128<16, 1>(k0, k1, lane);
    bitonic_step128<32, 16>(k0, k1, lane); bitonic_step128<32, 8>(k0, k1, lane); bitonic_step128<32, 4>(k0, k1, lane); bitonic_step128<32, 2>(k0, k1, lane); bitonic_step128<32, 1>(k0, k1, lane);
    bitonic_step128<64, 32>(k0, k1, lane); bitonic_step128<64, 16>(k0, k1, lane); bitonic_step128<64, 8>(k0, k1, lane); bitonic_step128<64, 4>(k0, k1, lane); bitonic_step128<64, 2>(k0, k1, lane); bitonic_step128<64, 1>(k0, k1, lane);
    bitonic_step128<128, 64>(k0, k1, lane); bitonic_step128<128, 32>(k0, k1, lane); bitonic_step128<128, 16>(k0, k1, lane); bitonic_step128<128, 8>(k0, k1, lane); bitonic_step128<128, 4>(k0, k1, lane); bitonic_step128<128, 2>(k0, k1, lane); bitonic_step128<128, 1>(k0, k1, lane);
}
__device__ __forceinline__ float e2m3_val(int k) { return k < 8 ? (float)k * 0.125f : ldexpf(1.f + (float)(k & 7) * 0.125f, (k >> 3) - 1); }
__device__ __forceinline__ int e2m3_idx(float x) { if (x < 1.f) return (int)(x * 8.f + 0.5f); const int e = x >= 4.f ? 2 : (x >= 2.f ? 1 : 0); return 8 * (e + 1) + (int)((x / (float)(1 << e) - 1.f) * 8.f + 0.5f); }
__device__ __forceinline__ float sum8(float v) {
    v += __uint_as_float((unsigned)__builtin_amdgcn_update_dpp(0, (int)__float_as_uint(v), 0xB1, 0xf, 0xf, false));
    v += __uint_as_float((unsigned)__builtin_amdgcn_update_dpp(0, (int)__float_as_uint(v), 0x4E, 0xf, 0xf, false));
    v += __uint_as_float((unsigned)__builtin_amdgcn_update_dpp(0, (int)__float_as_uint(v), 0x141, 0xf, 0xf, false));
    return v;
}
template <int MODE> __device__ __forceinline__ void p8_gather(Frame& F, const Params& p, const XcdBarrier& bar) {
    unsigned char* ws = p.ws;
    const bf16_t* H2 = (const bf16_t*)(ws + WS_H2); const unsigned char* U6 = ws + WS_UB; const unsigned char* V6 = ws + WS_VB;
    const int* EX = (const int*)(ws + WS_EXP); const float* GT = (const float*)(ws + WS_GATE); const float* SU = (const float*)(ws + WS_SU); const float* mod = (const float*)(ws + WS_MOD);
    const int lane = F.lane, l5 = lane & 31, b5 = (lane >> 5) & 1, b4 = (lane >> 4) & 1, b3 = (lane >> 3) & 1;
    const int ent = 2 * (2 * b4 + b3) + b5;
    LAS float* scr = (LAS float*)(F.lds + F.wave * 8192);
    int sw4;
    { const unsigned cw = __builtin_amdgcn_cvt_scalef32_pk_fp4_f32(0u, 1.0f, 2.0f, 1.0f, 0); const f32x2 cr = __builtin_amdgcn_cvt_scalef32_pk_f32_fp4(cw, 1.0f, 0);
      sw4 = __builtin_amdgcn_readfirstlane(cr.x == 1.0f ? 0 : 1); }
    const unsigned mlo = (lane & 3) == 0 ? 0x0000FFFFu : ((lane & 3) == 1 ? 0xFFFF0000u : 0u), mhi = (lane & 3) == 2 ? 0x0000FFFFu : ((lane & 3) == 3 ? 0xFFFF0000u : 0u);
#define FP4BF(w_, b_) __builtin_bit_cast(unsigned, __builtin_amdgcn_cvt_scalef32_pk_bf16_fp4((w_), 1.0f, (b_)))
    const unsigned char* ubase = U6 + l5 * 16; const unsigned char* vbase = V6 + l5 * 16;
    unsigned* ctr = (unsigned*)(ws + WS_CTL) + CW_P8CTR + (MODE != 0 ? 16 : 0);
    int cnext = 0;
    if (lane == 0) cnext = (int)__hip_atomic_fetch_add(ctr, 1u, __ATOMIC_RELAXED, __HIP_MEMORY_SCOPE_AGENT);
    cnext = __builtin_amdgcn_readfirstlane(cnext);
    for (;;) {
        const int t = cnext;
        if (t >= MLAT) break;
        if (lane == 0) cnext = (int)__hip_atomic_fetch_add(ctr, 1u, __ATOMIC_RELAXED, __HIP_MEMORY_SCOPE_AGENT);
        const size_t tb_ = (size_t)t * 128;
        unsigned key0 = ((unsigned)EX[tb_ + lane] << 7) | (unsigned)lane, key1 = ((unsigned)EX[tb_ + 64 + lane] << 7) | (unsigned)(64 + lane);
        hs16x4 hb[8]; f32x4 acc[8];
        { const u32x4* hp = (const u32x4*)(H2 + (size_t)t * D + l5 * 32);
#pragma unroll
          for (int j = 0; j < 4; ++j) { u32x4 w = hp[j];
              if (sw4) { w.x = __builtin_amdgcn_alignbit(w.x, w.x, 16); w.y = __builtin_amdgcn_alignbit(w.y, w.y, 16); w.z = __builtin_amdgcn_alignbit(w.z, w.z, 16); w.w = __builtin_amdgcn_alignbit(w.w, w.w, 16); }
              hb[2 * j] = __builtin_bit_cast(hs16x4, (u32x2){w.x, w.y}); hb[2 * j + 1] = __builtin_bit_cast(hs16x4, (u32x2){w.z, w.w}); }
#pragma unroll
          for (int j = 0; j < 8; ++j) acc[j] = (f32x4){0.f, 0.f, 0.f, 0.f}; }
        sort128_asc(key0, key1, lane);
        const unsigned off0 = (key0 & ~127u) << 2, off1 = (key1 & ~127u) << 2;
        for (int bb = 0; bb < 16; ++bb) {
            const unsigned kreg = bb < 8 ? key0 : key1, koff = bb < 8 ? off0 : off1; const int lb = (bb & 7) * 8;
            const unsigned kmine = (unsigned)__builtin_amdgcn_ds_bpermute((lb + ent) * 4, (int)kreg);
            unsigned eo[4];
#pragma unroll
            for (int pr = 0; pr < 4; ++pr) eo[pr] = (unsigned)__builtin_amdgcn_ds_bpermute((lb + 2 * pr + b5) * 4, (int)koff) & (MODE == 1 ? 0x7FFFFu : (MODE == 3 ? 0xFFFu : 0xFFFFFFFFu));
            u32x4 u4[4], v4[4];
#pragma unroll
            for (int pr = 0; pr < 4; ++pr) { u4[pr] = *(const u32x4*)(ubase + eo[pr]); v4[pr] = *(const u32x4*)(vbase + eo[pr]); }
            const float gl = GT[tb_ + (kmine & 127u)], sl = SU[tb_ + (kmine & 127u)];
            if (MODE == 4) { unsigned xa = 0u;
#pragma unroll
                for (int pr = 0; pr < 4; ++pr) xa ^= u4[pr].x ^ u4[pr].y ^ u4[pr].z ^ u4[pr].w ^ v4[pr].x ^ v4[pr].y ^ v4[pr].z ^ v4[pr].w;
                acc[0][0] += __uint_as_float(xa & 0x007FFFFFu) + gl + sl; continue; }
            f32x4 dq[4];
#pragma unroll
            for (int pr = 0; pr < 4; ++pr) dq[pr] = (f32x4){0.f, 0.f, 0.f, 0.f};
#pragma unroll
            for (int j = 0; j < 4; ++j) {
#pragma unroll
                for (int pr = 0; pr < 4; ++pr) { const unsigned c0 = FP4BF(u4[pr][j], 0), c1 = FP4BF(u4[pr][j], 1);
                    dq[pr] = __builtin_amdgcn_mfma_f32_4x4x4bf16_1k(__builtin_bit_cast(hs16x4, (u32x2){c0, c1}), hb[2 * j], dq[pr], 0, 0, 0); }
#pragma unroll
                for (int pr = 0; pr < 4; ++pr) { const unsigned c2 = FP4BF(u4[pr][j], 2), c3 = FP4BF(u4[pr][j], 3);
                    dq[pr] = __builtin_amdgcn_mfma_f32_4x4x4bf16_1k(__builtin_bit_cast(hs16x4, (u32x2){c2, c3}), hb[2 * j + 1], dq[pr], 0, 0, 0); }
            }
            float d[4];
#pragma unroll
            for (int pr = 0; pr < 4; ++pr) d[pr] = (lane & 2) ? ((lane & 1) ? dq[pr][3] : dq[pr][2]) : ((lane & 1) ? dq[pr][1] : dq[pr][0]);
            float r2[2], r1;
#pragma unroll
            for (int i = 0; i < 2; ++i) { auto rr = __builtin_amdgcn_permlane16_swap(__float_as_uint(d[i]), __float_as_uint(d[i + 2]), false, false); r2[i] = __uint_as_float(rr[0]) + __uint_as_float(rr[1]); }
            { const float keep = b3 ? r2[1] : r2[0], send = b3 ? r2[0] : r2[1]; r1 = keep + __uint_as_float((unsigned)__builtin_amdgcn_update_dpp(0, (int)__float_as_uint(send), 0x128, 0xf, 0xf, false)); }
            r1 = sum8(r1);
            const float pre = r1 * sl;
            float act;
            { const float av = fabsf(pre), dd = av * 0.2316418882f + 1.0f; const float tt = __builtin_amdgcn_rcpf(dd);
              float q = tt * 0.5307027145f + (-0.7265760135f); q = q * tt + 0.7107068705f; q = q * tt + (-0.142248368f); q = q * tt + 0.127414796f; q = q * tt;
              const float ee = __builtin_amdgcn_exp2f((pre * pre) * (-0.72134752044f));
              const float mm = pre * (q * ee); act = pre < 0.f ? mm : pre - mm; }
            const float cfl = gl * act;
            const unsigned cfpk_l = __builtin_bit_cast(unsigned, __builtin_convertvector((f32x2){cfl, cfl}, hbf16x2));
#pragma unroll
            for (int pr = 0; pr < 4; ++pr) {
                const unsigned cfpk = (unsigned)__builtin_amdgcn_ds_bpermute(((pr >> 1) * 16 + (pr & 1) * 8 + 32 * b5) * 4, (int)cfpk_l);
                const hs16x4 Aop = __builtin_bit_cast(hs16x4, (u32x2){cfpk & mlo, cfpk & mhi});
#pragma unroll
                for (int j = 0; j < 4; ++j) {
                    const unsigned c0 = FP4BF(v4[pr][j], 0), c1 = FP4BF(v4[pr][j], 1), c2 = FP4BF(v4[pr][j], 2), c3 = FP4BF(v4[pr][j], 3);
                    acc[2 * j] = __builtin_amdgcn_mfma_f32_4x4x4bf16_1k(Aop, __builtin_bit_cast(hs16x4, (u32x2){c0, c1}), acc[2 * j], 0, 0, 0);
                    acc[2 * j + 1] = __builtin_amdgcn_mfma_f32_4x4x4bf16_1k(Aop, __builtin_bit_cast(hs16x4, (u32x2){c2, c3}), acc[2 * j + 1], 0, 0, 0); }
            }
        }
#pragma unroll
        for (int j = 0; j < 32; ++j) { const float av = acc[j >> 2][j & 3]; auto rr = __builtin_amdgcn_permlane32_swap(__float_as_uint(av), __float_as_uint(av), false, false); scr[(j ^ sw4) * 64 + lane] = __uint_as_float(rr[0]) + __uint_as_float(rr[1]); }
        float at[16]; float s = 0.f;
#pragma unroll
        for (int k = 0; k < 16; ++k) { at[k] = scr[(16 * b5 + k) * 64 + lane]; s += at[k] * at[k]; }
        const float rstd = rsqrtf(wave_sum(s) * (1.f / D) + EPS);
        const float* mb = mod + (t >> 12) * NMOD + 5 * D; const float* g3 = p.g_norm + 3 * D;
#pragma unroll
        for (int j = 0; j < 4; ++j) { const int col = l5 * 32 + b5 * 16 + j * 4;
            float* op = p.out + (size_t)t * D + col;
            const u32x2 xw = *(const u32x2*)((const bf16_t*)(ws + WS_XN) + (size_t)t * D + col);
            const f32x4 x0 = (f32x4){bflo(xw.x), bfhi(xw.x), bflo(xw.y), bfhi(xw.y)}, ga = *(const f32x4*)(g3 + col), ta = *(const f32x4*)(mb + col);
            const f32x4 pa = (f32x4){at[4 * j], at[4 * j + 1], at[4 * j + 2], at[4 * j + 3]};
            if (MODE == 0 || rstd == 123456.f) *(f32x4*)op = x0 + ta * (pa * rstd * ga); }
        cnext = __builtin_amdgcn_readfirstlane(cnext);
    }
}

namespace att {
typedef short bf16x8 __attribute__((ext_vector_type(8)));
typedef short s16x4 __attribute__((ext_vector_type(4)));
typedef float f32x16 __attribute__((ext_vector_type(16)));
typedef __attribute__((address_space(3))) const unsigned char* lcp;
typedef __attribute__((address_space(3))) unsigned char* lp;
constexpr int NA_SLOT = 16384, NA_BIAS_OFF = 32768, WSF_OFF = 155648;
constexpr int DF_SLOT = 32768;
constexpr float THRL = 8.f;

__device__ __forceinline__ int crow(int r, int hi) { return (r & 3) + 8 * (r >> 2) + 4 * hi; }
__device__ __forceinline__ s16x4 vtr(lcp p) { return __builtin_bit_cast(s16x4, __builtin_amdgcn_ds_read_tr16_b64_v4i16((__attribute__((address_space(3))) s16x4*)p)); }
typedef float f32x2_t __attribute__((ext_vector_type(2))); typedef __bf16 bf16x2v_t __attribute__((ext_vector_type(2)));
__device__ __forceinline__ unsigned cvtpk(float lo, float hi) { f32x2_t v = {lo, hi}; bf16x2v_t b = __builtin_convertvector(v, bf16x2v_t); return __builtin_bit_cast(unsigned, b); }
__device__ __forceinline__ float swap_half(float v) { auto rr = __builtin_amdgcn_permlane32_swap(__float_as_uint(v), __float_as_uint(v), false, false); return __uint_as_float(rr[0]) == v ? __uint_as_float(rr[1]) : __uint_as_float(rr[0]); }
__device__ __forceinline__ void dma16(const void* gsrc, lp lds_dst) {
    unsigned keep; const unsigned dst = (unsigned)__builtin_amdgcn_readfirstlane((int)(unsigned)(size_t)lds_dst);
    asm volatile("s_mov_b32 %0, m0\n\ts_mov_b32 m0, %2\n\ts_nop 0\n\tglobal_load_lds_dwordx4 %1, off\n\ts_mov_b32 m0, %0" : "=&s"(keep) : "v"(gsrc), "s"(dst) : "memory");
}
__device__ __forceinline__ float max3f(float a, float b, float c) { float r; asm("v_max3_f32 %0, %1, %2, %3" : "=v"(r) : "v"(a), "v"(b), "v"(c)); return r; }
__device__ __forceinline__ float rowmax32(const f32x16& p0, const f32x16& p1) {
    float a = max3f(p0[0], p0[1], p1[0]), b = max3f(p0[2], p0[3], p1[1]); a = max3f(a, p1[2], p1[3]);
#pragma unroll
    for (int r = 4; r < 16; r += 4) { a = max3f(a, p0[r], p0[r + 1]); b = max3f(b, p0[r + 2], p0[r + 3]); a = max3f(a, p1[r], p1[r + 1]); b = max3f(b, p1[r + 2], p1[r + 3]); }
    float m = max3f(a, b, b);
    auto rr = __builtin_amdgcn_permlane32_swap(__float_as_uint(m), __float_as_uint(m), false, false);
    return max3f(__uint_as_float(rr[0]), __uint_as_float(rr[1]), __uint_as_float(rr[1]));
}

typedef __bf16 bf16x2_t __attribute__((ext_vector_type(2)));
__device__ __forceinline__ float psum_bf16(const u32x4 (&pw)[4], float acc) {
    const bf16x2_t ones = __builtin_bit_cast(bf16x2_t, 0x3F803F80u); float a0 = acc, a1 = 0.f;
#pragma unroll
    for (int k = 0; k < 4; ++k) { a0 = __builtin_amdgcn_fdot2_f32_bf16(__builtin_bit_cast(bf16x2_t, pw[k][0]), ones, a0, false); a1 = __builtin_amdgcn_fdot2_f32_bf16(__builtin_bit_cast(bf16x2_t, pw[k][1]), ones, a1, false);
        a0 = __builtin_amdgcn_fdot2_f32_bf16(__builtin_bit_cast(bf16x2_t, pw[k][2]), ones, a0, false); a1 = __builtin_amdgcn_fdot2_f32_bf16(__builtin_bit_cast(bf16x2_t, pw[k][3]), ones, a1, false); }
    return a0 + a1;
}
template <int NDV> struct FlashState { float mhat, l; f32x16 negm; f32x16 o[NDV]; };

template <int NDV, bool BIAS>
__device__ __forceinline__ void flash_tile(FlashState<NDV>& st, const bf16x8 (&qr)[4], lcp Kslot, lcp Vslot, lcp Bslot, const bf16x8 (&qoh)[2],
                                           __attribute__((address_space(3))) float* wsf, int r32, int hi, int lane, bool first) {
    f32x16 p0 = st.negm, p1 = st.negm;
    lcp kb = Kslot + hi * 1024 + r32 * 16;
    bf16x8 kf[8], bf_[4];
#pragma unroll
    for (int d0 = 0; d0 < 4; ++d0) { kf[2 * d0] = *(const __attribute__((address_space(3))) bf16x8*)(kb + d0 * 2048); kf[2 * d0 + 1] = *(const __attribute__((address_space(3))) bf16x8*)(kb + d0 * 2048 + 512); }
    if (BIAS) { lcp bb = Bslot + hi * 1024 + r32 * 16;
#pragma unroll
        for (int e = 0; e < 2; ++e) { bf_[2 * e] = *(const __attribute__((address_space(3))) bf16x8*)(bb + e * 2048); bf_[2 * e + 1] = *(const __attribute__((address_space(3))) bf16x8*)(bb + e * 2048 + 512); } }
    lcp vb = Vslot + ((lane >> 4) & 1) * 32 + (lane & 3) * 8 + (4 * hi + ((lane & 15) >> 2)) * 64;
    s16x4 va[8], vn[8];
#pragma unroll
    for (int ks = 0; ks < 4; ++ks) { va[2 * ks] = vtr(vb + ks * 1024); va[2 * ks + 1] = vtr(vb + ks * 1024 + 512); }
#pragma unroll
    for (int d0 = 0; d0 < 4; ++d0) { p0 = __builtin_amdgcn_mfma_f32_32x32x16_bf16(kf[2 * d0], qr[d0], p0, 0, 0, 0); p1 = __builtin_amdgcn_mfma_f32_32x32x16_bf16(kf[2 * d0 + 1], qr[d0], p1, 0, 0, 0); }
    if (BIAS) {
#pragma unroll
        for (int e = 0; e < 2; ++e) { p0 = __builtin_amdgcn_mfma_f32_32x32x16_bf16(bf_[2 * e], qoh[e], p0, 0, 0, 0); p1 = __builtin_amdgcn_mfma_f32_32x32x16_bf16(bf_[2 * e + 1], qoh[e], p1, 0, 0, 0); }
    }
    asm volatile("s_nop 15\n\ts_nop 7" : "+v"(p0), "+v"(p1));
    const float rm = rowmax32(p0, p1);
    if (first) {
        st.mhat += rm;
#pragma unroll
        for (int r = 0; r < 16; ++r) { p0[r] -= rm; p1[r] -= rm; st.negm[r] = -st.mhat; }
    } else if (__any(rm > THRL)) {
        const float dl = fmaxf(rm, 0.f); const float alpha = __builtin_amdgcn_exp2f(-dl); st.mhat += dl; st.l *= alpha;
        if (hi == 0) wsf[r32] = alpha;
        asm volatile("s_waitcnt lgkmcnt(0)" ::: "memory");
        float al[16];
#pragma unroll
        for (int r = 0; r < 16; ++r) al[r] = wsf[crow(r, hi)];
#pragma unroll
        for (int d = 0; d < NDV; ++d)
#pragma unroll
            for (int r = 0; r < 16; ++r) st.o[d][r] *= al[r];
#pragma unroll
        for (int r = 0; r < 16; ++r) { p0[r] -= dl; p1[r] -= dl; st.negm[r] = -st.mhat; }
    }
    float sacc = 0.f;
#pragma unroll
    for (int r = 0; r < 16; ++r) { p0[r] = __builtin_amdgcn_exp2f(p0[r]); p1[r] = __builtin_amdgcn_exp2f(p1[r]); sacc += p0[r] + p1[r]; }
    st.l += sacc;
    u32x4 pw[4];
#pragma unroll
    for (int i = 0; i < 4; ++i) { pw[0][i] = cvtpk(p0[2 * i], p0[2 * i + 1]); pw[1][i] = cvtpk(p0[8 + 2 * i], p0[8 + 2 * i + 1]); pw[2][i] = cvtpk(p1[2 * i], p1[2 * i + 1]); pw[3][i] = cvtpk(p1[8 + 2 * i], p1[8 + 2 * i + 1]); }
    __builtin_amdgcn_sched_barrier(0);
#pragma unroll
    for (int d0 = 0; d0 < NDV; ++d0) {
#pragma unroll
        for (int ks = 0; ks < 4; ++ks) {
            if (d0 < NDV - 1) { vn[2 * ks] = vtr(vb + (d0 + 1) * 4096 + ks * 1024); vn[2 * ks + 1] = vtr(vb + (d0 + 1) * 4096 + ks * 1024 + 512); }
            const bf16x8 vf = (bf16x8){va[2 * ks][0], va[2 * ks][1], va[2 * ks][2], va[2 * ks][3], va[2 * ks + 1][0], va[2 * ks + 1][1], va[2 * ks + 1][2], va[2 * ks + 1][3]};
            st.o[d0] = __builtin_amdgcn_mfma_f32_32x32x16_bf16(__builtin_bit_cast(bf16x8, pw[ks]), vf, st.o[d0], 0, 0, 0);
            __builtin_amdgcn_sched_barrier(0);
        }
#pragma unroll
        for (int i = 0; i < 8; ++i) va[i] = vn[i];
    }
}

constexpr int NA2_SLOT = 16384, NA2_BIAS_OFF = 65536;
__device__ __forceinline__ void na_units(Frame& F, const Params& p) {
    unsigned char* ws = p.ws;
    const bf16_t* QA = (const bf16_t*)(ws + WS_QA); const bf16_t* KA = (const bf16_t*)(ws + WS_KA); const bf16_t* VA = (const bf16_t*)(ws + WS_VA);
    const bf16_t* BT = (const bf16_t*)(ws + WS_BIAST); bf16_t* Y = (bf16_t*)(ws + WS_Y);
    const int lane = F.lane, r32 = lane & 31, hi = lane >> 5, wave = F.wave;
    lp lds = (lp)F.lds;
    __attribute__((address_space(3))) float* wsf = (__attribute__((address_space(3))) float*)(lds + WSF_OFF) + wave * 64;
    const int upw = 1024 / F.G;
    int cur_h = -1, cur_lo = -1, cur_hi = -1;
    bf16x8 qoh[2];
#pragma unroll
    for (int e = 0; e < 2; ++e)
#pragma unroll
        for (int j = 0; j < 8; ++j) qoh[e][j] = (16 * e + 8 * hi + j == r32) ? (short)0x3F80 : (short)0;
    for (int ui = 0; ui < upw; ++ui) {
        const int u = F.bid * upw + ui, bh = u >> 4, rg = u & 15, b = bh >> 3, h = bh & 7;
        const int r0 = rg * 4, r = r0 + (wave >> 1), ch = wave & 1;
        int rs = r - 4; rs = rs < 0 ? 0 : (rs > 56 ? 56 : rs);
        int kr_lo = r0 - 4; kr_lo = kr_lo < 0 ? 0 : (kr_lo > 56 ? 56 : kr_lo);
        int kr_hi = r0 + 3 - 4; kr_hi = kr_hi < 0 ? 0 : (kr_hi > 56 ? 56 : kr_hi); kr_hi += 7;
        const int T = 4 + (kr_hi - kr_lo + 1);
        int dr_lo = 99, dr_hi = -1;
#pragma unroll
        for (int q = 0; q < 4; ++q) { int s_ = r0 + q - 4; s_ = s_ < 0 ? 0 : (s_ > 56 ? 56 : s_); const int a = s_ - (r0 + q) + 7; dr_lo = a < dr_lo ? a : dr_lo; dr_hi = a + 7 > dr_hi ? a + 7 : dr_hi; }
        const bf16_t* Kb = KA + (size_t)bh * NKT * 4096; const bf16_t* Vb = VA + (size_t)bh * NKT * 4096;
        if (h != cur_h || dr_lo != cur_lo || dr_hi != cur_hi) {
            cur_h = h; cur_lo = dr_lo; cur_hi = dr_hi;
            const unsigned char* src = (const unsigned char*)(BT + ((size_t)h * 15 + dr_lo) * 4096);
            const int npc = (dr_hi - dr_lo + 1) * 8;
            for (int pi = wave; pi < npc; pi += 8) dma16(src + pi * 1024 + lane * 16, lds + NA2_BIAS_OFF + pi * 1024);
        }
        bf16x8 qr[4];
        { const bf16_t* qp = QA + ((size_t)bh * SEQ + r * 64 + ch * 32 + r32) * 64 + hi * 8;
#pragma unroll
          for (int d0 = 0; d0 < 4; ++d0) qr[d0] = *(const bf16x8*)(qp + d0 * 16); }
#define NA_DMA(i_) do { const int tg_ = (i_) < 4 ? (i_) : (4 + kr_lo + (i_) - 4); lp sl_ = lds + ((i_) & 3) * NA2_SLOT; \
            dma16((const unsigned char*)(Kb + (size_t)tg_ * 4096) + wave * 1024 + lane * 16, sl_ + wave * 1024); \
            dma16((const unsigned char*)(Vb + (size_t)tg_ * 4096) + wave * 1024 + lane * 16, sl_ + 8192 + wave * 1024); } while (0)
        NA_DMA(0); NA_DMA(1);
        FlashState<2> st; st.mhat = 0.f; st.l = 0.f;
#pragma unroll
        for (int rr = 0; rr < 16; ++rr) st.negm[rr] = 0.f;
#pragma unroll
        for (int d = 0; d < 2; ++d)
#pragma unroll
            for (int rr = 0; rr < 16; ++rr) st.o[d][rr] = 0.f;
        for (int i = 0; i < T; ++i) {
            if (i + 1 < T) asm volatile("s_waitcnt vmcnt(2)" ::: "memory"); else asm volatile("s_waitcnt vmcnt(0)" ::: "memory");
            __syncthreads();
            if (i + 2 < T) NA_DMA(i + 2);
            lcp sl = (lcp)(lds + (i & 3) * NA2_SLOT);
            if (i < 4) flash_tile<2, false>(st, qr, sl, sl + 8192, sl, qoh, wsf, r32, hi, lane, i == 0);
            else { const int kr = kr_lo + (i - 4);
                if (kr >= rs && kr < rs + 8) { const int dr = kr - r + 7;
                    flash_tile<2, true>(st, qr, sl, sl + 8192, (lcp)(lds + NA2_BIAS_OFF + (dr - dr_lo) * 8192 + ch * 4096), qoh, wsf, r32, hi, lane, false); } }
        }
#undef NA_DMA
        float lt = st.l; { auto rr = __builtin_amdgcn_permlane32_swap(__float_as_uint(lt), __float_as_uint(lt), false, false); lt = __uint_as_float(rr[0]) + __uint_as_float(rr[1]); }
        if (hi == 0) wsf[32 + r32] = lt;
        asm volatile("s_waitcnt lgkmcnt(0)" ::: "memory");
        bf16_t* yb = Y + ((size_t)b * SEQ + r * 64 + ch * 32) * D + h * 64 + r32;
#pragma unroll
        for (int rr = 0; rr < 16; ++rr) { const float rl = __builtin_amdgcn_rcpf(wsf[32 + crow(rr, hi)]);
#pragma unroll
            for (int d0 = 0; d0 < 2; ++d0) yb[(size_t)crow(rr, hi) * D + d0 * 32] = (bf16_t)f2bf(st.o[d0][rr] * rl); }
        __syncthreads();
    }
}

template <int MODE> __device__ __forceinline__ void diff_units_v2(Frame& F, const Params& p) {
    unsigned char* ws = p.ws;
    const bf16_t* QD = (const bf16_t*)(ws + WS_QD); const bf16_t* KD = (const bf16_t*)(ws + WS_KD); const bf16_t* VD = (const bf16_t*)(ws + WS_VD);
    bf16_t* Y = (bf16_t*)(ws + WS_Y);
    const float lam = *(const float*)(ws + WS_LAM);
    const int lane = F.lane, r32 = lane & 31, hi = lane >> 5, wave = F.wave, map = wave >> 2, qg = wave & 3;
    lp lds = (lp)F.lds;
    __attribute__((address_space(3))) float* wsf = (__attribute__((address_space(3))) float*)(lds + WSF_OFF) + wave * 64;
    __attribute__((address_space(3))) float* X = (__attribute__((address_space(3))) float*)lds;
    const int upw = 1024 / F.G;
    const int koff = map * 8192 + hi * 1024 + r32 * 16;
    const int voff = 16384 + ((lane >> 4) & 1) * 32 + (lane & 3) * 8 + (4 * hi + ((lane & 15) >> 2)) * 64;
    for (int ui = 0; ui < upw; ++ui) {
        int bh, qb;
        if (F.G == 256) { bh = (F.bid & 7) * 4 + ui; qb = F.bid >> 3; } else { const int u = F.bid * upw + ui; bh = u >> 5; qb = u & 31; }
        const int b = bh >> 2, h = bh & 3;
        const unsigned char* K1 = (const unsigned char*)(KD + (size_t)((b * 2 + 0) * 4 + h) * NKT * 4096);
        const unsigned char* K2 = (const unsigned char*)(KD + (size_t)((b * 2 + 1) * 4 + h) * NKT * 4096);
        const unsigned char* Vg = (const unsigned char*)(VD + (size_t)bh * NKT * 8192);
#define DF_DMA(t, slot) do { if (MODE != 1 && MODE != 3) { lp sl_ = lds + (slot) * DF_SLOT; \
            dma16(K1 + (size_t)(t) * 8192 + wave * 1024 + lane * 16, sl_ + wave * 1024); \
            dma16(K2 + (size_t)(t) * 8192 + wave * 1024 + lane * 16, sl_ + 8192 + wave * 1024); \
            dma16(Vg + (size_t)(t) * 16384 + wave * 1024 + lane * 16, sl_ + 16384 + wave * 1024); \
            dma16(Vg + (size_t)(t) * 16384 + 8192 + wave * 1024 + lane * 16, sl_ + 24576 + wave * 1024); } } while (0)
        DF_DMA(0, 0); DF_DMA(1, 1);
        const int q0 = qb * 128 + qg * 32;
        bf16x8 qr[4];
        { const bf16_t* qp = QD + ((size_t)((b * 2 + map) * 4 + h) * SEQ + q0 + r32) * 64 + hi * 8;
#pragma unroll
          for (int d0 = 0; d0 < 4; ++d0) qr[d0] = *(const bf16x8*)(qp + d0 * 16); }
        float mhat = 0.f, lsum = 0.f; f32x16 o[4], negm;
#pragma unroll
        for (int d = 0; d < 4; ++d)
#pragma unroll
            for (int rr = 0; rr < 16; ++rr) o[d][rr] = 0.f;
        asm volatile("s_waitcnt vmcnt(0)" ::: "memory");
        __syncthreads();
        f32x16 s0, s1;
#pragma unroll
        for (int rr = 0; rr < 16; ++rr) { s0[rr] = 0.f; s1[rr] = 0.f; }
        { lcp kb = (lcp)(lds + koff);
#pragma unroll
          for (int d0 = 0; d0 < 4; ++d0) {
              const bf16x8 b0 = *(const __attribute__((address_space(3))) bf16x8*)(kb + d0 * 2048), b1 = *(const __attribute__((address_space(3))) bf16x8*)(kb + d0 * 2048 + 512);
              s0 = __builtin_amdgcn_mfma_f32_32x32x16_bf16(b0, qr[d0], s0, 0, 0, 0); s1 = __builtin_amdgcn_mfma_f32_32x32x16_bf16(b1, qr[d0], s1, 0, 0, 0); } }
        { asm volatile("s_nop 15\n\ts_nop 7" : "+v"(s0), "+v"(s1)); const float rm0 = rowmax32(s0, s1); mhat = rm0;
#pragma unroll
          for (int rr = 0; rr < 16; ++rr) { s0[rr] -= rm0; s1[rr] -= rm0; negm[rr] = -rm0; } }
        u32x4 pw[4];
#define EXP4(X, B) do { X[B] = __builtin_amdgcn_exp2f(X[B]); X[B + 1] = __builtin_amdgcn_exp2f(X[B + 1]); X[B + 2] = __builtin_amdgcn_exp2f(X[B + 2]); X[B + 3] = __builtin_amdgcn_exp2f(X[B + 3]); sacc += X[B]; asm("" : "+v"(sacc)); sacc += X[B + 1]; asm("" : "+v"(sacc)); sacc += X[B + 2]; asm("" : "+v"(sacc)); sacc += X[B + 3]; asm("" : "+v"(sacc)); } while (0)
#define STAGE_A(t_) do { \
            lcp nxt = (lcp)(lds + (((t_) + 1) & 3) * DF_SLOT); \
            bf16x8 kf[8]; \
            _Pragma("unroll") for (int d0 = 0; d0 < 4; ++d0) { kf[2 * d0] = *(const __attribute__((address_space(3))) bf16x8*)(nxt + koff + d0 * 2048); kf[2 * d0 + 1] = *(const __attribute__((address_space(3))) bf16x8*)(nxt + koff + d0 * 2048 + 512); } \
            asm volatile("s_nop 15\n\ts_nop 7" : "+v"(s0), "+v"(s1)); \
            const float rm = rowmax32(s0, s1); \
            if (__any(rm > THRL)) { \
                const float dl = fmaxf(rm, 0.f); const float alpha = __builtin_amdgcn_exp2f(-dl); mhat += dl; lsum *= alpha; \
                if (hi == 0) wsf[r32] = alpha; \
                asm volatile("s_waitcnt lgkmcnt(0)" ::: "memory"); \
                float al[16]; \
                _Pragma("unroll") for (int r = 0; r < 16; ++r) al[r] = wsf[crow(r, hi)]; \
                _Pragma("unroll") for (int d = 0; d < 4; ++d) _Pragma("unroll") for (int r = 0; r < 16; ++r) o[d][r] *= al[r]; \
                _Pragma("unroll") for (int r = 0; r < 16; ++r) { s0[r] -= dl; s1[r] -= dl; negm[r] = -mhat; } \
            } \
            f32x16 n0, n1; float sacc = 0.f; \
            __builtin_amdgcn_sched_barrier(0); \
            n0 = __builtin_amdgcn_mfma_f32_32x32x16_bf16(kf[0], qr[0], negm, 0, 0, 0); EXP4(s0, 0);  __builtin_amdgcn_sched_barrier(0); \
            n1 = __builtin_amdgcn_mfma_f32_32x32x16_bf16(kf[1], qr[0], negm, 0, 0, 0); EXP4(s0, 4);  __builtin_amdgcn_sched_barrier(0); \
            n0 = __builtin_amdgcn_mfma_f32_32x32x16_bf16(kf[2], qr[1], n0, 0, 0, 0); EXP4(s0, 8);  __builtin_amdgcn_sched_barrier(0); \
            n1 = __builtin_amdgcn_mfma_f32_32x32x16_bf16(kf[3], qr[1], n1, 0, 0, 0); EXP4(s0, 12); __builtin_amdgcn_sched_barrier(0); \
            n0 = __builtin_amdgcn_mfma_f32_32x32x16_bf16(kf[4], qr[2], n0, 0, 0, 0); EXP4(s1, 0);  __builtin_amdgcn_sched_barrier(0); \
            n1 = __builtin_amdgcn_mfma_f32_32x32x16_bf16(kf[5], qr[2], n1, 0, 0, 0); EXP4(s1, 4);  __builtin_amdgcn_sched_barrier(0); \
            n0 = __builtin_amdgcn_mfma_f32_32x32x16_bf16(kf[6], qr[3], n0, 0, 0, 0); EXP4(s1, 8);  __builtin_amdgcn_sched_barrier(0); \
            n1 = __builtin_amdgcn_mfma_f32_32x32x16_bf16(kf[7], qr[3], n1, 0, 0, 0); EXP4(s1, 12); __builtin_amdgcn_sched_barrier(0); \
            _Pragma("unroll") for (int i = 0; i < 4; ++i) { pw[0][i] = cvtpk(s0[2 * i], s0[2 * i + 1]); pw[1][i] = cvtpk(s0[8 + 2 * i], s0[8 + 2 * i + 1]); pw[2][i] = cvtpk(s1[2 * i], s1[2 * i + 1]); pw[3][i] = cvtpk(s1[8 + 2 * i], s1[8 + 2 * i + 1]); } \
            lsum += sacc; \
            s0 = n0; s1 = n1; \
        } while (0)
#define STAGE_B(tl_) do { \
            lcp vb = (lcp)(lds + ((tl_) & 3) * DF_SLOT) + voff; \
            s16x4 va[8], vn[8]; \
            _Pragma("unroll") for (int ks = 0; ks < 4; ++ks) { va[2 * ks] = vtr(vb + ks * 1024); va[2 * ks + 1] = vtr(vb + ks * 1024 + 512); } \
            __builtin_amdgcn_sched_barrier(0); \
            _Pragma("unroll") for (int d0 = 0; d0 < 4; ++d0) { \
                _Pragma("unroll") for (int ks = 0; ks < 4; ++ks) { \
                    if (d0 < 3) { vn[2 * ks] = vtr(vb + (d0 + 1) * 4096 + ks * 1024); vn[2 * ks + 1] = vtr(vb + (d0 + 1) * 4096 + ks * 1024 + 512); } \
                    const bf16x8 vf = (bf16x8){va[2 * ks][0], va[2 * ks][1], va[2 * ks][2], va[2 * ks][3], va[2 * ks + 1][0], va[2 * ks + 1][1], va[2 * ks + 1][2], va[2 * ks + 1][3]}; \
                    o[d0] = __builtin_amdgcn_mfma_f32_32x32x16_bf16(__builtin_bit_cast(bf16x8, pw[ks]), vf, o[d0], 0, 0, 0); \
                    __builtin_amdgcn_sched_barrier(0); \
                } \
                _Pragma("unroll") for (int i = 0; i < 8; ++i) va[i] = vn[i]; \
            } \
        } while (0)
        for (int t = 0; t < NKT; ++t) {
            if (t > 0) { asm volatile("s_waitcnt vmcnt(0)" ::: "memory"); if (MODE != 3) __syncthreads(); }
            if (t + 2 < NKT) DF_DMA(t + 2, (t + 2) & 3);
            if (MODE != 2) {
                if (map == 1 && t > 0) STAGE_B(t - 1);
                STAGE_A(t);
                if (map == 0) STAGE_B(t);
            }
        }
        if (MODE != 2 && map == 1) STAGE_B(NKT - 1);
#undef STAGE_A
#undef STAGE_B
#undef EXP4
#undef DF_DMA
        float lt = lsum; { auto rr = __builtin_amdgcn_permlane32_swap(__float_as_uint(lt), __float_as_uint(lt), false, false); lt = __uint_as_float(rr[0]) + __uint_as_float(rr[1]); }
        if (hi == 0) wsf[32 + r32] = lt;
        asm volatile("s_waitcnt lgkmcnt(0)" ::: "memory");
#pragma unroll
        for (int rr = 0; rr < 16; ++rr) { const float rl = __builtin_amdgcn_rcpf(wsf[32 + crow(rr, hi)]);
#pragma unroll
            for (int d = 0; d < 4; ++d) o[d][rr] *= rl; }
        __syncthreads();
        if (map == 1) {
#pragma unroll
            for (int d = 0; d < 4; ++d)
#pragma unroll
                for (int rr = 0; rr < 16; ++rr) X[((qg * 4 + d) * 16 + rr) * 64 + lane] = o[d][rr];
        }
        __syncthreads();
        if (map == 0 && (MODE == 0 || lam == 123456.f)) {
            float ss[16];
#pragma unroll
            for (int rr = 0; rr < 16; ++rr) { float s = 0.f;
#pragma unroll
                for (int d = 0; d < 4; ++d) { const float v = o[d][rr] - lam * X[((qg * 4 + d) * 16 + rr) * 64 + lane]; o[d][rr] = v; s += v * v; }
                ss[rr] = s; }
#pragma unroll
            for (int oo = 1; oo < 32; oo <<= 1)
#pragma unroll
                for (int rr = 0; rr < 16; ++rr) ss[rr] += __shfl_xor(ss[rr], oo);
            float g[4];
#pragma unroll
            for (int d = 0; d < 4; ++d) g[d] = p.diff_subln[d * 32 + r32] * (1.f - LAMBDA_INIT);
            bf16_t* yb = Y + ((size_t)b * SEQ + q0) * D + 512 + h * 128 + r32;
#pragma unroll
            for (int rr = 0; rr < 16; ++rr) { const float rn = rsqrtf(ss[rr] * (1.f / 128.f) + EPS);
#pragma unroll
                for (int d = 0; d < 4; ++d) yb[(size_t)crow(rr, hi) * D + d * 32] = (bf16_t)f2bf(o[d][rr] * rn * g[d]); }
        }
        __syncthreads();
    }
}
}

__device__ __forceinline__ void p3_attention(Frame& F, const Params& p) {
    att::na_units(F, p);
    att::diff_units_v2<0>(F, p);
}

namespace tk {
typedef short bf16x8 __attribute__((ext_vector_type(8)));
typedef float f32x16 __attribute__((ext_vector_type(16)));
constexpr int WLK_OFF = 65536;
__device__ __forceinline__ unsigned ord(float f) { const unsigned u = __float_as_uint(f); return u ^ ((unsigned)((int)u >> 31) | 0x80000000u); }
__device__ __forceinline__ float unord(unsigned o) { return __uint_as_float(o ^ ((o & 0x80000000u) ? 0x80000000u : 0xFFFFFFFFu)); }
__device__ __forceinline__ void cs_desc(unsigned& a, unsigned& b) { const unsigned mx = a > b ? a : b, mn = a > b ? b : a; a = mx; b = mn; }
__device__ __forceinline__ void sort16_desc(unsigned (&v)[16]) {
#pragma unroll
    for (int k = 2; k <= 16; k <<= 1)
#pragma unroll
        for (int j = k >> 1; j > 0; j >>= 1)
#pragma unroll
            for (int i = 0; i < 16; ++i) { const int l = i ^ j; if (l > i) { if ((i & k) == 0 || k == 16) cs_desc(v[i], v[l]); else cs_desc(v[l], v[i]); } }
}
__device__ __forceinline__ void bmerge16_desc(unsigned (&v)[16]) {
#pragma unroll
    for (int j = 8; j > 0; j >>= 1)
#pragma unroll
        for (int i = 0; i < 16; ++i) { const int l = i ^ j; if (l > i) cs_desc(v[i], v[l]); }
}
__device__ __forceinline__ void merge_top16(unsigned (&a)[16], const unsigned (&b)[16]) {
#pragma unroll
    for (int i = 0; i < 16; ++i) a[i] = a[i] > b[15 - i] ? a[i] : b[15 - i];
    bmerge16_desc(a);
}
__device__ __forceinline__ void top16_of_64x2(unsigned (&v0)[16], unsigned (&v1)[16], unsigned (&v2)[16], unsigned (&v3)[16]) {
    sort16_desc(v0); sort16_desc(v1); sort16_desc(v2); sort16_desc(v3);
    merge_top16(v0, v1); merge_top16(v2, v3); merge_top16(v0, v2);
    unsigned pb[16];
#pragma unroll
    for (int i = 0; i < 16; ++i) pb[i] = (unsigned)__shfl_xor((int)v0[i], 32);
    merge_top16(v0, pb);
}
}

__device__ __forceinline__ void p7_topk(Frame& F, const Params& p) {
    using namespace tk;
    unsigned char* ws = p.ws;
    const bf16_t* Q2 = (const bf16_t*)(ws + WS_Q2); const unsigned char* KI = (const unsigned char*)(ws + WS_KEYSI);
    int* EX = (int*)(ws + WS_EXP); float* GT = (float*)(ws + WS_GATE); float* SUo = (float*)(ws + WS_SU);
    const float* USC = (const float*)(ws + WS_USC); const float* VSC = (const float*)(ws + WS_VSC);
    const int lane = F.lane, r32 = lane & 31, hi = lane >> 5, wave = F.wave;
    att::lp lds = (att::lp)F.lds;
    LAS int* W = (LAS int*)(F.lds + WLK_OFF + wave * 8192);
    const int ntask = 1024 / F.G;
    const int h = F.bid & 7;
    { const unsigned char* src = KI + (size_t)h * 65536;
      for (int k = 0; k < 8; ++k) { const int pi = wave + 8 * k; att::dma16(src + pi * 1024 + lane * 16, lds + pi * 1024); } }
    asm volatile("s_waitcnt vmcnt(0)" ::: "memory");
    __syncthreads();
    bf16x8 qf[8], qn[8];
    { const int tb32 = ((F.bid >> 3) * ntask) * 8 + wave;
      const bf16_t* qp = Q2 + ((((size_t)tb32 * 8 + h) * 2 + 0) * 8 * 2 + hi) * 256 + r32 * 8;
#pragma unroll
      for (int s = 0; s < 8; ++s) qn[s] = *(const bf16x8*)(qp + s * 512); }
    for (int ti = 0; ti < ntask; ++ti) {
        const int tb = (F.bid >> 3) * ntask + ti;
        const int t = tb * 256 + wave * 32 + r32;
        unsigned A[16], B[16];
#pragma unroll
        for (int pp = 0; pp < 2; ++pp) {
#pragma unroll
            for (int s = 0; s < 8; ++s) qf[s] = qn[s];
            { const int nti = pp == 0 ? ti : ti + 1, npp = pp ^ 1;
              if (nti < ntask) { const int tb32 = ((F.bid >> 3) * ntask + nti) * 8 + wave;
                  const bf16_t* qp = Q2 + ((((size_t)tb32 * 8 + h) * 2 + npp) * 8 * 2 + hi) * 256 + r32 * 8;
#pragma unroll
                  for (int s = 0; s < 8; ++s) qn[s] = *(const bf16x8*)(qp + s * 512); } }
            f32x16 acc[4];
#pragma unroll
            for (int kb = 0; kb < 4; ++kb)
#pragma unroll
                for (int r = 0; r < 16; ++r) acc[kb][r] = 0.f;
            att::lcp ab = (att::lcp)(lds + pp * 32768 + hi * 2048 + r32 * 16);
#pragma unroll
            for (int s = 0; s < 8; ++s)
#pragma unroll
                for (int kb = 0; kb < 4; ++kb) {
                    const bf16x8 a = *(const __attribute__((address_space(3))) bf16x8*)(ab + s * 4096 + kb * 512);
                    acc[kb] = __builtin_amdgcn_mfma_f32_32x32x16_bf16(a, qf[s], acc[kb], 0, 0, 0);
                }
            unsigned v0[16], v1[16], v2[16], v3[16];
#pragma unroll
            for (int r = 0; r < 16; ++r) {
                const int c = 127 - ((r & 3) + 8 * (r >> 2));
                v0[r] = (ord(acc[0][r]) & 0xFFFFFF80u) | (unsigned)(c - 0 - 4 * hi);
                v1[r] = (ord(acc[1][r]) & 0xFFFFFF80u) | (unsigned)(c - 32 - 4 * hi);
                v2[r] = (ord(acc[2][r]) & 0xFFFFFF80u) | (unsigned)(c - 64 - 4 * hi);
                v3[r] = (ord(acc[3][r]) & 0xFFFFFF80u) | (unsigned)(c - 96 - 4 * hi);
            }
            top16_of_64x2(v0, v1, v2, v3);
            if (pp == 0) {
#pragma unroll
                for (int i = 0; i < 16; ++i) A[i] = v0[i];
            } else {
#pragma unroll
                for (int i = 0; i < 16; ++i) B[i] = v0[i];
            }
        }
        float fa[16], fb[16];
#pragma unroll
        for (int i = 0; i < 16; ++i) { fa[i] = unord(A[i] & 0xFFFFFF80u); fb[i] = unord(B[i] & 0xFFFFFF80u);
            W[i * 64 + lane] = 127 - (int)(A[i] & 127u); W[(16 + i) * 64 + lane] = 127 - (int)(B[i] & 127u); }
        unsigned c0[16], c1[16], c2[16], c3[16];
#pragma unroll
        for (int j = 0; j < 16; ++j) c0[j] = (ord(fa[0] + fb[j]) & 0xFFFFFF00u) | (unsigned)(255 - j);
        {
            int n = 0;
#pragma unroll
            for (int i = 1; i < 16; ++i)
#pragma unroll
                for (int j = 0; j < 16; ++j) if ((i + 1) * (j + 1) <= 16) {
                    const unsigned key = (ord(fa[i] + fb[j]) & 0xFFFFFF00u) | (unsigned)(255 - (i * 16 + j));
                    if (n < 16) c1[n] = key; else if (n < 32) c2[n - 16] = key; else c3[n - 32] = key;
                    ++n;
                }
#pragma unroll
            for (int k = 2; k < 16; ++k) c3[k] = 0u;
        }
        sort16_desc(c1); sort16_desc(c2); sort16_desc(c3);
        merge_top16(c0, c1); merge_top16(c2, c3); merge_top16(c0, c2);
        float ev[16]; float l = 0.f; const float mx = unord(c0[0] & 0xFFFFFF00u);
#pragma unroll
        for (int k = 0; k < 16; ++k) { ev[k] = __expf(unord(c0[k] & 0xFFFFFF00u) - mx); l += ev[k]; }
        const float rl = 1.f / l;
        int ex[8]; float gt[8], su[8];
#pragma unroll
        for (int kk = 0; kk < 8; ++kk) {
            const unsigned key = hi ? c0[8 + kk] : c0[kk]; const float e = hi ? ev[8 + kk] : ev[kk];
            const int pos = 255 - (int)(key & 255u);
            ex[kk] = W[(pos >> 4) * 64 + lane] * 128 + W[(16 + (pos & 15)) * 64 + lane];
            gt[kk] = e * rl * VSC[ex[kk]]; su[kk] = USC[ex[kk]];
        }
        int* ep = EX + (size_t)t * 128 + h * 16 + hi * 8; float* gp = GT + (size_t)t * 128 + h * 16 + hi * 8;
        *(u32x4*)ep = (u32x4){(unsigned)ex[0], (unsigned)ex[1], (unsigned)ex[2], (unsigned)ex[3]}; *(u32x4*)(ep + 4) = (u32x4){(unsigned)ex[4], (unsigned)ex[5], (unsigned)ex[6], (unsigned)ex[7]};
        *(f32x4*)gp = (f32x4){gt[0], gt[1], gt[2], gt[3]}; *(f32x4*)(gp + 4) = (f32x4){gt[4], gt[5], gt[6], gt[7]};
        float* sp = SUo + (size_t)t * 128 + h * 16 + hi * 8;
        *(f32x4*)sp = (f32x4){su[0], su[1], su[2], su[3]}; *(f32x4*)(sp + 4) = (f32x4){su[4], su[5], su[6], su[7]};
    }
    __syncthreads();
}

#define P8_SYNC 0
#define P8_PARTITION 0
#define HAVE_P3 1
#define HAVE_P7 1
struct Args { Params p; int ph_lo, ph_hi, li, pad; };
__global__ void __launch_bounds__(NTHR, 2) mk_fwd(Args a) {
    extern __shared__ __attribute__((aligned(16))) unsigned char lds[];
    Frame F;
    F.lds = (LAS unsigned char*)lds;
    F.MISC = (volatile LAS unsigned*)(F.lds + MISC_OFF);
    F.tid = threadIdx.x; F.lane = F.tid & 63; F.wave = __builtin_amdgcn_readfirstlane(F.tid >> 6);
    F.G = gridDim.x; F.bid = blockIdx.x;
    const Params& p = a.p;
    gu32* ctl = (gu32*)(p.ws + WS_CTL);
    for (int u = F.tid; u < 128; u += NTHR) ((LAS unsigned*)(F.lds + MISC_OFF))[u] = 0u;
    __syncthreads();
    XcdBarrier bar = xcd_barrier_post((unsigned*)(ctl + CW_BAR) + a.li * XCD_BAR_WORDS, F.MISC + 8);
    const int lo = a.ph_lo, hi = a.ph_hi;
#ifdef PROBE_TS
    int nts_ = 0;
#define STAMP() do { if (threadIdx.x == 0 && nts_ < 12) { const unsigned long long t_ = __builtin_amdgcn_s_memrealtime(); F.MISC[32 + 2 * nts_] = (unsigned)t_; F.MISC[33 + 2 * nts_] = (unsigned)(t_ >> 32); } ++nts_; } while (0)
    STAMP();
#else
#define STAMP() do {} while (0)
#endif
#define IN(k) (lo <= (k) && (k) < hi)
#define REFRESH() do { F.lane = (int)__builtin_amdgcn_mbcnt_hi(~0u, __builtin_amdgcn_mbcnt_lo(~0u, 0u)); F.tid = F.wave * 64 + F.lane; } while (0)
#define SEAM(k) do { if (IN(k) && IN((k) + 1)) xcd_barrier(bar); STAMP(); } while (0)

#ifndef PROBE_DUP
#define PROBE_DUP -1
#endif
#define REP(k) for (int rep_ = 0; rep_ < (PROBE_DUP == (k) ? 2 : 1); ++rep_)
    if (IN(0)) { REP(0) p0_prologue(F, p); SEAM(0); }
    if (IN(1)) { REP(1) { p1_hrows(F, p); __syncthreads(); } SEAM(1); }
    if (IN(2)) {
        pg8::Gemm g{(const bf16_t*)(p.ws + WS_H), (const bf16_t*)(p.ws + WS_WIN), MALL, NQKV, D}; pg8::StaticOrder S; S.init(MALL, NQKV, F.G, F.bid);
        EpiQKVFast E{p.ws};
        REP(2) pg8::gemm_phase<EpiQKVFast, pg8::StaticOrder, true, true>(F.lds + RING_OFF, g, S, E);
        SEAM(2);
    }
#if HAVE_P3
    if (IN(3)) { REP(31) att::na_units(F, p); att::diff_units_v2<0>(F, p);
#if PROBE_DUP == 321
        att::diff_units_v2<1>(F, p);
#elif PROBE_DUP == 323
        att::diff_units_v2<3>(F, p);
#elif PROBE_DUP == 322
        att::diff_units_v2<2>(F, p);
#elif PROBE_DUP == 32
        att::diff_units_v2<0>(F, p);
#endif
        SEAM(3); }
#endif
    if (IN(4)) {
        pg8::Gemm g{(const bf16_t*)(p.ws + WS_Y), (const bf16_t*)(p.ws + WS_WOUT), MLAT, D, D}; pg8::StaticOrder S; S.init(MLAT, D, F.G, F.bid);
        pg8::EpiBf16<0> E{(bf16_t*)(p.ws + WS_YO), D, nullptr, 0, 0, 1.f};
        REP(4) pg8::gemm_phase<pg8::EpiBf16<0>, pg8::StaticOrder, true, true>(F.lds + RING_OFF, g, S, E);
        SEAM(4);
    }
    if (IN(5)) { REP(5) p5_rows2(F, p); SEAM(5); }
    if (IN(6)) {
        pg8::Gemm g{(const bf16_t*)(p.ws + WS_H2), (const bf16_t*)(p.ws + WS_WPQ), MLAT, 2048, D}; pg8::StaticOrder S; S.init(MLAT, 2048, F.G, F.bid);
        EpiQ2Frag E{(bf16_t*)(p.ws + WS_Q2)};
        REP(6) pg8::gemm_phase<EpiQ2Frag, pg8::StaticOrder, true, true>(F.lds + RING_OFF, g, S, E);
        SEAM(6);
    }
#if HAVE_P7
    if (IN(7)) { REP(7) p7_topk(F, p); SEAM(7); }
#endif
#if P8_PARTITION
    if (IN(8)) {
        p7b_sort(F, p); xcd_barrier(bar);
        for (int ch = 0; ch < 2; ++ch) { p8a_part(F, p, ch); xcd_barrier(bar); p8b_combine(F, p, ch); if (ch == 0) xcd_barrier(bar); }
    }
#else
    if (IN(8)) {
#if PROBE_DUP == 81
        p8_gather<1>(F, p, bar);
#elif PROBE_DUP == 82
        p8_gather<2>(F, p, bar);
#elif PROBE_DUP == 83
        p8_gather<3>(F, p, bar);
#elif PROBE_DUP == 84
        p8_gather<4>(F, p, bar);
#endif
        p8_gather<0>(F, p, bar); }
#endif
#ifdef PROBE_TS
#ifdef PROBE_TS_ENDBAR
    xcd_barrier(bar);
#endif
    STAMP();
    if (blockIdx.x == 0 && threadIdx.x == 0) { const unsigned long long t1_ = ((unsigned long long)F.MISC[33 + 2 * (PROBE_TS + 1)] << 32) | F.MISC[32 + 2 * (PROBE_TS + 1)], t0_ = ((unsigned long long)F.MISC[33 + 2 * PROBE_TS] << 32) | F.MISC[32 + 2 * PROBE_TS];
        const unsigned long long dt = t1_ - t0_; const unsigned long long t_end = __builtin_amdgcn_s_memrealtime();
        while (__builtin_amdgcn_s_memrealtime() - t_end < 8ull * dt) __builtin_amdgcn_s_sleep(8); }
#endif
#undef IN
#undef SEAM
}

static void launch_mk(const Params& p, int lo, int hi, int li, hipStream_t stream) {
    Args a{}; a.p = p; a.ph_lo = lo; a.ph_hi = hi; a.li = li; a.pad = 0;
    hipLaunchKernelGGL(mk_fwd, dim3(256), dim3(NTHR), LDS_BYTES, stream, a);
}
extern "C" void kernel_launch(void* const* d_in, const int* in_sizes, int n_in, void* d_out, int out_size, void* d_ws, size_t ws_size, hipStream_t stream) {
    if (n_in != 16 || ws_size < WS_END) return;
    static bool attr_done = false;
    if (!attr_done) {
        (void)hipFuncSetAttribute((const void*)mk_fwd, hipFuncAttributeMaxDynamicSharedMemorySize, LDS_BYTES);
        attr_done = true;
    }
    Params p{};
    p.x = (const float*)d_in[0]; p.c = (const float*)d_in[1]; p.ctx = (const float*)d_in[2]; p.c_ctx = (const float*)d_in[3];
    p.w_ada = (const float*)d_in[4]; p.b_ada = (const float*)d_in[5]; p.g_norm = (const float*)d_in[6]; p.w_in = (const float*)d_in[7];
    p.rel_bias = (const float*)d_in[8]; p.diff_lambda = (const float*)d_in[9]; p.diff_subln = (const float*)d_in[10]; p.w_out = (const float*)d_in[11];
    p.peer_wq = (const float*)d_in[12]; p.peer_keys = (const float*)d_in[13]; p.peer_u = (const float*)d_in[14]; p.peer_v = (const float*)d_in[15];
    p.out = (float*)d_out; p.ws = (unsigned char*)d_ws;
    (void)hipMemsetAsync((char*)d_ws + WS_CTL, 0, CTL_ZERO_BYTES, stream);

    launch_mk(p, 0, 9, 0, stream);

}
```

```cpp
#include <hip/hip_runtime.h>
#include <stdint.h>
#include <math.h>

typedef unsigned short bf16_t;
typedef float f32x4 __attribute__((ext_vector_type(4)));
typedef unsigned u32x4 __attribute__((ext_vector_type(4)));
typedef unsigned u32x2 __attribute__((ext_vector_type(2)));
typedef float f32x2 __attribute__((ext_vector_type(2)));

constexpr int D = 1024, BATCH = 8, SEQ = 4096, CTX = 256, GW = 64;
constexpr int MLAT = BATCH * SEQ;
constexpr int MCTX = BATCH * CTX;
constexpr int MALL = MLAT + MCTX;
constexpr int NQKV = 3072;
constexpr int NKT = 68;
constexpr int NMOD = 6 * D;
constexpr int PE_H = 8, PE_NK = 128, PE_QD = 256, PE_TOPK = 16, PE_NEXP = 16384;
constexpr float EPS = 1e-6f;
constexpr float LOG2E = 1.4426950408889634f;
constexpr float C2 = 0.125f * LOG2E;
constexpr float LAMBDA_INIT = 0.2f;
constexpr float NEG_BIG = -30000.0f;

constexpr size_t MiB = 1u << 20;
constexpr size_t WS_CTL = 0;
constexpr size_t WS_MOD = 1 * MiB;
constexpr size_t WS_LAM = 1 * MiB + 256 * 1024;
constexpr size_t WS_ROPE = 1 * MiB + 512 * 1024;
constexpr size_t WS_USC = 1 * MiB + 640 * 1024;
constexpr size_t WS_VSC = 1 * MiB + 704 * 1024;
constexpr size_t WS_MODP = 2 * MiB;
constexpr size_t WS_BIAST = 4 * MiB;
constexpr size_t WS_KEYS = 5 * MiB;
constexpr size_t WS_KEYSI = 5 * MiB + 512 * 1024;
constexpr size_t WS_WIN = 6 * MiB;
constexpr size_t WS_WOUT = 12 * MiB;
constexpr size_t WS_WPQ = 14 * MiB;
constexpr size_t WS_UB = 18 * MiB;
constexpr size_t WS_VB = 50 * MiB;
constexpr size_t WS_EXP = 82 * MiB;
constexpr size_t WS_GATE = 98 * MiB;
constexpr size_t WS_H2 = 114 * MiB;
constexpr size_t WS_H = 178 * MiB;
constexpr size_t WS_Y = 178 * MiB;
constexpr size_t WS_QA = 246 * MiB;
constexpr size_t WS_KA = 278 * MiB;
constexpr size_t WS_VA = 312 * MiB;
constexpr size_t WS_QD = 346 * MiB;
constexpr size_t WS_KD = 378 * MiB;
constexpr size_t WS_VD = 412 * MiB;
constexpr size_t WS_XN = 178 * MiB;
constexpr size_t WS_YO = 246 * MiB;
constexpr size_t WS_Q2 = 246 * MiB;
constexpr size_t WS_PART = 178 * MiB;
constexpr size_t WS_DSCR = 464 * MiB;
constexpr size_t WS_SU = 446 * MiB;
constexpr size_t WS_END = 496 * MiB;

struct Params {
    const float *x, *c, *ctx, *c_ctx, *w_ada, *b_ada, *g_norm, *w_in, *rel_bias, *diff_lambda, *diff_subln, *w_out, *peer_wq, *peer_keys, *peer_u, *peer_v;
    float* out;
    unsigned char* ws;
};

__device__ __forceinline__ unsigned f2bf(float f) { unsigned u = __builtin_bit_cast(unsigned, f); return (u + 0x7fffu + ((u >> 16) & 1u)) >> 16; }
__device__ __forceinline__ unsigned pk2(float lo, float hi) { return f2bf(lo) | (f2bf(hi) << 16); }
__device__ __forceinline__ float bf2f(bf16_t h) { return __builtin_bit_cast(float, (unsigned)h << 16); }
__device__ __forceinline__ float bflo(unsigned w) { return __builtin_bit_cast(float, w << 16); }
__device__ __forceinline__ float bfhi(unsigned w) { return __builtin_bit_cast(float, w & 0xffff0000u); }
__device__ __forceinline__ float wave_sum(float v) {
    v += __uint_as_float((unsigned)__builtin_amdgcn_update_dpp(0, (int)__float_as_uint(v), 0xB1, 0xf, 0xf, false));
    v += __uint_as_float((unsigned)__builtin_amdgcn_update_dpp(0, (int)__float_as_uint(v), 0x4E, 0xf, 0xf, false));
    v += __uint_as_float((unsigned)__builtin_amdgcn_update_dpp(0, (int)__float_as_uint(v), 0x141, 0xf, 0xf, false));
    v += __uint_as_float((unsigned)__builtin_amdgcn_update_dpp(0, (int)__float_as_uint(v), 0x128, 0xf, 0xf, false));
    { auto r = __builtin_amdgcn_permlane16_swap(__float_as_uint(v), __float_as_uint(v), false, false); v = __uint_as_float(r[0]) + __uint_as_float(r[1]); }
    { auto r = __builtin_amdgcn_permlane32_swap(__float_as_uint(v), __float_as_uint(v), false, false); v = __uint_as_float(r[0]) + __uint_as_float(r[1]); }
    return v;
}
__device__ __forceinline__ float wave_max(float v) {
    v = fmaxf(v, __uint_as_float((unsigned)__builtin_amdgcn_update_dpp(0, (int)__float_as_uint(v), 0xB1, 0xf, 0xf, false)));
    v = fmaxf(v, __uint_as_float((unsigned)__builtin_amdgcn_update_dpp(0, (int)__float_as_uint(v), 0x4E, 0xf, 0xf, false)));
    v = fmaxf(v, __uint_as_float((unsigned)__builtin_amdgcn_update_dpp(0, (int)__float_as_uint(v), 0x141, 0xf, 0xf, false)));
    v = fmaxf(v, __uint_as_float((unsigned)__builtin_amdgcn_update_dpp(0, (int)__float_as_uint(v), 0x128, 0xf, 0xf, false)));
    { auto r = __builtin_amdgcn_permlane16_swap(__float_as_uint(v), __float_as_uint(v), false, false); v = fmaxf(__uint_as_float(r[0]), __uint_as_float(r[1])); }
    { auto r = __builtin_amdgcn_permlane32_swap(__float_as_uint(v), __float_as_uint(v), false, false); v = fmaxf(__uint_as_float(r[0]), __uint_as_float(r[1])); }
    return v;
}

__device__ __forceinline__ float half_max(float v) {
    v = fmaxf(v, __uint_as_float((unsigned)__builtin_amdgcn_update_dpp(0, (int)__float_as_uint(v), 0xB1, 0xf, 0xf, false)));
    v = fmaxf(v, __uint_as_float((unsigned)__builtin_amdgcn_update_dpp(0, (int)__float_as_uint(v), 0x4E, 0xf, 0xf, false)));
    v = fmaxf(v, __uint_as_float((unsigned)__builtin_amdgcn_update_dpp(0, (int)__float_as_uint(v), 0x141, 0xf, 0xf, false)));
    v = fmaxf(v, __uint_as_float((unsigned)__builtin_amdgcn_update_dpp(0, (int)__float_as_uint(v), 0x128, 0xf, 0xf, false)));
    { auto r = __builtin_amdgcn_permlane16_swap(__float_as_uint(v), __float_as_uint(v), false, false); v = fmaxf(__uint_as_float(r[0]), __uint_as_float(r[1])); }
    return v;
}
typedef float f32x16 __attribute__((ext_vector_type(16)));
typedef float f32x32 __attribute__((ext_vector_type(32)));
typedef unsigned u32x6 __attribute__((ext_vector_type(6)));

__device__ __forceinline__ u32x6 enc_fp6(f32x16 a, f32x16 b) { u32x6 w; asm volatile("v_cvt_scalef32_2xpk16_fp6_f32 %0, %1, %2, 1.0" : "=&v"(w) : "v"(a), "v"(b)); return w; }
__device__ __forceinline__ f32x32 dec_fp6(u32x6 w) { f32x32 r; asm volatile("v_cvt_scalef32_pk32_f32_fp6 %0, %1, 1.0" : "=&v"(r) : "v"(w)); return r; }

typedef short hs16x4 __attribute__((ext_vector_type(4)));
typedef __bf16 hbf16x2 __attribute__((ext_vector_type(2)));

typedef unsigned u32x16 __attribute__((ext_vector_type(16)));

#ifndef PROBE_DUP
#define PROBE_DUP -1
#endif

__device__ __forceinline__ int ktile_off(int k, int d) { return (d >> 3) * 512 + k * 8 + (d & 7); }
__device__ __forceinline__ int vtile_off(int k, int d) { return (d >> 5) * 2048 + (k >> 4) * 512 + (k & 15) * 32 + (d & 31); }
__device__ __forceinline__ size_t qa_idx(int b, int h, int t, int d) { return ((size_t)(b * 8 + h) * SEQ + t) * 64 + d; }
__device__ __forceinline__ size_t ka_idx(int b, int h, int j, int d) { return ((size_t)(b * 8 + h) * NKT + (j >> 6)) * 4096 + ktile_off(j & 63, d); }
__device__ __forceinline__ size_t va_idx(int b, int h, int j, int d) { return ((size_t)(b * 8 + h) * NKT + (j >> 6)) * 4096 + vtile_off(j & 63, d); }
__device__ __forceinline__ size_t qd_idx(int b, int m, int h, int t, int d) { return ((size_t)((b * 2 + m) * 4 + h) * SEQ + t) * 64 + d; }
__device__ __forceinline__ size_t kd_idx(int b, int m, int h, int j, int d) { return ((size_t)((b * 2 + m) * 4 + h) * NKT + (j >> 6)) * 4096 + ktile_off(j & 63, d); }
__device__ __forceinline__ size_t vd_idx(int b, int h, int j, int d) { return ((size_t)(b * 4 + h) * NKT + (j >> 6)) * 8192 + vtile_off(j & 63, d); }


namespace pg8 {
#define PG8_LAS __attribute__((address_space(3)))
typedef unsigned short bf16_t;
typedef short bf16x8 __attribute__((ext_vector_type(8)));
typedef float f32x4 __attribute__((ext_vector_type(4)));
typedef unsigned u32x4 __attribute__((ext_vector_type(4)));
constexpr int BM = 256, BK = 64, HALF = 128, HTB = HALF * BK * 2  , STAGE_BYTES = 8 * HTB, NXCD = 8, WGM = 8;

__host__ __device__ __forceinline__ int lds_byte(int r, int c) { const int st = (r >> 4) * 2 + (c >> 5), rr = r & 15, cc = c & 31, ob = rr * 64 + cc * 2; return st * 1024 + (ob ^ (((ob >> 9) & 1) << 5)); }
__host__ __device__ __forceinline__ void stage_rc(int b, int& R, int& C) { const int st = b / 1024, sb = b % 1024, swz = sb ^ (((sb >> 9) & 1) << 5); R = (st >> 1) * 16 + swz / 64; C = (st & 1) * 32 + (swz % 64) / 2; }
__host__ __device__ __forceinline__ int perm32(int rho) { const int n = rho >> 4, i = rho & 15; return 8 * (i >> 2) + 4 * n + (i & 3); }

struct Unit { int pm, pn; };
struct Gemm { const bf16_t* A; const bf16_t* Bt; int M, N, K; };

struct StaticOrder {
    int nM, nN, nwg, G, c;
    __host__ __device__ void init(int M, int N, int G_, int c_) { nM = M / BM; nN = N / BM; nwg = nM * nN; G = G_; c = c_; }
    __host__ __device__ bool next(int i, Unit& u) const {
        const long L = (long)i * G + c; if (L >= nwg) return false;
        int wgid = (int)L; { const int q = nwg / NXCD, r = nwg % NXCD, xcd = wgid % NXCD, off = wgid / NXCD; wgid = (xcd < r ? xcd * (q + 1) : r * (q + 1) + (xcd - r) * q) + off; }
        const int nig = WGM * nN, gid = wgid / nig, fm = gid * WGM, gsz = (nM - fm) < WGM ? (nM - fm) : WGM;
        u.pm = fm + ((wgid % nig) % gsz); u.pn = (wgid % nig) / gsz; return true;
    }
    __device__ __forceinline__ void a_ready(const Unit&) const {}
    __device__ __forceinline__ void done(const Unit&) const {}
};

__device__ __forceinline__ unsigned cvt_pk_bf16(float lo, float hi) { unsigned r; asm volatile("v_cvt_pk_bf16_f32 %0, %1, %2" : "=v"(r) : "v"(lo), "v"(hi)); return r; }
typedef float f32x2 __attribute__((ext_vector_type(2)));
__device__ __forceinline__ f32x2 gelu_pk(f32x2 v) {
    const f32x2 av = __builtin_elementwise_abs(v), d = av * 0.2316418882f + 1.0f;
    f32x2 t; t.x = __builtin_amdgcn_rcpf(d.x); t.y = __builtin_amdgcn_rcpf(d.y);
    f32x2 q = t * 0.5307027145f + (-0.7265760135f); q = q * t + 0.7107068705f; q = q * t + (-0.142248368f); q = q * t + 0.127414796f; q = q * t;
    const f32x2 s = (v * v) * (-0.72134752044f);
    f32x2 e; e.x = __builtin_amdgcn_exp2f(s.x); e.y = __builtin_amdgcn_exp2f(s.y);
    const f32x2 m = v * (q * e), r = v - m;
    f32x2 o; o.x = v.x < 0.f ? m.x : r.x; o.y = v.y < 0.f ? m.y : r.y; return o;
}

template <int ACT  > struct EpiBf16 {
    static constexpr bool PERM = true, AFTER_DRAIN = false; static_assert(ACT == 0 || ACT == 1, "EpiBf16: ACT is 0 (none) or 1 (gelu_pk)");
    bf16_t* O; int ldc; const float* bias; int split_cols; size_t split_stride; float scale0;
    __device__ __forceinline__ void operator()(const f32x4 (&acc)[2][2][4][2], const Unit& u, int wr, int wc, int fr, int fq) const {
        const int row0 = u.pm * BM + wr * 64 + fr; int colt = u.pn * BM; bf16_t* base = O;
        float sc = 1.f; if (split_cols) { const int t = colt / split_cols; base += (size_t)t * split_stride; colt -= t * split_cols; if (t == 0) sc = scale0; }
        const int col0 = colt + wc * 32 + 8 * fq, bcol0 = u.pn * BM + wc * 32 + 8 * fq;
        f32x4 bv[2][2];
#pragma unroll
        for (int bj = 0; bj < 2; ++bj)
#pragma unroll
            for (int n = 0; n < 2; ++n) bv[bj][n] = bias ? *(const f32x4*)(bias + bcol0 + bj * HALF + 4 * n) : (f32x4){0.f, 0.f, 0.f, 0.f};
#pragma unroll
        for (int ai = 0; ai < 2; ++ai)
#pragma unroll
            for (int m = 0; m < 4; ++m) { bf16_t* rowp = base + (size_t)(row0 + ai * HALF + m * 16) * ldc + col0;
#pragma unroll
                for (int bj = 0; bj < 2; ++bj) { f32x4 v0 = acc[ai][bj][m][0] + bv[bj][0], v1 = acc[ai][bj][m][1] + bv[bj][1];
                    if (ACT == 1) { f32x2 a = gelu_pk((f32x2){v0[0], v0[1]}), b = gelu_pk((f32x2){v0[2], v0[3]}), c = gelu_pk((f32x2){v1[0], v1[1]}), d = gelu_pk((f32x2){v1[2], v1[3]});
                        v0 = (f32x4){a.x, a.y, b.x, b.y}; v1 = (f32x4){c.x, c.y, d.x, d.y}; }
                    v0 = v0 * sc; v1 = v1 * sc; u32x4 w; w.x = cvt_pk_bf16(v0[0], v0[1]); w.y = cvt_pk_bf16(v0[2], v0[3]); w.z = cvt_pk_bf16(v1[0], v1[1]); w.w = cvt_pk_bf16(v1[2], v1[3]);
                    *(u32x4*)(rowp + bj * HALF) = w; } }
    }
};

template <class Epi, class Sched, bool ALIGN_EPI = false, bool SP2 = false>
__device__ __forceinline__ void gemm_phase(PG8_LAS unsigned char* lds, const Gemm g, const Sched& S, const Epi& E) {
    const int tid = threadIdx.x, wid = __builtin_amdgcn_readfirstlane(tid >> 6), lane = tid & 63, wr = wid >> 2, wc = wid & 3, fr = lane & 15, fq = lane >> 4;
    const int K = g.K, nt = K / BK;
    unsigned voffA[2], voffB[2];
#pragma unroll
    for (int i = 0; i < 2; ++i) { int R, C; stage_rc(tid * 16 + i * 8192, R, C); const int Rb = Epi::PERM ? ((R & ~31) + perm32(R & 31)) : R;
        voffA[i] = (unsigned)(R * K + C) * 2u; voffB[i] = (unsigned)(Rb * K + C) * 2u; }
    const size_t kstep = (size_t)(BK * 2);
    const size_t hstep = (size_t)HALF * K * 2;
    const size_t tstep = 2 * hstep;
    const unsigned ldsw = (unsigned)wid * 1024u;
    const int aoff = lds_byte(wr * 64 + fr, fq * 8), boff = lds_byte(wc * 32 + fr, fq * 8);
#define PG8_SA(b, h) (((b) * 2 + (h)) * HTB)
#define PG8_SB(b, h) ((4 + (b) * 2 + (h)) * HTB)
#define PG8_STAGE(bufoff, gbase, voff) do { _Pragma("unroll") for (int _i = 0; _i < 2; ++_i) \
        __builtin_amdgcn_global_load_lds((const unsigned*)((const char*)(gbase) + (voff)[_i]), (PG8_LAS unsigned*)(lds + (bufoff) + ldsw + _i * 8192), 16, 0, 0); } while (0)
#define PG8_LDA(dst, b, h) do { _Pragma("unroll") for (int m = 0; m < 4; ++m) _Pragma("unroll") for (int k = 0; k < 2; ++k) dst[m][k] = *(const PG8_LAS bf16x8*)(lds + PG8_SA(b, h) + aoff + m * 2048 + k * 1024); } while (0)
#define PG8_LDB(dst, b, h) do { _Pragma("unroll") for (int n = 0; n < 2; ++n) _Pragma("unroll") for (int k = 0; k < 2; ++k) dst[n][k] = *(const PG8_LAS bf16x8*)(lds + PG8_SB(b, h) + boff + n * 2048 + k * 1024); } while (0)
#define PG8_MMA(ai, bj, At, Bt) do { __builtin_amdgcn_s_setprio(1); _Pragma("unroll") for (int m = 0; m < 4; ++m) _Pragma("unroll") for (int n = 0; n < 2; ++n) _Pragma("unroll") for (int k = 0; k < 2; ++k) \
        acc[ai][bj][m][n] = __builtin_amdgcn_mfma_f32_16x16x32_bf16(Bt[n][k], At[m][k], acc[ai][bj][m][n], 0, 0, 0); __builtin_amdgcn_s_setprio(0); } while (0)
#define PG8_WAIT_V(n) asm volatile("s_waitcnt vmcnt(" #n ")" ::: "memory")
#define PG8_WAIT_L(n) asm volatile("s_waitcnt lgkmcnt(" #n ")" ::: "memory")
#define PG8_BAR __builtin_amdgcn_s_barrier()
#define PG8_SCHED __builtin_amdgcn_sched_barrier(0)
    Unit cur, nxt; int ui = 0;
    if (!S.next(0, cur)) return;
    f32x4 acc[2][2][4][2];
#pragma unroll
    for (int a = 0; a < 2; ++a)
#pragma unroll
        for (int b = 0; b < 2; ++b)
#pragma unroll
            for (int m = 0; m < 4; ++m)
#pragma unroll
                for (int n = 0; n < 2; ++n) acc[a][b][m][n] = (f32x4){0.f, 0.f, 0.f, 0.f};
    bf16x8 At[4][2], B0[2][2], B1[2][2];
    const char* cA = (const char*)g.A + (size_t)cur.pm * tstep; const char* cB = (const char*)g.Bt + (size_t)cur.pn * tstep;
    S.a_ready(cur);
    if constexpr (SP2) {
        PG8_STAGE(PG8_SB(0, 0), cB, voffB); PG8_STAGE(PG8_SB(0, 1), cB + hstep, voffB); PG8_STAGE(PG8_SA(0, 0), cA, voffA); PG8_STAGE(PG8_SA(0, 1), cA + hstep, voffA);
        if (wr == 1) PG8_BAR;
        PG8_WAIT_V(2); PG8_BAR;
        PG8_STAGE(PG8_SB(1, 0), cB + kstep, voffB); PG8_STAGE(PG8_SA(1, 0), cA + kstep, voffA); PG8_STAGE(PG8_SB(1, 1), cB + hstep + kstep, voffB);
        PG8_WAIT_V(6); PG8_BAR;
    } else {
        PG8_STAGE(PG8_SB(0, 0), cB, voffB); PG8_STAGE(PG8_SA(0, 0), cA, voffA); PG8_STAGE(PG8_SB(0, 1), cB + hstep, voffB); PG8_STAGE(PG8_SA(0, 1), cA + hstep, voffA);
        if (wr == 1) PG8_BAR;
        PG8_WAIT_V(4); PG8_BAR;
        PG8_STAGE(PG8_SB(1, 0), cB + kstep, voffB); PG8_STAGE(PG8_SA(1, 0), cA + kstep, voffA); PG8_STAGE(PG8_SB(1, 1), cB + hstep + kstep, voffB);
        PG8_WAIT_V(6); PG8_BAR;
    }
    for (;;) {
        const bool has_next = S.next(ui + 1, nxt);
        const char* nA = has_next ? (const char*)g.A + (size_t)nxt.pm * tstep : cA; const char* nB = has_next ? (const char*)g.Bt + (size_t)nxt.pn * tstep : cB;
        for (int t = 0; t < nt; t += 2) {
            const bool last = (t == nt - 2);
            const char* a1 = cA + (size_t)(t + 1) * kstep;
            const char* a2 = last ? nA : cA + (size_t)(t + 2) * kstep; const char* b2 = last ? nB : cB + (size_t)(t + 2) * kstep;
            const char* a3 = a2 + kstep; const char* b3 = b2 + kstep;
            if (last && has_next) S.a_ready(nxt);
            if constexpr (SP2) {
            PG8_LDB(B0, 0, 0); PG8_LDB(B1, 0, 1); PG8_SCHED; PG8_LDA(At, 0, 0); PG8_STAGE(PG8_SA(1, 1), a1 + hstep, voffA);
            PG8_WAIT_V(8); PG8_WAIT_L(0); PG8_BAR; PG8_MMA(0, 0, At, B0); PG8_MMA(0, 1, At, B1); PG8_BAR; PG8_SCHED;
            PG8_LDA(At, 0, 1); PG8_STAGE(PG8_SB(0, 0), b2, voffB); PG8_STAGE(PG8_SB(0, 1), b2 + hstep, voffB); PG8_STAGE(PG8_SA(0, 0), a2, voffA);
            PG8_WAIT_V(8); PG8_WAIT_L(0); PG8_BAR; PG8_MMA(1, 0, At, B0); PG8_MMA(1, 1, At, B1); PG8_BAR; PG8_SCHED;
            PG8_LDB(B0, 1, 0); PG8_LDB(B1, 1, 1); PG8_SCHED; PG8_LDA(At, 1, 0); PG8_STAGE(PG8_SA(0, 1), a2 + hstep, voffA);
            PG8_WAIT_V(8); PG8_WAIT_L(0); PG8_BAR; PG8_MMA(0, 0, At, B0); PG8_MMA(0, 1, At, B1); PG8_BAR; PG8_SCHED;
            PG8_LDA(At, 1, 1); PG8_STAGE(PG8_SB(1, 0), b3, voffB); PG8_STAGE(PG8_SB(1, 1), b3 + hstep, voffB); PG8_STAGE(PG8_SA(1, 0), a3, voffA);
            PG8_WAIT_V(8); PG8_WAIT_L(0); PG8_BAR; PG8_MMA(1, 0, At, B0); PG8_MMA(1, 1, At, B1); PG8_BAR; PG8_SCHED;
            } else {
            PG8_LDB(B0, 0, 0); PG8_SCHED; PG8_LDA(At, 0, 0); PG8_STAGE(PG8_SA(1, 1), a1 + hstep, voffA);
            PG8_WAIT_L(8); PG8_BAR; PG8_WAIT_L(0); PG8_MMA(0, 0, At, B0); PG8_BAR; PG8_SCHED;
            PG8_LDB(B1, 0, 1); PG8_STAGE(PG8_SB(0, 0), b2, voffB);
            PG8_BAR; PG8_WAIT_L(0); PG8_MMA(0, 1, At, B1); PG8_BAR;
            PG8_LDA(At, 0, 1); PG8_STAGE(PG8_SA(0, 0), a2, voffA);
            PG8_BAR; PG8_WAIT_L(0); PG8_MMA(1, 0, At, B0); PG8_BAR; PG8_SCHED;
            PG8_STAGE(PG8_SB(0, 1), b2 + hstep, voffB);
            PG8_WAIT_V(6); PG8_BAR; PG8_MMA(1, 1, At, B1); PG8_BAR;
            PG8_LDB(B0, 1, 0); PG8_SCHED; PG8_LDA(At, 1, 0); PG8_STAGE(PG8_SA(0, 1), a2 + hstep, voffA);
            PG8_WAIT_L(8); PG8_BAR; PG8_WAIT_L(0); PG8_MMA(0, 0, At, B0); PG8_BAR; PG8_SCHED;
            PG8_LDB(B1, 1, 1); PG8_STAGE(PG8_SB(1, 0), b3, voffB);
            PG8_BAR; PG8_WAIT_L(0); PG8_MMA(0, 1, At, B1); PG8_BAR;
            PG8_LDA(At, 1, 1); PG8_STAGE(PG8_SA(1, 0), a3, voffA);
            PG8_BAR; PG8_WAIT_L(0); PG8_MMA(1, 0, At, B0); PG8_BAR; PG8_SCHED;
            PG8_STAGE(PG8_SB(1, 1), b3 + hstep, voffB);
            PG8_WAIT_V(6); PG8_BAR; PG8_MMA(1, 1, At, B1); PG8_BAR;
            }
        }
        if constexpr (ALIGN_EPI) { if (wr == 0) PG8_BAR; }
        if constexpr (!Epi::AFTER_DRAIN) { E(acc, cur, wr, wc, fr, fq); S.done(cur); }
        if (!has_next) break;
#pragma unroll
        for (int a = 0; a < 2; ++a)
#pragma unroll
            for (int b = 0; b < 2; ++b)
#pragma unroll
                for (int m = 0; m < 4; ++m)
#pragma unroll
                    for (int n = 0; n < 2; ++n) acc[a][b][m][n] = (f32x4){0.f, 0.f, 0.f, 0.f};
        cur = nxt; cA = nA; cB = nB; ++ui;
        if constexpr (ALIGN_EPI) { if (wr == 1) PG8_BAR; }
    }
    PG8_WAIT_V(0);
    if constexpr (!ALIGN_EPI) { if (wr == 0) PG8_BAR; }
    PG8_BAR;
    if constexpr (Epi::AFTER_DRAIN) { E.fused(acc, cur, wr, wc, fr, fq, lds, wid, lane); S.done(cur); }
#undef PG8_SA
#undef PG8_SB
#undef PG8_STAGE
#undef PG8_LDA
#undef PG8_LDB
#undef PG8_MMA
#undef PG8_WAIT_V
#undef PG8_WAIT_L
#undef PG8_BAR
#undef PG8_SCHED
}
}

#define GAS __attribute__((address_space(1)))
#define LAS __attribute__((address_space(3)))
typedef unsigned v4u __attribute__((ext_vector_type(4)));
typedef float f32x4 __attribute__((ext_vector_type(4)));
typedef short bf16x8 __attribute__((ext_vector_type(8)));
typedef GAS unsigned gu32;
typedef GAS unsigned long long gu64;
#define RLX_AGENT __ATOMIC_RELAXED, __HIP_MEMORY_SCOPE_AGENT
#define LDS_WAIT() asm volatile("s_waitcnt lgkmcnt(0)" ::: "memory")
#define VM_WAIT() asm volatile("s_waitcnt vmcnt(0)" ::: "memory")
__device__ __forceinline__ unsigned long long rt() { return __builtin_amdgcn_s_memrealtime(); }

#define XB_TMO      128
#define XB_XCNT(j)  (256  + 64 * (j))
#define XB_XSUB(j)  (1280 + 64 * (j))
#define XB_XGEN(j)  (2304 + 64 * (j))
#define XB_TOP      3328
#define XB_TOPGEN   3392
#define XCD_BAR_WORDS 3456
#define XB_SPIN_CAP (1u << 18)

__device__ __forceinline__ unsigned xb_ld(unsigned* p)              { return __hip_atomic_load(p, __ATOMIC_RELAXED, __HIP_MEMORY_SCOPE_AGENT); }
__device__ __forceinline__ unsigned xb_add(unsigned* p, unsigned v) { return __hip_atomic_fetch_add(p, v, __ATOMIC_RELAXED, __HIP_MEMORY_SCOPE_AGENT); }
__device__ __forceinline__ unsigned xb_xcc_id() { return (unsigned)__builtin_amdgcn_s_getreg((3 << 11) | 20) & 0xFu; }
#define XB_SPIN(cond, bar) do { unsigned _sp = 0; while (cond) { __builtin_amdgcn_s_sleep(1); \
    if ((++_sp & 255u) == 0u) { if (xb_ld(&(bar)[XB_TMO])) break; if (_sp > XB_SPIN_CAP) { atomicAdd(&(bar)[XB_TMO], 1u); break; } } } } while (0)

struct XcdBarrier {
    unsigned* bar; unsigned x;
    volatile LAS unsigned* st;
};

__device__ __forceinline__ XcdBarrier xcd_barrier_post(unsigned* bar, volatile LAS unsigned* st) {
    XcdBarrier b; b.bar = bar; b.x = xb_xcc_id(); b.st = st;
    if (threadIdx.x == 0) (void)xb_add(&bar[XB_XCNT(b.x)], 1u);
    return b;
}
__device__ __forceinline__ void xcd_barrier_complete(unsigned* bar, unsigned x, unsigned& nloc, unsigned& nx) {
    const unsigned G = gridDim.x * gridDim.y * gridDim.z;
    unsigned sum, cnt, mine, sp = 0u;
    for (;;) {
        sum = 0u; cnt = 0u; mine = 0u;
#pragma unroll
        for (unsigned j = 0; j < 16; ++j) { const unsigned c = xb_ld(&bar[XB_XCNT(j)]); sum += c; cnt += (c > 0u) ? 1u : 0u; mine = (j == x) ? c : mine; }
        if (sum == G) break;
        __builtin_amdgcn_s_sleep(1);
        if ((++sp & 255u) == 0u) { if (xb_ld(&bar[XB_TMO])) break; if (sp > XB_SPIN_CAP) { atomicAdd(&bar[XB_TMO], 1u); break; } }
    }
    nloc = mine > 0u ? mine : 1u; nx = cnt > 0u ? cnt : 1u;
}

__device__ __forceinline__ void xcd_barrier(const XcdBarrier& b) {
    asm volatile("s_waitcnt vmcnt(0)" ::: "memory");
    __syncthreads();
    if (threadIdx.x == 0) {
        unsigned* bar = b.bar;
        __builtin_amdgcn_s_waitcnt(0);
        unsigned nloc = b.st[0], nx = b.st[1];
        if (nloc == 0u) { xcd_barrier_complete(bar, b.x, nloc, nx); b.st[0] = nloc; b.st[1] = nx; }
        const unsigned old = xb_add(&bar[XB_XSUB(b.x)], 1u);
        const unsigned gen = old / nloc;
        if (old + 1u == (gen + 1u) * nloc) {
            __builtin_amdgcn_fence(__ATOMIC_RELEASE, "agent");
            asm volatile("s_waitcnt vmcnt(0)" ::: "memory");
            const unsigned og = xb_add(&bar[XB_TOP], 1u);
            const unsigned tg = og / nx;
            if (og + 1u == (tg + 1u) * nx) xb_add(&bar[XB_TOPGEN], 1u);
            else XB_SPIN(xb_ld(&bar[XB_TOPGEN]) == tg, bar);
            __builtin_amdgcn_fence(__ATOMIC_ACQUIRE, "agent");
            xb_add(&bar[XB_XGEN(b.x)], 1u);
            asm volatile("s_waitcnt vmcnt(0)" ::: "memory");
        } else {
            XB_SPIN(xb_ld(&bar[XB_XGEN(b.x)]) == gen, bar);
            __builtin_amdgcn_fence(__ATOMIC_ACQUIRE, "agent");
            asm volatile("s_waitcnt vmcnt(0)" ::: "memory");
        }
    }
    __syncthreads();
}

constexpr int NWAVES = 8, NTHR = 512;
constexpr int RING_OFF = 0, RING_BYTES = 131072;
constexpr int LDS_BYTES = 159744;
constexpr int MISC_OFF = LDS_BYTES - 512;
constexpr size_t CTL_ZERO_BYTES = 65536;
constexpr int CW_P8CTR = 2048;
constexpr int CW_BAR = 4096;

struct Frame {
    LAS unsigned char* lds;
    volatile LAS unsigned* MISC;
    int tid, lane, wave, G, bid;
};

__device__ __forceinline__ void p0_transpose_item(const float* W, int K, int N, bf16_t* WT, LAS float* scr, int item, int lane) {
    const int nblk = N / 32, kb = item / nblk, nb = item % nblk, k0 = 64 * kb, n0 = 32 * nb;
    float tv[32];
#pragma unroll
    for (int i = 0; i < 32; ++i) tv[i] = W[(size_t)(k0 + 2 * i + (lane >> 5)) * N + n0 + (lane & 31)];
#pragma unroll
    for (int i = 0; i < 32; ++i) scr[(2 * i + (lane >> 5)) * 33 + (lane & 31)] = tv[i];
    LDS_WAIT(); asm volatile("" ::: "memory");
    const int c = lane & 7;
#pragma unroll
    for (int j = 0; j < 4; ++j) { const int n = (lane >> 3) + 8 * j; const LAS float* s = scr + (8 * c) * 33 + n;
        v4u o; o.x = pk2(s[0 * 33], s[1 * 33]); o.y = pk2(s[2 * 33], s[3 * 33]); o.z = pk2(s[4 * 33], s[5 * 33]); o.w = pk2(s[6 * 33], s[7 * 33]);
        *(GAS v4u*)(WT + (size_t)(n0 + n) * K + k0 + 8 * c) = o; }
    LDS_WAIT(); asm volatile("" ::: "memory");
}
__device__ __forceinline__ void cvt_stream(const float* src, bf16_t* dst, size_t n4, size_t gtid, size_t gsz) {
    for (size_t i = gtid; i < n4; i += gsz) { const f32x4 v = ((const f32x4*)src)[i]; u32x2 o; o.x = pk2(v.x, v.y); o.y = pk2(v.z, v.w); ((u32x2*)dst)[i] = o; }
}
__device__ __forceinline__ void p0_prologue(Frame& F, const Params& p) {
    unsigned char* ws = p.ws;
    for (int item = F.bid; item < 192; item += F.G) {
        LAS float* sil = (LAS float*)(F.lds);
        LAS float* red = (LAS float*)(F.lds + 8192);
        const int ks = item / 24, cc = item % 24;
        for (int i = F.tid; i < 9 * 128; i += NTHR) { const int r = i >> 7, k = ks * 128 + (i & 127); const float v = r < 8 ? p.c[r * 1024 + k] : p.c_ctx[k]; sil[i] = v / (1.f + __expf(-v)); }
        __syncthreads();
        f32x4 acc[9];
#pragma unroll
        for (int r = 0; r < 9; ++r) acc[r] = (f32x4){0.f, 0.f, 0.f, 0.f};
        const float* wp = p.w_ada + (size_t)(ks * 128 + F.wave * 16) * NMOD + cc * 256 + F.lane * 4;
#pragma unroll 4
        for (int kk = 0; kk < 16; ++kk) { const f32x4 w = *(const f32x4*)(wp + (size_t)kk * NMOD);
#pragma unroll
            for (int r = 0; r < 9; ++r) acc[r] += w * sil[r * 128 + F.wave * 16 + kk]; }
#pragma unroll
        for (int r = 0; r < 9; ++r) *(LAS f32x4*)(red + ((F.wave * 9 + r) * 256 + F.lane * 4)) = acc[r];
        __syncthreads();
        float* modp = (float*)(ws + WS_MODP);
        for (int i = F.tid; i < 9 * 256; i += NTHR) { const int r = i >> 8, c = i & 255; float s = 0.f;
#pragma unroll
            for (int w = 0; w < 8; ++w) s += red[(w * 9 + r) * 256 + c];
            modp[(size_t)(ks * 9 + r) * NMOD + cc * 256 + c] = s; }
        __syncthreads();
    }
    {
        LAS float* scr = (LAS float*)(F.lds + F.wave * 16384);
        const int gw = F.bid * NWAVES + F.wave, NGW = F.G * NWAVES;
        constexpr int I_IN = 16 * 96, I_OUT = 16 * 32, I_PQ = 16 * 64;
        for (int it = gw; it < I_IN + I_OUT + I_PQ; it += NGW) {
            int r = it;
            if (r < I_IN) { p0_transpose_item(p.w_in, D, NQKV, (bf16_t*)(ws + WS_WIN), scr, r, F.lane); continue; } r -= I_IN;
            if (r < I_OUT) { p0_transpose_item(p.w_out, D, D, (bf16_t*)(ws + WS_WOUT), scr, r, F.lane); continue; } r -= I_OUT;
            p0_transpose_item(p.peer_wq, D, 2048, (bf16_t*)(ws + WS_WPQ), scr, r, F.lane);
        }
    }
    const size_t gtid = (size_t)F.bid * NTHR + F.tid, gsz = (size_t)F.G * NTHR;
    cvt_stream(p.peer_keys, (bf16_t*)(ws + WS_KEYS), (size_t)8 * 2 * 128 * 128 / 4, gtid, gsz);
    { bf16_t* ki = (bf16_t*)(ws + WS_KEYSI);
      for (int i = (int)gtid; i < 8 * 2 * 16 * 128; i += (int)gsz) { const int key = i & 127, c = (i >> 7) & 15, hp = i >> 11;
          const float* sp = p.peer_keys + ((size_t)hp * 128 + key) * 128 + c * 8; const f32x4 a = *(const f32x4*)sp, b = *(const f32x4*)(sp + 4);
          u32x4 o; o.x = pk2(a.x, a.y); o.y = pk2(a.z, a.w); o.z = pk2(b.x, b.y); o.w = pk2(b.z, b.w); *(u32x4*)(ki + (size_t)i * 8) = o; } }
    {
        const int gw = F.bid * NWAVES + F.wave, NGW = F.G * NWAVES, l5 = F.lane & 31, hb = F.lane >> 5;
        for (int e0 = gw * 2; e0 < PE_NEXP; e0 += NGW * 2) {
            f32x4 x[2][8];
#pragma unroll
            for (int q = 0; q < 2; ++q) { const float* src = (hb ? p.peer_v : p.peer_u) + (size_t)(e0 + q) * D + l5 * 32;
#pragma unroll
                for (int j = 0; j < 8; ++j) x[q][j] = ((const f32x4*)src)[j]; }
#pragma unroll
            for (int q = 0; q < 2; ++q) {
                float am = 0.f;
#pragma unroll
                for (int j = 0; j < 8; ++j) am = fmaxf(am, fmaxf(fmaxf(fabsf(x[q][j].x), fabsf(x[q][j].y)), fmaxf(fabsf(x[q][j].z), fabsf(x[q][j].w))));
                am = half_max(am);
                const float top = 6.0f;
                const float sc = am > 0.f ? top / am : 1.f, inv = am > 0.f ? am / top : 1.f;
                f32x16 va, vb;
#pragma unroll
                for (int j = 0; j < 4; ++j) { va[4 * j] = x[q][j].x * sc; va[4 * j + 1] = x[q][j].y * sc; va[4 * j + 2] = x[q][j].z * sc; va[4 * j + 3] = x[q][j].w * sc;
                    vb[4 * j] = x[q][4 + j].x * sc; vb[4 * j + 1] = x[q][4 + j].y * sc; vb[4 * j + 2] = x[q][4 + j].z * sc; vb[4 * j + 3] = x[q][4 + j].w * sc; }
                {
                    u32x4 o = (u32x4){0u, 0u, 0u, 0u};
#pragma unroll
                    for (int j = 0; j < 2; ++j) {
                        o[j] = __builtin_amdgcn_cvt_scalef32_pk_fp4_f32(o[j], va[8 * j + 0], va[8 * j + 1], 1.0f, 0); o[j] = __builtin_amdgcn_cvt_scalef32_pk_fp4_f32(o[j], va[8 * j + 2], va[8 * j + 3], 1.0f, 1);
                        o[j] = __builtin_amdgcn_cvt_scalef32_pk_fp4_f32(o[j], va[8 * j + 4], va[8 * j + 5], 1.0f, 2); o[j] = __builtin_amdgcn_cvt_scalef32_pk_fp4_f32(o[j], va[8 * j + 6], va[8 * j + 7], 1.0f, 3);
                        o[2 + j] = __builtin_amdgcn_cvt_scalef32_pk_fp4_f32(o[2 + j], vb[8 * j + 0], vb[8 * j + 1], 1.0f, 0); o[2 + j] = __builtin_amdgcn_cvt_scalef32_pk_fp4_f32(o[2 + j], vb[8 * j + 2], vb[8 * j + 3], 1.0f, 1);
                        o[2 + j] = __builtin_amdgcn_cvt_scalef32_pk_fp4_f32(o[2 + j], vb[8 * j + 4], vb[8 * j + 5], 1.0f, 2); o[2 + j] = __builtin_amdgcn_cvt_scalef32_pk_fp4_f32(o[2 + j], vb[8 * j + 6], vb[8 * j + 7], 1.0f, 3); }
                    *(u32x4*)(ws + (hb ? WS_VB : WS_UB) + (size_t)(e0 + q) * 512 + l5 * 16) = o;
                }
                if (l5 == 0) ((float*)(ws + (hb ? WS_VSC : WS_USC)))[e0 + q] = inv;
            }
        }
    }
    if (gtid == 0) {
        float s01 = 0.f, s23 = 0.f;
        for (int i = 0; i < 64; ++i) { s01 += p.diff_lambda[i] * p.diff_lambda[64 + i]; s23 += p.diff_lambda[128 + i] * p.diff_lambda[192 + i]; }
        *(float*)(ws + WS_LAM) = expf(s01) - expf(s23) + LAMBDA_INIT;
    }
    float* rope = (float*)(ws + WS_ROPE);
    for (int i = (int)gtid; i < 64 * 16; i += (int)gsz) { const int pos = i >> 4, f = i & 15; const float inv = exp2f(-(float)f * (13.287712379549449f / 16.f)); const float a = (float)pos * inv; rope[2 * i] = cosf(a); rope[2 * i + 1] = sinf(a); }
    bf16_t* bt = (bf16_t*)(ws + WS_BIAST);
    for (int i = (int)gtid; i < 8 * 15 * 4096; i += (int)gsz) {
        const int j = i & 7, kc = (i >> 3) & 63, cq = (i >> 9) & 7, hd = i >> 12, dr = hd % 15, h = hd / 15;
        const int cp = cq * 8 + j; int cs = cp - 8; cs = cs < 0 ? 0 : (cs > 48 ? 48 : cs);
        float v = NEG_BIG;
        if (kc >= cs && kc < cs + 16) v = p.rel_bias[(h * 15 + dr) * 31 + (kc - cp + 15)] * LOG2E;
        bt[i] = (bf16_t)f2bf(v);
    }
}

__device__ __forceinline__ void p1_hrows(Frame& F, const Params& p) {
    unsigned char* ws = p.ws;
    const float* modp = (const float*)(ws + WS_MODP);
    float* mod = (float*)(ws + WS_MOD);
    for (int i = F.bid * NTHR + F.tid; i < 9 * NMOD; i += F.G * NTHR) { float s = p.b_ada[i % NMOD];
#pragma unroll
        for (int ks = 0; ks < 8; ++ks) s += modp[(size_t)ks * 9 * NMOD + i];
        mod[i] = s; }
    const int rows_per = (MALL + F.G - 1) / F.G, r0 = F.bid * rows_per, r1 = min(MALL, r0 + rows_per);
    if (r0 >= r1) return;
    const int mr_lo = r0 < MLAT ? (r0 >> 12) : 8;
    LAS float* tab = (LAS float*)F.lds;
    for (int i = F.tid; i < 2 * 2048; i += NTHR) {
        const int which = i >> 11, ss = (i >> 10) & 1, col = i & 1023; const int mr = min(8, mr_lo + which);
        const int mi = mr * NMOD + (ss == 0 ? D : 0) + col;
        float s = p.b_ada[(ss == 0 ? D : 0) + col];
#pragma unroll
        for (int ks = 0; ks < 8; ++ks) s += modp[(size_t)ks * 9 * NMOD + mi];
        tab[i] = ss == 0 ? p.g_norm[col] * (1.f + s) : s;
    }
    __syncthreads();
    bf16_t* H = (bf16_t*)(ws + WS_H);
    f32x4 nx[2][4];
#define P1_LOAD(dst, rowa_) do { _Pragma("unroll") for (int q = 0; q < 2; ++q) { const int row = min((rowa_) + q * NWAVES, MALL - 1); \
            const float* xr = row < MLAT ? p.x + (size_t)row * D : p.ctx + (size_t)(row - MLAT) * D; \
            _Pragma("unroll") for (int j = 0; j < 4; ++j) dst[q][j] = ((const f32x4*)xr)[F.lane + 64 * j]; } } while (0)
    P1_LOAD(nx, r0 + F.wave);
    for (int rowa = r0 + F.wave; rowa < r1; rowa += 2 * NWAVES) {
        f32x4 v[2][4]; float ssq[2];
#pragma unroll
        for (int q = 0; q < 2; ++q)
#pragma unroll
            for (int j = 0; j < 4; ++j) v[q][j] = nx[q][j];
        if (rowa + 2 * NWAVES < r1) P1_LOAD(nx, rowa + 2 * NWAVES);
#pragma unroll
        for (int q = 0; q < 2; ++q) { float s = 0.f;
#pragma unroll
            for (int j = 0; j < 4; ++j) s += v[q][j].x * v[q][j].x + v[q][j].y * v[q][j].y + v[q][j].z * v[q][j].z + v[q][j].w * v[q][j].w;
            ssq[q] = wave_sum(s); }
#pragma unroll
        for (int q = 0; q < 2; ++q) { const int row = rowa + q * NWAVES; if (row < r1) {
            const int mr = row < MLAT ? (row >> 12) : 8; const LAS float* tb = tab + (mr - mr_lo) * 2048;
            const float rstd = rsqrtf(ssq[q] * (1.f / D) + EPS);
#pragma unroll
            for (int j = 0; j < 4; ++j) { const int col = (F.lane + 64 * j) * 4;
                const f32x4 sc = *(const LAS f32x4*)(tb + col), sh = *(const LAS f32x4*)(tb + 1024 + col);
                const f32x4 y = (v[q][j] * rstd) * sc + sh;
                u32x2 o; o.x = pk2(y.x, y.y); o.y = pk2(y.z, y.w);
                *(u32x2*)(H + (size_t)row * D + col) = o; } } }
    }
#undef P1_LOAD
}

struct EpiQKVFast {
    static constexpr bool PERM = true, AFTER_DRAIN = false;
    unsigned char* ws;
    __device__ __forceinline__ void operator()(const pg8::f32x4 (&acc)[2][2][4][2], const pg8::Unit& u, int wr, int wc, int fr, int fq) const {
        const bool lat = u.pm < 128;
        const int kind = u.pn >> 1;
        if (!lat && (kind == 0 || kind == 3)) return;
        const int b = lat ? (u.pm >> 4) : (u.pm - 128);
        const int tb = lat ? (u.pm & 15) * 256 : 0;
        const float* rope = (const float*)(ws + WS_ROPE);
#pragma unroll
        for (int bj = 0; bj < 2; ++bj) {
            const int cc = (u.pn & 1) * 256 + bj * 128 + wc * 32 + 8 * fq;
#pragma unroll
            for (int ai = 0; ai < 2; ++ai)
#pragma unroll
                for (int m = 0; m < 4; ++m) {
                    const int rowin = ai * 128 + wr * 64 + m * 16 + fr;
                    const int t = tb + rowin;
                    const int j = lat ? 256 + t : rowin;
                    f32x4 v0 = acc[ai][bj][m][0], v1 = acc[ai][bj][m][1];
                    bf16_t* dst;
                    if (kind == 0) { dst = (bf16_t*)(ws + WS_QA) + qa_idx(b, cc >> 6, t, cc & 63); v0 = v0 * C2; v1 = v1 * C2; }
                    else if (kind == 1) dst = (bf16_t*)(ws + WS_KA) + ka_idx(b, cc >> 6, j, cc & 63);
                    else if (kind == 2) dst = (bf16_t*)(ws + WS_VA) + va_idx(b, cc >> 6, j, cc & 63);
                    else if (kind == 5) dst = (bf16_t*)(ws + WS_VD) + vd_idx(b, cc >> 7, j, cc & 127);
                    else {
                        const int mm = cc >> 8, h = (cc >> 6) & 3, d = cc & 63;
                        if (lat) { const int i0 = d >> 1; const int pos = i0 < 16 ? (t >> 6) : (t & 63); const float* rp = rope + (pos * 16 + (i0 & 15)) * 2;
                            const f32x4 r0 = *(const f32x4*)rp, r1 = *(const f32x4*)(rp + 4);
                            f32x4 a0, a1;
                            a0.x = v0.x * r0.x - v0.y * r0.y; a0.y = v0.x * r0.y + v0.y * r0.x; a0.z = v0.z * r0.z - v0.w * r0.w; a0.w = v0.z * r0.w + v0.w * r0.z;
                            a1.x = v1.x * r1.x - v1.y * r1.y; a1.y = v1.x * r1.y + v1.y * r1.x; a1.z = v1.z * r1.z - v1.w * r1.w; a1.w = v1.z * r1.w + v1.w * r1.z;
                            v0 = a0; v1 = a1; }
                        if (kind == 3) { dst = (bf16_t*)(ws + WS_QD) + qd_idx(b, mm, h, t, d); v0 = v0 * C2; v1 = v1 * C2; }
                        else dst = (bf16_t*)(ws + WS_KD) + kd_idx(b, mm, h, j, d);
                    }
                    pg8::u32x4 w; w.x = pg8::cvt_pk_bf16(v0[0], v0[1]); w.y = pg8::cvt_pk_bf16(v0[2], v0[3]); w.z = pg8::cvt_pk_bf16(v1[0], v1[1]); w.w = pg8::cvt_pk_bf16(v1[2], v1[3]);
                    *(pg8::u32x4*)dst = w;
                }
        }
    }
};


struct EpiQ2Frag {
    static constexpr bool PERM = true, AFTER_DRAIN = false;
    bf16_t* O;
    __device__ __forceinline__ void operator()(const pg8::f32x4 (&acc)[2][2][4][2], const pg8::Unit& u, int wr, int wc, int fr, int fq) const {
        const int h = u.pn;
#pragma unroll
        for (int bj = 0; bj < 2; ++bj) {
            const int c8 = wc * 4 + fq;
#pragma unroll
            for (int ai = 0; ai < 2; ++ai)
#pragma unroll
                for (int m = 0; m < 4; ++m) {
                    const int row = u.pm * 256 + ai * 128 + wr * 64 + m * 16 + fr;
                    const size_t idx = ((((((size_t)(row >> 5) * 8 + h) * 2 + bj) * 8 + (c8 >> 1)) * 2 + (c8 & 1)) * 32 + (row & 31)) * 8;
                    const f32x4 v0 = acc[ai][bj][m][0], v1 = acc[ai][bj][m][1];
                    pg8::u32x4 w; w.x = pg8::cvt_pk_bf16(v0[0], v0[1]); w.y = pg8::cvt_pk_bf16(v0[2], v0[3]); w.z = pg8::cvt_pk_bf16(v1[0], v1[1]); w.w = pg8::cvt_pk_bf16(v1[2], v1[3]);
                    *(pg8::u32x4*)(O + idx) = w;
                }
        }
    }
};

__device__ __forceinline__ void p5_rows2(Frame& F, const Params& p) {
    unsigned char* ws = p.ws;
    const float* mod = (const float*)(ws + WS_MOD);
    const bf16_t* YO = (const bf16_t*)(ws + WS_YO);
    bf16_t* H2 = (bf16_t*)(ws + WS_H2); bf16_t* XN = (bf16_t*)(ws + WS_XN);
    const int gw = F.bid * NWAVES + F.wave, NGW = F.G * NWAVES;
    const int rows_per = (MLAT + NGW - 1) / NGW;
    const int rend = min(MLAT, (gw + 1) * rows_per);
    f32x4 nxx[2][4]; u32x2 nxy[2][4];
#define P5_LOAD(rowa_) do { _Pragma("unroll") for (int q = 0; q < 2; ++q) { const int row = min((rowa_) + q, MLAT - 1); \
            _Pragma("unroll") for (int j = 0; j < 4; ++j) { nxx[q][j] = ((const f32x4*)(p.x + (size_t)row * D))[F.lane + 64 * j]; nxy[q][j] = ((const u32x2*)(YO + (size_t)row * D))[F.lane + 64 * j]; } } } while (0)
    P5_LOAD(gw * rows_per);
    for (int rowa = gw * rows_per; rowa < rend; rowa += 2) {
        f32x4 xv[2][4], yv[2][4]; float ssq[2];
#pragma unroll
        for (int q = 0; q < 2; ++q)
#pragma unroll
            for (int j = 0; j < 4; ++j) { xv[q][j] = nxx[q][j]; const u32x2 yw = nxy[q][j]; yv[q][j] = (f32x4){bflo(yw.x), bfhi(yw.x), bflo(yw.y), bfhi(yw.y)}; }
        if (rowa + 2 < rend) P5_LOAD(rowa + 2);
#pragma unroll
        for (int q = 0; q < 2; ++q) { float s = 0.f;
#pragma unroll
            for (int j = 0; j < 4; ++j) s += yv[q][j].x * yv[q][j].x + yv[q][j].y * yv[q][j].y + yv[q][j].z * yv[q][j].z + yv[q][j].w * yv[q][j].w;
            ssq[q] = wave_sum(s); }
#pragma unroll
        for (int q = 0; q < 2; ++q) { const int row = rowa + q; if (row < MLAT) {
            const int b = row >> 12; const float* mb = mod + b * NMOD;
            const float rstd = rsqrtf(ssq[q] * (1.f / D) + EPS);
            float s2 = 0.f;
#pragma unroll
            for (int j = 0; j < 4; ++j) { const int col = (F.lane + 64 * j) * 4;
                const f32x4 g1 = *(const f32x4*)(p.g_norm + D + col), gt1 = *(const f32x4*)(mb + 2 * D + col);
                xv[q][j] = xv[q][j] + gt1 * (yv[q][j] * rstd * g1);
                { u32x2 xo; xo.x = pk2(xv[q][j].x, xv[q][j].y); xo.y = pk2(xv[q][j].z, xv[q][j].w); *(u32x2*)(XN + (size_t)row * D + col) = xo; }
                s2 += xv[q][j].x * xv[q][j].x + xv[q][j].y * xv[q][j].y + xv[q][j].z * xv[q][j].z + xv[q][j].w * xv[q][j].w; }
            const float rstd2 = rsqrtf(wave_sum(s2) * (1.f / D) + EPS);
#pragma unroll
            for (int j = 0; j < 4; ++j) { const int col = (F.lane + 64 * j) * 4;
                const f32x4 g2 = *(const f32x4*)(p.g_norm + 2 * D + col), sh2 = *(const f32x4*)(mb + 3 * D + col), sc2 = *(const f32x4*)(mb + 4 * D + col);
                const f32x4 y = (xv[q][j] * rstd2 * g2) * (sc2 + 1.f) + sh2;
                u32x2 o; o.x = pk2(y.x, y.y); o.y = pk2(y.z, y.w);
                *(u32x2*)(H2 + (size_t)row * D + col) = o; } } }
    }
#undef P5_LOAD
}

template <int J> __device__ __forceinline__ unsigned lane_xor(unsigned x, int lane) {
    if (J == 1) return (unsigned)__builtin_amdgcn_update_dpp(0, (int)x, 0xB1, 0xf, 0xf, false);
    if (J == 2) return (unsigned)__builtin_amdgcn_update_dpp(0, (int)x, 0x4E, 0xf, 0xf, false);
    if (J == 4) { const unsigned a = (unsigned)__builtin_amdgcn_update_dpp(0, (int)x, 0x104, 0xf, 0xf, false),
                                 b = (unsigned)__builtin_amdgcn_update_dpp(0, (int)x, 0x114, 0xf, 0xf, false);
                  return (lane & 4) ? b : a; }
    if (J == 8) return (unsigned)__builtin_amdgcn_update_dpp(0, (int)x, 0x128, 0xf, 0xf, false);
    if (J == 16) { auto r = __builtin_amdgcn_permlane16_swap(x, x, false, false); return (lane & 16) ? r[0] : r[1]; }
    auto r = __builtin_amdgcn_permlane32_swap(x, x, false, false); return (lane & 32) ? r[0] : r[1];
}
template <int K2, int J> __device__ __forceinline__ void bitonic_step128(unsigned& key0, unsigned& key1, int lane) {
    if (J == 64) { const unsigned lo = key0 < key1 ? key0 : key1, hi_ = key0 < key1 ? key1 : key0; key0 = lo; key1 = hi_; }
    else {
        const unsigned p0_ = lane_xor<J>(key0, lane), p1_ = lane_xor<J>(key1, lane);
        const bool lower = (lane & J) == 0;
        const bool asc0 = K2 == 128 ? true : ((lane & K2) == 0), asc1 = K2 == 128 ? true : (((64 + lane) & K2) == 0);
        const bool kmin0 = lower == asc0, kmin1 = lower == asc1;
        key0 = kmin0 ? (key0 < p0_ ? key0 : p0_) : (key0 < p0_ ? p0_ : key0);
        key1 = kmin1 ? (key1 < p1_ ? key1 : p1_) : (key1 < p1_ ? p1_ : key1);
    }
}
__device__ __forceinline__ void sort128_asc(unsigned& k0, unsigned& k1, int lane) {
    bitonic_step128<2, 1>(k0, k1, lane);
    bitonic_step128<4, 2>(k0, k1, lane); bitonic_step128<4, 1>(k0, k1, lane);
    bitonic_step128<8, 4>(k0, k1, lane); bitonic_step128<8, 2>(k0, k1, lane); bitonic_step128<8, 1>(k0, k1, lane);
    bitonic_step128<16, 8>(k0, k1, lane); bitonic_step128<16, 4>(k0, k1, lane); bitonic_step128<16, 2>(k0, k1, lane); bitonic_step128<16, 1>(k0, k1, lane);
    bitonic_step128<32, 16>(k0, k1, lane); bitonic_step128<32, 8>(k0, k1, lane); bitonic_step128<32, 4>(k0, k1, lane); bitonic_step128<32, 2>(k0, k1, lane); bitonic_step128<32, 1>(k0, k1, lane);
    bitonic_step128<64, 32>(k0, k1, lane); bitonic_step128<64, 16>(k0, k1, lane); bitonic_step128<64, 8>(k0, k1, lane); bitonic_step128<64, 4>(k0, k1, lane); bitonic_step128<64, 2>(k0, k1, lane); bitonic_step128<64, 1>(k0, k1, lane);
    bitonic_step128<128, 64>(k0, k1, lane); bitonic_step128<128, 32>(k0, k1, lane); bitonic_step128<128, 16>(k0, k1, lane); bitonic_step128<128, 8>(k0, k1, lane); bitonic_step128<128, 4>(k0, k1, lane); bitonic_step128<128, 2>(k0, k1, lane); bitonic_step128<128, 1>(k0, k1, lane);
}
__device__ __forceinline__ float e2m3_val(int k) { return k < 8 ? (float)k * 0.125f : ldexpf(1.f + (float)(k & 7) * 0.125f, (k >> 3) - 1); }
__device__ __forceinline__ int e2m3_idx(float x) { if (x < 1.f) return (int)(x * 8.f + 0.5f); const int e = x >= 4.f ? 2 : (x >= 2.f ? 1 : 0); return 8 * (e + 1) + (int)((x / (float)(1 << e) - 1.f) * 8.f + 0.5f); }
__device__ __forceinline__ float sum8(float v) {
    v += __uint_as_float((unsigned)__builtin_amdgcn_update_dpp(0, (int)__float_as_uint(v), 0xB1, 0xf, 0xf, false));
    v += __uint_as_float((unsigned)__builtin_amdgcn_update_dpp(0, (int)__float_as_uint(v), 0x4E, 0xf, 0xf, false));
    v += __uint_as_float((unsigned)__builtin_amdgcn_update_dpp(0, (int)__float_as_uint(v), 0x141, 0xf, 0xf, false));
    return v;
}
template <int MODE> __device__ __forceinline__ void p8_gather(Frame& F, const Params& p, const XcdBarrier& bar) {
    unsigned char* ws = p.ws;
    const bf16_t* H2 = (const bf16_t*)(ws + WS_H2); const unsigned char* U6 = ws + WS_UB; const unsigned char* V6 = ws + WS_VB;
    const int* EX = (const int*)(ws + WS_EXP); const float* USCT = (const float*)(ws + WS_USC); const float* mod = (const float*)(ws + WS_MOD);
    const int lane = F.lane, l5 = lane & 31, b5 = (lane >> 5) & 1, b4 = (lane >> 4) & 1, b3 = (lane >> 3) & 1;
    const int ent = 2 * (2 * b4 + b3) + b5;
    LAS float* scr = (LAS float*)(F.lds + F.wave * 8192);
    int sw4;
    { const unsigned cw = __builtin_amdgcn_cvt_scalef32_pk_fp4_f32(0u, 1.0f, 2.0f, 1.0f, 0); const f32x2 cr = __builtin_amdgcn_cvt_scalef32_pk_f32_fp4(cw, 1.0f, 0);
      sw4 = __builtin_amdgcn_readfirstlane(cr.x == 1.0f ? 0 : 1); }
    const unsigned mlo = (lane & 3) == 0 ? 0x0000FFFFu : ((lane & 3) == 1 ? 0xFFFF0000u : 0u), mhi = (lane & 3) == 2 ? 0x0000FFFFu : ((lane & 3) == 3 ? 0xFFFF0000u : 0u);
#define FP4BF(w_, b_) __builtin_bit_cast(unsigned, __builtin_amdgcn_cvt_scalef32_pk_bf16_fp4((w_), 1.0f, (b_)))
    const unsigned char* ubase = U6 + l5 * 16; const unsigned char* vbase = V6 + l5 * 16;
    unsigned* ctr = (unsigned*)(ws + WS_CTL) + CW_P8CTR + (MODE != 0 ? 16 : 0);
    int cnext = 0;
    if (lane == 0) cnext = (int)__hip_atomic_fetch_add(ctr, 1u, __ATOMIC_RELAXED, __HIP_MEMORY_SCOPE_AGENT);
    cnext = __builtin_amdgcn_readfirstlane(cnext);
    for (;;) {
        const int t = cnext;
        if (t >= MLAT) break;
        if (lane == 0) cnext = (int)__hip_atomic_fetch_add(ctr, 1u, __ATOMIC_RELAXED, __HIP_MEMORY_SCOPE_AGENT);
        const size_t tb_ = (size_t)t * 128;
        unsigned key0 = (unsigned)EX[tb_ + lane], key1 = (unsigned)EX[tb_ + 64 + lane];
        hs16x4 hb[8]; f32x4 acc[8];
        { const u32x4* hp = (const u32x4*)(H2 + (size_t)t * D + l5 * 32);
#pragma unroll
          for (int j = 0; j < 4; ++j) { u32x4 w = hp[j];
              if (sw4) { w.x = __builtin_amdgcn_alignbit(w.x, w.x, 16); w.y = __builtin_amdgcn_alignbit(w.y, w.y, 16); w.z = __builtin_amdgcn_alignbit(w.z, w.z, 16); w.w = __builtin_amdgcn_alignbit(w.w, w.w, 16); }
              hb[2 * j] = __builtin_bit_cast(hs16x4, (u32x2){w.x, w.y}); hb[2 * j + 1] = __builtin_bit_cast(hs16x4, (u32x2){w.z, w.w}); }
#pragma unroll
          for (int j = 0; j < 8; ++j) acc[j] = (f32x4){0.f, 0.f, 0.f, 0.f}; }
        sort128_asc(key0, key1, lane);
        const unsigned off0 = (key0 & 0xFFFF0000u) >> 7, off1 = (key1 & 0xFFFF0000u) >> 7;
        for (int bb = 0; bb < 16; ++bb) {
            const unsigned kreg = bb < 8 ? key0 : key1, koff = bb < 8 ? off0 : off1; const int lb = (bb & 7) * 8;
            const unsigned kmine = (unsigned)__builtin_amdgcn_ds_bpermute((lb + ent) * 4, (int)kreg);
            unsigned eo[4];
#pragma unroll
            for (int pr = 0; pr < 4; ++pr) eo[pr] = (unsigned)__builtin_amdgcn_ds_bpermute((lb + 2 * pr + b5) * 4, (int)koff) & (MODE == 1 ? 0x7FFFFu : (MODE == 3 ? 0xFFFu : 0xFFFFFFFFu));
            u32x4 u4[4], v4[4];
#pragma unroll
            for (int pr = 0; pr < 4; ++pr) { u4[pr] = *(const u32x4*)(ubase + eo[pr]); v4[pr] = *(const u32x4*)(vbase + eo[pr]); }
            const float gl = __uint_as_float(kmine << 16), sl = USCT[kmine >> 16];
            if (MODE == 4) { unsigned xa = 0u;
#pragma unroll
                for (int pr = 0; pr < 4; ++pr) xa ^= u4[pr].x ^ u4[pr].y ^ u4[pr].z ^ u4[pr].w ^ v4[pr].x ^ v4[pr].y ^ v4[pr].z ^ v4[pr].w;
                acc[0][0] += __uint_as_float(xa & 0x007FFFFFu) + gl + sl; continue; }
            f32x4 dq[4];
#pragma unroll
            for (int pr = 0; pr < 4; ++pr) dq[pr] = (f32x4){0.f, 0.f, 0.f, 0.f};
#pragma unroll
            for (int j = 0; j < 4; ++j) {
#pragma unroll
                for (int pr = 0; pr < 4; ++pr) { const unsigned c0 = FP4BF(u4[pr][j], 0), c1 = FP4BF(u4[pr][j], 1);
                    dq[pr] = __builtin_amdgcn_mfma_f32_4x4x4bf16_1k(__builtin_bit_cast(hs16x4, (u32x2){c0, c1}), hb[2 * j], dq[pr], 0, 0, 0); }
#pragma unroll
                for (int pr = 0; pr < 4; ++pr) { const unsigned c2 = FP4BF(u4[pr][j], 2), c3 = FP4BF(u4[pr][j], 3);
                    dq[pr] = __builtin_amdgcn_mfma_f32_4x4x4bf16_1k(__builtin_bit_cast(hs16x4, (u32x2){c2, c3}), hb[2 * j + 1], dq[pr], 0, 0, 0); }
            }
            float d[4];
#pragma unroll
            for (int pr = 0; pr < 4; ++pr) d[pr] = (lane & 2) ? ((lane & 1) ? dq[pr][3] : dq[pr][2]) : ((lane & 1) ? dq[pr][1] : dq[pr][0]);
            float r2[2], r1;
#pragma unroll
            for (int i = 0; i < 2; ++i) { auto rr = __builtin_amdgcn_permlane16_swap(__float_as_uint(d[i]), __float_as_uint(d[i + 2]), false, false); r2[i] = __uint_as_float(rr[0]) + __uint_as_float(rr[1]); }
            { const float keep = b3 ? r2[1] : r2[0], send = b3 ? r2[0] : r2[1]; r1 = keep + __uint_as_float((unsigned)__builtin_amdgcn_update_dpp(0, (int)__float_as_uint(send), 0x128, 0xf, 0xf, false)); }
            r1 = sum8(r1);
            const float pre = r1 * sl;
            float act;
            { const float av = fabsf(pre), dd = av * 0.2316418882f + 1.0f; const float tt = __builtin_amdgcn_rcpf(dd);
              float q = tt * 0.5307027145f + (-0.7265760135f); q = q * tt + 0.7107068705f; q = q * tt + (-0.142248368f); q = q * tt + 0.127414796f; q = q * tt;
              const float ee = __builtin_amdgcn_exp2f((pre * pre) * (-0.72134752044f));
              const float mm = pre * (q * ee); act = pre < 0.f ? mm : pre - mm; }
            const float cfl = gl * act;
            const unsigned cfpk_l = __builtin_bit_cast(unsigned, __builtin_convertvector((f32x2){cfl, cfl}, hbf16x2));
#pragma unroll
            for (int pr = 0; pr < 4; ++pr) {
                const unsigned cfpk = (unsigned)__builtin_amdgcn_ds_bpermute(((pr >> 1) * 16 + (pr & 1) * 8 + 32 * b5) * 4, (int)cfpk_l);
                const hs16x4 Aop = __builtin_bit_cast(hs16x4, (u32x2){cfpk & mlo, cfpk & mhi});
#pragma unroll
                for (int j = 0; j < 4; ++j) {
                    const unsigned c0 = FP4BF(v4[pr][j], 0), c1 = FP4BF(v4[pr][j], 1), c2 = FP4BF(v4[pr][j], 2), c3 = FP4BF(v4[pr][j], 3);
                    acc[2 * j] = __builtin_amdgcn_mfma_f32_4x4x4bf16_1k(Aop, __builtin_bit_cast(hs16x4, (u32x2){c0, c1}), acc[2 * j], 0, 0, 0);
                    acc[2 * j + 1] = __builtin_amdgcn_mfma_f32_4x4x4bf16_1k(Aop, __builtin_bit_cast(hs16x4, (u32x2){c2, c3}), acc[2 * j + 1], 0, 0, 0); }
            }
        }
#pragma unroll
        for (int j = 0; j < 32; ++j) { const float av = acc[j >> 2][j & 3]; auto rr = __builtin_amdgcn_permlane32_swap(__float_as_uint(av), __float_as_uint(av), false, false); scr[(j ^ sw4) * 64 + lane] = __uint_as_float(rr[0]) + __uint_as_float(rr[1]); }
        float at[16]; float s = 0.f;
#pragma unroll
        for (int k = 0; k < 16; ++k) { at[k] = scr[(16 * b5 + k) * 64 + lane]; s += at[k] * at[k]; }
        const float rstd = rsqrtf(wave_sum(s) * (1.f / D) + EPS);
        const float* mb = mod + (t >> 12) * NMOD + 5 * D; const float* g3 = p.g_norm + 3 * D;
#pragma unroll
        for (int j = 0; j < 4; ++j) { const int col = l5 * 32 + b5 * 16 + j * 4;
            float* op = p.out + (size_t)t * D + col;
            const u32x2 xw = *(const u32x2*)((const bf16_t*)(ws + WS_XN) + (size_t)t * D + col);
            const f32x4 x0 = (f32x4){bflo(xw.x), bfhi(xw.x), bflo(xw.y), bfhi(xw.y)}, ga = *(const f32x4*)(g3 + col), ta = *(const f32x4*)(mb + col);
            const f32x4 pa = (f32x4){at[4 * j], at[4 * j + 1], at[4 * j + 2], at[4 * j + 3]};
            if (MODE == 0 || rstd == 123456.f) *(f32x4*)op = x0 + ta * (pa * rstd * ga); }
        cnext = __builtin_amdgcn_readfirstlane(cnext);
    }
}

namespace att {
typedef short bf16x8 __attribute__((ext_vector_type(8)));
typedef short s16x4 __attribute__((ext_vector_type(4)));
typedef float f32x16 __attribute__((ext_vector_type(16)));
typedef __attribute__((address_space(3))) const unsigned char* lcp;
typedef __attribute__((address_space(3))) unsigned char* lp;
constexpr int NA_SLOT = 16384, NA_BIAS_OFF = 32768, WSF_OFF = 155648;
constexpr int DF_SLOT = 32768;
constexpr float THRL = 8.f;

__device__ __forceinline__ int crow(int r, int hi) { return (r & 3) + 8 * (r >> 2) + 4 * hi; }
__device__ __forceinline__ s16x4 vtr(lcp p) { return __builtin_bit_cast(s16x4, __builtin_amdgcn_ds_read_tr16_b64_v4i16((__attribute__((address_space(3))) s16x4*)p)); }
typedef float f32x2_t __attribute__((ext_vector_type(2))); typedef __bf16 bf16x2v_t __attribute__((ext_vector_type(2)));
__device__ __forceinline__ unsigned cvtpk(float lo, float hi) { f32x2_t v = {lo, hi}; bf16x2v_t b = __builtin_convertvector(v, bf16x2v_t); return __builtin_bit_cast(unsigned, b); }
__device__ __forceinline__ float swap_half(float v) { auto rr = __builtin_amdgcn_permlane32_swap(__float_as_uint(v), __float_as_uint(v), false, false); return __uint_as_float(rr[0]) == v ? __uint_as_float(rr[1]) : __uint_as_float(rr[0]); }
__device__ __forceinline__ void dma16(const void* gsrc, lp lds_dst) {
    unsigned keep; const unsigned dst = (unsigned)__builtin_amdgcn_readfirstlane((int)(unsigned)(size_t)lds_dst);
    asm volatile("s_mov_b32 %0, m0\n\ts_mov_b32 m0, %2\n\ts_nop 0\n\tglobal_load_lds_dwordx4 %1, off\n\ts_mov_b32 m0, %0" : "=&s"(keep) : "v"(gsrc), "s"(dst) : "memory");
}
__device__ __forceinline__ float max3f(float a, float b, float c) { float r; asm("v_max3_f32 %0, %1, %2, %3" : "=v"(r) : "v"(a), "v"(b), "v"(c)); return r; }
__device__ __forceinline__ float rowmax32(const f32x16& p0, const f32x16& p1) {
    float a = max3f(p0[0], p0[1], p1[0]), b = max3f(p0[2], p0[3], p1[1]); a = max3f(a, p1[2], p1[3]);
#pragma unroll
    for (int r = 4; r < 16; r += 4) { a = max3f(a, p0[r], p0[r + 1]); b = max3f(b, p0[r + 2], p0[r + 3]); a = max3f(a, p1[r], p1[r + 1]); b = max3f(b, p1[r + 2], p1[r + 3]); }
    float m = max3f(a, b, b);
    auto rr = __builtin_amdgcn_permlane32_swap(__float_as_uint(m), __float_as_uint(m), false, false);
    return max3f(__uint_as_float(rr[0]), __uint_as_float(rr[1]), __uint_as_float(rr[1]));
}

typedef __bf16 bf16x2_t __attribute__((ext_vector_type(2)));
__device__ __forceinline__ float psum_bf16(const u32x4 (&pw)[4], float acc) {
    const bf16x2_t ones = __builtin_bit_cast(bf16x2_t, 0x3F803F80u); float a0 = acc, a1 = 0.f;
#pragma unroll
    for (int k = 0; k < 4; ++k) { a0 = __builtin_amdgcn_fdot2_f32_bf16(__builtin_bit_cast(bf16x2_t, pw[k][0]), ones, a0, false); a1 = __builtin_amdgcn_fdot2_f32_bf16(__builtin_bit_cast(bf16x2_t, pw[k][1]), ones, a1, false);
        a0 = __builtin_amdgcn_fdot2_f32_bf16(__builtin_bit_cast(bf16x2_t, pw[k][2]), ones, a0, false); a1 = __builtin_amdgcn_fdot2_f32_bf16(__builtin_bit_cast(bf16x2_t, pw[k][3]), ones, a1, false); }
    return a0 + a1;
}
template <int NDV> struct FlashState { float mhat, l; f32x16 negm; f32x16 o[NDV]; };

template <int NDV, bool BIAS>
__device__ __forceinline__ void flash_tile(FlashState<NDV>& st, const bf16x8 (&qr)[4], lcp Kslot, lcp Vslot, lcp Bslot, const bf16x8 (&qoh)[2],
                                           __attribute__((address_space(3))) float* wsf, int r32, int hi, int lane, bool first) {
    f32x16 p0 = st.negm, p1 = st.negm;
    lcp kb = Kslot + hi * 1024 + r32 * 16;
    bf16x8 kf[8], bf_[4];
#pragma unroll
    for (int d0 = 0; d0 < 4; ++d0) { kf[2 * d0] = *(const __attribute__((address_space(3))) bf16x8*)(kb + d0 * 2048); kf[2 * d0 + 1] = *(const __attribute__((address_space(3))) bf16x8*)(kb + d0 * 2048 + 512); }
    if (BIAS) { lcp bb = Bslot + hi * 1024 + r32 * 16;
#pragma unroll
        for (int e = 0; e < 2; ++e) { bf_[2 * e] = *(const __attribute__((address_space(3))) bf16x8*)(bb + e * 2048); bf_[2 * e + 1] = *(const __attribute__((address_space(3))) bf16x8*)(bb + e * 2048 + 512); } }
    lcp vb = Vslot + ((lane >> 4) & 1) * 32 + (lane & 3) * 8 + (4 * hi + ((lane & 15) >> 2)) * 64;
    s16x4 va[8], vn[8];
#pragma unroll
    for (int ks = 0; ks < 4; ++ks) { va[2 * ks] = vtr(vb + ks * 1024); va[2 * ks + 1] = vtr(vb + ks * 1024 + 512); }
#pragma unroll
    for (int d0 = 0; d0 < 4; ++d0) { p0 = __builtin_amdgcn_mfma_f32_32x32x16_bf16(kf[2 * d0], qr[d0], p0, 0, 0, 0); p1 = __builtin_amdgcn_mfma_f32_32x32x16_bf16(kf[2 * d0 + 1], qr[d0], p1, 0, 0, 0); }
    if (BIAS) {
#pragma unroll
        for (int e = 0; e < 2; ++e) { p0 = __builtin_amdgcn_mfma_f32_32x32x16_bf16(bf_[2 * e], qoh[e], p0, 0, 0, 0); p1 = __builtin_amdgcn_mfma_f32_32x32x16_bf16(bf_[2 * e + 1], qoh[e], p1, 0, 0, 0); }
    }
    asm volatile("s_nop 15\n\ts_nop 7" : "+v"(p0), "+v"(p1));
    const float rm = rowmax32(p0, p1);
    if (first) {
        st.mhat += rm;
#pragma unroll
        for (int r = 0; r < 16; ++r) { p0[r] -= rm; p1[r] -= rm; st.negm[r] = -st.mhat; }
    } else if (__any(rm > THRL)) {
        const float dl = fmaxf(rm, 0.f); const float alpha = __builtin_amdgcn_exp2f(-dl); st.mhat += dl; st.l *= alpha;
        if (hi == 0) wsf[r32] = alpha;
        asm volatile("s_waitcnt lgkmcnt(0)" ::: "memory");
        float al[16];
#pragma unroll
        for (int r = 0; r < 16; ++r) al[r] = wsf[crow(r, hi)];
#pragma unroll
        for (int d = 0; d < NDV; ++d)
#pragma unroll
            for (int r = 0; r < 16; ++r) st.o[d][r] *= al[r];
#pragma unroll
        for (int r = 0; r < 16; ++r) { p0[r] -= dl; p1[r] -= dl; st.negm[r] = -st.mhat; }
    }
    float sacc = 0.f;
#pragma unroll
    for (int r = 0; r < 16; ++r) { p0[r] = __builtin_amdgcn_exp2f(p0[r]); p1[r] = __builtin_amdgcn_exp2f(p1[r]); sacc += p0[r] + p1[r]; }
    st.l += sacc;
    u32x4 pw[4];
#pragma unroll
    for (int i = 0; i < 4; ++i) { pw[0][i] = cvtpk(p0[2 * i], p0[2 * i + 1]); pw[1][i] = cvtpk(p0[8 + 2 * i], p0[8 + 2 * i + 1]); pw[2][i] = cvtpk(p1[2 * i], p1[2 * i + 1]); pw[3][i] = cvtpk(p1[8 + 2 * i], p1[8 + 2 * i + 1]); }
    __builtin_amdgcn_sched_barrier(0);
#pragma unroll
    for (int d0 = 0; d0 < NDV; ++d0) {
#pragma unroll
        for (int ks = 0; ks < 4; ++ks) {
            if (d0 < NDV - 1) { vn[2 * ks] = vtr(vb + (d0 + 1) * 4096 + ks * 1024); vn[2 * ks + 1] = vtr(vb + (d0 + 1) * 4096 + ks * 1024 + 512); }
            const bf16x8 vf = (bf16x8){va[2 * ks][0], va[2 * ks][1], va[2 * ks][2], va[2 * ks][3], va[2 * ks + 1][0], va[2 * ks + 1][1], va[2 * ks + 1][2], va[2 * ks + 1][3]};
            st.o[d0] = __builtin_amdgcn_mfma_f32_32x32x16_bf16(__builtin_bit_cast(bf16x8, pw[ks]), vf, st.o[d0], 0, 0, 0);
            __builtin_amdgcn_sched_barrier(0);
        }
#pragma unroll
        for (int i = 0; i < 8; ++i) va[i] = vn[i];
    }
}

constexpr int NA2_SLOT = 16384, NA2_BIAS_OFF = 65536;
__device__ __forceinline__ void na_units(Frame& F, const Params& p) {
    unsigned char* ws = p.ws;
    const bf16_t* QA = (const bf16_t*)(ws + WS_QA); const bf16_t* KA = (const bf16_t*)(ws + WS_KA); const bf16_t* VA = (const bf16_t*)(ws + WS_VA);
    const bf16_t* BT = (const bf16_t*)(ws + WS_BIAST); bf16_t* Y = (bf16_t*)(ws + WS_Y);
    const int lane = F.lane, r32 = lane & 31, hi = lane >> 5, wave = F.wave;
    lp lds = (lp)F.lds;
    __attribute__((address_space(3))) float* wsf = (__attribute__((address_space(3))) float*)(lds + WSF_OFF) + wave * 64;
    const int upw = 1024 / F.G;
    int cur_h = -1, cur_lo = -1, cur_hi = -1;
    bf16x8 qoh[2];
#pragma unroll
    for (int e = 0; e < 2; ++e)
#pragma unroll
        for (int j = 0; j < 8; ++j) qoh[e][j] = (16 * e + 8 * hi + j == r32) ? (short)0x3F80 : (short)0;
    for (int ui = 0; ui < upw; ++ui) {
        const int u = F.bid * upw + ui, bh = u >> 4, rg = u & 15, b = bh >> 3, h = bh & 7;
        const int r0 = rg * 4, r = r0 + (wave >> 1), ch = wave & 1;
        int rs = r - 4; rs = rs < 0 ? 0 : (rs > 56 ? 56 : rs);
        int kr_lo = r0 - 4; kr_lo = kr_lo < 0 ? 0 : (kr_lo > 56 ? 56 : kr_lo);
        int kr_hi = r0 + 3 - 4; kr_hi = kr_hi < 0 ? 0 : (kr_hi > 56 ? 56 : kr_hi); kr_hi += 7;
        const int T = 4 + (kr_hi - kr_lo + 1);
        int dr_lo = 99, dr_hi = -1;
#pragma unroll
        for (int q = 0; q < 4; ++q) { int s_ = r0 + q - 4; s_ = s_ < 0 ? 0 : (s_ > 56 ? 56 : s_); const int a = s_ - (r0 + q) + 7; dr_lo = a < dr_lo ? a : dr_lo; dr_hi = a + 7 > dr_hi ? a + 7 : dr_hi; }
        const bf16_t* Kb = KA + (size_t)bh * NKT * 4096; const bf16_t* Vb = VA + (size_t)bh * NKT * 4096;
        if (h != cur_h || dr_lo != cur_lo || dr_hi != cur_hi) {
            cur_h = h; cur_lo = dr_lo; cur_hi = dr_hi;
            const unsigned char* src = (const unsigned char*)(BT + ((size_t)h * 15 + dr_lo) * 4096);
            const int npc = (dr_hi - dr_lo + 1) * 8;
            for (int pi = wave; pi < npc; pi += 8) dma16(src + pi * 1024 + lane * 16, lds + NA2_BIAS_OFF + pi * 1024);
        }
        bf16x8 qr[4];
        { const bf16_t* qp = QA + ((size_t)bh * SEQ + r * 64 + ch * 32 + r32) * 64 + hi * 8;
#pragma unroll
          for (int d0 = 0; d0 < 4; ++d0) qr[d0] = *(const bf16x8*)(qp + d0 * 16); }
#define NA_DMA(i_) do { const int tg_ = (i_) < 4 ? (i_) : (4 + kr_lo + (i_) - 4); lp sl_ = lds + ((i_) & 3) * NA2_SLOT; \
            dma16((const unsigned char*)(Kb + (size_t)tg_ * 4096) + wave * 1024 + lane * 16, sl_ + wave * 1024); \
            dma16((const unsigned char*)(Vb + (size_t)tg_ * 4096) + wave * 1024 + lane * 16, sl_ + 8192 + wave * 1024); } while (0)
        NA_DMA(0); NA_DMA(1);
        FlashState<2> st; st.mhat = 0.f; st.l = 0.f;
#pragma unroll
        for (int rr = 0; rr < 16; ++rr) st.negm[rr] = 0.f;
#pragma unroll
        for (int d = 0; d < 2; ++d)
#pragma unroll
            for (int rr = 0; rr < 16; ++rr) st.o[d][rr] = 0.f;
        for (int i = 0; i < T; ++i) {
            if (i + 1 < T) asm volatile("s_waitcnt vmcnt(2)" ::: "memory"); else asm volatile("s_waitcnt vmcnt(0)" ::: "memory");
            __syncthreads();
            if (i + 2 < T) NA_DMA(i + 2);
            lcp sl = (lcp)(lds + (i & 3) * NA2_SLOT);
            if (i < 4) flash_tile<2, false>(st, qr, sl, sl + 8192, sl, qoh, wsf, r32, hi, lane, i == 0);
            else { const int kr = kr_lo + (i - 4);
                if (kr >= rs && kr < rs + 8) { const int dr = kr - r + 7;
                    flash_tile<2, true>(st, qr, sl, sl + 8192, (lcp)(lds + NA2_BIAS_OFF + (dr - dr_lo) * 8192 + ch * 4096), qoh, wsf, r32, hi, lane, false); } }
        }
#undef NA_DMA
        float lt = st.l; { auto rr = __builtin_amdgcn_permlane32_swap(__float_as_uint(lt), __float_as_uint(lt), false, false); lt = __uint_as_float(rr[0]) + __uint_as_float(rr[1]); }
        if (hi == 0) wsf[32 + r32] = lt;
        asm volatile("s_waitcnt lgkmcnt(0)" ::: "memory");
        bf16_t* yb = Y + ((size_t)b * SEQ + r * 64 + ch * 32) * D + h * 64 + r32;
#pragma unroll
        for (int rr = 0; rr < 16; ++rr) { const float rl = __builtin_amdgcn_rcpf(wsf[32 + crow(rr, hi)]);
#pragma unroll
            for (int d0 = 0; d0 < 2; ++d0) yb[(size_t)crow(rr, hi) * D + d0 * 32] = (bf16_t)f2bf(st.o[d0][rr] * rl); }
        __syncthreads();
    }
}

template <int MODE> __device__ __forceinline__ void diff_units_v2(Frame& F, const Params& p) {
    unsigned char* ws = p.ws;
    const bf16_t* QD = (const bf16_t*)(ws + WS_QD); const bf16_t* KD = (const bf16_t*)(ws + WS_KD); const bf16_t* VD = (const bf16_t*)(ws + WS_VD);
    bf16_t* Y = (bf16_t*)(ws + WS_Y);
    const float lam = *(const float*)(ws + WS_LAM);
    const int lane = F.lane, r32 = lane & 31, hi = lane >> 5, wave = F.wave, map = wave >> 2, qg = wave & 3;
    lp lds = (lp)F.lds;
    __attribute__((address_space(3))) float* wsf = (__attribute__((address_space(3))) float*)(lds + WSF_OFF) + wave * 64;
    __attribute__((address_space(3))) float* X = (__attribute__((address_space(3))) float*)lds;
    const int upw = 1024 / F.G;
    const int koff = map * 8192 + hi * 1024 + r32 * 16;
    const int voff = 16384 + ((lane >> 4) & 1) * 32 + (lane & 3) * 8 + (4 * hi + ((lane & 15) >> 2)) * 64;
    for (int ui = 0; ui < upw; ++ui) {
        int bh, qb;
        if (F.G == 256) { bh = (F.bid & 7) * 4 + ui; qb = F.bid >> 3; } else { const int u = F.bid * upw + ui; bh = u >> 5; qb = u & 31; }
        const int b = bh >> 2, h = bh & 3;
        const unsigned char* K1 = (const unsigned char*)(KD + (size_t)((b * 2 + 0) * 4 + h) * NKT * 4096);
        const unsigned char* K2 = (const unsigned char*)(KD + (size_t)((b * 2 + 1) * 4 + h) * NKT * 4096);
        const unsigned char* Vg = (const unsigned char*)(VD + (size_t)bh * NKT * 8192);
#define DF_DMA(t, slot) do { if (MODE != 1 && MODE != 3) { lp sl_ = lds + (slot) * DF_SLOT; \
            dma16(K1 + (size_t)(t) * 8192 + wave * 1024 + lane * 16, sl_ + wave * 1024); \
            dma16(K2 + (size_t)(t) * 8192 + wave * 1024 + lane * 16, sl_ + 8192 + wave * 1024); \
            dma16(Vg + (size_t)(t) * 16384 + wave * 1024 + lane * 16, sl_ + 16384 + wave * 1024); \
            dma16(Vg + (size_t)(t) * 16384 + 8192 + wave * 1024 + lane * 16, sl_ + 24576 + wave * 1024); } } while (0)
        DF_DMA(0, 0); DF_DMA(1, 1);
        const int q0 = qb * 128 + qg * 32;
        bf16x8 qr[4];
        { const bf16_t* qp = QD + ((size_t)((b * 2 + map) * 4 + h) * SEQ + q0 + r32) * 64 + hi * 8;
#pragma unroll
          for (int d0 = 0; d0 < 4; ++d0) qr[d0] = *(const bf16x8*)(qp + d0 * 16); }
        float mhat = 0.f, lsum = 0.f; f32x16 o[4], negm;
#pragma unroll
        for (int d = 0; d < 4; ++d)
#pragma unroll
            for (int rr = 0; rr < 16; ++rr) o[d][rr] = 0.f;
        asm volatile("s_waitcnt vmcnt(0)" ::: "memory");
        __syncthreads();
        f32x16 s0, s1;
#pragma unroll
        for (int rr = 0; rr < 16; ++rr) { s0[rr] = 0.f; s1[rr] = 0.f; }
        { lcp kb = (lcp)(lds + koff);
#pragma unroll
          for (int d0 = 0; d0 < 4; ++d0) {
              const bf16x8 b0 = *(const __attribute__((address_space(3))) bf16x8*)(kb + d0 * 2048), b1 = *(const __attribute__((address_space(3))) bf16x8*)(kb + d0 * 2048 + 512);
              s0 = __builtin_amdgcn_mfma_f32_32x32x16_bf16(b0, qr[d0], s0, 0, 0, 0); s1 = __builtin_amdgcn_mfma_f32_32x32x16_bf16(b1, qr[d0], s1, 0, 0, 0); } }
        { asm volatile("s_nop 15\n\ts_nop 7" : "+v"(s0), "+v"(s1)); const float rm0 = rowmax32(s0, s1); mhat = rm0;
#pragma unroll
          for (int rr = 0; rr < 16; ++rr) { s0[rr] -= rm0; s1[rr] -= rm0; negm[rr] = -rm0; } }
        u32x4 pw[4];
#define EXP4(X, B) do { X[B] = __builtin_amdgcn_exp2f(X[B]); X[B + 1] = __builtin_amdgcn_exp2f(X[B + 1]); X[B + 2] = __builtin_amdgcn_exp2f(X[B + 2]); X[B + 3] = __builtin_amdgcn_exp2f(X[B + 3]); sacc += X[B]; asm("" : "+v"(sacc)); sacc += X[B + 1]; asm("" : "+v"(sacc)); sacc += X[B + 2]; asm("" : "+v"(sacc)); sacc += X[B + 3]; asm("" : "+v"(sacc)); } while (0)
#define STAGE_A(t_) do { \
            lcp nxt = (lcp)(lds + (((t_) + 1) & 3) * DF_SLOT); \
            bf16x8 kf[8]; \
            _Pragma("unroll") for (int d0 = 0; d0 < 4; ++d0) { kf[2 * d0] = *(const __attribute__((address_space(3))) bf16x8*)(nxt + koff + d0 * 2048); kf[2 * d0 + 1] = *(const __attribute__((address_space(3))) bf16x8*)(nxt + koff + d0 * 2048 + 512); } \
            asm volatile("s_nop 15\n\ts_nop 7" : "+v"(s0), "+v"(s1)); \
            const float rm = rowmax32(s0, s1); \
            if (__any(rm > THRL)) { \
                const float dl = fmaxf(rm, 0.f); const float alpha = __builtin_amdgcn_exp2f(-dl); mhat += dl; lsum *= alpha; \
                if (hi == 0) wsf[r32] = alpha; \
                asm volatile("s_waitcnt lgkmcnt(0)" ::: "memory"); \
                float al[16]; \
                _Pragma("unroll") for (int r = 0; r < 16; ++r) al[r] = wsf[crow(r, hi)]; \
                _Pragma("unroll") for (int d = 0; d < 4; ++d) _Pragma("unroll") for (int r = 0; r < 16; ++r) o[d][r] *= al[r]; \
                _Pragma("unroll") for (int r = 0; r < 16; ++r) { s0[r] -= dl; s1[r] -= dl; negm[r] = -mhat; } \
            } \
            f32x16 n0, n1; float sacc = 0.f; \
            __builtin_amdgcn_sched_barrier(0); \
            n0 = __builtin_amdgcn_mfma_f32_32x32x16_bf16(kf[0], qr[0], negm, 0, 0, 0); EXP4(s0, 0);  __builtin_amdgcn_sched_barrier(0); \
            n1 = __builtin_amdgcn_mfma_f32_32x32x16_bf16(kf[1], qr[0], negm, 0, 0, 0); EXP4(s0, 4);  __builtin_amdgcn_sched_barrier(0); \
            n0 = __builtin_amdgcn_mfma_f32_32x32x16_bf16(kf[2], qr[1], n0, 0, 0, 0); EXP4(s0, 8);  __builtin_amdgcn_sched_barrier(0); \
            n1 = __builtin_amdgcn_mfma_f32_32x32x16_bf16(kf[3], qr[1], n1, 0, 0, 0); EXP4(s0, 12); __builtin_amdgcn_sched_barrier(0); \
            n0 = __builtin_amdgcn_mfma_f32_32x32x16_bf16(kf[4], qr[2], n0, 0, 0, 0); EXP4(s1, 0);  __builtin_amdgcn_sched_barrier(0); \
            n1 = __builtin_amdgcn_mfma_f32_32x32x16_bf16(kf[5], qr[2], n1, 0, 0, 0); EXP4(s1, 4);  __builtin_amdgcn_sched_barrier(0); \
            n0 = __builtin_amdgcn_mfma_f32_32x32x16_bf16(kf[6], qr[3], n0, 0, 0, 0); EXP4(s1, 8);  __builtin_amdgcn_sched_barrier(0); \
            n1 = __builtin_amdgcn_mfma_f32_32x32x16_bf16(kf[7], qr[3], n1, 0, 0, 0); EXP4(s1, 12); __builtin_amdgcn_sched_barrier(0); \
            _Pragma("unroll") for (int i = 0; i < 4; ++i) { pw[0][i] = cvtpk(s0[2 * i], s0[2 * i + 1]); pw[1][i] = cvtpk(s0[8 + 2 * i], s0[8 + 2 * i + 1]); pw[2][i] = cvtpk(s1[2 * i], s1[2 * i + 1]); pw[3][i] = cvtpk(s1[8 + 2 * i], s1[8 + 2 * i + 1]); } \
            lsum += sacc; \
            s0 = n0; s1 = n1; \
        } while (0)
#define STAGE_B(tl_) do { \
            lcp vb = (lcp)(lds + ((tl_) & 3) * DF_SLOT) + voff; \
            s16x4 va[8], vn[8]; \
            _Pragma("unroll") for (int ks = 0; ks < 4; ++ks) { va[2 * ks] = vtr(vb + ks * 1024); va[2 * ks + 1] = vtr(vb + ks * 1024 + 512); } \
            __builtin_amdgcn_sched_barrier(0); \
            _Pragma("unroll") for (int d0 = 0; d0 < 4; ++d0) { \
                _Pragma("unroll") for (int ks = 0; ks < 4; ++ks) { \
                    if (d0 < 3) { vn[2 * ks] = vtr(vb + (d0 + 1) * 4096 + ks * 1024); vn[2 * ks + 1] = vtr(vb + (d0 + 1) * 4096 + ks * 1024 + 512); } \
                    const bf16x8 vf = (bf16x8){va[2 * ks][0], va[2 * ks][1], va[2 * ks][2], va[2 * ks][3], va[2 * ks + 1][0], va[2 * ks + 1][1], va[2 * ks + 1][2], va[2 * ks + 1][3]}; \
                    o[d0] = __builtin_amdgcn_mfma_f32_32x32x16_bf16(__builtin_bit_cast(bf16x8, pw[ks]), vf, o[d0], 0, 0, 0); \
                    __builtin_amdgcn_sched_barrier(0); \
                } \
                _Pragma("unroll") for (int i = 0; i < 8; ++i) va[i] = vn[i]; \
            } \
        } while (0)
        for (int t = 0; t < NKT; ++t) {
            if (t > 0) { asm volatile("s_waitcnt vmcnt(0)" ::: "memory"); if (MODE != 3) __syncthreads(); }
            if (t + 2 < NKT) DF_DMA(t + 2, (t + 2) & 3);
            if (MODE != 2) {
                if (map == 1 && t > 0) STAGE_B(t - 1);
                STAGE_A(t);
                if (map == 0) STAGE_B(t);
            }
        }
        if (MODE != 2 && map == 1) STAGE_B(NKT - 1);
#undef STAGE_A
#undef STAGE_B
#undef EXP4
#undef DF_DMA
        float lt = lsum; { auto rr = __builtin_amdgcn_permlane32_swap(__float_as_uint(lt), __float_as_uint(lt), false, false); lt = __uint_as_float(rr[0]) + __uint_as_float(rr[1]); }
        if (hi == 0) wsf[32 + r32] = lt;
        asm volatile("s_waitcnt lgkmcnt(0)" ::: "memory");
#pragma unroll
        for (int rr = 0; rr < 16; ++rr) { const float rl = __builtin_amdgcn_rcpf(wsf[32 + crow(rr, hi)]);
#pragma unroll
            for (int d = 0; d < 4; ++d) o[d][rr] *= rl; }
        __syncthreads();
        if (map == 1) {
#pragma unroll
            for (int d = 0; d < 4; ++d)
#pragma unroll
                for (int rr = 0; rr < 16; ++rr) X[((qg * 4 + d) * 16 + rr) * 64 + lane] = o[d][rr];
        }
        __syncthreads();
        if (map == 0 && (MODE == 0 || lam == 123456.f)) {
            float ss[16];
#pragma unroll
            for (int rr = 0; rr < 16; ++rr) { float s = 0.f;
#pragma unroll
                for (int d = 0; d < 4; ++d) { const float v = o[d][rr] - lam * X[((qg * 4 + d) * 16 + rr) * 64 + lane]; o[d][rr] = v; s += v * v; }
                ss[rr] = s; }
#pragma unroll
            for (int oo = 1; oo < 32; oo <<= 1)
#pragma unroll
                for (int rr = 0; rr < 16; ++rr) ss[rr] += __shfl_xor(ss[rr], oo);
            float g[4];
#pragma unroll
            for (int d = 0; d < 4; ++d) g[d] = p.diff_subln[d * 32 + r32] * (1.f - LAMBDA_INIT);
            bf16_t* yb = Y + ((size_t)b * SEQ + q0) * D + 512 + h * 128 + r32;
#pragma unroll
            for (int rr = 0; rr < 16; ++rr) { const float rn = rsqrtf(ss[rr] * (1.f / 128.f) + EPS);
#pragma unroll
                for (int d = 0; d < 4; ++d) yb[(size_t)crow(rr, hi) * D + d * 32] = (bf16_t)f2bf(o[d][rr] * rn * g[d]); }
        }
        __syncthreads();
    }
}
}

__device__ __forceinline__ void p3_attention(Frame& F, const Params& p) {
    att::na_units(F, p);
    att::diff_units_v2<0>(F, p);
}

namespace tk {
typedef short bf16x8 __attribute__((ext_vector_type(8)));
typedef float f32x16 __attribute__((ext_vector_type(16)));
constexpr int WLK_OFF = 65536;
__device__ __forceinline__ unsigned ord(float f) { const unsigned u = __float_as_uint(f); return u ^ ((unsigned)((int)u >> 31) | 0x80000000u); }
__device__ __forceinline__ float unord(unsigned o) { return __uint_as_float(o ^ ((o & 0x80000000u) ? 0x80000000u : 0xFFFFFFFFu)); }
__device__ __forceinline__ void cs_desc(unsigned& a, unsigned& b) { const unsigned mx = a > b ? a : b, mn = a > b ? b : a; a = mx; b = mn; }
__device__ __forceinline__ void sort16_desc(unsigned (&v)[16]) {
#pragma unroll
    for (int k = 2; k <= 16; k <<= 1)
#pragma unroll
        for (int j = k >> 1; j > 0; j >>= 1)
#pragma unroll
            for (int i = 0; i < 16; ++i) { const int l = i ^ j; if (l > i) { if ((i & k) == 0 || k == 16) cs_desc(v[i], v[l]); else cs_desc(v[l], v[i]); } }
}
__device__ __forceinline__ void bmerge16_desc(unsigned (&v)[16]) {
#pragma unroll
    for (int j = 8; j > 0; j >>= 1)
#pragma unroll
        for (int i = 0; i < 16; ++i) { const int l = i ^ j; if (l > i) cs_desc(v[i], v[l]); }
}
__device__ __forceinline__ void merge_top16(unsigned (&a)[16], const unsigned (&b)[16]) {
#pragma unroll
    for (int i = 0; i < 16; ++i) a[i] = a[i] > b[15 - i] ? a[i] : b[15 - i];
    bmerge16_desc(a);
}
__device__ __forceinline__ void top16_of_64x2(unsigned (&v0)[16], unsigned (&v1)[16], unsigned (&v2)[16], unsigned (&v3)[16]) {
    sort16_desc(v0); sort16_desc(v1); sort16_desc(v2); sort16_desc(v3);
    merge_top16(v0, v1); merge_top16(v2, v3); merge_top16(v0, v2);
    unsigned pb[16];
#pragma unroll
    for (int i = 0; i < 16; ++i) pb[i] = (unsigned)__shfl_xor((int)v0[i], 32);
    merge_top16(v0, pb);
}
}

__device__ __forceinline__ void p7_topk(Frame& F, const Params& p) {
    using namespace tk;
    unsigned char* ws = p.ws;
    const bf16_t* Q2 = (const bf16_t*)(ws + WS_Q2); const unsigned char* KI = (const unsigned char*)(ws + WS_KEYSI);
    int* EX = (int*)(ws + WS_EXP); float* GT = (float*)(ws + WS_GATE); float* SUo = (float*)(ws + WS_SU);
    const float* USC = (const float*)(ws + WS_USC); const float* VSC = (const float*)(ws + WS_VSC);
    const int lane = F.lane, r32 = lane & 31, hi = lane >> 5, wave = F.wave;
    att::lp lds = (att::lp)F.lds;
    LAS int* W = (LAS int*)(F.lds + WLK_OFF + wave * 8192);
    const int ntask = 1024 / F.G;
    const int h = F.bid & 7;
    { const unsigned char* src = KI + (size_t)h * 65536;
      for (int k = 0; k < 8; ++k) { const int pi = wave + 8 * k; att::dma16(src + pi * 1024 + lane * 16, lds + pi * 1024); } }
    asm volatile("s_waitcnt vmcnt(0)" ::: "memory");
    __syncthreads();
    bf16x8 qf[8], qn[8];
    { const int tb32 = ((F.bid >> 3) * ntask) * 8 + wave;
      const bf16_t* qp = Q2 + ((((size_t)tb32 * 8 + h) * 2 + 0) * 8 * 2 + hi) * 256 + r32 * 8;
#pragma unroll
      for (int s = 0; s < 8; ++s) qn[s] = *(const bf16x8*)(qp + s * 512); }
    for (int ti = 0; ti < ntask; ++ti) {
        const int tb = (F.bid >> 3) * ntask + ti;
        const int t = tb * 256 + wave * 32 + r32;
        unsigned A[16], B[16];
#pragma unroll
        for (int pp = 0; pp < 2; ++pp) {
#pragma unroll
            for (int s = 0; s < 8; ++s) qf[s] = qn[s];
            { const int nti = pp == 0 ? ti : ti + 1, npp = pp ^ 1;
              if (nti < ntask) { const int tb32 = ((F.bid >> 3) * ntask + nti) * 8 + wave;
                  const bf16_t* qp = Q2 + ((((size_t)tb32 * 8 + h) * 2 + npp) * 8 * 2 + hi) * 256 + r32 * 8;
#pragma unroll
                  for (int s = 0; s < 8; ++s) qn[s] = *(const bf16x8*)(qp + s * 512); } }
            f32x16 acc[4];
#pragma unroll
            for (int kb = 0; kb < 4; ++kb)
#pragma unroll
                for (int r = 0; r < 16; ++r) acc[kb][r] = 0.f;
            att::lcp ab = (att::lcp)(lds + pp * 32768 + hi * 2048 + r32 * 16);
#pragma unroll
            for (int s = 0; s < 8; ++s)
#pragma unroll
                for (int kb = 0; kb < 4; ++kb) {
                    const bf16x8 a = *(const __attribute__((address_space(3))) bf16x8*)(ab + s * 4096 + kb * 512);
                    acc[kb] = __builtin_amdgcn_mfma_f32_32x32x16_bf16(a, qf[s], acc[kb], 0, 0, 0);
                }
            unsigned v0[16], v1[16], v2[16], v3[16];
#pragma unroll
            for (int r = 0; r < 16; ++r) {
                const int c = 127 - ((r & 3) + 8 * (r >> 2));
                v0[r] = (ord(acc[0][r]) & 0xFFFFFF80u) | (unsigned)(c - 0 - 4 * hi);
                v1[r] = (ord(acc[1][r]) & 0xFFFFFF80u) | (unsigned)(c - 32 - 4 * hi);
                v2[r] = (ord(acc[2][r]) & 0xFFFFFF80u) | (unsigned)(c - 64 - 4 * hi);
                v3[r] = (ord(acc[3][r]) & 0xFFFFFF80u) | (unsigned)(c - 96 - 4 * hi);
            }
            top16_of_64x2(v0, v1, v2, v3);
            if (pp == 0) {
#pragma unroll
                for (int i = 0; i < 16; ++i) A[i] = v0[i];
            } else {
#pragma unroll
                for (int i = 0; i < 16; ++i) B[i] = v0[i];
            }
        }
        float fa[16], fb[16];
#pragma unroll
        for (int i = 0; i < 16; ++i) { fa[i] = unord(A[i] & 0xFFFFFF80u); fb[i] = unord(B[i] & 0xFFFFFF80u);
            W[i * 64 + lane] = 127 - (int)(A[i] & 127u); W[(16 + i) * 64 + lane] = 127 - (int)(B[i] & 127u); }
        unsigned c0[16], c1[16], c2[16], c3[16];
#pragma unroll
        for (int j = 0; j < 16; ++j) c0[j] = (ord(fa[0] + fb[j]) & 0xFFFFFF00u) | (unsigned)(255 - j);
        {
            int n = 0;
#pragma unroll
            for (int i = 1; i < 16; ++i)
#pragma unroll
                for (int j = 0; j < 16; ++j) if ((i + 1) * (j + 1) <= 16) {
                    const unsigned key = (ord(fa[i] + fb[j]) & 0xFFFFFF00u) | (unsigned)(255 - (i * 16 + j));
                    if (n < 16) c1[n] = key; else if (n < 32) c2[n - 16] = key; else c3[n - 32] = key;
                    ++n;
                }
#pragma unroll
            for (int k = 2; k < 16; ++k) c3[k] = 0u;
        }
        sort16_desc(c1); sort16_desc(c2); sort16_desc(c3);
        merge_top16(c0, c1); merge_top16(c2, c3); merge_top16(c0, c2);
        float ev[16]; float l = 0.f; const float mx = unord(c0[0] & 0xFFFFFF00u);
#pragma unroll
        for (int k = 0; k < 16; ++k) { ev[k] = __expf(unord(c0[k] & 0xFFFFFF00u) - mx); l += ev[k]; }
        const float rl = 1.f / l;
        unsigned pk[8];
#pragma unroll
        for (int kk = 0; kk < 8; ++kk) {
            const unsigned key = hi ? c0[8 + kk] : c0[kk]; const float e = hi ? ev[8 + kk] : ev[kk];
            const int pos = 255 - (int)(key & 255u);
            const int ex = W[(pos >> 4) * 64 + lane] * 128 + W[(16 + (pos & 15)) * 64 + lane];
            pk[kk] = ((unsigned)ex << 16) | (unsigned)f2bf(e * rl * VSC[ex]);
        }
        int* ep = EX + (size_t)t * 128 + h * 16 + hi * 8;
        *(u32x4*)ep = (u32x4){pk[0], pk[1], pk[2], pk[3]}; *(u32x4*)(ep + 4) = (u32x4){pk[4], pk[5], pk[6], pk[7]};
    }
    __syncthreads();
}

#define P8_SYNC 0
#define P8_PARTITION 0
#define HAVE_P3 1
#define HAVE_P7 1
struct Args { Params p; int ph_lo, ph_hi, li, pad; };
__global__ void __launch_bounds__(NTHR, 2) mk_fwd(Args a) {
    extern __shared__ __attribute__((aligned(16))) unsigned char lds[];
    Frame F;
    F.lds = (LAS unsigned char*)lds;
    F.MISC = (volatile LAS unsigned*)(F.lds + MISC_OFF);
    F.tid = threadIdx.x; F.lane = F.tid & 63; F.wave = __builtin_amdgcn_readfirstlane(F.tid >> 6);
    F.G = gridDim.x; F.bid = blockIdx.x;
    const Params& p = a.p;
    gu32* ctl = (gu32*)(p.ws + WS_CTL);
    for (int u = F.tid; u < 128; u += NTHR) ((LAS unsigned*)(F.lds + MISC_OFF))[u] = 0u;
    __syncthreads();
    XcdBarrier bar = xcd_barrier_post((unsigned*)(ctl + CW_BAR) + a.li * XCD_BAR_WORDS, F.MISC + 8);
    const int lo = a.ph_lo, hi = a.ph_hi;
#ifdef PROBE_TS
    int nts_ = 0;
#define STAMP() do { if (threadIdx.x == 0 && nts_ < 12) { const unsigned long long t_ = __builtin_amdgcn_s_memrealtime(); F.MISC[32 + 2 * nts_] = (unsigned)t_; F.MISC[33 + 2 * nts_] = (unsigned)(t_ >> 32); } ++nts_; } while (0)
    STAMP();
#else
#define STAMP() do {} while (0)
#endif
#define IN(k) (lo <= (k) && (k) < hi)
#define REFRESH() do { F.lane = (int)__builtin_amdgcn_mbcnt_hi(~0u, __builtin_amdgcn_mbcnt_lo(~0u, 0u)); F.tid = F.wave * 64 + F.lane; } while (0)
#define SEAM(k) do { if (IN(k) && IN((k) + 1)) xcd_barrier(bar); STAMP(); } while (0)

#ifndef PROBE_DUP
#define PROBE_DUP -1
#endif
#define REP(k) for (int rep_ = 0; rep_ < (PROBE_DUP == (k) ? 2 : 1); ++rep_)
    if (IN(0)) { REP(0) p0_prologue(F, p); SEAM(0); }
    if (IN(1)) { REP(1) { p1_hrows(F, p); __syncthreads(); } SEAM(1); }
    if (IN(2)) {
        pg8::Gemm g{(const bf16_t*)(p.ws + WS_H), (const bf16_t*)(p.ws + WS_WIN), MALL, NQKV, D}; pg8::StaticOrder S; S.init(MALL, NQKV, F.G, F.bid);
        EpiQKVFast E{p.ws};
        REP(2) pg8::gemm_phase<EpiQKVFast, pg8::StaticOrder, true, true>(F.lds + RING_OFF, g, S, E);
        SEAM(2);
    }
#if HAVE_P3
    if (IN(3)) { REP(31) att::na_units(F, p); att::diff_units_v2<0>(F, p);
#if PROBE_DUP == 321
        att::diff_units_v2<1>(F, p);
#elif PROBE_DUP == 323
        att::diff_units_v2<3>(F, p);
#elif PROBE_DUP == 322
        att::diff_units_v2<2>(F, p);
#elif PROBE_DUP == 32
        att::diff_units_v2<0>(F, p);
#endif
        SEAM(3); }
#endif
    if (IN(4)) {
        pg8::Gemm g{(const bf16_t*)(p.ws + WS_Y), (const bf16_t*)(p.ws + WS_WOUT), MLAT, D, D}; pg8::StaticOrder S; S.init(MLAT, D, F.G, F.bid);
        pg8::EpiBf16<0> E{(bf16_t*)(p.ws + WS_YO), D, nullptr, 0, 0, 1.f};
        REP(4) pg8::gemm_phase<pg8::EpiBf16<0>, pg8::StaticOrder, true, true>(F.lds + RING_OFF, g, S, E);
        SEAM(4);
    }
    if (IN(5)) { REP(5) p5_rows2(F, p); SEAM(5); }
    if (IN(6)) {
        pg8::Gemm g{(const bf16_t*)(p.ws + WS_H2), (const bf16_t*)(p.ws + WS_WPQ), MLAT, 2048, D}; pg8::StaticOrder S; S.init(MLAT, 2048, F.G, F.bid);
        EpiQ2Frag E{(bf16_t*)(p.ws + WS_Q2)};
        REP(6) pg8::gemm_phase<EpiQ2Frag, pg8::StaticOrder, true, true>(F.lds + RING_OFF, g, S, E);
        SEAM(6);
    }
#if HAVE_P7
    if (IN(7)) { REP(7) p7_topk(F, p); SEAM(7); }
#endif
#if P8_PARTITION
    if (IN(8)) {
        p7b_sort(F, p); xcd_barrier(bar);
        for (int ch = 0; ch < 2; ++ch) { p8a_part(F, p, ch); xcd_barrier(bar); p8b_combine(F, p, ch); if (ch == 0) xcd_barrier(bar); }
    }
#else
    if (IN(8)) {
#if PROBE_DUP == 81
        p8_gather<1>(F, p, bar);
#elif PROBE_DUP == 82
        p8_gather<2>(F, p, bar);
#elif PROBE_DUP == 83
        p8_gather<3>(F, p, bar);
#elif PROBE_DUP == 84
        p8_gather<4>(F, p, bar);
#endif
        p8_gather<0>(F, p, bar); }
#endif
#ifdef PROBE_TS
#ifdef PROBE_TS_ENDBAR
    xcd_barrier(bar);
#endif
    STAMP();
    if (blockIdx.x == 0 && threadIdx.x == 0) { const unsigned long long t1_ = ((unsigned long long)F.MISC[33 + 2 * (PROBE_TS + 1)] << 32) | F.MISC[32 + 2 * (PROBE_TS + 1)], t0_ = ((unsigned long long)F.MISC[33 + 2 * PROBE_TS] << 32) | F.MISC[32 + 2 * PROBE_TS];
        const unsigned long long dt = t1_ - t0_; const unsigned long long t_end = __builtin_amdgcn_s_memrealtime();
        while (__builtin_amdgcn_s_memrealtime() - t_end < 8ull * dt) __builtin_amdgcn_s_sleep(8); }
#endif
#undef IN
#undef SEAM
}

static void launch_mk(const Params& p, int lo, int hi, int li, hipStream_t stream) {
    Args a{}; a.p = p; a.ph_lo = lo; a.ph_hi = hi; a.li = li; a.pad = 0;
    hipLaunchKernelGGL(mk_fwd, dim3(256), dim3(NTHR), LDS_BYTES, stream, a);
}
extern "C" void kernel_launch(void* const* d_in, const int* in_sizes, int n_in, void* d_out, int out_size, void* d_ws, size_t ws_size, hipStream_t stream) {
    if (n_in != 16 || ws_size < WS_END) return;
    static bool attr_done = false;
    if (!attr_done) {
        (void)hipFuncSetAttribute((const void*)mk_fwd, hipFuncAttributeMaxDynamicSharedMemorySize, LDS_BYTES);
        attr_done = true;
    }
    Params p{};
    p.x = (const float*)d_in[0]; p.c = (const float*)d_in[1]; p.ctx = (const float*)d_in[2]; p.c_ctx = (const float*)d_in[3];
    p.w_ada = (const float*)d_in[4]; p.b_ada = (const float*)d_in[5]; p.g_norm = (const float*)d_in[6]; p.w_in = (const float*)d_in[7];
    p.rel_bias = (const float*)d_in[8]; p.diff_lambda = (const float*)d_in[9]; p.diff_subln = (const float*)d_in[10]; p.w_out = (const float*)d_in[11];
    p.peer_wq = (const float*)d_in[12]; p.peer_keys = (const float*)d_in[13]; p.peer_u = (const float*)d_in[14]; p.peer_v = (const float*)d_in[15];
    p.out = (float*)d_out; p.ws = (unsigned char*)d_ws;
    (void)hipMemsetAsync((char*)d_ws + WS_CTL, 0, CTL_ZERO_BYTES, stream);

    launch_mk(p, 0, 9, 0, stream);

}
```

```cpp
#include <hip/hip_runtime.h>
#include <stdint.h>
#include <math.h>

typedef unsigned short bf16_t;
typedef float f32x4 __attribute__((ext_vector_type(4)));
typedef unsigned u32x4 __attribute__((ext_vector_type(4)));
typedef unsigned u32x2 __attribute__((ext_vector_type(2)));
typedef float f32x2 __attribute__((ext_vector_type(2)));

constexpr int D = 1024, BATCH = 8, SEQ = 4096, CTX = 256, GW = 64;
constexpr int MLAT = BATCH * SEQ;
constexpr int MCTX = BATCH * CTX;
constexpr int MALL = MLAT + MCTX;
constexpr int NQKV = 3072;
constexpr int NKT = 68;
constexpr int NMOD = 6 * D;
constexpr int PE_H = 8, PE_NK = 128, PE_QD = 256, PE_TOPK = 16, PE_NEXP = 16384;
constexpr float EPS = 1e-6f;
constexpr float LOG2E = 1.4426950408889634f;
constexpr float C2 = 0.125f * LOG2E;
constexpr float LAMBDA_INIT = 0.2f;
constexpr float NEG_BIG = -30000.0f;

constexpr size_t MiB = 1u << 20;
constexpr size_t WS_CTL = 0;
constexpr size_t WS_MOD = 1 * MiB;
constexpr size_t WS_LAM = 1 * MiB + 256 * 1024;
constexpr size_t WS_ROPE = 1 * MiB + 512 * 1024;
constexpr size_t WS_USC = 1 * MiB + 640 * 1024;
constexpr size_t WS_VSC = 1 * MiB + 704 * 1024;
constexpr size_t WS_MODP = 2 * MiB;
constexpr size_t WS_BIAST = 4 * MiB;
constexpr size_t WS_KEYS = 5 * MiB;
constexpr size_t WS_KEYSI = 5 * MiB + 512 * 1024;
constexpr size_t WS_WIN = 6 * MiB;
constexpr size_t WS_WOUT = 12 * MiB;
constexpr size_t WS_WPQ = 14 * MiB;
constexpr size_t WS_UB = 18 * MiB;
constexpr size_t WS_VB = 50 * MiB;
constexpr size_t WS_EXP = 82 * MiB;
constexpr size_t WS_GATE = 98 * MiB;
constexpr size_t WS_XB = 114 * MiB;
constexpr size_t WS_H2 = 178 * MiB;
constexpr size_t WS_H = 178 * MiB;
constexpr size_t WS_Y = 178 * MiB;
constexpr size_t WS_QA = 246 * MiB;
constexpr size_t WS_KA = 278 * MiB;
constexpr size_t WS_VA = 312 * MiB;
constexpr size_t WS_QD = 346 * MiB;
constexpr size_t WS_KD = 378 * MiB;
constexpr size_t WS_VD = 412 * MiB;
constexpr size_t WS_YO = 246 * MiB;
constexpr size_t WS_Q2 = 310 * MiB;
constexpr size_t WS_PART = 178 * MiB;
constexpr size_t WS_DSCR = 464 * MiB;
constexpr size_t WS_SU = 446 * MiB;
constexpr size_t WS_END = 496 * MiB;

struct Params {
    const float *x, *c, *ctx, *c_ctx, *w_ada, *b_ada, *g_norm, *w_in, *rel_bias, *diff_lambda, *diff_subln, *w_out, *peer_wq, *peer_keys, *peer_u, *peer_v;
    float* out;
    unsigned char* ws;
};

__device__ __forceinline__ unsigned f2bf(float f) { unsigned u = __builtin_bit_cast(unsigned, f); return (u + 0x7fffu + ((u >> 16) & 1u)) >> 16; }
__device__ __forceinline__ unsigned pk2(float lo, float hi) { return f2bf(lo) | (f2bf(hi) << 16); }
__device__ __forceinline__ float bf2f(bf16_t h) { return __builtin_bit_cast(float, (unsigned)h << 16); }
__device__ __forceinline__ float bflo(unsigned w) { return __builtin_bit_cast(float, w << 16); }
__device__ __forceinline__ float bfhi(unsigned w) { return __builtin_bit_cast(float, w & 0xffff0000u); }
__device__ __forceinline__ float wave_sum(float v) {
    v += __uint_as_float((unsigned)__builtin_amdgcn_update_dpp(0, (int)__float_as_uint(v), 0xB1, 0xf, 0xf, false));
    v += __uint_as_float((unsigned)__builtin_amdgcn_update_dpp(0, (int)__float_as_uint(v), 0x4E, 0xf, 0xf, false));
    v += __uint_as_float((unsigned)__builtin_amdgcn_update_dpp(0, (int)__float_as_uint(v), 0x141, 0xf, 0xf, false));
    v += __uint_as_float((unsigned)__builtin_amdgcn_update_dpp(0, (int)__float_as_uint(v), 0x128, 0xf, 0xf, false));
    { auto r = __builtin_amdgcn_permlane16_swap(__float_as_uint(v), __float_as_uint(v), false, false); v = __uint_as_float(r[0]) + __uint_as_float(r[1]); }
    { auto r = __builtin_amdgcn_permlane32_swap(__float_as_uint(v), __float_as_uint(v), false, false); v = __uint_as_float(r[0]) + __uint_as_float(r[1]); }
    return v;
}
__device__ __forceinline__ float wave_max(float v) {
    v = fmaxf(v, __uint_as_float((unsigned)__builtin_amdgcn_update_dpp(0, (int)__float_as_uint(v), 0xB1, 0xf, 0xf, false)));
    v = fmaxf(v, __uint_as_float((unsigned)__builtin_amdgcn_update_dpp(0, (int)__float_as_uint(v), 0x4E, 0xf, 0xf, false)));
    v = fmaxf(v, __uint_as_float((unsigned)__builtin_amdgcn_update_dpp(0, (int)__float_as_uint(v), 0x141, 0xf, 0xf, false)));
    v = fmaxf(v, __uint_as_float((unsigned)__builtin_amdgcn_update_dpp(0, (int)__float_as_uint(v), 0x128, 0xf, 0xf, false)));
    { auto r = __builtin_amdgcn_permlane16_swap(__float_as_uint(v), __float_as_uint(v), false, false); v = fmaxf(__uint_as_float(r[0]), __uint_as_float(r[1])); }
    { auto r = __builtin_amdgcn_permlane32_swap(__float_as_uint(v), __float_as_uint(v), false, false); v = fmaxf(__uint_as_float(r[0]), __uint_as_float(r[1])); }
    return v;
}

__device__ __forceinline__ float half_max(float v) {
    v = fmaxf(v, __uint_as_float((unsigned)__builtin_amdgcn_update_dpp(0, (int)__float_as_uint(v), 0xB1, 0xf, 0xf, false)));
    v = fmaxf(v, __uint_as_float((unsigned)__builtin_amdgcn_update_dpp(0, (int)__float_as_uint(v), 0x4E, 0xf, 0xf, false)));
    v = fmaxf(v, __uint_as_float((unsigned)__builtin_amdgcn_update_dpp(0, (int)__float_as_uint(v), 0x141, 0xf, 0xf, false)));
    v = fmaxf(v, __uint_as_float((unsigned)__builtin_amdgcn_update_dpp(0, (int)__float_as_uint(v), 0x128, 0xf, 0xf, false)));
    { auto r = __builtin_amdgcn_permlane16_swap(__float_as_uint(v), __float_as_uint(v), false, false); v = fmaxf(__uint_as_float(r[0]), __uint_as_float(r[1])); }
    return v;
}
__device__ __forceinline__ float half_sum(float v) {
    v += __uint_as_float((unsigned)__builtin_amdgcn_update_dpp(0, (int)__float_as_uint(v), 0xB1, 0xf, 0xf, false));
    v += __uint_as_float((unsigned)__builtin_amdgcn_update_dpp(0, (int)__float_as_uint(v), 0x4E, 0xf, 0xf, false));
    v += __uint_as_float((unsigned)__builtin_amdgcn_update_dpp(0, (int)__float_as_uint(v), 0x141, 0xf, 0xf, false));
    v += __uint_as_float((unsigned)__builtin_amdgcn_update_dpp(0, (int)__float_as_uint(v), 0x128, 0xf, 0xf, false));
    { auto r = __builtin_amdgcn_permlane16_swap(__float_as_uint(v), __float_as_uint(v), false, false); v = __uint_as_float(r[0]) + __uint_as_float(r[1]); }
    return v;
}
typedef float f32x16 __attribute__((ext_vector_type(16)));
typedef float f32x32 __attribute__((ext_vector_type(32)));
typedef unsigned u32x6 __attribute__((ext_vector_type(6)));


typedef short hs16x4 __attribute__((ext_vector_type(4)));
typedef __bf16 hbf16x2 __attribute__((ext_vector_type(2)));

typedef unsigned u32x16 __attribute__((ext_vector_type(16)));

#ifndef PROBE_DUP
#define PROBE_DUP -1
#endif

constexpr int NCTXWG = 64;

__device__ __forceinline__ int ktile_off(int k, int d) { return (d >> 3) * 512 + k * 8 + (d & 7); }
__device__ __forceinline__ int vtile_off(int k, int d) { return (d >> 5) * 2048 + (k >> 4) * 512 + (k & 15) * 32 + (d & 31); }
__device__ __forceinline__ size_t qa_idx(int b, int h, int t, int d) { return ((size_t)(b * 8 + h) * SEQ + t) * 64 + d; }
__device__ __forceinline__ size_t ka_idx(int b, int h, int j, int d) { return ((size_t)(b * 8 + h) * NKT + (j >> 6)) * 4096 + ktile_off(j & 63, d); }
__device__ __forceinline__ size_t va_idx(int b, int h, int j, int d) { return ((size_t)(b * 8 + h) * NKT + (j >> 6)) * 4096 + vtile_off(j & 63, d); }
__device__ __forceinline__ size_t qd_idx(int b, int m, int h, int t, int d) { return ((size_t)((b * 2 + m) * 4 + h) * SEQ + t) * 64 + d; }
__device__ __forceinline__ size_t kd_idx(int b, int m, int h, int j, int d) { return ((size_t)((b * 2 + m) * 4 + h) * NKT + (j >> 6)) * 4096 + ktile_off(j & 63, d); }
__device__ __forceinline__ size_t vd_idx(int b, int h, int j, int d) { return ((size_t)(b * 4 + h) * NKT + (j >> 6)) * 8192 + vtile_off(j & 63, d); }


namespace pg8 {
#define PG8_LAS __attribute__((address_space(3)))
typedef unsigned short bf16_t;
typedef short bf16x8 __attribute__((ext_vector_type(8)));
typedef float f32x4 __attribute__((ext_vector_type(4)));
typedef unsigned u32x4 __attribute__((ext_vector_type(4)));
constexpr int BM = 256, BK = 64, HALF = 128, HTB = HALF * BK * 2  , STAGE_BYTES = 8 * HTB, NXCD = 8, WGM = 8;

__host__ __device__ __forceinline__ int lds_byte(int r, int c) { const int st = (r >> 4) * 2 + (c >> 5), rr = r & 15, cc = c & 31, ob = rr * 64 + cc * 2; return st * 1024 + (ob ^ (((ob >> 9) & 1) << 5)); }
__host__ __device__ __forceinline__ void stage_rc(int b, int& R, int& C) { const int st = b / 1024, sb = b % 1024, swz = sb ^ (((sb >> 9) & 1) << 5); R = (st >> 1) * 16 + swz / 64; C = (st & 1) * 32 + (swz % 64) / 2; }
__host__ __device__ __forceinline__ int perm32(int rho) { const int n = rho >> 4, i = rho & 15; return 8 * (i >> 2) + 4 * n + (i & 3); }

struct Unit { int pm, pn; };
struct Gemm { const bf16_t* A; const bf16_t* Bt; int M, N, K; };

struct StaticOrder {
    int nM, nN, nwg, G, c;
    __host__ __device__ void init(int M, int N, int G_, int c_) { nM = M / BM; nN = N / BM; nwg = nM * nN; G = G_; c = c_; }
    __host__ __device__ bool next(int i, Unit& u) const {
        const long L = (long)i * G + c; if (L >= nwg) return false;
        int wgid = (int)L; { const int q = nwg / NXCD, r = nwg % NXCD, xcd = wgid % NXCD, off = wgid / NXCD; wgid = (xcd < r ? xcd * (q + 1) : r * (q + 1) + (xcd - r) * q) + off; }
        const int nig = WGM * nN, gid = wgid / nig, fm = gid * WGM, gsz = (nM - fm) < WGM ? (nM - fm) : WGM;
        u.pm = fm + ((wgid % nig) % gsz); u.pn = (wgid % nig) / gsz; return true;
    }
    __device__ __forceinline__ void a_ready(const Unit&) const {}
    __device__ __forceinline__ void done(const Unit&) const {}
};

__device__ __forceinline__ unsigned cvt_pk_bf16(float lo, float hi) { unsigned r; asm volatile("v_cvt_pk_bf16_f32 %0, %1, %2" : "=v"(r) : "v"(lo), "v"(hi)); return r; }
typedef float f32x2 __attribute__((ext_vector_type(2)));
__device__ __forceinline__ f32x2 gelu_pk(f32x2 v) {
    const f32x2 av = __builtin_elementwise_abs(v), d = av * 0.2316418882f + 1.0f;
    f32x2 t; t.x = __builtin_amdgcn_rcpf(d.x); t.y = __builtin_amdgcn_rcpf(d.y);
    f32x2 q = t * 0.5307027145f + (-0.7265760135f); q = q * t + 0.7107068705f; q = q * t + (-0.142248368f); q = q * t + 0.127414796f; q = q * t;
    const f32x2 s = (v * v) * (-0.72134752044f);
    f32x2 e; e.x = __builtin_amdgcn_exp2f(s.x); e.y = __builtin_amdgcn_exp2f(s.y);
    const f32x2 m = v * (q * e), r = v - m;
    f32x2 o; o.x = v.x < 0.f ? m.x : r.x; o.y = v.y < 0.f ? m.y : r.y; return o;
}

template <int ACT  > struct EpiBf16 {
    static constexpr bool PERM = true, AFTER_DRAIN = false; static_assert(ACT == 0 || ACT == 1, "EpiBf16: ACT is 0 (none) or 1 (gelu_pk)");
    bf16_t* O; int ldc; const float* bias; int split_cols; size_t split_stride; float scale0;
    __device__ __forceinline__ void operator()(const f32x4 (&acc)[2][2][4][2], const Unit& u, int wr, int wc, int fr, int fq) const {
        const int row0 = u.pm * BM + wr * 64 + fr; int colt = u.pn * BM; bf16_t* base = O;
        float sc = 1.f; if (split_cols) { const int t = colt / split_cols; base += (size_t)t * split_stride; colt -= t * split_cols; if (t == 0) sc = scale0; }
        const int col0 = colt + wc * 32 + 8 * fq, bcol0 = u.pn * BM + wc * 32 + 8 * fq;
        f32x4 bv[2][2];
#pragma unroll
        for (int bj = 0; bj < 2; ++bj)
#pragma unroll
            for (int n = 0; n < 2; ++n) bv[bj][n] = bias ? *(const f32x4*)(bias + bcol0 + bj * HALF + 4 * n) : (f32x4){0.f, 0.f, 0.f, 0.f};
#pragma unroll
        for (int ai = 0; ai < 2; ++ai)
#pragma unroll
            for (int m = 0; m < 4; ++m) { bf16_t* rowp = base + (size_t)(row0 + ai * HALF + m * 16) * ldc + col0;
#pragma unroll
                for (int bj = 0; bj < 2; ++bj) { f32x4 v0 = acc[ai][bj][m][0] + bv[bj][0], v1 = acc[ai][bj][m][1] + bv[bj][1];
                    if (ACT == 1) { f32x2 a = gelu_pk((f32x2){v0[0], v0[1]}), b = gelu_pk((f32x2){v0[2], v0[3]}), c = gelu_pk((f32x2){v1[0], v1[1]}), d = gelu_pk((f32x2){v1[2], v1[3]});
                        v0 = (f32x4){a.x, a.y, b.x, b.y}; v1 = (f32x4){c.x, c.y, d.x, d.y}; }
                    v0 = v0 * sc; v1 = v1 * sc; u32x4 w; w.x = cvt_pk_bf16(v0[0], v0[1]); w.y = cvt_pk_bf16(v0[2], v0[3]); w.z = cvt_pk_bf16(v1[0], v1[1]); w.w = cvt_pk_bf16(v1[2], v1[3]);
                    *(u32x4*)(rowp + bj * HALF) = w; } }
    }
};

template <class Epi, class Sched, bool ALIGN_EPI = false, bool SP2 = false>
__device__ __forceinline__ void gemm_phase(PG8_LAS unsigned char* lds, const Gemm g, const Sched& S, const Epi& E) {
    const int tid = threadIdx.x, wid = __builtin_amdgcn_readfirstlane(tid >> 6), lane = tid & 63, wr = wid >> 2, wc = wid & 3, fr = lane & 15, fq = lane >> 4;
    const int K = g.K, nt = K / BK;
    unsigned voffA[2], voffB[2];
#pragma unroll
    for (int i = 0; i < 2; ++i) { int R, C; stage_rc(tid * 16 + i * 8192, R, C); const int Rb = Epi::PERM ? ((R & ~31) + perm32(R & 31)) : R;
        voffA[i] = (unsigned)(R * K + C) * 2u; voffB[i] = (unsigned)(Rb * K + C) * 2u; }
    const size_t kstep = (size_t)(BK * 2);
    const size_t hstep = (size_t)HALF * K * 2;
    const size_t tstep = 2 * hstep;
    const unsigned ldsw = (unsigned)wid * 1024u;
    const int aoff = lds_byte(wr * 64 + fr, fq * 8), boff = lds_byte(wc * 32 + fr, fq * 8);
#define PG8_SA(b, h) (((b) * 2 + (h)) * HTB)
#define PG8_SB(b, h) ((4 + (b) * 2 + (h)) * HTB)
#define PG8_STAGE(bufoff, gbase, voff) do { _Pragma("unroll") for (int _i = 0; _i < 2; ++_i) \
        __builtin_amdgcn_global_load_lds((const unsigned*)((const char*)(gbase) + (voff)[_i]), (PG8_LAS unsigned*)(lds + (bufoff) + ldsw + _i * 8192), 16, 0, 0); } while (0)
#define PG8_LDA(dst, b, h) do { _Pragma("unroll") for (int m = 0; m < 4; ++m) _Pragma("unroll") for (int k = 0; k < 2; ++k) dst[m][k] = *(const PG8_LAS bf16x8*)(lds + PG8_SA(b, h) + aoff + m * 2048 + k * 1024); } while (0)
#define PG8_LDB(dst, b, h) do { _Pragma("unroll") for (int n = 0; n < 2; ++n) _Pragma("unroll") for (int k = 0; k < 2; ++k) dst[n][k] = *(const PG8_LAS bf16x8*)(lds + PG8_SB(b, h) + boff + n * 2048 + k * 1024); } while (0)
#define PG8_MMA(ai, bj, At, Bt) do { __builtin_amdgcn_s_setprio(1); _Pragma("unroll") for (int m = 0; m < 4; ++m) _Pragma("unroll") for (int n = 0; n < 2; ++n) _Pragma("unroll") for (int k = 0; k < 2; ++k) \
        acc[ai][bj][m][n] = __builtin_amdgcn_mfma_f32_16x16x32_bf16(Bt[n][k], At[m][k], acc[ai][bj][m][n], 0, 0, 0); __builtin_amdgcn_s_setprio(0); } while (0)
#define PG8_WAIT_V(n) asm volatile("s_waitcnt vmcnt(" #n ")" ::: "memory")
#define PG8_WAIT_L(n) asm volatile("s_waitcnt lgkmcnt(" #n ")" ::: "memory")
#define PG8_BAR __builtin_amdgcn_s_barrier()
#define PG8_SCHED __builtin_amdgcn_sched_barrier(0)
    Unit cur, nxt; int ui = 0;
    if (!S.next(0, cur)) return;
    f32x4 acc[2][2][4][2];
#pragma unroll
    for (int a = 0; a < 2; ++a)
#pragma unroll
        for (int b = 0; b < 2; ++b)
#pragma unroll
            for (int m = 0; m < 4; ++m)
#pragma unroll
                for (int n = 0; n < 2; ++n) acc[a][b][m][n] = (f32x4){0.f, 0.f, 0.f, 0.f};
    bf16x8 At[4][2], B0[2][2], B1[2][2];
    const char* cA = (const char*)g.A + (size_t)cur.pm * tstep; const char* cB = (const char*)g.Bt + (size_t)cur.pn * tstep;
    S.a_ready(cur);
    if constexpr (SP2) {
        PG8_STAGE(PG8_SB(0, 0), cB, voffB); PG8_STAGE(PG8_SB(0, 1), cB + hstep, voffB); PG8_STAGE(PG8_SA(0, 0), cA, voffA); PG8_STAGE(PG8_SA(0, 1), cA + hstep, voffA);
        if (wr == 1) PG8_BAR;
        PG8_WAIT_V(2); PG8_BAR;
        PG8_STAGE(PG8_SB(1, 0), cB + kstep, voffB); PG8_STAGE(PG8_SA(1, 0), cA + kstep, voffA); PG8_STAGE(PG8_SB(1, 1), cB + hstep + kstep, voffB);
        PG8_WAIT_V(6); PG8_BAR;
    } else {
        PG8_STAGE(PG8_SB(0, 0), cB, voffB); PG8_STAGE(PG8_SA(0, 0), cA, voffA); PG8_STAGE(PG8_SB(0, 1), cB + hstep, voffB); PG8_STAGE(PG8_SA(0, 1), cA + hstep, voffA);
        if (wr == 1) PG8_BAR;
        PG8_WAIT_V(4); PG8_BAR;
        PG8_STAGE(PG8_SB(1, 0), cB + kstep, voffB); PG8_STAGE(PG8_SA(1, 0), cA + kstep, voffA); PG8_STAGE(PG8_SB(1, 1), cB + hstep + kstep, voffB);
        PG8_WAIT_V(6); PG8_BAR;
    }
    for (;;) {
        const bool has_next = S.next(ui + 1, nxt);
        const char* nA = has_next ? (const char*)g.A + (size_t)nxt.pm * tstep : cA; const char* nB = has_next ? (const char*)g.Bt + (size_t)nxt.pn * tstep : cB;
        for (int t = 0; t < nt; t += 2) {
            const bool last = (t == nt - 2);
            const char* a1 = cA + (size_t)(t + 1) * kstep;
            const char* a2 = last ? nA : cA + (size_t)(t + 2) * kstep; const char* b2 = last ? nB : cB + (size_t)(t + 2) * kstep;
            const char* a3 = a2 + kstep; const char* b3 = b2 + kstep;
            if (last && has_next) S.a_ready(nxt);
            if constexpr (SP2) {
            PG8_LDB(B0, 0, 0); PG8_LDB(B1, 0, 1); PG8_SCHED; PG8_LDA(At, 0, 0); PG8_STAGE(PG8_SA(1, 1), a1 + hstep, voffA);
            PG8_WAIT_V(8); PG8_WAIT_L(0); PG8_BAR; PG8_MMA(0, 0, At, B0); PG8_MMA(0, 1, At, B1); PG8_BAR; PG8_SCHED;
            PG8_LDA(At, 0, 1); PG8_STAGE(PG8_SB(0, 0), b2, voffB); PG8_STAGE(PG8_SB(0, 1), b2 + hstep, voffB); PG8_STAGE(PG8_SA(0, 0), a2, voffA);
            PG8_WAIT_V(8); PG8_WAIT_L(0); PG8_BAR; PG8_MMA(1, 0, At, B0); PG8_MMA(1, 1, At, B1); PG8_BAR; PG8_SCHED;
            PG8_LDB(B0, 1, 0); PG8_LDB(B1, 1, 1); PG8_SCHED; PG8_LDA(At, 1, 0); PG8_STAGE(PG8_SA(0, 1), a2 + hstep, voffA);
            PG8_WAIT_V(8); PG8_WAIT_L(0); PG8_BAR; PG8_MMA(0, 0, At, B0); PG8_MMA(0, 1, At, B1); PG8_BAR; PG8_SCHED;
            PG8_LDA(At, 1, 1); PG8_STAGE(PG8_SB(1, 0), b3, voffB); PG8_STAGE(PG8_SB(1, 1), b3 + hstep, voffB); PG8_STAGE(PG8_SA(1, 0), a3, voffA);
            PG8_WAIT_V(8); PG8_WAIT_L(0); PG8_BAR; PG8_MMA(1, 0, At, B0); PG8_MMA(1, 1, At, B1); PG8_BAR; PG8_SCHED;
            } else {
            PG8_LDB(B0, 0, 0); PG8_SCHED; PG8_LDA(At, 0, 0); PG8_STAGE(PG8_SA(1, 1), a1 + hstep, voffA);
            PG8_WAIT_L(8); PG8_BAR; PG8_WAIT_L(0); PG8_MMA(0, 0, At, B0); PG8_BAR; PG8_SCHED;
            PG8_LDB(B1, 0, 1); PG8_STAGE(PG8_SB(0, 0), b2, voffB);
            PG8_BAR; PG8_WAIT_L(0); PG8_MMA(0, 1, At, B1); PG8_BAR;
            PG8_LDA(At, 0, 1); PG8_STAGE(PG8_SA(0, 0), a2, voffA);
            PG8_BAR; PG8_WAIT_L(0); PG8_MMA(1, 0, At, B0); PG8_BAR; PG8_SCHED;
            PG8_STAGE(PG8_SB(0, 1), b2 + hstep, voffB);
            PG8_WAIT_V(6); PG8_BAR; PG8_MMA(1, 1, At, B1); PG8_BAR;
            PG8_LDB(B0, 1, 0); PG8_SCHED; PG8_LDA(At, 1, 0); PG8_STAGE(PG8_SA(0, 1), a2 + hstep, voffA);
            PG8_WAIT_L(8); PG8_BAR; PG8_WAIT_L(0); PG8_MMA(0, 0, At, B0); PG8_BAR; PG8_SCHED;
            PG8_LDB(B1, 1, 1); PG8_STAGE(PG8_SB(1, 0), b3, voffB);
            PG8_BAR; PG8_WAIT_L(0); PG8_MMA(0, 1, At, B1); PG8_BAR;
            PG8_LDA(At, 1, 1); PG8_STAGE(PG8_SA(1, 0), a3, voffA);
            PG8_BAR; PG8_WAIT_L(0); PG8_MMA(1, 0, At, B0); PG8_BAR; PG8_SCHED;
            PG8_STAGE(PG8_SB(1, 1), b3 + hstep, voffB);
            PG8_WAIT_V(6); PG8_BAR; PG8_MMA(1, 1, At, B1); PG8_BAR;
            }
        }
        if constexpr (ALIGN_EPI) { if (wr == 0) PG8_BAR; }
        if constexpr (!Epi::AFTER_DRAIN) { E(acc, cur, wr, wc, fr, fq); S.done(cur); }
        if (!has_next) break;
#pragma unroll
        for (int a = 0; a < 2; ++a)
#pragma unroll
            for (int b = 0; b < 2; ++b)
#pragma unroll
                for (int m = 0; m < 4; ++m)
#pragma unroll
                    for (int n = 0; n < 2; ++n) acc[a][b][m][n] = (f32x4){0.f, 0.f, 0.f, 0.f};
        cur = nxt; cA = nA; cB = nB; ++ui;
        if constexpr (ALIGN_EPI) { if (wr == 1) PG8_BAR; }
    }
    PG8_WAIT_V(0);
    if constexpr (!ALIGN_EPI) { if (wr == 0) PG8_BAR; }
    PG8_BAR;
    if constexpr (Epi::AFTER_DRAIN) { E.fused(acc, cur, wr, wc, fr, fq, lds, wid, lane); S.done(cur); }
#undef PG8_SA
#undef PG8_SB
#undef PG8_STAGE
#undef PG8_LDA
#undef PG8_LDB
#undef PG8_MMA
#undef PG8_WAIT_V
#undef PG8_WAIT_L
#undef PG8_BAR
#undef PG8_SCHED
}
}

#define GAS __attribute__((address_space(1)))
#define LAS __attribute__((address_space(3)))
typedef unsigned v4u __attribute__((ext_vector_type(4)));
typedef float f32x4 __attribute__((ext_vector_type(4)));
typedef short bf16x8 __attribute__((ext_vector_type(8)));
typedef GAS unsigned gu32;
typedef GAS unsigned long long gu64;
#define RLX_AGENT __ATOMIC_RELAXED, __HIP_MEMORY_SCOPE_AGENT
#define LDS_WAIT() asm volatile("s_waitcnt lgkmcnt(0)" ::: "memory")
#define VM_WAIT() asm volatile("s_waitcnt vmcnt(0)" ::: "memory")
__device__ __forceinline__ unsigned long long rt() { return __builtin_amdgcn_s_memrealtime(); }

#define XB_TMO      128
#define XB_XCNT(j)  (256  + 64 * (j))
#define XB_XSUB(j)  (1280 + 64 * (j))
#define XB_XGEN(j)  (2304 + 64 * (j))
#define XB_TOP      3328
#define XB_TOPGEN   3392
#define XCD_BAR_WORDS 3456
#define XB_SPIN_CAP (1u << 18)

__device__ __forceinline__ unsigned xb_ld(unsigned* p)              { return __hip_atomic_load(p, __ATOMIC_RELAXED, __HIP_MEMORY_SCOPE_AGENT); }
__device__ __forceinline__ unsigned xb_add(unsigned* p, unsigned v) { return __hip_atomic_fetch_add(p, v, __ATOMIC_RELAXED, __HIP_MEMORY_SCOPE_AGENT); }
__device__ __forceinline__ unsigned xb_xcc_id() { return (unsigned)__builtin_amdgcn_s_getreg((3 << 11) | 20) & 0xFu; }
#define XB_SPIN(cond, bar) do { unsigned _sp = 0; while (cond) { __builtin_amdgcn_s_sleep(1); \
    if ((++_sp & 255u) == 0u) { if (xb_ld(&(bar)[XB_TMO])) break; if (_sp > XB_SPIN_CAP) { atomicAdd(&(bar)[XB_TMO], 1u); break; } } } } while (0)

struct XcdBarrier {
    unsigned* bar; unsigned x;
    volatile LAS unsigned* st;
};

__device__ __forceinline__ XcdBarrier xcd_barrier_post(unsigned* bar, volatile LAS unsigned* st) {
    XcdBarrier b; b.bar = bar; b.x = xb_xcc_id(); b.st = st;
    if (threadIdx.x == 0) (void)xb_add(&bar[XB_XCNT(b.x)], 1u);
    return b;
}
__device__ __forceinline__ void xcd_barrier_complete(unsigned* bar, unsigned x, unsigned& nloc, unsigned& nx) {
    const unsigned G = gridDim.x * gridDim.y * gridDim.z;
    unsigned sum, cnt, mine, sp = 0u;
    for (;;) {
        sum = 0u; cnt = 0u; mine = 0u;
#pragma unroll
        for (unsigned j = 0; j < 16; ++j) { const unsigned c = xb_ld(&bar[XB_XCNT(j)]); sum += c; cnt += (c > 0u) ? 1u : 0u; mine = (j == x) ? c : mine; }
        if (sum == G) break;
        __builtin_amdgcn_s_sleep(1);
        if ((++sp & 255u) == 0u) { if (xb_ld(&bar[XB_TMO])) break; if (sp > XB_SPIN_CAP) { atomicAdd(&bar[XB_TMO], 1u); break; } }
    }
    nloc = mine > 0u ? mine : 1u; nx = cnt > 0u ? cnt : 1u;
}

__device__ __forceinline__ void xcd_barrier(const XcdBarrier& b) {
    asm volatile("s_waitcnt vmcnt(0)" ::: "memory");
    __syncthreads();
    if (threadIdx.x == 0) {
        unsigned* bar = b.bar;
        __builtin_amdgcn_s_waitcnt(0);
        unsigned nloc = b.st[0], nx = b.st[1];
        if (nloc == 0u) { xcd_barrier_complete(bar, b.x, nloc, nx); b.st[0] = nloc; b.st[1] = nx; }
        const unsigned old = xb_add(&bar[XB_XSUB(b.x)], 1u);
        const unsigned gen = old / nloc;
        if (old + 1u == (gen + 1u) * nloc) {
            __builtin_amdgcn_fence(__ATOMIC_RELEASE, "agent");
            asm volatile("s_waitcnt vmcnt(0)" ::: "memory");
            const unsigned og = xb_add(&bar[XB_TOP], 1u);
            const unsigned tg = og / nx;
            if (og + 1u == (tg + 1u) * nx) xb_add(&bar[XB_TOPGEN], 1u);
            else XB_SPIN(xb_ld(&bar[XB_TOPGEN]) == tg, bar);
            __builtin_amdgcn_fence(__ATOMIC_ACQUIRE, "agent");
            xb_add(&bar[XB_XGEN(b.x)], 1u);
            asm volatile("s_waitcnt vmcnt(0)" ::: "memory");
        } else {
            XB_SPIN(xb_ld(&bar[XB_XGEN(b.x)]) == gen, bar);
            __builtin_amdgcn_fence(__ATOMIC_ACQUIRE, "agent");
            asm volatile("s_waitcnt vmcnt(0)" ::: "memory");
        }
    }
    __syncthreads();
}

constexpr int CW_LBAR = 3072;
constexpr int CW_MISPLACED = 3000;
__device__ __forceinline__ void xcd_local_barrier(unsigned* ctlw, unsigned x) {
    asm volatile("s_waitcnt vmcnt(0)" ::: "memory");
    __syncthreads();
    if (threadIdx.x == 0) {
        unsigned* arr = ctlw + CW_LBAR + x * 32; unsigned* gen_ = arr + 16;
        const unsigned old = xb_add(arr, 1u), gen = old / 32u;
        if (old + 1u == (gen + 1u) * 32u) xb_add(gen_, 1u);
        else { unsigned sp = 0u; while (xb_ld(gen_) == gen && ++sp < (1u << 22)) __builtin_amdgcn_s_sleep(1); }
        __builtin_amdgcn_fence(__ATOMIC_ACQUIRE, "agent");
        asm volatile("s_waitcnt vmcnt(0)" ::: "memory");
    }
    __syncthreads();
}

constexpr int NWAVES = 8, NTHR = 512;
constexpr int RING_OFF = 0, RING_BYTES = 131072;
constexpr int LDS_BYTES = 159744;
constexpr int MISC_OFF = LDS_BYTES - 512;
constexpr size_t CTL_ZERO_BYTES = 65536;
constexpr int CW_P8CTR = 2048;
constexpr int CW_BAR = 4096;

struct Frame {
    LAS unsigned char* lds;
    volatile LAS unsigned* MISC;
    int tid, lane, wave, G, bid;
};

__device__ __forceinline__ void p0_transpose_item(const float* W, int K, int N, bf16_t* WT, LAS float* scr, int item, int lane) {
    const int nblk = N / 32, kb = item / nblk, nb = item % nblk, k0 = 64 * kb, n0 = 32 * nb;
    float tv[32];
#pragma unroll
    for (int i = 0; i < 32; ++i) tv[i] = W[(size_t)(k0 + 2 * i + (lane >> 5)) * N + n0 + (lane & 31)];
#pragma unroll
    for (int i = 0; i < 32; ++i) scr[(2 * i + (lane >> 5)) * 33 + (lane & 31)] = tv[i];
    LDS_WAIT(); asm volatile("" ::: "memory");
    const int c = lane & 7;
#pragma unroll
    for (int j = 0; j < 4; ++j) { const int n = (lane >> 3) + 8 * j; const LAS float* s = scr + (8 * c) * 33 + n;
        v4u o; o.x = pk2(s[0 * 33], s[1 * 33]); o.y = pk2(s[2 * 33], s[3 * 33]); o.z = pk2(s[4 * 33], s[5 * 33]); o.w = pk2(s[6 * 33], s[7 * 33]);
        *(GAS v4u*)(WT + (size_t)(n0 + n) * K + k0 + 8 * c) = o; }
    LDS_WAIT(); asm volatile("" ::: "memory");
}
__device__ __forceinline__ void cvt_stream(const float* src, bf16_t* dst, size_t n4, size_t gtid, size_t gsz) {
    for (size_t i = gtid; i < n4; i += gsz) { const f32x4 v = ((const f32x4*)src)[i]; u32x2 o; o.x = pk2(v.x, v.y); o.y = pk2(v.z, v.w); ((u32x2*)dst)[i] = o; }
}
struct CvRows { f32x4 x[2][8]; };
__device__ __forceinline__ void convert_load(const Params& p, int e0, int lane, CvRows& R) {
    const int l5 = lane & 31, hb = lane >> 5;
#pragma unroll
    for (int q = 0; q < 2; ++q) { const float* src = (hb ? p.peer_v : p.peer_u) + (size_t)(e0 + q) * D;
#pragma unroll
        for (int j = 0; j < 8; ++j) R.x[q][j] = ((const f32x4*)src)[32 * j + l5]; }
}
__device__ __forceinline__ void convert_finish(const Params& p, int e0, int lane, const CvRows& R) {
    unsigned char* ws = p.ws;
    const int l5 = lane & 31, hb = lane >> 5;
    const f32x4 (&x)[2][8] = R.x;
    {
#pragma unroll
            for (int q = 0; q < 2; ++q) {
                float am = 0.f;
#pragma unroll
                for (int j = 0; j < 8; ++j) am = fmaxf(am, fmaxf(fmaxf(fabsf(x[q][j].x), fabsf(x[q][j].y)), fmaxf(fabsf(x[q][j].z), fabsf(x[q][j].w))));
                am = half_max(am);
                const float top = 6.0f;
                const float sc = am > 0.f ? top / am : 1.f, inv = am > 0.f ? am / top : 1.f;
                f32x16 va, vb;
#pragma unroll
                for (int j = 0; j < 4; ++j) { va[4 * j] = x[q][j].x * sc; va[4 * j + 1] = x[q][j].y * sc; va[4 * j + 2] = x[q][j].z * sc; va[4 * j + 3] = x[q][j].w * sc;
                    vb[4 * j] = x[q][4 + j].x * sc; vb[4 * j + 1] = x[q][4 + j].y * sc; vb[4 * j + 2] = x[q][4 + j].z * sc; vb[4 * j + 3] = x[q][4 + j].w * sc; }
                {
                    u32x4 o = (u32x4){0u, 0u, 0u, 0u};
#pragma unroll
                    for (int j = 0; j < 2; ++j) {
                        o[j] = __builtin_amdgcn_cvt_scalef32_pk_fp4_f32(o[j], va[8 * j + 0], va[8 * j + 1], 1.0f, 0); o[j] = __builtin_amdgcn_cvt_scalef32_pk_fp4_f32(o[j], va[8 * j + 2], va[8 * j + 3], 1.0f, 1);
                        o[j] = __builtin_amdgcn_cvt_scalef32_pk_fp4_f32(o[j], va[8 * j + 4], va[8 * j + 5], 1.0f, 2); o[j] = __builtin_amdgcn_cvt_scalef32_pk_fp4_f32(o[j], va[8 * j + 6], va[8 * j + 7], 1.0f, 3);
                        o[2 + j] = __builtin_amdgcn_cvt_scalef32_pk_fp4_f32(o[2 + j], vb[8 * j + 0], vb[8 * j + 1], 1.0f, 0); o[2 + j] = __builtin_amdgcn_cvt_scalef32_pk_fp4_f32(o[2 + j], vb[8 * j + 2], vb[8 * j + 3], 1.0f, 1);
                        o[2 + j] = __builtin_amdgcn_cvt_scalef32_pk_fp4_f32(o[2 + j], vb[8 * j + 4], vb[8 * j + 5], 1.0f, 2); o[2 + j] = __builtin_amdgcn_cvt_scalef32_pk_fp4_f32(o[2 + j], vb[8 * j + 6], vb[8 * j + 7], 1.0f, 3); }
                    *(u32x4*)(ws + (hb ? WS_VB : WS_UB) + (size_t)(e0 + q) * 512 + l5 * 16) = o;
                }
                if (l5 == 0) ((float*)(ws + (hb ? WS_VSC : WS_USC)))[e0 + q] = inv;
            }
    }
}

__device__ __forceinline__ void p0_prologue(Frame& F, const Params& p) {
    unsigned char* ws = p.ws;
    for (int item = F.bid; item < 192; item += F.G) {
        LAS float* sil = (LAS float*)(F.lds);
        LAS float* red = (LAS float*)(F.lds + 8192);
        const int ks = item / 24, cc = item % 24;
        for (int i = F.tid; i < 9 * 128; i += NTHR) { const int r = i >> 7, k = ks * 128 + (i & 127); const float v = r < 8 ? p.c[r * 1024 + k] : p.c_ctx[k]; sil[i] = v / (1.f + __expf(-v)); }
        __syncthreads();
        f32x4 acc[9];
#pragma unroll
        for (int r = 0; r < 9; ++r) acc[r] = (f32x4){0.f, 0.f, 0.f, 0.f};
        const float* wp = p.w_ada + (size_t)(ks * 128 + F.wave * 16) * NMOD + cc * 256 + F.lane * 4;
#pragma unroll 4
        for (int kk = 0; kk < 16; ++kk) { const f32x4 w = *(const f32x4*)(wp + (size_t)kk * NMOD);
#pragma unroll
            for (int r = 0; r < 9; ++r) acc[r] += w * sil[r * 128 + F.wave * 16 + kk]; }
#pragma unroll
        for (int r = 0; r < 9; ++r) *(LAS f32x4*)(red + ((F.wave * 9 + r) * 256 + F.lane * 4)) = acc[r];
        __syncthreads();
        float* modp = (float*)(ws + WS_MODP);
        for (int i = F.tid; i < 9 * 256; i += NTHR) { const int r = i >> 8, c = i & 255; float s = 0.f;
#pragma unroll
            for (int w = 0; w < 8; ++w) s += red[(w * 9 + r) * 256 + c];
            modp[(size_t)(ks * 9 + r) * NMOD + cc * 256 + c] = s; }
        __syncthreads();
    }
    {
        LAS float* scr = (LAS float*)(F.lds + F.wave * 16384);
        const int gw = F.bid * NWAVES + F.wave, NGW = F.G * NWAVES;
        constexpr int I_IN = 16 * 96, I_OUT = 16 * 32, I_PQ = 16 * 64;
        for (int it = gw; it < I_IN + I_OUT + I_PQ; it += NGW) {
            int r = it;
            if (r < I_IN) { p0_transpose_item(p.w_in, D, NQKV, (bf16_t*)(ws + WS_WIN), scr, r, F.lane); continue; } r -= I_IN;
            if (r < I_OUT) { p0_transpose_item(p.w_out, D, D, (bf16_t*)(ws + WS_WOUT), scr, r, F.lane); continue; } r -= I_OUT;
            p0_transpose_item(p.peer_wq, D, 2048, (bf16_t*)(ws + WS_WPQ), scr, r, F.lane);
        }
    }
    const size_t gtid = (size_t)F.bid * NTHR + F.tid, gsz = (size_t)F.G * NTHR;
    cvt_stream(p.peer_keys, (bf16_t*)(ws + WS_KEYS), (size_t)8 * 2 * 128 * 128 / 4, gtid, gsz);
    { bf16_t* ki = (bf16_t*)(ws + WS_KEYSI);
      for (int i = (int)gtid; i < 8 * 2 * 16 * 128; i += (int)gsz) { const int key = i & 127, c = (i >> 7) & 15, hp = i >> 11;
          const float* sp = p.peer_keys + ((size_t)hp * 128 + key) * 128 + c * 8; const f32x4 a = *(const f32x4*)sp, b = *(const f32x4*)(sp + 4);
          u32x4 o; o.x = pk2(a.x, a.y); o.y = pk2(a.z, a.w); o.z = pk2(b.x, b.y); o.w = pk2(b.z, b.w); *(u32x4*)(ki + (size_t)i * 8) = o; } }
    if (gtid == 0) {
        float s01 = 0.f, s23 = 0.f;
        for (int i = 0; i < 64; ++i) { s01 += p.diff_lambda[i] * p.diff_lambda[64 + i]; s23 += p.diff_lambda[128 + i] * p.diff_lambda[192 + i]; }
        *(float*)(ws + WS_LAM) = expf(s01) - expf(s23) + LAMBDA_INIT;
    }
    float* rope = (float*)(ws + WS_ROPE);
    for (int i = (int)gtid; i < 64 * 16; i += (int)gsz) { const int pos = i >> 4, f = i & 15; const float inv = exp2f(-(float)f * (13.287712379549449f / 16.f)); const float a = (float)pos * inv; rope[2 * i] = cosf(a); rope[2 * i + 1] = sinf(a); }
    bf16_t* bt = (bf16_t*)(ws + WS_BIAST);
    for (int i = (int)gtid; i < 8 * 15 * 4096; i += (int)gsz) {
        const int j = i & 7, kc = (i >> 3) & 63, cq = (i >> 9) & 7, hd = i >> 12, dr = hd % 15, h = hd / 15;
        const int cp = cq * 8 + j; int cs = cp - 8; cs = cs < 0 ? 0 : (cs > 48 ? 48 : cs);
        float v = NEG_BIG;
        if (kc >= cs && kc < cs + 16) v = p.rel_bias[(h * 15 + dr) * 31 + (kc - cp + 15)] * LOG2E;
        bt[i] = (bf16_t)f2bf(v);
    }
}

__device__ __forceinline__ void p1_hrows(Frame& F, const Params& p) {
    unsigned char* ws = p.ws;
    const float* modp = (const float*)(ws + WS_MODP);
    float* mod = (float*)(ws + WS_MOD);
    for (int i = F.bid * NTHR + F.tid; i < 9 * NMOD; i += F.G * NTHR) { float s = p.b_ada[i % NMOD];
#pragma unroll
        for (int ks = 0; ks < 8; ++ks) s += modp[(size_t)ks * 9 * NMOD + i];
        mod[i] = s; }
    const bool ctxwg = F.G > NCTXWG && F.bid < NCTXWG;
    int r0, r1;
    if (F.G > NCTXWG) { if (ctxwg) { r0 = MLAT + 256 * (F.bid & 7) + 32 * (F.bid >> 3); r1 = r0 + 32; } else { const int nl = F.G - NCTXWG, rows_per = (MLAT + nl - 1) / nl; r0 = (F.bid - NCTXWG) * rows_per; r1 = min(MLAT, r0 + rows_per); } }
    else { const int rows_per = (MALL + F.G - 1) / F.G; r0 = F.bid * rows_per; r1 = min(MALL, r0 + rows_per); }
    if (r0 >= r1) return;
    const int mr_lo = r0 < MLAT ? (r0 >> 12) : 8;
    LAS float* tab = (LAS float*)F.lds;
    for (int i = F.tid; i < 2 * 2048; i += NTHR) {
        const int which = i >> 11, ss = (i >> 10) & 1, col = i & 1023; const int mr = min(8, mr_lo + which);
        const int mi = mr * NMOD + (ss == 0 ? D : 0) + col;
        float s = p.b_ada[(ss == 0 ? D : 0) + col];
#pragma unroll
        for (int ks = 0; ks < 8; ++ks) s += modp[(size_t)ks * 9 * NMOD + mi];
        tab[i] = ss == 0 ? p.g_norm[col] * (1.f + s) : s;
    }
    __syncthreads();
    bf16_t* H = (bf16_t*)(ws + WS_H); bf16_t* XB = (bf16_t*)(ws + WS_XB);
    f32x4 nx[2][4];
#define P1_LOAD(dst, rowa_) do { _Pragma("unroll") for (int q = 0; q < 2; ++q) { const int row = min((rowa_) + q * NWAVES, MALL - 1); \
            const float* xr = row < MLAT ? p.x + (size_t)row * D : p.ctx + (size_t)(row - MLAT) * D; \
            _Pragma("unroll") for (int j = 0; j < 4; ++j) dst[q][j] = ((const f32x4*)xr)[F.lane + 64 * j]; } } while (0)
    P1_LOAD(nx, r0 + F.wave);
    for (int rowa = r0 + F.wave; rowa < r1; rowa += 2 * NWAVES) {
        f32x4 v[2][4]; float ssq[2];
#pragma unroll
        for (int q = 0; q < 2; ++q)
#pragma unroll
            for (int j = 0; j < 4; ++j) v[q][j] = nx[q][j];
        if (rowa + 2 * NWAVES < r1) P1_LOAD(nx, rowa + 2 * NWAVES);
#pragma unroll
        for (int q = 0; q < 2; ++q) { float s = 0.f;
#pragma unroll
            for (int j = 0; j < 4; ++j) s += v[q][j].x * v[q][j].x + v[q][j].y * v[q][j].y + v[q][j].z * v[q][j].z + v[q][j].w * v[q][j].w;
            ssq[q] = wave_sum(s); }
#pragma unroll
        for (int q = 0; q < 2; ++q) { const int row = rowa + q * NWAVES; if (row < r1) {
            const int mr = row < MLAT ? (row >> 12) : 8; const LAS float* tb = tab + (mr - mr_lo) * 2048;
            const float rstd = rsqrtf(ssq[q] * (1.f / D) + EPS);
#pragma unroll
            for (int j = 0; j < 4; ++j) { const int col = (F.lane + 64 * j) * 4;
                const f32x4 sc = *(const LAS f32x4*)(tb + col), sh = *(const LAS f32x4*)(tb + 1024 + col);
                const f32x4 y = (v[q][j] * rstd) * sc + sh;
                u32x2 o; o.x = pk2(y.x, y.y); o.y = pk2(y.z, y.w);
                *(u32x2*)(H + (size_t)row * D + col) = o;
                if (row < MLAT) { u32x2 xo; xo.x = pk2(v[q][j].x, v[q][j].y); xo.y = pk2(v[q][j].z, v[q][j].w); *(u32x2*)(XB + (size_t)row * D + col) = xo; } } } }
    }
#undef P1_LOAD
}

struct EpiQKVFast {
    static constexpr bool PERM = true, AFTER_DRAIN = false;
    unsigned char* ws;
    __device__ __forceinline__ void operator()(const pg8::f32x4 (&acc)[2][2][4][2], const pg8::Unit& u, int wr, int wc, int fr, int fq) const {
        const bool lat = u.pm < 128;
        const int kind = u.pn >> 1;
        if (!lat && (kind == 0 || kind == 3)) return;
        const int b = lat ? (u.pm >> 4) : (u.pm - 128);
        const int tb = lat ? (u.pm & 15) * 256 : 0;
        const float* rope = (const float*)(ws + WS_ROPE);
#pragma unroll
        for (int bj = 0; bj < 2; ++bj) {
            const int cc = (u.pn & 1) * 256 + bj * 128 + wc * 32 + 8 * fq;
#pragma unroll
            for (int ai = 0; ai < 2; ++ai)
#pragma unroll
                for (int m = 0; m < 4; ++m) {
                    const int rowin = ai * 128 + wr * 64 + m * 16 + fr;
                    const int t = tb + rowin;
                    const int j = lat ? 256 + t : rowin;
                    f32x4 v0 = acc[ai][bj][m][0], v1 = acc[ai][bj][m][1];
                    bf16_t* dst;
                    if (kind == 0) { dst = (bf16_t*)(ws + WS_QA) + qa_idx(b, cc >> 6, t, cc & 63); v0 = v0 * C2; v1 = v1 * C2; }
                    else if (kind == 1) dst = (bf16_t*)(ws + WS_KA) + ka_idx(b, cc >> 6, j, cc & 63);
                    else if (kind == 2) dst = (bf16_t*)(ws + WS_VA) + va_idx(b, cc >> 6, j, cc & 63);
                    else if (kind == 5) dst = (bf16_t*)(ws + WS_VD) + vd_idx(b, cc >> 7, j, cc & 127);
                    else {
                        const int mm = cc >> 8, h = (cc >> 6) & 3, d = cc & 63;
                        if (lat) { const int i0 = d >> 1; const int pos = i0 < 16 ? (t >> 6) : (t & 63); const float* rp = rope + (pos * 16 + (i0 & 15)) * 2;
                            const f32x4 r0 = *(const f32x4*)rp, r1 = *(const f32x4*)(rp + 4);
                            f32x4 a0, a1;
                            a0.x = v0.x * r0.x - v0.y * r0.y; a0.y = v0.x * r0.y + v0.y * r0.x; a0.z = v0.z * r0.z - v0.w * r0.w; a0.w = v0.z * r0.w + v0.w * r0.z;
                            a1.x = v1.x * r1.x - v1.y * r1.y; a1.y = v1.x * r1.y + v1.y * r1.x; a1.z = v1.z * r1.z - v1.w * r1.w; a1.w = v1.z * r1.w + v1.w * r1.z;
                            v0 = a0; v1 = a1; }
                        if (kind == 3) { dst = (bf16_t*)(ws + WS_QD) + qd_idx(b, mm, h, t, d); v0 = v0 * C2; v1 = v1 * C2; }
                        else dst = (bf16_t*)(ws + WS_KD) + kd_idx(b, mm, h, j, d);
                    }
                    pg8::u32x4 w; w.x = pg8::cvt_pk_bf16(v0[0], v0[1]); w.y = pg8::cvt_pk_bf16(v0[2], v0[3]); w.z = pg8::cvt_pk_bf16(v1[0], v1[1]); w.w = pg8::cvt_pk_bf16(v1[2], v1[3]);
                    *(pg8::u32x4*)dst = w;
                }
        }
    }
};


struct OneTile { int pm, pn; int pad0, pad1;
    __device__ __forceinline__ bool next(int i, pg8::Unit& u) const { if (i != 0) return false; u.pm = pm; u.pn = pn; return true; }
    __device__ __forceinline__ void a_ready(const pg8::Unit&) const {}
    __device__ __forceinline__ void done(const pg8::Unit&) const {}
};
constexpr int CW_CTXCNT = 2112;
__device__ __forceinline__ void p1_ctx_tile(Frame& F, const Params& p) {
    if (!(F.G > NCTXWG && F.bid < NCTXWG)) return;
    const int b = F.bid & 7, ni = F.bid >> 3;
    unsigned* cnt = (unsigned*)(p.ws + WS_CTL) + CW_CTXCNT + b;
    asm volatile("s_waitcnt vmcnt(0)" ::: "memory");
    __syncthreads();
    if (F.tid == 0) {
        __builtin_amdgcn_fence(__ATOMIC_RELEASE, "agent");
        asm volatile("s_waitcnt vmcnt(0)" ::: "memory");
        __hip_atomic_fetch_add(cnt, 1u, __ATOMIC_RELAXED, __HIP_MEMORY_SCOPE_AGENT);
        while (__hip_atomic_load(cnt, __ATOMIC_RELAXED, __HIP_MEMORY_SCOPE_AGENT) < 8u) __builtin_amdgcn_s_sleep(2);
        __builtin_amdgcn_fence(__ATOMIC_ACQUIRE, "agent");
        asm volatile("s_waitcnt vmcnt(0)" ::: "memory");
    }
    __syncthreads();
    OneTile S{128 + b, ni < 4 ? 2 + ni : 4 + ni, 0, 0};
    pg8::Gemm g{(const bf16_t*)(p.ws + WS_H), (const bf16_t*)(p.ws + WS_WIN), MALL, NQKV, D};
    EpiQKVFast E{p.ws};
    pg8::gemm_phase<EpiQKVFast, OneTile, true, true>(F.lds + RING_OFF, g, S, E);
}

struct EpiQ2Frag {
    static constexpr bool PERM = true, AFTER_DRAIN = false;
    bf16_t* O;
    __device__ __forceinline__ void operator()(const pg8::f32x4 (&acc)[2][2][4][2], const pg8::Unit& u, int wr, int wc, int fr, int fq) const {
        const int h = u.pn;
#pragma unroll
        for (int bj = 0; bj < 2; ++bj) {
            const int c8 = wc * 4 + fq;
#pragma unroll
            for (int ai = 0; ai < 2; ++ai)
#pragma unroll
                for (int m = 0; m < 4; ++m) {
                    const int row = u.pm * 256 + ai * 128 + wr * 64 + m * 16 + fr;
                    const size_t idx = ((((((size_t)(row >> 5) * 8 + h) * 2 + bj) * 8 + (c8 >> 1)) * 2 + (c8 & 1)) * 32 + (row & 31)) * 8;
                    const f32x4 v0 = acc[ai][bj][m][0], v1 = acc[ai][bj][m][1];
                    pg8::u32x4 w; w.x = pg8::cvt_pk_bf16(v0[0], v0[1]); w.y = pg8::cvt_pk_bf16(v0[2], v0[3]); w.z = pg8::cvt_pk_bf16(v1[0], v1[1]); w.w = pg8::cvt_pk_bf16(v1[2], v1[3]);
                    *(pg8::u32x4*)(O + idx) = w;
                }
        }
    }
};

__device__ __forceinline__ void p5_rows2(Frame& F, const Params& p) {
    unsigned char* ws = p.ws;
    const float* mod = (const float*)(ws + WS_MOD);
    const bf16_t* YO = (const bf16_t*)(ws + WS_YO);
    bf16_t* H2 = (bf16_t*)(ws + WS_H2); const bf16_t* XB = (const bf16_t*)(ws + WS_XB);
    const int gw = F.G == 256 ? ((F.bid & 7) * 32 + (F.bid >> 3)) * NWAVES + F.wave : F.bid * NWAVES + F.wave, NGW = F.G * NWAVES;
    const int rows_per = (MLAT + NGW - 1) / NGW;
    const int rend = min(MLAT, (gw + 1) * rows_per);
    u32x2 nxx[2][4]; u32x2 nxy[2][4];
#define P5_LOAD(rowa_) do { _Pragma("unroll") for (int q = 0; q < 2; ++q) { const int row = min((rowa_) + q, MLAT - 1); \
            _Pragma("unroll") for (int j = 0; j < 4; ++j) { nxx[q][j] = ((const u32x2*)(XB + (size_t)row * D))[F.lane + 64 * j]; nxy[q][j] = ((const u32x2*)(YO + (size_t)row * D))[F.lane + 64 * j]; } } } while (0)
    P5_LOAD(gw * rows_per);
    f32x4 tA[4], tB[4], tC[4]; int bcur = -1;
#define P5_TABS(b_) do { const float* mb_ = mod + (b_) * NMOD; _Pragma("unroll") for (int j = 0; j < 4; ++j) { const int col = (F.lane + 64 * j) * 4; \
            const f32x4 g1 = *(const f32x4*)(p.g_norm + D + col), gt1 = *(const f32x4*)(mb_ + 2 * D + col); tA[j] = gt1 * g1; \
            const f32x4 g2 = *(const f32x4*)(p.g_norm + 2 * D + col), sh2 = *(const f32x4*)(mb_ + 3 * D + col), sc2 = *(const f32x4*)(mb_ + 4 * D + col); tB[j] = g2 * (sc2 + 1.f); tC[j] = sh2; } bcur = (b_); } while (0)
    P5_TABS(min(gw * rows_per, MLAT - 1) >> 12);
    for (int rowa = gw * rows_per; rowa < rend; rowa += 2) {
        f32x4 xv[2][4], yv[2][4]; float ssq[2];
#pragma unroll
        for (int q = 0; q < 2; ++q)
#pragma unroll
            for (int j = 0; j < 4; ++j) { const u32x2 xw_ = nxx[q][j]; xv[q][j] = (f32x4){bflo(xw_.x), bfhi(xw_.x), bflo(xw_.y), bfhi(xw_.y)}; const u32x2 yw = nxy[q][j]; yv[q][j] = (f32x4){bflo(yw.x), bfhi(yw.x), bflo(yw.y), bfhi(yw.y)}; }
        if (rowa + 2 < rend) P5_LOAD(rowa + 2);
#pragma unroll
        for (int q = 0; q < 2; ++q) { float s = 0.f;
#pragma unroll
            for (int j = 0; j < 4; ++j) s += yv[q][j].x * yv[q][j].x + yv[q][j].y * yv[q][j].y + yv[q][j].z * yv[q][j].z + yv[q][j].w * yv[q][j].w;
            ssq[q] = wave_sum(s); }
#pragma unroll
        for (int q = 0; q < 2; ++q) { const int row = rowa + q; if (row < MLAT) {
            const int b = row >> 12; if (b != bcur) P5_TABS(b);
            const float rstd = rsqrtf(ssq[q] * (1.f / D) + EPS);
            float s2 = 0.f;
#pragma unroll
            for (int j = 0; j < 4; ++j) {
                xv[q][j] = xv[q][j] + tA[j] * (yv[q][j] * rstd);
                s2 += xv[q][j].x * xv[q][j].x + xv[q][j].y * xv[q][j].y + xv[q][j].z * xv[q][j].z + xv[q][j].w * xv[q][j].w; }
            const float rstd2 = rsqrtf(wave_sum(s2) * (1.f / D) + EPS);
#pragma unroll
            for (int j = 0; j < 4; ++j) { const int col = (F.lane + 64 * j) * 4;
                const f32x4 y = (xv[q][j] * rstd2) * tB[j] + tC[j];
                u32x2 o; o.x = pk2(y.x, y.y); o.y = pk2(y.z, y.w);
                *(u32x2*)(H2 + (size_t)row * D + col) = o; } } }
    }
#undef P5_LOAD
#undef P5_TABS
}

template <int J> __device__ __forceinline__ unsigned lane_xor(unsigned x, int lane) {
    if (J == 1) return (unsigned)__builtin_amdgcn_update_dpp(0, (int)x, 0xB1, 0xf, 0xf, false);
    if (J == 2) return (unsigned)__builtin_amdgcn_update_dpp(0, (int)x, 0x4E, 0xf, 0xf, false);
    if (J == 4) { const unsigned a = (unsigned)__builtin_amdgcn_update_dpp(0, (int)x, 0x104, 0xf, 0xf, false),
                                 b = (unsigned)__builtin_amdgcn_update_dpp(0, (int)x, 0x114, 0xf, 0xf, false);
                  return (lane & 4) ? b : a; }
    if (J == 8) return (unsigned)__builtin_amdgcn_update_dpp(0, (int)x, 0x128, 0xf, 0xf, false);
    if (J == 16) { auto r = __builtin_amdgcn_permlane16_swap(x, x, false, false); return (lane & 16) ? r[0] : r[1]; }
    auto r = __builtin_amdgcn_permlane32_swap(x, x, false, false); return (lane & 32) ? r[0] : r[1];
}
template <int K2, int J> __device__ __forceinline__ void bitonic_step128(unsigned& key0, unsigned& key1, int lane) {
    if (J == 64) { const unsigned lo = key0 < key1 ? key0 : key1, hi_ = key0 < key1 ? key1 : key0; key0 = lo; key1 = hi_; }
    else {
        const unsigned p0_ = lane_xor<J>(key0, lane), p1_ = lane_xor<J>(key1, lane);
        const bool lower = (lane & J) == 0;
        const bool asc0 = K2 == 128 ? true : ((lane & K2) == 0), asc1 = K2 == 128 ? true : (((64 + lane) & K2) == 0);
        const bool kmin0 = lower == asc0, kmin1 = lower == asc1;
        key0 = kmin0 ? (key0 < p0_ ? key0 : p0_) : (key0 < p0_ ? p0_ : key0);
        key1 = kmin1 ? (key1 < p1_ ? key1 : p1_) : (key1 < p1_ ? p1_ : key1);
    }
}
__device__ __forceinline__ void sort128_asc(unsigned& k0, unsigned& k1, int lane) {
    bitonic_step128<2, 1>(k0, k1, lane);
    bitonic_step128<4, 2>(k0, k1, lane); bitonic_step128<4, 1>(k0, k1, lane);
    bitonic_step128<8, 4>(k0, k1, lane); bitonic_step128<8, 2>(k0, k1, lane); bitonic_step128<8, 1>(k0, k1, lane);
    bitonic_step128<16, 8>(k0, k1, lane); bitonic_step128<16, 4>(k0, k1, lane); bitonic_step128<16, 2>(k0, k1, lane); bitonic_step128<16, 1>(k0, k1, lane);
    bitonic_step128<32, 16>(k0, k1, lane); bitonic_step128<32, 8>(k0, k1, lane); bitonic_step128<32, 4>(k0, k1, lane); bitonic_step128<32, 2>(k0, k1, lane); bitonic_step128<32, 1>(k0, k1, lane);
    bitonic_step128<64, 32>(k0, k1, lane); bitonic_step128<64, 16>(k0, k1, lane); bitonic_step128<64, 8>(k0, k1, lane); bitonic_step128<64, 4>(k0, k1, lane); bitonic_step128<64, 2>(k0, k1, lane); bitonic_step128<64, 1>(k0, k1, lane);
    bitonic_step128<128, 64>(k0, k1, lane); bitonic_step128<128, 32>(k0, k1, lane); bitonic_step128<128, 16>(k0, k1, lane); bitonic_step128<128, 8>(k0, k1, lane); bitonic_step128<128, 4>(k0, k1, lane); bitonic_step128<128, 2>(k0, k1, lane); bitonic_step128<128, 1>(k0, k1, lane);
}
__device__ __forceinline__ float sum8(float v) {
    v += __uint_as_float((unsigned)__builtin_amdgcn_update_dpp(0, (int)__float_as_uint(v), 0xB1, 0xf, 0xf, false));
    v += __uint_as_float((unsigned)__builtin_amdgcn_update_dpp(0, (int)__float_as_uint(v), 0x4E, 0xf, 0xf, false));
    v += __uint_as_float((unsigned)__builtin_amdgcn_update_dpp(0, (int)__float_as_uint(v), 0x141, 0xf, 0xf, false));
    return v;
}
#ifndef P8_STATIC
#define P8_STATIC 1
#endif
template <int MODE> __device__ __forceinline__ void p8_gather(Frame& F, const Params& p, const XcdBarrier& bar) {
    unsigned char* ws = p.ws;
    const bf16_t* H2 = (const bf16_t*)(ws + WS_H2); const unsigned char* U6 = ws + WS_UB; const unsigned char* V6 = ws + WS_VB;
    const int* EX = (const int*)(ws + WS_EXP); const float* USCT = (const float*)(ws + WS_USC); const float* VSCT = (const float*)(ws + WS_VSC); const float* mod = (const float*)(ws + WS_MOD);
    const int lane = F.lane, l5 = lane & 31, b5 = (lane >> 5) & 1, b4 = (lane >> 4) & 1, b3 = (lane >> 3) & 1;
    int sw4;
    { const unsigned cw = __builtin_amdgcn_cvt_scalef32_pk_fp4_f32(0u, 1.0f, 2.0f, 1.0f, 0); const f32x2 cr = __builtin_amdgcn_cvt_scalef32_pk_f32_fp4(cw, 1.0f, 0);
      sw4 = __builtin_amdgcn_readfirstlane(cr.x == 1.0f ? 0 : 1); }
    const unsigned mlo = (lane & 3) == 0 ? 0x0000FFFFu : ((lane & 3) == 1 ? 0xFFFF0000u : 0u), mhi = (lane & 3) == 2 ? 0x0000FFFFu : ((lane & 3) == 3 ? 0xFFFF0000u : 0u);
#define FP4BF(w_, b_) __builtin_bit_cast(unsigned, __builtin_amdgcn_cvt_scalef32_pk_bf16_fp4((w_), 1.0f, (b_)))
    const unsigned lofs = (unsigned)l5 * 16u;
    unsigned* ctr = (unsigned*)(ws + WS_CTL) + CW_P8CTR + (MODE != 0 ? 16 : 0);
    LAS unsigned* skl = (LAS unsigned*)(F.lds + F.wave * 1024);
    volatile LAS unsigned* tokslot = F.MISC + 110;
    const bool lead = F.wave == 0 && lane == 0;
    if (lead) tokslot[0] = P8_STATIC ? (unsigned)F.bid * 16u : __hip_atomic_fetch_add(ctr, 16u, __ATOMIC_RELAXED, __HIP_MEMORY_SCOPE_AGENT);
    __syncthreads();
    int base = (int)tokslot[0], round = 0;
    const int pmine = 2 * b4 + b3;
    for (;;) {
        if (base >= MLAT) break;
        unsigned nbase = 0u;
        if (lead) nbase = P8_STATIC ? (unsigned)((round + 1) * F.G + F.bid) * 16u : __hip_atomic_fetch_add(ctr, 16u, __ATOMIC_RELAXED, __HIP_MEMORY_SCOPE_AGENT);
        const int tA = base + 2 * F.wave, t = tA + b5;
        unsigned kA0 = (unsigned)EX[(size_t)tA * 128 + lane], kA1 = (unsigned)EX[(size_t)tA * 128 + 64 + lane];
        unsigned kB0 = (unsigned)EX[(size_t)tA * 128 + 128 + lane], kB1 = (unsigned)EX[(size_t)tA * 128 + 192 + lane];
        hs16x4 hb[8]; f32x4 acc[8];
        { const u32x2* hp = (const u32x2*)(H2 + (size_t)t * D + 4 * l5);
#pragma unroll
          for (int mm = 0; mm < 8; ++mm) { u32x2 w = hp[32 * mm];
              if (sw4) { w.x = __builtin_amdgcn_alignbit(w.x, w.x, 16); w.y = __builtin_amdgcn_alignbit(w.y, w.y, 16); }
              hb[mm] = __builtin_bit_cast(hs16x4, w); acc[mm] = (f32x4){0.f, 0.f, 0.f, 0.f}; } }
        sort128_asc(kA0, kA1, lane); sort128_asc(kB0, kB1, lane);
        skl[lane] = kA0; skl[64 + lane] = kA1; skl[128 + lane] = kB0; skl[192 + lane] = kB1;
        u32x4 u4[4], v4[4]; unsigned kmine; float vsc, usc;
#define P8_FETCH(bb_, U_, V_, KM_, VS_, US_) do { const int lb_ = (bb_) * 4; const u32x4 k4_ = *(const LAS u32x4*)(skl + b5 * 128 + lb_); KM_ = skl[b5 * 128 + lb_ + pmine]; \
            _Pragma("unroll") for (int pr = 0; pr < 4; ++pr) { const unsigned eo_ = ((((k4_[pr] & 0xFFFF0000u) >> 7) & (MODE == 1 ? 0x7FFFFu : (MODE == 3 ? 0xFFFu : 0xFFFFFFFFu)))) | lofs; \
                U_[pr] = *(const u32x4*)(U6 + eo_); V_[pr] = *(const u32x4*)(V6 + eo_); } \
            VS_ = VSCT[KM_ >> 16]; US_ = USCT[KM_ >> 16]; } while (0)
        P8_FETCH(0, u4, v4, kmine, vsc, usc);
#define P8_BATCH() do { \
            const float gl = __uint_as_float(kmine << 16) * vsc, sl = usc; \
            f32x4 dq[4]; \
_Pragma("unroll") \
            for (int pr = 0; pr < 4; ++pr) dq[pr] = (f32x4){0.f, 0.f, 0.f, 0.f}; \
_Pragma("unroll") \
            for (int j = 0; j < 4; ++j) { \
_Pragma("unroll") \
                for (int pr = 0; pr < 4; ++pr) { const unsigned c0 = FP4BF(u4[pr][j], 0), c1 = FP4BF(u4[pr][j], 1); \
                    dq[pr] = __builtin_amdgcn_mfma_f32_4x4x4bf16_1k(__builtin_bit_cast(hs16x4, (u32x2){c0, c1}), hb[2 * j], dq[pr], 0, 0, 0); } \
_Pragma("unroll") \
                for (int pr = 0; pr < 4; ++pr) { const unsigned c2 = FP4BF(u4[pr][j], 2), c3 = FP4BF(u4[pr][j], 3); \
                    dq[pr] = __builtin_amdgcn_mfma_f32_4x4x4bf16_1k(__builtin_bit_cast(hs16x4, (u32x2){c2, c3}), hb[2 * j + 1], dq[pr], 0, 0, 0); } \
            } \
            float d[4]; \
_Pragma("unroll") \
            for (int pr = 0; pr < 4; ++pr) d[pr] = (lane & 2) ? ((lane & 1) ? dq[pr][3] : dq[pr][2]) : ((lane & 1) ? dq[pr][1] : dq[pr][0]); \
            float r2[2], r1; \
_Pragma("unroll") \
            for (int i = 0; i < 2; ++i) { auto rr = __builtin_amdgcn_permlane16_swap(__float_as_uint(d[i]), __float_as_uint(d[i + 2]), false, false); r2[i] = __uint_as_float(rr[0]) + __uint_as_float(rr[1]); } \
            { const float keep = b3 ? r2[1] : r2[0], send = b3 ? r2[0] : r2[1]; r1 = keep + __uint_as_float((unsigned)__builtin_amdgcn_update_dpp(0, (int)__float_as_uint(send), 0x128, 0xf, 0xf, false)); } \
            r1 = sum8(r1); \
            const float pre = r1 * sl; \
            float act; \
            { const float av = fabsf(pre), dd = av * 0.2316418882f + 1.0f; const float tt = __builtin_amdgcn_rcpf(dd); \
              float q = tt * 0.5307027145f + (-0.7265760135f); q = q * tt + 0.7107068705f; q = q * tt + (-0.142248368f); q = q * tt + 0.127414796f; q = q * tt; \
              const float ee = __builtin_amdgcn_exp2f((pre * pre) * (-0.72134752044f)); \
              const float mm = pre * (q * ee); act = pre < 0.f ? mm : pre - mm; } \
            const float cfl = gl * act; \
            const unsigned cfpk_l = __builtin_bit_cast(unsigned, __builtin_convertvector((f32x2){cfl, cfl}, hbf16x2)); \
_Pragma("unroll") \
            for (int pr = 0; pr < 4; ++pr) { \
                const unsigned cfpk = (unsigned)__builtin_amdgcn_ds_bpermute(((pr >> 1) * 16 + (pr & 1) * 8 + 32 * b5) * 4, (int)cfpk_l); \
                const hs16x4 Aop = __builtin_bit_cast(hs16x4, (u32x2){cfpk & mlo, cfpk & mhi}); \
_Pragma("unroll") \
                for (int j = 0; j < 4; ++j) { \
                    const unsigned c0 = FP4BF(v4[pr][j], 0), c1 = FP4BF(v4[pr][j], 1), c2 = FP4BF(v4[pr][j], 2), c3 = FP4BF(v4[pr][j], 3); \
                    acc[2 * j] = __builtin_amdgcn_mfma_f32_4x4x4bf16_1k(Aop, __builtin_bit_cast(hs16x4, (u32x2){c0, c1}), acc[2 * j], 0, 0, 0); \
                    acc[2 * j + 1] = __builtin_amdgcn_mfma_f32_4x4x4bf16_1k(Aop, __builtin_bit_cast(hs16x4, (u32x2){c2, c3}), acc[2 * j + 1], 0, 0, 0); } \
            } \
        } while (0)
        for (int bb = 0; bb < 31; ++bb) {
            u32x4 un[4], vn[4]; unsigned kmn; float vsn, usn;
            P8_FETCH(bb + 1, un, vn, kmn, vsn, usn);
            P8_BATCH();
#pragma unroll
            for (int pr = 0; pr < 4; ++pr) { u4[pr] = un[pr]; v4[pr] = vn[pr]; }
            kmine = kmn; vsc = vsn; usc = usn;
        }
        u32x2 yraw[8], xraw[8];
        { const u32x2* yp = (const u32x2*)((const bf16_t*)(ws + WS_YO) + (size_t)t * D + 4 * l5); const u32x2* xp = (const u32x2*)((const bf16_t*)(ws + WS_XB) + (size_t)t * D + 4 * l5);
#pragma unroll
          for (int mm = 0; mm < 8; ++mm) { yraw[mm] = yp[32 * mm]; xraw[mm] = xp[32 * mm]; } }
        P8_BATCH();
#undef P8_BATCH
#undef P8_FETCH
        float s = 0.f, sy = 0.f; f32x4 yv[8];
        {
#pragma unroll
          for (int mm = 0; mm < 8; ++mm) { const u32x2 yw = yraw[mm]; yv[mm] = (f32x4){bflo(yw.x), bfhi(yw.x), bflo(yw.y), bfhi(yw.y)};
              sy += yv[mm].x * yv[mm].x + yv[mm].y * yv[mm].y + yv[mm].z * yv[mm].z + yv[mm].w * yv[mm].w; } }
#pragma unroll
        for (int mm = 0; mm < 8; ++mm) { if (sw4) acc[mm] = (f32x4){acc[mm].y, acc[mm].x, acc[mm].w, acc[mm].z}; s += acc[mm].x * acc[mm].x + acc[mm].y * acc[mm].y + acc[mm].z * acc[mm].z + acc[mm].w * acc[mm].w; }
        const float rstd = rsqrtf(half_sum(s) * (1.f / D) + EPS), rstd1 = rsqrtf(half_sum(sy) * (1.f / D) + EPS);
        const float* mbase = mod + (tA >> 12) * NMOD; const float* mb = mbase + 5 * D; const float* g3 = p.g_norm + 3 * D;
#pragma unroll
        for (int mm = 0; mm < 8; ++mm) { const int col = 128 * mm + 4 * l5;
            float* op = p.out + (size_t)t * D + col;
            const u32x2 xw = xraw[mm];
            const f32x4 g1 = *(const f32x4*)(p.g_norm + D + col), gt1 = *(const f32x4*)(mbase + 2 * D + col);
            const f32x4 x0 = (f32x4){bflo(xw.x), bfhi(xw.x), bflo(xw.y), bfhi(xw.y)} + gt1 * (yv[mm] * rstd1 * g1);
            const f32x4 ga = *(const f32x4*)(g3 + col), ta = *(const f32x4*)(mb + col);
            if (MODE == 0 || rstd == 123456.f) *(f32x4*)op = x0 + ta * (acc[mm] * rstd * ga); }
        ++round;
        if (lead) tokslot[round & 1] = nbase;
        __syncthreads();
        base = (int)tokslot[round & 1];
    }
}

namespace att {
typedef short bf16x8 __attribute__((ext_vector_type(8)));
typedef short s16x4 __attribute__((ext_vector_type(4)));
typedef float f32x16 __attribute__((ext_vector_type(16)));
typedef __attribute__((address_space(3))) const unsigned char* lcp;
typedef __attribute__((address_space(3))) unsigned char* lp;
constexpr int NA_SLOT = 16384, NA_BIAS_OFF = 32768, WSF_OFF = 155648;
constexpr int DF_SLOT = 32768;
constexpr float THRL = 8.f;

__device__ __forceinline__ int crow(int r, int hi) { return (r & 3) + 8 * (r >> 2) + 4 * hi; }
__device__ __forceinline__ s16x4 vtr(lcp p) { return __builtin_bit_cast(s16x4, __builtin_amdgcn_ds_read_tr16_b64_v4i16((__attribute__((address_space(3))) s16x4*)p)); }
typedef float f32x2_t __attribute__((ext_vector_type(2))); typedef __bf16 bf16x2v_t __attribute__((ext_vector_type(2)));
__device__ __forceinline__ unsigned cvtpk(float lo, float hi) { f32x2_t v = {lo, hi}; bf16x2v_t b = __builtin_convertvector(v, bf16x2v_t); return __builtin_bit_cast(unsigned, b); }
__device__ __forceinline__ float swap_half(float v) { auto rr = __builtin_amdgcn_permlane32_swap(__float_as_uint(v), __float_as_uint(v), false, false); return __uint_as_float(rr[0]) == v ? __uint_as_float(rr[1]) : __uint_as_float(rr[0]); }
__device__ __forceinline__ void dma16(const void* gsrc, lp lds_dst) {
    unsigned keep; const unsigned dst = (unsigned)__builtin_amdgcn_readfirstlane((int)(unsigned)(size_t)lds_dst);
    asm volatile("s_mov_b32 %0, m0\n\ts_mov_b32 m0, %2\n\ts_nop 0\n\tglobal_load_lds_dwordx4 %1, off\n\ts_mov_b32 m0, %0" : "=&s"(keep) : "v"(gsrc), "s"(dst) : "memory");
}
__device__ __forceinline__ float max3f(float a, float b, float c) { float r; asm("v_max3_f32 %0, %1, %2, %3" : "=v"(r) : "v"(a), "v"(b), "v"(c)); return r; }
__device__ __forceinline__ float rowmax32(const f32x16& p0, const f32x16& p1) {
    float a = max3f(p0[0], p0[1], p1[0]), b = max3f(p0[2], p0[3], p1[1]); a = max3f(a, p1[2], p1[3]);
#pragma unroll
    for (int r = 4; r < 16; r += 4) { a = max3f(a, p0[r], p0[r + 1]); b = max3f(b, p0[r + 2], p0[r + 3]); a = max3f(a, p1[r], p1[r + 1]); b = max3f(b, p1[r + 2], p1[r + 3]); }
    float m = max3f(a, b, b);
    auto rr = __builtin_amdgcn_permlane32_swap(__float_as_uint(m), __float_as_uint(m), false, false);
    return max3f(__uint_as_float(rr[0]), __uint_as_float(rr[1]), __uint_as_float(rr[1]));
}

typedef __bf16 bf16x2_t __attribute__((ext_vector_type(2)));
__device__ __forceinline__ float psum_bf16(const u32x4 (&pw)[4], float acc) {
    const bf16x2_t ones = __builtin_bit_cast(bf16x2_t, 0x3F803F80u); float a0 = acc, a1 = 0.f;
#pragma unroll
    for (int k = 0; k < 4; ++k) { a0 = __builtin_amdgcn_fdot2_f32_bf16(__builtin_bit_cast(bf16x2_t, pw[k][0]), ones, a0, false); a1 = __builtin_amdgcn_fdot2_f32_bf16(__builtin_bit_cast(bf16x2_t, pw[k][1]), ones, a1, false);
        a0 = __builtin_amdgcn_fdot2_f32_bf16(__builtin_bit_cast(bf16x2_t, pw[k][2]), ones, a0, false); a1 = __builtin_amdgcn_fdot2_f32_bf16(__builtin_bit_cast(bf16x2_t, pw[k][3]), ones, a1, false); }
    return a0 + a1;
}
template <int NDV> struct FlashState { float mhat, l; f32x16 negm; f32x16 o[NDV]; };

template <int NDV, bool BIAS>
__device__ __forceinline__ void flash_tile(FlashState<NDV>& st, const bf16x8 (&qr)[4], lcp Kslot, lcp Vslot, lcp Bslot, const bf16x8 (&qoh)[2],
                                           __attribute__((address_space(3))) float* wsf, int r32, int hi, int lane, bool first) {
    f32x16 p0 = st.negm, p1 = st.negm;
    lcp kb = Kslot + hi * 1024 + r32 * 16;
    bf16x8 kf[8], bf_[4];
#pragma unroll
    for (int d0 = 0; d0 < 4; ++d0) { kf[2 * d0] = *(const __attribute__((address_space(3))) bf16x8*)(kb + d0 * 2048); kf[2 * d0 + 1] = *(const __attribute__((address_space(3))) bf16x8*)(kb + d0 * 2048 + 512); }
    if (BIAS) { lcp bb = Bslot + hi * 1024 + r32 * 16;
#pragma unroll
        for (int e = 0; e < 2; ++e) { bf_[2 * e] = *(const __attribute__((address_space(3))) bf16x8*)(bb + e * 2048); bf_[2 * e + 1] = *(const __attribute__((address_space(3))) bf16x8*)(bb + e * 2048 + 512); } }
    lcp vb = Vslot + ((lane >> 4) & 1) * 32 + (lane & 3) * 8 + (4 * hi + ((lane & 15) >> 2)) * 64;
    s16x4 va[8], vn[8];
#pragma unroll
    for (int ks = 0; ks < 4; ++ks) { va[2 * ks] = vtr(vb + ks * 1024); va[2 * ks + 1] = vtr(vb + ks * 1024 + 512); }
#pragma unroll
    for (int d0 = 0; d0 < 4; ++d0) { p0 = __builtin_amdgcn_mfma_f32_32x32x16_bf16(kf[2 * d0], qr[d0], p0, 0, 0, 0); p1 = __builtin_amdgcn_mfma_f32_32x32x16_bf16(kf[2 * d0 + 1], qr[d0], p1, 0, 0, 0); }
    if (BIAS) {
#pragma unroll
        for (int e = 0; e < 2; ++e) { p0 = __builtin_amdgcn_mfma_f32_32x32x16_bf16(bf_[2 * e], qoh[e], p0, 0, 0, 0); p1 = __builtin_amdgcn_mfma_f32_32x32x16_bf16(bf_[2 * e + 1], qoh[e], p1, 0, 0, 0); }
    }
    asm volatile("s_nop 15\n\ts_nop 7" : "+v"(p0), "+v"(p1));
    const float rm = rowmax32(p0, p1);
    if (first) {
        st.mhat += rm;
#pragma unroll
        for (int r = 0; r < 16; ++r) { p0[r] -= rm; p1[r] -= rm; st.negm[r] = -st.mhat; }
    } else if (__any(rm > THRL)) {
        const float dl = fmaxf(rm, 0.f); const float alpha = __builtin_amdgcn_exp2f(-dl); st.mhat += dl; st.l *= alpha;
        if (hi == 0) wsf[r32] = alpha;
        asm volatile("s_waitcnt lgkmcnt(0)" ::: "memory");
        float al[16];
#pragma unroll
        for (int r = 0; r < 16; ++r) al[r] = wsf[crow(r, hi)];
#pragma unroll
        for (int d = 0; d < NDV; ++d)
#pragma unroll
            for (int r = 0; r < 16; ++r) st.o[d][r] *= al[r];
#pragma unroll
        for (int r = 0; r < 16; ++r) { p0[r] -= dl; p1[r] -= dl; st.negm[r] = -st.mhat; }
    }
    float sacc = 0.f;
#pragma unroll
    for (int r = 0; r < 16; ++r) { p0[r] = __builtin_amdgcn_exp2f(p0[r]); p1[r] = __builtin_amdgcn_exp2f(p1[r]); sacc += p0[r] + p1[r]; }
    st.l += sacc;
    u32x4 pw[4];
#pragma unroll
    for (int i = 0; i < 4; ++i) { pw[0][i] = cvtpk(p0[2 * i], p0[2 * i + 1]); pw[1][i] = cvtpk(p0[8 + 2 * i], p0[8 + 2 * i + 1]); pw[2][i] = cvtpk(p1[2 * i], p1[2 * i + 1]); pw[3][i] = cvtpk(p1[8 + 2 * i], p1[8 + 2 * i + 1]); }
    __builtin_amdgcn_sched_barrier(0);
#pragma unroll
    for (int d0 = 0; d0 < NDV; ++d0) {
#pragma unroll
        for (int ks = 0; ks < 4; ++ks) {
            if (d0 < NDV - 1) { vn[2 * ks] = vtr(vb + (d0 + 1) * 4096 + ks * 1024); vn[2 * ks + 1] = vtr(vb + (d0 + 1) * 4096 + ks * 1024 + 512); }
            const bf16x8 vf = (bf16x8){va[2 * ks][0], va[2 * ks][1], va[2 * ks][2], va[2 * ks][3], va[2 * ks + 1][0], va[2 * ks + 1][1], va[2 * ks + 1][2], va[2 * ks + 1][3]};
            st.o[d0] = __builtin_amdgcn_mfma_f32_32x32x16_bf16(__builtin_bit_cast(bf16x8, pw[ks]), vf, st.o[d0], 0, 0, 0);
            __builtin_amdgcn_sched_barrier(0);
        }
#pragma unroll
        for (int i = 0; i < 8; ++i) va[i] = vn[i];
    }
}

constexpr int NA2_SLOT = 16384, NA2_BIAS_OFF = 65536;
__device__ __forceinline__ void na_units(Frame& F, const Params& p) {
    unsigned char* ws = p.ws;
    const bf16_t* QA = (const bf16_t*)(ws + WS_QA); const bf16_t* KA = (const bf16_t*)(ws + WS_KA); const bf16_t* VA = (const bf16_t*)(ws + WS_VA);
    const bf16_t* BT = (const bf16_t*)(ws + WS_BIAST); bf16_t* Y = (bf16_t*)(ws + WS_Y);
    const int lane = F.lane, r32 = lane & 31, hi = lane >> 5, wave = F.wave;
    lp lds = (lp)F.lds;
    __attribute__((address_space(3))) float* wsf = (__attribute__((address_space(3))) float*)(lds + WSF_OFF) + wave * 64;
    const int upw = 1024 / F.G;
    int cur_h = -1, cur_lo = -1, cur_hi = -1;
    bf16x8 qoh[2];
#pragma unroll
    for (int e = 0; e < 2; ++e)
#pragma unroll
        for (int j = 0; j < 8; ++j) qoh[e][j] = (16 * e + 8 * hi + j == r32) ? (short)0x3F80 : (short)0;
    for (int ui = 0; ui < upw; ++ui) {
        int bh, rg;
        if (F.G == 256) { bh = (F.bid & 7) * 8 + (F.bid >> 5); rg = ((F.bid >> 3) & 3) * 4 + ui; } else { const int u = F.bid * upw + ui; bh = u >> 4; rg = u & 15; }
        const int b = bh >> 3, h = bh & 7;
        const int r0 = rg * 4, r = r0 + (wave >> 1), ch = wave & 1;
        int rs = r - 4; rs = rs < 0 ? 0 : (rs > 56 ? 56 : rs);
        int kr_lo = r0 - 4; kr_lo = kr_lo < 0 ? 0 : (kr_lo > 56 ? 56 : kr_lo);
        int kr_hi = r0 + 3 - 4; kr_hi = kr_hi < 0 ? 0 : (kr_hi > 56 ? 56 : kr_hi); kr_hi += 7;
        const int T = 4 + (kr_hi - kr_lo + 1);
        int dr_lo = 99, dr_hi = -1;
#pragma unroll
        for (int q = 0; q < 4; ++q) { int s_ = r0 + q - 4; s_ = s_ < 0 ? 0 : (s_ > 56 ? 56 : s_); const int a = s_ - (r0 + q) + 7; dr_lo = a < dr_lo ? a : dr_lo; dr_hi = a + 7 > dr_hi ? a + 7 : dr_hi; }
        const bf16_t* Kb = KA + (size_t)bh * NKT * 4096; const bf16_t* Vb = VA + (size_t)bh * NKT * 4096;
        if (h != cur_h || dr_lo != cur_lo || dr_hi != cur_hi) {
            cur_h = h; cur_lo = dr_lo; cur_hi = dr_hi;
            const unsigned char* src = (const unsigned char*)(BT + ((size_t)h * 15 + dr_lo) * 4096);
            const int npc = (dr_hi - dr_lo + 1) * 8;
            for (int pi = wave; pi < npc; pi += 8) dma16(src + pi * 1024 + lane * 16, lds + NA2_BIAS_OFF + pi * 1024);
        }
        bf16x8 qr[4];
        { const bf16_t* qp = QA + ((size_t)bh * SEQ + r * 64 + ch * 32 + r32) * 64 + hi * 8;
#pragma unroll
          for (int d0 = 0; d0 < 4; ++d0) qr[d0] = *(const bf16x8*)(qp + d0 * 16); }
#define NA_DMA(i_) do { const int tg_ = (i_) < 4 ? (i_) : (4 + kr_lo + (i_) - 4); lp sl_ = lds + ((i_) & 3) * NA2_SLOT; \
            dma16((const unsigned char*)(Kb + (size_t)tg_ * 4096) + wave * 1024 + lane * 16, sl_ + wave * 1024); \
            dma16((const unsigned char*)(Vb + (size_t)tg_ * 4096) + wave * 1024 + lane * 16, sl_ + 8192 + wave * 1024); } while (0)
        NA_DMA(0); NA_DMA(1);
        FlashState<2> st; st.mhat = 0.f; st.l = 0.f;
#pragma unroll
        for (int rr = 0; rr < 16; ++rr) st.negm[rr] = 0.f;
#pragma unroll
        for (int d = 0; d < 2; ++d)
#pragma unroll
            for (int rr = 0; rr < 16; ++rr) st.o[d][rr] = 0.f;
        for (int i = 0; i < T; ++i) {
            if (i + 1 < T) asm volatile("s_waitcnt vmcnt(2)" ::: "memory"); else asm volatile("s_waitcnt vmcnt(0)" ::: "memory");
            __syncthreads();
            if (i + 2 < T) NA_DMA(i + 2);
            lcp sl = (lcp)(lds + (i & 3) * NA2_SLOT);
            if (i < 4) flash_tile<2, false>(st, qr, sl, sl + 8192, sl, qoh, wsf, r32, hi, lane, i == 0);
            else { const int kr = kr_lo + (i - 4);
                if (kr >= rs && kr < rs + 8) { const int dr = kr - r + 7;
                    flash_tile<2, true>(st, qr, sl, sl + 8192, (lcp)(lds + NA2_BIAS_OFF + (dr - dr_lo) * 8192 + ch * 4096), qoh, wsf, r32, hi, lane, false); } }
        }
#undef NA_DMA
        float lt = st.l; { auto rr = __builtin_amdgcn_permlane32_swap(__float_as_uint(lt), __float_as_uint(lt), false, false); lt = __uint_as_float(rr[0]) + __uint_as_float(rr[1]); }
        if (hi == 0) wsf[32 + r32] = lt;
        asm volatile("s_waitcnt lgkmcnt(0)" ::: "memory");
        bf16_t* yb = Y + ((size_t)b * SEQ + r * 64 + ch * 32) * D + h * 64 + r32;
#pragma unroll
        for (int rr = 0; rr < 16; ++rr) { const float rl = __builtin_amdgcn_rcpf(wsf[32 + crow(rr, hi)]);
#pragma unroll
            for (int d0 = 0; d0 < 2; ++d0) yb[(size_t)crow(rr, hi) * D + d0 * 32] = (bf16_t)f2bf(st.o[d0][rr] * rl); }
        __syncthreads();
    }
}

template <int MODE> __device__ __forceinline__ void diff_units_v2(Frame& F, const Params& p) {
    unsigned char* ws = p.ws;
    const bf16_t* QD = (const bf16_t*)(ws + WS_QD); const bf16_t* KD = (const bf16_t*)(ws + WS_KD); const bf16_t* VD = (const bf16_t*)(ws + WS_VD);
    bf16_t* Y = (bf16_t*)(ws + WS_Y);
    const float lam = *(const float*)(ws + WS_LAM);
    const int lane = F.lane, r32 = lane & 31, hi = lane >> 5, wave = F.wave, map = wave >> 2, qg = wave & 3;
    lp lds = (lp)F.lds;
    __attribute__((address_space(3))) float* wsf = (__attribute__((address_space(3))) float*)(lds + WSF_OFF) + wave * 64;
    __attribute__((address_space(3))) float* X = (__attribute__((address_space(3))) float*)lds;
    const int upw = 1024 / F.G;
    const int koff = map * 8192 + hi * 1024 + r32 * 16;
    const int voff = 16384 + ((lane >> 4) & 1) * 32 + (lane & 3) * 8 + (4 * hi + ((lane & 15) >> 2)) * 64;
    for (int ui = 0; ui < upw; ++ui) {
        int bh, qb;
        if (F.G == 256) { bh = (F.bid & 7) * 4 + ui; qb = F.bid >> 3; } else { const int u = F.bid * upw + ui; bh = u >> 5; qb = u & 31; }
        const int b = bh >> 2, h = bh & 3;
        const unsigned char* K1 = (const unsigned char*)(KD + (size_t)((b * 2 + 0) * 4 + h) * NKT * 4096);
        const unsigned char* K2 = (const unsigned char*)(KD + (size_t)((b * 2 + 1) * 4 + h) * NKT * 4096);
        const unsigned char* Vg = (const unsigned char*)(VD + (size_t)bh * NKT * 8192);
#define DF_DMA(t, slot) do { if (MODE != 1 && MODE != 3) { lp sl_ = lds + (slot) * DF_SLOT; \
            dma16(K1 + (size_t)(t) * 8192 + wave * 1024 + lane * 16, sl_ + wave * 1024); \
            dma16(K2 + (size_t)(t) * 8192 + wave * 1024 + lane * 16, sl_ + 8192 + wave * 1024); \
            dma16(Vg + (size_t)(t) * 16384 + wave * 1024 + lane * 16, sl_ + 16384 + wave * 1024); \
            dma16(Vg + (size_t)(t) * 16384 + 8192 + wave * 1024 + lane * 16, sl_ + 24576 + wave * 1024); } } while (0)
        DF_DMA(0, 0); DF_DMA(1, 1);
        const int q0 = qb * 128 + qg * 32;
        bf16x8 qr[4];
        { const bf16_t* qp = QD + ((size_t)((b * 2 + map) * 4 + h) * SEQ + q0 + r32) * 64 + hi * 8;
#pragma unroll
          for (int d0 = 0; d0 < 4; ++d0) qr[d0] = *(const bf16x8*)(qp + d0 * 16); }
        float mhat = 0.f, lsum = 0.f; f32x16 o[4], negm;
#pragma unroll
        for (int d = 0; d < 4; ++d)
#pragma unroll
            for (int rr = 0; rr < 16; ++rr) o[d][rr] = 0.f;
        asm volatile("s_waitcnt vmcnt(0)" ::: "memory");
        __syncthreads();
        f32x16 s0, s1;
#pragma unroll
        for (int rr = 0; rr < 16; ++rr) { s0[rr] = 0.f; s1[rr] = 0.f; }
        { lcp kb = (lcp)(lds + koff);
#pragma unroll
          for (int d0 = 0; d0 < 4; ++d0) {
              const bf16x8 b0 = *(const __attribute__((address_space(3))) bf16x8*)(kb + d0 * 2048), b1 = *(const __attribute__((address_space(3))) bf16x8*)(kb + d0 * 2048 + 512);
              s0 = __builtin_amdgcn_mfma_f32_32x32x16_bf16(b0, qr[d0], s0, 0, 0, 0); s1 = __builtin_amdgcn_mfma_f32_32x32x16_bf16(b1, qr[d0], s1, 0, 0, 0); } }
        { asm volatile("s_nop 15\n\ts_nop 7" : "+v"(s0), "+v"(s1)); const float rm0 = rowmax32(s0, s1); mhat = rm0;
#pragma unroll
          for (int rr = 0; rr < 16; ++rr) { s0[rr] -= rm0; s1[rr] -= rm0; negm[rr] = -rm0; } }
        u32x4 pw[4];
#define EXP4(X, B) do { X[B] = __builtin_amdgcn_exp2f(X[B]); X[B + 1] = __builtin_amdgcn_exp2f(X[B + 1]); X[B + 2] = __builtin_amdgcn_exp2f(X[B + 2]); X[B + 3] = __builtin_amdgcn_exp2f(X[B + 3]); sacc += X[B]; asm("" : "+v"(sacc)); sacc1 += X[B + 1]; asm("" : "+v"(sacc1)); sacc2 += X[B + 2]; asm("" : "+v"(sacc2)); sacc3 += X[B + 3]; asm("" : "+v"(sacc3)); } while (0)
#define STAGE_A(t_) do { \
            lcp nxt = (lcp)(lds + (((t_) + 1) & 3) * DF_SLOT); \
            bf16x8 kf[8]; \
            _Pragma("unroll") for (int d0 = 0; d0 < 4; ++d0) { kf[2 * d0] = *(const __attribute__((address_space(3))) bf16x8*)(nxt + koff + d0 * 2048); kf[2 * d0 + 1] = *(const __attribute__((address_space(3))) bf16x8*)(nxt + koff + d0 * 2048 + 512); } \
            asm volatile("s_nop 15\n\ts_nop 7" : "+v"(s0), "+v"(s1)); \
            const float rm = rowmax32(s0, s1); \
            if (__any(rm > THRL)) { \
                const float dl = fmaxf(rm, 0.f); const float alpha = __builtin_amdgcn_exp2f(-dl); mhat += dl; lsum *= alpha; \
                if (hi == 0) wsf[r32] = alpha; \
                asm volatile("s_waitcnt lgkmcnt(0)" ::: "memory"); \
                float al[16]; \
                _Pragma("unroll") for (int r = 0; r < 16; ++r) al[r] = wsf[crow(r, hi)]; \
                _Pragma("unroll") for (int d = 0; d < 4; ++d) _Pragma("unroll") for (int r = 0; r < 16; ++r) o[d][r] *= al[r]; \
                _Pragma("unroll") for (int r = 0; r < 16; ++r) { s0[r] -= dl; s1[r] -= dl; negm[r] = -mhat; } \
            } \
            f32x16 n0, n1; float sacc = 0.f, sacc1 = 0.f, sacc2 = 0.f, sacc3 = 0.f; \
            __builtin_amdgcn_sched_barrier(0); \
            n0 = __builtin_amdgcn_mfma_f32_32x32x16_bf16(kf[0], qr[0], negm, 0, 0, 0); EXP4(s0, 0);  __builtin_amdgcn_sched_barrier(0); \
            n1 = __builtin_amdgcn_mfma_f32_32x32x16_bf16(kf[1], qr[0], negm, 0, 0, 0); EXP4(s0, 4);  __builtin_amdgcn_sched_barrier(0); \
            n0 = __builtin_amdgcn_mfma_f32_32x32x16_bf16(kf[2], qr[1], n0, 0, 0, 0); EXP4(s0, 8);  __builtin_amdgcn_sched_barrier(0); \
            n1 = __builtin_amdgcn_mfma_f32_32x32x16_bf16(kf[3], qr[1], n1, 0, 0, 0); EXP4(s0, 12); __builtin_amdgcn_sched_barrier(0); \
            n0 = __builtin_amdgcn_mfma_f32_32x32x16_bf16(kf[4], qr[2], n0, 0, 0, 0); EXP4(s1, 0);  __builtin_amdgcn_sched_barrier(0); \
            n1 = __builtin_amdgcn_mfma_f32_32x32x16_bf16(kf[5], qr[2], n1, 0, 0, 0); EXP4(s1, 4);  __builtin_amdgcn_sched_barrier(0); \
            n0 = __builtin_amdgcn_mfma_f32_32x32x16_bf16(kf[6], qr[3], n0, 0, 0, 0); EXP4(s1, 8);  __builtin_amdgcn_sched_barrier(0); \
            n1 = __builtin_amdgcn_mfma_f32_32x32x16_bf16(kf[7], qr[3], n1, 0, 0, 0); EXP4(s1, 12); __builtin_amdgcn_sched_barrier(0); \
            _Pragma("unroll") for (int i = 0; i < 4; ++i) { pw[0][i] = cvtpk(s0[2 * i], s0[2 * i + 1]); pw[1][i] = cvtpk(s0[8 + 2 * i], s0[8 + 2 * i + 1]); pw[2][i] = cvtpk(s1[2 * i], s1[2 * i + 1]); pw[3][i] = cvtpk(s1[8 + 2 * i], s1[8 + 2 * i + 1]); } \
            lsum += (sacc + sacc1) + (sacc2 + sacc3); \
            s0 = n0; s1 = n1; \
        } while (0)
#define STAGE_B(tl_) do { \
            lcp vb = (lcp)(lds + ((tl_) & 3) * DF_SLOT) + voff; \
            s16x4 va[8], vn[8]; \
            _Pragma("unroll") for (int ks = 0; ks < 4; ++ks) { va[2 * ks] = vtr(vb + ks * 1024); va[2 * ks + 1] = vtr(vb + ks * 1024 + 512); } \
            __builtin_amdgcn_sched_barrier(0); \
            _Pragma("unroll") for (int d0 = 0; d0 < 4; ++d0) { \
                _Pragma("unroll") for (int ks = 0; ks < 4; ++ks) { \
                    if (d0 < 3) { vn[2 * ks] = vtr(vb + (d0 + 1) * 4096 + ks * 1024); vn[2 * ks + 1] = vtr(vb + (d0 + 1) * 4096 + ks * 1024 + 512); } \
                    const bf16x8 vf = (bf16x8){va[2 * ks][0], va[2 * ks][1], va[2 * ks][2], va[2 * ks][3], va[2 * ks + 1][0], va[2 * ks + 1][1], va[2 * ks + 1][2], va[2 * ks + 1][3]}; \
                    o[d0] = __builtin_amdgcn_mfma_f32_32x32x16_bf16(__builtin_bit_cast(bf16x8, pw[ks]), vf, o[d0], 0, 0, 0); \
                    __builtin_amdgcn_sched_barrier(0); \
                } \
                _Pragma("unroll") for (int i = 0; i < 8; ++i) va[i] = vn[i]; \
            } \
        } while (0)
        for (int t = 0; t < NKT; ++t) {
            if (t > 0) { asm volatile("s_waitcnt vmcnt(0)" ::: "memory"); if (MODE != 3) __syncthreads(); }
            if (t + 2 < NKT) DF_DMA(t + 2, (t + 2) & 3);
            if (MODE != 2) {
                if (map == 1 && t > 0) STAGE_B(t - 1);
                STAGE_A(t);
                if (map == 0) STAGE_B(t);
            }
        }
        if (MODE != 2 && map == 1) STAGE_B(NKT - 1);
#undef STAGE_A
#undef STAGE_B
#undef EXP4
#undef DF_DMA
        float lt = lsum; { auto rr = __builtin_amdgcn_permlane32_swap(__float_as_uint(lt), __float_as_uint(lt), false, false); lt = __uint_as_float(rr[0]) + __uint_as_float(rr[1]); }
        if (hi == 0) wsf[32 + r32] = lt;
        asm volatile("s_waitcnt lgkmcnt(0)" ::: "memory");
#pragma unroll
        for (int rr = 0; rr < 16; ++rr) { const float rl = __builtin_amdgcn_rcpf(wsf[32 + crow(rr, hi)]);
#pragma unroll
            for (int d = 0; d < 4; ++d) o[d][rr] *= rl; }
        __syncthreads();
        if (map == 1) {
#pragma unroll
            for (int d = 0; d < 4; ++d)
#pragma unroll
                for (int rr = 0; rr < 16; ++rr) X[((qg * 4 + d) * 16 + rr) * 64 + lane] = o[d][rr];
        }
        __syncthreads();
        if (map == 0 && (MODE == 0 || lam == 123456.f)) {
            float ss[16];
#pragma unroll
            for (int rr = 0; rr < 16; ++rr) { float s = 0.f;
#pragma unroll
                for (int d = 0; d < 4; ++d) { const float v = o[d][rr] - lam * X[((qg * 4 + d) * 16 + rr) * 64 + lane]; o[d][rr] = v; s += v * v; }
                ss[rr] = s; }
#pragma unroll
            for (int oo = 1; oo < 32; oo <<= 1)
#pragma unroll
                for (int rr = 0; rr < 16; ++rr) ss[rr] += __shfl_xor(ss[rr], oo);
            float g[4];
#pragma unroll
            for (int d = 0; d < 4; ++d) g[d] = p.diff_subln[d * 32 + r32] * (1.f - LAMBDA_INIT);
            bf16_t* yb = Y + ((size_t)b * SEQ + q0) * D + 512 + h * 128 + r32;
#pragma unroll
            for (int rr = 0; rr < 16; ++rr) { const float rn = rsqrtf(ss[rr] * (1.f / 128.f) + EPS);
#pragma unroll
                for (int d = 0; d < 4; ++d) yb[(size_t)crow(rr, hi) * D + d * 32] = (bf16_t)f2bf(o[d][rr] * rn * g[d]); }
        }
        __syncthreads();
    }
}
}

__device__ __forceinline__ void p3_attention(Frame& F, const Params& p) {
    att::na_units(F, p);
    att::diff_units_v2<0>(F, p);
}

namespace tk {
typedef short bf16x8 __attribute__((ext_vector_type(8)));
typedef float f32x16 __attribute__((ext_vector_type(16)));
constexpr int WLK_OFF = 65536;
__device__ __forceinline__ unsigned ord(float f) { const unsigned u = __float_as_uint(f); return u ^ ((unsigned)((int)u >> 31) | 0x80000000u); }
__device__ __forceinline__ float unord(unsigned o) { return __uint_as_float(o ^ ((o & 0x80000000u) ? 0x80000000u : 0xFFFFFFFFu)); }
__device__ __forceinline__ void cs_desc(unsigned& a, unsigned& b) { unsigned mx, mn; asm("v_max_f32 %0, %2, %3\n\tv_min_f32 %1, %2, %3" : "=&v"(mx), "=&v"(mn) : "v"(a), "v"(b)); a = mx; b = mn; }
__device__ __forceinline__ unsigned fmax_bits(unsigned a, unsigned b) { unsigned r; asm("v_max_f32 %0, %1, %2" : "=v"(r) : "v"(a), "v"(b)); return r; }
__device__ __forceinline__ void sort16_desc(unsigned (&v)[16]) {
#define CS_(a, b) cs_desc(v[a], v[b])
    CS_(0, 13); CS_(1, 12); CS_(2, 15); CS_(3, 14); CS_(4, 8); CS_(5, 6); CS_(7, 11); CS_(9, 10);
    CS_(0, 5); CS_(1, 7); CS_(2, 9); CS_(3, 4); CS_(6, 13); CS_(8, 14); CS_(10, 15); CS_(11, 12);
    CS_(0, 1); CS_(2, 3); CS_(4, 5); CS_(6, 8); CS_(7, 9); CS_(10, 11); CS_(12, 13); CS_(14, 15);
    CS_(0, 2); CS_(1, 3); CS_(4, 10); CS_(5, 11); CS_(6, 7); CS_(8, 9); CS_(12, 14); CS_(13, 15);
    CS_(1, 2); CS_(3, 12); CS_(4, 6); CS_(5, 7); CS_(8, 10); CS_(9, 11); CS_(13, 14);
    CS_(1, 4); CS_(2, 6); CS_(5, 8); CS_(7, 10); CS_(9, 13); CS_(11, 14);
    CS_(2, 4); CS_(3, 6); CS_(9, 12); CS_(11, 13);
    CS_(3, 5); CS_(6, 8); CS_(7, 9); CS_(10, 12);
    CS_(3, 4); CS_(5, 6); CS_(7, 8); CS_(9, 10); CS_(11, 12);
    CS_(6, 7); CS_(8, 9);
#undef CS_
}
__device__ __forceinline__ void bmerge16_desc(unsigned (&v)[16]) {
#pragma unroll
    for (int j = 8; j > 0; j >>= 1)
#pragma unroll
        for (int i = 0; i < 16; ++i) { const int l = i ^ j; if (l > i) cs_desc(v[i], v[l]); }
}
__device__ __forceinline__ void merge_top16(unsigned (&a)[16], const unsigned (&b)[16]) {
#pragma unroll
    for (int i = 0; i < 16; ++i) a[i] = fmax_bits(a[i], b[15 - i]);
    bmerge16_desc(a);
}
__device__ __forceinline__ void top16_of_64x2(unsigned (&v0)[16], unsigned (&v1)[16], unsigned (&v2)[16], unsigned (&v3)[16]) {
    sort16_desc(v0); sort16_desc(v1); sort16_desc(v2); sort16_desc(v3);
    merge_top16(v0, v1); merge_top16(v2, v3); merge_top16(v0, v2);
    unsigned pb[16];
#pragma unroll
    for (int i = 0; i < 16; ++i) pb[i] = (unsigned)__shfl_xor((int)v0[i], 32);
    merge_top16(v0, pb);
}
}

__device__ __forceinline__ void p7_topk(Frame& F, const Params& p) {
    using namespace tk;
    unsigned char* ws = p.ws;
    const bf16_t* Q2 = (const bf16_t*)(ws + WS_Q2); const unsigned char* KI = (const unsigned char*)(ws + WS_KEYSI);
    int* EX = (int*)(ws + WS_EXP); float* GT = (float*)(ws + WS_GATE); float* SUo = (float*)(ws + WS_SU);
    const float* USC = (const float*)(ws + WS_USC); const float* VSC = (const float*)(ws + WS_VSC);
    const int lane = F.lane, r32 = lane & 31, hi = lane >> 5, wave = F.wave;
    att::lp lds = (att::lp)F.lds;
    LAS int* W = (LAS int*)(F.lds + WLK_OFF + wave * 8192);
    const int ntask = 1024 / F.G;
    const bool bmap = F.G == 256;
    const int h = bmap ? ((F.bid >> 3) & 7) : (F.bid & 7);
    const int tbase = bmap ? (F.bid & 7) * 16 + (F.bid >> 6) * 4 : (F.bid >> 3) * ntask;
    { const unsigned char* src = KI + (size_t)h * 65536;
      for (int k = 0; k < 8; ++k) { const int pi = wave + 8 * k; att::dma16(src + pi * 1024 + lane * 16, lds + pi * 1024); } }
    asm volatile("s_waitcnt vmcnt(0)" ::: "memory");
    __syncthreads();
    bf16x8 qf[8], qn[8];
    { const int tb32 = tbase * 8 + wave;
      const bf16_t* qp = Q2 + ((((size_t)tb32 * 8 + h) * 2 + 0) * 8 * 2 + hi) * 256 + r32 * 8;
#pragma unroll
      for (int s = 0; s < 8; ++s) qn[s] = *(const bf16x8*)(qp + s * 512); }
    for (int ti = 0; ti < ntask; ++ti) {
        const int tb = tbase + ti;
        const int t = tb * 256 + wave * 32 + r32;
        unsigned A[16], B[16];
#pragma unroll
        for (int pp = 0; pp < 2; ++pp) {
#pragma unroll
            for (int s = 0; s < 8; ++s) qf[s] = qn[s];
            { const int nti = pp == 0 ? ti : ti + 1, npp = pp ^ 1;
              if (nti < ntask) { const int tb32 = (tbase + nti) * 8 + wave;
                  const bf16_t* qp = Q2 + ((((size_t)tb32 * 8 + h) * 2 + npp) * 8 * 2 + hi) * 256 + r32 * 8;
#pragma unroll
                  for (int s = 0; s < 8; ++s) qn[s] = *(const bf16x8*)(qp + s * 512); } }
            f32x16 acc[4];
#pragma unroll
            for (int kb = 0; kb < 4; ++kb)
#pragma unroll
                for (int r = 0; r < 16; ++r) acc[kb][r] = 0.f;
            att::lcp ab = (att::lcp)(lds + pp * 32768 + hi * 2048 + r32 * 16);
#pragma unroll
            for (int s = 0; s < 8; ++s)
#pragma unroll
                for (int kb = 0; kb < 4; ++kb) {
                    const bf16x8 a = *(const __attribute__((address_space(3))) bf16x8*)(ab + s * 4096 + kb * 512);
                    acc[kb] = __builtin_amdgcn_mfma_f32_32x32x16_bf16(a, qf[s], acc[kb], 0, 0, 0);
                }
            unsigned v0[16], v1[16], v2[16], v3[16];
#pragma unroll
            for (int r = 0; r < 16; ++r) {
                const int c = 127 - ((r & 3) + 8 * (r >> 2));
                v0[r] = (__float_as_uint(acc[0][r]) & 0xFFFFFF80u) | (unsigned)(c - 0 - 4 * hi);
                v1[r] = (__float_as_uint(acc[1][r]) & 0xFFFFFF80u) | (unsigned)(c - 32 - 4 * hi);
                v2[r] = (__float_as_uint(acc[2][r]) & 0xFFFFFF80u) | (unsigned)(c - 64 - 4 * hi);
                v3[r] = (__float_as_uint(acc[3][r]) & 0xFFFFFF80u) | (unsigned)(c - 96 - 4 * hi);
            }
            top16_of_64x2(v0, v1, v2, v3);
            if (pp == 0) {
#pragma unroll
                for (int i = 0; i < 16; ++i) A[i] = v0[i];
            } else {
#pragma unroll
                for (int i = 0; i < 16; ++i) B[i] = v0[i];
            }
        }
        CvRows cvr; convert_load(p, ((F.bid * 8 + wave) * ntask + ti) * 2, lane, cvr);
        float fa[16], fb[16];
#pragma unroll
        for (int i = 0; i < 16; ++i) { fa[i] = __uint_as_float(A[i] & 0xFFFFFF80u); fb[i] = __uint_as_float(B[i] & 0xFFFFFF80u);
            W[i * 64 + lane] = 127 - (int)(A[i] & 127u); W[(16 + i) * 64 + lane] = 127 - (int)(B[i] & 127u); }
        unsigned c0[16], c1[16], c2[16], c3[16];
#pragma unroll
        for (int j = 0; j < 16; ++j) c0[j] = (__float_as_uint(fa[0] + fb[j]) & 0xFFFFFF00u) | (unsigned)(255 - j);
        {
            int n = 0;
#pragma unroll
            for (int i = 1; i < 16; ++i)
#pragma unroll
                for (int j = 0; j < 16; ++j) if ((i + 1) * (j + 1) <= 16) {
                    const unsigned key = (__float_as_uint(fa[i] + fb[j]) & 0xFFFFFF00u) | (unsigned)(255 - (i * 16 + j));
                    if (n < 16) c1[n] = key; else if (n < 32) c2[n - 16] = key; else c3[n - 32] = key;
                    ++n;
                }
#pragma unroll
            for (int k = 2; k < 16; ++k) c3[k] = 0xFF800000u;
        }
        sort16_desc(c1); sort16_desc(c2); cs_desc(c3[0], c3[1]);
        merge_top16(c0, c1); merge_top16(c2, c3); merge_top16(c0, c2);
        float ev[16]; float l = 0.f; const float mx = __uint_as_float(c0[0] & 0xFFFFFF00u);
#pragma unroll
        for (int k = 0; k < 16; ++k) { ev[k] = __expf(__uint_as_float(c0[k] & 0xFFFFFF00u) - mx); l += ev[k]; }
        const float rl = 1.f / l;
        unsigned pk[8];
#pragma unroll
        for (int kk = 0; kk < 8; ++kk) {
            const unsigned key = hi ? c0[8 + kk] : c0[kk]; const float e = hi ? ev[8 + kk] : ev[kk];
            const int pos = 255 - (int)(key & 255u);
            const int ex = W[(pos >> 4) * 64 + lane] * 128 + W[(16 + (pos & 15)) * 64 + lane];
            pk[kk] = ((unsigned)ex << 16) | (unsigned)f2bf(e * rl);
        }
        int* ep = EX + (size_t)t * 128 + h * 16 + hi * 8;
        *(u32x4*)ep = (u32x4){pk[0], pk[1], pk[2], pk[3]}; *(u32x4*)(ep + 4) = (u32x4){pk[4], pk[5], pk[6], pk[7]};
        convert_finish(p, ((F.bid * 8 + wave) * ntask + ti) * 2, lane, cvr);
    }
    __syncthreads();
}

#define P8_SYNC 0
#define P8_PARTITION 0
#define HAVE_P3 1
#define HAVE_P7 1
struct Args { Params p; int ph_lo, ph_hi, li, pad; };
__global__ void __launch_bounds__(NTHR, 2) mk_fwd(Args a) {
    extern __shared__ __attribute__((aligned(16))) unsigned char lds[];
    Frame F;
    F.lds = (LAS unsigned char*)lds;
    F.MISC = (volatile LAS unsigned*)(F.lds + MISC_OFF);
    F.tid = threadIdx.x; F.lane = F.tid & 63; F.wave = __builtin_amdgcn_readfirstlane(F.tid >> 6);
    F.G = gridDim.x; F.bid = blockIdx.x;
    const Params& p = a.p;
    gu32* ctl = (gu32*)(p.ws + WS_CTL);
    for (int u = F.tid; u < 128; u += NTHR) ((LAS unsigned*)(F.lds + MISC_OFF))[u] = 0u;
    __syncthreads();
    XcdBarrier bar = xcd_barrier_post((unsigned*)(ctl + CW_BAR) + a.li * XCD_BAR_WORDS, F.MISC + 8);
    if (F.tid == 0 && (unsigned)(F.bid & 7) != bar.x) (void)xb_add((unsigned*)ctl + CW_MISPLACED, 1u);
    bool local_ok = false;
    const int lo = a.ph_lo, hi = a.ph_hi;
#ifdef PROBE_TS
    int nts_ = 0;
#define STAMP() do { if (threadIdx.x == 0 && nts_ < 12) { const unsigned long long t_ = __builtin_amdgcn_s_memrealtime(); F.MISC[32 + 2 * nts_] = (unsigned)t_; F.MISC[33 + 2 * nts_] = (unsigned)(t_ >> 32); } ++nts_; } while (0)
    STAMP();
#else
#define STAMP() do {} while (0)
#endif
#define IN(k) (lo <= (k) && (k) < hi)
#define REFRESH() do { F.lane = (int)__builtin_amdgcn_mbcnt_hi(~0u, __builtin_amdgcn_mbcnt_lo(~0u, 0u)); F.tid = F.wave * 64 + F.lane; } while (0)
#define SEAM(k) do { if (IN(k) && IN((k) + 1)) xcd_barrier(bar); STAMP(); } while (0)
#define SEAML(k) do { if (IN(k) && IN((k) + 1)) { if (local_ok) xcd_local_barrier((unsigned*)ctl, bar.x); else xcd_barrier(bar); } STAMP(); } while (0)

#ifndef PROBE_DUP
#define PROBE_DUP -1
#endif
#define REP(k) for (int rep_ = 0; rep_ < (PROBE_DUP == (k) ? 2 : 1); ++rep_)
    if (IN(0)) { REP(0) p0_prologue(F, p); SEAM(0); }
    local_ok = F.G == 256 && lo == 0 && xb_ld((unsigned*)ctl + CW_MISPLACED) == 0u;
    if (IN(1)) { REP(1) { p1_hrows(F, p); __syncthreads(); p1_ctx_tile(F, p); __syncthreads(); } SEAM(1); }
    if (IN(2)) {
        const int mrows = F.G > NCTXWG ? MLAT : MALL;
        pg8::Gemm g{(const bf16_t*)(p.ws + WS_H), (const bf16_t*)(p.ws + WS_WIN), mrows, NQKV, D}; pg8::StaticOrder S; S.init(mrows, NQKV, F.G, F.bid);
        EpiQKVFast E{p.ws};
        REP(2) pg8::gemm_phase<EpiQKVFast, pg8::StaticOrder, true, true>(F.lds + RING_OFF, g, S, E);
        SEAML(2);
    }
#if HAVE_P3
    if (IN(3)) { REP(31) att::na_units(F, p); att::diff_units_v2<0>(F, p);
#if PROBE_DUP == 321
        att::diff_units_v2<1>(F, p);
#elif PROBE_DUP == 323
        att::diff_units_v2<3>(F, p);
#elif PROBE_DUP == 322
        att::diff_units_v2<2>(F, p);
#elif PROBE_DUP == 32
        att::diff_units_v2<0>(F, p);
#endif
        SEAML(3); }
#endif
    if (IN(4)) {
        pg8::Gemm g{(const bf16_t*)(p.ws + WS_Y), (const bf16_t*)(p.ws + WS_WOUT), MLAT, D, D}; pg8::StaticOrder S; S.init(MLAT, D, F.G, F.bid);
        pg8::EpiBf16<0> E{(bf16_t*)(p.ws + WS_YO), D, nullptr, 0, 0, 1.f};
        REP(4) pg8::gemm_phase<pg8::EpiBf16<0>, pg8::StaticOrder, true, true>(F.lds + RING_OFF, g, S, E);
        SEAML(4);
    }
    if (IN(5)) { REP(5) p5_rows2(F, p); SEAML(5); }
    if (IN(6)) {
        pg8::Gemm g{(const bf16_t*)(p.ws + WS_H2), (const bf16_t*)(p.ws + WS_WPQ), MLAT, 2048, D}; pg8::StaticOrder S; S.init(MLAT, 2048, F.G, F.bid);
        EpiQ2Frag E{(bf16_t*)(p.ws + WS_Q2)};
        REP(6) pg8::gemm_phase<EpiQ2Frag, pg8::StaticOrder, true, true>(F.lds + RING_OFF, g, S, E);
#if PROBE_DUP == 61
        { EpiQ2Frag E2{nullptr}; pg8::gemm_phase<EpiQ2Frag, pg8::StaticOrder, true, true>(F.lds + RING_OFF, g, S, E2); }
#endif
        SEAML(6);
    }
#if HAVE_P7
    if (IN(7)) { REP(7) p7_topk(F, p); SEAM(7); }
#endif
#if P8_PARTITION
    if (IN(8)) {
        p7b_sort(F, p); xcd_barrier(bar);
        for (int ch = 0; ch < 2; ++ch) { p8a_part(F, p, ch); xcd_barrier(bar); p8b_combine(F, p, ch); if (ch == 0) xcd_barrier(bar); }
    }
#else
    if (IN(8)) {
#if PROBE_DUP == 81
        p8_gather<1>(F, p, bar);
#elif PROBE_DUP == 82
        p8_gather<2>(F, p, bar);
#elif PROBE_DUP == 83
        p8_gather<3>(F, p, bar);
#elif PROBE_DUP == 84
        p8_gather<4>(F, p, bar);
#endif
        p8_gather<0>(F, p, bar); }
#endif
#ifdef PROBE_TS
#ifdef PROBE_TS_ENDBAR
    xcd_barrier(bar);
#endif
    STAMP();
    if (blockIdx.x == 0 && threadIdx.x == 0) { const unsigned long long t1_ = ((unsigned long long)F.MISC[33 + 2 * (PROBE_TS + 1)] << 32) | F.MISC[32 + 2 * (PROBE_TS + 1)], t0_ = ((unsigned long long)F.MISC[33 + 2 * PROBE_TS] << 32) | F.MISC[32 + 2 * PROBE_TS];
        const unsigned long long dt = t1_ - t0_; const unsigned long long t_end = __builtin_amdgcn_s_memrealtime();
        while (__builtin_amdgcn_s_memrealtime() - t_end < 8ull * dt) __builtin_amdgcn_s_sleep(8); }
#endif
#undef IN
#undef SEAM
}

static void launch_mk(const Params& p, int lo, int hi, int li, hipStream_t stream) {
    Args a{}; a.p = p; a.ph_lo = lo; a.ph_hi = hi; a.li = li; a.pad = 0;
    hipLaunchKernelGGL(mk_fwd, dim3(256), dim3(NTHR), LDS_BYTES, stream, a);
}
extern "C" void kernel_launch(void* const* d_in, const int* in_sizes, int n_in, void* d_out, int out_size, void* d_ws, size_t ws_size, hipStream_t stream) {
    if (n_in != 16 || ws_size < WS_END) return;
    static bool attr_done = false;
    if (!attr_done) {
        (void)hipFuncSetAttribute((const void*)mk_fwd, hipFuncAttributeMaxDynamicSharedMemorySize, LDS_BYTES);
        attr_done = true;
    }
    Params p{};
    p.x = (const float*)d_in[0]; p.c = (const float*)d_in[1]; p.ctx = (const float*)d_in[2]; p.c_ctx = (const float*)d_in[3];
    p.w_ada = (const float*)d_in[4]; p.b_ada = (const float*)d_in[5]; p.g_norm = (const float*)d_in[6]; p.w_in = (const float*)d_in[7];
    p.rel_bias = (const float*)d_in[8]; p.diff_lambda = (const float*)d_in[9]; p.diff_subln = (const float*)d_in[10]; p.w_out = (const float*)d_in[11];
    p.peer_wq = (const float*)d_in[12]; p.peer_keys = (const float*)d_in[13]; p.peer_u = (const float*)d_in[14]; p.peer_v = (const float*)d_in[15];
    p.out = (float*)d_out; p.ws = (unsigned char*)d_ws;
    (void)hipMemsetAsync((char*)d_ws + WS_CTL, 0, CTL_ZERO_BYTES, stream);

    launch_mk(p, 0, 9, 0, stream);

}
```
